# Optimizing an MI355X kernel written in HIP

```python
import jax, jax.numpy as jnp
from jax import lax
import numpy as np

D_MODEL = 1024
BATCH = 4
SEQ = 4096
DEPTH = 1

EPS = 1e-6
D_MIX = D_MODEL
HG_HEADS = 4
HG_DK = 128
HG_DV = 128
HG_WIDTH = HG_HEADS * HG_DV
HG_CHUNK = 64
NSA_HEADS = 8
NSA_KV_GROUPS = 2
NSA_HD = 64
NSA_WIDTH = NSA_HEADS * NSA_HD
NSA_KV = NSA_KV_GROUPS * NSA_HD
CMP_BLOCK = 32
CMP_STRIDE = 16
CMP_HIDDEN = 256
SEL_BLOCK = 64
N_SEL = 16
WINDOW = 512
Q_BLOCK = 128
ROPE_THETA = 10000.0
N_EXPERTS = 64
TOP_K = 8
N_GROUPS = 8
TOPK_GROUPS = 4
EXPERT_HIDDEN = 256
SHARED_HIDDEN = 256
ROUTED_SCALE = 2.5
EXPERT_BLOCK = 128
IN_SPLITS = (HG_WIDTH,) * 4 + (NSA_WIDTH,) + (NSA_KV,) * 6 + (3 * NSA_HEADS,)
IN_COLS = 4 * HG_WIDTH + NSA_WIDTH + 6 * NSA_KV + 3 * NSA_HEADS

kernel_name = "hymba_hgrn2_nsa_moe_adaln"


def rmsnorm(x, g):
    xf = x.astype(jnp.float32)
    y = xf * lax.rsqrt(jnp.mean(xf * xf, axis=-1, keepdims=True) + EPS)
    return (y * g.astype(jnp.float32)).astype(x.dtype)


def rope(t, pos):
    half = t.shape[-1] // 2
    inv = ROPE_THETA ** (-jnp.arange(half, dtype=jnp.float32) / half)
    ang = pos.astype(jnp.float32)[:, None] * inv[None, :]
    cos, sin = jnp.cos(ang), jnp.sin(ang)
    t1 = t[..., :half].astype(jnp.float32)
    t2 = t[..., half:].astype(jnp.float32)
    return jnp.concatenate([t1 * cos - t2 * sin, t2 * cos + t1 * sin], axis=-1).astype(t.dtype)


def swiglu(t, w_gu, w_dn):
    g, u = jnp.split(t @ w_gu, 2, axis=-1)
    return (jax.nn.silu(g) * u) @ w_dn


def hgrn2_mixer(q, f_logit, i, gate, lb, norm_g):
    B, S, _ = q.shape
    f32 = jnp.float32
    f = lb + (1.0 - lb) * jax.nn.sigmoid(f_logit.astype(f32))
    log_f = jnp.log(f)
    k = 1.0 - f
    n_ch = S // HG_CHUNK

    def to_chunks(t, d):
        return t.reshape(B, n_ch, HG_CHUNK, HG_HEADS, d).transpose(1, 0, 3, 2, 4)

    qc = to_chunks(q.astype(f32) * HG_DK ** -0.5, HG_DK)
    kc = to_chunks(k, HG_DK)
    vc = to_chunks(i.astype(f32), HG_DV)
    bc = jnp.cumsum(to_chunks(log_f, HG_DK), axis=3)
    causal = jnp.tril(jnp.ones((HG_CHUNK, HG_CHUNK), bool))

    def step(state, inp):
        q_, k_, v_, b_ = inp
        diff = jnp.where(causal[:, :, None], b_[:, :, :, None, :] - b_[:, :, None, :, :], -jnp.inf)
        a = jnp.einsum('bhtd,bhtsd,bhsd->bhts', q_, jnp.exp(diff), k_)
        o = a @ v_ + jnp.einsum('bhtd,bhde->bhte', q_ * jnp.exp(b_), state)
        b_last = b_[:, :, -1]
        state = jnp.exp(b_last)[..., None] * state + jnp.einsum(
            'bhsd,bhse->bhde', k_ * jnp.exp(b_last[:, :, None, :] - b_), v_)
        return state, o

    s0 = jnp.zeros((B, HG_HEADS, HG_DK, HG_DV), f32)
    _, o = lax.scan(step, s0, (qc, kc, vc, bc))
    o = o.transpose(1, 0, 3, 2, 4).reshape(B, S, HG_HEADS, HG_DV)
    o = o * lax.rsqrt(jnp.mean(o * o, axis=-1, keepdims=True) + EPS) * norm_g.astype(f32).reshape(HG_HEADS, HG_DV)
    o = o.reshape(B, S, HG_WIDTH) * jax.nn.silu(gate.astype(f32))
    return o.astype(q.dtype)


def nsa_mixer(q, kc, vc, ks, vs, kw, vw, gate_logit,
              pos_k, w1_k, b1_k, w2_k, pos_v, w1_v, b1_v, w2_v):
    B, S, _ = q.shape
    G, HG, HD = NSA_KV_GROUPS, NSA_HEADS // NSA_KV_GROUPS, NSA_HD
    f32 = jnp.float32
    pos = jnp.arange(S)
    scale = HD ** -0.5
    qh = q.reshape(B, S, G, HG, HD).transpose(0, 2, 3, 1, 4)
    q_rot = rope(qh, pos)

    def kv_heads(t):
        return t.reshape(B, S, G, HD).transpose(0, 2, 1, 3)

    n_cmp = (S - CMP_BLOCK) // CMP_STRIDE + 1
    tok_idx = jnp.arange(n_cmp)[:, None] * CMP_STRIDE + jnp.arange(CMP_BLOCK)[None, :]

    def compress(t, pe, w1, b1, w2):
        blocks = kv_heads(t)[:, :, tok_idx] + pe
        hdn = jax.nn.gelu(blocks.reshape(B, G, n_cmp, CMP_BLOCK * HD) @ w1 + b1)
        return hdn @ w2

    k_cmp = compress(kc, pos_k, w1_k, b1_k, w2_k)
    v_cmp = compress(vc, pos_v, w1_v, b1_v, w2_v)
    s_cmp = jnp.einsum('bghsd,bgcd->bghsc', qh, k_cmp).astype(f32) * scale
    c_start = jnp.arange(n_cmp) * CMP_STRIDE
    cmp_mask = (c_start + CMP_BLOCK - 1)[None, :] <= pos[:, None]
    p_cmp = jax.nn.softmax(jnp.where(cmp_mask, s_cmp, -1e30), axis=-1) * cmp_mask
    o_cmp = jnp.einsum('bghsc,bgcd->bghsd', p_cmp, v_cmp.astype(f32))

    n_sb = S // SEL_BLOCK
    n_sel = min(N_SEL, n_sb)
    s_start = jnp.arange(n_sb) * SEL_BLOCK
    overlap = jnp.clip(jnp.minimum(c_start[:, None] + CMP_BLOCK, s_start[None, :] + SEL_BLOCK)
                       - jnp.maximum(c_start[:, None], s_start[None, :]), 0, None).astype(f32) / CMP_BLOCK
    p_slc = jnp.einsum('bghsc,cj->bgsj', p_cmp, overlap)
    cur = pos // SEL_BLOCK
    blk = jnp.arange(n_sb)
    available = blk[None, :] <= cur[:, None]
    forced = (blk[None, :] == 0) | (blk[None, :] == cur[:, None]) | (blk[None, :] == cur[:, None] - 1)
    sel_score = jnp.where(forced, 1e30, jnp.where(available, p_slc, -1e30))
    top_val, top_idx = lax.top_k(sel_score, n_sel)
    top_valid = top_val > -1e29

    n_qb = S // Q_BLOCK
    k_blocks = rope(kv_heads(ks), pos).reshape(B, G, n_sb, SEL_BLOCK * HD)
    v_blocks = kv_heads(vs).reshape(B, G, n_sb, SEL_BLOCK * HD)
    bi = jnp.arange(B)[:, None, None]
    gi = jnp.arange(G)[None, :, None]

    def by_qblock(t, axis):
        shape = t.shape[:axis] + (n_qb, Q_BLOCK) + t.shape[axis + 1:]
        return jnp.moveaxis(t.reshape(shape), axis, 0)

    def slc_block(args):
        qb, idx, valid, qpos = args
        flat = idx.reshape(B, G, Q_BLOCK * n_sel)
        kg = k_blocks[bi, gi, flat].reshape(B, G, Q_BLOCK, n_sel, SEL_BLOCK, HD)
        vg = v_blocks[bi, gi, flat].reshape(B, G, Q_BLOCK, n_sel, SEL_BLOCK, HD)
        s = jnp.einsum('bghqd,bgqnld->bghqnl', qb, kg).astype(f32) * scale
        kpos = idx[..., None] * SEL_BLOCK + jnp.arange(SEL_BLOCK)
        ok = valid[..., None] & (kpos <= qpos[:, None, None])
        s = jnp.where(ok[:, :, None], s, -1e30).reshape(B, G, HG, Q_BLOCK, n_sel * SEL_BLOCK)
        p = jax.nn.softmax(s, axis=-1).reshape(B, G, HG, Q_BLOCK, n_sel, SEL_BLOCK)
        return jnp.einsum('bghqnl,bgqnld->bghqd', p, vg.astype(f32))

    o_slc = lax.map(slc_block, (by_qblock(q_rot, 3), by_qblock(top_idx, 2),
                                by_qblock(top_valid, 2), pos.reshape(n_qb, Q_BLOCK)))
    o_slc = jnp.moveaxis(o_slc, 0, 3).reshape(B, G, HG, S, HD)

    n_back = WINDOW // Q_BLOCK

    def banded(t):
        tp = jnp.pad(t, ((0, 0), (0, 0), (WINDOW, 0), (0, 0))).reshape(B, G, n_qb + n_back, Q_BLOCK, HD)
        return jnp.concatenate([tp[:, :, o:o + n_qb] for o in range(n_back + 1)], axis=3)

    kwb = banded(rope(kv_heads(kw), pos))
    vwb = banded(kv_heads(vw))
    qw = q_rot.reshape(B, G, HG, n_qb, Q_BLOCK, HD)
    s_w = jnp.einsum('bghnqd,bgnkd->bghnqk', qw, kwb).astype(f32) * scale
    qpos = pos.reshape(n_qb, Q_BLOCK)
    kpos = (jnp.arange(n_qb)[:, None] - n_back) * Q_BLOCK + jnp.arange((n_back + 1) * Q_BLOCK)[None, :]
    d = qpos[:, :, None] - kpos[:, None, :]
    ok_w = (d >= 0) & (d < WINDOW) & (kpos[:, None, :] >= 0)
    p_w = jax.nn.softmax(jnp.where(ok_w, s_w, -1e30), axis=-1)
    o_win = jnp.einsum('bghnqk,bgnkd->bghnqd', p_w, vwb.astype(f32)).reshape(B, G, HG, S, HD)

    gates = jax.nn.sigmoid(gate_logit.astype(f32)).reshape(B, S, G, HG, 3).transpose(0, 2, 3, 1, 4)
    o = gates[..., 0:1] * o_cmp + gates[..., 1:2] * o_slc + gates[..., 2:3] * o_win
    return o.transpose(0, 3, 1, 2, 4).reshape(B, S, NSA_WIDTH).astype(q.dtype)


def routed_experts(t, top_i, top_w, w_gu, w_dn):
    T, D = t.shape
    A = T * TOP_K
    e_flat = top_i.reshape(A).astype(jnp.int32)
    w_flat = top_w.reshape(A).astype(jnp.float32)
    order = jnp.argsort(e_flat)
    e_sorted = e_flat[order]
    tok_sorted = (order // TOP_K).astype(jnp.int32)
    counts = jnp.bincount(e_flat, length=N_EXPERTS)
    start = jnp.cumsum(counts) - counts
    padded = (counts + EXPERT_BLOCK - 1) // EXPERT_BLOCK * EXPERT_BLOCK
    pad_end = jnp.cumsum(padded)
    pad_start = pad_end - padded
    dest = pad_start[e_sorted] + jnp.arange(A) - start[e_sorted]
    n_blk = -(-A // EXPERT_BLOCK) + N_EXPERTS
    P = n_blk * EXPERT_BLOCK
    rows = jnp.full((P,), T, jnp.int32).at[dest].set(tok_sorted)
    wts = jnp.zeros((P,), jnp.float32).at[dest].set(w_flat[order])
    blk_expert = jnp.minimum(jnp.searchsorted(pad_end, jnp.arange(n_blk) * EXPERT_BLOCK, side='right'),
                             N_EXPERTS - 1)
    t_pad = jnp.concatenate([t, jnp.zeros((1, D), t.dtype)], axis=0)

    def one_block(args):
        rb, e = args
        return swiglu(t_pad[rb], w_gu[e], w_dn[e]).astype(jnp.float32)

    ys = lax.map(one_block, (rows.reshape(n_blk, EXPERT_BLOCK), blk_expert)).reshape(P, D)
    out = jnp.zeros((T + 1, D), jnp.float32).at[rows].add(ys * wts[:, None])
    return out[:T]


def moe_ffn(h, router_w, router_bias, w_gu, w_dn, w_sh_gu, w_sh_dn):
    B, S, D = h.shape
    t = h.reshape(B * S, D)
    scores = jax.nn.sigmoid((t @ router_w).astype(jnp.float32))
    choice = scores + router_bias.astype(jnp.float32)
    grp = choice.reshape(B * S, N_GROUPS, N_EXPERTS // N_GROUPS)
    grp_score = lax.top_k(grp, 2)[0].sum(-1)
    top_g = lax.top_k(grp_score, TOPK_GROUPS)[1]
    gmask = jnp.any(top_g[..., None] == jnp.arange(N_GROUPS), axis=-2)
    emask = jnp.repeat(gmask, N_EXPERTS // N_GROUPS, axis=-1)
    top_i = lax.top_k(jnp.where(emask, choice, -jnp.inf), TOP_K)[1]
    top_w = jnp.take_along_axis(scores, top_i, axis=-1)
    top_w = top_w / jnp.sum(top_w, axis=-1, keepdims=True) * ROUTED_SCALE
    routed = routed_experts(t, top_i, top_w, w_gu, w_dn)
    shared = swiglu(t, w_sh_gu, w_sh_dn).astype(jnp.float32)
    return (routed + shared).reshape(B, S, D).astype(h.dtype)


def setup_inputs(seed: int = 0) -> dict:
    key = jax.random.key(seed)
    ks = jax.random.split(key, 26)
    L = DEPTH

    def nrm(k, shape, s):
        return jax.random.normal(k, shape, jnp.float32) * s

    return {
        "x": nrm(ks[0], (BATCH, SEQ, D_MODEL), 1.0),
        "c": nrm(ks[1], (BATCH, D_MODEL), 1.0),
        "w_ada": nrm(ks[2], (L, D_MODEL, 6 * D_MODEL), 0.5 * D_MODEL ** -0.5),
        "b_ada": nrm(ks[3], (L, 6 * D_MODEL), 0.02),
        "norm1_g": 1.0 + nrm(ks[4], (L, D_MODEL), 0.02),
        "w_in": nrm(ks[5], (L, D_MODEL, IN_COLS), D_MODEL ** -0.5),
        "hg_lb_logits": nrm(ks[6], (L + 1, HG_WIDTH), 0.5),
        "hg_norm_g": 1.0 + nrm(ks[7], (L, HG_WIDTH), 0.02),
        "cmp_pos_k": nrm(ks[8], (L, CMP_BLOCK, NSA_HD), 0.1),
        "cmp_w1_k": nrm(ks[9], (L, CMP_BLOCK * NSA_HD, CMP_HIDDEN), (CMP_BLOCK * NSA_HD) ** -0.5),
        "cmp_b1_k": nrm(ks[10], (L, CMP_HIDDEN), 0.02),
        "cmp_w2_k": nrm(ks[11], (L, CMP_HIDDEN, NSA_HD), CMP_HIDDEN ** -0.5),
        "cmp_pos_v": nrm(ks[12], (L, CMP_BLOCK, NSA_HD), 0.1),
        "cmp_w1_v": nrm(ks[13], (L, CMP_BLOCK * NSA_HD, CMP_HIDDEN), (CMP_BLOCK * NSA_HD) ** -0.5),
        "cmp_b1_v": nrm(ks[14], (L, CMP_HIDDEN), 0.02),
        "cmp_w2_v": nrm(ks[15], (L, CMP_HIDDEN, NSA_HD), CMP_HIDDEN ** -0.5),
        "w_out": nrm(ks[16], (L, D_MIX, D_MODEL), D_MIX ** -0.5),
        "norm2_g": 1.0 + nrm(ks[17], (L, D_MODEL), 0.02),
        "router_w": nrm(ks[18], (L, D_MODEL, N_EXPERTS), D_MODEL ** -0.5),
        "router_bias": nrm(ks[19], (L, N_EXPERTS), 0.01),
        "w_exp_gu": nrm(ks[20], (L, N_EXPERTS, D_MODEL, 2 * EXPERT_HIDDEN), D_MODEL ** -0.5),
        "w_exp_dn": nrm(ks[21], (L, N_EXPERTS, EXPERT_HIDDEN, D_MODEL), EXPERT_HIDDEN ** -0.5),
        "w_sh_gu": nrm(ks[22], (L, D_MODEL, 2 * SHARED_HIDDEN), D_MODEL ** -0.5),
        "w_sh_dn": nrm(ks[23], (L, SHARED_HIDDEN, D_MODEL), SHARED_HIDDEN ** -0.5),
        "final_g": 1.0 + nrm(ks[24], (D_MODEL,), 0.02),
    }


def reference(x, c, w_ada, b_ada, norm1_g, w_in, hg_lb_logits, hg_norm_g,
              cmp_pos_k, cmp_w1_k, cmp_b1_k, cmp_w2_k, cmp_pos_v, cmp_w1_v, cmp_b1_v, cmp_w2_v,
              w_out, norm2_g, router_w, router_bias, w_exp_gu, w_exp_dn, w_sh_gu, w_sh_dn, final_g):
    offsets = np.cumsum(IN_SPLITS)[:-1].tolist()
    lb_all = jnp.cumsum(jax.nn.softmax(hg_lb_logits.astype(jnp.float32), axis=0), axis=0)
    c_act = jax.nn.silu(c)
    for l in range(DEPTH):
        mod = (c_act @ w_ada[l] + b_ada[l])[:, None, :]
        sh1, sc1, g1, sh2, sc2, g2 = jnp.split(mod, 6, axis=-1)
        h = rmsnorm(x, norm1_g[l]) * (1.0 + sc1) + sh1
        hq, hf, hi, hgt, nq, kc, vc, ksl, vsl, kwn, vwn, ngate = jnp.split(h @ w_in[l], offsets, axis=-1)
        o_hg = hgrn2_mixer(hq, hf, hi, hgt, lb_all[l], hg_norm_g[l])
        o_nsa = nsa_mixer(nq, kc, vc, ksl, vsl, kwn, vwn, ngate,
                          cmp_pos_k[l], cmp_w1_k[l], cmp_b1_k[l], cmp_w2_k[l],
                          cmp_pos_v[l], cmp_w1_v[l], cmp_b1_v[l], cmp_w2_v[l])
        x = x + g1 * (jnp.concatenate([o_hg, o_nsa], axis=-1) @ w_out[l])
        h = rmsnorm(x, norm2_g[l]) * (1.0 + sc2) + sh2
        x = x + g2 * moe_ffn(h, router_w[l], router_bias[l], w_exp_gu[l], w_exp_dn[l], w_sh_gu[l], w_sh_dn[l])
    return rmsnorm(x, final_g)
```

```cpp
#ifndef CPU_EMU
#include <hip/hip_runtime.h>
#endif
#include <cstdio>
#include <cstdint>
#include <cmath>

#ifndef BATCH
#define BATCH 4
#endif
#ifndef SEQ
#define SEQ 4096
#endif

#ifdef CPU_EMU
struct dim3e { unsigned x, y, z; };
static thread_local dim3e threadIdx, blockIdx, blockDim, gridDim;
#define __global__
#define __device__
#define __host__
#define __forceinline__ inline
#define __launch_bounds__(...)
typedef int hipStream_t;
template <class F> static void cpu_launch(unsigned grid, unsigned block, F f) {
#pragma omp parallel for schedule(dynamic, 1)
    for (long b = 0; b < (long)grid; ++b) {
        blockIdx = {(unsigned)b, 0, 0}; blockDim = {block, 1, 1}; gridDim = {grid, 1, 1};
        for (unsigned t = 0; t < block; ++t) { threadIdx = {t, 0, 0}; f(); }
    }
}
static int g_launch_limit = 1 << 30, g_launch_count = 0;
#define LAUNCH(kern, grid, block, ...) do { if (g_launch_count++ < g_launch_limit) cpu_launch((unsigned)(grid), (unsigned)(block), [&]() { kern(__VA_ARGS__); }); } while (0)
#else
#define LAUNCH(kern, grid, block, ...) kern<<<dim3((unsigned)(grid)), dim3((unsigned)(block)), 0, stream>>>(__VA_ARGS__)
#endif

namespace nv {
constexpr int D = 1024, T = BATCH * SEQ, INC = 3352;
constexpr int C_HQ = 0, C_HF = 512, C_HI = 1024, C_HGT = 1536, C_NQ = 2048, C_KC = 2560, C_VC = 2688, C_KS = 2816, C_VS = 2944, C_KW = 3072, C_VW = 3200, C_NG = 3328;
constexpr int NCMP = (SEQ - 32) / 16 + 1, NSB = SEQ / 64, NSEL = NSB < 16 ? NSB : 16;
constexpr float EPS = 1e-6f;

__device__ __forceinline__ float sigmoidf_(float z) { return 1.0f / (1.0f + expf(-z)); }
__device__ __forceinline__ float siluf_(float z) { return z * sigmoidf_(z); }
__device__ __forceinline__ float gelu_tanh(float z) { return 0.5f * z * (1.0f + tanhf(0.7978845608028654f * (z + 0.044715f * z * z * z))); }
__device__ __forceinline__ long gtid() { return (long)blockIdx.x * blockDim.x + threadIdx.x; }

__global__ void k_mod(const float* c, const float* w_ada, const float* b_ada, float* mod) {
    long i = gtid(); if (i >= BATCH * 6144) return; int b = (int)(i / 6144), n = (int)(i % 6144);
    float acc = b_ada[n];
    for (int k = 0; k < D; ++k) acc += siluf_(c[b * D + k]) * w_ada[(size_t)k * 6144 + n];
    mod[i] = acc;
}
__global__ void k_rowrstd(const float* x, float* rstd, int rows) {
    long r = gtid(); if (r >= rows) return; float s = 0.f;
    for (int k = 0; k < D; ++k) { float v = x[(size_t)r * D + k]; s += v * v; }
    rstd[r] = 1.0f / sqrtf(s / D + EPS);
}
__global__ void k_modnorm(const float* x, const float* rstd, const float* g, const float* mod, int sh_chunk, int sc_chunk, float* h) {
    long i = gtid(); if (i >= (long)T * D) return; int r = (int)(i / D), k = (int)(i % D), b = r / SEQ;
    h[i] = x[i] * rstd[r] * g[k] * (1.0f + mod[b * 6144 + sc_chunk * D + k]) + mod[b * 6144 + sh_chunk * D + k];
}
__global__ void k_gemm_nn(const float* A, int lda, const float* Bm, int ldb, float* C, int ldc, int M, int N, int K) {
    long i = gtid(); if (i >= (long)M * N) return; int m = (int)(i / N), n = (int)(i % N);
    float acc = 0.f; const float* a = A + (size_t)m * lda;
    for (int k = 0; k < K; ++k) acc += a[k] * Bm[(size_t)k * ldb + n];
    C[(size_t)m * ldc + n] = acc;
}
__global__ void k_hgf(const float* proj, const float* lbl, float* F) {
    long i = gtid(); if (i >= (long)T * 512) return; int r = (int)(i / 512), j = (int)(i % 512);
    float l0 = lbl[j], l1 = lbl[512 + j]; float mx = fmaxf(l0, l1); float e0 = expf(l0 - mx), e1 = expf(l1 - mx); float lb = e0 / (e0 + e1);
    F[i] = lb + (1.0f - lb) * sigmoidf_(proj[(size_t)r * INC + C_HF + j]);
}
__global__ void __launch_bounds__(64) k_hgrn(const float* proj, const float* F, float* Oraw) {
    long i = gtid(); if (i >= BATCH * 4 * 128) return; int e = (int)(i % 128), h = (int)((i / 128) % 4), b = (int)(i / 512);
    float S[128];
#pragma unroll
    for (int d = 0; d < 128; ++d) S[d] = 0.f;
    for (int t = 0; t < SEQ; ++t) {
        size_t row = (size_t)b * SEQ + t; const float* p = proj + row * INC; const float* f = F + row * 512 + h * 128;
        float v = p[C_HI + h * 128 + e], o = 0.f;
#pragma unroll
        for (int d = 0; d < 128; ++d) { float ff = f[d]; S[d] = ff * S[d] + (1.0f - ff) * v; o += S[d] * p[C_HQ + h * 128 + d]; }
        Oraw[row * 512 + h * 128 + e] = o * 0.08838834764831845f;
    }
}
__global__ void k_hgnorm(const float* Oraw, const float* proj, const float* ng, float* mix) {
    long i = gtid(); if (i >= (long)T * 4) return; size_t row = (size_t)(i / 4); int h = (int)(i % 4);
    const float* o = Oraw + row * 512 + h * 128; float s = 0.f;
    for (int e = 0; e < 128; ++e) s += o[e] * o[e];
    float r = 1.0f / sqrtf(s / 128 + EPS);
    for (int e = 0; e < 128; ++e) mix[row * D + h * 128 + e] = o[e] * r * ng[h * 128 + e] * siluf_(proj[row * INC + C_HGT + h * 128 + e]);
}
__global__ void k_cmp_hidden(const float* proj, int coloff, const float* pe, const float* w1, const float* b1, float* hid) {
    long i = gtid(); if (i >= (long)BATCH * 2 * NCMP * 256) return; int j = (int)(i % 256); long r = i / 256; int c = (int)(r % NCMP), g = (int)((r / NCMP) % 2), b = (int)(r / (NCMP * 2));
    float acc = b1[j];
    for (int l = 0; l < 32; ++l) { const float* p = proj + ((size_t)b * SEQ + 16 * c + l) * INC + coloff + g * 64;
        for (int d = 0; d < 64; ++d) acc += (p[d] + pe[l * 64 + d]) * w1[(size_t)(l * 64 + d) * 256 + j]; }
    hid[i] = gelu_tanh(acc);
}
__global__ void k_cmp_out(const float* hid, const float* w2, float* out) {
    long i = gtid(); if (i >= (long)BATCH * 2 * NCMP * 64) return; int d = (int)(i % 64); long r = i / 64;
    float acc = 0.f; for (int j = 0; j < 256; ++j) acc += hid[r * 256 + j] * w2[j * 64 + d];
    out[i] = acc;
}
__global__ void k_rope_tab(float* cs, float* sn) {
    long i = gtid(); if (i >= (long)SEQ * 32) return; int pos = (int)(i / 32), k = (int)(i % 32);
    float inv = powf(10000.0f, -(float)k / 32.0f); float ang = (float)pos * inv; cs[i] = cosf(ang); sn[i] = sinf(ang);
}
__global__ void k_rope_apply(const float* proj, int coloff, int nh, const float* cs, const float* sn, float* dst) {
    long i = gtid(); if (i >= (long)T * nh * 32) return; int k = (int)(i % 32); int h = (int)((i / 32) % nh); size_t row = (size_t)(i / (32 * nh)); int pos = (int)(row % SEQ);
    const float* p = proj + row * INC + coloff + h * 64; float t1 = p[k], t2 = p[k + 32], co = cs[pos * 32 + k], si = sn[pos * 32 + k];
    dst[row * (nh * 64) + h * 64 + k] = t1 * co - t2 * si; dst[row * (nh * 64) + h * 64 + k + 32] = t2 * co + t1 * si;
}
__global__ void __launch_bounds__(64) k_cmp_attn(const float* proj, const float* kcmp, const float* vcmp, float* ocmp, float* PS) {
    long i = gtid(); if (i >= (long)BATCH * 2 * SEQ) return; int s = (int)(i % SEQ), g = (int)((i / SEQ) % 2), b = (int)(i / (2 * SEQ));
    size_t row = (size_t)b * SEQ + s; float* ps = PS + (size_t)i * 64;
    for (int j = 0; j < 64; ++j) ps[j] = 0.f;
    int ncv = s >= 31 ? (s - 31) / 16 + 1 : 0; if (ncv > NCMP) ncv = NCMP;
    const float* kc = kcmp + (size_t)(b * 2 + g) * NCMP * 64; const float* vc = vcmp + (size_t)(b * 2 + g) * NCMP * 64;
    for (int hh = 0; hh < 4; ++hh) {
        int head = g * 4 + hh; const float* qp = proj + row * INC + C_NQ + head * 64;
        float q[64], o[64];
#pragma unroll
        for (int d = 0; d < 64; ++d) { q[d] = qp[d]; o[d] = 0.f; }
        float m = -3.0e38f, l = 0.f;
        for (int c = 0; c < ncv; ++c) { float sc = 0.f;
#pragma unroll
            for (int d = 0; d < 64; ++d) sc += q[d] * kc[c * 64 + d];
            sc *= 0.125f; float mn = fmaxf(m, sc); l = l * expf(m - mn) + expf(sc - mn); m = mn; }
        for (int c = 0; c < ncv; ++c) { float sc = 0.f;
#pragma unroll
            for (int d = 0; d < 64; ++d) sc += q[d] * kc[c * 64 + d];
            sc *= 0.125f; float p = expf(sc - m) / l;
#pragma unroll
            for (int d = 0; d < 64; ++d) o[d] += p * vc[c * 64 + d];
            int c0 = 16 * c, c1 = 16 * c + 32;
            for (int j = c0 / 64; j <= (c1 - 1) / 64 && j < NSB; ++j) { int lo = c0 > 64 * j ? c0 : 64 * j, hi = c1 < 64 * j + 64 ? c1 : 64 * j + 64; if (hi > lo) ps[j] += p * (float)(hi - lo) / 32.0f; } }
#pragma unroll
        for (int d = 0; d < 64; ++d) ocmp[row * 512 + head * 64 + d] = o[d];
    }
}
__global__ void k_select(const float* PS, unsigned* SEL) {
    long i = gtid(); if (i >= (long)BATCH * 2 * SEQ) return; int s = (int)(i % SEQ); const float* ps = PS + (size_t)i * 64; int cur = s / 64;
    unsigned m0 = 0, m1 = 0;
    for (int j = 0; j < NSB; ++j) {
        bool fj = (j == 0) || (j == cur) || (j == cur - 1); float sj = fj ? 1e30f : (j <= cur ? ps[j] : -1e30f);
        int rank = 0;
        for (int k = 0; k < NSB; ++k) { bool fk = (k == 0) || (k == cur) || (k == cur - 1); float sk = fk ? 1e30f : (k <= cur ? ps[k] : -1e30f); if (sk > sj || (sk == sj && k < j)) ++rank; }
        if (rank < NSEL && sj > -1e29f) { if (j < 32) m0 |= 1u << j; else m1 |= 1u << (j - 32); }
    }
    SEL[i * 2] = m0; SEL[i * 2 + 1] = m1;
}
__global__ void __launch_bounds__(64) k_attn_naive(const float* qrot, const float* krot, const float* proj, int vcol, const unsigned* SEL, int mode, float* out) {
    long i = gtid(); if (i >= (long)BATCH * 8 * SEQ) return; int s = (int)(i % SEQ), head = (int)((i / SEQ) % 8), b = (int)(i / (8 * SEQ)); int g = head / 4;
    size_t row = (size_t)b * SEQ + s; float q[64], o[64];
#pragma unroll
    for (int d = 0; d < 64; ++d) { q[d] = qrot[row * 512 + head * 64 + d]; o[d] = 0.f; }
    float m = -3.0e38f, l = 0.f;
    unsigned m0 = 0, m1 = 0; if (mode == 0) { size_t si = ((size_t)(b * 2 + g) * SEQ + s) * 2; m0 = SEL[si]; m1 = SEL[si + 1]; }
    int k0 = mode == 0 ? 0 : (s - 511 > 0 ? s - 511 : 0);
    for (int key = k0; key <= s; ++key) {
        if (mode == 0) { int j = key / 64; bool sel = j < 32 ? ((m0 >> j) & 1u) : ((m1 >> (j - 32)) & 1u); if (!sel) { key = j * 64 + 63; continue; } }
        size_t kr = (size_t)b * SEQ + key; const float* kp = krot + kr * 128 + g * 64; const float* vp = proj + kr * INC + vcol + g * 64;
        float sc = 0.f;
#pragma unroll
        for (int d = 0; d < 64; ++d) sc += q[d] * kp[d];
        sc *= 0.125f; float mn = fmaxf(m, sc), a = expf(m - mn), p = expf(sc - mn); l = l * a + p; m = mn;
#pragma unroll
        for (int d = 0; d < 64; ++d) o[d] = o[d] * a + p * vp[d];
    }
#pragma unroll
    for (int d = 0; d < 64; ++d) out[row * 512 + head * 64 + d] = o[d] / l;
}
__global__ void k_nsa_combine(const float* proj, const float* ocmp, const float* oslc, const float* owin, float* mix) {
    long i = gtid(); if (i >= (long)T * 512) return; size_t row = (size_t)(i / 512); int c = (int)(i % 512), head = c / 64;
    const float* gp = proj + row * INC + C_NG + head * 3;
    mix[row * D + 512 + c] = sigmoidf_(gp[0]) * ocmp[i] + sigmoidf_(gp[1]) * oslc[i] + sigmoidf_(gp[2]) * owin[i];
}
__global__ void k_proj_res(const float* A, const float* W, const float* x, const float* mod, int chunk, float* out) {
    long i = gtid(); if (i >= (long)T * D) return; int r = (int)(i / D), n = (int)(i % D), b = r / SEQ;
    float acc = 0.f; const float* a = A + (size_t)r * D;
    for (int k = 0; k < D; ++k) acc += a[k] * W[(size_t)k * D + n];
    out[i] = x[i] + mod[b * 6144 + chunk * D + n] * acc;
}
__global__ void k_route(const float* LG, const float* bias, int* TOPI, float* TOPW) {
    long t = gtid(); if (t >= T) return; const float* lg = LG + (size_t)t * 64;
    float gs[8];
#pragma unroll
    for (int gI = 0; gI < 8; ++gI) { float a = -3e38f, b2 = -3e38f;
        for (int e = 0; e < 8; ++e) { float ch = sigmoidf_(lg[gI * 8 + e]) + bias[gI * 8 + e]; if (ch > a) { b2 = a; a = ch; } else if (ch > b2) b2 = ch; }
        gs[gI] = a + b2; }
    unsigned gmask = 0;
#pragma unroll
    for (int gI = 0; gI < 8; ++gI) { int rank = 0;
#pragma unroll
        for (int k = 0; k < 8; ++k) if (gs[k] > gs[gI] || (gs[k] == gs[gI] && k < gI)) ++rank;
        if (rank < 4) gmask |= 1u << gI; }
    int n = 0; float wsum = 0.f;
    for (int e = 0; e < 64; ++e) { if (!((gmask >> (e / 8)) & 1u)) continue; float se = sigmoidf_(lg[e]), ce = se + bias[e]; int rank = 0;
        for (int k = 0; k < 64; ++k) { if (!((gmask >> (k / 8)) & 1u)) continue; float ck = sigmoidf_(lg[k]) + bias[k]; if (ck > ce || (ck == ce && k < e)) ++rank; }
        if (rank < 8) { TOPI[t * 8 + n] = e; TOPW[t * 8 + n] = se; wsum += se; ++n; } }
    for (int k = 0; k < 8; ++k) TOPW[t * 8 + k] = TOPW[t * 8 + k] / wsum * 2.5f;
}
__global__ void k_moe_act(const float* h2, const float* Wgu, const int* TOPI, float* ACT, long nA) {
    long i = gtid(); if (i >= nA * 256) return; long a = i / 256; int j = (int)(i % 256); long t = TOPI ? a / 8 : a; int e = TOPI ? TOPI[a] : 0;
    const float* hp = h2 + (size_t)t * D; const float* w = Wgu + (size_t)e * D * 512; float gq = 0.f, u = 0.f;
    for (int k = 0; k < D; ++k) { float hv = hp[k]; gq += hv * w[(size_t)k * 512 + j]; u += hv * w[(size_t)k * 512 + 256 + j]; }
    ACT[i] = siluf_(gq) * u;
}
__global__ void k_moe_out(const float* ACT, const float* ACTS, const float* Wdn, const float* Wsd, const int* TOPI, const float* TOPW, const float* x2, const float* mod, float* x3) {
    long i = gtid(); if (i >= (long)T * D) return; long t = i / D; int n = (int)(i % D), b = (int)(t / SEQ);
    float acc = 0.f;
    for (int sl = 0; sl < 8; ++sl) { int e = TOPI[t * 8 + sl]; const float* a = ACT + (size_t)(t * 8 + sl) * 256; const float* w = Wdn + (size_t)e * 256 * D; float y = 0.f;
        for (int k = 0; k < 256; ++k) y += a[k] * w[(size_t)k * D + n];
        acc += TOPW[t * 8 + sl] * y; }
    { const float* a = ACTS + (size_t)t * 256; float y = 0.f; for (int k = 0; k < 256; ++k) y += a[k] * Wsd[(size_t)k * D + n]; acc += y; }
    x3[i] = x2[i] + mod[b * 6144 + 5 * D + n] * acc;
}
__global__ void k_final(const float* x3, const float* rstd, const float* g, float* out) {
    long i = gtid(); if (i >= (long)T * D) return; out[i] = x3[i] * rstd[i / D] * g[i % D];
}

struct Bufs {
    float *mod, *rstd, *h, *h2, *proj, *F, *oraw, *mix, *hid, *kcmp, *vcmp, *cs, *sn, *qrot, *ksr, *kwr, *ocmp, *oslc, *owin, *PS, *x2, *lg, *topw, *act, *acts, *x3;
    unsigned* sel; int* topi; size_t total;
    void init(float* w) { size_t o = 0; auto take = [&](size_t n) { float* p = w + o; o += (n + 63) / 64 * 64; return p; };
        mod = take(BATCH * 6144); rstd = take(T); hid = take((size_t)BATCH * 2 * NCMP * 256); kcmp = take((size_t)BATCH * 2 * NCMP * 64); vcmp = take((size_t)BATCH * 2 * NCMP * 64); cs = take(SEQ * 32); sn = take(SEQ * 32);
        h = take((size_t)T * D); proj = take((size_t)T * INC); F = take((size_t)T * 512); oraw = take((size_t)T * 512); mix = take((size_t)T * D);
        qrot = take((size_t)T * 512); ksr = take((size_t)T * 128); kwr = take((size_t)T * 128); PS = take((size_t)BATCH * 2 * SEQ * 64); sel = (unsigned*)take((size_t)BATCH * 2 * SEQ * 2);
        topi = (int*)take((size_t)T * 8); topw = take((size_t)T * 8); total = o;
        owin = h;
        x2 = h;
        ocmp = F; oslc = oraw;
        h2 = F;
        act = proj;
        acts = qrot;
        lg = PS;
        x3 = mix; }
};

static void run_naive(void* const* d_in, float* out, float* ws, hipStream_t stream) {
    const float* x = (const float*)d_in[0]; const float* c = (const float*)d_in[1]; const float* w_ada = (const float*)d_in[2]; const float* b_ada = (const float*)d_in[3];
    const float* n1g = (const float*)d_in[4]; const float* w_in = (const float*)d_in[5]; const float* lbl = (const float*)d_in[6]; const float* hng = (const float*)d_in[7];
    const float* pek = (const float*)d_in[8]; const float* w1k = (const float*)d_in[9]; const float* b1k = (const float*)d_in[10]; const float* w2k = (const float*)d_in[11];
    const float* pev = (const float*)d_in[12]; const float* w1v = (const float*)d_in[13]; const float* b1v = (const float*)d_in[14]; const float* w2v = (const float*)d_in[15];
    const float* w_out = (const float*)d_in[16]; const float* n2g = (const float*)d_in[17]; const float* rw = (const float*)d_in[18]; const float* rb = (const float*)d_in[19];
    const float* wgu = (const float*)d_in[20]; const float* wdn = (const float*)d_in[21]; const float* wsgu = (const float*)d_in[22]; const float* wsdn = (const float*)d_in[23]; const float* fg = (const float*)d_in[24];
    Bufs B; B.init(ws);
    const int TB = 256;
#define NB(n) (((long)(n) + TB - 1) / TB)
    LAUNCH(k_mod, NB(BATCH * 6144), TB, c, w_ada, b_ada, B.mod);
    LAUNCH(k_rowrstd, NB(T), TB, x, B.rstd, T);
    LAUNCH(k_modnorm, NB((long)T * D), TB, x, B.rstd, n1g, B.mod, 0, 1, B.h);
    LAUNCH(k_gemm_nn, NB((long)T * INC), TB, B.h, D, w_in, INC, B.proj, INC, T, INC, D);
    LAUNCH(k_hgf, NB((long)T * 512), TB, B.proj, lbl, B.F);
    LAUNCH(k_hgrn, (BATCH * 512 + 63) / 64, 64, B.proj, B.F, B.oraw);
    LAUNCH(k_hgnorm, NB((long)T * 4), TB, B.oraw, B.proj, hng, B.mix);
    LAUNCH(k_cmp_hidden, NB((long)BATCH * 2 * NCMP * 256), TB, B.proj, C_KC, pek, w1k, b1k, B.hid);
    LAUNCH(k_cmp_out, NB((long)BATCH * 2 * NCMP * 64), TB, B.hid, w2k, B.kcmp);
    LAUNCH(k_cmp_hidden, NB((long)BATCH * 2 * NCMP * 256), TB, B.proj, C_VC, pev, w1v, b1v, B.hid);
    LAUNCH(k_cmp_out, NB((long)BATCH * 2 * NCMP * 64), TB, B.hid, w2v, B.vcmp);
    LAUNCH(k_rope_tab, NB(SEQ * 32), TB, B.cs, B.sn);
    LAUNCH(k_rope_apply, NB((long)T * 8 * 32), TB, B.proj, C_NQ, 8, B.cs, B.sn, B.qrot);
    LAUNCH(k_rope_apply, NB((long)T * 2 * 32), TB, B.proj, C_KS, 2, B.cs, B.sn, B.ksr);
    LAUNCH(k_rope_apply, NB((long)T * 2 * 32), TB, B.proj, C_KW, 2, B.cs, B.sn, B.kwr);
    LAUNCH(k_cmp_attn, ((long)BATCH * 2 * SEQ + 63) / 64, 64, B.proj, B.kcmp, B.vcmp, B.ocmp, B.PS);
    LAUNCH(k_select, NB((long)BATCH * 2 * SEQ), TB, B.PS, B.sel);
    LAUNCH(k_attn_naive, ((long)BATCH * 8 * SEQ + 63) / 64, 64, B.qrot, B.ksr, B.proj, C_VS, B.sel, 0, B.oslc);
    LAUNCH(k_attn_naive, ((long)BATCH * 8 * SEQ + 63) / 64, 64, B.qrot, B.kwr, B.proj, C_VW, B.sel, 1, B.owin);
    LAUNCH(k_nsa_combine, NB((long)T * 512), TB, B.proj, B.ocmp, B.oslc, B.owin, B.mix);
    LAUNCH(k_proj_res, NB((long)T * D), TB, B.mix, w_out, x, B.mod, 2, B.x2);
    LAUNCH(k_rowrstd, NB(T), TB, B.x2, B.rstd, T);
    LAUNCH(k_modnorm, NB((long)T * D), TB, B.x2, B.rstd, n2g, B.mod, 3, 4, B.h2);
    LAUNCH(k_gemm_nn, NB((long)T * 64), TB, B.h2, D, rw, 64, B.lg, 64, T, 64, D);
    LAUNCH(k_route, (T + 63) / 64, 64, B.lg, rb, B.topi, B.topw);
    LAUNCH(k_moe_act, NB((long)T * 8 * 256), TB, B.h2, wgu, B.topi, B.act, (long)T * 8);
    LAUNCH(k_moe_act, NB((long)T * 256), TB, B.h2, wsgu, (const int*)nullptr, B.acts, (long)T);
    LAUNCH(k_moe_out, NB((long)T * D), TB, B.act, B.acts, wdn, wsdn, B.topi, B.topw, B.x2, B.mod, B.x3);
    LAUNCH(k_rowrstd, NB(T), TB, B.x3, B.rstd, T);
    LAUNCH(k_final, NB((long)T * D), TB, B.x3, B.rstd, fg, out);
#undef NB
}
}

#ifndef CPU_EMU
extern "C" void kernel_launch(void* const* d_in, const int* in_sizes, int n_in, void* d_out, int out_size, void* d_ws, size_t ws_size, hipStream_t stream) {
    nv::Bufs B; B.init((float*)d_ws);
    if (B.total * 4 > ws_size) { fprintf(stderr, "ws too small: need %zu have %zu\n", B.total * 4, ws_size); return; }
    nv::run_naive(d_in, (float*)d_out, (float*)d_ws, stream);
}
#endif
```

```cpp
#ifndef CPU_EMU
#include <hip/hip_runtime.h>
#endif
#include <cstdio>
#include <cstdint>
#include <cmath>

#ifndef BATCH
#define BATCH 4
#endif
#ifndef SEQ
#define SEQ 4096
#endif

#ifdef CPU_EMU
struct dim3e { unsigned x, y, z; };
static thread_local dim3e threadIdx, blockIdx, blockDim, gridDim;
#define __global__
#define __device__
#define __host__
#define __forceinline__ inline
#define __launch_bounds__(...)
typedef int hipStream_t;
template <class F> static void cpu_launch(unsigned grid, unsigned block, F f) {
#pragma omp parallel for schedule(dynamic, 1)
    for (long b = 0; b < (long)grid; ++b) {
        blockIdx = {(unsigned)b, 0, 0}; blockDim = {block, 1, 1}; gridDim = {grid, 1, 1};
        for (unsigned t = 0; t < block; ++t) { threadIdx = {t, 0, 0}; f(); }
    }
}
static int g_launch_limit = 1 << 30, g_launch_count = 0;
#define LAUNCH(kern, grid, block, ...) do { if (g_launch_count++ < g_launch_limit) cpu_launch((unsigned)(grid), (unsigned)(block), [&]() { kern(__VA_ARGS__); }); } while (0)
#else
#define LAUNCH(kern, grid, block, ...) kern<<<dim3((unsigned)(grid)), dim3((unsigned)(block)), 0, stream>>>(__VA_ARGS__)
#endif

typedef unsigned short bf16_t;
constexpr int D = 1024, T = BATCH * SEQ, INC = 3352, LDP = 3584;
constexpr int C_HQ = 0, C_HF = 512, C_HI = 1024, C_HGT = 1536, C_NQ = 2048, C_KC = 2560, C_VC = 2688, C_KS = 2816, C_VS = 2944, C_KW = 3072, C_VW = 3200, C_NG = 3328;
constexpr int NCMP = (SEQ - 32) / 16 + 1, NSB = SEQ / 64, NSEL = NSB < 16 ? NSB : 16;
constexpr float EPS = 1e-6f;

constexpr size_t MiB = 1u << 20, KiB = 1u << 10;
constexpr size_t WS_CTL = 0, CTL_ZERO_BYTES = 1 * MiB;
constexpr size_t WS_MODP = 1 * MiB;
constexpr size_t WS_MOD = 2 * MiB + 512 * KiB;
constexpr size_t WS_B1F = WS_MOD + 128 * KiB;
constexpr size_t WS_CS = 2 * MiB + 768 * KiB, WS_SN = WS_CS + 512 * KiB;
constexpr size_t WS_WDNT = 4 * MiB;
constexpr size_t WS_WSDNT = 36 * MiB;
constexpr size_t WS_X2 = 37 * MiB;
constexpr size_t WS_ACT = 101 * MiB;
constexpr size_t WS_ACTS = 173 * MiB;
constexpr size_t WS_ROWL = 181 * MiB;
constexpr size_t WS_TOPI = 189 * MiB, WS_TOPW = WS_TOPI + 512 * KiB;
constexpr size_t WS_ERANK = 185 * MiB;
constexpr size_t WS_WGUT = 190 * MiB;
constexpr size_t WS_WSGUT = 254 * MiB;
constexpr size_t WS_WINT = 255 * MiB;
constexpr size_t WS_WOUTT = 262 * MiB;
constexpr size_t WS_W1KT = 264 * MiB, WS_W1VT = 265 * MiB;
constexpr size_t WS_W2T = 266 * MiB;
constexpr size_t WS_RW = 267 * MiB;
constexpr size_t WS_XN = 268 * MiB;
constexpr size_t WS_H2 = WS_XN;
constexpr size_t WS_PROJ = 300 * MiB;
constexpr size_t WS_KSR = 412 * MiB, WS_KWR = 416 * MiB;
constexpr size_t WS_VST = 420 * MiB, WS_VWT = 424 * MiB;
constexpr size_t WS_KCMP = 428 * MiB, WS_VCMPT = WS_KCMP + 256 * KiB;
constexpr size_t WS_U = 429 * MiB, WS_DD = 445 * MiB;
constexpr size_t WS_MIX = 446 * MiB;
constexpr size_t WS_Y = 190 * MiB;
constexpr size_t WS_YS = 478 * MiB;
constexpr size_t WS_END = 512 * MiB;
constexpr size_t NV_H = 37 * MiB, NV_RSTD = 101 * MiB;
constexpr size_t NV_F = 37 * MiB, NV_ORAW = 69 * MiB, NV_OWIN = 101 * MiB, NV_KSR = 133 * MiB, NV_KWR = 141 * MiB, NV_PS = 149 * MiB, NV_SEL = 157 * MiB,
                 NV_HID = 158 * MiB, NV_KCMP = 160 * MiB, NV_VCMP = 160 * MiB + 512 * KiB, NV_CS = 161 * MiB, NV_SN = 161 * MiB + 512 * KiB, NV_QROT = 478 * MiB;
constexpr size_t NV_H2F = 300 * MiB, NV_LG = 364 * MiB, NV_RSTD2 = 368 * MiB;
constexpr size_t NV_ACT = 300 * MiB, NV_ACTS = 101 * MiB, NV_X3 = 446 * MiB, NV_RSTD3 = 510 * MiB;

__host__ __device__ __forceinline__ float bf2f(bf16_t v) { union { unsigned u; float f; } c; c.u = (unsigned)v << 16; return c.f; }
__host__ __device__ __forceinline__ bf16_t f2bf(float f) { union { unsigned u; float f; } c; c.f = f; unsigned u = c.u; return (bf16_t)((u + 0x7fffu + ((u >> 16) & 1u)) >> 16); }

namespace nv {
__device__ __forceinline__ float sigmoidf_(float z) { return 1.0f / (1.0f + expf(-z)); }
__device__ __forceinline__ float siluf_(float z) { return z * sigmoidf_(z); }
__device__ __forceinline__ float gelu_tanh(float z) { return 0.5f * z * (1.0f + tanhf(0.7978845608028654f * (z + 0.044715f * z * z * z))); }
__device__ __forceinline__ long gtid() { return (long)blockIdx.x * blockDim.x + threadIdx.x; }
#define PJ(row, col) bf2f(proj[(size_t)(row) * LDP + (col)])

__global__ void k_mod(const float* c, const float* w_ada, const float* b_ada, float* mod) {
    long i = gtid(); if (i >= BATCH * 6144) return; int b = (int)(i / 6144), n = (int)(i % 6144);
    float acc = b_ada[n];
    for (int k = 0; k < D; ++k) acc += siluf_(c[b * D + k]) * w_ada[(size_t)k * 6144 + n];
    mod[i] = acc;
}
__global__ void k_rowrstd(const float* x, float* rstd, int rows) {
    long r = gtid(); if (r >= rows) return; float s = 0.f;
    for (int k = 0; k < D; ++k) { float v = x[(size_t)r * D + k]; s += v * v; }
    rstd[r] = 1.0f / sqrtf(s / D + EPS);
}
__global__ void k_modnorm(const float* x, const float* rstd, const float* g, const float* mod, int sh_chunk, int sc_chunk, float* hf, bf16_t* hb) {
    long i = gtid(); if (i >= (long)T * D) return; int r = (int)(i / D), k = (int)(i % D), b = r / SEQ;
    float v = x[i] * rstd[r] * g[k] * (1.0f + mod[b * 6144 + sc_chunk * D + k]) + mod[b * 6144 + sh_chunk * D + k];
    if (hf) hf[i] = v; if (hb) hb[i] = f2bf(v);
}
__global__ void k_gemm_nn_bf(const float* A, int lda, const float* Bm, int ldb, bf16_t* C, int ldc, int M, int N, int K) {
    long i = gtid(); if (i >= (long)M * N) return; int m = (int)(i / N), n = (int)(i % N);
    float acc = 0.f; const float* a = A + (size_t)m * lda;
    for (int k = 0; k < K; ++k) acc += a[k] * Bm[(size_t)k * ldb + n];
    C[(size_t)m * ldc + n] = f2bf(acc);
}
__global__ void k_gemm_nn(const float* A, int lda, const float* Bm, int ldb, float* C, int ldc, int M, int N, int K) {
    long i = gtid(); if (i >= (long)M * N) return; int m = (int)(i / N), n = (int)(i % N);
    float acc = 0.f; const float* a = A + (size_t)m * lda;
    for (int k = 0; k < K; ++k) acc += a[k] * Bm[(size_t)k * ldb + n];
    C[(size_t)m * ldc + n] = acc;
}
__global__ void k_hgf(const bf16_t* proj, const float* lbl, float* F) {
    long i = gtid(); if (i >= (long)T * 512) return; int r = (int)(i / 512), j = (int)(i % 512);
    float l0 = lbl[j], l1 = lbl[512 + j]; float mx = fmaxf(l0, l1); float e0 = expf(l0 - mx), e1 = expf(l1 - mx); float lb = e0 / (e0 + e1);
    F[i] = lb + (1.0f - lb) * sigmoidf_(PJ(r, C_HF + j));
}
__global__ void __launch_bounds__(64) k_hgrn(const bf16_t* proj, const float* F, float* Oraw) {
    long i = gtid(); if (i >= BATCH * 4 * 128) return; int e = (int)(i % 128), h = (int)((i / 128) % 4), b = (int)(i / 512);
    float S[128];
#pragma unroll
    for (int d = 0; d < 128; ++d) S[d] = 0.f;
    for (int t = 0; t < SEQ; ++t) {
        size_t row = (size_t)b * SEQ + t; const bf16_t* p = proj + row * LDP; const float* f = F + row * 512 + h * 128;
        float v = bf2f(p[C_HI + h * 128 + e]), o = 0.f;
#pragma unroll
        for (int d = 0; d < 128; ++d) { float ff = f[d]; S[d] = ff * S[d] + (1.0f - ff) * v; o += S[d] * bf2f(p[C_HQ + h * 128 + d]); }
        Oraw[row * 512 + h * 128 + e] = o * 0.08838834764831845f;
    }
}
__global__ void k_hgnorm(const float* Oraw, const bf16_t* proj, const float* ng, bf16_t* mix) {
    long i = gtid(); if (i >= (long)T * 4) return; size_t row = (size_t)(i / 4); int h = (int)(i % 4);
    const float* o = Oraw + row * 512 + h * 128; float s = 0.f;
    for (int e = 0; e < 128; ++e) s += o[e] * o[e];
    float r = 1.0f / sqrtf(s / 128 + EPS);
    for (int e = 0; e < 128; ++e) mix[row * D + h * 128 + e] = f2bf(o[e] * r * ng[h * 128 + e] * siluf_(PJ(row, C_HGT + h * 128 + e)));
}
__global__ void k_cmp_hidden(const bf16_t* proj, int coloff, const float* pe, const float* w1, const float* b1, float* hid) {
    long i = gtid(); if (i >= (long)BATCH * 2 * NCMP * 256) return; int j = (int)(i % 256); long r = i / 256; int c = (int)(r % NCMP), g = (int)((r / NCMP) % 2), b = (int)(r / (NCMP * 2));
    float acc = b1[j];
    for (int l = 0; l < 32; ++l) { const bf16_t* p = proj + ((size_t)b * SEQ + 16 * c + l) * LDP + coloff + g * 64;
        for (int d = 0; d < 64; ++d) acc += (bf2f(p[d]) + pe[l * 64 + d]) * w1[(size_t)(l * 64 + d) * 256 + j]; }
    hid[i] = gelu_tanh(acc);
}
__global__ void k_cmp_out(const float* hid, const float* w2, float* out) {
    long i = gtid(); if (i >= (long)BATCH * 2 * NCMP * 64) return; int d = (int)(i % 64); long r = i / 64;
    float acc = 0.f; for (int j = 0; j < 256; ++j) acc += hid[r * 256 + j] * w2[j * 64 + d];
    out[i] = acc;
}
__global__ void k_rope_tab(float* cs, float* sn) {
    long i = gtid(); if (i >= (long)SEQ * 32) return; int pos = (int)(i / 32), k = (int)(i % 32);
    float inv = powf(10000.0f, -(float)k / 32.0f); float ang = (float)pos * inv; cs[i] = cosf(ang); sn[i] = sinf(ang);
}
__global__ void k_rope_apply(const bf16_t* proj, int coloff, int nh, const float* cs, const float* sn, float* dst) {
    long i = gtid(); if (i >= (long)T * nh * 32) return; int k = (int)(i % 32); int h = (int)((i / 32) % nh); size_t row = (size_t)(i / (32 * nh)); int pos = (int)(row % SEQ);
    float t1 = PJ(row, coloff + h * 64 + k), t2 = PJ(row, coloff + h * 64 + k + 32), co = cs[pos * 32 + k], si = sn[pos * 32 + k];
    dst[row * (nh * 64) + h * 64 + k] = t1 * co - t2 * si; dst[row * (nh * 64) + h * 64 + k + 32] = t2 * co + t1 * si;
}
__global__ void __launch_bounds__(64) k_cmp_attn(const bf16_t* proj, const float* kcmp, const float* vcmp, float* ocmp, float* PS) {
    long i = gtid(); if (i >= (long)BATCH * 2 * SEQ) return; int s = (int)(i % SEQ), g = (int)((i / SEQ) % 2), b = (int)(i / (2 * SEQ));
    size_t row = (size_t)b * SEQ + s; float* ps = PS + (size_t)i * 64;
    for (int j = 0; j < 64; ++j) ps[j] = 0.f;
    int ncv = s >= 31 ? (s - 31) / 16 + 1 : 0; if (ncv > NCMP) ncv = NCMP;
    const float* kc = kcmp + (size_t)(b * 2 + g) * NCMP * 64; const float* vc = vcmp + (size_t)(b * 2 + g) * NCMP * 64;
    for (int hh = 0; hh < 4; ++hh) {
        int head = g * 4 + hh;
        float q[64], o[64];
#pragma unroll
        for (int d = 0; d < 64; ++d) { q[d] = PJ(row, C_NQ + head * 64 + d); o[d] = 0.f; }
        float m = -3.0e38f, l = 0.f;
        for (int c = 0; c < ncv; ++c) { float sc = 0.f;
#pragma unroll
            for (int d = 0; d < 64; ++d) sc += q[d] * kc[c * 64 + d];
            sc *= 0.125f; float mn = fmaxf(m, sc); l = l * expf(m - mn) + expf(sc - mn); m = mn; }
        for (int c = 0; c < ncv; ++c) { float sc = 0.f;
#pragma unroll
            for (int d = 0; d < 64; ++d) sc += q[d] * kc[c * 64 + d];
            sc *= 0.125f; float p = expf(sc - m) / l;
#pragma unroll
            for (int d = 0; d < 64; ++d) o[d] += p * vc[c * 64 + d];
            int c0 = 16 * c, c1 = 16 * c + 32;
            for (int j = c0 / 64; j <= (c1 - 1) / 64 && j < NSB; ++j) { int lo = c0 > 64 * j ? c0 : 64 * j, hi = c1 < 64 * j + 64 ? c1 : 64 * j + 64; if (hi > lo) ps[j] += p * (float)(hi - lo) / 32.0f; } }
#pragma unroll
        for (int d = 0; d < 64; ++d) ocmp[row * 512 + head * 64 + d] = o[d];
    }
}
__global__ void k_select(const float* PS, unsigned* SEL) {
    long i = gtid(); if (i >= (long)BATCH * 2 * SEQ) return; int s = (int)(i % SEQ); const float* ps = PS + (size_t)i * 64; int cur = s / 64;
    unsigned m0 = 0, m1 = 0;
    for (int j = 0; j < NSB; ++j) {
        bool fj = (j == 0) || (j == cur) || (j == cur - 1); float sj = fj ? 1e30f : (j <= cur ? ps[j] : -1e30f);
        int rank = 0;
        for (int k = 0; k < NSB; ++k) { bool fk = (k == 0) || (k == cur) || (k == cur - 1); float sk = fk ? 1e30f : (k <= cur ? ps[k] : -1e30f); if (sk > sj || (sk == sj && k < j)) ++rank; }
        if (rank < NSEL && sj > -1e29f) { if (j < 32) m0 |= 1u << j; else m1 |= 1u << (j - 32); }
    }
    SEL[i * 2] = m0; SEL[i * 2 + 1] = m1;
}
__global__ void __launch_bounds__(64) k_attn_naive(const float* qrot, const float* krot, const bf16_t* proj, int vcol, const unsigned* SEL, int mode, float* out) {
    long i = gtid(); if (i >= (long)BATCH * 8 * SEQ) return; int s = (int)(i % SEQ), head = (int)((i / SEQ) % 8), b = (int)(i / (8 * SEQ)); int g = head / 4;
    size_t row = (size_t)b * SEQ + s; float q[64], o[64];
#pragma unroll
    for (int d = 0; d < 64; ++d) { q[d] = qrot[row * 512 + head * 64 + d]; o[d] = 0.f; }
    float m = -3.0e38f, l = 0.f;
    unsigned m0 = 0, m1 = 0; if (mode == 0) { size_t si = ((size_t)(b * 2 + g) * SEQ + s) * 2; m0 = SEL[si]; m1 = SEL[si + 1]; }
    int k0 = mode == 0 ? 0 : (s - 511 > 0 ? s - 511 : 0);
    for (int key = k0; key <= s; ++key) {
        if (mode == 0) { int j = key / 64; bool sel = j < 32 ? ((m0 >> j) & 1u) : ((m1 >> (j - 32)) & 1u); if (!sel) { key = j * 64 + 63; continue; } }
        size_t kr = (size_t)b * SEQ + key; const float* kp = krot + kr * 128 + g * 64;
        float sc = 0.f;
#pragma unroll
        for (int d = 0; d < 64; ++d) sc += q[d] * kp[d];
        sc *= 0.125f; float mn = fmaxf(m, sc), a = expf(m - mn), p = expf(sc - mn); l = l * a + p; m = mn;
#pragma unroll
        for (int d = 0; d < 64; ++d) o[d] = o[d] * a + p * PJ(kr, vcol + g * 64 + d);
    }
#pragma unroll
    for (int d = 0; d < 64; ++d) out[row * 512 + head * 64 + d] = o[d] / l;
}
__global__ void k_nsa_combine(const bf16_t* proj, const float* ocmp, const float* oslc, const float* owin, bf16_t* mix) {
    long i = gtid(); if (i >= (long)T * 512) return; size_t row = (size_t)(i / 512); int c = (int)(i % 512), head = c / 64;
    mix[row * D + 512 + c] = f2bf(sigmoidf_(PJ(row, C_NG + head * 3)) * ocmp[i] + sigmoidf_(PJ(row, C_NG + head * 3 + 1)) * oslc[i] + sigmoidf_(PJ(row, C_NG + head * 3 + 2)) * owin[i]);
}
__global__ void k_proj_res(const bf16_t* A, const float* W, const float* x, const float* mod, int chunk, float* out) {
    long i = gtid(); if (i >= (long)T * D) return; int r = (int)(i / D), n = (int)(i % D), b = r / SEQ;
    float acc = 0.f; const bf16_t* a = A + (size_t)r * D;
    for (int k = 0; k < D; ++k) acc += bf2f(a[k]) * W[(size_t)k * D + n];
    out[i] = x[i] + mod[b * 6144 + chunk * D + n] * acc;
}
__global__ void __launch_bounds__(64) k_route(const float* LG, const float* bias, int* TOPI, float* TOPW) {
    long t = gtid(); if (t >= T) return; const float* lg = LG + (size_t)t * 64;
    float gs[8];
#pragma unroll
    for (int gI = 0; gI < 8; ++gI) { float a = -3e38f, b2 = -3e38f;
        for (int e = 0; e < 8; ++e) { float ch = sigmoidf_(lg[gI * 8 + e]) + bias[gI * 8 + e]; if (ch > a) { b2 = a; a = ch; } else if (ch > b2) b2 = ch; }
        gs[gI] = a + b2; }
    unsigned gmask = 0;
#pragma unroll
    for (int gI = 0; gI < 8; ++gI) { int rank = 0;
#pragma unroll
        for (int k = 0; k < 8; ++k) if (gs[k] > gs[gI] || (gs[k] == gs[gI] && k < gI)) ++rank;
        if (rank < 4) gmask |= 1u << gI; }
    int n = 0; float wsum = 0.f;
    for (int e = 0; e < 64; ++e) { if (!((gmask >> (e / 8)) & 1u)) continue; float se = sigmoidf_(lg[e]), ce = se + bias[e]; int rank = 0;
        for (int k = 0; k < 64; ++k) { if (!((gmask >> (k / 8)) & 1u)) continue; float ck = sigmoidf_(lg[k]) + bias[k]; if (ck > ce || (ck == ce && k < e)) ++rank; }
        if (rank < 8 && n < 8) { TOPI[t * 8 + n] = e; TOPW[t * 8 + n] = se; wsum += se; ++n; } }
    for (int k = 0; k < 8; ++k) TOPW[t * 8 + k] = TOPW[t * 8 + k] / wsum * 2.5f;
}
__global__ void k_moe_act(const bf16_t* h2, const float* Wgu, const int* TOPI, float* ACT, long nA) {
    long i = gtid(); if (i >= nA * 256) return; long a = i / 256; int j = (int)(i % 256); long t = TOPI ? a / 8 : a; int e = TOPI ? TOPI[a] : 0;
    const bf16_t* hp = h2 + (size_t)t * D; const float* w = Wgu + (size_t)e * D * 512; float gq = 0.f, u = 0.f;
    for (int k = 0; k < D; ++k) { float hv = bf2f(hp[k]); gq += hv * w[(size_t)k * 512 + j]; u += hv * w[(size_t)k * 512 + 256 + j]; }
    ACT[i] = siluf_(gq) * u;
}
__global__ void k_moe_out(const float* ACT, const float* ACTS, const float* Wdn, const float* Wsd, const int* TOPI, const float* TOPW, const float* x2, const float* mod, float* x3) {
    long i = gtid(); if (i >= (long)T * D) return; long t = i / D; int n = (int)(i % D), b = (int)(t / SEQ);
    float acc = 0.f;
    for (int sl = 0; sl < 8; ++sl) { int e = TOPI[t * 8 + sl]; const float* a = ACT + (size_t)(t * 8 + sl) * 256; const float* w = Wdn + (size_t)e * 256 * D; float y = 0.f;
        for (int k = 0; k < 256; ++k) y += a[k] * w[(size_t)k * D + n];
        acc += TOPW[t * 8 + sl] * y; }
    { const float* a = ACTS + (size_t)t * 256; float y = 0.f; for (int k = 0; k < 256; ++k) y += a[k] * Wsd[(size_t)k * D + n]; acc += y; }
    x3[i] = x2[i] + mod[b * 6144 + 5 * D + n] * acc;
}
__global__ void k_final(const float* x3, const float* rstd, const float* g, float* out) {
    long i = gtid(); if (i >= (long)T * D) return; out[i] = x3[i] * rstd[i / D] * g[i % D];
}
#undef PJ

struct In { const float *x, *c, *w_ada, *b_ada, *n1g, *w_in, *lbl, *hng, *pek, *w1k, *b1k, *w2k, *pev, *w1v, *b1v, *w2v, *w_out, *n2g, *rw, *rb, *wgu, *wdn, *wsgu, *wsdn, *fg;
    void set(void* const* d) { const float** p = (const float**)this; for (int i = 0; i < 25; ++i) p[i] = (const float*)d[i]; } };
#define NBK(n, tb) (((long)(n) + (tb) - 1) / (tb))
template <class Tp> static Tp* wsp(unsigned char* ws, size_t off) { return (Tp*)(ws + off); }
static void s1_naive(const In& I, unsigned char* ws, hipStream_t stream) {
    float* mod = wsp<float>(ws, WS_MOD); float* h = wsp<float>(ws, NV_H); float* rstd = wsp<float>(ws, NV_RSTD); bf16_t* proj = wsp<bf16_t>(ws, WS_PROJ);
    LAUNCH(k_mod, NBK(BATCH * 6144, 256), 256, I.c, I.w_ada, I.b_ada, mod);
    LAUNCH(k_rowrstd, NBK(T, 256), 256, I.x, rstd, T);
    LAUNCH(k_modnorm, NBK((long)T * D, 256), 256, I.x, rstd, I.n1g, mod, 0, 1, h, (bf16_t*)nullptr);
    LAUNCH(k_gemm_nn_bf, NBK((long)T * INC, 256), 256, h, D, I.w_in, INC, proj, LDP, T, INC, D);
}
static void s2_naive(const In& I, unsigned char* ws, hipStream_t stream, bool do_hg = true, bool do_nsa = true) {
    const bf16_t* proj = wsp<bf16_t>(ws, WS_PROJ); bf16_t* mix = wsp<bf16_t>(ws, WS_MIX);
    float *F = wsp<float>(ws, NV_F), *oraw = wsp<float>(ws, NV_ORAW), *owin = wsp<float>(ws, NV_OWIN), *ksr = wsp<float>(ws, NV_KSR), *kwr = wsp<float>(ws, NV_KWR), *PS = wsp<float>(ws, NV_PS);
    float *hid = wsp<float>(ws, NV_HID), *kcmp = wsp<float>(ws, NV_KCMP), *vcmp = wsp<float>(ws, NV_VCMP), *cs = wsp<float>(ws, NV_CS), *sn = wsp<float>(ws, NV_SN), *qrot = wsp<float>(ws, NV_QROT);
    unsigned* sel = wsp<unsigned>(ws, NV_SEL); float *ocmp = F, *oslc = oraw;
    if (do_hg) {
    LAUNCH(k_hgf, NBK((long)T * 512, 256), 256, proj, I.lbl, F);
    LAUNCH(k_hgrn, NBK(BATCH * 512, 64), 64, proj, F, oraw);
    LAUNCH(k_hgnorm, NBK((long)T * 4, 256), 256, oraw, proj, I.hng, mix);
    }
    if (!do_nsa) return;
    LAUNCH(k_cmp_hidden, NBK((long)BATCH * 2 * NCMP * 256, 256), 256, proj, C_KC, I.pek, I.w1k, I.b1k, hid);
    LAUNCH(k_cmp_out, NBK((long)BATCH * 2 * NCMP * 64, 256), 256, hid, I.w2k, kcmp);
    LAUNCH(k_cmp_hidden, NBK((long)BATCH * 2 * NCMP * 256, 256), 256, proj, C_VC, I.pev, I.w1v, I.b1v, hid);
    LAUNCH(k_cmp_out, NBK((long)BATCH * 2 * NCMP * 64, 256), 256, hid, I.w2v, vcmp);
    LAUNCH(k_rope_tab, NBK(SEQ * 32, 256), 256, cs, sn);
    LAUNCH(k_rope_apply, NBK((long)T * 8 * 32, 256), 256, proj, C_NQ, 8, cs, sn, qrot);
    LAUNCH(k_rope_apply, NBK((long)T * 2 * 32, 256), 256, proj, C_KS, 2, cs, sn, ksr);
    LAUNCH(k_rope_apply, NBK((long)T * 2 * 32, 256), 256, proj, C_KW, 2, cs, sn, kwr);
    LAUNCH(k_cmp_attn, NBK((long)BATCH * 2 * SEQ, 64), 64, proj, kcmp, vcmp, ocmp, PS);
    LAUNCH(k_select, NBK((long)BATCH * 2 * SEQ, 256), 256, PS, sel);
    LAUNCH(k_attn_naive, NBK((long)BATCH * 8 * SEQ, 64), 64, qrot, ksr, proj, C_VS, sel, 0, oslc);
    LAUNCH(k_attn_naive, NBK((long)BATCH * 8 * SEQ, 64), 64, qrot, kwr, proj, C_VW, sel, 1, owin);
    LAUNCH(k_nsa_combine, NBK((long)T * 512, 256), 256, proj, ocmp, oslc, owin, mix);
}
static void s3_naive(const In& I, unsigned char* ws, hipStream_t stream) {
    LAUNCH(k_proj_res, NBK((long)T * D, 256), 256, wsp<bf16_t>(ws, WS_MIX), I.w_out, I.x, wsp<float>(ws, WS_MOD), 2, wsp<float>(ws, WS_X2));
}
static void s4_naive(const In& I, unsigned char* ws, hipStream_t stream) {
    float *x2 = wsp<float>(ws, WS_X2), *rstd = wsp<float>(ws, NV_RSTD2), *h2f = wsp<float>(ws, NV_H2F), *lg = wsp<float>(ws, NV_LG), *mod = wsp<float>(ws, WS_MOD);
    LAUNCH(k_rowrstd, NBK(T, 256), 256, x2, rstd, T);
    LAUNCH(k_modnorm, NBK((long)T * D, 256), 256, x2, rstd, I.n2g, mod, 3, 4, h2f, wsp<bf16_t>(ws, WS_H2));
    LAUNCH(k_gemm_nn, NBK((long)T * 64, 256), 256, h2f, D, I.rw, 64, lg, 64, T, 64, D);
    LAUNCH(k_route, NBK(T, 64), 64, lg, I.rb, wsp<int>(ws, WS_TOPI), wsp<float>(ws, WS_TOPW));
}
static void s5_naive(const In& I, unsigned char* ws, float* out, hipStream_t stream) {
    float *act = wsp<float>(ws, NV_ACT), *acts = wsp<float>(ws, NV_ACTS), *x3 = wsp<float>(ws, NV_X3), *rstd = wsp<float>(ws, NV_RSTD3);
    const bf16_t* h2 = wsp<bf16_t>(ws, WS_H2); const int* topi = wsp<int>(ws, WS_TOPI);
    LAUNCH(k_moe_act, NBK((long)T * 8 * 256, 256), 256, h2, I.wgu, topi, act, (long)T * 8);
    LAUNCH(k_moe_act, NBK((long)T * 256, 256), 256, h2, I.wsgu, (const int*)nullptr, acts, (long)T);
    LAUNCH(k_moe_out, NBK((long)T * D, 256), 256, act, acts, I.wdn, I.wsdn, topi, wsp<float>(ws, WS_TOPW), wsp<float>(ws, WS_X2), wsp<float>(ws, WS_MOD), x3);
    LAUNCH(k_rowrstd, NBK(T, 256), 256, x3, rstd, T);
    LAUNCH(k_final, NBK((long)T * D, 256), 256, x3, rstd, I.fg, out);
}
}
#ifndef CPU_EMU
#define GAS __attribute__((address_space(1)))
#define LAS __attribute__((address_space(3)))
typedef unsigned v4u __attribute__((ext_vector_type(4)));
typedef unsigned v2u __attribute__((ext_vector_type(2)));
typedef float f32x4 __attribute__((ext_vector_type(4)));
typedef float f32x2 __attribute__((ext_vector_type(2)));
typedef float f32x16 __attribute__((ext_vector_type(16)));
typedef short bf16x8 __attribute__((ext_vector_type(8)));
typedef short bf16x4 __attribute__((ext_vector_type(4)));
typedef GAS unsigned gu32;
#define RLX_AGENT __ATOMIC_RELAXED, __HIP_MEMORY_SCOPE_AGENT
#define LDS_WAIT() asm volatile("s_waitcnt lgkmcnt(0)" ::: "memory")
#define VM_WAIT() asm volatile("s_waitcnt vmcnt(0)" ::: "memory")
constexpr int NWAVES = 8, NTHR = 512;
__device__ __forceinline__ unsigned pk2(float lo, float hi) { return (unsigned)f2bf(lo) | ((unsigned)f2bf(hi) << 16); }
__device__ __forceinline__ unsigned cvt_pk_bf16(float lo, float hi) { unsigned r; asm volatile("v_cvt_pk_bf16_f32 %0, %1, %2" : "=v"(r) : "v"(lo), "v"(hi)); return r; }
__device__ __forceinline__ float fexp2(float x) { return __builtin_amdgcn_exp2f(fmaxf(x, -120.0f)); }
__device__ __forceinline__ float fexp(float x) { return __builtin_amdgcn_exp2f(fmaxf(x * 1.4426950408889634f, -120.0f)); }
__device__ __forceinline__ float fsigmoid(float z) { return 1.0f / (1.0f + __builtin_amdgcn_exp2f(fminf(fmaxf(-z * 1.4426950408889634f, -120.0f), 120.0f))); }
__device__ __forceinline__ float fsilu(float z) { return z / (1.0f + __builtin_amdgcn_exp2f(fminf(fmaxf(-z * 1.4426950408889634f, -120.0f), 120.0f))); }
__device__ __forceinline__ float wave_sum(float v) {
#pragma unroll
    for (int o = 1; o < 64; o <<= 1) v += __shfl_xor(v, o);
    return v;
}

#define XB_TMO      128
#define XB_XCNT(j)  (256  + 64 * (j))
#define XB_XSUB(j)  (1280 + 64 * (j))
#define XB_XGEN(j)  (2304 + 64 * (j))
#define XB_TOP      3328
#define XB_TOPGEN   3392
#define XCD_BAR_WORDS 3456
#define XB_SPIN_CAP (1u << 18)
__device__ __forceinline__ unsigned xb_ld(unsigned* p)              { return __hip_atomic_load(p, __ATOMIC_RELAXED, __HIP_MEMORY_SCOPE_AGENT); }
__device__ __forceinline__ unsigned xb_add(unsigned* p, unsigned v) { return __hip_atomic_fetch_add(p, v, __ATOMIC_RELAXED, __HIP_MEMORY_SCOPE_AGENT); }
__device__ __forceinline__ unsigned xb_xcc_id() { return (unsigned)__builtin_amdgcn_s_getreg((3 << 11) | 20) & 0xFu; }
#define XB_SPIN(cond, bar) do { unsigned _sp = 0; while (cond) { __builtin_amdgcn_s_sleep(1); \
    if ((++_sp & 255u) == 0u) { if (xb_ld(&(bar)[XB_TMO])) break; if (_sp > XB_SPIN_CAP) { atomicAdd(&(bar)[XB_TMO], 1u); break; } } } } while (0)
struct XcdBarrier { unsigned* bar; unsigned x; volatile LAS unsigned* st; };
__device__ __forceinline__ XcdBarrier xcd_barrier_post(unsigned* bar, volatile LAS unsigned* st) {
    XcdBarrier b; b.bar = bar; b.x = xb_xcc_id(); b.st = st;
    if (threadIdx.x == 0) (void)xb_add(&bar[XB_XCNT(b.x)], 1u);
    return b;
}
__device__ __forceinline__ void xcd_barrier_complete(unsigned* bar, unsigned x, unsigned& nloc, unsigned& nx) {
    const unsigned G = gridDim.x * gridDim.y * gridDim.z;
    unsigned sum, cnt, mine, sp = 0u;
    for (;;) {
        sum = 0u; cnt = 0u; mine = 0u;
#pragma unroll
        for (unsigned j = 0; j < 16; ++j) { const unsigned c = xb_ld(&bar[XB_XCNT(j)]); sum += c; cnt += (c > 0u) ? 1u : 0u; mine = (j == x) ? c : mine; }
        if (sum == G) break;
        __builtin_amdgcn_s_sleep(1);
        if ((++sp & 255u) == 0u) { if (xb_ld(&bar[XB_TMO])) break; if (sp > XB_SPIN_CAP) { atomicAdd(&bar[XB_TMO], 1u); break; } }
    }
    nloc = mine > 0u ? mine : 1u; nx = cnt > 0u ? cnt : 1u;
}
__device__ __forceinline__ void xcd_barrier(const XcdBarrier& b) {
    asm volatile("s_waitcnt vmcnt(0)" ::: "memory");
    __syncthreads();
    if (threadIdx.x == 0) {
        unsigned* bar = b.bar;
        __builtin_amdgcn_s_waitcnt(0);
        unsigned nloc = b.st[0], nx = b.st[1];
        if (nloc == 0u) { xcd_barrier_complete(bar, b.x, nloc, nx); b.st[0] = nloc; b.st[1] = nx; }
        const unsigned old = xb_add(&bar[XB_XSUB(b.x)], 1u);
        const unsigned gen = old / nloc;
        if (old + 1u == (gen + 1u) * nloc) {
            __builtin_amdgcn_fence(__ATOMIC_RELEASE, "agent");
            asm volatile("s_waitcnt vmcnt(0)" ::: "memory");
            const unsigned og = xb_add(&bar[XB_TOP], 1u);
            const unsigned tg = og / nx;
            if (og + 1u == (tg + 1u) * nx) xb_add(&bar[XB_TOPGEN], 1u);
            else XB_SPIN(xb_ld(&bar[XB_TOPGEN]) == tg, bar);
            __builtin_amdgcn_fence(__ATOMIC_ACQUIRE, "agent");
            xb_add(&bar[XB_XGEN(b.x)], 1u);
            asm volatile("s_waitcnt vmcnt(0)" ::: "memory");
        } else {
            XB_SPIN(xb_ld(&bar[XB_XGEN(b.x)]) == gen, bar);
            __builtin_amdgcn_fence(__ATOMIC_ACQUIRE, "agent");
            asm volatile("s_waitcnt vmcnt(0)" ::: "memory");
        }
    }
    __syncthreads();
}

namespace gm {
constexpr int BM = 256, BK = 64, HALF = 128, HTB = HALF * BK * 2, STAGE_BYTES = 8 * HTB, NXCD = 8, WGM = 8;
__host__ __device__ __forceinline__ int lds_byte(int r, int c) { const int st = (r >> 4) * 2 + (c >> 5), rr = r & 15, cc = c & 31, ob = rr * 64 + cc * 2; return st * 1024 + (ob ^ (((ob >> 9) & 1) << 5)); }
__host__ __device__ __forceinline__ void stage_rc(int b, int& R, int& C) { const int st = b / 1024, sb = b % 1024, swz = sb ^ (((sb >> 9) & 1) << 5); R = (st >> 1) * 16 + swz / 64; C = (st & 1) * 32 + (swz % 64) / 2; }
__host__ __device__ __forceinline__ int perm32(int rho) { const int n = rho >> 4, i = rho & 15; return 8 * (i >> 2) + 4 * n + (i & 3); }

struct Unit { int pm, pn; const char* A; const char* B; int e, m0; };

__device__ __forceinline__ bool static_tile(int nM, int nN, int G, int c, int i, int& pm, int& pn) {
    const int nwg = nM * nN; const long L = (long)i * G + c; if (L >= nwg) return false;
    int wgid = (int)L; { const int q = nwg / NXCD, r = nwg % NXCD, xcd = wgid % NXCD, off = wgid / NXCD; wgid = (xcd < r ? xcd * (q + 1) : r * (q + 1) + (xcd - r) * q) + off; }
    const int nig = WGM * nN, gid = wgid / nig, fm = gid * WGM, gsz = (nM - fm) < WGM ? (nM - fm) : WGM;
    pm = fm + ((wgid % nig) % gsz); pn = (wgid % nig) / gsz; return true;
}
struct DenseSched {
    const char* A; const char* Bt; int nM, nN, G, c; unsigned lda_b, K;
    __device__ __forceinline__ bool next(int i, Unit& u) const { int pm, pn; if (!static_tile(nM, nN, G, c, i, pm, pn)) return false; u.pm = pm; u.pn = pn; u.A = A + (size_t)pm * BM * lda_b; u.B = Bt + (size_t)pn * BM * K * 2; u.e = 0; u.m0 = 0; return true; }
    __device__ __forceinline__ unsigned arow(const Unit&, int r) const { return (unsigned)r * lda_b; }
};

template <class Epi, class Sched>
__device__ __forceinline__ void gemm_phase(LAS unsigned char* lds, const Sched& S, const Epi& E, const int K, const unsigned kstepA) {
    const int tid = threadIdx.x, wid = __builtin_amdgcn_readfirstlane(tid >> 6), lane = tid & 63, wr = wid >> 2, wc = wid & 3, fr = lane & 15, fq = lane >> 4;
    const int nt = K / BK;
    int R0, C0; stage_rc(tid * 16, R0, C0);
    unsigned voffB[2];
#pragma unroll
    for (int i = 0; i < 2; ++i) { const int R = R0 + 64 * i; const int Rb = Epi::PERM ? ((R & ~31) + perm32(R & 31)) : R; voffB[i] = (unsigned)(Rb * K + C0) * 2u; }
    const unsigned ca = (unsigned)C0 * 2u;
    const size_t kstepB = (size_t)(BK * 2);
    const size_t hstepB = (size_t)HALF * K * 2;
    const unsigned ldsw = (unsigned)wid * 1024u;
    const int aoff = lds_byte(wr * 64 + fr, fq * 8), boff = lds_byte(wc * 32 + fr, fq * 8);
#define GM_SA(b, h) (((b) * 2 + (h)) * HTB)
#define GM_SB(b, h) ((4 + (b) * 2 + (h)) * HTB)
#define GM_STAGEB(bufoff, gbase) do { _Pragma("unroll") for (int _i = 0; _i < 2; ++_i) \
        __builtin_amdgcn_global_load_lds((const unsigned*)((const char*)(gbase) + voffB[_i]), (LAS unsigned*)(lds + (bufoff) + ldsw + _i * 8192), 16, 0, 0); } while (0)
#define GM_STAGEA(bufoff, abase, offs, h, kb) do { _Pragma("unroll") for (int _i = 0; _i < 2; ++_i) \
        __builtin_amdgcn_global_load_lds((const unsigned*)((const char*)(abase) + (offs)[2 * (h) + _i] + (kb)), (LAS unsigned*)(lds + (bufoff) + ldsw + _i * 8192), 16, 0, 0); } while (0)
#define GM_LDA(dst, b, h) do { _Pragma("unroll") for (int m = 0; m < 4; ++m) _Pragma("unroll") for (int k = 0; k < 2; ++k) dst[m][k] = *(const LAS bf16x8*)(lds + GM_SA(b, h) + aoff + m * 2048 + k * 1024); } while (0)
#define GM_LDB(dst, b, h) do { _Pragma("unroll") for (int n = 0; n < 2; ++n) _Pragma("unroll") for (int k = 0; k < 2; ++k) dst[n][k] = *(const LAS bf16x8*)(lds + GM_SB(b, h) + boff + n * 2048 + k * 1024); } while (0)
#define GM_MMA(ai, bj, At, Bt) do { __builtin_amdgcn_s_setprio(1); _Pragma("unroll") for (int m = 0; m < 4; ++m) _Pragma("unroll") for (int n = 0; n < 2; ++n) _Pragma("unroll") for (int k = 0; k < 2; ++k) \
        acc[ai][bj][m][n] = __builtin_amdgcn_mfma_f32_16x16x32_bf16(Bt[n][k], At[m][k], acc[ai][bj][m][n], 0, 0, 0); __builtin_amdgcn_s_setprio(0); } while (0)
#define GM_WAIT_V(n) asm volatile("s_waitcnt vmcnt(" #n ")" ::: "memory")
#define GM_WAIT_L(n) asm volatile("s_waitcnt lgkmcnt(" #n ")" ::: "memory")
#define GM_BAR __builtin_amdgcn_s_barrier()
#define GM_SCHED __builtin_amdgcn_sched_barrier(0)
    Unit cur, nxt; int ui = 0;
    if (!S.next(0, cur)) return;
    unsigned coff[4], noff[4];
#pragma unroll
    for (int q = 0; q < 4; ++q) { coff[q] = S.arow(cur, R0 + 64 * q) + ca; noff[q] = coff[q]; }
    f32x4 acc[2][2][4][2];
#pragma unroll
    for (int a = 0; a < 2; ++a)
#pragma unroll
        for (int b = 0; b < 2; ++b)
#pragma unroll
            for (int m = 0; m < 4; ++m)
#pragma unroll
                for (int n = 0; n < 2; ++n) acc[a][b][m][n] = (f32x4){0.f, 0.f, 0.f, 0.f};
    bf16x8 At[4][2], B0[2][2], B1[2][2];
    const char* cA = cur.A; const char* cB = cur.B;
    GM_STAGEB(GM_SB(0, 0), cB); GM_STAGEB(GM_SB(0, 1), cB + hstepB); GM_STAGEA(GM_SA(0, 0), cA, coff, 0, 0u); GM_STAGEA(GM_SA(0, 1), cA, coff, 1, 0u);
    if (wr == 1) GM_BAR;
    GM_WAIT_V(2); GM_BAR;
    GM_STAGEB(GM_SB(1, 0), cB + kstepB); GM_STAGEA(GM_SA(1, 0), cA, coff, 0, kstepA); GM_STAGEB(GM_SB(1, 1), cB + hstepB + kstepB);
    GM_WAIT_V(6); GM_BAR;
    for (;;) {
        const bool has_next = S.next(ui + 1, nxt);
        const char* nA = has_next ? nxt.A : cA; const char* nB = has_next ? nxt.B : cB;
        if (has_next) {
#pragma unroll
            for (int q = 0; q < 4; ++q) noff[q] = S.arow(nxt, R0 + 64 * q) + ca;
        } else {
#pragma unroll
            for (int q = 0; q < 4; ++q) noff[q] = coff[q];
        }
#pragma unroll 1
        for (int t = 0; t < nt; t += 2) {
            const bool last = (t == nt - 2);
            const unsigned k1 = (unsigned)(t + 1) * kstepA;
            const char* a2 = last ? nA : cA; const unsigned k2 = last ? 0u : (unsigned)(t + 2) * kstepA, k3 = k2 + kstepA;
            unsigned o2[4];
#pragma unroll
            for (int q = 0; q < 4; ++q) o2[q] = last ? noff[q] : coff[q];
            const char* b2 = last ? nB : cB + (size_t)(t + 2) * kstepB; const char* b3 = b2 + kstepB;
            GM_LDB(B0, 0, 0); GM_LDB(B1, 0, 1); GM_SCHED; GM_LDA(At, 0, 0); GM_STAGEA(GM_SA(1, 1), cA, coff, 1, k1);
            GM_WAIT_V(8); GM_WAIT_L(0); GM_BAR; GM_MMA(0, 0, At, B0); GM_MMA(0, 1, At, B1); GM_BAR; GM_SCHED;
            GM_LDA(At, 0, 1); GM_STAGEB(GM_SB(0, 0), b2); GM_STAGEB(GM_SB(0, 1), b2 + hstepB); GM_STAGEA(GM_SA(0, 0), a2, o2, 0, k2);
            GM_WAIT_V(8); GM_WAIT_L(0); GM_BAR; GM_MMA(1, 0, At, B0); GM_MMA(1, 1, At, B1); GM_BAR; GM_SCHED;
            GM_LDB(B0, 1, 0); GM_LDB(B1, 1, 1); GM_SCHED; GM_LDA(At, 1, 0); GM_STAGEA(GM_SA(0, 1), a2, o2, 1, k2);
            GM_WAIT_V(8); GM_WAIT_L(0); GM_BAR; GM_MMA(0, 0, At, B0); GM_MMA(0, 1, At, B1); GM_BAR; GM_SCHED;
            GM_LDA(At, 1, 1); GM_STAGEB(GM_SB(1, 0), b3); GM_STAGEB(GM_SB(1, 1), b3 + hstepB); GM_STAGEA(GM_SA(1, 0), a2, o2, 0, k3);
            GM_WAIT_V(8); GM_WAIT_L(0); GM_BAR; GM_MMA(1, 0, At, B0); GM_MMA(1, 1, At, B1); GM_BAR; GM_SCHED;
        }
        if (wr == 0) GM_BAR;
        E(acc, cur, wr, wc, fr, fq);
        if (!has_next) break;
#pragma unroll
        for (int a = 0; a < 2; ++a)
#pragma unroll
            for (int b = 0; b < 2; ++b)
#pragma unroll
                for (int m = 0; m < 4; ++m)
#pragma unroll
                    for (int n = 0; n < 2; ++n) acc[a][b][m][n] = (f32x4){0.f, 0.f, 0.f, 0.f};
        cur = nxt; cA = nA; cB = nB; ++ui;
#pragma unroll
        for (int q = 0; q < 4; ++q) coff[q] = noff[q];
        if (wr == 1) GM_BAR;
    }
    GM_WAIT_V(0);
    GM_BAR;
#undef GM_SA
#undef GM_SB
#undef GM_STAGEA
#undef GM_STAGEB
#undef GM_LDA
#undef GM_LDB
#undef GM_MMA
#undef GM_WAIT_V
#undef GM_WAIT_L
#undef GM_BAR
#undef GM_SCHED
}

struct EpiBf16 {
    static constexpr bool PERM = true;
    bf16_t* O; int ldc;
    __device__ __forceinline__ void operator()(const f32x4 (&acc)[2][2][4][2], const Unit& u, int wr, int wc, int fr, int fq) const {
        const int row0 = u.pm * BM + wr * 64 + fr, col0 = u.pn * BM + wc * 32 + 8 * fq;
#pragma unroll
        for (int ai = 0; ai < 2; ++ai)
#pragma unroll
            for (int m = 0; m < 4; ++m) { bf16_t* rowp = O + (size_t)(row0 + ai * HALF + m * 16) * ldc + col0;
#pragma unroll
                for (int bj = 0; bj < 2; ++bj) { const f32x4 v0 = acc[ai][bj][m][0], v1 = acc[ai][bj][m][1];
                    v4u w; w.x = cvt_pk_bf16(v0[0], v0[1]); w.y = cvt_pk_bf16(v0[2], v0[3]); w.z = cvt_pk_bf16(v1[0], v1[1]); w.w = cvt_pk_bf16(v1[2], v1[3]);
                    *(v4u*)(rowp + bj * HALF) = w; } }
    }
};
struct EpiRes {
    static constexpr bool PERM = false;
    const float* x; const float* mod; int chunk; float* out;
    __device__ __forceinline__ void operator()(const f32x4 (&acc)[2][2][4][2], const Unit& u, int wr, int wc, int fr, int fq) const {
        const int row0 = u.pm * BM + wr * 64 + fr, col0 = u.pn * BM + wc * 32 + 4 * fq; const int b = (u.pm * BM) / SEQ;
        f32x4 gv[2][2];
#pragma unroll
        for (int bj = 0; bj < 2; ++bj)
#pragma unroll
            for (int n = 0; n < 2; ++n) gv[bj][n] = *(const f32x4*)(mod + (size_t)b * 6144 + chunk * 1024 + col0 + bj * HALF + n * 16);
#pragma unroll
        for (int ai = 0; ai < 2; ++ai)
#pragma unroll
            for (int m = 0; m < 4; ++m) { const size_t off = (size_t)(row0 + ai * HALF + m * 16) * 1024 + col0;
#pragma unroll
                for (int bj = 0; bj < 2; ++bj)
#pragma unroll
                    for (int n = 0; n < 2; ++n) { const f32x4 xv = *(const f32x4*)(x + off + bj * HALF + n * 16); *(f32x4*)(out + off + bj * HALF + n * 16) = xv + gv[bj][n] * acc[ai][bj][m][n]; } }
    }
};
}
#ifndef PROBE_REP
#define PROBE_REP -1
#endif
constexpr int RING_BYTES = 131072, LDSCTL_OFF = RING_BYTES, MISC_OFF = LDSCTL_OFF + 320, LDS_BYTES = 147456;
constexpr int CW_BAR = 4096;
constexpr int CW_ECNT = 65536;

struct Args { const float* in[25]; float* out; unsigned char* ws; int ph_lo, ph_hi, rep, pad; };
struct Frame {
    LAS unsigned char* lds; volatile LAS unsigned* MISC; unsigned* ctl; unsigned char* ws;
    int tid, lane, wave, vcu, G;
    const float* in[25]; float* out;
};
#define IN_X 0
#define IN_C 1
#define IN_WADA 2
#define IN_BADA 3
#define IN_N1G 4
#define IN_WIN 5
#define IN_LBL 6
#define IN_HNG 7
#define IN_PEK 8
#define IN_W1K 9
#define IN_B1K 10
#define IN_W2K 11
#define IN_PEV 12
#define IN_W1V 13
#define IN_B1V 14
#define IN_W2V 15
#define IN_WOUT 16
#define IN_N2G 17
#define IN_RW 18
#define IN_RB 19
#define IN_WGU 20
#define IN_WDN 21
#define IN_WSGU 22
#define IN_WSDN 23
#define IN_FG 24

template <bool FRAG = false> __device__ __forceinline__ void p0_transpose_item(const float* W, int K, int N, bf16_t* WT, int drow0, int k0, int n0, LAS float* scr, int lane) {
    const int kq = lane >> 3, nq = lane & 7; const int nn = n0 + 4 * nq; const bool ok = nn < N;
    f32x4 v[8];
#pragma unroll
    for (int i = 0; i < 8; ++i) v[i] = ok ? *(const f32x4*)(W + (size_t)(k0 + 8 * i + kq) * N + nn) : (f32x4){0.f, 0.f, 0.f, 0.f};
#pragma unroll
    for (int i = 0; i < 8; ++i) { LAS float* d = scr + (8 * i + kq) * 33 + 4 * nq; d[0] = v[i][0]; d[1] = v[i][1]; d[2] = v[i][2]; d[3] = v[i][3]; }
    LDS_WAIT(); asm volatile("" ::: "memory");
    const int c = lane & 7;
#pragma unroll
    for (int j = 0; j < 4; ++j) { const int n = (lane >> 3) + 8 * j; const LAS float* s = scr + (8 * c) * 33 + n;
        v4u o; o.x = pk2(s[0 * 33], s[1 * 33]); o.y = pk2(s[2 * 33], s[3 * 33]); o.z = pk2(s[4 * 33], s[5 * 33]); o.w = pk2(s[6 * 33], s[7 * 33]);
        if (FRAG) { const int kk = k0 + 8 * c, col = drow0 + n; *(v4u*)(WT + ((size_t)((kk >> 5) * (N / 16) + (col >> 4)) * 64 + ((kk & 31) >> 3) * 16 + (col & 15)) * 8) = o; }
        else *(v4u*)(WT + (size_t)(drow0 + n) * K + k0 + 8 * c) = o; }
    LDS_WAIT(); asm volatile("" ::: "memory");
}
__device__ __forceinline__ int gu_row(int n) { const int j = n & 255; return (j >> 7) * 256 + ((n >> 8) << 7) + (j & 127); }

__device__ __forceinline__ void p0_prologue(Frame& F) {
    unsigned char* ws = F.ws;
    if (F.vcu < 256) {
        LAS float* ca = (LAS float*)F.lds;
        const int ks = F.vcu >> 4, cg = F.vcu & 15;
        if (F.tid < 256) { const int b = F.tid >> 6, k = F.tid & 63; ca[F.tid] = fsilu(F.in[IN_C][b * D + ks * 64 + k]); }
        __syncthreads();
        if (F.tid < 384) { const int n = cg * 384 + F.tid; const float* w = F.in[IN_WADA] + (size_t)(ks * 64) * 6144 + n; float a0 = 0.f, a1 = 0.f, a2 = 0.f, a3 = 0.f;
#pragma unroll 8
            for (int k = 0; k < 64; ++k) { const float wv = w[(size_t)k * 6144]; a0 += ca[k] * wv; a1 += ca[64 + k] * wv; a2 += ca[128 + k] * wv; a3 += ca[192 + k] * wv; }
            float* mp = (float*)(ws + WS_MODP) + (size_t)ks * 4 * 6144 + n; mp[0] = a0; mp[6144] = a1; mp[2 * 6144] = a2; mp[3 * 6144] = a3; }
        __syncthreads();
    }
    { float* cs = (float*)(ws + WS_CS); float* sn = (float*)(ws + WS_SN);
      for (int i = F.vcu * NTHR + F.tid; i < SEQ * 32; i += F.G * NTHR) { const int pos = i >> 5, k = i & 31; const float inv = powf(10000.0f, -(float)k / 32.0f); const float ang = (float)pos * inv; cs[i] = cosf(ang); sn[i] = sinf(ang); } }
    LAS float* scr = (LAS float*)(F.lds + 4096 + F.wave * 8704);
    const int gw = F.vcu * NWAVES + F.wave, NGW = F.G * NWAVES;
    constexpr int I_IN = 16 * 105, I_OUT = 16 * 32, I_GU = 16 * 16, I_DN = 4 * 32, I_W1 = 32 * 8;
    constexpr int NIT = I_IN + I_OUT + 64 * I_GU + 64 * I_DN + I_GU + I_DN + 2 * I_W1;
    for (int it = gw; it < NIT; it += NGW) {
        int r = it;
        if (r < I_IN) { const int kb = r / 105, nb = r % 105; p0_transpose_item(F.in[IN_WIN], 1024, INC, (bf16_t*)(ws + WS_WINT), 32 * nb, 64 * kb, 32 * nb, scr, F.lane); continue; } r -= I_IN;
        if (r < I_OUT) { const int kb = r / 32, nb = r % 32; p0_transpose_item(F.in[IN_WOUT], 1024, 1024, (bf16_t*)(ws + WS_WOUTT), 32 * nb, 64 * kb, 32 * nb, scr, F.lane); continue; } r -= I_OUT;
        if (r < 64 * I_GU) { const int e = r / I_GU, q = r % I_GU, kb = q / 16, nb = q % 16;
            p0_transpose_item(F.in[IN_WGU] + (size_t)e * 1024 * 512, 1024, 512, (bf16_t*)(ws + WS_WGUT) + (size_t)e * 512 * 1024, gu_row(32 * nb), 64 * kb, 32 * nb, scr, F.lane); continue; } r -= 64 * I_GU;
        if (r < 64 * I_DN) { const int e = r / I_DN, q = r % I_DN, kb = q / 32, nb = q % 32;
            p0_transpose_item(F.in[IN_WDN] + (size_t)e * 256 * 1024, 256, 1024, (bf16_t*)(ws + WS_WDNT) + (size_t)e * 1024 * 256, 32 * nb, 64 * kb, 32 * nb, scr, F.lane); continue; } r -= 64 * I_DN;
        if (r < I_GU) { const int kb = r / 16, nb = r % 16; p0_transpose_item(F.in[IN_WSGU], 1024, 512, (bf16_t*)(ws + WS_WSGUT), gu_row(32 * nb), 64 * kb, 32 * nb, scr, F.lane); continue; } r -= I_GU;
        if (r < I_DN) { const int kb = r / 32, nb = r % 32; p0_transpose_item(F.in[IN_WSDN], 256, 1024, (bf16_t*)(ws + WS_WSDNT), 32 * nb, 64 * kb, 32 * nb, scr, F.lane); continue; } r -= I_DN;
        { const int kv = r / I_W1, q = r % I_W1, kb = q / 8, nb = q % 8;
          p0_transpose_item<true>(F.in[kv ? IN_W1V : IN_W1K], 2048, 256, (bf16_t*)(ws + (kv ? WS_W1VT : WS_W1KT)), 32 * nb, 64 * kb, 32 * nb, scr, F.lane); }
    }
    { v4u* z = (v4u*)((bf16_t*)(ws + WS_WINT) + (size_t)3360 * 1024); const int n16 = 224 * 1024 * 2 / 16;
      for (int i = F.vcu * NTHR + F.tid; i < n16; i += F.G * NTHR) z[i] = (v4u){0u, 0u, 0u, 0u}; }
    { bf16_t* w2f = (bf16_t*)(ws + WS_W2T);
      for (int i = F.vcu * NTHR + F.tid; i < 2 * 256 * 64; i += F.G * NTHR) { const int kv = i >> 14, r = i & 16383, k = r >> 6, dd = r & 63; const float v = F.in[kv ? IN_W2V : IN_W2K][r];
          w2f[(size_t)kv * 16384 + ((size_t)((k >> 5) * 4 + (dd >> 4)) * 64 + ((k & 31) >> 3) * 16 + (dd & 15)) * 8 + (k & 7)] = f2bf(v); } }
    { bf16_t* hi = (bf16_t*)(ws + WS_RW); bf16_t* lo = hi + 64 * 1024; const float* rw = F.in[IN_RW];
      for (int i = F.vcu * NTHR + F.tid; i < 64 * 1024; i += F.G * NTHR) { const int k = i >> 6, e = i & 63; const float w = rw[i]; const bf16_t h = f2bf(w);
          const size_t o = ((size_t)((k >> 5) * 4 + (e >> 4)) * 64 + ((k & 31) >> 3) * 16 + (e & 15)) * 8 + (k & 7); hi[o] = h; lo[o] = f2bf(w - bf2f(h)); } }
}

__device__ __forceinline__ void p1a_norm(Frame& F) {
    unsigned char* ws = F.ws; const float* modp = (const float*)(ws + WS_MODP); const float* bada = F.in[IN_BADA];
    for (int i = F.vcu * NTHR + F.tid; i < BATCH * 6144; i += F.G * NTHR) { float a = bada[i % 6144];
#pragma unroll
        for (int ks = 0; ks < 16; ++ks) a += modp[(size_t)ks * 4 * 6144 + i];
        ((float*)(ws + WS_MOD))[i] = a; }
    for (int o = F.vcu * NWAVES + F.wave; o < 512; o += F.G * NWAVES) { const int kv = o >> 8, j = o & 255; const float* pe = F.in[kv ? IN_PEV : IN_PEK];
        const bf16_t* wf = (const bf16_t*)(ws + (kv ? WS_W1VT : WS_W1KT)); float a = 0.f;
#pragma unroll
        for (int i = 0; i < 4; ++i) { const int cid = F.lane + 64 * i, s = cid >> 2, q = cid & 3; const v4u wv = *(const v4u*)(wf + ((size_t)(s * 16 + (j >> 4)) * 64 + q * 16 + (j & 15)) * 8);
            const f32x4 p0 = *(const f32x4*)(pe + 32 * s + 8 * q), p1 = *(const f32x4*)(pe + 32 * s + 8 * q + 4);
            a += bf2f((bf16_t)(wv.x & 0xffff)) * p0[0] + bf2f((bf16_t)(wv.x >> 16)) * p0[1] + bf2f((bf16_t)(wv.y & 0xffff)) * p0[2] + bf2f((bf16_t)(wv.y >> 16)) * p0[3]
               + bf2f((bf16_t)(wv.z & 0xffff)) * p1[0] + bf2f((bf16_t)(wv.z >> 16)) * p1[1] + bf2f((bf16_t)(wv.w & 0xffff)) * p1[2] + bf2f((bf16_t)(wv.w >> 16)) * p1[3]; }
        a = wave_sum(a); if (F.lane == 0) ((float*)(ws + WS_B1F))[o] = a + F.in[kv ? IN_B1V : IN_B1K][j]; }
    LAS float* sh = (LAS float*)F.lds; LAS float* sc = sh + 1024;
    const float* g1 = F.in[IN_N1G]; const float* x = F.in[IN_X]; bf16_t* xn = (bf16_t*)(ws + WS_XN);
    for (int chunk = F.vcu; chunk < T / 64; chunk += F.G) {
        const int b = (chunk * 64) / SEQ;
        __syncthreads();
        for (int i = F.tid; i < 2048; i += NTHR) { const int col = i; float a = bada[col];
#pragma unroll
            for (int ks = 0; ks < 16; ++ks) a += modp[(size_t)(ks * 4 + b) * 6144 + col];
            sh[i] = a; }
        __syncthreads();
#pragma unroll 1
        for (int rr = 0; rr < 8; ++rr) {
            const int row = chunk * 64 + F.wave * 8 + rr; const f32x4* xr = (const f32x4*)(x + (size_t)row * D) + F.lane;
            f32x4 v[4]; float s = 0.f;
#pragma unroll
            for (int j = 0; j < 4; ++j) { v[j] = xr[64 * j]; s += (v[j].x * v[j].x + v[j].y * v[j].y) + (v[j].z * v[j].z + v[j].w * v[j].w); }
            const float rstd = 1.0f / sqrtf(wave_sum(s) * (1.0f / D) + EPS);
            unsigned long long* o8 = (unsigned long long*)(xn + (size_t)row * D) + F.lane;
#pragma unroll
            for (int j = 0; j < 4; ++j) { const int c0 = 4 * F.lane + 256 * j; const f32x4 g = *(const f32x4*)(g1 + c0);
                const float h0 = v[j].x * rstd * g.x * (1.0f + sc[c0]) + sh[c0], h1 = v[j].y * rstd * g.y * (1.0f + sc[c0 + 1]) + sh[c0 + 1];
                const float h2 = v[j].z * rstd * g.z * (1.0f + sc[c0 + 2]) + sh[c0 + 2], h3 = v[j].w * rstd * g.w * (1.0f + sc[c0 + 3]) + sh[c0 + 3];
                o8[64 * j] = (unsigned long long)pk2(h0, h1) | ((unsigned long long)pk2(h2, h3) << 32); }
        }
    }
    __syncthreads();
}


__device__ __forceinline__ float hg_lb(const float* lbl, int j) { return 1.0f / (1.0f + expf(lbl[512 + j] - lbl[j])); }
__device__ __forceinline__ void hg_passA(Frame& F, int unit) {
    unsigned char* ws = F.ws; const bf16_t* proj = (const bf16_t*)(ws + WS_PROJ); float* U = (float*)(ws + WS_U) + (size_t)unit * 16384; float* Dd = (float*)(ws + WS_DD) + (size_t)unit * 128;
    const int b = unit >> 6, h = (unit >> 4) & 3, J = unit & 15; const size_t tok0 = (size_t)b * SEQ + 256 * J;
    const int d = F.tid & 127, g = F.tid >> 7;
    LAS unsigned char* KT = F.lds; LAS unsigned char* VT = F.lds + 65536; LAS float* segtot = (LAS float*)(F.lds + LDSCTL_OFF + 512);
    const float lb = hg_lb(F.in[IN_LBL], h * 128 + d);
    const bf16_t* pf = proj + (tok0 + 64 * g) * LDP + C_HF + h * 128 + d; const bf16_t* pv = proj + (tok0 + 64 * g) * LDP + C_HI + h * 128 + d;
    __syncthreads();
    float fs[64]; unsigned short vraw[64];
#pragma unroll
    for (int s = 0; s < 64; ++s) { fs[s] = bf2f(pf[(size_t)s * LDP]); vraw[s] = pv[(size_t)s * LDP]; }
    float sum = 0.f;
#pragma unroll
    for (int s = 0; s < 64; ++s) { const float f = lb + (1.0f - lb) * fsigmoid(fs[s]); fs[s] = f; sum += __logf(f); }
    segtot[g * 128 + d] = sum;
    __syncthreads();
    float off = 0.f, Bt = 0.f;
#pragma unroll
    for (int k = 0; k < 4; ++k) { const float v = segtot[k * 128 + d]; Bt += v; if (k < g) off += v; }
    float run = off;
#pragma unroll
    for (int s8 = 0; s8 < 8; ++s8) { unsigned kk[4], vv[4];
#pragma unroll
        for (int i = 0; i < 4; ++i) { float kt[2];
#pragma unroll
            for (int j = 0; j < 2; ++j) { const int s = 8 * s8 + 2 * i + j; const float f = fs[s]; run += __logf(f); kt[j] = (1.0f - f) * fexp(Bt - run); }
            kk[i] = pk2(kt[0], kt[1]); vv[i] = (unsigned)vraw[8 * s8 + 2 * i] | ((unsigned)vraw[8 * s8 + 2 * i + 1] << 16); }
        const int c = (8 * g + s8) ^ (d & 31);
        *(LAS v4u*)(KT + d * 512 + c * 16) = (v4u){kk[0], kk[1], kk[2], kk[3]}; *(LAS v4u*)(VT + d * 512 + c * 16) = (v4u){vv[0], vv[1], vv[2], vv[3]}; }
    if (g == 0) Dd[d] = fexp(Bt);
    __syncthreads();
    const int dt = F.wave >> 1, et0 = 2 * (F.wave & 1), i = F.lane & 31, hh = F.lane >> 5;
    f32x16 acc[2];
#pragma unroll
    for (int k = 0; k < 16; ++k) { acc[0][k] = 0.f; acc[1][k] = 0.f; }
#pragma unroll 4
    for (int st = 0; st < 16; ++st) { const int ch = 2 * st + hh;
        const bf16x8 a = *(const LAS bf16x8*)(KT + (32 * dt + i) * 512 + ((ch ^ i) & 31) * 16);
#pragma unroll
        for (int t = 0; t < 2; ++t) { const bf16x8 bv = *(const LAS bf16x8*)(VT + (32 * (et0 + t) + i) * 512 + ((ch ^ i) & 31) * 16);
            acc[t] = __builtin_amdgcn_mfma_f32_32x32x16_bf16(a, bv, acc[t], 0, 0, 0); } }
#pragma unroll
    for (int t = 0; t < 2; ++t)
#pragma unroll
        for (int gq = 0; gq < 4; ++gq) { const int dd = 32 * dt + 8 * gq + 4 * hh, e = 32 * (et0 + t) + i;
            *(f32x4*)(U + ((size_t)((e >> 4) * 8 + (dd >> 4)) * 64 + ((dd & 15) >> 2) * 16 + (e & 15)) * 4) = (f32x4){acc[t][4 * gq], acc[t][4 * gq + 1], acc[t][4 * gq + 2], acc[t][4 * gq + 3]}; }
    __syncthreads();
}
__device__ __forceinline__ void hg_passC(Frame& F, int unit) {
    unsigned char* ws = F.ws; const bf16_t* proj = (const bf16_t*)(ws + WS_PROJ); bf16_t* mix = (bf16_t*)(ws + WS_MIX);
    const float* Uall = (const float*)(ws + WS_U); const float* Dall = (const float*)(ws + WS_DD);
    const int b = unit >> 6, h = (unit >> 4) & 3, J = unit & 15; const size_t tok0 = (size_t)b * SEQ + 256 * J;
    const int w = F.wave, n = F.lane & 15, q = F.lane >> 4;
    LAS bf16_t* Qs = (LAS bf16_t*)F.lds; LAS bf16_t* Kh = Qs + 16 * 136; LAS bf16_t* Kt = Kh + 16 * 136; LAS bf16_t* Vt = Kt + 128 * 24;
    LAS float* G = (LAS float*)(Vt + 128 * 24); LAS float* TQ = G + 128; LAS float* SSP = TQ + 512;
    f32x4 S[8];
#pragma unroll
    for (int dt = 0; dt < 8; ++dt) S[dt] = (f32x4){0.f, 0.f, 0.f, 0.f};
    {
        LAS float* WJ = (LAS float*)F.lds;
        __syncthreads();
        if (F.tid < 128) { float wgt = 1.0f; for (int j = J - 1; j >= 0; --j) { WJ[j * 128 + F.tid] = wgt; wgt *= Dall[(size_t)(unit - J + j) * 128 + F.tid]; } }
        __syncthreads();
#pragma unroll 4
        for (int j = 0; j < J; ++j) { const float* Uj = Uall + (size_t)(unit - J + j) * 16384;
#pragma unroll
            for (int dt = 0; dt < 8; ++dt) { const f32x4 wv = *(const LAS f32x4*)(WJ + j * 128 + 16 * dt + 4 * q); const f32x4 uv = *(const f32x4*)(Uj + ((size_t)(w * 8 + dt) * 64 + F.lane) * 4);
                S[dt] = S[dt] + wv * uv; } }
        __syncthreads();
    }
    const int d = F.tid & 127, tq = F.tid >> 7; const float lb = hg_lb(F.in[IN_LBL], h * 128 + d);
    const float ngv0 = 0.f; (void)ngv0;
    unsigned short rf[4], rq[4], rv[4]; v2u rgate;
    const int e0 = h * 128 + 16 * w + 4 * q;
#pragma unroll
    for (int i = 0; i < 4; ++i) { const bf16_t* pr = proj + (tok0 + 4 * tq + i) * LDP + h * 128 + d; rf[i] = pr[C_HF]; rq[i] = pr[C_HQ]; rv[i] = pr[C_HI]; }
    rgate = *(const v2u*)(proj + (tok0 + n) * LDP + C_HGT + e0);
#pragma unroll 1
    for (int blk = 0; blk < 16; ++blk) {
        const size_t t0 = tok0 + 16 * blk;
        float fv[4], lf[4], qv[4]; unsigned short vb[4]; float tot = 0.f;
#pragma unroll
        for (int i = 0; i < 4; ++i) { const float f = lb + (1.0f - lb) * fsigmoid(bf2f(rf[i])); fv[i] = f; tot += __logf(f); lf[i] = tot; qv[i] = bf2f(rq[i]) * 0.08838834764831845f; vb[i] = rv[i]; }
        const v2u gt = rgate;
        if (blk < 15) {
#pragma unroll
            for (int i = 0; i < 4; ++i) { const bf16_t* pr = proj + (t0 + 16 + 4 * tq + i) * LDP + h * 128 + d; rf[i] = pr[C_HF]; rq[i] = pr[C_HQ]; rv[i] = pr[C_HI]; }
            rgate = *(const v2u*)(proj + (t0 + 16 + n) * LDP + C_HGT + e0); }
        TQ[tq * 128 + d] = tot;
        __syncthreads();
        float off = 0.f, cc = 0.f;
#pragma unroll
        for (int k = 0; k < 4; ++k) { const float v = TQ[k * 128 + d]; cc += v; if (k < tq) off += v; }
        { unsigned kt2[2], v2[2];
#pragma unroll
          for (int i = 0; i < 4; ++i) { const float bt = off + lf[i]; const int t = 4 * tq + i; const float kf = 1.0f - fv[i];
              Qs[t * 136 + d] = f2bf(qv[i] * fexp(bt)); Kh[t * 136 + d] = f2bf(kf * fexp(-bt));
              const unsigned short kb = f2bf(kf * fexp(cc - bt));
              if (i & 1) { kt2[i >> 1] |= (unsigned)kb << 16; v2[i >> 1] |= (unsigned)vb[i] << 16; } else { kt2[i >> 1] = kb; v2[i >> 1] = vb[i]; } }
          *(LAS v2u*)(Kt + d * 24 + 4 * tq) = (v2u){kt2[0], kt2[1]}; *(LAS v2u*)(Vt + d * 24 + 4 * tq) = (v2u){v2[0], v2[1]}; }
        if (tq == 0) G[d] = fexp(cc);
        __syncthreads();
        f32x4 pt = (f32x4){0.f, 0.f, 0.f, 0.f};
#pragma unroll
        for (int st = 0; st < 4; ++st) { const bf16x8 a = *(const LAS bf16x8*)(Kh + n * 136 + 32 * st + 8 * q), bq = *(const LAS bf16x8*)(Qs + n * 136 + 32 * st + 8 * q);
            pt = __builtin_amdgcn_mfma_f32_16x16x32_bf16(a, bq, pt, 0, 0, 0); }
        bf16x8 pB;
#pragma unroll
        for (int r = 0; r < 4; ++r) { pB[r] = (short)f2bf((4 * q + r) <= n ? pt[r] : 0.f); pB[4 + r] = 0; }
        f32x4 o = (f32x4){0.f, 0.f, 0.f, 0.f};
#pragma unroll
        for (int st = 0; st < 4; ++st) { bf16x8 a, bq;
            const v2u s0 = (v2u){cvt_pk_bf16(S[2 * st][0], S[2 * st][1]), cvt_pk_bf16(S[2 * st][2], S[2 * st][3])}, s1 = (v2u){cvt_pk_bf16(S[2 * st + 1][0], S[2 * st + 1][1]), cvt_pk_bf16(S[2 * st + 1][2], S[2 * st + 1][3])};
            a = __builtin_bit_cast(bf16x8, (v4u){s0.x, s0.y, s1.x, s1.y});
            const v2u q0 = *(const LAS v2u*)(Qs + n * 136 + 32 * st + 4 * q), q1 = *(const LAS v2u*)(Qs + n * 136 + 32 * st + 16 + 4 * q);
            bq = __builtin_bit_cast(bf16x8, (v4u){q0.x, q0.y, q1.x, q1.y});
            o = __builtin_amdgcn_mfma_f32_16x16x32_bf16(a, bq, o, 0, 0, 0); }
        { const v2u va = *(const LAS v2u*)(Vt + (16 * w + n) * 24 + 4 * q); const bf16x8 a = __builtin_bit_cast(bf16x8, (v4u){va.x, va.y, 0u, 0u});
          o = __builtin_amdgcn_mfma_f32_16x16x32_bf16(a, pB, o, 0, 0, 0); }
        { bf16x8 bv; if (q < 2) bv = *(const LAS bf16x8*)(Vt + (16 * w + n) * 24 + 8 * q); else bv = (bf16x8){0, 0, 0, 0, 0, 0, 0, 0};
#pragma unroll
          for (int dt = 0; dt < 8; ++dt) { const f32x4 gv = *(const LAS f32x4*)(G + 16 * dt + 4 * q); S[dt] = S[dt] * gv;
              bf16x8 a; if (q < 2) a = *(const LAS bf16x8*)(Kt + (16 * dt + n) * 24 + 8 * q); else a = (bf16x8){0, 0, 0, 0, 0, 0, 0, 0};
              S[dt] = __builtin_amdgcn_mfma_f32_16x16x32_bf16(a, bv, S[dt], 0, 0, 0); } }
        float ss = (o[0] * o[0] + o[1] * o[1]) + (o[2] * o[2] + o[3] * o[3]); ss += __shfl_xor(ss, 16); ss += __shfl_xor(ss, 32);
        if (q == 0) SSP[w * 16 + n] = ss;
        __syncthreads();
        float tots = 0.f;
#pragma unroll
        for (int k = 0; k < 8; ++k) tots += SSP[k * 16 + n];
        const float rstd = 1.0f / sqrtf(tots * (1.0f / 128.0f) + EPS);
        const f32x4 ng = *(const f32x4*)(F.in[IN_HNG] + e0);
        const float g0 = bf2f((bf16_t)(gt.x & 0xffff)), g1 = bf2f((bf16_t)(gt.x >> 16)), g2 = bf2f((bf16_t)(gt.y & 0xffff)), g3 = bf2f((bf16_t)(gt.y >> 16));
        v2u ov; ov.x = cvt_pk_bf16(o[0] * rstd * ng[0] * fsilu(g0), o[1] * rstd * ng[1] * fsilu(g1)); ov.y = cvt_pk_bf16(o[2] * rstd * ng[2] * fsilu(g2), o[3] * rstd * ng[3] * fsilu(g3));
        *(v2u*)(mix + (t0 + n) * D + e0) = ov;
    }
    __syncthreads();
}

constexpr int LG_P = 65;
__device__ __forceinline__ void p5_router(Frame& F) {
    unsigned char* ws = F.ws; const float* x2 = (const float*)(ws + WS_X2); const float* mod = (const float*)(ws + WS_MOD); const float* g2 = F.in[IN_N2G];
    const bf16_t* rwh = (const bf16_t*)(ws + WS_RW); const bf16_t* rwl = rwh + 64 * 1024; bf16_t* H2 = (bf16_t*)(ws + WS_H2);
    int* TOPI = (int*)(ws + WS_TOPI); float* TOPW = (float*)(ws + WS_TOPW); int* ROWL = (int*)(ws + WS_ROWL); int* ERANK = (int*)(ws + WS_ERANK); unsigned* ECNT = F.ctl + CW_ECNT;
    LAS float* LG = (LAS float*)F.lds;
    LAS float* GS = LG + 64 * LG_P;
    LAS float* WSL = GS + 512;
    LAS int* EI = (LAS int*)(WSL + 512);
    LAS unsigned* LCNT = (LAS unsigned*)(EI + 512);
    LAS unsigned* LBASE = LCNT + 64;
    LAS float* GSL = (LAS float*)(LBASE + 64);
    LAS float* SHL = GSL + 1024;
    const int r = F.lane & 15, q = F.lane >> 4, rt = F.wave & 3, eh = F.wave >> 2;
    for (int unit = F.vcu; unit < T / 64; unit += F.G) {
        const int row0 = unit * 64, b = row0 / SEQ, row = row0 + 16 * rt + r;
        __syncthreads();
        if (F.tid < 64) LCNT[F.tid] = 0u;
        for (int k = F.tid; k < 1024; k += NTHR) { GSL[k] = g2[k] * (1.0f + mod[(size_t)b * 6144 + 4 * 1024 + k]); SHL[k] = mod[(size_t)b * 6144 + 3 * 1024 + k]; }
        const float* xr = x2 + (size_t)row * D + 8 * q;
        float ss = 0.f;
#pragma unroll 8
        for (int s = 0; s < 32; ++s) { const f32x4 a = *(const f32x4*)(xr + 32 * s), c = *(const f32x4*)(xr + 32 * s + 4); ss += (a.x * a.x + a.y * a.y) + (a.z * a.z + a.w * a.w) + (c.x * c.x + c.y * c.y) + (c.z * c.z + c.w * c.w); }
        ss += __shfl_xor(ss, 16); ss += __shfl_xor(ss, 32);
        const float rstd = 1.0f / sqrtf(ss * (1.0f / D) + EPS);
        __syncthreads();
#ifndef PROBE_R7
#define PROBE_R7 0
#endif
        f32x4 acc[2];
        for (int rep7_ = 0; rep7_ <= PROBE_R7; ++rep7_) {
        acc[0] = (f32x4){0.f, 0.f, 0.f, 0.f}; acc[1] = acc[0];
        const bf16_t* rwh0 = rwh + ((size_t)(2 * eh) * 64 + F.lane) * 8; const bf16_t* rwl0 = rwl + ((size_t)(2 * eh) * 64 + F.lane) * 8;
#pragma unroll 1
        for (int s4 = 0; s4 < 32; s4 += 4) {
            f32x4 xa[4][2]; bf16x8 bh[4][2], bl[4][2];
#pragma unroll
            for (int u = 0; u < 4; ++u) { const int s = s4 + u; xa[u][0] = *(const f32x4*)(xr + 32 * s); xa[u][1] = *(const f32x4*)(xr + 32 * s + 4);
                bh[u][0] = *(const bf16x8*)(rwh0 + (size_t)s * 2048); bl[u][0] = *(const bf16x8*)(rwl0 + (size_t)s * 2048); bh[u][1] = *(const bf16x8*)(rwh0 + (size_t)s * 2048 + 512); bl[u][1] = *(const bf16x8*)(rwl0 + (size_t)s * 2048 + 512); }
#pragma unroll
            for (int u = 0; u < 4; ++u) { const int s = s4 + u; float gv[8], sh[8];
                *(f32x4*)&gv[0] = *(const LAS f32x4*)(GSL + 32 * s + 8 * q); *(f32x4*)&gv[4] = *(const LAS f32x4*)(GSL + 32 * s + 8 * q + 4);
                *(f32x4*)&sh[0] = *(const LAS f32x4*)(SHL + 32 * s + 8 * q); *(f32x4*)&sh[4] = *(const LAS f32x4*)(SHL + 32 * s + 8 * q + 4);
                bf16x8 ahi, alo;
#pragma unroll
                for (int j = 0; j < 8; ++j) { const float h = xa[u][j >> 2][j & 3] * rstd * gv[j] + sh[j]; const bf16_t hb = f2bf(h); ahi[j] = (short)hb; alo[j] = (short)f2bf(h - bf2f(hb)); }
                if (eh == 0) *(bf16x8*)(H2 + (size_t)row * D + 32 * s + 8 * q) = ahi;
                acc[0] = __builtin_amdgcn_mfma_f32_16x16x32_bf16(ahi, bh[u][0], acc[0], 0, 0, 0); acc[0] = __builtin_amdgcn_mfma_f32_16x16x32_bf16(ahi, bl[u][0], acc[0], 0, 0, 0); acc[0] = __builtin_amdgcn_mfma_f32_16x16x32_bf16(alo, bh[u][0], acc[0], 0, 0, 0);
                acc[1] = __builtin_amdgcn_mfma_f32_16x16x32_bf16(ahi, bh[u][1], acc[1], 0, 0, 0); acc[1] = __builtin_amdgcn_mfma_f32_16x16x32_bf16(ahi, bl[u][1], acc[1], 0, 0, 0); acc[1] = __builtin_amdgcn_mfma_f32_16x16x32_bf16(alo, bh[u][1], acc[1], 0, 0, 0); }
        }
        }
#pragma unroll
        for (int nt = 0; nt < 2; ++nt)
#pragma unroll
            for (int i = 0; i < 4; ++i) LG[(16 * rt + 4 * q + i) * LG_P + 32 * eh + 16 * nt + r] = acc[nt][i];
        __syncthreads();
        const int t = F.tid >> 3, g = F.tid & 7; const float* rb = F.in[IN_RB];
        float sc8[8], ch8[8]; float a1 = -3e38f, a2 = -3e38f;
#pragma unroll
        for (int j = 0; j < 8; ++j) { const float s_ = 1.0f / (1.0f + expf(-LG[t * LG_P + 8 * g + j])); sc8[j] = s_; const float c_ = s_ + rb[8 * g + j]; ch8[j] = c_; if (c_ > a1) { a2 = a1; a1 = c_; } else if (c_ > a2) a2 = c_; }
        GS[t * 8 + g] = a1 + a2;
        __syncthreads();
#pragma unroll
        for (int j = 0; j < 8; ++j) LG[t * LG_P + 8 * g + j] = ch8[j];
        int grank = 0; const float myg = GS[t * 8 + g];
#pragma unroll
        for (int k = 0; k < 8; ++k) { const float o = GS[t * 8 + k]; if (o > myg || (o == myg && k < g)) ++grank; }
        const bool gsel = grank < 4;
        const unsigned long long bal = __ballot(gsel); const unsigned gmask = (unsigned)(bal >> (F.lane & ~7)) & 0xffu;
        __syncthreads();
        if (gsel) {
            int rk[8];
#pragma unroll
            for (int j = 0; j < 8; ++j) rk[j] = 0;
            for (int k = 0; k < 8; ++k) { if (!((gmask >> k) & 1u)) continue;
#pragma unroll
                for (int jj = 0; jj < 8; ++jj) { const float o = LG[t * LG_P + 8 * k + jj]; const int oe = 8 * k + jj;
#pragma unroll
                    for (int j = 0; j < 8; ++j) { if (o > ch8[j] || (o == ch8[j] && oe < 8 * g + j)) ++rk[j]; } } }
#pragma unroll
            for (int j = 0; j < 8; ++j) if (rk[j] < 8) { WSL[t * 8 + rk[j]] = sc8[j]; EI[t * 8 + rk[j]] = 8 * g + j; }
        }
        __syncthreads();
        float wsum = 0.f;
#pragma unroll
        for (int k = 0; k < 8; ++k) wsum += WSL[t * 8 + k];
        const int e = EI[t * 8 + g]; const float w = WSL[t * 8 + g] / wsum * 2.5f;
        const int aid = (row0 + t) * 8 + g;
        TOPI[aid] = e; TOPW[aid] = w;
        const unsigned lp = atomicAdd((unsigned*)&LCNT[e], 1u);
        __syncthreads();
        if (F.tid < 64) { const unsigned c = LCNT[F.tid]; LBASE[F.tid] = c ? atomicAdd(&ECNT[F.tid], c) : 0u; }
        __syncthreads();
        { const unsigned rk = LBASE[e] + lp; ROWL[(size_t)e * T + rk] = aid; ERANK[aid] = (int)rk; }
    }
    __syncthreads();
}


struct MoeTabs { LAS unsigned* cnt; LAS unsigned* tstart; LAS unsigned short* tex; int ntr; };
__device__ __forceinline__ MoeTabs moe_tabs_build(Frame& F) {
    MoeTabs Tb; Tb.cnt = (LAS unsigned*)(F.lds + LDSCTL_OFF + 512); Tb.tstart = Tb.cnt + 64; Tb.tex = (LAS unsigned short*)(Tb.tstart + 68);
    __syncthreads();
    if (F.tid < 64) { unsigned c = __hip_atomic_load(F.ctl + CW_ECNT + F.tid, RLX_AGENT); Tb.cnt[F.tid] = c > (unsigned)T ? (unsigned)T : c; }
    __syncthreads();
    if (F.tid == 0) { unsigned a = 0; for (int e = 0; e < 64; ++e) { Tb.tstart[e] = a; a += (Tb.cnt[e] + 255u) >> 8; } Tb.tstart[64] = a; }
    __syncthreads();
    Tb.ntr = (int)Tb.tstart[64];
    for (int tau = F.tid; tau < Tb.ntr; tau += NTHR) { int e = 0; for (int k = 0; k < 64; ++k) if (Tb.tstart[k] <= (unsigned)tau) e = k; Tb.tex[tau] = (unsigned short)e; }
    __syncthreads();
    return Tb;
}
__device__ __forceinline__ int xcd_chunk(int L, int n) { const int q = n / 8, r = n % 8, xcd = L % 8, off = L / 8; return (xcd < r ? xcd * (q + 1) : r * (q + 1) + (xcd - r) * q) + off; }
struct GateUpSched {
    MoeTabs Tb; const char* H2; const char* Wgu; const char* Wsgu; const int* rowl; int G, c;
    __device__ __forceinline__ bool next(int i, gm::Unit& u) const {
        const int nun = 2 * Tb.ntr + 2 * (T / 256); const long L = (long)i * G + c; if (L >= nun) return false;
        const int w = xcd_chunk((int)L, nun); u.A = H2;
        if (w < 2 * Tb.ntr) { const int tau = w >> 1; u.pn = w & 1; u.e = Tb.tex[tau]; u.m0 = 256 * (tau - (int)Tb.tstart[u.e]); u.pm = tau; u.B = Wgu + (size_t)u.e * 512 * 2048 + (size_t)u.pn * 256 * 2048; }
        else { const int s = w - 2 * Tb.ntr; u.pm = s >> 1; u.pn = s & 1; u.e = 64; u.m0 = 256 * u.pm; u.B = Wsgu + (size_t)u.pn * 256 * 2048; }
        return true;
    }
    __device__ __forceinline__ unsigned arow(const gm::Unit& u, int r) const {
        if (u.e == 64) return (unsigned)(u.m0 + r) * 2048u;
        const int idx = u.m0 + r; const int aid = idx < (int)Tb.cnt[u.e] ? rowl[(size_t)u.e * T + idx] : 0;
        return (unsigned)(aid >> 3) * 2048u;
    }
};
struct EpiSwiglu {
    static constexpr bool PERM = true;
    bf16_t* act; bf16_t* acts;
    __device__ __forceinline__ void operator()(const f32x4 (&acc)[2][2][4][2], const gm::Unit& u, int wr, int wc, int fr, int fq) const {
        bf16_t* O = (u.e == 64 ? acts : act) + (size_t)(u.pm * 256 + wr * 64 + fr) * 256 + 128 * u.pn + wc * 32 + 8 * fq;
#pragma unroll
        for (int ai = 0; ai < 2; ++ai)
#pragma unroll
            for (int m = 0; m < 4; ++m) { const f32x4 g0 = acc[ai][0][m][0], g1 = acc[ai][0][m][1], u0 = acc[ai][1][m][0], u1 = acc[ai][1][m][1];
                v4u w; w.x = cvt_pk_bf16(fsilu(g0[0]) * u0[0], fsilu(g0[1]) * u0[1]); w.y = cvt_pk_bf16(fsilu(g0[2]) * u0[2], fsilu(g0[3]) * u0[3]);
                w.z = cvt_pk_bf16(fsilu(g1[0]) * u1[0], fsilu(g1[1]) * u1[1]); w.w = cvt_pk_bf16(fsilu(g1[2]) * u1[2], fsilu(g1[3]) * u1[3]);
                *(v4u*)(O + (size_t)(ai * 128 + m * 16) * 256) = w; }
    }
};
struct DownSched {
    MoeTabs Tb; const char* act; const char* acts; const char* Wdn; const char* Wsdn; int G, c;
    __device__ __forceinline__ bool next(int i, gm::Unit& u) const {
        const int nun = 4 * Tb.ntr + 4 * (T / 256); const long L = (long)i * G + c; if (L >= nun) return false;
        const int w = xcd_chunk((int)L, nun);
        if (w < 4 * Tb.ntr) { const int tau = w >> 2; u.pn = w & 3; u.e = Tb.tex[tau]; u.m0 = 256 * (tau - (int)Tb.tstart[u.e]); u.pm = tau;
            u.A = act + (size_t)tau * 256 * 512; u.B = Wdn + (size_t)u.e * 1024 * 512 + (size_t)u.pn * 256 * 512; }
        else { const int s = w - 4 * Tb.ntr; u.pm = s >> 2; u.pn = s & 3; u.e = 64; u.m0 = 256 * u.pm; u.A = acts + (size_t)u.pm * 256 * 512; u.B = Wsdn + (size_t)u.pn * 256 * 512; }
        return true;
    }
    __device__ __forceinline__ unsigned arow(const gm::Unit&, int r) const { return (unsigned)r * 512u; }
};
typedef float f32x2_t __attribute__((ext_vector_type(2)));
__device__ __forceinline__ unsigned pk4_fp8(float a, float b, float c, float d) {
    a = fminf(fmaxf(a * 16.0f, -448.0f), 448.0f); b = fminf(fmaxf(b * 16.0f, -448.0f), 448.0f); c = fminf(fmaxf(c * 16.0f, -448.0f), 448.0f); d = fminf(fmaxf(d * 16.0f, -448.0f), 448.0f);
    int w = __builtin_amdgcn_cvt_pk_fp8_f32(a, b, 0, false); w = __builtin_amdgcn_cvt_pk_fp8_f32(c, d, w, true); return (unsigned)w;
}
struct EpiDown {
    static constexpr bool PERM = true;
    unsigned char* Y8; bf16_t* YS;
    __device__ __forceinline__ void operator()(const f32x4 (&acc)[2][2][4][2], const gm::Unit& u, int wr, int wc, int fr, int fq) const {
        const size_t off = (size_t)(u.pm * 256 + wr * 64 + fr) * 1024 + u.pn * 256 + wc * 32 + 8 * fq;
        if (u.e == 64) {
#pragma unroll
            for (int ai = 0; ai < 2; ++ai)
#pragma unroll
                for (int m = 0; m < 4; ++m)
#pragma unroll
                    for (int bj = 0; bj < 2; ++bj) { const f32x4 v0 = acc[ai][bj][m][0], v1 = acc[ai][bj][m][1];
                        v4u w; w.x = cvt_pk_bf16(v0[0], v0[1]); w.y = cvt_pk_bf16(v0[2], v0[3]); w.z = cvt_pk_bf16(v1[0], v1[1]); w.w = cvt_pk_bf16(v1[2], v1[3]);
                        *(v4u*)(YS + off + (size_t)(ai * 128 + m * 16) * 1024 + bj * 128) = w; }
        } else {
#pragma unroll
            for (int ai = 0; ai < 2; ++ai)
#pragma unroll
                for (int m = 0; m < 4; ++m)
#pragma unroll
                    for (int bj = 0; bj < 2; ++bj) { const f32x4 v0 = acc[ai][bj][m][0], v1 = acc[ai][bj][m][1];
                        *(v2u*)(Y8 + off + (size_t)(ai * 128 + m * 16) * 1024 + bj * 128) = (v2u){pk4_fp8(v0[0], v0[1], v0[2], v0[3]), pk4_fp8(v1[0], v1[1], v1[2], v1[3])}; }
        }
    }
};

__device__ __forceinline__ void p8_final(Frame& F) {
    unsigned char* ws = F.ws; const unsigned char* Y = (const unsigned char*)(ws + WS_Y); const bf16_t* YS = (const bf16_t*)(ws + WS_YS);
    const float* x2 = (const float*)(ws + WS_X2); const float* mod = (const float*)(ws + WS_MOD); const float* fg = F.in[IN_FG];
    const int* TOPI = (const int*)(ws + WS_TOPI); const float* TOPW = (const float*)(ws + WS_TOPW); const int* ERANK = (const int*)(ws + WS_ERANK);
    const MoeTabs Tb = moe_tabs_build(F);
    const int w = F.wave;
    for (int unit = F.vcu; unit < T / 64; unit += F.G) {
        const int row0 = unit * 64 + 8 * w, b = row0 / SEQ;
        const int aid = row0 * 8 + F.lane; const int e = TOPI[aid]; const float wl = TOPW[aid]; const unsigned prl = 256u * Tb.tstart[e] + (unsigned)ERANK[aid];
        v2u ybA[8]; v4u ysA; v2u ybB[8]; v4u ysB;
#define P10_LOAD(yb, ysb, rr_, sg_) do { const int t_ = row0 + (rr_); _Pragma("unroll") for (int sl = 0; sl < 8; ++sl) { const unsigned pr_ = (unsigned)__shfl((int)prl, (rr_) * 8 + sl); \
            yb[sl] = *(const v2u*)(Y + (size_t)pr_ * 1024 + (sg_) * 512 + 8 * F.lane); } \
            ysb = *(const v4u*)(YS + (size_t)t_ * 1024 + (sg_) * 512 + 8 * F.lane); } while (0)
#define P10_HALF(yb, ysb, rr_, sg_) do { const int t = row0 + (rr_); float moe[8]; \
            { const unsigned vw[4] = {ysb.x, ysb.y, ysb.z, ysb.w}; \
                _Pragma("unroll") for (int k = 0; k < 4; ++k) { moe[2 * k] = bf2f((bf16_t)(vw[k] & 0xffff)); moe[2 * k + 1] = bf2f((bf16_t)(vw[k] >> 16)); } } \
            _Pragma("unroll") for (int sl = 0; sl < 8; ++sl) { const float wgt = __shfl(wl, (rr_) * 8 + sl) * 0.0625f; \
                const f32x2_t d0 = __builtin_amdgcn_cvt_pk_f32_fp8((int)yb[sl].x, false), d1 = __builtin_amdgcn_cvt_pk_f32_fp8((int)yb[sl].x, true), d2 = __builtin_amdgcn_cvt_pk_f32_fp8((int)yb[sl].y, false), d3 = __builtin_amdgcn_cvt_pk_f32_fp8((int)yb[sl].y, true); \
                moe[0] += wgt * d0[0]; moe[1] += wgt * d0[1]; moe[2] += wgt * d1[0]; moe[3] += wgt * d1[1]; moe[4] += wgt * d2[0]; moe[5] += wgt * d2[1]; moe[6] += wgt * d3[0]; moe[7] += wgt * d3[1]; } \
            _Pragma("unroll") for (int h = 0; h < 2; ++h) { const int c0 = (sg_) * 512 + 8 * F.lane + 4 * h; \
                const f32x4 xv = *(const f32x4*)(x2 + (size_t)t * D + c0), gv = *(const f32x4*)(mod + (size_t)b * 6144 + 5 * 1024 + c0); \
                _Pragma("unroll") for (int j = 0; j < 4; ++j) { const float v = xv[j] + gv[j] * moe[4 * h + j]; x3[(sg_) * 8 + 4 * h + j] = v; ss += v * v; } } } while (0)
        P10_LOAD(ybA, ysA, 0, 0);
#pragma unroll 1
        for (int rr = 0; rr < 8; ++rr) {
            float x3[16]; float ss = 0.f;
            P10_LOAD(ybB, ysB, rr, 1);
            P10_HALF(ybA, ysA, rr, 0);
            if (rr < 7) P10_LOAD(ybA, ysA, rr + 1, 0);
            P10_HALF(ybB, ysB, rr, 1);
            const int t = row0 + rr;
            const float rstd = 1.0f / sqrtf(wave_sum(ss) * (1.0f / D) + EPS);
#pragma unroll
            for (int sg = 0; sg < 2; ++sg)
#pragma unroll
                for (int h = 0; h < 2; ++h) { const int c0 = sg * 512 + 8 * F.lane + 4 * h; const f32x4 gg = *(const f32x4*)(fg + c0); f32x4 o;
#pragma unroll
                    for (int j = 0; j < 4; ++j) o[j] = x3[sg * 8 + 4 * h + j] * rstd * gg[j];
                    *(f32x4*)(F.out + (size_t)t * D + c0) = o; }
        }
#undef P10_HALF
#undef P10_LOAD
    }
    __syncthreads();
}

__device__ __forceinline__ float fgelu_tanh(float z) { const float u = 0.7978845608028654f * (z + 0.044715f * z * z * z); const float e = __expf(2.0f * u); return 0.5f * z * (1.0f + (e - 1.0f) / (e + 1.0f)); }
__device__ __forceinline__ float fgelu_safe(float z) { const float u = 0.7978845608028654f * (z + 0.044715f * z * z * z); const float uc = fminf(fmaxf(u, -15.f), 15.f); const float e = fexp(2.0f * uc); return 0.5f * z * (1.0f + (e - 1.0f) / (e + 1.0f)); }

__device__ __forceinline__ void cmp_unit(Frame& F, int unit) {
    unsigned char* ws = F.ws; const bf16_t* proj = (const bf16_t*)(ws + WS_PROJ);
    const int kv = unit >> 6, mb = unit & 63; const bf16_t* W1T = (const bf16_t*)(ws + (kv ? WS_W1VT : WS_W1KT)); const int coloff = kv ? C_VC : C_KC;
    const float* b1f = (const float*)(ws + WS_B1F) + kv * 256;
    const int w = F.wave, n = F.lane & 15, q = F.lane >> 4;
    LAS bf16_t* HID = (LAS bf16_t*)F.lds;
    size_t base[2];
#pragma unroll
    for (int rt = 0; rt < 2; ++rt) { const int R = 32 * mb + 16 * rt + n, bg = R >> 8; int c = R & 255; if (c > 254) c = 254; base[rt] = ((size_t)(bg >> 1) * SEQ + 16 * c) * LDP + coloff + (bg & 1) * 64; }
    f32x4 acc[2][2];
#pragma unroll
    for (int rt = 0; rt < 2; ++rt)
#pragma unroll
        for (int ct = 0; ct < 2; ++ct) acc[rt][ct] = (f32x4){0.f, 0.f, 0.f, 0.f};
    __syncthreads();
#pragma unroll 8
    for (int s = 0; s < 64; ++s) { const int ltok = s >> 1, dd = 32 * (s & 1) + 8 * q; bf16x8 a[2], bb[2];
#pragma unroll
        for (int rt = 0; rt < 2; ++rt) a[rt] = *(const bf16x8*)(proj + base[rt] + (size_t)ltok * LDP + dd);
#pragma unroll
        for (int ct = 0; ct < 2; ++ct) bb[ct] = *(const bf16x8*)(W1T + ((size_t)(s * 16 + 2 * w + ct) * 64 + F.lane) * 8);
#pragma unroll
        for (int rt = 0; rt < 2; ++rt)
#pragma unroll
            for (int ct = 0; ct < 2; ++ct) acc[rt][ct] = __builtin_amdgcn_mfma_f32_16x16x32_bf16(bb[ct], a[rt], acc[rt][ct], 0, 0, 0); }
#pragma unroll
    for (int rt = 0; rt < 2; ++rt)
#pragma unroll
        for (int ct = 0; ct < 2; ++ct) { const int col = 32 * w + 16 * ct + 4 * q; const f32x4 bv = *(const f32x4*)(b1f + col); const f32x4 v = acc[rt][ct] + bv;
            v2u o; o.x = cvt_pk_bf16(fgelu_safe(v[0]), fgelu_safe(v[1])); o.y = cvt_pk_bf16(fgelu_safe(v[2]), fgelu_safe(v[3]));
            *(LAS v2u*)(HID + (16 * rt + n) * 264 + col) = o; }
    __syncthreads();
    { const int rt = w & 1, ct = w >> 1; f32x4 o = (f32x4){0.f, 0.f, 0.f, 0.f};
      const bf16_t* w2f = (const bf16_t*)(ws + WS_W2T) + (size_t)kv * 16384;
#pragma unroll
      for (int s = 0; s < 8; ++s) { const bf16x8 a = *(const LAS bf16x8*)(HID + (16 * rt + n) * 264 + 32 * s + 8 * q); const bf16x8 bw = *(const bf16x8*)(w2f + ((size_t)(s * 4 + ct) * 64 + F.lane) * 8);
          o = __builtin_amdgcn_mfma_f32_16x16x32_bf16(bw, a, o, 0, 0, 0); }
      const int R = 32 * mb + 16 * rt + n, bg = R >> 8, c = R & 255, d0 = 16 * ct + 4 * q;
      if (c == 255) o = (f32x4){0.f, 0.f, 0.f, 0.f};
      if (kv == 0) { v2u ov; ov.x = cvt_pk_bf16(o[0], o[1]); ov.y = cvt_pk_bf16(o[2], o[3]); *(v2u*)((bf16_t*)(ws + WS_KCMP) + ((size_t)bg * 256 + c) * 64 + d0) = ov; }
      else { bf16_t* vt = (bf16_t*)(ws + WS_VCMPT) + (size_t)bg * 64 * 256 + c;
#pragma unroll
          for (int r = 0; r < 4; ++r) vt[(size_t)(d0 + r) * 256] = f2bf(o[r]); } }
    __syncthreads();
}

__device__ __forceinline__ void kv_prep_unit(Frame& F, int unit) {
    unsigned char* ws = F.ws; const bf16_t* proj = (const bf16_t*)(ws + WS_PROJ); const float* cs = (const float*)(ws + WS_CS); const float* sn = (const float*)(ws + WS_SN);
    const int b = unit >> 6, tile = unit & 63; const size_t tok0 = (size_t)b * SEQ + 64 * tile;
#pragma unroll
    for (int it = 0; it < 2; ++it) { const int id = F.tid + 512 * it; const int c = id & 3, g = (id >> 2) & 1, wh = (id >> 3) & 1, tk = id >> 4; const int pos = 64 * tile + tk;
        const bf16_t* src = proj + (tok0 + tk) * LDP + (wh ? C_KW : C_KS) + g * 64 + 8 * c; const v4u lo = *(const v4u*)src, hi = *(const v4u*)(src + 32);
        const f32x4 c0 = *(const f32x4*)(cs + pos * 32 + 8 * c), c1 = *(const f32x4*)(cs + pos * 32 + 8 * c + 4), s0 = *(const f32x4*)(sn + pos * 32 + 8 * c), s1 = *(const f32x4*)(sn + pos * 32 + 8 * c + 4);
        float a[8], bb[8], co[8], si[8];
        const unsigned lw[4] = {lo.x, lo.y, lo.z, lo.w}, hw[4] = {hi.x, hi.y, hi.z, hi.w};
#pragma unroll
        for (int k = 0; k < 4; ++k) { a[2 * k] = bf2f((bf16_t)(lw[k] & 0xffff)); a[2 * k + 1] = bf2f((bf16_t)(lw[k] >> 16)); bb[2 * k] = bf2f((bf16_t)(hw[k] & 0xffff)); bb[2 * k + 1] = bf2f((bf16_t)(hw[k] >> 16)); co[k] = c0[k]; co[4 + k] = c1[k]; si[k] = s0[k]; si[4 + k] = s1[k]; }
        unsigned olp[4], ohp[4];
#pragma unroll
        for (int k = 0; k < 4; ++k) { olp[k] = pk2(a[2 * k] * co[2 * k] - bb[2 * k] * si[2 * k], a[2 * k + 1] * co[2 * k + 1] - bb[2 * k + 1] * si[2 * k + 1]);
            ohp[k] = pk2(bb[2 * k] * co[2 * k] + a[2 * k] * si[2 * k], bb[2 * k + 1] * co[2 * k + 1] + a[2 * k + 1] * si[2 * k + 1]); }
        bf16_t* dst = (bf16_t*)(ws + (wh ? WS_KWR : WS_KSR)) + (((size_t)(b * 2 + g) * SEQ) + pos) * 64 + 8 * c; *(v4u*)dst = (v4u){olp[0], olp[1], olp[2], olp[3]}; *(v4u*)(dst + 32) = (v4u){ohp[0], ohp[1], ohp[2], ohp[3]}; }
    LAS bf16_t* TL = (LAS bf16_t*)F.lds;
    v4u vin[4];
#pragma unroll
    for (int m = 0; m < 4; ++m) { const int wh = m >> 1, g = m & 1, tk = F.tid >> 3, c = F.tid & 7; vin[m] = *(const v4u*)(proj + (tok0 + tk) * LDP + (wh ? C_VW : C_VS) + g * 64 + 8 * c); }
#pragma unroll
    for (int m = 0; m < 4; ++m) { const int wh = m >> 1, g = m & 1;
        __syncthreads();
        { const int tk = F.tid >> 3, c = F.tid & 7; *(LAS v4u*)(TL + tk * 72 + 8 * c) = vin[m]; }
        __syncthreads();
        { const int d = F.tid >> 3, sc = F.tid & 7; unsigned short e[8];
#pragma unroll
          for (int i = 0; i < 8; ++i) e[i] = TL[(8 * sc + i) * 72 + d];
          v4u o; o.x = e[0] | ((unsigned)e[1] << 16); o.y = e[2] | ((unsigned)e[3] << 16); o.z = e[4] | ((unsigned)e[5] << 16); o.w = e[6] | ((unsigned)e[7] << 16);
          *(v4u*)((bf16_t*)(ws + (wh ? WS_VWT : WS_VST)) + ((size_t)(b * 2 + g) * 64 + d) * SEQ + 64 * tile + 8 * sc) = o; } }
    __syncthreads();
}

constexpr int ATT_PSL = 32768, ATT_SELM = 49152, ATT_UNI = 49664, ATT_TL = 49680, ATT_NT = 49760;
constexpr float ATT_QS = 0.125f * 1.4426950408889634f;
__device__ __forceinline__ int att_swz(int row, int c) { return row * 128 + ((c ^ ((row >> 1) & 7)) << 4); }
struct TileSrc { const bf16_t* K; int kpitch; const bf16_t* V; int vpitch; };
__device__ __forceinline__ void att_load(const TileSrc& s, int tid, v4u& kr, v4u& vr) { const int row = tid >> 3, c = tid & 7; kr = *(const v4u*)(s.K + (size_t)row * s.kpitch + 8 * c); vr = *(const v4u*)(s.V + (size_t)row * s.vpitch + 8 * c); }
__device__ __forceinline__ void att_store(LAS unsigned char* lds, int buf, int tid, const v4u& kr, const v4u& vr) {
    const int row = tid >> 3, c = tid & 7;
    *(LAS v4u*)(lds + buf * 8192 + att_swz(row, c)) = kr;
    const int s16 = c >> 1, half = c & 1;
    *(LAS v2u*)(lds + 16384 + buf * 8192 + att_swz(row, 2 * s16) + half * 8) = (v2u){vr.x, vr.y};
    *(LAS v2u*)(lds + 16384 + buf * 8192 + att_swz(row, 2 * s16 + 1) + half * 8) = (v2u){vr.z, vr.w};
}
__device__ __forceinline__ void att_qk(const LAS unsigned char* kb, const bf16x8 (&qf)[4], f32x16 (&s)[2], int i, int hh, const f32x16& ini0, const f32x16& ini1) {
#pragma unroll
    for (int kt = 0; kt < 2; ++kt) {
#pragma unroll
        for (int st = 0; st < 4; ++st) { const bf16x8 a = *(const LAS bf16x8*)(kb + att_swz(32 * kt + i, 2 * st + hh)); s[kt] = __builtin_amdgcn_mfma_f32_32x32x16_bf16(a, qf[st], st == 0 ? (kt ? ini1 : ini0) : s[kt], 0, 0, 0); } }
}
__device__ __forceinline__ void att_ini(f32x16 (&ini)[2], bool uniform, float base, int lo, int hi, int hh) {
    if (uniform) {
#pragma unroll
        for (int r = 0; r < 16; ++r) ini[0][r] = base;
        ini[1] = ini[0];
    } else {
        const unsigned span = (unsigned)(hi - lo);
#pragma unroll
        for (int kt = 0; kt < 2; ++kt)
#pragma unroll
            for (int r = 0; r < 16; ++r) { const int kk = 32 * kt + (r & 3) + 8 * (r >> 2) + 4 * hh; ini[kt][r] = ((unsigned)(kk - lo) <= span && hi >= lo) ? base : -1e30f; }
    }
}
__device__ __forceinline__ void att_pv(const LAS unsigned char* vb, const f32x16 (&p)[2], f32x16 (&o)[2], int i, int hh) {
#pragma unroll
    for (int kt = 0; kt < 2; ++kt)
#pragma unroll
        for (int s = 0; s < 2; ++s) { const v4u pb = (v4u){cvt_pk_bf16(p[kt][8 * s], p[kt][8 * s + 1]), cvt_pk_bf16(p[kt][8 * s + 2], p[kt][8 * s + 3]), cvt_pk_bf16(p[kt][8 * s + 4], p[kt][8 * s + 5]), cvt_pk_bf16(p[kt][8 * s + 6], p[kt][8 * s + 7])};
            const bf16x8 bf = __builtin_bit_cast(bf16x8, pb);
#pragma unroll
            for (int dt = 0; dt < 2; ++dt) { const bf16x8 a = *(const LAS bf16x8*)(vb + att_swz(32 * dt + i, 2 * (2 * kt + s) + hh)); o[dt] = __builtin_amdgcn_mfma_f32_32x32x16_bf16(a, bf, o[dt], 0, 0, 0); } }
}
#define ATT_KEY(kt, r, hh) (32 * (kt) + ((r) & 3) + 8 * ((r) >> 2) + 4 * (hh))

__device__ __forceinline__ void att_unit(Frame& F, int unit) {
    unsigned char* ws = F.ws; const bf16_t* proj = (const bf16_t*)(ws + WS_PROJ); bf16_t* mix = (bf16_t*)(ws + WS_MIX);
    const int qb = unit & 63, bg = unit >> 6, b = bg >> 1, g = bg & 1;
    const int w = F.wave, i = F.lane & 31, hh = F.lane >> 5, head = i >> 3, tloc = i & 7, tt = 8 * w + tloc; const int pos = 64 * qb + tt; const size_t tok = (size_t)b * SEQ + pos;
    LAS unsigned char* lds = F.lds; LAS float* PSL = (LAS float*)(lds + ATT_PSL); LAS unsigned* SELM = (LAS unsigned*)(lds + ATT_SELM); LAS unsigned* UNI = (LAS unsigned*)(lds + ATT_UNI);
    LAS unsigned char* TL = lds + ATT_TL; LAS int* NTL = (LAS int*)(lds + ATT_NT);
    const bf16_t* kcmp = (const bf16_t*)(ws + WS_KCMP) + (size_t)bg * 256 * 64; const bf16_t* vcmpt = (const bf16_t*)(ws + WS_VCMPT) + (size_t)bg * 64 * 256;
    const bf16_t* ksr = (const bf16_t*)(ws + WS_KSR) + (size_t)bg * SEQ * 64; const bf16_t* vst = (const bf16_t*)(ws + WS_VST) + (size_t)bg * 64 * SEQ;
    const bf16_t* kwr = (const bf16_t*)(ws + WS_KWR) + (size_t)bg * SEQ * 64; const bf16_t* vwt = (const bf16_t*)(ws + WS_VWT) + (size_t)bg * 64 * SEQ;
    __syncthreads();
    for (int k = F.tid; k < 64 * 64; k += NTHR) PSL[k] = 0.f;
    if (F.tid < 2) UNI[F.tid] = 0u;
    bf16x8 qf[4];
    const bf16_t* qp = proj + tok * LDP + C_NQ + (4 * g + head) * 64 + 8 * hh;
    { float qraw[4][8];
#pragma unroll
      for (int st = 0; st < 4; ++st) { const v4u v = *(const v4u*)(qp + 16 * st); const unsigned vw[4] = {v.x, v.y, v.z, v.w};
#pragma unroll
          for (int k = 0; k < 4; ++k) { qraw[st][2 * k] = bf2f((bf16_t)(vw[k] & 0xffff)); qraw[st][2 * k + 1] = bf2f((bf16_t)(vw[k] >> 16)); } }
#pragma unroll
      for (int st = 0; st < 4; ++st) { const v4u o = (v4u){cvt_pk_bf16(qraw[st][0] * ATT_QS, qraw[st][1] * ATT_QS), cvt_pk_bf16(qraw[st][2] * ATT_QS, qraw[st][3] * ATT_QS), cvt_pk_bf16(qraw[st][4] * ATT_QS, qraw[st][5] * ATT_QS), cvt_pk_bf16(qraw[st][6] * ATT_QS, qraw[st][7] * ATT_QS)};
          qf[st] = __builtin_bit_cast(bf16x8, o); } }
    LAS float* OUTA = (LAS float*)(lds + 65536) + (size_t)w * 32 * 64 + F.lane;
    const float* gl = nullptr; (void)gl;
    const float gate0 = fsigmoid(bf2f(proj[tok * LDP + C_NG + (4 * g + head) * 3 + 0])), gate1 = fsigmoid(bf2f(proj[tok * LDP + C_NG + (4 * g + head) * 3 + 1])), gate2 = fsigmoid(bf2f(proj[tok * LDP + C_NG + (4 * g + head) * 3 + 2]));
    v4u kr, vr; f32x16 s[2];
#ifndef PROBE_ATT
#define PROBE_ATT 0
#endif
    for (int rep1_ = 0; rep1_ < (PROBE_ATT == 1 ? 2 : 1); ++rep1_) {
    const int ncu = (4 * qb + 3) < 255 ? (4 * qb + 3) : 255, ntile = (ncu + 63) >> 6;
    const int ncv = pos >= 31 ? ((pos - 31) >> 4) + 1 : 0;
    const int ncv_min = qb >= 1 ? 4 * qb - 1 : 0;
    float m = -1e30f, l = 0.f;
    {
        int cur = 0; { TileSrc ts{kcmp, 64, vcmpt, 256}; att_load(ts, F.tid, kr, vr); att_store(lds, 0, F.tid, kr, vr); }
        __syncthreads();
        for (int T_ = 0; T_ < ntile; ++T_) {
            const bool more = T_ + 1 < ntile;
            if (more) { TileSrc ts{kcmp + (size_t)(T_ + 1) * 64 * 64, 64, vcmpt + (T_ + 1) * 64, 256}; att_load(ts, F.tid, kr, vr); }
            { f32x16 ini[2]; att_ini(ini, 64 * T_ + 64 <= ncv_min, 0.f, 0, ncv - 1 - 64 * T_, hh); att_qk(lds + cur * 8192, qf, s, i, hh, ini[0], ini[1]); }
            float tm = -1e30f;
#pragma unroll
            for (int kt = 0; kt < 2; ++kt)
#pragma unroll
                for (int r = 0; r < 16; ++r) tm = fmaxf(tm, s[kt][r]);
            tm = fmaxf(tm, __shfl_xor(tm, 32));
            const float mn = fmaxf(m, tm); l *= fexp2(m - mn);
#pragma unroll
            for (int kt = 0; kt < 2; ++kt)
#pragma unroll
                for (int r = 0; r < 16; ++r) l += fexp2(s[kt][r] - mn);
            m = mn;
            if (more) att_store(lds, cur ^ 1, F.tid, kr, vr);
            __syncthreads(); cur ^= 1;
        }
        l += __shfl_xor(l, 32);
    }
    {
        const float rl = (ncv > 0 && l > 0.f) ? 1.0f / l : 0.f;
        f32x16 o[2];
#pragma unroll
        for (int k = 0; k < 16; ++k) { o[0][k] = 0.f; o[1][k] = 0.f; }
        float carry = 0.f;
        int cur = 0; { TileSrc ts{kcmp, 64, vcmpt, 256}; att_load(ts, F.tid, kr, vr); att_store(lds, 0, F.tid, kr, vr); }
        __syncthreads();
        for (int T_ = 0; T_ < ntile; ++T_) {
            const bool more = T_ + 1 < ntile;
            if (more) { TileSrc ts{kcmp + (size_t)(T_ + 1) * 64 * 64, 64, vcmpt + (T_ + 1) * 64, 256}; att_load(ts, F.tid, kr, vr); }
            { f32x16 ini[2]; att_ini(ini, 64 * T_ + 64 <= ncv_min, -m, 0, ncv - 1 - 64 * T_, hh); att_qk(lds + cur * 8192, qf, s, i, hh, ini[0], ini[1]); }
#pragma unroll
            for (int kt = 0; kt < 2; ++kt)
#pragma unroll
                for (int r = 0; r < 16; ++r) s[kt][r] = fexp2(s[kt][r]) * rl;
            att_pv(lds + 16384 + cur * 8192, s, o, i, hh);
            float ps[8];
#pragma unroll
            for (int kt = 0; kt < 2; ++kt)
#pragma unroll
                for (int gi = 0; gi < 4; ++gi) ps[4 * kt + gi] = (s[kt][4 * gi] + s[kt][4 * gi + 1]) + (s[kt][4 * gi + 2] + 0.5f * s[kt][4 * gi + 3]);
            float nc = 0.f;
#pragma unroll
            for (int sl = 0; sl < 8; ++sl) { const float x = 0.5f * s[sl >> 2][4 * (sl & 3) + 3]; const float y = __shfl_xor(x, 32);
                if (hh == 1) ps[sl] += y; else { if (sl < 7) ps[sl + 1] += y; else nc = y; } }
            if (hh == 0) { ps[0] += carry; carry = nc; }
#pragma unroll
            for (int sl = 0; sl < 8; ++sl) { float v = ps[sl]; v += __shfl_xor(v, 8); v += __shfl_xor(v, 16); ps[sl] = v; }
            if (head == 0) {
#pragma unroll
                for (int sl = 0; sl < 8; ++sl) PSL[tt * 64 + 16 * T_ + 2 * sl + hh] = ps[sl]; }
            if (more) att_store(lds, cur ^ 1, F.tid, kr, vr);
            __syncthreads(); cur ^= 1;
        }
#pragma unroll
        for (int dt = 0; dt < 2; ++dt)
#pragma unroll
            for (int k = 0; k < 16; ++k) OUTA[(dt * 16 + k) * 64] = gate0 * o[dt][k];
    }
    __syncthreads();
#pragma unroll 1
    for (int tl = 0; tl < 8; ++tl) {
        const int t = 8 * w + tl, j = F.lane; const bool fj = (j == 0) || (j == qb) || (j == qb - 1);
        const unsigned key = fj ? 0xFFFFFFFFu : (j <= qb ? __float_as_uint(PSL[t * 64 + j]) + 1u : 0u);
        unsigned thr = 0u;
#pragma unroll 1
        for (int bit = 31; bit >= 0; --bit) { const unsigned cand = thr | (1u << bit); if (__popcll(__ballot(key >= cand)) >= NSEL) thr = cand; }
        const unsigned long long gt = __ballot(key > thr), eq = __ballot(key == thr); const int need = NSEL - __popcll(gt);
        const int below = __popcll(eq & ((1ull << j) - 1ull));
        const bool sel = (key > 0u) && ((key > thr) || (key == thr && below < need));
        const unsigned long long msk = __ballot(sel);
        if (F.lane == 0) { const unsigned lo = (unsigned)msk, hi = (unsigned)(msk >> 32); SELM[2 * t] = lo; SELM[2 * t + 1] = hi; atomicOr((unsigned*)&UNI[0], lo); atomicOr((unsigned*)&UNI[1], hi); }
    }
    __syncthreads();
    }
    const unsigned sel0 = SELM[2 * tt], sel1 = SELM[2 * tt + 1];
    { const float* csp = (const float*)(ws + WS_CS) + pos * 32 + 8 * hh; const float* snp = (const float*)(ws + WS_SN) + pos * 32 + 8 * hh;
      float qraw[4][8];
#pragma unroll
      for (int st = 0; st < 4; ++st) { const v4u v = *(const v4u*)(qp + 16 * st); const unsigned vw[4] = {v.x, v.y, v.z, v.w};
#pragma unroll
          for (int k = 0; k < 4; ++k) { qraw[st][2 * k] = bf2f((bf16_t)(vw[k] & 0xffff)); qraw[st][2 * k + 1] = bf2f((bf16_t)(vw[k] >> 16)); } }
#pragma unroll
      for (int st = 0; st < 2; ++st) { float co[8], si[8]; *(f32x4*)&co[0] = *(const f32x4*)(csp + 16 * st); *(f32x4*)&co[4] = *(const f32x4*)(csp + 16 * st + 4); *(f32x4*)&si[0] = *(const f32x4*)(snp + 16 * st); *(f32x4*)&si[4] = *(const f32x4*)(snp + 16 * st + 4);
          float rl_[8], rh_[8];
#pragma unroll
          for (int k = 0; k < 8; ++k) { rl_[k] = (qraw[st][k] * co[k] - qraw[st + 2][k] * si[k]) * ATT_QS; rh_[k] = (qraw[st + 2][k] * co[k] + qraw[st][k] * si[k]) * ATT_QS; }
          qf[st] = __builtin_bit_cast(bf16x8, (v4u){cvt_pk_bf16(rl_[0], rl_[1]), cvt_pk_bf16(rl_[2], rl_[3]), cvt_pk_bf16(rl_[4], rl_[5]), cvt_pk_bf16(rl_[6], rl_[7])});
          qf[st + 2] = __builtin_bit_cast(bf16x8, (v4u){cvt_pk_bf16(rh_[0], rh_[1]), cvt_pk_bf16(rh_[2], rh_[3]), cvt_pk_bf16(rh_[4], rh_[5]), cvt_pk_bf16(rh_[6], rh_[7])}); } }
    for (int rep2_ = 0; rep2_ < (PROBE_ATT == 2 ? 2 : 1); ++rep2_)
#pragma unroll 1
    for (int br = 0; br < 2; ++br) {
        if (F.tid == 0) { int nl = 0;
            if (br == 0) { const unsigned u0 = UNI[0], u1 = UNI[1]; for (int j = 0; j <= qb; ++j) { const bool on = j < 32 ? ((u0 >> j) & 1u) : ((u1 >> (j - 32)) & 1u); if (on) TL[nl++] = (unsigned char)j; } }
            else { for (int j = (qb >= 8 ? qb - 8 : 0); j <= qb; ++j) TL[nl++] = (unsigned char)j; }
            NTL[0] = nl; }
        __syncthreads();
        const int nl = NTL[0]; const bf16_t* Kg = br ? kwr : ksr; const bf16_t* Vg = br ? vwt : vst;
        float mm = 0.f, ll = 0.f; bool started = false; f32x16 o[2];
#pragma unroll
        for (int k = 0; k < 16; ++k) { o[0][k] = 0.f; o[1][k] = 0.f; }
        v4u kr2, vr2;
        { const int j0 = TL[0]; TileSrc ts{Kg + (size_t)j0 * 64 * 64, 64, Vg + (size_t)j0 * 64, SEQ}; att_load(ts, F.tid, kr, vr); att_store(lds, 0, F.tid, kr, vr); }
        if (nl > 1) { const int j1 = TL[1]; TileSrc ts{Kg + (size_t)j1 * 64 * 64, 64, Vg + (size_t)j1 * 64, SEQ}; att_load(ts, F.tid, kr, vr); }
        if (nl > 2) { const int j2 = TL[2]; TileSrc ts{Kg + (size_t)j2 * 64 * 64, 64, Vg + (size_t)j2 * 64, SEQ}; att_load(ts, F.tid, kr2, vr2); }
        __syncthreads();
        int cur = 0;
        for (int it = 0; it < nl; ++it) {
            const int j = TL[it];
            if (it + 1 < nl) att_store(lds, cur ^ 1, F.tid, kr, vr);
            kr = kr2; vr = vr2;
            if (it + 3 < nl) { const int jn = TL[it + 3]; TileSrc ts{Kg + (size_t)jn * 64 * 64, 64, Vg + (size_t)jn * 64, SEQ}; att_load(ts, F.tid, kr2, vr2); }
            bool lane_on; int lo_k, hi_k;
            if (br == 0) { lane_on = j < 32 ? ((sel0 >> j) & 1u) : ((sel1 >> (j - 32)) & 1u); lo_k = 0; hi_k = (j == qb) ? tt : 63; }
            else { lane_on = true; lo_k = (j == qb - 8) ? tt + 1 : 0; hi_k = (j == qb) ? tt : 63; if (lo_k > hi_k) lane_on = false; }
            const bool full = (j != qb) && (br == 0 || j != qb - 8);
            if (__any(lane_on)) {
                { f32x16 ini[2]; att_ini(ini, full, lane_on ? -mm : -1e30f, lo_k, lane_on ? hi_k : -1, hh); att_qk(lds + cur * 8192, qf, s, i, hh, ini[0], ini[1]); }
                float tm = -1e30f;
#pragma unroll
                for (int kt = 0; kt < 2; ++kt)
#pragma unroll
                    for (int r = 0; r < 16; ++r) tm = fmaxf(tm, s[kt][r]);
                tm = fmaxf(tm, __shfl_xor(tm, 32));
                const bool first = !started && (tm > -1e29f); started = started || first;
                const bool upd = first || (tm > 8.0f);
                if (__any(upd)) {
                    const float delta = upd ? tm : 0.f, al = fexp2(-delta); mm += delta; ll *= al;
#pragma unroll
                    for (int dt = 0; dt < 2; ++dt)
#pragma unroll
                        for (int k = 0; k < 16; ++k) o[dt][k] *= al;
#pragma unroll
                    for (int kt = 0; kt < 2; ++kt)
#pragma unroll
                        for (int r = 0; r < 16; ++r) s[kt][r] -= delta;
                }
#pragma unroll
                for (int kt = 0; kt < 2; ++kt)
#pragma unroll
                    for (int r = 0; r < 16; ++r) { const float pv_ = fexp2(s[kt][r]); s[kt][r] = pv_; ll += pv_; }
                att_pv(lds + 16384 + cur * 8192, s, o, i, hh);
            }
            __syncthreads(); cur ^= 1;
        }
        ll += __shfl_xor(ll, 32);
        const float sc_ = rep2_ ? 0.f : (br ? gate2 : gate1) / ll;
#pragma unroll
        for (int dt = 0; dt < 2; ++dt)
#pragma unroll
            for (int k = 0; k < 16; ++k) OUTA[(dt * 16 + k) * 64] += sc_ * o[dt][k];
    }
    { bf16_t* op = mix + tok * D + 512 + (4 * g + head) * 64 + 4 * hh;
#pragma unroll
      for (int dt = 0; dt < 2; ++dt)
#pragma unroll
          for (int gi = 0; gi < 4; ++gi) { const float a0 = OUTA[(dt * 16 + 4 * gi) * 64], a1 = OUTA[(dt * 16 + 4 * gi + 1) * 64], a2 = OUTA[(dt * 16 + 4 * gi + 2) * 64], a3 = OUTA[(dt * 16 + 4 * gi + 3) * 64];
              v2u ov; ov.x = cvt_pk_bf16(a0, a1); ov.y = cvt_pk_bf16(a2, a3); *(v2u*)(op + 32 * dt + 8 * gi) = ov; } }
    __syncthreads();
}

__global__ void __launch_bounds__(NTHR, 2) mk_fwd(Args args) {
    extern __shared__ __attribute__((aligned(16))) unsigned char lds_raw[];
    Frame F;
    F.lds = (LAS unsigned char*)lds_raw; F.MISC = (volatile LAS unsigned*)(F.lds + MISC_OFF);
    F.tid = threadIdx.x; F.lane = F.tid & 63; F.wave = __builtin_amdgcn_readfirstlane(F.tid >> 6);
    F.G = gridDim.x; { const int bx = blockIdx.x; F.vcu = (F.G % 8 == 0) ? (bx % 8) * (F.G / 8) + bx / 8 : bx; }
    F.ws = args.ws; F.ctl = (unsigned*)(args.ws + WS_CTL); F.out = args.out;
#pragma unroll
    for (int i = 0; i < 25; ++i) F.in[i] = args.in[i];
    for (int u = F.tid; u < (LDS_BYTES - LDSCTL_OFF) / 4; u += NTHR) ((LAS unsigned*)(F.lds + LDSCTL_OFF))[u] = 0u;
    __syncthreads();
    const int lo = args.ph_lo, hi = args.ph_hi;
    XcdBarrier bar = xcd_barrier_post(F.ctl + CW_BAR + lo * XCD_BAR_WORDS, F.MISC + 8);
#define IN_PH(k) (lo <= (k) && (k) < hi)
#define SEAM(k) do { if (IN_PH(k) && IN_PH((k) + 1)) xcd_barrier(bar); } while (0)
#define RUNP(k, BODY) do { if (IN_PH(k)) { BODY; if (PROBE_REP == (k)) { xcd_barrier(bar); BODY; } } } while (0)
#define BODY0 p0_prologue(F)
#define BODY1 p1a_norm(F)
#define BODY2 { gm::DenseSched S{(const char*)(F.ws + WS_XN), (const char*)(F.ws + WS_WINT), T / 256, LDP / 256, F.G, (int)blockIdx.x, 2048u, 1024u}; \
        gm::EpiBf16 E{(bf16_t*)(F.ws + WS_PROJ), LDP}; gm::gemm_phase<gm::EpiBf16, gm::DenseSched>(F.lds, S, E, 1024, 128u); }
#define BODY3 { if (F.G == 256) { if (F.vcu < 128) cmp_unit(F, F.vcu); else { const int u0 = 2 * (F.vcu - 128); hg_passA(F, u0); hg_passA(F, u0 + 1); kv_prep_unit(F, u0); kv_prep_unit(F, u0 + 1); } } \
        else { for (int u = F.vcu; u < 128; u += F.G) cmp_unit(F, u); for (int u = F.vcu; u < 256; u += F.G) hg_passA(F, u); for (int u = F.vcu; u < 256; u += F.G) kv_prep_unit(F, u); } }
#define BODY4 { for (int u = F.vcu; u < 256; u += F.G) hg_passC(F, u); }
#define BODY5 { for (int c = F.vcu; c < 256; c += F.G) { const int bg = c >> 5, k = c & 31; att_unit(F, bg * 64 + 63 - k); att_unit(F, bg * 64 + k); } }
#define BODY6 { gm::DenseSched S{(const char*)(F.ws + WS_MIX), (const char*)(F.ws + WS_WOUTT), T / 256, 4, F.G, (int)blockIdx.x, 2048u, 1024u}; \
        gm::EpiRes E{F.in[IN_X], (const float*)(F.ws + WS_MOD), 2, (float*)(F.ws + WS_X2)}; gm::gemm_phase<gm::EpiRes, gm::DenseSched>(F.lds, S, E, 1024, 128u); }
#define BODY7 p5_router(F)
#define BODY8 { const MoeTabs Tb = moe_tabs_build(F); \
        GateUpSched S{Tb, (const char*)(F.ws + WS_H2), (const char*)(F.ws + WS_WGUT), (const char*)(F.ws + WS_WSGUT), (const int*)(F.ws + WS_ROWL), F.G, (int)blockIdx.x}; \
        EpiSwiglu E{(bf16_t*)(F.ws + WS_ACT), (bf16_t*)(F.ws + WS_ACTS)}; gm::gemm_phase<EpiSwiglu, GateUpSched>(F.lds, S, E, 1024, 128u); }
#define BODY9 { const MoeTabs Tb = moe_tabs_build(F); DownSched S{Tb, (const char*)(F.ws + WS_ACT), (const char*)(F.ws + WS_ACTS), (const char*)(F.ws + WS_WDNT), (const char*)(F.ws + WS_WSDNT), F.G, (int)blockIdx.x}; \
        EpiDown E{(unsigned char*)(F.ws + WS_Y), (bf16_t*)(F.ws + WS_YS)}; gm::gemm_phase<EpiDown, DownSched>(F.lds, S, E, 256, 128u); }
#define BODY10 p8_final(F)
    RUNP(0, BODY0); SEAM(0);
    RUNP(1, BODY1); SEAM(1);
    RUNP(2, BODY2); SEAM(2);
    RUNP(3, BODY3); SEAM(3);
    RUNP(4, BODY4); SEAM(4);
    RUNP(5, BODY5); SEAM(5);
    RUNP(6, BODY6); SEAM(6);
    RUNP(7, BODY7); SEAM(7);
    RUNP(8, BODY8); SEAM(8);
    RUNP(9, BODY9); SEAM(9);
    RUNP(10, BODY10);
#undef IN_PH
#undef SEAM
#undef RUNP
}
#ifndef ONE_LAUNCH
#define ONE_LAUNCH 1
#endif
#ifndef OPT_S1
#define OPT_S1 1
#endif
#ifndef OPT_S2B
#define OPT_S2B 1
#endif
#ifndef OPT_S2A
#define OPT_S2A 1
#endif
#ifndef OPT_S5
#define OPT_S5 1
#endif
#ifndef OPT_S3
#define OPT_S3 1
#endif
#ifndef OPT_S4
#define OPT_S4 1
#endif
static void launch_mk(const nv::In& I, void* const* d_in, float* out, unsigned char* ws, int lo, int hi, int grid, hipStream_t stream) {
    Args a{}; for (int i = 0; i < 25; ++i) a.in[i] = (const float*)d_in[i];
    a.out = out; a.ws = ws; a.ph_lo = lo; a.ph_hi = hi; a.rep = 0; a.pad = 0;
    hipLaunchKernelGGL(mk_fwd, dim3(grid), dim3(NTHR), LDS_BYTES, stream, a);
}
extern "C" void kernel_launch(void* const* d_in, const int* in_sizes, int n_in, void* d_out, int out_size, void* d_ws, size_t ws_size, hipStream_t stream) {
    static int grid = 0;
    if (grid == 0) {
        if (ws_size < WS_END || n_in != 25) { fprintf(stderr, "kernel_launch: ws %zu < %zu or n_in %d != 25\n", ws_size, (size_t)WS_END, n_in); grid = -1; return; }
        int dev = 0, cus = 0;
        if (hipGetDevice(&dev) != hipSuccess || hipDeviceGetAttribute(&cus, hipDeviceAttributeMultiprocessorCount, dev) != hipSuccess) { grid = -1; return; }
        if (hipFuncSetAttribute((const void*)mk_fwd, hipFuncAttributeMaxDynamicSharedMemorySize, LDS_BYTES) != hipSuccess) { fprintf(stderr, "kernel_launch: hipFuncSetAttribute failed\n"); grid = -1; return; }
        int per_cu = 0; (void)hipOccupancyMaxActiveBlocksPerMultiprocessor(&per_cu, (const void*)mk_fwd, NTHR, LDS_BYTES); (void)hipGetLastError();
        if (per_cu < 1) fprintf(stderr, "kernel_launch: occupancy query says %d blocks/CU\n", per_cu);
        grid = cus;
    }
    if (grid < 0) return;
    unsigned char* ws = (unsigned char*)d_ws; float* out = (float*)d_out;
    nv::In I; I.set(d_in);
    (void)hipMemsetAsync(ws + WS_CTL, 0, CTL_ZERO_BYTES, stream);
#if ONE_LAUNCH
    launch_mk(I, d_in, out, ws, 0, 11, grid, stream);
#else
#if OPT_S1
    launch_mk(I, d_in, out, ws, 0, 3, grid, stream);
#else
    nv::s1_naive(I, ws, stream);
#endif
#if OPT_S2A
    launch_mk(I, d_in, out, ws, 3, OPT_S2B ? 6 : 5, grid, stream);
#endif
    if (!OPT_S2A || !OPT_S2B) nv::s2_naive(I, ws, stream, !OPT_S2A, !OPT_S2B);
#if OPT_S3
    launch_mk(I, d_in, out, ws, 6, OPT_S4 ? 8 : 7, grid, stream);
#else
    nv::s3_naive(I, ws, stream);
#endif
#if OPT_S4
    if (!OPT_S3) launch_mk(I, d_in, out, ws, 7, 8, grid, stream);
#else
    nv::s4_naive(I, ws, stream);
#endif
#if OPT_S5
    launch_mk(I, d_in, out, ws, 8, 11, grid, stream);
#else
    nv::s5_naive(I, ws, out, stream);
#endif
#endif
}
#endif
```

```cpp
#ifndef CPU_EMU
#include <hip/hip_runtime.h>
#endif
#include <cstdio>
#include <cstdint>
#include <cmath>

#ifndef BATCH
#define BATCH 4
#endif
#ifndef SEQ
#define SEQ 4096
#endif

#ifdef CPU_EMU
struct dim3e { unsigned x, y, z; };
static thread_local dim3e threadIdx, blockIdx, blockDim, gridDim;
#define __global__
#define __device__
#define __host__
#define __forceinline__ inline
#define __launch_bounds__(...)
typedef int hipStream_t;
template <class F> static void cpu_launch(unsigned grid, unsigned block, F f) {
#pragma omp parallel for schedule(dynamic, 1)
    for (long b = 0; b < (long)grid; ++b) {
        blockIdx = {(unsigned)b, 0, 0}; blockDim = {block, 1, 1}; gridDim = {grid, 1, 1};
        for (unsigned t = 0; t < block; ++t) { threadIdx = {t, 0, 0}; f(); }
    }
}
static int g_launch_limit = 1 << 30, g_launch_count = 0;
#define LAUNCH(kern, grid, block, ...) do { if (g_launch_count++ < g_launch_limit) cpu_launch((unsigned)(grid), (unsigned)(block), [&]() { kern(__VA_ARGS__); }); } while (0)
#else
#define LAUNCH(kern, grid, block, ...) kern<<<dim3((unsigned)(grid)), dim3((unsigned)(block)), 0, stream>>>(__VA_ARGS__)
#endif

typedef unsigned short bf16_t;
constexpr int D = 1024, T = BATCH * SEQ, INC = 3352, LDP = 3584;
constexpr int C_HQ = 0, C_HF = 512, C_HI = 1024, C_HGT = 1536, C_NQ = 2048, C_KC = 2560, C_VC = 2688, C_KS = 2816, C_VS = 2944, C_KW = 3072, C_VW = 3200, C_NG = 3328;
constexpr int NCMP = (SEQ - 32) / 16 + 1, NSB = SEQ / 64, NSEL = NSB < 16 ? NSB : 16;
constexpr float EPS = 1e-6f;

constexpr size_t MiB = 1u << 20, KiB = 1u << 10;
constexpr size_t WS_CTL = 0, CTL_ZERO_BYTES = 1 * MiB;
constexpr size_t WS_MODP = 1 * MiB;
constexpr size_t WS_MOD = 2 * MiB + 512 * KiB;
constexpr size_t WS_B1F = WS_MOD + 128 * KiB;
constexpr size_t WS_CS = 2 * MiB + 768 * KiB, WS_SN = WS_CS + 512 * KiB;
constexpr size_t WS_WDNT = 4 * MiB;
constexpr size_t WS_WSDNT = 36 * MiB;
constexpr size_t WS_X2 = 37 * MiB;
constexpr size_t WS_ACT = 101 * MiB;
constexpr size_t WS_ACTS = 173 * MiB;
constexpr size_t WS_ROWL = 181 * MiB;
constexpr size_t WS_TOPI = 189 * MiB, WS_TOPW = WS_TOPI + 512 * KiB;
constexpr size_t WS_ERANK = 185 * MiB;
constexpr size_t WS_WGUT = 190 * MiB;
constexpr size_t WS_WSGUT = 254 * MiB;
constexpr size_t WS_WINT = 255 * MiB;
constexpr size_t WS_WOUTT = 262 * MiB;
constexpr size_t WS_W1KT = 264 * MiB, WS_W1VT = 265 * MiB;
constexpr size_t WS_W2T = 266 * MiB;
constexpr size_t WS_RW = 267 * MiB;
constexpr size_t WS_XN = 268 * MiB;
constexpr size_t WS_H2 = WS_XN;
constexpr size_t WS_PROJ = 300 * MiB;
constexpr size_t WS_KSR = 412 * MiB, WS_KWR = 416 * MiB;
constexpr size_t WS_VST = 420 * MiB, WS_VWT = 424 * MiB;
constexpr size_t WS_KCMP = 428 * MiB, WS_VCMPT = WS_KCMP + 256 * KiB;
constexpr size_t WS_U = 429 * MiB, WS_DD = 445 * MiB;
constexpr size_t WS_MIX = 446 * MiB;
constexpr size_t WS_Y = 190 * MiB;
constexpr size_t WS_YS = 478 * MiB;
constexpr size_t WS_END = 512 * MiB;
constexpr size_t NV_H = 37 * MiB, NV_RSTD = 101 * MiB;
constexpr size_t NV_F = 37 * MiB, NV_ORAW = 69 * MiB, NV_OWIN = 101 * MiB, NV_KSR = 133 * MiB, NV_KWR = 141 * MiB, NV_PS = 149 * MiB, NV_SEL = 157 * MiB,
                 NV_HID = 158 * MiB, NV_KCMP = 160 * MiB, NV_VCMP = 160 * MiB + 512 * KiB, NV_CS = 161 * MiB, NV_SN = 161 * MiB + 512 * KiB, NV_QROT = 478 * MiB;
constexpr size_t NV_H2F = 300 * MiB, NV_LG = 364 * MiB, NV_RSTD2 = 368 * MiB;
constexpr size_t NV_ACT = 300 * MiB, NV_ACTS = 101 * MiB, NV_X3 = 446 * MiB, NV_RSTD3 = 510 * MiB;

__host__ __device__ __forceinline__ float bf2f(bf16_t v) { union { unsigned u; float f; } c; c.u = (unsigned)v << 16; return c.f; }
__host__ __device__ __forceinline__ bf16_t f2bf(float f) { union { unsigned u; float f; } c; c.f = f; unsigned u = c.u; return (bf16_t)((u + 0x7fffu + ((u >> 16) & 1u)) >> 16); }

namespace nv {
__device__ __forceinline__ float sigmoidf_(float z) { return 1.0f / (1.0f + expf(-z)); }
__device__ __forceinline__ float siluf_(float z) { return z * sigmoidf_(z); }
__device__ __forceinline__ float gelu_tanh(float z) { return 0.5f * z * (1.0f + tanhf(0.7978845608028654f * (z + 0.044715f * z * z * z))); }
__device__ __forceinline__ long gtid() { return (long)blockIdx.x * blockDim.x + threadIdx.x; }
#define PJ(row, col) bf2f(proj[(size_t)(row) * LDP + (col)])

__global__ void k_mod(const float* c, const float* w_ada, const float* b_ada, float* mod) {
    long i = gtid(); if (i >= BATCH * 6144) return; int b = (int)(i / 6144), n = (int)(i % 6144);
    float acc = b_ada[n];
    for (int k = 0; k < D; ++k) acc += siluf_(c[b * D + k]) * w_ada[(size_t)k * 6144 + n];
    mod[i] = acc;
}
__global__ void k_rowrstd(const float* x, float* rstd, int rows) {
    long r = gtid(); if (r >= rows) return; float s = 0.f;
    for (int k = 0; k < D; ++k) { float v = x[(size_t)r * D + k]; s += v * v; }
    rstd[r] = 1.0f / sqrtf(s / D + EPS);
}
__global__ void k_modnorm(const float* x, const float* rstd, const float* g, const float* mod, int sh_chunk, int sc_chunk, float* hf, bf16_t* hb) {
    long i = gtid(); if (i >= (long)T * D) return; int r = (int)(i / D), k = (int)(i % D), b = r / SEQ;
    float v = x[i] * rstd[r] * g[k] * (1.0f + mod[b * 6144 + sc_chunk * D + k]) + mod[b * 6144 + sh_chunk * D + k];
    if (hf) hf[i] = v; if (hb) hb[i] = f2bf(v);
}
__global__ void k_gemm_nn_bf(const float* A, int lda, const float* Bm, int ldb, bf16_t* C, int ldc, int M, int N, int K) {
    long i = gtid(); if (i >= (long)M * N) return; int m = (int)(i / N), n = (int)(i % N);
    float acc = 0.f; const float* a = A + (size_t)m * lda;
    for (int k = 0; k < K; ++k) acc += a[k] * Bm[(size_t)k * ldb + n];
    C[(size_t)m * ldc + n] = f2bf(acc);
}
__global__ void k_gemm_nn(const float* A, int lda, const float* Bm, int ldb, float* C, int ldc, int M, int N, int K) {
    long i = gtid(); if (i >= (long)M * N) return; int m = (int)(i / N), n = (int)(i % N);
    float acc = 0.f; const float* a = A + (size_t)m * lda;
    for (int k = 0; k < K; ++k) acc += a[k] * Bm[(size_t)k * ldb + n];
    C[(size_t)m * ldc + n] = acc;
}
__global__ void k_hgf(const bf16_t* proj, const float* lbl, float* F) {
    long i = gtid(); if (i >= (long)T * 512) return; int r = (int)(i / 512), j = (int)(i % 512);
    float l0 = lbl[j], l1 = lbl[512 + j]; float mx = fmaxf(l0, l1); float e0 = expf(l0 - mx), e1 = expf(l1 - mx); float lb = e0 / (e0 + e1);
    F[i] = lb + (1.0f - lb) * sigmoidf_(PJ(r, C_HF + j));
}
__global__ void __launch_bounds__(64) k_hgrn(const bf16_t* proj, const float* F, float* Oraw) {
    long i = gtid(); if (i >= BATCH * 4 * 128) return; int e = (int)(i % 128), h = (int)((i / 128) % 4), b = (int)(i / 512);
    float S[128];
#pragma unroll
    for (int d = 0; d < 128; ++d) S[d] = 0.f;
    for (int t = 0; t < SEQ; ++t) {
        size_t row = (size_t)b * SEQ + t; const bf16_t* p = proj + row * LDP; const float* f = F + row * 512 + h * 128;
        float v = bf2f(p[C_HI + h * 128 + e]), o = 0.f;
#pragma unroll
        for (int d = 0; d < 128; ++d) { float ff = f[d]; S[d] = ff * S[d] + (1.0f - ff) * v; o += S[d] * bf2f(p[C_HQ + h * 128 + d]); }
        Oraw[row * 512 + h * 128 + e] = o * 0.08838834764831845f;
    }
}
__global__ void k_hgnorm(const float* Oraw, const bf16_t* proj, const float* ng, bf16_t* mix) {
    long i = gtid(); if (i >= (long)T * 4) return; size_t row = (size_t)(i / 4); int h = (int)(i % 4);
    const float* o = Oraw + row * 512 + h * 128; float s = 0.f;
    for (int e = 0; e < 128; ++e) s += o[e] * o[e];
    float r = 1.0f / sqrtf(s / 128 + EPS);
    for (int e = 0; e < 128; ++e) mix[row * D + h * 128 + e] = f2bf(o[e] * r * ng[h * 128 + e] * siluf_(PJ(row, C_HGT + h * 128 + e)));
}
__global__ void k_cmp_hidden(const bf16_t* proj, int coloff, const float* pe, const float* w1, const float* b1, float* hid) {
    long i = gtid(); if (i >= (long)BATCH * 2 * NCMP * 256) return; int j = (int)(i % 256); long r = i / 256; int c = (int)(r % NCMP), g = (int)((r / NCMP) % 2), b = (int)(r / (NCMP * 2));
    float acc = b1[j];
    for (int l = 0; l < 32; ++l) { const bf16_t* p = proj + ((size_t)b * SEQ + 16 * c + l) * LDP + coloff + g * 64;
        for (int d = 0; d < 64; ++d) acc += (bf2f(p[d]) + pe[l * 64 + d]) * w1[(size_t)(l * 64 + d) * 256 + j]; }
    hid[i] = gelu_tanh(acc);
}
__global__ void k_cmp_out(const float* hid, const float* w2, float* out) {
    long i = gtid(); if (i >= (long)BATCH * 2 * NCMP * 64) return; int d = (int)(i % 64); long r = i / 64;
    float acc = 0.f; for (int j = 0; j < 256; ++j) acc += hid[r * 256 + j] * w2[j * 64 + d];
    out[i] = acc;
}
__global__ void k_rope_tab(float* cs, float* sn) {
    long i = gtid(); if (i >= (long)SEQ * 32) return; int pos = (int)(i / 32), k = (int)(i % 32);
    float inv = powf(10000.0f, -(float)k / 32.0f); float ang = (float)pos * inv; cs[i] = cosf(ang); sn[i] = sinf(ang);
}
__global__ void k_rope_apply(const bf16_t* proj, int coloff, int nh, const float* cs, const float* sn, float* dst) {
    long i = gtid(); if (i >= (long)T * nh * 32) return; int k = (int)(i % 32); int h = (int)((i / 32) % nh); size_t row = (size_t)(i / (32 * nh)); int pos = (int)(row % SEQ);
    float t1 = PJ(row, coloff + h * 64 + k), t2 = PJ(row, coloff + h * 64 + k + 32), co = cs[pos * 32 + k], si = sn[pos * 32 + k];
    dst[row * (nh * 64) + h * 64 + k] = t1 * co - t2 * si; dst[row * (nh * 64) + h * 64 + k + 32] = t2 * co + t1 * si;
}
__global__ void __launch_bounds__(64) k_cmp_attn(const bf16_t* proj, const float* kcmp, const float* vcmp, float* ocmp, float* PS) {
    long i = gtid(); if (i >= (long)BATCH * 2 * SEQ) return; int s = (int)(i % SEQ), g = (int)((i / SEQ) % 2), b = (int)(i / (2 * SEQ));
    size_t row = (size_t)b * SEQ + s; float* ps = PS + (size_t)i * 64;
    for (int j = 0; j < 64; ++j) ps[j] = 0.f;
    int ncv = s >= 31 ? (s - 31) / 16 + 1 : 0; if (ncv > NCMP) ncv = NCMP;
    const float* kc = kcmp + (size_t)(b * 2 + g) * NCMP * 64; const float* vc = vcmp + (size_t)(b * 2 + g) * NCMP * 64;
    for (int hh = 0; hh < 4; ++hh) {
        int head = g * 4 + hh;
        float q[64], o[64];
#pragma unroll
        for (int d = 0; d < 64; ++d) { q[d] = PJ(row, C_NQ + head * 64 + d); o[d] = 0.f; }
        float m = -3.0e38f, l = 0.f;
        for (int c = 0; c < ncv; ++c) { float sc = 0.f;
#pragma unroll
            for (int d = 0; d < 64; ++d) sc += q[d] * kc[c * 64 + d];
            sc *= 0.125f; float mn = fmaxf(m, sc); l = l * expf(m - mn) + expf(sc - mn); m = mn; }
        for (int c = 0; c < ncv; ++c) { float sc = 0.f;
#pragma unroll
            for (int d = 0; d < 64; ++d) sc += q[d] * kc[c * 64 + d];
            sc *= 0.125f; float p = expf(sc - m) / l;
#pragma unroll
            for (int d = 0; d < 64; ++d) o[d] += p * vc[c * 64 + d];
            int c0 = 16 * c, c1 = 16 * c + 32;
            for (int j = c0 / 64; j <= (c1 - 1) / 64 && j < NSB; ++j) { int lo = c0 > 64 * j ? c0 : 64 * j, hi = c1 < 64 * j + 64 ? c1 : 64 * j + 64; if (hi > lo) ps[j] += p * (float)(hi - lo) / 32.0f; } }
#pragma unroll
        for (int d = 0; d < 64; ++d) ocmp[row * 512 + head * 64 + d] = o[d];
    }
}
__global__ void k_select(const float* PS, unsigned* SEL) {
    long i = gtid(); if (i >= (long)BATCH * 2 * SEQ) return; int s = (int)(i % SEQ); const float* ps = PS + (size_t)i * 64; int cur = s / 64;
    unsigned m0 = 0, m1 = 0;
    for (int j = 0; j < NSB; ++j) {
        bool fj = (j == 0) || (j == cur) || (j == cur - 1); float sj = fj ? 1e30f : (j <= cur ? ps[j] : -1e30f);
        int rank = 0;
        for (int k = 0; k < NSB; ++k) { bool fk = (k == 0) || (k == cur) || (k == cur - 1); float sk = fk ? 1e30f : (k <= cur ? ps[k] : -1e30f); if (sk > sj || (sk == sj && k < j)) ++rank; }
        if (rank < NSEL && sj > -1e29f) { if (j < 32) m0 |= 1u << j; else m1 |= 1u << (j - 32); }
    }
    SEL[i * 2] = m0; SEL[i * 2 + 1] = m1;
}
__global__ void __launch_bounds__(64) k_attn_naive(const float* qrot, const float* krot, const bf16_t* proj, int vcol, const unsigned* SEL, int mode, float* out) {
    long i = gtid(); if (i >= (long)BATCH * 8 * SEQ) return; int s = (int)(i % SEQ), head = (int)((i / SEQ) % 8), b = (int)(i / (8 * SEQ)); int g = head / 4;
    size_t row = (size_t)b * SEQ + s; float q[64], o[64];
#pragma unroll
    for (int d = 0; d < 64; ++d) { q[d] = qrot[row * 512 + head * 64 + d]; o[d] = 0.f; }
    float m = -3.0e38f, l = 0.f;
    unsigned m0 = 0, m1 = 0; if (mode == 0) { size_t si = ((size_t)(b * 2 + g) * SEQ + s) * 2; m0 = SEL[si]; m1 = SEL[si + 1]; }
    int k0 = mode == 0 ? 0 : (s - 511 > 0 ? s - 511 : 0);
    for (int key = k0; key <= s; ++key) {
        if (mode == 0) { int j = key / 64; bool sel = j < 32 ? ((m0 >> j) & 1u) : ((m1 >> (j - 32)) & 1u); if (!sel) { key = j * 64 + 63; continue; } }
        size_t kr = (size_t)b * SEQ + key; const float* kp = krot + kr * 128 + g * 64;
        float sc = 0.f;
#pragma unroll
        for (int d = 0; d < 64; ++d) sc += q[d] * kp[d];
        sc *= 0.125f; float mn = fmaxf(m, sc), a = expf(m - mn), p = expf(sc - mn); l = l * a + p; m = mn;
#pragma unroll
        for (int d = 0; d < 64; ++d) o[d] = o[d] * a + p * PJ(kr, vcol + g * 64 + d);
    }
#pragma unroll
    for (int d = 0; d < 64; ++d) out[row * 512 + head * 64 + d] = o[d] / l;
}
__global__ void k_nsa_combine(const bf16_t* proj, const float* ocmp, const float* oslc, const float* owin, bf16_t* mix) {
    long i = gtid(); if (i >= (long)T * 512) return; size_t row = (size_t)(i / 512); int c = (int)(i % 512), head = c / 64;
    mix[row * D + 512 + c] = f2bf(sigmoidf_(PJ(row, C_NG + head * 3)) * ocmp[i] + sigmoidf_(PJ(row, C_NG + head * 3 + 1)) * oslc[i] + sigmoidf_(PJ(row, C_NG + head * 3 + 2)) * owin[i]);
}
__global__ void k_proj_res(const bf16_t* A, const float* W, const float* x, const float* mod, int chunk, float* out) {
    long i = gtid(); if (i >= (long)T * D) return; int r = (int)(i / D), n = (int)(i % D), b = r / SEQ;
    float acc = 0.f; const bf16_t* a = A + (size_t)r * D;
    for (int k = 0; k < D; ++k) acc += bf2f(a[k]) * W[(size_t)k * D + n];
    out[i] = x[i] + mod[b * 6144 + chunk * D + n] * acc;
}
__global__ void __launch_bounds__(64) k_route(const float* LG, const float* bias, int* TOPI, float* TOPW) {
    long t = gtid(); if (t >= T) return; const float* lg = LG + (size_t)t * 64;
    float gs[8];
#pragma unroll
    for (int gI = 0; gI < 8; ++gI) { float a = -3e38f, b2 = -3e38f;
        for (int e = 0; e < 8; ++e) { float ch = sigmoidf_(lg[gI * 8 + e]) + bias[gI * 8 + e]; if (ch > a) { b2 = a; a = ch; } else if (ch > b2) b2 = ch; }
        gs[gI] = a + b2; }
    unsigned gmask = 0;
#pragma unroll
    for (int gI = 0; gI < 8; ++gI) { int rank = 0;
#pragma unroll
        for (int k = 0; k < 8; ++k) if (gs[k] > gs[gI] || (gs[k] == gs[gI] && k < gI)) ++rank;
        if (rank < 4) gmask |= 1u << gI; }
    int n = 0; float wsum = 0.f;
    for (int e = 0; e < 64; ++e) { if (!((gmask >> (e / 8)) & 1u)) continue; float se = sigmoidf_(lg[e]), ce = se + bias[e]; int rank = 0;
        for (int k = 0; k < 64; ++k) { if (!((gmask >> (k / 8)) & 1u)) continue; float ck = sigmoidf_(lg[k]) + bias[k]; if (ck > ce || (ck == ce && k < e)) ++rank; }
        if (rank < 8 && n < 8) { TOPI[t * 8 + n] = e; TOPW[t * 8 + n] = se; wsum += se; ++n; } }
    for (int k = 0; k < 8; ++k) TOPW[t * 8 + k] = TOPW[t * 8 + k] / wsum * 2.5f;
}
__global__ void k_moe_act(const bf16_t* h2, const float* Wgu, const int* TOPI, float* ACT, long nA) {
    long i = gtid(); if (i >= nA * 256) return; long a = i / 256; int j = (int)(i % 256); long t = TOPI ? a / 8 : a; int e = TOPI ? TOPI[a] : 0;
    const bf16_t* hp = h2 + (size_t)t * D; const float* w = Wgu + (size_t)e * D * 512; float gq = 0.f, u = 0.f;
    for (int k = 0; k < D; ++k) { float hv = bf2f(hp[k]); gq += hv * w[(size_t)k * 512 + j]; u += hv * w[(size_t)k * 512 + 256 + j]; }
    ACT[i] = siluf_(gq) * u;
}
__global__ void k_moe_out(const float* ACT, const float* ACTS, const float* Wdn, const float* Wsd, const int* TOPI, const float* TOPW, const float* x2, const float* mod, float* x3) {
    long i = gtid(); if (i >= (long)T * D) return; long t = i / D; int n = (int)(i % D), b = (int)(t / SEQ);
    float acc = 0.f;
    for (int sl = 0; sl < 8; ++sl) { int e = TOPI[t * 8 + sl]; const float* a = ACT + (size_t)(t * 8 + sl) * 256; const float* w = Wdn + (size_t)e * 256 * D; float y = 0.f;
        for (int k = 0; k < 256; ++k) y += a[k] * w[(size_t)k * D + n];
        acc += TOPW[t * 8 + sl] * y; }
    { const float* a = ACTS + (size_t)t * 256; float y = 0.f; for (int k = 0; k < 256; ++k) y += a[k] * Wsd[(size_t)k * D + n]; acc += y; }
    x3[i] = x2[i] + mod[b * 6144 + 5 * D + n] * acc;
}
__global__ void k_final(const float* x3, const float* rstd, const float* g, float* out) {
    long i = gtid(); if (i >= (long)T * D) return; out[i] = x3[i] * rstd[i / D] * g[i % D];
}
#undef PJ

struct In { const float *x, *c, *w_ada, *b_ada, *n1g, *w_in, *lbl, *hng, *pek, *w1k, *b1k, *w2k, *pev, *w1v, *b1v, *w2v, *w_out, *n2g, *rw, *rb, *wgu, *wdn, *wsgu, *wsdn, *fg;
    void set(void* const* d) { const float** p = (const float**)this; for (int i = 0; i < 25; ++i) p[i] = (const float*)d[i]; } };
#define NBK(n, tb) (((long)(n) + (tb) - 1) / (tb))
template <class Tp> static Tp* wsp(unsigned char* ws, size_t off) { return (Tp*)(ws + off); }
static void s1_naive(const In& I, unsigned char* ws, hipStream_t stream) {
    float* mod = wsp<float>(ws, WS_MOD); float* h = wsp<float>(ws, NV_H); float* rstd = wsp<float>(ws, NV_RSTD); bf16_t* proj = wsp<bf16_t>(ws, WS_PROJ);
    LAUNCH(k_mod, NBK(BATCH * 6144, 256), 256, I.c, I.w_ada, I.b_ada, mod);
    LAUNCH(k_rowrstd, NBK(T, 256), 256, I.x, rstd, T);
    LAUNCH(k_modnorm, NBK((long)T * D, 256), 256, I.x, rstd, I.n1g, mod, 0, 1, h, (bf16_t*)nullptr);
    LAUNCH(k_gemm_nn_bf, NBK((long)T * INC, 256), 256, h, D, I.w_in, INC, proj, LDP, T, INC, D);
}
static void s2_naive(const In& I, unsigned char* ws, hipStream_t stream, bool do_hg = true, bool do_nsa = true) {
    const bf16_t* proj = wsp<bf16_t>(ws, WS_PROJ); bf16_t* mix = wsp<bf16_t>(ws, WS_MIX);
    float *F = wsp<float>(ws, NV_F), *oraw = wsp<float>(ws, NV_ORAW), *owin = wsp<float>(ws, NV_OWIN), *ksr = wsp<float>(ws, NV_KSR), *kwr = wsp<float>(ws, NV_KWR), *PS = wsp<float>(ws, NV_PS);
    float *hid = wsp<float>(ws, NV_HID), *kcmp = wsp<float>(ws, NV_KCMP), *vcmp = wsp<float>(ws, NV_VCMP), *cs = wsp<float>(ws, NV_CS), *sn = wsp<float>(ws, NV_SN), *qrot = wsp<float>(ws, NV_QROT);
    unsigned* sel = wsp<unsigned>(ws, NV_SEL); float *ocmp = F, *oslc = oraw;
    if (do_hg) {
    LAUNCH(k_hgf, NBK((long)T * 512, 256), 256, proj, I.lbl, F);
    LAUNCH(k_hgrn, NBK(BATCH * 512, 64), 64, proj, F, oraw);
    LAUNCH(k_hgnorm, NBK((long)T * 4, 256), 256, oraw, proj, I.hng, mix);
    }
    if (!do_nsa) return;
    LAUNCH(k_cmp_hidden, NBK((long)BATCH * 2 * NCMP * 256, 256), 256, proj, C_KC, I.pek, I.w1k, I.b1k, hid);
    LAUNCH(k_cmp_out, NBK((long)BATCH * 2 * NCMP * 64, 256), 256, hid, I.w2k, kcmp);
    LAUNCH(k_cmp_hidden, NBK((long)BATCH * 2 * NCMP * 256, 256), 256, proj, C_VC, I.pev, I.w1v, I.b1v, hid);
    LAUNCH(k_cmp_out, NBK((long)BATCH * 2 * NCMP * 64, 256), 256, hid, I.w2v, vcmp);
    LAUNCH(k_rope_tab, NBK(SEQ * 32, 256), 256, cs, sn);
    LAUNCH(k_rope_apply, NBK((long)T * 8 * 32, 256), 256, proj, C_NQ, 8, cs, sn, qrot);
    LAUNCH(k_rope_apply, NBK((long)T * 2 * 32, 256), 256, proj, C_KS, 2, cs, sn, ksr);
    LAUNCH(k_rope_apply, NBK((long)T * 2 * 32, 256), 256, proj, C_KW, 2, cs, sn, kwr);
    LAUNCH(k_cmp_attn, NBK((long)BATCH * 2 * SEQ, 64), 64, proj, kcmp, vcmp, ocmp, PS);
    LAUNCH(k_select, NBK((long)BATCH * 2 * SEQ, 256), 256, PS, sel);
    LAUNCH(k_attn_naive, NBK((long)BATCH * 8 * SEQ, 64), 64, qrot, ksr, proj, C_VS, sel, 0, oslc);
    LAUNCH(k_attn_naive, NBK((long)BATCH * 8 * SEQ, 64), 64, qrot, kwr, proj, C_VW, sel, 1, owin);
    LAUNCH(k_nsa_combine, NBK((long)T * 512, 256), 256, proj, ocmp, oslc, owin, mix);
}
static void s3_naive(const In& I, unsigned char* ws, hipStream_t stream) {
    LAUNCH(k_proj_res, NBK((long)T * D, 256), 256, wsp<bf16_t>(ws, WS_MIX), I.w_out, I.x, wsp<float>(ws, WS_MOD), 2, wsp<float>(ws, WS_X2));
}
static void s4_naive(const In& I, unsigned char* ws, hipStream_t stream) {
    float *x2 = wsp<float>(ws, WS_X2), *rstd = wsp<float>(ws, NV_RSTD2), *h2f = wsp<float>(ws, NV_H2F), *lg = wsp<float>(ws, NV_LG), *mod = wsp<float>(ws, WS_MOD);
    LAUNCH(k_rowrstd, NBK(T, 256), 256, x2, rstd, T);
    LAUNCH(k_modnorm, NBK((long)T * D, 256), 256, x2, rstd, I.n2g, mod, 3, 4, h2f, wsp<bf16_t>(ws, WS_H2));
    LAUNCH(k_gemm_nn, NBK((long)T * 64, 256), 256, h2f, D, I.rw, 64, lg, 64, T, 64, D);
    LAUNCH(k_route, NBK(T, 64), 64, lg, I.rb, wsp<int>(ws, WS_TOPI), wsp<float>(ws, WS_TOPW));
}
static void s5_naive(const In& I, unsigned char* ws, float* out, hipStream_t stream) {
    float *act = wsp<float>(ws, NV_ACT), *acts = wsp<float>(ws, NV_ACTS), *x3 = wsp<float>(ws, NV_X3), *rstd = wsp<float>(ws, NV_RSTD3);
    const bf16_t* h2 = wsp<bf16_t>(ws, WS_H2); const int* topi = wsp<int>(ws, WS_TOPI);
    LAUNCH(k_moe_act, NBK((long)T * 8 * 256, 256), 256, h2, I.wgu, topi, act, (long)T * 8);
    LAUNCH(k_moe_act, NBK((long)T * 256, 256), 256, h2, I.wsgu, (const int*)nullptr, acts, (long)T);
    LAUNCH(k_moe_out, NBK((long)T * D, 256), 256, act, acts, I.wdn, I.wsdn, topi, wsp<float>(ws, WS_TOPW), wsp<float>(ws, WS_X2), wsp<float>(ws, WS_MOD), x3);
    LAUNCH(k_rowrstd, NBK(T, 256), 256, x3, rstd, T);
    LAUNCH(k_final, NBK((long)T * D, 256), 256, x3, rstd, I.fg, out);
}
}
#ifndef CPU_EMU
#define GAS __attribute__((address_space(1)))
#define LAS __attribute__((address_space(3)))
typedef unsigned v4u __attribute__((ext_vector_type(4)));
typedef unsigned v2u __attribute__((ext_vector_type(2)));
typedef float f32x4 __attribute__((ext_vector_type(4)));
typedef float f32x2 __attribute__((ext_vector_type(2)));
typedef float f32x16 __attribute__((ext_vector_type(16)));
typedef short bf16x8 __attribute__((ext_vector_type(8)));
typedef short bf16x4 __attribute__((ext_vector_type(4)));
typedef GAS unsigned gu32;
#define RLX_AGENT __ATOMIC_RELAXED, __HIP_MEMORY_SCOPE_AGENT
#define LDS_WAIT() asm volatile("s_waitcnt lgkmcnt(0)" ::: "memory")
#define VM_WAIT() asm volatile("s_waitcnt vmcnt(0)" ::: "memory")
constexpr int NWAVES = 8, NTHR = 512;
__device__ __forceinline__ unsigned pk2(float lo, float hi) { return (unsigned)f2bf(lo) | ((unsigned)f2bf(hi) << 16); }
__device__ __forceinline__ unsigned cvt_pk_bf16(float lo, float hi) { unsigned r; asm volatile("v_cvt_pk_bf16_f32 %0, %1, %2" : "=v"(r) : "v"(lo), "v"(hi)); return r; }
__device__ __forceinline__ float fexp2(float x) { return __builtin_amdgcn_exp2f(__builtin_amdgcn_fmed3f(x, -120.0f, 3.0e38f)); }
__device__ __forceinline__ float fexp(float x) { return __builtin_amdgcn_exp2f(fmaxf(x * 1.4426950408889634f, -120.0f)); }
__device__ __forceinline__ float fsigmoid(float z) { return 1.0f / (1.0f + __builtin_amdgcn_exp2f(fminf(fmaxf(-z * 1.4426950408889634f, -120.0f), 120.0f))); }
__device__ __forceinline__ float fsilu(float z) { return z / (1.0f + __builtin_amdgcn_exp2f(fminf(fmaxf(-z * 1.4426950408889634f, -120.0f), 120.0f))); }
__device__ __forceinline__ float wave_sum(float v) {
#pragma unroll
    for (int o = 1; o < 64; o <<= 1) v += __shfl_xor(v, o);
    return v;
}

#define XB_TMO      128
#define XB_XCNT(j)  (256  + 64 * (j))
#define XB_XSUB(j)  (1280 + 64 * (j))
#define XB_XGEN(j)  (2304 + 64 * (j))
#define XB_TOP      3328
#define XB_TOPGEN   3392
#define XCD_BAR_WORDS 3456
#define XB_SPIN_CAP (1u << 18)
__device__ __forceinline__ unsigned xb_ld(unsigned* p)              { return __hip_atomic_load(p, __ATOMIC_RELAXED, __HIP_MEMORY_SCOPE_AGENT); }
__device__ __forceinline__ unsigned xb_add(unsigned* p, unsigned v) { return __hip_atomic_fetch_add(p, v, __ATOMIC_RELAXED, __HIP_MEMORY_SCOPE_AGENT); }
__device__ __forceinline__ unsigned xb_xcc_id() { return (unsigned)__builtin_amdgcn_s_getreg((3 << 11) | 20) & 0xFu; }
#define XB_SPIN(cond, bar) do { unsigned _sp = 0; while (cond) { __builtin_amdgcn_s_sleep(1); \
    if ((++_sp & 255u) == 0u) { if (xb_ld(&(bar)[XB_TMO])) break; if (_sp > XB_SPIN_CAP) { atomicAdd(&(bar)[XB_TMO], 1u); break; } } } } while (0)
struct XcdBarrier { unsigned* bar; unsigned x; volatile LAS unsigned* st; };
__device__ __forceinline__ XcdBarrier xcd_barrier_post(unsigned* bar, volatile LAS unsigned* st) {
    XcdBarrier b; b.bar = bar; b.x = xb_xcc_id(); b.st = st;
    if (threadIdx.x == 0) (void)xb_add(&bar[XB_XCNT(b.x)], 1u);
    return b;
}
__device__ __forceinline__ void xcd_barrier_complete(unsigned* bar, unsigned x, unsigned& nloc, unsigned& nx) {
    const unsigned G = gridDim.x * gridDim.y * gridDim.z;
    unsigned sum, cnt, mine, sp = 0u;
    for (;;) {
        sum = 0u; cnt = 0u; mine = 0u;
#pragma unroll
        for (unsigned j = 0; j < 16; ++j) { const unsigned c = xb_ld(&bar[XB_XCNT(j)]); sum += c; cnt += (c > 0u) ? 1u : 0u; mine = (j == x) ? c : mine; }
        if (sum == G) break;
        __builtin_amdgcn_s_sleep(1);
        if ((++sp & 255u) == 0u) { if (xb_ld(&bar[XB_TMO])) break; if (sp > XB_SPIN_CAP) { atomicAdd(&bar[XB_TMO], 1u); break; } }
    }
    nloc = mine > 0u ? mine : 1u; nx = cnt > 0u ? cnt : 1u;
}
__device__ __forceinline__ void xcd_barrier(const XcdBarrier& b) {
    asm volatile("s_waitcnt vmcnt(0)" ::: "memory");
    __syncthreads();
    if (threadIdx.x == 0) {
        unsigned* bar = b.bar;
        __builtin_amdgcn_s_waitcnt(0);
        unsigned nloc = b.st[0], nx = b.st[1];
        if (nloc == 0u) { xcd_barrier_complete(bar, b.x, nloc, nx); b.st[0] = nloc; b.st[1] = nx; }
        const unsigned old = xb_add(&bar[XB_XSUB(b.x)], 1u);
        const unsigned gen = old / nloc;
        if (old + 1u == (gen + 1u) * nloc) {
            __builtin_amdgcn_fence(__ATOMIC_RELEASE, "agent");
            asm volatile("s_waitcnt vmcnt(0)" ::: "memory");
            const unsigned og = xb_add(&bar[XB_TOP], 1u);
            const unsigned tg = og / nx;
            if (og + 1u == (tg + 1u) * nx) xb_add(&bar[XB_TOPGEN], 1u);
            else XB_SPIN(xb_ld(&bar[XB_TOPGEN]) == tg, bar);
            __builtin_amdgcn_fence(__ATOMIC_ACQUIRE, "agent");
            xb_add(&bar[XB_XGEN(b.x)], 1u);
            asm volatile("s_waitcnt vmcnt(0)" ::: "memory");
        } else {
            XB_SPIN(xb_ld(&bar[XB_XGEN(b.x)]) == gen, bar);
            __builtin_amdgcn_fence(__ATOMIC_ACQUIRE, "agent");
            asm volatile("s_waitcnt vmcnt(0)" ::: "memory");
        }
    }
    __syncthreads();
}

namespace gm {
constexpr int BM = 256, BK = 64, HALF = 128, HTB = HALF * BK * 2, STAGE_BYTES = 8 * HTB, NXCD = 8, WGM = 8;
__host__ __device__ __forceinline__ int lds_byte(int r, int c) { const int st = (r >> 4) * 2 + (c >> 5), rr = r & 15, cc = c & 31, ob = rr * 64 + cc * 2; return st * 1024 + (ob ^ (((ob >> 9) & 1) << 5)); }
__host__ __device__ __forceinline__ void stage_rc(int b, int& R, int& C) { const int st = b / 1024, sb = b % 1024, swz = sb ^ (((sb >> 9) & 1) << 5); R = (st >> 1) * 16 + swz / 64; C = (st & 1) * 32 + (swz % 64) / 2; }
__host__ __device__ __forceinline__ int perm32(int rho) { const int n = rho >> 4, i = rho & 15; return 8 * (i >> 2) + 4 * n + (i & 3); }

struct Unit { int pm, pn; const char* A; const char* B; int e, m0; };

__device__ __forceinline__ bool static_tile(int nM, int nN, int G, int c, int i, int& pm, int& pn) {
    const int nwg = nM * nN; const long L = (long)i * G + c; if (L >= nwg) return false;
    int wgid = (int)L; { const int q = nwg / NXCD, r = nwg % NXCD, xcd = wgid % NXCD, off = wgid / NXCD; wgid = (xcd < r ? xcd * (q + 1) : r * (q + 1) + (xcd - r) * q) + off; }
    const int nig = WGM * nN, gid = wgid / nig, fm = gid * WGM, gsz = (nM - fm) < WGM ? (nM - fm) : WGM;
    pm = fm + ((wgid % nig) % gsz); pn = (wgid % nig) / gsz; return true;
}
struct DenseSched {
    const char* A; const char* Bt; int nM, nN, G, c; unsigned lda_b, K;
    __device__ __forceinline__ bool next(int i, Unit& u) const { int pm, pn; if (!static_tile(nM, nN, G, c, i, pm, pn)) return false; u.pm = pm; u.pn = pn; u.A = A + (size_t)pm * BM * lda_b; u.B = Bt + (size_t)pn * BM * K * 2; u.e = 0; u.m0 = 0; return true; }
    __device__ __forceinline__ unsigned arow(const Unit&, int r) const { return (unsigned)r * lda_b; }
};

template <class Epi, class Sched>
__device__ __forceinline__ void gemm_phase(LAS unsigned char* lds, const Sched& S, const Epi& E, const int K, const unsigned kstepA) {
    const int tid = threadIdx.x, wid = __builtin_amdgcn_readfirstlane(tid >> 6), lane = tid & 63, wr = wid >> 2, wc = wid & 3, fr = lane & 15, fq = lane >> 4;
    const int nt = K / BK;
    int R0, C0; stage_rc(tid * 16, R0, C0);
    unsigned voffB[2];
#pragma unroll
    for (int i = 0; i < 2; ++i) { const int R = R0 + 64 * i; const int Rb = Epi::PERM ? ((R & ~31) + perm32(R & 31)) : R; voffB[i] = (unsigned)(Rb * K + C0) * 2u; }
    const unsigned ca = (unsigned)C0 * 2u;
    const size_t kstepB = (size_t)(BK * 2);
    const size_t hstepB = (size_t)HALF * K * 2;
    const unsigned ldsw = (unsigned)wid * 1024u;
    const int aoff = lds_byte(wr * 64 + fr, fq * 8), boff = lds_byte(wc * 32 + fr, fq * 8);
#define GM_SA(b, h) (((b) * 2 + (h)) * HTB)
#define GM_SB(b, h) ((4 + (b) * 2 + (h)) * HTB)
#define GM_STAGEB(bufoff, gbase) do { _Pragma("unroll") for (int _i = 0; _i < 2; ++_i) \
        __builtin_amdgcn_global_load_lds((const unsigned*)((const char*)(gbase) + voffB[_i]), (LAS unsigned*)(lds + (bufoff) + ldsw + _i * 8192), 16, 0, 0); } while (0)
#define GM_STAGEA(bufoff, abase, offs, h, kb) do { _Pragma("unroll") for (int _i = 0; _i < 2; ++_i) \
        __builtin_amdgcn_global_load_lds((const unsigned*)((const char*)(abase) + (offs)[2 * (h) + _i] + (kb)), (LAS unsigned*)(lds + (bufoff) + ldsw + _i * 8192), 16, 0, 0); } while (0)
#define GM_LDA(dst, b, h) do { _Pragma("unroll") for (int m = 0; m < 4; ++m) _Pragma("unroll") for (int k = 0; k < 2; ++k) dst[m][k] = *(const LAS bf16x8*)(lds + GM_SA(b, h) + aoff + m * 2048 + k * 1024); } while (0)
#define GM_LDB(dst, b, h) do { _Pragma("unroll") for (int n = 0; n < 2; ++n) _Pragma("unroll") for (int k = 0; k < 2; ++k) dst[n][k] = *(const LAS bf16x8*)(lds + GM_SB(b, h) + boff + n * 2048 + k * 1024); } while (0)
#define GM_MMA(ai, bj, At, Bt) do { __builtin_amdgcn_s_setprio(1); _Pragma("unroll") for (int m = 0; m < 4; ++m) _Pragma("unroll") for (int n = 0; n < 2; ++n) _Pragma("unroll") for (int k = 0; k < 2; ++k) \
        acc[ai][bj][m][n] = __builtin_amdgcn_mfma_f32_16x16x32_bf16(Bt[n][k], At[m][k], acc[ai][bj][m][n], 0, 0, 0); __builtin_amdgcn_s_setprio(0); } while (0)
#define GM_WAIT_V(n) asm volatile("s_waitcnt vmcnt(" #n ")" ::: "memory")
#define GM_WAIT_L(n) asm volatile("s_waitcnt lgkmcnt(" #n ")" ::: "memory")
#define GM_BAR __builtin_amdgcn_s_barrier()
#define GM_SCHED __builtin_amdgcn_sched_barrier(0)
    Unit cur, nxt; int ui = 0;
    if (!S.next(0, cur)) return;
    unsigned coff[4], noff[4];
#pragma unroll
    for (int q = 0; q < 4; ++q) { coff[q] = S.arow(cur, R0 + 64 * q) + ca; noff[q] = coff[q]; }
    f32x4 acc[2][2][4][2];
#pragma unroll
    for (int a = 0; a < 2; ++a)
#pragma unroll
        for (int b = 0; b < 2; ++b)
#pragma unroll
            for (int m = 0; m < 4; ++m)
#pragma unroll
                for (int n = 0; n < 2; ++n) acc[a][b][m][n] = (f32x4){0.f, 0.f, 0.f, 0.f};
    bf16x8 At[4][2], B0[2][2], B1[2][2];
    const char* cA = cur.A; const char* cB = cur.B;
    GM_STAGEB(GM_SB(0, 0), cB); GM_STAGEB(GM_SB(0, 1), cB + hstepB); GM_STAGEA(GM_SA(0, 0), cA, coff, 0, 0u); GM_STAGEA(GM_SA(0, 1), cA, coff, 1, 0u);
    if (wr == 1) GM_BAR;
    GM_WAIT_V(2); GM_BAR;
    GM_STAGEB(GM_SB(1, 0), cB + kstepB); GM_STAGEA(GM_SA(1, 0), cA, coff, 0, kstepA); GM_STAGEB(GM_SB(1, 1), cB + hstepB + kstepB);
    GM_WAIT_V(6); GM_BAR;
    for (;;) {
        const bool has_next = S.next(ui + 1, nxt);
        const char* nA = has_next ? nxt.A : cA; const char* nB = has_next ? nxt.B : cB;
        if (has_next) {
#pragma unroll
            for (int q = 0; q < 4; ++q) noff[q] = S.arow(nxt, R0 + 64 * q) + ca;
        } else {
#pragma unroll
            for (int q = 0; q < 4; ++q) noff[q] = coff[q];
        }
#pragma unroll 1
        for (int t = 0; t < nt; t += 2) {
            const bool last = (t == nt - 2);
            const unsigned k1 = (unsigned)(t + 1) * kstepA;
            const char* a2 = last ? nA : cA; const unsigned k2 = last ? 0u : (unsigned)(t + 2) * kstepA, k3 = k2 + kstepA;
            unsigned o2[4];
#pragma unroll
            for (int q = 0; q < 4; ++q) o2[q] = last ? noff[q] : coff[q];
            const char* b2 = last ? nB : cB + (size_t)(t + 2) * kstepB; const char* b3 = b2 + kstepB;
            GM_LDB(B0, 0, 0); GM_LDB(B1, 0, 1); GM_SCHED; GM_LDA(At, 0, 0); GM_STAGEA(GM_SA(1, 1), cA, coff, 1, k1);
            GM_WAIT_V(8); GM_WAIT_L(0); GM_BAR; GM_MMA(0, 0, At, B0); GM_MMA(0, 1, At, B1); GM_BAR; GM_SCHED;
            GM_LDA(At, 0, 1); GM_STAGEB(GM_SB(0, 0), b2); GM_STAGEB(GM_SB(0, 1), b2 + hstepB); GM_STAGEA(GM_SA(0, 0), a2, o2, 0, k2);
            GM_WAIT_V(8); GM_WAIT_L(0); GM_BAR; GM_MMA(1, 0, At, B0); GM_MMA(1, 1, At, B1); GM_BAR; GM_SCHED;
            GM_LDB(B0, 1, 0); GM_LDB(B1, 1, 1); GM_SCHED; GM_LDA(At, 1, 0); GM_STAGEA(GM_SA(0, 1), a2, o2, 1, k2);
            GM_WAIT_V(8); GM_WAIT_L(0); GM_BAR; GM_MMA(0, 0, At, B0); GM_MMA(0, 1, At, B1); GM_BAR; GM_SCHED;
            GM_LDA(At, 1, 1); GM_STAGEB(GM_SB(1, 0), b3); GM_STAGEB(GM_SB(1, 1), b3 + hstepB); GM_STAGEA(GM_SA(1, 0), a2, o2, 0, k3);
            GM_WAIT_V(8); GM_WAIT_L(0); GM_BAR; GM_MMA(1, 0, At, B0); GM_MMA(1, 1, At, B1); GM_BAR; GM_SCHED;
        }
        if (wr == 0) GM_BAR;
        E(acc, cur, wr, wc, fr, fq);
        if (!has_next) break;
#pragma unroll
        for (int a = 0; a < 2; ++a)
#pragma unroll
            for (int b = 0; b < 2; ++b)
#pragma unroll
                for (int m = 0; m < 4; ++m)
#pragma unroll
                    for (int n = 0; n < 2; ++n) acc[a][b][m][n] = (f32x4){0.f, 0.f, 0.f, 0.f};
        cur = nxt; cA = nA; cB = nB; ++ui;
#pragma unroll
        for (int q = 0; q < 4; ++q) coff[q] = noff[q];
        if (wr == 1) GM_BAR;
    }
    GM_WAIT_V(0);
    GM_BAR;
#undef GM_SA
#undef GM_SB
#undef GM_STAGEA
#undef GM_STAGEB
#undef GM_LDA
#undef GM_LDB
#undef GM_MMA
#undef GM_WAIT_V
#undef GM_WAIT_L
#undef GM_BAR
#undef GM_SCHED
}

struct EpiBf16 {
    static constexpr bool PERM = true;
    bf16_t* O; int ldc;
    __device__ __forceinline__ void operator()(const f32x4 (&acc)[2][2][4][2], const Unit& u, int wr, int wc, int fr, int fq) const {
        const int row0 = u.pm * BM + wr * 64 + fr, col0 = u.pn * BM + wc * 32 + 8 * fq;
#pragma unroll
        for (int ai = 0; ai < 2; ++ai)
#pragma unroll
            for (int m = 0; m < 4; ++m) { bf16_t* rowp = O + (size_t)(row0 + ai * HALF + m * 16) * ldc + col0;
#pragma unroll
                for (int bj = 0; bj < 2; ++bj) { const f32x4 v0 = acc[ai][bj][m][0], v1 = acc[ai][bj][m][1];
                    v4u w; w.x = cvt_pk_bf16(v0[0], v0[1]); w.y = cvt_pk_bf16(v0[2], v0[3]); w.z = cvt_pk_bf16(v1[0], v1[1]); w.w = cvt_pk_bf16(v1[2], v1[3]);
                    *(v4u*)(rowp + bj * HALF) = w; } }
    }
};
struct EpiRes {
    static constexpr bool PERM = false;
    const float* x; const float* mod; int chunk; float* out;
    __device__ __forceinline__ void operator()(const f32x4 (&acc)[2][2][4][2], const Unit& u, int wr, int wc, int fr, int fq) const {
        const int row0 = u.pm * BM + wr * 64 + fr, col0 = u.pn * BM + wc * 32 + 4 * fq; const int b = (u.pm * BM) / SEQ;
        f32x4 gv[2][2];
#pragma unroll
        for (int bj = 0; bj < 2; ++bj)
#pragma unroll
            for (int n = 0; n < 2; ++n) gv[bj][n] = *(const f32x4*)(mod + (size_t)b * 6144 + chunk * 1024 + col0 + bj * HALF + n * 16);
#pragma unroll
        for (int ai = 0; ai < 2; ++ai)
#pragma unroll
            for (int m = 0; m < 4; ++m) { const size_t off = (size_t)(row0 + ai * HALF + m * 16) * 1024 + col0;
#pragma unroll
                for (int bj = 0; bj < 2; ++bj)
#pragma unroll
                    for (int n = 0; n < 2; ++n) { const f32x4 xv = *(const f32x4*)(x + off + bj * HALF + n * 16); *(f32x4*)(out + off + bj * HALF + n * 16) = xv + gv[bj][n] * acc[ai][bj][m][n]; } }
    }
};
}
#ifndef PROBE_REP
#define PROBE_REP -1
#endif
constexpr int RING_BYTES = 131072, LDSCTL_OFF = RING_BYTES, MISC_OFF = LDSCTL_OFF + 320, LDS_BYTES = 147456;
constexpr int CW_BAR = 4096;
constexpr int CW_ECNT = 65536;

struct Args { const float* in[25]; float* out; unsigned char* ws; int ph_lo, ph_hi, rep, pad; };
struct Frame {
    LAS unsigned char* lds; volatile LAS unsigned* MISC; unsigned* ctl; unsigned char* ws;
    int tid, lane, wave, vcu, G;
    const float* in[25]; float* out;
};
#define IN_X 0
#define IN_C 1
#define IN_WADA 2
#define IN_BADA 3
#define IN_N1G 4
#define IN_WIN 5
#define IN_LBL 6
#define IN_HNG 7
#define IN_PEK 8
#define IN_W1K 9
#define IN_B1K 10
#define IN_W2K 11
#define IN_PEV 12
#define IN_W1V 13
#define IN_B1V 14
#define IN_W2V 15
#define IN_WOUT 16
#define IN_N2G 17
#define IN_RW 18
#define IN_RB 19
#define IN_WGU 20
#define IN_WDN 21
#define IN_WSGU 22
#define IN_WSDN 23
#define IN_FG 24

template <bool FRAG = false> __device__ __forceinline__ void p0_transpose_item(const float* W, int K, int N, bf16_t* WT, int drow0, int k0, int n0, LAS float* scr, int lane) {
    const int kq = lane >> 3, nq = lane & 7; const int nn = n0 + 4 * nq; const bool ok = nn < N;
    f32x4 v[8];
#pragma unroll
    for (int i = 0; i < 8; ++i) v[i] = ok ? *(const f32x4*)(W + (size_t)(k0 + 8 * i + kq) * N + nn) : (f32x4){0.f, 0.f, 0.f, 0.f};
#pragma unroll
    for (int i = 0; i < 8; ++i) { LAS float* d = scr + (8 * i + kq) * 33 + 4 * nq; d[0] = v[i][0]; d[1] = v[i][1]; d[2] = v[i][2]; d[3] = v[i][3]; }
    LDS_WAIT(); asm volatile("" ::: "memory");
    const int c = lane & 7;
#pragma unroll
    for (int j = 0; j < 4; ++j) { const int n = (lane >> 3) + 8 * j; const LAS float* s = scr + (8 * c) * 33 + n;
        v4u o; o.x = pk2(s[0 * 33], s[1 * 33]); o.y = pk2(s[2 * 33], s[3 * 33]); o.z = pk2(s[4 * 33], s[5 * 33]); o.w = pk2(s[6 * 33], s[7 * 33]);
        if (FRAG) { const int kk = k0 + 8 * c, col = drow0 + n; *(v4u*)(WT + ((size_t)((kk >> 5) * (N / 16) + (col >> 4)) * 64 + ((kk & 31) >> 3) * 16 + (col & 15)) * 8) = o; }
        else *(v4u*)(WT + (size_t)(drow0 + n) * K + k0 + 8 * c) = o; }
    LDS_WAIT(); asm volatile("" ::: "memory");
}
__device__ __forceinline__ int gu_row(int n) { const int j = n & 255; return (j >> 7) * 256 + ((n >> 8) << 7) + (j & 127); }

__device__ __forceinline__ void p0_prologue(Frame& F) {
    unsigned char* ws = F.ws;
    if (F.vcu < 256) {
        LAS float* ca = (LAS float*)F.lds;
        const int ks = F.vcu >> 4, cg = F.vcu & 15;
        if (F.tid < 256) { const int b = F.tid >> 6, k = F.tid & 63; ca[F.tid] = fsilu(F.in[IN_C][b * D + ks * 64 + k]); }
        __syncthreads();
        if (F.tid < 384) { const int n = cg * 384 + F.tid; const float* w = F.in[IN_WADA] + (size_t)(ks * 64) * 6144 + n; float a0 = 0.f, a1 = 0.f, a2 = 0.f, a3 = 0.f;
#pragma unroll 8
            for (int k = 0; k < 64; ++k) { const float wv = w[(size_t)k * 6144]; a0 += ca[k] * wv; a1 += ca[64 + k] * wv; a2 += ca[128 + k] * wv; a3 += ca[192 + k] * wv; }
            float* mp = (float*)(ws + WS_MODP) + (size_t)ks * 4 * 6144 + n; mp[0] = a0; mp[6144] = a1; mp[2 * 6144] = a2; mp[3 * 6144] = a3; }
        __syncthreads();
    }
    { float* cs = (float*)(ws + WS_CS); float* sn = (float*)(ws + WS_SN);
      for (int i = F.vcu * NTHR + F.tid; i < SEQ * 32; i += F.G * NTHR) { const int pos = i >> 5, k = i & 31; const float inv = powf(10000.0f, -(float)k / 32.0f); const float ang = (float)pos * inv; cs[i] = cosf(ang); sn[i] = sinf(ang); } }
    LAS float* scr = (LAS float*)(F.lds + 4096 + F.wave * 8704);
    const int gw = F.vcu * NWAVES + F.wave, NGW = F.G * NWAVES;
    constexpr int I_IN = 16 * 105, I_OUT = 16 * 32, I_GU = 16 * 16, I_DN = 4 * 32, I_W1 = 32 * 8;
    constexpr int NIT = I_IN + I_OUT + 64 * I_GU + 64 * I_DN + I_GU + I_DN + 2 * I_W1;
    for (int it = gw; it < NIT; it += NGW) {
        int r = it;
        if (r < I_IN) { const int kb = r / 105, nb = r % 105; p0_transpose_item(F.in[IN_WIN], 1024, INC, (bf16_t*)(ws + WS_WINT), 32 * nb, 64 * kb, 32 * nb, scr, F.lane); continue; } r -= I_IN;
        if (r < I_OUT) { const int kb = r / 32, nb = r % 32; p0_transpose_item(F.in[IN_WOUT], 1024, 1024, (bf16_t*)(ws + WS_WOUTT), 32 * nb, 64 * kb, 32 * nb, scr, F.lane); continue; } r -= I_OUT;
        if (r < 64 * I_GU) { const int e = r / I_GU, q = r % I_GU, kb = q / 16, nb = q % 16;
            p0_transpose_item(F.in[IN_WGU] + (size_t)e * 1024 * 512, 1024, 512, (bf16_t*)(ws + WS_WGUT) + (size_t)e * 512 * 1024, gu_row(32 * nb), 64 * kb, 32 * nb, scr, F.lane); continue; } r -= 64 * I_GU;
        if (r < 64 * I_DN) { const int e = r / I_DN, q = r % I_DN, kb = q / 32, nb = q % 32;
            p0_transpose_item(F.in[IN_WDN] + (size_t)e * 256 * 1024, 256, 1024, (bf16_t*)(ws + WS_WDNT) + (size_t)e * 1024 * 256, 32 * nb, 64 * kb, 32 * nb, scr, F.lane); continue; } r -= 64 * I_DN;
        if (r < I_GU) { const int kb = r / 16, nb = r % 16; p0_transpose_item(F.in[IN_WSGU], 1024, 512, (bf16_t*)(ws + WS_WSGUT), gu_row(32 * nb), 64 * kb, 32 * nb, scr, F.lane); continue; } r -= I_GU;
        if (r < I_DN) { const int kb = r / 32, nb = r % 32; p0_transpose_item(F.in[IN_WSDN], 256, 1024, (bf16_t*)(ws + WS_WSDNT), 32 * nb, 64 * kb, 32 * nb, scr, F.lane); continue; } r -= I_DN;
        { const int kv = r / I_W1, q = r % I_W1, kb = q / 8, nb = q % 8;
          p0_transpose_item<true>(F.in[kv ? IN_W1V : IN_W1K], 2048, 256, (bf16_t*)(ws + (kv ? WS_W1VT : WS_W1KT)), 32 * nb, 64 * kb, 32 * nb, scr, F.lane); }
    }
    { v4u* z = (v4u*)((bf16_t*)(ws + WS_WINT) + (size_t)3360 * 1024); const int n16 = 224 * 1024 * 2 / 16;
      for (int i = F.vcu * NTHR + F.tid; i < n16; i += F.G * NTHR) z[i] = (v4u){0u, 0u, 0u, 0u}; }
    { bf16_t* w2f = (bf16_t*)(ws + WS_W2T);
      for (int i = F.vcu * NTHR + F.tid; i < 2 * 256 * 64; i += F.G * NTHR) { const int kv = i >> 14, r = i & 16383, k = r >> 6, dd = r & 63; const float v = F.in[kv ? IN_W2V : IN_W2K][r];
          w2f[(size_t)kv * 16384 + ((size_t)((k >> 5) * 4 + (dd >> 4)) * 64 + ((k & 31) >> 3) * 16 + (dd & 15)) * 8 + (k & 7)] = f2bf(v); } }
    { bf16_t* hi = (bf16_t*)(ws + WS_RW); bf16_t* lo = hi + 64 * 1024; const float* rw = F.in[IN_RW];
      for (int i = F.vcu * NTHR + F.tid; i < 64 * 1024; i += F.G * NTHR) { const int k = i >> 6, e = i & 63; const float w = rw[i]; const bf16_t h = f2bf(w);
          const size_t o = ((size_t)((k >> 5) * 4 + (e >> 4)) * 64 + ((k & 31) >> 3) * 16 + (e & 15)) * 8 + (k & 7); hi[o] = h; lo[o] = f2bf(w - bf2f(h)); } }
}

__device__ __forceinline__ void p1a_norm(Frame& F) {
    unsigned char* ws = F.ws; const float* modp = (const float*)(ws + WS_MODP); const float* bada = F.in[IN_BADA];
    for (int i = F.vcu * NTHR + F.tid; i < BATCH * 6144; i += F.G * NTHR) { float a = bada[i % 6144];
#pragma unroll
        for (int ks = 0; ks < 16; ++ks) a += modp[(size_t)ks * 4 * 6144 + i];
        ((float*)(ws + WS_MOD))[i] = a; }
    for (int o = F.vcu * NWAVES + F.wave; o < 512; o += F.G * NWAVES) { const int kv = o >> 8, j = o & 255; const float* pe = F.in[kv ? IN_PEV : IN_PEK];
        const bf16_t* wf = (const bf16_t*)(ws + (kv ? WS_W1VT : WS_W1KT)); float a = 0.f;
#pragma unroll
        for (int i = 0; i < 4; ++i) { const int cid = F.lane + 64 * i, s = cid >> 2, q = cid & 3; const v4u wv = *(const v4u*)(wf + ((size_t)(s * 16 + (j >> 4)) * 64 + q * 16 + (j & 15)) * 8);
            const f32x4 p0 = *(const f32x4*)(pe + 32 * s + 8 * q), p1 = *(const f32x4*)(pe + 32 * s + 8 * q + 4);
            a += bf2f((bf16_t)(wv.x & 0xffff)) * p0[0] + bf2f((bf16_t)(wv.x >> 16)) * p0[1] + bf2f((bf16_t)(wv.y & 0xffff)) * p0[2] + bf2f((bf16_t)(wv.y >> 16)) * p0[3]
               + bf2f((bf16_t)(wv.z & 0xffff)) * p1[0] + bf2f((bf16_t)(wv.z >> 16)) * p1[1] + bf2f((bf16_t)(wv.w & 0xffff)) * p1[2] + bf2f((bf16_t)(wv.w >> 16)) * p1[3]; }
        a = wave_sum(a); if (F.lane == 0) ((float*)(ws + WS_B1F))[o] = a + F.in[kv ? IN_B1V : IN_B1K][j]; }
    LAS float* sh = (LAS float*)F.lds; LAS float* sc = sh + 1024;
    const float* g1 = F.in[IN_N1G]; const float* x = F.in[IN_X]; bf16_t* xn = (bf16_t*)(ws + WS_XN);
    for (int chunk = F.vcu; chunk < T / 64; chunk += F.G) {
        const int b = (chunk * 64) / SEQ;
        __syncthreads();
        for (int i = F.tid; i < 2048; i += NTHR) { const int col = i; float a = bada[col];
#pragma unroll
            for (int ks = 0; ks < 16; ++ks) a += modp[(size_t)(ks * 4 + b) * 6144 + col];
            sh[i] = a; }
        __syncthreads();
#pragma unroll 1
        for (int rr = 0; rr < 8; ++rr) {
            const int row = chunk * 64 + F.wave * 8 + rr; const f32x4* xr = (const f32x4*)(x + (size_t)row * D) + F.lane;
            f32x4 v[4]; float s = 0.f;
#pragma unroll
            for (int j = 0; j < 4; ++j) { v[j] = xr[64 * j]; s += (v[j].x * v[j].x + v[j].y * v[j].y) + (v[j].z * v[j].z + v[j].w * v[j].w); }
            const float rstd = 1.0f / sqrtf(wave_sum(s) * (1.0f / D) + EPS);
            unsigned long long* o8 = (unsigned long long*)(xn + (size_t)row * D) + F.lane;
#pragma unroll
            for (int j = 0; j < 4; ++j) { const int c0 = 4 * F.lane + 256 * j; const f32x4 g = *(const f32x4*)(g1 + c0);
                const float h0 = v[j].x * rstd * g.x * (1.0f + sc[c0]) + sh[c0], h1 = v[j].y * rstd * g.y * (1.0f + sc[c0 + 1]) + sh[c0 + 1];
                const float h2 = v[j].z * rstd * g.z * (1.0f + sc[c0 + 2]) + sh[c0 + 2], h3 = v[j].w * rstd * g.w * (1.0f + sc[c0 + 3]) + sh[c0 + 3];
                o8[64 * j] = (unsigned long long)pk2(h0, h1) | ((unsigned long long)pk2(h2, h3) << 32); }
        }
    }
    __syncthreads();
}


__device__ __forceinline__ float hg_lb(const float* lbl, int j) { return 1.0f / (1.0f + expf(lbl[512 + j] - lbl[j])); }
__device__ __forceinline__ void hg_passA(Frame& F, int unit) {
    unsigned char* ws = F.ws; const bf16_t* proj = (const bf16_t*)(ws + WS_PROJ); float* U = (float*)(ws + WS_U) + (size_t)unit * 16384; float* Dd = (float*)(ws + WS_DD) + (size_t)unit * 128;
    const int b = unit >> 6, h = (unit >> 4) & 3, J = unit & 15; const size_t tok0 = (size_t)b * SEQ + 256 * J;
    const int d = F.tid & 127, g = F.tid >> 7;
    LAS unsigned char* KT = F.lds; LAS unsigned char* VT = F.lds + 65536; LAS float* segtot = (LAS float*)(F.lds + LDSCTL_OFF + 512);
    const float lb = hg_lb(F.in[IN_LBL], h * 128 + d);
    const bf16_t* pf = proj + (tok0 + 64 * g) * LDP + C_HF + h * 128 + d; const bf16_t* pv = proj + (tok0 + 64 * g) * LDP + C_HI + h * 128 + d;
    __syncthreads();
    float fs[64]; unsigned short vraw[64];
#pragma unroll
    for (int s = 0; s < 64; ++s) { fs[s] = bf2f(pf[(size_t)s * LDP]); vraw[s] = pv[(size_t)s * LDP]; }
    float sum = 0.f;
#pragma unroll
    for (int s = 0; s < 64; ++s) { const float f = lb + (1.0f - lb) * fsigmoid(fs[s]); fs[s] = f; sum += __logf(f); }
    segtot[g * 128 + d] = sum;
    __syncthreads();
    float off = 0.f, Bt = 0.f;
#pragma unroll
    for (int k = 0; k < 4; ++k) { const float v = segtot[k * 128 + d]; Bt += v; if (k < g) off += v; }
    float run = off;
#pragma unroll
    for (int s8 = 0; s8 < 8; ++s8) { unsigned kk[4], vv[4];
#pragma unroll
        for (int i = 0; i < 4; ++i) { float kt[2];
#pragma unroll
            for (int j = 0; j < 2; ++j) { const int s = 8 * s8 + 2 * i + j; const float f = fs[s]; run += __logf(f); kt[j] = (1.0f - f) * fexp(Bt - run); }
            kk[i] = pk2(kt[0], kt[1]); vv[i] = (unsigned)vraw[8 * s8 + 2 * i] | ((unsigned)vraw[8 * s8 + 2 * i + 1] << 16); }
        const int c = (8 * g + s8) ^ (d & 31);
        *(LAS v4u*)(KT + d * 512 + c * 16) = (v4u){kk[0], kk[1], kk[2], kk[3]}; *(LAS v4u*)(VT + d * 512 + c * 16) = (v4u){vv[0], vv[1], vv[2], vv[3]}; }
    if (g == 0) Dd[d] = fexp(Bt);
    __syncthreads();
    const int dt = F.wave >> 1, et0 = 2 * (F.wave & 1), i = F.lane & 31, hh = F.lane >> 5;
    f32x16 acc[2];
#pragma unroll
    for (int k = 0; k < 16; ++k) { acc[0][k] = 0.f; acc[1][k] = 0.f; }
#pragma unroll 4
    for (int st = 0; st < 16; ++st) { const int ch = 2 * st + hh;
        const bf16x8 a = *(const LAS bf16x8*)(KT + (32 * dt + i) * 512 + ((ch ^ i) & 31) * 16);
#pragma unroll
        for (int t = 0; t < 2; ++t) { const bf16x8 bv = *(const LAS bf16x8*)(VT + (32 * (et0 + t) + i) * 512 + ((ch ^ i) & 31) * 16);
            acc[t] = __builtin_amdgcn_mfma_f32_32x32x16_bf16(a, bv, acc[t], 0, 0, 0); } }
#pragma unroll
    for (int t = 0; t < 2; ++t)
#pragma unroll
        for (int r = 0; r < 16; ++r) U[(size_t)(32 * dt + (r & 3) + 8 * (r >> 2) + 4 * hh) * 128 + 32 * (et0 + t) + i] = acc[t][r];
    __syncthreads();
}
__device__ __forceinline__ void hg_passC(Frame& F, int unit) {
    unsigned char* ws = F.ws; const bf16_t* proj = (const bf16_t*)(ws + WS_PROJ); bf16_t* mix = (bf16_t*)(ws + WS_MIX);
    const float* Uall = (const float*)(ws + WS_U); const float* Dall = (const float*)(ws + WS_DD);
    const int b = unit >> 6, h = (unit >> 4) & 3, J = unit & 15; const size_t tok0 = (size_t)b * SEQ + 256 * J;
    const int w = F.wave, n = F.lane & 15, q = F.lane >> 4;
    LAS bf16_t* Qs = (LAS bf16_t*)F.lds; LAS bf16_t* Kh = Qs + 16 * 136; LAS bf16_t* Kt = Kh + 16 * 136; LAS bf16_t* Vt = Kt + 128 * 24;
    LAS float* G = (LAS float*)(Vt + 128 * 24); LAS float* TQ = G + 128; LAS float* SSP = TQ + 512;
    f32x4 S[8];
#pragma unroll
    for (int dt = 0; dt < 8; ++dt) S[dt] = (f32x4){0.f, 0.f, 0.f, 0.f};
    {
        LAS float* WJ = (LAS float*)F.lds;
        __syncthreads();
        if (F.tid < 128) { float wgt = 1.0f; for (int j = J - 1; j >= 0; --j) { WJ[j * 128 + F.tid] = wgt; wgt *= Dall[(size_t)(unit - J + j) * 128 + F.tid]; } }
        __syncthreads();
#pragma unroll 2
        for (int j = 0; j < J; ++j) { const float* Uj = Uall + (size_t)(unit - J + j) * 16384;
#pragma unroll
            for (int dt = 0; dt < 8; ++dt) { const f32x4 wv = *(const LAS f32x4*)(WJ + j * 128 + 16 * dt + 4 * q);
#pragma unroll
                for (int r = 0; r < 4; ++r) S[dt][r] += wv[r] * Uj[(size_t)(16 * dt + 4 * q + r) * 128 + 16 * w + n]; } }
        __syncthreads();
    }
    const int d = F.tid & 127, tq = F.tid >> 7; const float lb = hg_lb(F.in[IN_LBL], h * 128 + d);
    const float ngv0 = 0.f; (void)ngv0;
    unsigned short rf[4], rq[4], rv[4]; v2u rgate;
    const int e0 = h * 128 + 16 * w + 4 * q;
#pragma unroll
    for (int i = 0; i < 4; ++i) { const bf16_t* pr = proj + (tok0 + 4 * tq + i) * LDP + h * 128 + d; rf[i] = pr[C_HF]; rq[i] = pr[C_HQ]; rv[i] = pr[C_HI]; }
    rgate = *(const v2u*)(proj + (tok0 + n) * LDP + C_HGT + e0);
#pragma unroll 1
    for (int blk = 0; blk < 16; ++blk) {
        const size_t t0 = tok0 + 16 * blk;
        __syncthreads();
        float fv[4], lf[4], qv[4]; unsigned short vb[4]; float tot = 0.f;
#pragma unroll
        for (int i = 0; i < 4; ++i) { const float f = lb + (1.0f - lb) * fsigmoid(bf2f(rf[i])); fv[i] = f; tot += __logf(f); lf[i] = tot; qv[i] = bf2f(rq[i]) * 0.08838834764831845f; vb[i] = rv[i]; }
        const v2u gt = rgate;
        if (blk < 15) {
#pragma unroll
            for (int i = 0; i < 4; ++i) { const bf16_t* pr = proj + (t0 + 16 + 4 * tq + i) * LDP + h * 128 + d; rf[i] = pr[C_HF]; rq[i] = pr[C_HQ]; rv[i] = pr[C_HI]; }
            rgate = *(const v2u*)(proj + (t0 + 16 + n) * LDP + C_HGT + e0); }
        TQ[tq * 128 + d] = tot;
        __syncthreads();
        float off = 0.f, cc = 0.f;
#pragma unroll
        for (int k = 0; k < 4; ++k) { const float v = TQ[k * 128 + d]; cc += v; if (k < tq) off += v; }
        { unsigned kt2[2], v2[2];
#pragma unroll
          for (int i = 0; i < 4; ++i) { const float bt = off + lf[i]; const int t = 4 * tq + i; const float kf = 1.0f - fv[i];
              Qs[t * 136 + d] = f2bf(qv[i] * fexp(bt)); Kh[t * 136 + d] = f2bf(kf * fexp(-bt));
              const unsigned short kb = f2bf(kf * fexp(cc - bt));
              if (i & 1) { kt2[i >> 1] |= (unsigned)kb << 16; v2[i >> 1] |= (unsigned)vb[i] << 16; } else { kt2[i >> 1] = kb; v2[i >> 1] = vb[i]; } }
          *(LAS v2u*)(Kt + d * 24 + 4 * tq) = (v2u){kt2[0], kt2[1]}; *(LAS v2u*)(Vt + d * 24 + 4 * tq) = (v2u){v2[0], v2[1]}; }
        if (tq == 0) G[d] = fexp(cc);
        __syncthreads();
        f32x4 pt = (f32x4){0.f, 0.f, 0.f, 0.f};
#pragma unroll
        for (int st = 0; st < 4; ++st) { const bf16x8 a = *(const LAS bf16x8*)(Kh + n * 136 + 32 * st + 8 * q), bq = *(const LAS bf16x8*)(Qs + n * 136 + 32 * st + 8 * q);
            pt = __builtin_amdgcn_mfma_f32_16x16x32_bf16(a, bq, pt, 0, 0, 0); }
        bf16x8 pB;
#pragma unroll
        for (int r = 0; r < 4; ++r) { pB[r] = (short)f2bf((4 * q + r) <= n ? pt[r] : 0.f); pB[4 + r] = 0; }
        f32x4 o = (f32x4){0.f, 0.f, 0.f, 0.f};
#pragma unroll
        for (int st = 0; st < 4; ++st) { bf16x8 a, bq;
            const v2u s0 = (v2u){cvt_pk_bf16(S[2 * st][0], S[2 * st][1]), cvt_pk_bf16(S[2 * st][2], S[2 * st][3])}, s1 = (v2u){cvt_pk_bf16(S[2 * st + 1][0], S[2 * st + 1][1]), cvt_pk_bf16(S[2 * st + 1][2], S[2 * st + 1][3])};
            a = __builtin_bit_cast(bf16x8, (v4u){s0.x, s0.y, s1.x, s1.y});
            const v2u q0 = *(const LAS v2u*)(Qs + n * 136 + 32 * st + 4 * q), q1 = *(const LAS v2u*)(Qs + n * 136 + 32 * st + 16 + 4 * q);
            bq = __builtin_bit_cast(bf16x8, (v4u){q0.x, q0.y, q1.x, q1.y});
            o = __builtin_amdgcn_mfma_f32_16x16x32_bf16(a, bq, o, 0, 0, 0); }
        { const v2u va = *(const LAS v2u*)(Vt + (16 * w + n) * 24 + 4 * q); const bf16x8 a = __builtin_bit_cast(bf16x8, (v4u){va.x, va.y, 0u, 0u});
          o = __builtin_amdgcn_mfma_f32_16x16x32_bf16(a, pB, o, 0, 0, 0); }
        { bf16x8 bv; if (q < 2) bv = *(const LAS bf16x8*)(Vt + (16 * w + n) * 24 + 8 * q); else bv = (bf16x8){0, 0, 0, 0, 0, 0, 0, 0};
#pragma unroll
          for (int dt = 0; dt < 8; ++dt) { const f32x4 gv = *(const LAS f32x4*)(G + 16 * dt + 4 * q); S[dt] = S[dt] * gv;
              bf16x8 a; if (q < 2) a = *(const LAS bf16x8*)(Kt + (16 * dt + n) * 24 + 8 * q); else a = (bf16x8){0, 0, 0, 0, 0, 0, 0, 0};
              S[dt] = __builtin_amdgcn_mfma_f32_16x16x32_bf16(a, bv, S[dt], 0, 0, 0); } }
        float ss = (o[0] * o[0] + o[1] * o[1]) + (o[2] * o[2] + o[3] * o[3]); ss += __shfl_xor(ss, 16); ss += __shfl_xor(ss, 32);
        if (q == 0) SSP[w * 16 + n] = ss;
        __syncthreads();
        float tots = 0.f;
#pragma unroll
        for (int k = 0; k < 8; ++k) tots += SSP[k * 16 + n];
        const float rstd = 1.0f / sqrtf(tots * (1.0f / 128.0f) + EPS);
        const f32x4 ng = *(const f32x4*)(F.in[IN_HNG] + e0);
        const float g0 = bf2f((bf16_t)(gt.x & 0xffff)), g1 = bf2f((bf16_t)(gt.x >> 16)), g2 = bf2f((bf16_t)(gt.y & 0xffff)), g3 = bf2f((bf16_t)(gt.y >> 16));
        v2u ov; ov.x = cvt_pk_bf16(o[0] * rstd * ng[0] * fsilu(g0), o[1] * rstd * ng[1] * fsilu(g1)); ov.y = cvt_pk_bf16(o[2] * rstd * ng[2] * fsilu(g2), o[3] * rstd * ng[3] * fsilu(g3));
        *(v2u*)(mix + (t0 + n) * D + e0) = ov;
    }
    __syncthreads();
}

constexpr int LG_P = 65;
__device__ __forceinline__ void p5_router(Frame& F) {
    unsigned char* ws = F.ws; const float* x2 = (const float*)(ws + WS_X2); const float* mod = (const float*)(ws + WS_MOD); const float* g2 = F.in[IN_N2G];
    const bf16_t* rwh = (const bf16_t*)(ws + WS_RW); const bf16_t* rwl = rwh + 64 * 1024; bf16_t* H2 = (bf16_t*)(ws + WS_H2);
    int* TOPI = (int*)(ws + WS_TOPI); float* TOPW = (float*)(ws + WS_TOPW); int* ROWL = (int*)(ws + WS_ROWL); int* ERANK = (int*)(ws + WS_ERANK); unsigned* ECNT = F.ctl + CW_ECNT;
    LAS float* LG = (LAS float*)F.lds;
    LAS float* GS = LG + 64 * LG_P;
    LAS float* WSL = GS + 512;
    LAS int* EI = (LAS int*)(WSL + 512);
    LAS unsigned* LCNT = (LAS unsigned*)(EI + 512);
    LAS unsigned* LBASE = LCNT + 64;
    LAS float* GSL = (LAS float*)(LBASE + 64);
    LAS float* SHL = GSL + 1024;
    const int r = F.lane & 15, q = F.lane >> 4, rt = F.wave & 3, eh = F.wave >> 2;
    for (int unit = F.vcu; unit < T / 64; unit += F.G) {
        const int row0 = unit * 64, b = row0 / SEQ, row = row0 + 16 * rt + r;
        __syncthreads();
        if (F.tid < 64) LCNT[F.tid] = 0u;
        for (int k = F.tid; k < 1024; k += NTHR) { GSL[k] = g2[k] * (1.0f + mod[(size_t)b * 6144 + 4 * 1024 + k]); SHL[k] = mod[(size_t)b * 6144 + 3 * 1024 + k]; }
        const float* xr = x2 + (size_t)row * D + 8 * q;
        float ss = 0.f;
#pragma unroll 8
        for (int s = 0; s < 32; ++s) { const f32x4 a = *(const f32x4*)(xr + 32 * s), c = *(const f32x4*)(xr + 32 * s + 4); ss += (a.x * a.x + a.y * a.y) + (a.z * a.z + a.w * a.w) + (c.x * c.x + c.y * c.y) + (c.z * c.z + c.w * c.w); }
        ss += __shfl_xor(ss, 16); ss += __shfl_xor(ss, 32);
        const float rstd = 1.0f / sqrtf(ss * (1.0f / D) + EPS);
        __syncthreads();
#ifndef PROBE_R7
#define PROBE_R7 0
#endif
        f32x4 acc[2];
        for (int rep7_ = 0; rep7_ <= PROBE_R7; ++rep7_) {
        acc[0] = (f32x4){0.f, 0.f, 0.f, 0.f}; acc[1] = acc[0];
        const bf16_t* rwh0 = rwh + ((size_t)(2 * eh) * 64 + F.lane) * 8; const bf16_t* rwl0 = rwl + ((size_t)(2 * eh) * 64 + F.lane) * 8;
#pragma unroll 1
        for (int s4 = 0; s4 < 32; s4 += 4) {
            f32x4 xa[4][2]; bf16x8 bh[4][2], bl[4][2];
#pragma unroll
            for (int u = 0; u < 4; ++u) { const int s = s4 + u; xa[u][0] = *(const f32x4*)(xr + 32 * s); xa[u][1] = *(const f32x4*)(xr + 32 * s + 4);
                bh[u][0] = *(const bf16x8*)(rwh0 + (size_t)s * 2048); bl[u][0] = *(const bf16x8*)(rwl0 + (size_t)s * 2048); bh[u][1] = *(const bf16x8*)(rwh0 + (size_t)s * 2048 + 512); bl[u][1] = *(const bf16x8*)(rwl0 + (size_t)s * 2048 + 512); }
#pragma unroll
            for (int u = 0; u < 4; ++u) { const int s = s4 + u; float gv[8], sh[8];
                *(f32x4*)&gv[0] = *(const LAS f32x4*)(GSL + 32 * s + 8 * q); *(f32x4*)&gv[4] = *(const LAS f32x4*)(GSL + 32 * s + 8 * q + 4);
                *(f32x4*)&sh[0] = *(const LAS f32x4*)(SHL + 32 * s + 8 * q); *(f32x4*)&sh[4] = *(const LAS f32x4*)(SHL + 32 * s + 8 * q + 4);
                bf16x8 ahi, alo;
#pragma unroll
                for (int j = 0; j < 8; ++j) { const float h = xa[u][j >> 2][j & 3] * rstd * gv[j] + sh[j]; const bf16_t hb = f2bf(h); ahi[j] = (short)hb; alo[j] = (short)f2bf(h - bf2f(hb)); }
                if (eh == 0) *(bf16x8*)(H2 + (size_t)row * D + 32 * s + 8 * q) = ahi;
                acc[0] = __builtin_amdgcn_mfma_f32_16x16x32_bf16(ahi, bh[u][0], acc[0], 0, 0, 0); acc[0] = __builtin_amdgcn_mfma_f32_16x16x32_bf16(ahi, bl[u][0], acc[0], 0, 0, 0); acc[0] = __builtin_amdgcn_mfma_f32_16x16x32_bf16(alo, bh[u][0], acc[0], 0, 0, 0);
                acc[1] = __builtin_amdgcn_mfma_f32_16x16x32_bf16(ahi, bh[u][1], acc[1], 0, 0, 0); acc[1] = __builtin_amdgcn_mfma_f32_16x16x32_bf16(ahi, bl[u][1], acc[1], 0, 0, 0); acc[1] = __builtin_amdgcn_mfma_f32_16x16x32_bf16(alo, bh[u][1], acc[1], 0, 0, 0); }
        }
        }
#pragma unroll
        for (int nt = 0; nt < 2; ++nt)
#pragma unroll
            for (int i = 0; i < 4; ++i) LG[(16 * rt + 4 * q + i) * LG_P + 32 * eh + 16 * nt + r] = acc[nt][i];
        __syncthreads();
        const int t = F.tid >> 3, g = F.tid & 7; const float* rb = F.in[IN_RB];
        float sc8[8], ch8[8]; float a1 = -3e38f, a2 = -3e38f;
#pragma unroll
        for (int j = 0; j < 8; ++j) { const float s_ = 1.0f / (1.0f + expf(-LG[t * LG_P + 8 * g + j])); sc8[j] = s_; const float c_ = s_ + rb[8 * g + j]; ch8[j] = c_; if (c_ > a1) { a2 = a1; a1 = c_; } else if (c_ > a2) a2 = c_; }
        GS[t * 8 + g] = a1 + a2;
        __syncthreads();
#pragma unroll
        for (int j = 0; j < 8; ++j) LG[t * LG_P + 8 * g + j] = ch8[j];
        int grank = 0; const float myg = GS[t * 8 + g];
#pragma unroll
        for (int k = 0; k < 8; ++k) { const float o = GS[t * 8 + k]; if (o > myg || (o == myg && k < g)) ++grank; }
        const bool gsel = grank < 4;
        const unsigned long long bal = __ballot(gsel); const unsigned gmask = (unsigned)(bal >> (F.lane & ~7)) & 0xffu;
        __syncthreads();
        if (gsel) {
            int rk[8];
#pragma unroll
            for (int j = 0; j < 8; ++j) rk[j] = 0;
            for (int k = 0; k < 8; ++k) { if (!((gmask >> k) & 1u)) continue;
#pragma unroll
                for (int jj = 0; jj < 8; ++jj) { const float o = LG[t * LG_P + 8 * k + jj]; const int oe = 8 * k + jj;
#pragma unroll
                    for (int j = 0; j < 8; ++j) { if (o > ch8[j] || (o == ch8[j] && oe < 8 * g + j)) ++rk[j]; } } }
#pragma unroll
            for (int j = 0; j < 8; ++j) if (rk[j] < 8) { WSL[t * 8 + rk[j]] = sc8[j]; EI[t * 8 + rk[j]] = 8 * g + j; }
        }
        __syncthreads();
        float wsum = 0.f;
#pragma unroll
        for (int k = 0; k < 8; ++k) wsum += WSL[t * 8 + k];
        const int e = EI[t * 8 + g]; const float w = WSL[t * 8 + g] / wsum * 2.5f;
        const int aid = (row0 + t) * 8 + g;
        TOPI[aid] = e; TOPW[aid] = w;
        const unsigned lp = atomicAdd((unsigned*)&LCNT[e], 1u);
        __syncthreads();
        if (F.tid < 64) { const unsigned c = LCNT[F.tid]; LBASE[F.tid] = c ? atomicAdd(&ECNT[F.tid], c) : 0u; }
        __syncthreads();
        { const unsigned rk = LBASE[e] + lp; ROWL[(size_t)e * T + rk] = aid; ERANK[aid] = (int)rk; }
    }
    __syncthreads();
}


struct MoeTabs { LAS unsigned* cnt; LAS unsigned* tstart; LAS unsigned short* tex; int ntr; };
__device__ __forceinline__ MoeTabs moe_tabs_build(Frame& F) {
    MoeTabs Tb; Tb.cnt = (LAS unsigned*)(F.lds + LDSCTL_OFF + 512); Tb.tstart = Tb.cnt + 64; Tb.tex = (LAS unsigned short*)(Tb.tstart + 68);
    __syncthreads();
    if (F.tid < 64) { unsigned c = __hip_atomic_load(F.ctl + CW_ECNT + F.tid, RLX_AGENT); Tb.cnt[F.tid] = c > (unsigned)T ? (unsigned)T : c; }
    __syncthreads();
    if (F.tid == 0) { unsigned a = 0; for (int e = 0; e < 64; ++e) { Tb.tstart[e] = a; a += (Tb.cnt[e] + 255u) >> 8; } Tb.tstart[64] = a; }
    __syncthreads();
    Tb.ntr = (int)Tb.tstart[64];
    for (int tau = F.tid; tau < Tb.ntr; tau += NTHR) { int e = 0; for (int k = 0; k < 64; ++k) if (Tb.tstart[k] <= (unsigned)tau) e = k; Tb.tex[tau] = (unsigned short)e; }
    __syncthreads();
    return Tb;
}
__device__ __forceinline__ int xcd_chunk(int L, int n) { const int q = n / 8, r = n % 8, xcd = L % 8, off = L / 8; return (xcd < r ? xcd * (q + 1) : r * (q + 1) + (xcd - r) * q) + off; }
struct GateUpSched {
    MoeTabs Tb; const char* H2; const char* Wgu; const char* Wsgu; const int* rowl; int G, c;
    __device__ __forceinline__ bool next(int i, gm::Unit& u) const {
        const int nun = 2 * Tb.ntr + 2 * (T / 256); const long L = (long)i * G + c; if (L >= nun) return false;
        const int w = xcd_chunk((int)L, nun); u.A = H2;
        if (w < 2 * Tb.ntr) { const int tau = w >> 1; u.pn = w & 1; u.e = Tb.tex[tau]; u.m0 = 256 * (tau - (int)Tb.tstart[u.e]); u.pm = tau; u.B = Wgu + (size_t)u.e * 512 * 2048 + (size_t)u.pn * 256 * 2048; }
        else { const int s = w - 2 * Tb.ntr; u.pm = s >> 1; u.pn = s & 1; u.e = 64; u.m0 = 256 * u.pm; u.B = Wsgu + (size_t)u.pn * 256 * 2048; }
        return true;
    }
    __device__ __forceinline__ unsigned arow(const gm::Unit& u, int r) const {
        if (u.e == 64) return (unsigned)(u.m0 + r) * 2048u;
        const int idx = u.m0 + r; const int aid = idx < (int)Tb.cnt[u.e] ? rowl[(size_t)u.e * T + idx] : 0;
        return (unsigned)(aid >> 3) * 2048u;
    }
};
struct EpiSwiglu {
    static constexpr bool PERM = true;
    bf16_t* act; bf16_t* acts;
    __device__ __forceinline__ void operator()(const f32x4 (&acc)[2][2][4][2], const gm::Unit& u, int wr, int wc, int fr, int fq) const {
        bf16_t* O = (u.e == 64 ? acts : act) + (size_t)(u.pm * 256 + wr * 64 + fr) * 256 + 128 * u.pn + wc * 32 + 8 * fq;
#pragma unroll
        for (int ai = 0; ai < 2; ++ai)
#pragma unroll
            for (int m = 0; m < 4; ++m) { const f32x4 g0 = acc[ai][0][m][0], g1 = acc[ai][0][m][1], u0 = acc[ai][1][m][0], u1 = acc[ai][1][m][1];
                v4u w; w.x = cvt_pk_bf16(fsilu(g0[0]) * u0[0], fsilu(g0[1]) * u0[1]); w.y = cvt_pk_bf16(fsilu(g0[2]) * u0[2], fsilu(g0[3]) * u0[3]);
                w.z = cvt_pk_bf16(fsilu(g1[0]) * u1[0], fsilu(g1[1]) * u1[1]); w.w = cvt_pk_bf16(fsilu(g1[2]) * u1[2], fsilu(g1[3]) * u1[3]);
                *(v4u*)(O + (size_t)(ai * 128 + m * 16) * 256) = w; }
    }
};
struct DownSched {
    MoeTabs Tb; const char* act; const char* acts; const char* Wdn; const char* Wsdn; int G, c;
    __device__ __forceinline__ bool next(int i, gm::Unit& u) const {
        const int nun = 4 * Tb.ntr + 4 * (T / 256); const long L = (long)i * G + c; if (L >= nun) return false;
        const int w = xcd_chunk((int)L, nun);
        if (w < 4 * Tb.ntr) { const int tau = w >> 2; u.pn = w & 3; u.e = Tb.tex[tau]; u.m0 = 256 * (tau - (int)Tb.tstart[u.e]); u.pm = tau;
            u.A = act + (size_t)tau * 256 * 512; u.B = Wdn + (size_t)u.e * 1024 * 512 + (size_t)u.pn * 256 * 512; }
        else { const int s = w - 4 * Tb.ntr; u.pm = s >> 2; u.pn = s & 3; u.e = 64; u.m0 = 256 * u.pm; u.A = acts + (size_t)u.pm * 256 * 512; u.B = Wsdn + (size_t)u.pn * 256 * 512; }
        return true;
    }
    __device__ __forceinline__ unsigned arow(const gm::Unit&, int r) const { return (unsigned)r * 512u; }
};
typedef float f32x2_t __attribute__((ext_vector_type(2)));
__device__ __forceinline__ unsigned pk4_fp8(float a, float b, float c, float d) {
    a = fminf(fmaxf(a * 16.0f, -448.0f), 448.0f); b = fminf(fmaxf(b * 16.0f, -448.0f), 448.0f); c = fminf(fmaxf(c * 16.0f, -448.0f), 448.0f); d = fminf(fmaxf(d * 16.0f, -448.0f), 448.0f);
    int w = __builtin_amdgcn_cvt_pk_fp8_f32(a, b, 0, false); w = __builtin_amdgcn_cvt_pk_fp8_f32(c, d, w, true); return (unsigned)w;
}
struct EpiDown {
    static constexpr bool PERM = true;
    unsigned char* Y8; bf16_t* YS;
    __device__ __forceinline__ void operator()(const f32x4 (&acc)[2][2][4][2], const gm::Unit& u, int wr, int wc, int fr, int fq) const {
        const size_t off = (size_t)(u.pm * 256 + wr * 64 + fr) * 1024 + u.pn * 256 + wc * 32 + 8 * fq;
        if (u.e == 64) {
#pragma unroll
            for (int ai = 0; ai < 2; ++ai)
#pragma unroll
                for (int m = 0; m < 4; ++m)
#pragma unroll
                    for (int bj = 0; bj < 2; ++bj) { const f32x4 v0 = acc[ai][bj][m][0], v1 = acc[ai][bj][m][1];
                        v4u w; w.x = cvt_pk_bf16(v0[0], v0[1]); w.y = cvt_pk_bf16(v0[2], v0[3]); w.z = cvt_pk_bf16(v1[0], v1[1]); w.w = cvt_pk_bf16(v1[2], v1[3]);
                        *(v4u*)(YS + off + (size_t)(ai * 128 + m * 16) * 1024 + bj * 128) = w; }
        } else {
#pragma unroll
            for (int ai = 0; ai < 2; ++ai)
#pragma unroll
                for (int m = 0; m < 4; ++m)
#pragma unroll
                    for (int bj = 0; bj < 2; ++bj) { const f32x4 v0 = acc[ai][bj][m][0], v1 = acc[ai][bj][m][1];
                        *(v2u*)(Y8 + off + (size_t)(ai * 128 + m * 16) * 1024 + bj * 128) = (v2u){pk4_fp8(v0[0], v0[1], v0[2], v0[3]), pk4_fp8(v1[0], v1[1], v1[2], v1[3])}; }
        }
    }
};

__device__ __forceinline__ void p8_final(Frame& F) {
    unsigned char* ws = F.ws; const unsigned char* Y = (const unsigned char*)(ws + WS_Y); const bf16_t* YS = (const bf16_t*)(ws + WS_YS);
    const float* x2 = (const float*)(ws + WS_X2); const float* mod = (const float*)(ws + WS_MOD); const float* fg = F.in[IN_FG];
    const int* TOPI = (const int*)(ws + WS_TOPI); const float* TOPW = (const float*)(ws + WS_TOPW); const int* ERANK = (const int*)(ws + WS_ERANK);
    const MoeTabs Tb = moe_tabs_build(F);
    const int w = F.wave;
    for (int unit = F.vcu; unit < T / 64; unit += F.G) {
        const int row0 = unit * 64 + 8 * w, b = row0 / SEQ;
        const int aid = row0 * 8 + F.lane; const int e = TOPI[aid]; const float wl = TOPW[aid]; const unsigned prl = 256u * Tb.tstart[e] + (unsigned)ERANK[aid];
        v2u ybA[8]; v4u ysA; v2u ybB[8]; v4u ysB;
#define P10_LOAD(yb, ysb, rr_, sg_) do { const int t_ = row0 + (rr_); _Pragma("unroll") for (int sl = 0; sl < 8; ++sl) { const unsigned pr_ = (unsigned)__shfl((int)prl, (rr_) * 8 + sl); \
            yb[sl] = *(const v2u*)(Y + (size_t)pr_ * 1024 + (sg_) * 512 + 8 * F.lane); } \
            ysb = *(const v4u*)(YS + (size_t)t_ * 1024 + (sg_) * 512 + 8 * F.lane); } while (0)
#define P10_HALF(yb, ysb, rr_, sg_) do { const int t = row0 + (rr_); float moe[8]; \
            { const unsigned vw[4] = {ysb.x, ysb.y, ysb.z, ysb.w}; \
                _Pragma("unroll") for (int k = 0; k < 4; ++k) { moe[2 * k] = bf2f((bf16_t)(vw[k] & 0xffff)); moe[2 * k + 1] = bf2f((bf16_t)(vw[k] >> 16)); } } \
            _Pragma("unroll") for (int sl = 0; sl < 8; ++sl) { const float wgt = __shfl(wl, (rr_) * 8 + sl) * 0.0625f; \
                const f32x2_t d0 = __builtin_amdgcn_cvt_pk_f32_fp8((int)yb[sl].x, false), d1 = __builtin_amdgcn_cvt_pk_f32_fp8((int)yb[sl].x, true), d2 = __builtin_amdgcn_cvt_pk_f32_fp8((int)yb[sl].y, false), d3 = __builtin_amdgcn_cvt_pk_f32_fp8((int)yb[sl].y, true); \
                moe[0] += wgt * d0[0]; moe[1] += wgt * d0[1]; moe[2] += wgt * d1[0]; moe[3] += wgt * d1[1]; moe[4] += wgt * d2[0]; moe[5] += wgt * d2[1]; moe[6] += wgt * d3[0]; moe[7] += wgt * d3[1]; } \
            _Pragma("unroll") for (int h = 0; h < 2; ++h) { const int c0 = (sg_) * 512 + 8 * F.lane + 4 * h; \
                const f32x4 xv = *(const f32x4*)(x2 + (size_t)t * D + c0), gv = *(const f32x4*)(mod + (size_t)b * 6144 + 5 * 1024 + c0); \
                _Pragma("unroll") for (int j = 0; j < 4; ++j) { const float v = xv[j] + gv[j] * moe[4 * h + j]; x3[(sg_) * 8 + 4 * h + j] = v; ss += v * v; } } } while (0)
        P10_LOAD(ybA, ysA, 0, 0);
#pragma unroll 1
        for (int rr = 0; rr < 8; ++rr) {
            float x3[16]; float ss = 0.f;
            P10_LOAD(ybB, ysB, rr, 1);
            P10_HALF(ybA, ysA, rr, 0);
            if (rr < 7) P10_LOAD(ybA, ysA, rr + 1, 0);
            P10_HALF(ybB, ysB, rr, 1);
            const int t = row0 + rr;
            const float rstd = 1.0f / sqrtf(wave_sum(ss) * (1.0f / D) + EPS);
#pragma unroll
            for (int sg = 0; sg < 2; ++sg)
#pragma unroll
                for (int h = 0; h < 2; ++h) { const int c0 = sg * 512 + 8 * F.lane + 4 * h; const f32x4 gg = *(const f32x4*)(fg + c0); f32x4 o;
#pragma unroll
                    for (int j = 0; j < 4; ++j) o[j] = x3[sg * 8 + 4 * h + j] * rstd * gg[j];
                    *(f32x4*)(F.out + (size_t)t * D + c0) = o; }
        }
#undef P10_HALF
#undef P10_LOAD
    }
    __syncthreads();
}

__device__ __forceinline__ float fgelu_tanh(float z) { const float u = 0.7978845608028654f * (z + 0.044715f * z * z * z); const float e = __expf(2.0f * u); return 0.5f * z * (1.0f + (e - 1.0f) / (e + 1.0f)); }
__device__ __forceinline__ float fgelu_safe(float z) { const float u = 0.7978845608028654f * (z + 0.044715f * z * z * z); const float uc = fminf(fmaxf(u, -15.f), 15.f); const float e = fexp(2.0f * uc); return 0.5f * z * (1.0f + (e - 1.0f) / (e + 1.0f)); }

__device__ __forceinline__ void cmp_unit(Frame& F, int unit) {
    unsigned char* ws = F.ws; const bf16_t* proj = (const bf16_t*)(ws + WS_PROJ);
    const int kv = unit >> 6, mb = unit & 63; const bf16_t* W1T = (const bf16_t*)(ws + (kv ? WS_W1VT : WS_W1KT)); const int coloff = kv ? C_VC : C_KC;
    const float* b1f = (const float*)(ws + WS_B1F) + kv * 256;
    const int w = F.wave, n = F.lane & 15, q = F.lane >> 4;
    LAS bf16_t* HID = (LAS bf16_t*)F.lds;
    size_t base[2];
#pragma unroll
    for (int rt = 0; rt < 2; ++rt) { const int R = 32 * mb + 16 * rt + n, bg = R >> 8; int c = R & 255; if (c > 254) c = 254; base[rt] = ((size_t)(bg >> 1) * SEQ + 16 * c) * LDP + coloff + (bg & 1) * 64; }
    f32x4 acc[2][2];
#pragma unroll
    for (int rt = 0; rt < 2; ++rt)
#pragma unroll
        for (int ct = 0; ct < 2; ++ct) acc[rt][ct] = (f32x4){0.f, 0.f, 0.f, 0.f};
    __syncthreads();
#pragma unroll 8
    for (int s = 0; s < 64; ++s) { const int ltok = s >> 1, dd = 32 * (s & 1) + 8 * q; bf16x8 a[2], bb[2];
#pragma unroll
        for (int rt = 0; rt < 2; ++rt) a[rt] = *(const bf16x8*)(proj + base[rt] + (size_t)ltok * LDP + dd);
#pragma unroll
        for (int ct = 0; ct < 2; ++ct) bb[ct] = *(const bf16x8*)(W1T + ((size_t)(s * 16 + 2 * w + ct) * 64 + F.lane) * 8);
#pragma unroll
        for (int rt = 0; rt < 2; ++rt)
#pragma unroll
            for (int ct = 0; ct < 2; ++ct) acc[rt][ct] = __builtin_amdgcn_mfma_f32_16x16x32_bf16(bb[ct], a[rt], acc[rt][ct], 0, 0, 0); }
#pragma unroll
    for (int rt = 0; rt < 2; ++rt)
#pragma unroll
        for (int ct = 0; ct < 2; ++ct) { const int col = 32 * w + 16 * ct + 4 * q; const f32x4 bv = *(const f32x4*)(b1f + col); const f32x4 v = acc[rt][ct] + bv;
            v2u o; o.x = cvt_pk_bf16(fgelu_safe(v[0]), fgelu_safe(v[1])); o.y = cvt_pk_bf16(fgelu_safe(v[2]), fgelu_safe(v[3]));
            *(LAS v2u*)(HID + (16 * rt + n) * 264 + col) = o; }
    __syncthreads();
    { const int rt = w & 1, ct = w >> 1; f32x4 o = (f32x4){0.f, 0.f, 0.f, 0.f};
      const bf16_t* w2f = (const bf16_t*)(ws + WS_W2T) + (size_t)kv * 16384;
#pragma unroll
      for (int s = 0; s < 8; ++s) { const bf16x8 a = *(const LAS bf16x8*)(HID + (16 * rt + n) * 264 + 32 * s + 8 * q); const bf16x8 bw = *(const bf16x8*)(w2f + ((size_t)(s * 4 + ct) * 64 + F.lane) * 8);
          o = __builtin_amdgcn_mfma_f32_16x16x32_bf16(bw, a, o, 0, 0, 0); }
      const int R = 32 * mb + 16 * rt + n, bg = R >> 8, c = R & 255, d0 = 16 * ct + 4 * q;
      if (c == 255) o = (f32x4){0.f, 0.f, 0.f, 0.f};
      if (kv == 0) { v2u ov; ov.x = cvt_pk_bf16(o[0], o[1]); ov.y = cvt_pk_bf16(o[2], o[3]); *(v2u*)((bf16_t*)(ws + WS_KCMP) + ((size_t)bg * 256 + c) * 64 + d0) = ov; }
      else { bf16_t* vt = (bf16_t*)(ws + WS_VCMPT) + (size_t)bg * 64 * 256 + c;
#pragma unroll
          for (int r = 0; r < 4; ++r) vt[(size_t)(d0 + r) * 256] = f2bf(o[r]); } }
    __syncthreads();
}

__device__ __forceinline__ void kv_prep_unit(Frame& F, int unit) {
    unsigned char* ws = F.ws; const bf16_t* proj = (const bf16_t*)(ws + WS_PROJ); const float* cs = (const float*)(ws + WS_CS); const float* sn = (const float*)(ws + WS_SN);
    const int b = unit >> 6, tile = unit & 63; const size_t tok0 = (size_t)b * SEQ + 64 * tile;
#pragma unroll
    for (int it = 0; it < 2; ++it) { const int id = F.tid + 512 * it; const int c = id & 3, g = (id >> 2) & 1, wh = (id >> 3) & 1, tk = id >> 4; const int pos = 64 * tile + tk;
        const bf16_t* src = proj + (tok0 + tk) * LDP + (wh ? C_KW : C_KS) + g * 64 + 8 * c; const v4u lo = *(const v4u*)src, hi = *(const v4u*)(src + 32);
        const f32x4 c0 = *(const f32x4*)(cs + pos * 32 + 8 * c), c1 = *(const f32x4*)(cs + pos * 32 + 8 * c + 4), s0 = *(const f32x4*)(sn + pos * 32 + 8 * c), s1 = *(const f32x4*)(sn + pos * 32 + 8 * c + 4);
        float a[8], bb[8], co[8], si[8];
        const unsigned lw[4] = {lo.x, lo.y, lo.z, lo.w}, hw[4] = {hi.x, hi.y, hi.z, hi.w};
#pragma unroll
        for (int k = 0; k < 4; ++k) { a[2 * k] = bf2f((bf16_t)(lw[k] & 0xffff)); a[2 * k + 1] = bf2f((bf16_t)(lw[k] >> 16)); bb[2 * k] = bf2f((bf16_t)(hw[k] & 0xffff)); bb[2 * k + 1] = bf2f((bf16_t)(hw[k] >> 16)); co[k] = c0[k]; co[4 + k] = c1[k]; si[k] = s0[k]; si[4 + k] = s1[k]; }
        unsigned olp[4], ohp[4];
#pragma unroll
        for (int k = 0; k < 4; ++k) { olp[k] = pk2(a[2 * k] * co[2 * k] - bb[2 * k] * si[2 * k], a[2 * k + 1] * co[2 * k + 1] - bb[2 * k + 1] * si[2 * k + 1]);
            ohp[k] = pk2(bb[2 * k] * co[2 * k] + a[2 * k] * si[2 * k], bb[2 * k + 1] * co[2 * k + 1] + a[2 * k + 1] * si[2 * k + 1]); }
        bf16_t* dst = (bf16_t*)(ws + (wh ? WS_KWR : WS_KSR)) + (((size_t)(b * 2 + g) * SEQ) + pos) * 64 + 8 * c; *(v4u*)dst = (v4u){olp[0], olp[1], olp[2], olp[3]}; *(v4u*)(dst + 32) = (v4u){ohp[0], ohp[1], ohp[2], ohp[3]}; }
    LAS bf16_t* TL = (LAS bf16_t*)F.lds;
    v4u vin[4];
#pragma unroll
    for (int m = 0; m < 4; ++m) { const int wh = m >> 1, g = m & 1, tk = F.tid >> 3, c = F.tid & 7; vin[m] = *(const v4u*)(proj + (tok0 + tk) * LDP + (wh ? C_VW : C_VS) + g * 64 + 8 * c); }
#pragma unroll
    for (int m = 0; m < 4; ++m) { const int wh = m >> 1, g = m & 1;
        __syncthreads();
        { const int tk = F.tid >> 3, c = F.tid & 7; *(LAS v4u*)(TL + tk * 72 + 8 * c) = vin[m]; }
        __syncthreads();
        { const int d = F.tid >> 3, sc = F.tid & 7; unsigned short e[8];
#pragma unroll
          for (int i = 0; i < 8; ++i) e[i] = TL[(8 * sc + i) * 72 + d];
          v4u o; o.x = e[0] | ((unsigned)e[1] << 16); o.y = e[2] | ((unsigned)e[3] << 16); o.z = e[4] | ((unsigned)e[5] << 16); o.w = e[6] | ((unsigned)e[7] << 16);
          *(v4u*)((bf16_t*)(ws + (wh ? WS_VWT : WS_VST)) + ((size_t)(b * 2 + g) * 64 + d) * SEQ + 64 * tile + 8 * sc) = o; } }
    __syncthreads();
}

constexpr int ATT_VB = 32768, ATT_PSL = 65536, ATT_OUTA = 65536, ATT_SELM = LDSCTL_OFF + 512, ATT_UNI = ATT_SELM + 512, ATT_TL = ATT_UNI + 16, ATT_NT = ATT_TL + 80;
constexpr float ATT_QS = 0.125f * 1.4426950408889634f;
__device__ __forceinline__ int att_swz(int row, int c) { return row * 128 + ((c ^ ((row >> 1) & 7)) << 4); }
struct TileSrc { const bf16_t* K; int kpitch; const bf16_t* V; int vpitch; };
__device__ __forceinline__ void att_load(const TileSrc& s, int tid, v4u& kr, v4u& vr) { const int row = tid >> 3, c = tid & 7; kr = *(const v4u*)(s.K + (size_t)row * s.kpitch + 8 * c); vr = *(const v4u*)(s.V + (size_t)row * s.vpitch + 8 * c); }
__device__ __forceinline__ void att_store(LAS unsigned char* lds, int buf, int tid, const v4u& kr, const v4u& vr) {
    const int row = tid >> 3, c = tid & 7;
    *(LAS v4u*)(lds + buf * 8192 + att_swz(row, c)) = kr;
    const int s16 = c >> 1, half = c & 1;
    *(LAS v2u*)(lds + ATT_VB + buf * 8192 + att_swz(row, 2 * s16) + half * 8) = (v2u){vr.x, vr.y};
    *(LAS v2u*)(lds + ATT_VB + buf * 8192 + att_swz(row, 2 * s16 + 1) + half * 8) = (v2u){vr.z, vr.w};
}
__device__ __forceinline__ void att_qk(const LAS unsigned char* kb, const bf16x8 (&qf)[4], f32x16 (&s)[2], int i, int hh, const f32x16& ini0, const f32x16& ini1) {
    bf16x8 kf[2][4];
#pragma unroll
    for (int kt = 0; kt < 2; ++kt)
#pragma unroll
        for (int st = 0; st < 4; ++st) kf[kt][st] = *(const LAS bf16x8*)(kb + att_swz(32 * kt + i, 2 * st + hh));
    __builtin_amdgcn_s_setprio(1);
#pragma unroll
    for (int st = 0; st < 4; ++st)
#pragma unroll
        for (int kt = 0; kt < 2; ++kt) s[kt] = __builtin_amdgcn_mfma_f32_32x32x16_bf16(kf[kt][st], qf[st], st == 0 ? (kt ? ini1 : ini0) : s[kt], 0, 0, 0);
    __builtin_amdgcn_s_setprio(0);
}
__device__ __forceinline__ void att_vload(const LAS unsigned char* vb, bf16x8 (&vf)[4][2], int i, int hh) {
#pragma unroll
    for (int ks = 0; ks < 4; ++ks)
#pragma unroll
        for (int dt = 0; dt < 2; ++dt) vf[ks][dt] = *(const LAS bf16x8*)(vb + att_swz(32 * dt + i, 2 * ks + hh));
}
__device__ __forceinline__ void att_pv(const bf16x8 (&vf)[4][2], const f32x16 (&p)[2], f32x16 (&o)[2]) {
    __builtin_amdgcn_s_setprio(1);
#pragma unroll
    for (int kt = 0; kt < 2; ++kt)
#pragma unroll
        for (int s = 0; s < 2; ++s) { const v4u pb = (v4u){cvt_pk_bf16(p[kt][8 * s], p[kt][8 * s + 1]), cvt_pk_bf16(p[kt][8 * s + 2], p[kt][8 * s + 3]), cvt_pk_bf16(p[kt][8 * s + 4], p[kt][8 * s + 5]), cvt_pk_bf16(p[kt][8 * s + 6], p[kt][8 * s + 7])};
            const bf16x8 bf = __builtin_bit_cast(bf16x8, pb);
#pragma unroll
            for (int dt = 0; dt < 2; ++dt) o[dt] = __builtin_amdgcn_mfma_f32_32x32x16_bf16(vf[2 * kt + s][dt], bf, o[dt], 0, 0, 0); }
    __builtin_amdgcn_s_setprio(0);
}
__device__ __forceinline__ void att_ini(f32x16 (&ini)[2], bool uniform, float base, int lo, int hi, int hh) {
    if (uniform) {
#pragma unroll
        for (int r = 0; r < 16; ++r) ini[0][r] = base;
        ini[1] = ini[0];
    } else {
        const unsigned span = (unsigned)(hi - lo);
#pragma unroll
        for (int kt = 0; kt < 2; ++kt)
#pragma unroll
            for (int r = 0; r < 16; ++r) { const int kk = 32 * kt + (r & 3) + 8 * (r >> 2) + 4 * hh; ini[kt][r] = ((unsigned)(kk - lo) <= span && hi >= lo) ? base : -1e30f; }
    }
}
#define ATT_KEY(kt, r, hh) (32 * (kt) + ((r) & 3) + 8 * ((r) >> 2) + 4 * (hh))

__device__ __forceinline__ void att_unit(Frame& F, int unit) {
    unsigned char* ws = F.ws; const bf16_t* proj = (const bf16_t*)(ws + WS_PROJ); bf16_t* mix = (bf16_t*)(ws + WS_MIX);
    const int qb = unit & 63, bg = unit >> 6, b = bg >> 1, g = bg & 1;
    const int w = F.wave, i = F.lane & 31, hh = F.lane >> 5, head = i >> 3, tloc = i & 7, tt = 8 * w + tloc; const int pos = 64 * qb + tt; const size_t tok = (size_t)b * SEQ + pos;
    LAS unsigned char* lds = F.lds; LAS float* PSL = (LAS float*)(lds + ATT_PSL); LAS unsigned* SELM = (LAS unsigned*)(lds + ATT_SELM); LAS unsigned* UNI = (LAS unsigned*)(lds + ATT_UNI);
    LAS unsigned char* TL = lds + ATT_TL; LAS int* NTL = (LAS int*)(lds + ATT_NT);
    const bf16_t* kcmp = (const bf16_t*)(ws + WS_KCMP) + (size_t)bg * 256 * 64; const bf16_t* vcmpt = (const bf16_t*)(ws + WS_VCMPT) + (size_t)bg * 64 * 256;
    const bf16_t* ksr = (const bf16_t*)(ws + WS_KSR) + (size_t)bg * SEQ * 64; const bf16_t* vst = (const bf16_t*)(ws + WS_VST) + (size_t)bg * 64 * SEQ;
    const bf16_t* kwr = (const bf16_t*)(ws + WS_KWR) + (size_t)bg * SEQ * 64; const bf16_t* vwt = (const bf16_t*)(ws + WS_VWT) + (size_t)bg * 64 * SEQ;
    __syncthreads();
    for (int k = F.tid; k < 64 * 64; k += NTHR) PSL[k] = 0.f;
    if (F.tid < 2) UNI[F.tid] = 0u;
    bf16x8 qf[4];
    const bf16_t* qp = proj + tok * LDP + C_NQ + (4 * g + head) * 64 + 8 * hh;
    { float qraw[4][8];
#pragma unroll
      for (int st = 0; st < 4; ++st) { const v4u v = *(const v4u*)(qp + 16 * st); const unsigned vw[4] = {v.x, v.y, v.z, v.w};
#pragma unroll
          for (int k = 0; k < 4; ++k) { qraw[st][2 * k] = bf2f((bf16_t)(vw[k] & 0xffff)); qraw[st][2 * k + 1] = bf2f((bf16_t)(vw[k] >> 16)); } }
#pragma unroll
      for (int st = 0; st < 4; ++st) { const v4u o = (v4u){cvt_pk_bf16(qraw[st][0] * ATT_QS, qraw[st][1] * ATT_QS), cvt_pk_bf16(qraw[st][2] * ATT_QS, qraw[st][3] * ATT_QS), cvt_pk_bf16(qraw[st][4] * ATT_QS, qraw[st][5] * ATT_QS), cvt_pk_bf16(qraw[st][6] * ATT_QS, qraw[st][7] * ATT_QS)};
          qf[st] = __builtin_bit_cast(bf16x8, o); } }
    LAS float* OUTA = (LAS float*)(lds + ATT_OUTA) + (size_t)w * 32 * 64 + F.lane;
    const float* gl = nullptr; (void)gl;
    const float gate0 = fsigmoid(bf2f(proj[tok * LDP + C_NG + (4 * g + head) * 3 + 0])), gate1 = fsigmoid(bf2f(proj[tok * LDP + C_NG + (4 * g + head) * 3 + 1])), gate2 = fsigmoid(bf2f(proj[tok * LDP + C_NG + (4 * g + head) * 3 + 2]));
    v4u kr, vr; f32x16 s[2]; f32x16 ocmp[2];
#ifndef PROBE_ATT
#define PROBE_ATT 0
#endif
    for (int rep1_ = 0; rep1_ < (PROBE_ATT == 1 ? 2 : 1); ++rep1_) {
    const int ncu = (4 * qb + 3) < 255 ? (4 * qb + 3) : 255, ntile = (ncu + 63) >> 6;
    const int ncv = pos >= 31 ? ((pos - 31) >> 4) + 1 : 0;
    const int ncv_min = qb >= 1 ? 4 * qb - 1 : 0;
    float m = -1e30f, l = 0.f;
    {
        int cur = 0; { TileSrc ts{kcmp, 64, vcmpt, 256}; att_load(ts, F.tid, kr, vr); att_store(lds, 0, F.tid, kr, vr); }
        __syncthreads();
        for (int T_ = 0; T_ < ntile; ++T_) {
            const bool more = T_ + 1 < ntile;
            if (more) { TileSrc ts{kcmp + (size_t)(T_ + 1) * 64 * 64, 64, vcmpt + (T_ + 1) * 64, 256}; att_load(ts, F.tid, kr, vr); }
            { f32x16 ini[2]; att_ini(ini, 64 * T_ + 64 <= ncv_min, 0.f, 0, ncv - 1 - 64 * T_, hh); att_qk(lds + cur * 8192, qf, s, i, hh, ini[0], ini[1]); }
            float tm = -1e30f;
#pragma unroll
            for (int kt = 0; kt < 2; ++kt)
#pragma unroll
                for (int r = 0; r < 16; ++r) tm = fmaxf(tm, s[kt][r]);
            tm = fmaxf(tm, __shfl_xor(tm, 32));
            const float mn = fmaxf(m, tm); l *= fexp2(m - mn);
#pragma unroll
            for (int kt = 0; kt < 2; ++kt)
#pragma unroll
                for (int r = 0; r < 16; ++r) l += fexp2(s[kt][r] - mn);
            m = mn;
            if (more) att_store(lds, cur ^ 1, F.tid, kr, vr);
            __syncthreads(); cur ^= 1;
        }
        l += __shfl_xor(l, 32);
    }
    {
        const float rl = (ncv > 0 && l > 0.f) ? 1.0f / l : 0.f;
        f32x16 o[2];
#pragma unroll
        for (int k = 0; k < 16; ++k) { o[0][k] = 0.f; o[1][k] = 0.f; }
        float carry = 0.f;
        int cur = 0; { TileSrc ts{kcmp, 64, vcmpt, 256}; att_load(ts, F.tid, kr, vr); att_store(lds, 0, F.tid, kr, vr); }
        __syncthreads();
        for (int T_ = 0; T_ < ntile; ++T_) {
            const bool more = T_ + 1 < ntile;
            if (more) { TileSrc ts{kcmp + (size_t)(T_ + 1) * 64 * 64, 64, vcmpt + (T_ + 1) * 64, 256}; att_load(ts, F.tid, kr, vr); }
            bf16x8 vf[4][2];
            { f32x16 ini[2]; att_ini(ini, 64 * T_ + 64 <= ncv_min, -m, 0, ncv - 1 - 64 * T_, hh); att_qk(lds + cur * 8192, qf, s, i, hh, ini[0], ini[1]); }
            att_vload(lds + ATT_VB + cur * 8192, vf, i, hh);
#pragma unroll
            for (int kt = 0; kt < 2; ++kt)
#pragma unroll
                for (int r = 0; r < 16; ++r) s[kt][r] = fexp2(s[kt][r]) * rl;
            att_pv(vf, s, o);
            float ps[8];
#pragma unroll
            for (int kt = 0; kt < 2; ++kt)
#pragma unroll
                for (int gi = 0; gi < 4; ++gi) ps[4 * kt + gi] = (s[kt][4 * gi] + s[kt][4 * gi + 1]) + (s[kt][4 * gi + 2] + 0.5f * s[kt][4 * gi + 3]);
            float nc = 0.f;
#pragma unroll
            for (int sl = 0; sl < 8; ++sl) { const float x = 0.5f * s[sl >> 2][4 * (sl & 3) + 3]; const float y = __shfl_xor(x, 32);
                if (hh == 1) ps[sl] += y; else { if (sl < 7) ps[sl + 1] += y; else nc = y; } }
            if (hh == 0) { ps[0] += carry; carry = nc; }
#pragma unroll
            for (int sl = 0; sl < 8; ++sl) { float v = ps[sl]; v += __shfl_xor(v, 8); v += __shfl_xor(v, 16); ps[sl] = v; }
            if (head == 0) {
#pragma unroll
                for (int sl = 0; sl < 8; ++sl) PSL[tt * 64 + 16 * T_ + 2 * sl + hh] = ps[sl]; }
            if (more) att_store(lds, cur ^ 1, F.tid, kr, vr);
            __syncthreads(); cur ^= 1;
        }
#pragma unroll
        for (int dt = 0; dt < 2; ++dt)
#pragma unroll
            for (int k = 0; k < 16; ++k) ocmp[dt][k] = gate0 * o[dt][k];
    }
    __syncthreads();
#pragma unroll 1
    for (int tl = 0; tl < 8; ++tl) {
        const int t = 8 * w + tl, j = F.lane; const bool fj = (j == 0) || (j == qb) || (j == qb - 1);
        const unsigned key = fj ? 0xFFFFFFFFu : (j <= qb ? __float_as_uint(PSL[t * 64 + j]) + 1u : 0u);
        unsigned thr = 0u;
#pragma unroll 1
        for (int bit = 31; bit >= 0; --bit) { const unsigned cand = thr | (1u << bit); if (__popcll(__ballot(key >= cand)) >= NSEL) thr = cand; }
        const unsigned long long gt = __ballot(key > thr), eq = __ballot(key == thr); const int need = NSEL - __popcll(gt);
        const int below = __popcll(eq & ((1ull << j) - 1ull));
        const bool sel = (key > 0u) && ((key > thr) || (key == thr && below < need));
        const unsigned long long msk = __ballot(sel);
        if (F.lane == 0) { const unsigned lo = (unsigned)msk, hi = (unsigned)(msk >> 32); SELM[2 * t] = lo; SELM[2 * t + 1] = hi; atomicOr((unsigned*)&UNI[0], lo); atomicOr((unsigned*)&UNI[1], hi); }
    }
    __syncthreads();
    }
    const unsigned sel0 = SELM[2 * tt], sel1 = SELM[2 * tt + 1];
#pragma unroll
    for (int dt = 0; dt < 2; ++dt)
#pragma unroll
        for (int k = 0; k < 16; ++k) OUTA[(dt * 16 + k) * 64] = ocmp[dt][k];
    { const float* csp = (const float*)(ws + WS_CS) + pos * 32 + 8 * hh; const float* snp = (const float*)(ws + WS_SN) + pos * 32 + 8 * hh;
      float qraw[4][8];
#pragma unroll
      for (int st = 0; st < 4; ++st) { const v4u v = *(const v4u*)(qp + 16 * st); const unsigned vw[4] = {v.x, v.y, v.z, v.w};
#pragma unroll
          for (int k = 0; k < 4; ++k) { qraw[st][2 * k] = bf2f((bf16_t)(vw[k] & 0xffff)); qraw[st][2 * k + 1] = bf2f((bf16_t)(vw[k] >> 16)); } }
#pragma unroll
      for (int st = 0; st < 2; ++st) { float co[8], si[8]; *(f32x4*)&co[0] = *(const f32x4*)(csp + 16 * st); *(f32x4*)&co[4] = *(const f32x4*)(csp + 16 * st + 4); *(f32x4*)&si[0] = *(const f32x4*)(snp + 16 * st); *(f32x4*)&si[4] = *(const f32x4*)(snp + 16 * st + 4);
          float rl_[8], rh_[8];
#pragma unroll
          for (int k = 0; k < 8; ++k) { rl_[k] = (qraw[st][k] * co[k] - qraw[st + 2][k] * si[k]) * ATT_QS; rh_[k] = (qraw[st + 2][k] * co[k] + qraw[st][k] * si[k]) * ATT_QS; }
          qf[st] = __builtin_bit_cast(bf16x8, (v4u){cvt_pk_bf16(rl_[0], rl_[1]), cvt_pk_bf16(rl_[2], rl_[3]), cvt_pk_bf16(rl_[4], rl_[5]), cvt_pk_bf16(rl_[6], rl_[7])});
          qf[st + 2] = __builtin_bit_cast(bf16x8, (v4u){cvt_pk_bf16(rh_[0], rh_[1]), cvt_pk_bf16(rh_[2], rh_[3]), cvt_pk_bf16(rh_[4], rh_[5]), cvt_pk_bf16(rh_[6], rh_[7])}); } }
    for (int rep2_ = 0; rep2_ < (PROBE_ATT == 2 ? 2 : 1); ++rep2_)
#pragma unroll 1
    for (int br = 0; br < 2; ++br) {
        if (F.tid == 0) { int nl = 0;
            if (br == 0) { const unsigned u0 = UNI[0], u1 = UNI[1]; for (int j = 0; j <= qb; ++j) { const bool on = j < 32 ? ((u0 >> j) & 1u) : ((u1 >> (j - 32)) & 1u); if (on) TL[nl++] = (unsigned char)j; } }
            else { for (int j = (qb >= 8 ? qb - 8 : 0); j <= qb; ++j) TL[nl++] = (unsigned char)j; }
            NTL[0] = nl; }
        __syncthreads();
        const int nl = NTL[0]; const bf16_t* Kg = br ? kwr : ksr; const bf16_t* Vg = br ? vwt : vst;
        float mm = 0.f, ll = 0.f; bool started = false; f32x16 o[2];
#pragma unroll
        for (int k = 0; k < 16; ++k) { o[0][k] = 0.f; o[1][k] = 0.f; }
#define ATT_BODY \
            bool lane_on; int lo_k, hi_k;     \
            if (br == 0) { lane_on = j < 32 ? ((sel0 >> j) & 1u) : ((sel1 >> (j - 32)) & 1u); lo_k = 0; hi_k = (j == qb) ? tt : 63; } \
            else { lane_on = true; lo_k = (j == qb - 8) ? tt + 1 : 0; hi_k = (j == qb) ? tt : 63; if (lo_k > hi_k) lane_on = false; } \
            const bool full = (j != qb) && (br == 0 || j != qb - 8);               \
            if (__any(lane_on)) { \
                bf16x8 vf[4][2]; \
                { f32x16 ini[2]; att_ini(ini, full, lane_on ? -mm : -1e30f, lo_k, lane_on ? hi_k : -1, hh); att_qk(lds + kslot * 8192, qf, s, i, hh, ini[0], ini[1]); } \
                att_vload(lds + ATT_VB + kslot * 8192, vf, i, hh); \
                float tm = -1e30f; \
_Pragma("unroll") \
                for (int kt = 0; kt < 2; ++kt) \
_Pragma("unroll") \
                    for (int r = 0; r < 16; ++r) tm = fmaxf(tm, s[kt][r]); \
                tm = fmaxf(tm, __shfl_xor(tm, 32)); \
                const bool first = !started && (tm > -1e29f); started = started || first; \
                const bool upd = first || (tm > 8.0f); \
                if (__any(upd)) { \
                    const float delta = upd ? tm : 0.f, al = fexp2(-delta); mm += delta; ll *= al; \
_Pragma("unroll") \
                    for (int dt = 0; dt < 2; ++dt) \
_Pragma("unroll") \
                        for (int k = 0; k < 16; ++k) o[dt][k] *= al; \
_Pragma("unroll") \
                    for (int kt = 0; kt < 2; ++kt) \
_Pragma("unroll") \
                        for (int r = 0; r < 16; ++r) s[kt][r] -= delta; \
                } \
_Pragma("unroll") \
                for (int kt = 0; kt < 2; ++kt) \
_Pragma("unroll") \
                    for (int r = 0; r < 16; ++r) { const float pv_ = fexp2(s[kt][r]); s[kt][r] = pv_; ll += pv_; } \
                att_pv(vf, s, o); \
            }
        v4u kr2, vr2;
        const int np = (nl + 1) >> 1;
#define ATT_LOADPAIR(p_) do { { const int ja = TL[2 * (p_)]; TileSrc ts{Kg + (size_t)ja * 64 * 64, 64, Vg + (size_t)ja * 64, SEQ}; att_load(ts, F.tid, kr, vr); } \
            if (2 * (p_) + 1 < nl) { const int jb = TL[2 * (p_) + 1]; TileSrc ts{Kg + (size_t)jb * 64 * 64, 64, Vg + (size_t)jb * 64, SEQ}; att_load(ts, F.tid, kr2, vr2); } } while (0)
#define ATT_STOREPAIR(p_, c_) do { att_store(lds, 2 * (c_), F.tid, kr, vr); if (2 * (p_) + 1 < nl) att_store(lds, 2 * (c_) + 1, F.tid, kr2, vr2); } while (0)
        ATT_LOADPAIR(0); ATT_STOREPAIR(0, 0);
        if (np > 1) ATT_LOADPAIR(1);
        __syncthreads();
        int cur = 0;
        for (int p = 0; p < np; ++p) {
            if (p + 1 < np) ATT_STOREPAIR(p + 1, cur ^ 1);
            if (p + 2 < np) ATT_LOADPAIR(p + 2);
#pragma unroll 1
            for (int t2 = 0; t2 < 2; ++t2) { const int it = 2 * p + t2; if (it < nl) { const int j = TL[it]; const int kslot = 2 * cur + t2;
                ATT_BODY
            } }
            __syncthreads(); cur ^= 1;
        }
#undef ATT_LOADPAIR
#undef ATT_STOREPAIR
#undef ATT_BODY
        ll += __shfl_xor(ll, 32);
        const float sc_ = rep2_ ? 0.f : (br ? gate2 : gate1) / ll;
#pragma unroll
        for (int dt = 0; dt < 2; ++dt)
#pragma unroll
            for (int k = 0; k < 16; ++k) OUTA[(dt * 16 + k) * 64] += sc_ * o[dt][k];
    }
    { bf16_t* op = mix + tok * D + 512 + (4 * g + head) * 64 + 4 * hh;
#pragma unroll
      for (int dt = 0; dt < 2; ++dt)
#pragma unroll
          for (int gi = 0; gi < 4; ++gi) { const float a0 = OUTA[(dt * 16 + 4 * gi) * 64], a1 = OUTA[(dt * 16 + 4 * gi + 1) * 64], a2 = OUTA[(dt * 16 + 4 * gi + 2) * 64], a3 = OUTA[(dt * 16 + 4 * gi + 3) * 64];
              v2u ov; ov.x = cvt_pk_bf16(a0, a1); ov.y = cvt_pk_bf16(a2, a3); *(v2u*)(op + 32 * dt + 8 * gi) = ov; } }
    __syncthreads();
}

__global__ void __launch_bounds__(NTHR, 2) mk_fwd(Args args) {
    extern __shared__ __attribute__((aligned(16))) unsigned char lds_raw[];
    Frame F;
    F.lds = (LAS unsigned char*)lds_raw; F.MISC = (volatile LAS unsigned*)(F.lds + MISC_OFF);
    F.tid = threadIdx.x; F.lane = F.tid & 63; F.wave = __builtin_amdgcn_readfirstlane(F.tid >> 6);
    F.G = gridDim.x; { const int bx = blockIdx.x; F.vcu = (F.G % 8 == 0) ? (bx % 8) * (F.G / 8) + bx / 8 : bx; }
    F.ws = args.ws; F.ctl = (unsigned*)(args.ws + WS_CTL); F.out = args.out;
#pragma unroll
    for (int i = 0; i < 25; ++i) F.in[i] = args.in[i];
    for (int u = F.tid; u < (LDS_BYTES - LDSCTL_OFF) / 4; u += NTHR) ((LAS unsigned*)(F.lds + LDSCTL_OFF))[u] = 0u;
    __syncthreads();
    const int lo = args.ph_lo, hi = args.ph_hi;
    XcdBarrier bar = xcd_barrier_post(F.ctl + CW_BAR + lo * XCD_BAR_WORDS, F.MISC + 8);
#define IN_PH(k) (lo <= (k) && (k) < hi)
#define SEAM(k) do { if (IN_PH(k) && IN_PH((k) + 1)) xcd_barrier(bar); } while (0)
#define RUNP(k, BODY) do { if (IN_PH(k)) { BODY; if (PROBE_REP == (k)) { xcd_barrier(bar); BODY; } } } while (0)
#define BODY0 p0_prologue(F)
#define BODY1 p1a_norm(F)
#define BODY2 { gm::DenseSched S{(const char*)(F.ws + WS_XN), (const char*)(F.ws + WS_WINT), T / 256, LDP / 256, F.G, (int)blockIdx.x, 2048u, 1024u}; \
        gm::EpiBf16 E{(bf16_t*)(F.ws + WS_PROJ), LDP}; gm::gemm_phase<gm::EpiBf16, gm::DenseSched>(F.lds, S, E, 1024, 128u); }
#define BODY3 { if (F.G == 256) { if (F.vcu < 128) cmp_unit(F, F.vcu); else { const int u0 = 2 * (F.vcu - 128); hg_passA(F, u0); hg_passA(F, u0 + 1); kv_prep_unit(F, u0); kv_prep_unit(F, u0 + 1); } } \
        else { for (int u = F.vcu; u < 128; u += F.G) cmp_unit(F, u); for (int u = F.vcu; u < 256; u += F.G) hg_passA(F, u); for (int u = F.vcu; u < 256; u += F.G) kv_prep_unit(F, u); } }
#define BODY4 { for (int u = F.vcu; u < 256; u += F.G) hg_passC(F, u); }
#define BODY5 { for (int c = F.vcu; c < 256; c += F.G) { const int bg = c >> 5, k = c & 31; att_unit(F, bg * 64 + 63 - k); att_unit(F, bg * 64 + k); } }
#define BODY6 { gm::DenseSched S{(const char*)(F.ws + WS_MIX), (const char*)(F.ws + WS_WOUTT), T / 256, 4, F.G, (int)blockIdx.x, 2048u, 1024u}; \
        gm::EpiRes E{F.in[IN_X], (const float*)(F.ws + WS_MOD), 2, (float*)(F.ws + WS_X2)}; gm::gemm_phase<gm::EpiRes, gm::DenseSched>(F.lds, S, E, 1024, 128u); }
#define BODY7 p5_router(F)
#define BODY8 { const MoeTabs Tb = moe_tabs_build(F); \
        GateUpSched S{Tb, (const char*)(F.ws + WS_H2), (const char*)(F.ws + WS_WGUT), (const char*)(F.ws + WS_WSGUT), (const int*)(F.ws + WS_ROWL), F.G, (int)blockIdx.x}; \
        EpiSwiglu E{(bf16_t*)(F.ws + WS_ACT), (bf16_t*)(F.ws + WS_ACTS)}; gm::gemm_phase<EpiSwiglu, GateUpSched>(F.lds, S, E, 1024, 128u); }
#define BODY9 { const MoeTabs Tb = moe_tabs_build(F); DownSched S{Tb, (const char*)(F.ws + WS_ACT), (const char*)(F.ws + WS_ACTS), (const char*)(F.ws + WS_WDNT), (const char*)(F.ws + WS_WSDNT), F.G, (int)blockIdx.x}; \
        EpiDown E{(unsigned char*)(F.ws + WS_Y), (bf16_t*)(F.ws + WS_YS)}; gm::gemm_phase<EpiDown, DownSched>(F.lds, S, E, 256, 128u); }
#define BODY10 p8_final(F)
    RUNP(0, BODY0); SEAM(0);
    RUNP(1, BODY1); SEAM(1);
    RUNP(2, BODY2); SEAM(2);
    RUNP(3, BODY3); SEAM(3);
    RUNP(4, BODY4); SEAM(4);
    RUNP(5, BODY5); SEAM(5);
    RUNP(6, BODY6); SEAM(6);
    RUNP(7, BODY7); SEAM(7);
    RUNP(8, BODY8); SEAM(8);
    RUNP(9, BODY9); SEAM(9);
    RUNP(10, BODY10);
#undef IN_PH
#undef SEAM
#undef RUNP
}
#ifndef ONE_LAUNCH
#define ONE_LAUNCH 1
#endif
#ifndef OPT_S1
#define OPT_S1 1
#endif
#ifndef OPT_S2B
#define OPT_S2B 1
#endif
#ifndef OPT_S2A
#define OPT_S2A 1
#endif
#ifndef OPT_S5
#define OPT_S5 1
#endif
#ifndef OPT_S3
#define OPT_S3 1
#endif
#ifndef OPT_S4
#define OPT_S4 1
#endif
static void launch_mk(const nv::In& I, void* const* d_in, float* out, unsigned char* ws, int lo, int hi, int grid, hipStream_t stream) {
    Args a{}; for (int i = 0; i < 25; ++i) a.in[i] = (const float*)d_in[i];
    a.out = out; a.ws = ws; a.ph_lo = lo; a.ph_hi = hi; a.rep = 0; a.pad = 0;
    hipLaunchKernelGGL(mk_fwd, dim3(grid), dim3(NTHR), LDS_BYTES, stream, a);
}
extern "C" void kernel_launch(void* const* d_in, const int* in_sizes, int n_in, void* d_out, int out_size, void* d_ws, size_t ws_size, hipStream_t stream) {
    static int grid = 0;
    if (grid == 0) {
        if (ws_size < WS_END || n_in != 25) { fprintf(stderr, "kernel_launch: ws %zu < %zu or n_in %d != 25\n", ws_size, (size_t)WS_END, n_in); grid = -1; return; }
        int dev = 0, cus = 0;
        if (hipGetDevice(&dev) != hipSuccess || hipDeviceGetAttribute(&cus, hipDeviceAttributeMultiprocessorCount, dev) != hipSuccess) { grid = -1; return; }
        if (hipFuncSetAttribute((const void*)mk_fwd, hipFuncAttributeMaxDynamicSharedMemorySize, LDS_BYTES) != hipSuccess) { fprintf(stderr, "kernel_launch: hipFuncSetAttribute failed\n"); grid = -1; return; }
        int per_cu = 0; (void)hipOccupancyMaxActiveBlocksPerMultiprocessor(&per_cu, (const void*)mk_fwd, NTHR, LDS_BYTES); (void)hipGetLastError();
        if (per_cu < 1) fprintf(stderr, "kernel_launch: occupancy query says %d blocks/CU\n", per_cu);
        grid = cus;
    }
    if (grid < 0) return;
    unsigned char* ws = (unsigned char*)d_ws; float* out = (float*)d_out;
    nv::In I; I.set(d_in);
    (void)hipMemsetAsync(ws + WS_CTL, 0, CTL_ZERO_BYTES, stream);
#if ONE_LAUNCH
    launch_mk(I, d_in, out, ws, 0, 11, grid, stream);
#else
#if OPT_S1
    launch_mk(I, d_in, out, ws, 0, 3, grid, stream);
#else
    nv::s1_naive(I, ws, stream);
#endif
#if OPT_S2A
    launch_mk(I, d_in, out, ws, 3, OPT_S2B ? 6 : 5, grid, stream);
#endif
    if (!OPT_S2A || !OPT_S2B) nv::s2_naive(I, ws, stream, !OPT_S2A, !OPT_S2B);
#if OPT_S3
    launch_mk(I, d_in, out, ws, 6, OPT_S4 ? 8 : 7, grid, stream);
#else
    nv::s3_naive(I, ws, stream);
#endif
#if OPT_S4
    if (!OPT_S3) launch_mk(I, d_in, out, ws, 7, 8, grid, stream);
#else
    nv::s4_naive(I, ws, stream);
#endif
#if OPT_S5
    launch_mk(I, d_in, out, ws, 8, 11, grid, stream);
#else
    nv::s5_naive(I, ws, out, stream);
#endif
#endif
}
#endif
```

```cpp
#ifndef CPU_EMU
#include <hip/hip_runtime.h>
#endif
#include <cstdio>
#include <cstdint>
#include <cmath>

#ifndef BATCH
#define BATCH 4
#endif
#ifndef SEQ
#define SEQ 4096
#endif

#ifdef CPU_EMU
struct dim3e { unsigned x, y, z; };
static thread_local dim3e threadIdx, blockIdx, blockDim, gridDim;
#define __global__
#define __device__
#define __host__
#define __forceinline__ inline
#define __launch_bounds__(...)
typedef int hipStream_t;
template <class F> static void cpu_launch(unsigned grid, unsigned block, F f) {
#pragma omp parallel for schedule(dynamic, 1)
    for (long b = 0; b < (long)grid; ++b) {
        blockIdx = {(unsigned)b, 0, 0}; blockDim = {block, 1, 1}; gridDim = {grid, 1, 1};
        for (unsigned t = 0; t < block; ++t) { threadIdx = {t, 0, 0}; f(); }
    }
}
static int g_launch_limit = 1 << 30, g_launch_count = 0;
#define LAUNCH(kern, grid, block, ...) do { if (g_launch_count++ < g_launch_limit) cpu_launch((unsigned)(grid), (unsigned)(block), [&]() { kern(__VA_ARGS__); }); } while (0)
#else
#define LAUNCH(kern, grid, block, ...) kern<<<dim3((unsigned)(grid)), dim3((unsigned)(block)), 0, stream>>>(__VA_ARGS__)
#endif

typedef unsigned short bf16_t;
constexpr int D = 1024, T = BATCH * SEQ, INC = 3352, LDP = 3584;
constexpr int C_HQ = 0, C_HF = 512, C_HI = 1024, C_HGT = 1536, C_NQ = 2048, C_KC = 2560, C_VC = 2688, C_KS = 2816, C_VS = 2944, C_KW = 3072, C_VW = 3200, C_NG = 3328;
constexpr int NCMP = (SEQ - 32) / 16 + 1, NSB = SEQ / 64, NSEL = NSB < 16 ? NSB : 16;
constexpr float EPS = 1e-6f;

constexpr size_t MiB = 1u << 20, KiB = 1u << 10;
constexpr size_t WS_CTL = 0, CTL_ZERO_BYTES = 1 * MiB;
constexpr size_t WS_MODP = 1 * MiB;
constexpr size_t WS_MOD = 2 * MiB + 512 * KiB;
constexpr size_t WS_B1F = WS_MOD + 128 * KiB;
constexpr size_t WS_CS = 2 * MiB + 768 * KiB, WS_SN = WS_CS + 512 * KiB;
constexpr size_t WS_WDNT = 4 * MiB;
constexpr size_t WS_WSDNT = 36 * MiB;
constexpr size_t WS_X2 = 37 * MiB;
constexpr size_t WS_ACT = 101 * MiB;
constexpr size_t WS_ACTS = 173 * MiB;
constexpr size_t WS_ROWL = 181 * MiB;
constexpr size_t WS_TOPI = 189 * MiB, WS_TOPW = WS_TOPI + 512 * KiB;
constexpr size_t WS_ERANK = 185 * MiB;
constexpr size_t WS_WGUT = 190 * MiB;
constexpr size_t WS_WSGUT = 254 * MiB;
constexpr size_t WS_WINT = 255 * MiB;
constexpr size_t WS_WOUTT = 262 * MiB;
constexpr size_t WS_W1KT = 264 * MiB, WS_W1VT = 265 * MiB;
constexpr size_t WS_W2T = 266 * MiB;
constexpr size_t WS_RW = 267 * MiB;
constexpr size_t WS_XN = 268 * MiB;
constexpr size_t WS_H2 = WS_XN;
constexpr size_t WS_PROJ = 300 * MiB;
constexpr size_t WS_KSR = 412 * MiB, WS_KWR = 416 * MiB;
constexpr size_t WS_VST = 420 * MiB, WS_VWT = 424 * MiB;
constexpr size_t WS_KCMP = 428 * MiB, WS_VCMPT = WS_KCMP + 256 * KiB;
constexpr size_t WS_U = 429 * MiB, WS_DD = 445 * MiB;
constexpr size_t WS_MIX = 446 * MiB;
constexpr size_t WS_Y = 190 * MiB;
constexpr size_t WS_YS = 478 * MiB;
constexpr size_t WS_END = 512 * MiB;
constexpr size_t NV_H = 37 * MiB, NV_RSTD = 101 * MiB;
constexpr size_t NV_F = 37 * MiB, NV_ORAW = 69 * MiB, NV_OWIN = 101 * MiB, NV_KSR = 133 * MiB, NV_KWR = 141 * MiB, NV_PS = 149 * MiB, NV_SEL = 157 * MiB,
                 NV_HID = 158 * MiB, NV_KCMP = 160 * MiB, NV_VCMP = 160 * MiB + 512 * KiB, NV_CS = 161 * MiB, NV_SN = 161 * MiB + 512 * KiB, NV_QROT = 478 * MiB;
constexpr size_t NV_H2F = 300 * MiB, NV_LG = 364 * MiB, NV_RSTD2 = 368 * MiB;
constexpr size_t NV_ACT = 300 * MiB, NV_ACTS = 101 * MiB, NV_X3 = 446 * MiB, NV_RSTD3 = 510 * MiB;

__host__ __device__ __forceinline__ float bf2f(bf16_t v) { union { unsigned u; float f; } c; c.u = (unsigned)v << 16; return c.f; }
__host__ __device__ __forceinline__ bf16_t f2bf(float f) { union { unsigned u; float f; } c; c.f = f; unsigned u = c.u; return (bf16_t)((u + 0x7fffu + ((u >> 16) & 1u)) >> 16); }

namespace nv {
__device__ __forceinline__ float sigmoidf_(float z) { return 1.0f / (1.0f + expf(-z)); }
__device__ __forceinline__ float siluf_(float z) { return z * sigmoidf_(z); }
__device__ __forceinline__ float gelu_tanh(float z) { return 0.5f * z * (1.0f + tanhf(0.7978845608028654f * (z + 0.044715f * z * z * z))); }
__device__ __forceinline__ long gtid() { return (long)blockIdx.x * blockDim.x + threadIdx.x; }
#define PJ(row, col) bf2f(proj[(size_t)(row) * LDP + (col)])

__global__ void k_mod(const float* c, const float* w_ada, const float* b_ada, float* mod) {
    long i = gtid(); if (i >= BATCH * 6144) return; int b = (int)(i / 6144), n = (int)(i % 6144);
    float acc = b_ada[n];
    for (int k = 0; k < D; ++k) acc += siluf_(c[b * D + k]) * w_ada[(size_t)k * 6144 + n];
    mod[i] = acc;
}
__global__ void k_rowrstd(const float* x, float* rstd, int rows) {
    long r = gtid(); if (r >= rows) return; float s = 0.f;
    for (int k = 0; k < D; ++k) { float v = x[(size_t)r * D + k]; s += v * v; }
    rstd[r] = 1.0f / sqrtf(s / D + EPS);
}
__global__ void k_modnorm(const float* x, const float* rstd, const float* g, const float* mod, int sh_chunk, int sc_chunk, float* hf, bf16_t* hb) {
    long i = gtid(); if (i >= (long)T * D) return; int r = (int)(i / D), k = (int)(i % D), b = r / SEQ;
    float v = x[i] * rstd[r] * g[k] * (1.0f + mod[b * 6144 + sc_chunk * D + k]) + mod[b * 6144 + sh_chunk * D + k];
    if (hf) hf[i] = v; if (hb) hb[i] = f2bf(v);
}
__global__ void k_gemm_nn_bf(const float* A, int lda, const float* Bm, int ldb, bf16_t* C, int ldc, int M, int N, int K) {
    long i = gtid(); if (i >= (long)M * N) return; int m = (int)(i / N), n = (int)(i % N);
    float acc = 0.f; const float* a = A + (size_t)m * lda;
    for (int k = 0; k < K; ++k) acc += a[k] * Bm[(size_t)k * ldb + n];
    C[(size_t)m * ldc + n] = f2bf(acc);
}
__global__ void k_gemm_nn(const float* A, int lda, const float* Bm, int ldb, float* C, int ldc, int M, int N, int K) {
    long i = gtid(); if (i >= (long)M * N) return; int m = (int)(i / N), n = (int)(i % N);
    float acc = 0.f; const float* a = A + (size_t)m * lda;
    for (int k = 0; k < K; ++k) acc += a[k] * Bm[(size_t)k * ldb + n];
    C[(size_t)m * ldc + n] = acc;
}
__global__ void k_hgf(const bf16_t* proj, const float* lbl, float* F) {
    long i = gtid(); if (i >= (long)T * 512) return; int r = (int)(i / 512), j = (int)(i % 512);
    float l0 = lbl[j], l1 = lbl[512 + j]; float mx = fmaxf(l0, l1); float e0 = expf(l0 - mx), e1 = expf(l1 - mx); float lb = e0 / (e0 + e1);
    F[i] = lb + (1.0f - lb) * sigmoidf_(PJ(r, C_HF + j));
}
__global__ void __launch_bounds__(64) k_hgrn(const bf16_t* proj, const float* F, float* Oraw) {
    long i = gtid(); if (i >= BATCH * 4 * 128) return; int e = (int)(i % 128), h = (int)((i / 128) % 4), b = (int)(i / 512);
    float S[128];
#pragma unroll
    for (int d = 0; d < 128; ++d) S[d] = 0.f;
    for (int t = 0; t < SEQ; ++t) {
        size_t row = (size_t)b * SEQ + t; const bf16_t* p = proj + row * LDP; const float* f = F + row * 512 + h * 128;
        float v = bf2f(p[C_HI + h * 128 + e]), o = 0.f;
#pragma unroll
        for (int d = 0; d < 128; ++d) { float ff = f[d]; S[d] = ff * S[d] + (1.0f - ff) * v; o += S[d] * bf2f(p[C_HQ + h * 128 + d]); }
        Oraw[row * 512 + h * 128 + e] = o * 0.08838834764831845f;
    }
}
__global__ void k_hgnorm(const float* Oraw, const bf16_t* proj, const float* ng, bf16_t* mix) {
    long i = gtid(); if (i >= (long)T * 4) return; size_t row = (size_t)(i / 4); int h = (int)(i % 4);
    const float* o = Oraw + row * 512 + h * 128; float s = 0.f;
    for (int e = 0; e < 128; ++e) s += o[e] * o[e];
    float r = 1.0f / sqrtf(s / 128 + EPS);
    for (int e = 0; e < 128; ++e) mix[row * D + h * 128 + e] = f2bf(o[e] * r * ng[h * 128 + e] * siluf_(PJ(row, C_HGT + h * 128 + e)));
}
__global__ void k_cmp_hidden(const bf16_t* proj, int coloff, const float* pe, const float* w1, const float* b1, float* hid) {
    long i = gtid(); if (i >= (long)BATCH * 2 * NCMP * 256) return; int j = (int)(i % 256); long r = i / 256; int c = (int)(r % NCMP), g = (int)((r / NCMP) % 2), b = (int)(r / (NCMP * 2));
    float acc = b1[j];
    for (int l = 0; l < 32; ++l) { const bf16_t* p = proj + ((size_t)b * SEQ + 16 * c + l) * LDP + coloff + g * 64;
        for (int d = 0; d < 64; ++d) acc += (bf2f(p[d]) + pe[l * 64 + d]) * w1[(size_t)(l * 64 + d) * 256 + j]; }
    hid[i] = gelu_tanh(acc);
}
__global__ void k_cmp_out(const float* hid, const float* w2, float* out) {
    long i = gtid(); if (i >= (long)BATCH * 2 * NCMP * 64) return; int d = (int)(i % 64); long r = i / 64;
    float acc = 0.f; for (int j = 0; j < 256; ++j) acc += hid[r * 256 + j] * w2[j * 64 + d];
    out[i] = acc;
}
__global__ void k_rope_tab(float* cs, float* sn) {
    long i = gtid(); if (i >= (long)SEQ * 32) return; int pos = (int)(i / 32), k = (int)(i % 32);
    float inv = powf(10000.0f, -(float)k / 32.0f); float ang = (float)pos * inv; cs[i] = cosf(ang); sn[i] = sinf(ang);
}
__global__ void k_rope_apply(const bf16_t* proj, int coloff, int nh, const float* cs, const float* sn, float* dst) {
    long i = gtid(); if (i >= (long)T * nh * 32) return; int k = (int)(i % 32); int h = (int)((i / 32) % nh); size_t row = (size_t)(i / (32 * nh)); int pos = (int)(row % SEQ);
    float t1 = PJ(row, coloff + h * 64 + k), t2 = PJ(row, coloff + h * 64 + k + 32), co = cs[pos * 32 + k], si = sn[pos * 32 + k];
    dst[row * (nh * 64) + h * 64 + k] = t1 * co - t2 * si; dst[row * (nh * 64) + h * 64 + k + 32] = t2 * co + t1 * si;
}
__global__ void __launch_bounds__(64) k_cmp_attn(const bf16_t* proj, const float* kcmp, const float* vcmp, float* ocmp, float* PS) {
    long i = gtid(); if (i >= (long)BATCH * 2 * SEQ) return; int s = (int)(i % SEQ), g = (int)((i / SEQ) % 2), b = (int)(i / (2 * SEQ));
    size_t row = (size_t)b * SEQ + s; float* ps = PS + (size_t)i * 64;
    for (int j = 0; j < 64; ++j) ps[j] = 0.f;
    int ncv = s >= 31 ? (s - 31) / 16 + 1 : 0; if (ncv > NCMP) ncv = NCMP;
    const float* kc = kcmp + (size_t)(b * 2 + g) * NCMP * 64; const float* vc = vcmp + (size_t)(b * 2 + g) * NCMP * 64;
    for (int hh = 0; hh < 4; ++hh) {
        int head = g * 4 + hh;
        float q[64], o[64];
#pragma unroll
        for (int d = 0; d < 64; ++d) { q[d] = PJ(row, C_NQ + head * 64 + d); o[d] = 0.f; }
        float m = -3.0e38f, l = 0.f;
        for (int c = 0; c < ncv; ++c) { float sc = 0.f;
#pragma unroll
            for (int d = 0; d < 64; ++d) sc += q[d] * kc[c * 64 + d];
            sc *= 0.125f; float mn = fmaxf(m, sc); l = l * expf(m - mn) + expf(sc - mn); m = mn; }
        for (int c = 0; c < ncv; ++c) { float sc = 0.f;
#pragma unroll
            for (int d = 0; d < 64; ++d) sc += q[d] * kc[c * 64 + d];
            sc *= 0.125f; float p = expf(sc - m) / l;
#pragma unroll
            for (int d = 0; d < 64; ++d) o[d] += p * vc[c * 64 + d];
            int c0 = 16 * c, c1 = 16 * c + 32;
            for (int j = c0 / 64; j <= (c1 - 1) / 64 && j < NSB; ++j) { int lo = c0 > 64 * j ? c0 : 64 * j, hi = c1 < 64 * j + 64 ? c1 : 64 * j + 64; if (hi > lo) ps[j] += p * (float)(hi - lo) / 32.0f; } }
#pragma unroll
        for (int d = 0; d < 64; ++d) ocmp[row * 512 + head * 64 + d] = o[d];
    }
}
__global__ void k_select(const float* PS, unsigned* SEL) {
    long i = gtid(); if (i >= (long)BATCH * 2 * SEQ) return; int s = (int)(i % SEQ); const float* ps = PS + (size_t)i * 64; int cur = s / 64;
    unsigned m0 = 0, m1 = 0;
    for (int j = 0; j < NSB; ++j) {
        bool fj = (j == 0) || (j == cur) || (j == cur - 1); float sj = fj ? 1e30f : (j <= cur ? ps[j] : -1e30f);
        int rank = 0;
        for (int k = 0; k < NSB; ++k) { bool fk = (k == 0) || (k == cur) || (k == cur - 1); float sk = fk ? 1e30f : (k <= cur ? ps[k] : -1e30f); if (sk > sj || (sk == sj && k < j)) ++rank; }
        if (rank < NSEL && sj > -1e29f) { if (j < 32) m0 |= 1u << j; else m1 |= 1u << (j - 32); }
    }
    SEL[i * 2] = m0; SEL[i * 2 + 1] = m1;
}
__global__ void __launch_bounds__(64) k_attn_naive(const float* qrot, const float* krot, const bf16_t* proj, int vcol, const unsigned* SEL, int mode, float* out) {
    long i = gtid(); if (i >= (long)BATCH * 8 * SEQ) return; int s = (int)(i % SEQ), head = (int)((i / SEQ) % 8), b = (int)(i / (8 * SEQ)); int g = head / 4;
    size_t row = (size_t)b * SEQ + s; float q[64], o[64];
#pragma unroll
    for (int d = 0; d < 64; ++d) { q[d] = qrot[row * 512 + head * 64 + d]; o[d] = 0.f; }
    float m = -3.0e38f, l = 0.f;
    unsigned m0 = 0, m1 = 0; if (mode == 0) { size_t si = ((size_t)(b * 2 + g) * SEQ + s) * 2; m0 = SEL[si]; m1 = SEL[si + 1]; }
    int k0 = mode == 0 ? 0 : (s - 511 > 0 ? s - 511 : 0);
    for (int key = k0; key <= s; ++key) {
        if (mode == 0) { int j = key / 64; bool sel = j < 32 ? ((m0 >> j) & 1u) : ((m1 >> (j - 32)) & 1u); if (!sel) { key = j * 64 + 63; continue; } }
        size_t kr = (size_t)b * SEQ + key; const float* kp = krot + kr * 128 + g * 64;
        float sc = 0.f;
#pragma unroll
        for (int d = 0; d < 64; ++d) sc += q[d] * kp[d];
        sc *= 0.125f; float mn = fmaxf(m, sc), a = expf(m - mn), p = expf(sc - mn); l = l * a + p; m = mn;
#pragma unroll
        for (int d = 0; d < 64; ++d) o[d] = o[d] * a + p * PJ(kr, vcol + g * 64 + d);
    }
#pragma unroll
    for (int d = 0; d < 64; ++d) out[row * 512 + head * 64 + d] = o[d] / l;
}
__global__ void k_nsa_combine(const bf16_t* proj, const float* ocmp, const float* oslc, const float* owin, bf16_t* mix) {
    long i = gtid(); if (i >= (long)T * 512) return; size_t row = (size_t)(i / 512); int c = (int)(i % 512), head = c / 64;
    mix[row * D + 512 + c] = f2bf(sigmoidf_(PJ(row, C_NG + head * 3)) * ocmp[i] + sigmoidf_(PJ(row, C_NG + head * 3 + 1)) * oslc[i] + sigmoidf_(PJ(row, C_NG + head * 3 + 2)) * owin[i]);
}
__global__ void k_proj_res(const bf16_t* A, const float* W, const float* x, const float* mod, int chunk, float* out) {
    long i = gtid(); if (i >= (long)T * D) return; int r = (int)(i / D), n = (int)(i % D), b = r / SEQ;
    float acc = 0.f; const bf16_t* a = A + (size_t)r * D;
    for (int k = 0; k < D; ++k) acc += bf2f(a[k]) * W[(size_t)k * D + n];
    out[i] = x[i] + mod[b * 6144 + chunk * D + n] * acc;
}
__global__ void __launch_bounds__(64) k_route(const float* LG, const float* bias, int* TOPI, float* TOPW) {
    long t = gtid(); if (t >= T) return; const float* lg = LG + (size_t)t * 64;
    float gs[8];
#pragma unroll
    for (int gI = 0; gI < 8; ++gI) { float a = -3e38f, b2 = -3e38f;
        for (int e = 0; e < 8; ++e) { float ch = sigmoidf_(lg[gI * 8 + e]) + bias[gI * 8 + e]; if (ch > a) { b2 = a; a = ch; } else if (ch > b2) b2 = ch; }
        gs[gI] = a + b2; }
    unsigned gmask = 0;
#pragma unroll
    for (int gI = 0; gI < 8; ++gI) { int rank = 0;
#pragma unroll
        for (int k = 0; k < 8; ++k) if (gs[k] > gs[gI] || (gs[k] == gs[gI] && k < gI)) ++rank;
        if (rank < 4) gmask |= 1u << gI; }
    int n = 0; float wsum = 0.f;
    for (int e = 0; e < 64; ++e) { if (!((gmask >> (e / 8)) & 1u)) continue; float se = sigmoidf_(lg[e]), ce = se + bias[e]; int rank = 0;
        for (int k = 0; k < 64; ++k) { if (!((gmask >> (k / 8)) & 1u)) continue; float ck = sigmoidf_(lg[k]) + bias[k]; if (ck > ce || (ck == ce && k < e)) ++rank; }
        if (rank < 8 && n < 8) { TOPI[t * 8 + n] = e; TOPW[t * 8 + n] = se; wsum += se; ++n; } }
    for (int k = 0; k < 8; ++k) TOPW[t * 8 + k] = TOPW[t * 8 + k] / wsum * 2.5f;
}
__global__ void k_moe_act(const bf16_t* h2, const float* Wgu, const int* TOPI, float* ACT, long nA) {
    long i = gtid(); if (i >= nA * 256) return; long a = i / 256; int j = (int)(i % 256); long t = TOPI ? a / 8 : a; int e = TOPI ? TOPI[a] : 0;
    const bf16_t* hp = h2 + (size_t)t * D; const float* w = Wgu + (size_t)e * D * 512; float gq = 0.f, u = 0.f;
    for (int k = 0; k < D; ++k) { float hv = bf2f(hp[k]); gq += hv * w[(size_t)k * 512 + j]; u += hv * w[(size_t)k * 512 + 256 + j]; }
    ACT[i] = siluf_(gq) * u;
}
__global__ void k_moe_out(const float* ACT, const float* ACTS, const float* Wdn, const float* Wsd, const int* TOPI, const float* TOPW, const float* x2, const float* mod, float* x3) {
    long i = gtid(); if (i >= (long)T * D) return; long t = i / D; int n = (int)(i % D), b = (int)(t / SEQ);
    float acc = 0.f;
    for (int sl = 0; sl < 8; ++sl) { int e = TOPI[t * 8 + sl]; const float* a = ACT + (size_t)(t * 8 + sl) * 256; const float* w = Wdn + (size_t)e * 256 * D; float y = 0.f;
        for (int k = 0; k < 256; ++k) y += a[k] * w[(size_t)k * D + n];
        acc += TOPW[t * 8 + sl] * y; }
    { const float* a = ACTS + (size_t)t * 256; float y = 0.f; for (int k = 0; k < 256; ++k) y += a[k] * Wsd[(size_t)k * D + n]; acc += y; }
    x3[i] = x2[i] + mod[b * 6144 + 5 * D + n] * acc;
}
__global__ void k_final(const float* x3, const float* rstd, const float* g, float* out) {
    long i = gtid(); if (i >= (long)T * D) return; out[i] = x3[i] * rstd[i / D] * g[i % D];
}
#undef PJ

struct In { const float *x, *c, *w_ada, *b_ada, *n1g, *w_in, *lbl, *hng, *pek, *w1k, *b1k, *w2k, *pev, *w1v, *b1v, *w2v, *w_out, *n2g, *rw, *rb, *wgu, *wdn, *wsgu, *wsdn, *fg;
    void set(void* const* d) { const float** p = (const float**)this; for (int i = 0; i < 25; ++i) p[i] = (const float*)d[i]; } };
#define NBK(n, tb) (((long)(n) + (tb) - 1) / (tb))
template <class Tp> static Tp* wsp(unsigned char* ws, size_t off) { return (Tp*)(ws + off); }
static void s1_naive(const In& I, unsigned char* ws, hipStream_t stream) {
    float* mod = wsp<float>(ws, WS_MOD); float* h = wsp<float>(ws, NV_H); float* rstd = wsp<float>(ws, NV_RSTD); bf16_t* proj = wsp<bf16_t>(ws, WS_PROJ);
    LAUNCH(k_mod, NBK(BATCH * 6144, 256), 256, I.c, I.w_ada, I.b_ada, mod);
    LAUNCH(k_rowrstd, NBK(T, 256), 256, I.x, rstd, T);
    LAUNCH(k_modnorm, NBK((long)T * D, 256), 256, I.x, rstd, I.n1g, mod, 0, 1, h, (bf16_t*)nullptr);
    LAUNCH(k_gemm_nn_bf, NBK((long)T * INC, 256), 256, h, D, I.w_in, INC, proj, LDP, T, INC, D);
}
static void s2_naive(const In& I, unsigned char* ws, hipStream_t stream, bool do_hg = true, bool do_nsa = true) {
    const bf16_t* proj = wsp<bf16_t>(ws, WS_PROJ); bf16_t* mix = wsp<bf16_t>(ws, WS_MIX);
    float *F = wsp<float>(ws, NV_F), *oraw = wsp<float>(ws, NV_ORAW), *owin = wsp<float>(ws, NV_OWIN), *ksr = wsp<float>(ws, NV_KSR), *kwr = wsp<float>(ws, NV_KWR), *PS = wsp<float>(ws, NV_PS);
    float *hid = wsp<float>(ws, NV_HID), *kcmp = wsp<float>(ws, NV_KCMP), *vcmp = wsp<float>(ws, NV_VCMP), *cs = wsp<float>(ws, NV_CS), *sn = wsp<float>(ws, NV_SN), *qrot = wsp<float>(ws, NV_QROT);
    unsigned* sel = wsp<unsigned>(ws, NV_SEL); float *ocmp = F, *oslc = oraw;
    if (do_hg) {
    LAUNCH(k_hgf, NBK((long)T * 512, 256), 256, proj, I.lbl, F);
    LAUNCH(k_hgrn, NBK(BATCH * 512, 64), 64, proj, F, oraw);
    LAUNCH(k_hgnorm, NBK((long)T * 4, 256), 256, oraw, proj, I.hng, mix);
    }
    if (!do_nsa) return;
    LAUNCH(k_cmp_hidden, NBK((long)BATCH * 2 * NCMP * 256, 256), 256, proj, C_KC, I.pek, I.w1k, I.b1k, hid);
    LAUNCH(k_cmp_out, NBK((long)BATCH * 2 * NCMP * 64, 256), 256, hid, I.w2k, kcmp);
    LAUNCH(k_cmp_hidden, NBK((long)BATCH * 2 * NCMP * 256, 256), 256, proj, C_VC, I.pev, I.w1v, I.b1v, hid);
    LAUNCH(k_cmp_out, NBK((long)BATCH * 2 * NCMP * 64, 256), 256, hid, I.w2v, vcmp);
    LAUNCH(k_rope_tab, NBK(SEQ * 32, 256), 256, cs, sn);
    LAUNCH(k_rope_apply, NBK((long)T * 8 * 32, 256), 256, proj, C_NQ, 8, cs, sn, qrot);
    LAUNCH(k_rope_apply, NBK((long)T * 2 * 32, 256), 256, proj, C_KS, 2, cs, sn, ksr);
    LAUNCH(k_rope_apply, NBK((long)T * 2 * 32, 256), 256, proj, C_KW, 2, cs, sn, kwr);
    LAUNCH(k_cmp_attn, NBK((long)BATCH * 2 * SEQ, 64), 64, proj, kcmp, vcmp, ocmp, PS);
    LAUNCH(k_select, NBK((long)BATCH * 2 * SEQ, 256), 256, PS, sel);
    LAUNCH(k_attn_naive, NBK((long)BATCH * 8 * SEQ, 64), 64, qrot, ksr, proj, C_VS, sel, 0, oslc);
    LAUNCH(k_attn_naive, NBK((long)BATCH * 8 * SEQ, 64), 64, qrot, kwr, proj, C_VW, sel, 1, owin);
    LAUNCH(k_nsa_combine, NBK((long)T * 512, 256), 256, proj, ocmp, oslc, owin, mix);
}
static void s3_naive(const In& I, unsigned char* ws, hipStream_t stream) {
    LAUNCH(k_proj_res, NBK((long)T * D, 256), 256, wsp<bf16_t>(ws, WS_MIX), I.w_out, I.x, wsp<float>(ws, WS_MOD), 2, wsp<float>(ws, WS_X2));
}
static void s4_naive(const In& I, unsigned char* ws, hipStream_t stream) {
    float *x2 = wsp<float>(ws, WS_X2), *rstd = wsp<float>(ws, NV_RSTD2), *h2f = wsp<float>(ws, NV_H2F), *lg = wsp<float>(ws, NV_LG), *mod = wsp<float>(ws, WS_MOD);
    LAUNCH(k_rowrstd, NBK(T, 256), 256, x2, rstd, T);
    LAUNCH(k_modnorm, NBK((long)T * D, 256), 256, x2, rstd, I.n2g, mod, 3, 4, h2f, wsp<bf16_t>(ws, WS_H2));
    LAUNCH(k_gemm_nn, NBK((long)T * 64, 256), 256, h2f, D, I.rw, 64, lg, 64, T, 64, D);
    LAUNCH(k_route, NBK(T, 64), 64, lg, I.rb, wsp<int>(ws, WS_TOPI), wsp<float>(ws, WS_TOPW));
}
static void s5_naive(const In& I, unsigned char* ws, float* out, hipStream_t stream) {
    float *act = wsp<float>(ws, NV_ACT), *acts = wsp<float>(ws, NV_ACTS), *x3 = wsp<float>(ws, NV_X3), *rstd = wsp<float>(ws, NV_RSTD3);
    const bf16_t* h2 = wsp<bf16_t>(ws, WS_H2); const int* topi = wsp<int>(ws, WS_TOPI);
    LAUNCH(k_moe_act, NBK((long)T * 8 * 256, 256), 256, h2, I.wgu, topi, act, (long)T * 8);
    LAUNCH(k_moe_act, NBK((long)T * 256, 256), 256, h2, I.wsgu, (const int*)nullptr, acts, (long)T);
    LAUNCH(k_moe_out, NBK((long)T * D, 256), 256, act, acts, I.wdn, I.wsdn, topi, wsp<float>(ws, WS_TOPW), wsp<float>(ws, WS_X2), wsp<float>(ws, WS_MOD), x3);
    LAUNCH(k_rowrstd, NBK(T, 256), 256, x3, rstd, T);
    LAUNCH(k_final, NBK((long)T * D, 256), 256, x3, rstd, I.fg, out);
}
}
#ifndef CPU_EMU
#define GAS __attribute__((address_space(1)))
#define LAS __attribute__((address_space(3)))
typedef unsigned v4u __attribute__((ext_vector_type(4)));
typedef unsigned v2u __attribute__((ext_vector_type(2)));
typedef float f32x4 __attribute__((ext_vector_type(4)));
typedef float f32x2 __attribute__((ext_vector_type(2)));
typedef float f32x16 __attribute__((ext_vector_type(16)));
typedef short bf16x8 __attribute__((ext_vector_type(8)));
typedef short bf16x4 __attribute__((ext_vector_type(4)));
typedef GAS unsigned gu32;
#define RLX_AGENT __ATOMIC_RELAXED, __HIP_MEMORY_SCOPE_AGENT
#define LDS_WAIT() asm volatile("s_waitcnt lgkmcnt(0)" ::: "memory")
#define VM_WAIT() asm volatile("s_waitcnt vmcnt(0)" ::: "memory")
constexpr int NWAVES = 8, NTHR = 512;
__device__ __forceinline__ unsigned pk2(float lo, float hi) { return (unsigned)f2bf(lo) | ((unsigned)f2bf(hi) << 16); }
__device__ __forceinline__ unsigned cvt_pk_bf16(float lo, float hi) { unsigned r; asm volatile("v_cvt_pk_bf16_f32 %0, %1, %2" : "=v"(r) : "v"(lo), "v"(hi)); return r; }
__device__ __forceinline__ float fexp2(float x) { return __builtin_amdgcn_exp2f(__builtin_amdgcn_fmed3f(x, -120.0f, 3.0e38f)); }
__device__ __forceinline__ float fexp(float x) { return __builtin_amdgcn_exp2f(fmaxf(x * 1.4426950408889634f, -120.0f)); }
__device__ __forceinline__ float fsigmoid(float z) { return 1.0f / (1.0f + __builtin_amdgcn_exp2f(fminf(fmaxf(-z * 1.4426950408889634f, -120.0f), 120.0f))); }
__device__ __forceinline__ float fsilu(float z) { return z / (1.0f + __builtin_amdgcn_exp2f(fminf(fmaxf(-z * 1.4426950408889634f, -120.0f), 120.0f))); }
__device__ __forceinline__ float wave_sum(float v) {
#pragma unroll
    for (int o = 1; o < 64; o <<= 1) v += __shfl_xor(v, o);
    return v;
}

#define XB_TMO      128
#define XB_XCNT(j)  (256  + 64 * (j))
#define XB_XSUB(j)  (1280 + 64 * (j))
#define XB_XGEN(j)  (2304 + 64 * (j))
#define XB_TOP      3328
#define XB_TOPGEN   3392
#define XCD_BAR_WORDS 3456
#define XB_SPIN_CAP (1u << 18)
__device__ __forceinline__ unsigned xb_ld(unsigned* p)              { return __hip_atomic_load(p, __ATOMIC_RELAXED, __HIP_MEMORY_SCOPE_AGENT); }
__device__ __forceinline__ unsigned xb_add(unsigned* p, unsigned v) { return __hip_atomic_fetch_add(p, v, __ATOMIC_RELAXED, __HIP_MEMORY_SCOPE_AGENT); }
__device__ __forceinline__ unsigned xb_xcc_id() { return (unsigned)__builtin_amdgcn_s_getreg((3 << 11) | 20) & 0xFu; }
#define XB_SPIN(cond, bar) do { unsigned _sp = 0; while (cond) { __builtin_amdgcn_s_sleep(1); \
    if ((++_sp & 255u) == 0u) { if (xb_ld(&(bar)[XB_TMO])) break; if (_sp > XB_SPIN_CAP) { atomicAdd(&(bar)[XB_TMO], 1u); break; } } } } while (0)
struct XcdBarrier { unsigned* bar; unsigned x; volatile LAS unsigned* st; };
__device__ __forceinline__ XcdBarrier xcd_barrier_post(unsigned* bar, volatile LAS unsigned* st) {
    XcdBarrier b; b.bar = bar; b.x = xb_xcc_id(); b.st = st;
    if (threadIdx.x == 0) (void)xb_add(&bar[XB_XCNT(b.x)], 1u);
    return b;
}
__device__ __forceinline__ void xcd_barrier_complete(unsigned* bar, unsigned x, unsigned& nloc, unsigned& nx) {
    const unsigned G = gridDim.x * gridDim.y * gridDim.z;
    unsigned sum, cnt, mine, sp = 0u;
    for (;;) {
        sum = 0u; cnt = 0u; mine = 0u;
#pragma unroll
        for (unsigned j = 0; j < 16; ++j) { const unsigned c = xb_ld(&bar[XB_XCNT(j)]); sum += c; cnt += (c > 0u) ? 1u : 0u; mine = (j == x) ? c : mine; }
        if (sum == G) break;
        __builtin_amdgcn_s_sleep(1);
        if ((++sp & 255u) == 0u) { if (xb_ld(&bar[XB_TMO])) break; if (sp > XB_SPIN_CAP) { atomicAdd(&bar[XB_TMO], 1u); break; } }
    }
    nloc = mine > 0u ? mine : 1u; nx = cnt > 0u ? cnt : 1u;
}
__device__ __forceinline__ void xcd_barrier(const XcdBarrier& b) {
    asm volatile("s_waitcnt vmcnt(0)" ::: "memory");
    __syncthreads();
    if (threadIdx.x == 0) {
        unsigned* bar = b.bar;
        __builtin_amdgcn_s_waitcnt(0);
        unsigned nloc = b.st[0], nx = b.st[1];
        if (nloc == 0u) { xcd_barrier_complete(bar, b.x, nloc, nx); b.st[0] = nloc; b.st[1] = nx; }
        const unsigned old = xb_add(&bar[XB_XSUB(b.x)], 1u);
        const unsigned gen = old / nloc;
        if (old + 1u == (gen + 1u) * nloc) {
            __builtin_amdgcn_fence(__ATOMIC_RELEASE, "agent");
            asm volatile("s_waitcnt vmcnt(0)" ::: "memory");
            const unsigned og = xb_add(&bar[XB_TOP], 1u);
            const unsigned tg = og / nx;
            if (og + 1u == (tg + 1u) * nx) xb_add(&bar[XB_TOPGEN], 1u);
            else XB_SPIN(xb_ld(&bar[XB_TOPGEN]) == tg, bar);
            __builtin_amdgcn_fence(__ATOMIC_ACQUIRE, "agent");
            xb_add(&bar[XB_XGEN(b.x)], 1u);
            asm volatile("s_waitcnt vmcnt(0)" ::: "memory");
        } else {
            XB_SPIN(xb_ld(&bar[XB_XGEN(b.x)]) == gen, bar);
            __builtin_amdgcn_fence(__ATOMIC_ACQUIRE, "agent");
            asm volatile("s_waitcnt vmcnt(0)" ::: "memory");
        }
    }
    __syncthreads();
}

namespace gm {
constexpr int BM = 256, BK = 64, HALF = 128, HTB = HALF * BK * 2, STAGE_BYTES = 8 * HTB, NXCD = 8, WGM = 8;
__host__ __device__ __forceinline__ int lds_byte(int r, int c) { const int st = (r >> 4) * 2 + (c >> 5), rr = r & 15, cc = c & 31, ob = rr * 64 + cc * 2; return st * 1024 + (ob ^ (((ob >> 9) & 1) << 5)); }
__host__ __device__ __forceinline__ void stage_rc(int b, int& R, int& C) { const int st = b / 1024, sb = b % 1024, swz = sb ^ (((sb >> 9) & 1) << 5); R = (st >> 1) * 16 + swz / 64; C = (st & 1) * 32 + (swz % 64) / 2; }
__host__ __device__ __forceinline__ int perm32(int rho) { const int n = rho >> 4, i = rho & 15; return 8 * (i >> 2) + 4 * n + (i & 3); }

struct Unit { int pm, pn; const char* A; const char* B; int e, m0; };

__device__ __forceinline__ bool static_tile(int nM, int nN, int G, int c, int i, int& pm, int& pn) {
    const int nwg = nM * nN; const long L = (long)i * G + c; if (L >= nwg) return false;
    int wgid = (int)L; { const int q = nwg / NXCD, r = nwg % NXCD, xcd = wgid % NXCD, off = wgid / NXCD; wgid = (xcd < r ? xcd * (q + 1) : r * (q + 1) + (xcd - r) * q) + off; }
    const int nig = WGM * nN, gid = wgid / nig, fm = gid * WGM, gsz = (nM - fm) < WGM ? (nM - fm) : WGM;
    pm = fm + ((wgid % nig) % gsz); pn = (wgid % nig) / gsz; return true;
}
struct DenseSched {
    const char* A; const char* Bt; int nM, nN, G, c; unsigned lda_b, K;
    __device__ __forceinline__ bool next(int i, Unit& u) const { int pm, pn; if (!static_tile(nM, nN, G, c, i, pm, pn)) return false; u.pm = pm; u.pn = pn; u.A = A + (size_t)pm * BM * lda_b; u.B = Bt + (size_t)pn * BM * K * 2; u.e = 0; u.m0 = 0; return true; }
    __device__ __forceinline__ unsigned arow(const Unit&, int r) const { return (unsigned)r * lda_b; }
};

template <class Epi, class Sched>
__device__ __forceinline__ void gemm_phase(LAS unsigned char* lds, const Sched& S, const Epi& E, const int K, const unsigned kstepA) {
    const int tid = threadIdx.x, wid = __builtin_amdgcn_readfirstlane(tid >> 6), lane = tid & 63, wr = wid >> 2, wc = wid & 3, fr = lane & 15, fq = lane >> 4;
    const int nt = K / BK;
    int R0, C0; stage_rc(tid * 16, R0, C0);
    unsigned voffB[2];
#pragma unroll
    for (int i = 0; i < 2; ++i) { const int R = R0 + 64 * i; const int Rb = Epi::PERM ? ((R & ~31) + perm32(R & 31)) : R; voffB[i] = (unsigned)(Rb * K + C0) * 2u; }
    const unsigned ca = (unsigned)C0 * 2u;
    const size_t kstepB = (size_t)(BK * 2);
    const size_t hstepB = (size_t)HALF * K * 2;
    const unsigned ldsw = (unsigned)wid * 1024u;
    const int aoff = lds_byte(wr * 64 + fr, fq * 8), boff = lds_byte(wc * 32 + fr, fq * 8);
#define GM_SA(b, h) (((b) * 2 + (h)) * HTB)
#define GM_SB(b, h) ((4 + (b) * 2 + (h)) * HTB)
#define GM_STAGEB(bufoff, gbase) do { _Pragma("unroll") for (int _i = 0; _i < 2; ++_i) \
        __builtin_amdgcn_global_load_lds((const unsigned*)((const char*)(gbase) + voffB[_i]), (LAS unsigned*)(lds + (bufoff) + ldsw + _i * 8192), 16, 0, 0); } while (0)
#define GM_STAGEA(bufoff, abase, offs, h, kb) do { _Pragma("unroll") for (int _i = 0; _i < 2; ++_i) \
        __builtin_amdgcn_global_load_lds((const unsigned*)((const char*)(abase) + (offs)[2 * (h) + _i] + (kb)), (LAS unsigned*)(lds + (bufoff) + ldsw + _i * 8192), 16, 0, 0); } while (0)
#define GM_LDA(dst, b, h) do { _Pragma("unroll") for (int m = 0; m < 4; ++m) _Pragma("unroll") for (int k = 0; k < 2; ++k) dst[m][k] = *(const LAS bf16x8*)(lds + GM_SA(b, h) + aoff + m * 2048 + k * 1024); } while (0)
#define GM_LDB(dst, b, h) do { _Pragma("unroll") for (int n = 0; n < 2; ++n) _Pragma("unroll") for (int k = 0; k < 2; ++k) dst[n][k] = *(const LAS bf16x8*)(lds + GM_SB(b, h) + boff + n * 2048 + k * 1024); } while (0)
#define GM_MMA(ai, bj, At, Bt) do { __builtin_amdgcn_s_setprio(1); _Pragma("unroll") for (int m = 0; m < 4; ++m) _Pragma("unroll") for (int n = 0; n < 2; ++n) _Pragma("unroll") for (int k = 0; k < 2; ++k) \
        acc[ai][bj][m][n] = __builtin_amdgcn_mfma_f32_16x16x32_bf16(Bt[n][k], At[m][k], acc[ai][bj][m][n], 0, 0, 0); __builtin_amdgcn_s_setprio(0); } while (0)
#define GM_WAIT_V(n) asm volatile("s_waitcnt vmcnt(" #n ")" ::: "memory")
#define GM_WAIT_L(n) asm volatile("s_waitcnt lgkmcnt(" #n ")" ::: "memory")
#define GM_BAR __builtin_amdgcn_s_barrier()
#define GM_SCHED __builtin_amdgcn_sched_barrier(0)
    Unit cur, nxt; int ui = 0;
    if (!S.next(0, cur)) return;
    unsigned coff[4], noff[4];
#pragma unroll
    for (int q = 0; q < 4; ++q) { coff[q] = S.arow(cur, R0 + 64 * q) + ca; noff[q] = coff[q]; }
    f32x4 acc[2][2][4][2];
#pragma unroll
    for (int a = 0; a < 2; ++a)
#pragma unroll
        for (int b = 0; b < 2; ++b)
#pragma unroll
            for (int m = 0; m < 4; ++m)
#pragma unroll
                for (int n = 0; n < 2; ++n) acc[a][b][m][n] = (f32x4){0.f, 0.f, 0.f, 0.f};
    bf16x8 At[4][2], B0[2][2], B1[2][2];
    const char* cA = cur.A; const char* cB = cur.B;
    GM_STAGEB(GM_SB(0, 0), cB); GM_STAGEB(GM_SB(0, 1), cB + hstepB); GM_STAGEA(GM_SA(0, 0), cA, coff, 0, 0u); GM_STAGEA(GM_SA(0, 1), cA, coff, 1, 0u);
    if (wr == 1) GM_BAR;
    GM_WAIT_V(2); GM_BAR;
    GM_STAGEB(GM_SB(1, 0), cB + kstepB); GM_STAGEA(GM_SA(1, 0), cA, coff, 0, kstepA); GM_STAGEB(GM_SB(1, 1), cB + hstepB + kstepB);
    GM_WAIT_V(6); GM_BAR;
    for (;;) {
        const bool has_next = S.next(ui + 1, nxt);
        const char* nA = has_next ? nxt.A : cA; const char* nB = has_next ? nxt.B : cB;
        if (has_next) {
#pragma unroll
            for (int q = 0; q < 4; ++q) noff[q] = S.arow(nxt, R0 + 64 * q) + ca;
        } else {
#pragma unroll
            for (int q = 0; q < 4; ++q) noff[q] = coff[q];
        }
#pragma unroll 1
        for (int t = 0; t < nt; t += 2) {
            const bool last = (t == nt - 2);
            const unsigned k1 = (unsigned)(t + 1) * kstepA;
            const char* a2 = last ? nA : cA; const unsigned k2 = last ? 0u : (unsigned)(t + 2) * kstepA, k3 = k2 + kstepA;
            unsigned o2[4];
#pragma unroll
            for (int q = 0; q < 4; ++q) o2[q] = last ? noff[q] : coff[q];
            const char* b2 = last ? nB : cB + (size_t)(t + 2) * kstepB; const char* b3 = b2 + kstepB;
            GM_LDB(B0, 0, 0); GM_LDB(B1, 0, 1); GM_SCHED; GM_LDA(At, 0, 0); GM_STAGEA(GM_SA(1, 1), cA, coff, 1, k1);
            GM_WAIT_V(8); GM_WAIT_L(0); GM_BAR; GM_MMA(0, 0, At, B0); GM_MMA(0, 1, At, B1); GM_BAR; GM_SCHED;
            GM_LDA(At, 0, 1); GM_STAGEB(GM_SB(0, 0), b2); GM_STAGEB(GM_SB(0, 1), b2 + hstepB); GM_STAGEA(GM_SA(0, 0), a2, o2, 0, k2);
            GM_WAIT_V(8); GM_WAIT_L(0); GM_BAR; GM_MMA(1, 0, At, B0); GM_MMA(1, 1, At, B1); GM_BAR; GM_SCHED;
            GM_LDB(B0, 1, 0); GM_LDB(B1, 1, 1); GM_SCHED; GM_LDA(At, 1, 0); GM_STAGEA(GM_SA(0, 1), a2, o2, 1, k2);
            GM_WAIT_V(8); GM_WAIT_L(0); GM_BAR; GM_MMA(0, 0, At, B0); GM_MMA(0, 1, At, B1); GM_BAR; GM_SCHED;
            GM_LDA(At, 1, 1); GM_STAGEB(GM_SB(1, 0), b3); GM_STAGEB(GM_SB(1, 1), b3 + hstepB); GM_STAGEA(GM_SA(1, 0), a2, o2, 0, k3);
            GM_WAIT_V(8); GM_WAIT_L(0); GM_BAR; GM_MMA(1, 0, At, B0); GM_MMA(1, 1, At, B1); GM_BAR; GM_SCHED;
        }
        if (wr == 0) GM_BAR;
        E(acc, cur, wr, wc, fr, fq);
        if (!has_next) break;
#pragma unroll
        for (int a = 0; a < 2; ++a)
#pragma unroll
            for (int b = 0; b < 2; ++b)
#pragma unroll
                for (int m = 0; m < 4; ++m)
#pragma unroll
                    for (int n = 0; n < 2; ++n) acc[a][b][m][n] = (f32x4){0.f, 0.f, 0.f, 0.f};
        cur = nxt; cA = nA; cB = nB; ++ui;
#pragma unroll
        for (int q = 0; q < 4; ++q) coff[q] = noff[q];
        if (wr == 1) GM_BAR;
    }
    GM_WAIT_V(0);
    GM_BAR;
#undef GM_SA
#undef GM_SB
#undef GM_STAGEA
#undef GM_STAGEB
#undef GM_LDA
#undef GM_LDB
#undef GM_MMA
#undef GM_WAIT_V
#undef GM_WAIT_L
#undef GM_BAR
#undef GM_SCHED
}

struct EpiBf16 {
    static constexpr bool PERM = true;
    bf16_t* O; int ldc;
    __device__ __forceinline__ void operator()(const f32x4 (&acc)[2][2][4][2], const Unit& u, int wr, int wc, int fr, int fq) const {
        const int row0 = u.pm * BM + wr * 64 + fr, col0 = u.pn * BM + wc * 32 + 8 * fq;
#pragma unroll
        for (int ai = 0; ai < 2; ++ai)
#pragma unroll
            for (int m = 0; m < 4; ++m) { bf16_t* rowp = O + (size_t)(row0 + ai * HALF + m * 16) * ldc + col0;
#pragma unroll
                for (int bj = 0; bj < 2; ++bj) { const f32x4 v0 = acc[ai][bj][m][0], v1 = acc[ai][bj][m][1];
                    v4u w; w.x = cvt_pk_bf16(v0[0], v0[1]); w.y = cvt_pk_bf16(v0[2], v0[3]); w.z = cvt_pk_bf16(v1[0], v1[1]); w.w = cvt_pk_bf16(v1[2], v1[3]);
                    *(v4u*)(rowp + bj * HALF) = w; } }
    }
};
struct EpiRes {
    static constexpr bool PERM = false;
    const float* x; const float* mod; int chunk; float* out;
    __device__ __forceinline__ void operator()(const f32x4 (&acc)[2][2][4][2], const Unit& u, int wr, int wc, int fr, int fq) const {
        const int row0 = u.pm * BM + wr * 64 + fr, col0 = u.pn * BM + wc * 32 + 4 * fq; const int b = (u.pm * BM) / SEQ;
        f32x4 gv[2][2];
#pragma unroll
        for (int bj = 0; bj < 2; ++bj)
#pragma unroll
            for (int n = 0; n < 2; ++n) gv[bj][n] = *(const f32x4*)(mod + (size_t)b * 6144 + chunk * 1024 + col0 + bj * HALF + n * 16);
#pragma unroll
        for (int ai = 0; ai < 2; ++ai)
#pragma unroll
            for (int m = 0; m < 4; ++m) { const size_t off = (size_t)(row0 + ai * HALF + m * 16) * 1024 + col0;
#pragma unroll
                for (int bj = 0; bj < 2; ++bj)
#pragma unroll
                    for (int n = 0; n < 2; ++n) { const f32x4 xv = *(const f32x4*)(x + off + bj * HALF + n * 16); *(f32x4*)(out + off + bj * HALF + n * 16) = xv + gv[bj][n] * acc[ai][bj][m][n]; } }
    }
};
}
#ifndef PROBE_REP
#define PROBE_REP -1
#endif
constexpr int RING_BYTES = 131072, LDSCTL_OFF = RING_BYTES, MISC_OFF = LDSCTL_OFF + 320, LDS_BYTES = 147456;
constexpr int CW_BAR = 4096;
constexpr int CW_ECNT = 65536;

struct Args { const float* in[25]; float* out; unsigned char* ws; int ph_lo, ph_hi, rep, pad; };
struct Frame {
    LAS unsigned char* lds; volatile LAS unsigned* MISC; unsigned* ctl; unsigned char* ws;
    int tid, lane, wave, vcu, G;
    const float* in[25]; float* out;
};
#define IN_X 0
#define IN_C 1
#define IN_WADA 2
#define IN_BADA 3
#define IN_N1G 4
#define IN_WIN 5
#define IN_LBL 6
#define IN_HNG 7
#define IN_PEK 8
#define IN_W1K 9
#define IN_B1K 10
#define IN_W2K 11
#define IN_PEV 12
#define IN_W1V 13
#define IN_B1V 14
#define IN_W2V 15
#define IN_WOUT 16
#define IN_N2G 17
#define IN_RW 18
#define IN_RB 19
#define IN_WGU 20
#define IN_WDN 21
#define IN_WSGU 22
#define IN_WSDN 23
#define IN_FG 24

template <bool FRAG = false> __device__ __forceinline__ void p0_transpose_item(const float* W, int K, int N, bf16_t* WT, int drow0, int k0, int n0, LAS float* scr, int lane) {
    const int kq = lane >> 3, nq = lane & 7; const int nn = n0 + 4 * nq; const bool ok = nn < N;
    f32x4 v[8];
#pragma unroll
    for (int i = 0; i < 8; ++i) v[i] = ok ? *(const f32x4*)(W + (size_t)(k0 + 8 * i + kq) * N + nn) : (f32x4){0.f, 0.f, 0.f, 0.f};
#pragma unroll
    for (int i = 0; i < 8; ++i) { LAS float* d = scr + (8 * i + kq) * 33 + 4 * nq; d[0] = v[i][0]; d[1] = v[i][1]; d[2] = v[i][2]; d[3] = v[i][3]; }
    LDS_WAIT(); asm volatile("" ::: "memory");
    const int c = lane & 7;
#pragma unroll
    for (int j = 0; j < 4; ++j) { const int n = (lane >> 3) + 8 * j; const LAS float* s = scr + (8 * c) * 33 + n;
        v4u o; o.x = pk2(s[0 * 33], s[1 * 33]); o.y = pk2(s[2 * 33], s[3 * 33]); o.z = pk2(s[4 * 33], s[5 * 33]); o.w = pk2(s[6 * 33], s[7 * 33]);
        if (FRAG) { const int kk = k0 + 8 * c, col = drow0 + n; *(v4u*)(WT + ((size_t)((kk >> 5) * (N / 16) + (col >> 4)) * 64 + ((kk & 31) >> 3) * 16 + (col & 15)) * 8) = o; }
        else *(v4u*)(WT + (size_t)(drow0 + n) * K + k0 + 8 * c) = o; }
    LDS_WAIT(); asm volatile("" ::: "memory");
}
__device__ __forceinline__ int gu_row(int n) { const int j = n & 255; return (j >> 7) * 256 + ((n >> 8) << 7) + (j & 127); }

__device__ __forceinline__ void p0_prologue(Frame& F) {
    unsigned char* ws = F.ws;
    if (F.vcu < 256) {
        LAS float* ca = (LAS float*)F.lds;
        const int ks = F.vcu >> 4, cg = F.vcu & 15;
        if (F.tid < 256) { const int b = F.tid >> 6, k = F.tid & 63; ca[F.tid] = fsilu(F.in[IN_C][b * D + ks * 64 + k]); }
        __syncthreads();
        if (F.tid < 384) { const int n = cg * 384 + F.tid; const float* w = F.in[IN_WADA] + (size_t)(ks * 64) * 6144 + n; float a0 = 0.f, a1 = 0.f, a2 = 0.f, a3 = 0.f;
#pragma unroll 8
            for (int k = 0; k < 64; ++k) { const float wv = w[(size_t)k * 6144]; a0 += ca[k] * wv; a1 += ca[64 + k] * wv; a2 += ca[128 + k] * wv; a3 += ca[192 + k] * wv; }
            float* mp = (float*)(ws + WS_MODP) + (size_t)ks * 4 * 6144 + n; mp[0] = a0; mp[6144] = a1; mp[2 * 6144] = a2; mp[3 * 6144] = a3; }
        __syncthreads();
    }
    { float* cs = (float*)(ws + WS_CS); float* sn = (float*)(ws + WS_SN);
      for (int i = F.vcu * NTHR + F.tid; i < SEQ * 32; i += F.G * NTHR) { const int pos = i >> 5, k = i & 31; const float inv = powf(10000.0f, -(float)k / 32.0f); const float ang = (float)pos * inv; cs[i] = cosf(ang); sn[i] = sinf(ang); } }
    LAS float* scr = (LAS float*)(F.lds + 4096 + F.wave * 8704);
    const int gw = F.vcu * NWAVES + F.wave, NGW = F.G * NWAVES;
    constexpr int I_IN = 16 * 105, I_OUT = 16 * 32, I_GU = 16 * 16, I_DN = 4 * 32, I_W1 = 32 * 8;
    constexpr int NIT = I_IN + I_OUT + 64 * I_GU + 64 * I_DN + I_GU + I_DN + 2 * I_W1;
    for (int it = gw; it < NIT; it += NGW) {
        int r = it;
        if (r < I_IN) { const int kb = r / 105, nb = r % 105; p0_transpose_item(F.in[IN_WIN], 1024, INC, (bf16_t*)(ws + WS_WINT), 32 * nb, 64 * kb, 32 * nb, scr, F.lane); continue; } r -= I_IN;
        if (r < I_OUT) { const int kb = r / 32, nb = r % 32; p0_transpose_item(F.in[IN_WOUT], 1024, 1024, (bf16_t*)(ws + WS_WOUTT), 32 * nb, 64 * kb, 32 * nb, scr, F.lane); continue; } r -= I_OUT;
        if (r < 64 * I_GU) { const int e = r / I_GU, q = r % I_GU, kb = q / 16, nb = q % 16;
            p0_transpose_item(F.in[IN_WGU] + (size_t)e * 1024 * 512, 1024, 512, (bf16_t*)(ws + WS_WGUT) + (size_t)e * 512 * 1024, gu_row(32 * nb), 64 * kb, 32 * nb, scr, F.lane); continue; } r -= 64 * I_GU;
        if (r < 64 * I_DN) { const int e = r / I_DN, q = r % I_DN, kb = q / 32, nb = q % 32;
            p0_transpose_item(F.in[IN_WDN] + (size_t)e * 256 * 1024, 256, 1024, (bf16_t*)(ws + WS_WDNT) + (size_t)e * 1024 * 256, 32 * nb, 64 * kb, 32 * nb, scr, F.lane); continue; } r -= 64 * I_DN;
        if (r < I_GU) { const int kb = r / 16, nb = r % 16; p0_transpose_item(F.in[IN_WSGU], 1024, 512, (bf16_t*)(ws + WS_WSGUT), gu_row(32 * nb), 64 * kb, 32 * nb, scr, F.lane); continue; } r -= I_GU;
        if (r < I_DN) { const int kb = r / 32, nb = r % 32; p0_transpose_item(F.in[IN_WSDN], 256, 1024, (bf16_t*)(ws + WS_WSDNT), 32 * nb, 64 * kb, 32 * nb, scr, F.lane); continue; } r -= I_DN;
        { const int kv = r / I_W1, q = r % I_W1, kb = q / 8, nb = q % 8;
          p0_transpose_item<true>(F.in[kv ? IN_W1V : IN_W1K], 2048, 256, (bf16_t*)(ws + (kv ? WS_W1VT : WS_W1KT)), 32 * nb, 64 * kb, 32 * nb, scr, F.lane); }
    }
    { v4u* z = (v4u*)((bf16_t*)(ws + WS_WINT) + (size_t)3360 * 1024); const int n16 = 224 * 1024 * 2 / 16;
      for (int i = F.vcu * NTHR + F.tid; i < n16; i += F.G * NTHR) z[i] = (v4u){0u, 0u, 0u, 0u}; }
    { bf16_t* w2f = (bf16_t*)(ws + WS_W2T);
      for (int i = F.vcu * NTHR + F.tid; i < 2 * 256 * 64; i += F.G * NTHR) { const int kv = i >> 14, r = i & 16383, k = r >> 6, dd = r & 63; const float v = F.in[kv ? IN_W2V : IN_W2K][r];
          w2f[(size_t)kv * 16384 + ((size_t)((k >> 5) * 4 + (dd >> 4)) * 64 + ((k & 31) >> 3) * 16 + (dd & 15)) * 8 + (k & 7)] = f2bf(v); } }
    { bf16_t* hi = (bf16_t*)(ws + WS_RW); bf16_t* lo = hi + 64 * 1024; const float* rw = F.in[IN_RW];
      for (int i = F.vcu * NTHR + F.tid; i < 64 * 1024; i += F.G * NTHR) { const int k = i >> 6, e = i & 63; const float w = rw[i]; const bf16_t h = f2bf(w);
          const size_t o = ((size_t)((k >> 5) * 4 + (e >> 4)) * 64 + ((k & 31) >> 3) * 16 + (e & 15)) * 8 + (k & 7); hi[o] = h; lo[o] = f2bf(w - bf2f(h)); } }
}

__device__ __forceinline__ void p1a_norm(Frame& F) {
    unsigned char* ws = F.ws; const float* modp = (const float*)(ws + WS_MODP); const float* bada = F.in[IN_BADA];
    for (int i = F.vcu * NTHR + F.tid; i < BATCH * 6144; i += F.G * NTHR) { float a = bada[i % 6144];
#pragma unroll
        for (int ks = 0; ks < 16; ++ks) a += modp[(size_t)ks * 4 * 6144 + i];
        ((float*)(ws + WS_MOD))[i] = a; }
    for (int o = F.vcu * NWAVES + F.wave; o < 512; o += F.G * NWAVES) { const int kv = o >> 8, j = o & 255; const float* pe = F.in[kv ? IN_PEV : IN_PEK];
        const bf16_t* wf = (const bf16_t*)(ws + (kv ? WS_W1VT : WS_W1KT)); float a = 0.f;
#pragma unroll
        for (int i = 0; i < 4; ++i) { const int cid = F.lane + 64 * i, s = cid >> 2, q = cid & 3; const v4u wv = *(const v4u*)(wf + ((size_t)(s * 16 + (j >> 4)) * 64 + q * 16 + (j & 15)) * 8);
            const f32x4 p0 = *(const f32x4*)(pe + 32 * s + 8 * q), p1 = *(const f32x4*)(pe + 32 * s + 8 * q + 4);
            a += bf2f((bf16_t)(wv.x & 0xffff)) * p0[0] + bf2f((bf16_t)(wv.x >> 16)) * p0[1] + bf2f((bf16_t)(wv.y & 0xffff)) * p0[2] + bf2f((bf16_t)(wv.y >> 16)) * p0[3]
               + bf2f((bf16_t)(wv.z & 0xffff)) * p1[0] + bf2f((bf16_t)(wv.z >> 16)) * p1[1] + bf2f((bf16_t)(wv.w & 0xffff)) * p1[2] + bf2f((bf16_t)(wv.w >> 16)) * p1[3]; }
        a = wave_sum(a); if (F.lane == 0) ((float*)(ws + WS_B1F))[o] = a + F.in[kv ? IN_B1V : IN_B1K][j]; }
    LAS float* sh = (LAS float*)F.lds; LAS float* sc = sh + 1024;
    const float* g1 = F.in[IN_N1G]; const float* x = F.in[IN_X]; bf16_t* xn = (bf16_t*)(ws + WS_XN);
    for (int chunk = F.vcu; chunk < T / 64; chunk += F.G) {
        const int b = (chunk * 64) / SEQ;
        __syncthreads();
        for (int i = F.tid; i < 2048; i += NTHR) { const int col = i; float a = bada[col];
#pragma unroll
            for (int ks = 0; ks < 16; ++ks) a += modp[(size_t)(ks * 4 + b) * 6144 + col];
            sh[i] = a; }
        __syncthreads();
#pragma unroll 1
        for (int rr = 0; rr < 8; ++rr) {
            const int row = chunk * 64 + F.wave * 8 + rr; const f32x4* xr = (const f32x4*)(x + (size_t)row * D) + F.lane;
            f32x4 v[4]; float s = 0.f;
#pragma unroll
            for (int j = 0; j < 4; ++j) { v[j] = xr[64 * j]; s += (v[j].x * v[j].x + v[j].y * v[j].y) + (v[j].z * v[j].z + v[j].w * v[j].w); }
            const float rstd = 1.0f / sqrtf(wave_sum(s) * (1.0f / D) + EPS);
            unsigned long long* o8 = (unsigned long long*)(xn + (size_t)row * D) + F.lane;
#pragma unroll
            for (int j = 0; j < 4; ++j) { const int c0 = 4 * F.lane + 256 * j; const f32x4 g = *(const f32x4*)(g1 + c0);
                const float h0 = v[j].x * rstd * g.x * (1.0f + sc[c0]) + sh[c0], h1 = v[j].y * rstd * g.y * (1.0f + sc[c0 + 1]) + sh[c0 + 1];
                const float h2 = v[j].z * rstd * g.z * (1.0f + sc[c0 + 2]) + sh[c0 + 2], h3 = v[j].w * rstd * g.w * (1.0f + sc[c0 + 3]) + sh[c0 + 3];
                o8[64 * j] = (unsigned long long)pk2(h0, h1) | ((unsigned long long)pk2(h2, h3) << 32); }
        }
    }
    __syncthreads();
}


__device__ __forceinline__ float hg_lb(const float* lbl, int j) { return 1.0f / (1.0f + expf(lbl[512 + j] - lbl[j])); }
__device__ __forceinline__ void hg_passA(Frame& F, int unit) {
    unsigned char* ws = F.ws; const bf16_t* proj = (const bf16_t*)(ws + WS_PROJ); float* U = (float*)(ws + WS_U) + (size_t)unit * 16384; float* Dd = (float*)(ws + WS_DD) + (size_t)unit * 128;
    const int b = unit >> 6, h = (unit >> 4) & 3, J = unit & 15; const size_t tok0 = (size_t)b * SEQ + 256 * J;
    const int d = F.tid & 127, g = F.tid >> 7;
    LAS unsigned char* KT = F.lds; LAS unsigned char* VT = F.lds + 65536; LAS float* segtot = (LAS float*)(F.lds + LDSCTL_OFF + 512);
    const float lb = hg_lb(F.in[IN_LBL], h * 128 + d);
    const bf16_t* pf = proj + (tok0 + 64 * g) * LDP + C_HF + h * 128 + d; const bf16_t* pv = proj + (tok0 + 64 * g) * LDP + C_HI + h * 128 + d;
    __syncthreads();
    float fs[64]; unsigned short vraw[64];
#pragma unroll
    for (int s = 0; s < 64; ++s) { fs[s] = bf2f(pf[(size_t)s * LDP]); vraw[s] = pv[(size_t)s * LDP]; }
    float sum = 0.f;
#pragma unroll
    for (int s = 0; s < 64; ++s) { const float f = lb + (1.0f - lb) * fsigmoid(fs[s]); fs[s] = f; sum += __logf(f); }
    segtot[g * 128 + d] = sum;
    __syncthreads();
    float off = 0.f, Bt = 0.f;
#pragma unroll
    for (int k = 0; k < 4; ++k) { const float v = segtot[k * 128 + d]; Bt += v; if (k < g) off += v; }
    float run = off;
#pragma unroll
    for (int s8 = 0; s8 < 8; ++s8) { unsigned kk[4], vv[4];
#pragma unroll
        for (int i = 0; i < 4; ++i) { float kt[2];
#pragma unroll
            for (int j = 0; j < 2; ++j) { const int s = 8 * s8 + 2 * i + j; const float f = fs[s]; run += __logf(f); kt[j] = (1.0f - f) * fexp(Bt - run); }
            kk[i] = pk2(kt[0], kt[1]); vv[i] = (unsigned)vraw[8 * s8 + 2 * i] | ((unsigned)vraw[8 * s8 + 2 * i + 1] << 16); }
        const int c = (8 * g + s8) ^ (d & 31);
        *(LAS v4u*)(KT + d * 512 + c * 16) = (v4u){kk[0], kk[1], kk[2], kk[3]}; *(LAS v4u*)(VT + d * 512 + c * 16) = (v4u){vv[0], vv[1], vv[2], vv[3]}; }
    if (g == 0) Dd[d] = fexp(Bt);
    __syncthreads();
    const int dt = F.wave >> 1, et0 = 2 * (F.wave & 1), i = F.lane & 31, hh = F.lane >> 5;
    f32x16 acc[2];
#pragma unroll
    for (int k = 0; k < 16; ++k) { acc[0][k] = 0.f; acc[1][k] = 0.f; }
#pragma unroll 4
    for (int st = 0; st < 16; ++st) { const int ch = 2 * st + hh;
        const bf16x8 a = *(const LAS bf16x8*)(KT + (32 * dt + i) * 512 + ((ch ^ i) & 31) * 16);
#pragma unroll
        for (int t = 0; t < 2; ++t) { const bf16x8 bv = *(const LAS bf16x8*)(VT + (32 * (et0 + t) + i) * 512 + ((ch ^ i) & 31) * 16);
            acc[t] = __builtin_amdgcn_mfma_f32_32x32x16_bf16(a, bv, acc[t], 0, 0, 0); } }
#pragma unroll
    for (int t = 0; t < 2; ++t)
#pragma unroll
        for (int r = 0; r < 16; ++r) U[(size_t)(32 * dt + (r & 3) + 8 * (r >> 2) + 4 * hh) * 128 + 32 * (et0 + t) + i] = acc[t][r];
    __syncthreads();
}
__device__ __forceinline__ void hg_passC(Frame& F, int unit) {
    unsigned char* ws = F.ws; const bf16_t* proj = (const bf16_t*)(ws + WS_PROJ); bf16_t* mix = (bf16_t*)(ws + WS_MIX);
    const float* Uall = (const float*)(ws + WS_U); const float* Dall = (const float*)(ws + WS_DD);
    const int b = unit >> 6, h = (unit >> 4) & 3, J = unit & 15; const size_t tok0 = (size_t)b * SEQ + 256 * J;
    const int w = F.wave, n = F.lane & 15, q = F.lane >> 4;
    LAS bf16_t* Qs = (LAS bf16_t*)F.lds; LAS bf16_t* Kh = Qs + 16 * 136; LAS bf16_t* Kt = Kh + 16 * 136; LAS bf16_t* Vt = Kt + 128 * 24;
    LAS float* G = (LAS float*)(Vt + 128 * 24); LAS float* TQ = G + 128; LAS float* SSP = TQ + 512;
    f32x4 S[8];
#pragma unroll
    for (int dt = 0; dt < 8; ++dt) S[dt] = (f32x4){0.f, 0.f, 0.f, 0.f};
#ifndef PROBE_HGC
#define PROBE_HGC 0
#endif
    for (int rp_ = 0; rp_ < (PROBE_HGC == 1 ? 2 : 1); ++rp_) {
#pragma unroll
    for (int dt = 0; dt < 8; ++dt) S[dt] = (f32x4){0.f, 0.f, 0.f, 0.f};
    {
        LAS float* WJ = (LAS float*)F.lds;
        __syncthreads();
        if (F.tid < 128) { float wgt = 1.0f; for (int j = J - 1; j >= 0; --j) { WJ[j * 128 + F.tid] = wgt; wgt *= Dall[(size_t)(unit - J + j) * 128 + F.tid]; } }
        __syncthreads();
#pragma unroll 2
        for (int j = 0; j < J; ++j) { const float* Uj = Uall + (size_t)(unit - J + j) * 16384;
#pragma unroll
            for (int dt = 0; dt < 8; ++dt) { const f32x4 wv = *(const LAS f32x4*)(WJ + j * 128 + 16 * dt + 4 * q);
#pragma unroll
                for (int r = 0; r < 4; ++r) S[dt][r] += wv[r] * Uj[(size_t)(16 * dt + 4 * q + r) * 128 + 16 * w + n]; } }
        __syncthreads();
    }
    }
    const int d = F.tid & 127, tq = F.tid >> 7; const float lb = hg_lb(F.in[IN_LBL], h * 128 + d);
    const float ngv0 = 0.f; (void)ngv0;
    unsigned short rf[4], rq[4], rv[4]; v2u rgate;
    const int e0 = h * 128 + 16 * w + 4 * q;
#pragma unroll
    for (int i = 0; i < 4; ++i) { const bf16_t* pr = proj + (tok0 + 4 * tq + i) * LDP + h * 128 + d; rf[i] = pr[C_HF]; rq[i] = pr[C_HQ]; rv[i] = pr[C_HI]; }
    rgate = *(const v2u*)(proj + (tok0 + n) * LDP + C_HGT + e0);
#pragma unroll 1
    for (int blk = 0; blk < 16; ++blk) {
        const size_t t0 = tok0 + 16 * blk;
        __syncthreads();
        float fv[4], pr[4], qv[4]; unsigned short vb[4]; float tot = 1.f;
#pragma unroll
        for (int i = 0; i < 4; ++i) { const float f = lb + (1.0f - lb) * fsigmoid(bf2f(rf[i])); fv[i] = f; tot *= f; pr[i] = tot; qv[i] = bf2f(rq[i]) * 0.08838834764831845f; vb[i] = rv[i]; }
        const v2u gt = rgate;
        if (blk < 15) {
#pragma unroll
            for (int i = 0; i < 4; ++i) { const bf16_t* pr_ = proj + (t0 + 16 + 4 * tq + i) * LDP + h * 128 + d; rf[i] = pr_[C_HF]; rq[i] = pr_[C_HQ]; rv[i] = pr_[C_HI]; }
            rgate = *(const v2u*)(proj + (t0 + 16 + n) * LDP + C_HGT + e0); }
        TQ[tq * 128 + d] = tot;
        __syncthreads();
        float off = 1.f, cc = 1.f;
#pragma unroll
        for (int k = 0; k < 4; ++k) { const float v = TQ[k * 128 + d]; cc *= v; if (k < tq) off *= v; }
        { unsigned kt2[2], v2[2];
#pragma unroll
          for (int i = 0; i < 4; ++i) { const float eb = off * pr[i], inv = __builtin_amdgcn_rcpf(eb); const int t = 4 * tq + i; const float kf = 1.0f - fv[i];
              Qs[t * 136 + d] = f2bf(qv[i] * eb); Kh[t * 136 + d] = f2bf(kf * inv);
              const unsigned short kb = f2bf(kf * cc * inv);
              if (i & 1) { kt2[i >> 1] |= (unsigned)kb << 16; v2[i >> 1] |= (unsigned)vb[i] << 16; } else { kt2[i >> 1] = kb; v2[i >> 1] = vb[i]; } }
          *(LAS v2u*)(Kt + d * 24 + 4 * tq) = (v2u){kt2[0], kt2[1]}; *(LAS v2u*)(Vt + d * 24 + 4 * tq) = (v2u){v2[0], v2[1]}; }
        if (tq == 0) G[d] = cc;
        __syncthreads();
        f32x4 pt = (f32x4){0.f, 0.f, 0.f, 0.f};
#pragma unroll
        for (int st = 0; st < 4; ++st) { const bf16x8 a = *(const LAS bf16x8*)(Kh + n * 136 + 32 * st + 8 * q), bq = *(const LAS bf16x8*)(Qs + n * 136 + 32 * st + 8 * q);
            pt = __builtin_amdgcn_mfma_f32_16x16x32_bf16(a, bq, pt, 0, 0, 0); }
        bf16x8 pB;
#pragma unroll
        for (int r = 0; r < 4; ++r) { pB[r] = (short)f2bf((4 * q + r) <= n ? pt[r] : 0.f); pB[4 + r] = 0; }
        f32x4 o = (f32x4){0.f, 0.f, 0.f, 0.f};
#pragma unroll
        for (int st = 0; st < 4; ++st) { bf16x8 a, bq;
            const v2u s0 = (v2u){cvt_pk_bf16(S[2 * st][0], S[2 * st][1]), cvt_pk_bf16(S[2 * st][2], S[2 * st][3])}, s1 = (v2u){cvt_pk_bf16(S[2 * st + 1][0], S[2 * st + 1][1]), cvt_pk_bf16(S[2 * st + 1][2], S[2 * st + 1][3])};
            a = __builtin_bit_cast(bf16x8, (v4u){s0.x, s0.y, s1.x, s1.y});
            const v2u q0 = *(const LAS v2u*)(Qs + n * 136 + 32 * st + 4 * q), q1 = *(const LAS v2u*)(Qs + n * 136 + 32 * st + 16 + 4 * q);
            bq = __builtin_bit_cast(bf16x8, (v4u){q0.x, q0.y, q1.x, q1.y});
            o = __builtin_amdgcn_mfma_f32_16x16x32_bf16(a, bq, o, 0, 0, 0); }
        { const v2u va = *(const LAS v2u*)(Vt + (16 * w + n) * 24 + 4 * q); const bf16x8 a = __builtin_bit_cast(bf16x8, (v4u){va.x, va.y, 0u, 0u});
          o = __builtin_amdgcn_mfma_f32_16x16x32_bf16(a, pB, o, 0, 0, 0); }
        { bf16x8 bv; if (q < 2) bv = *(const LAS bf16x8*)(Vt + (16 * w + n) * 24 + 8 * q); else bv = (bf16x8){0, 0, 0, 0, 0, 0, 0, 0};
#pragma unroll
          for (int dt = 0; dt < 8; ++dt) { const f32x4 gv = *(const LAS f32x4*)(G + 16 * dt + 4 * q); S[dt] = S[dt] * gv;
              bf16x8 a; if (q < 2) a = *(const LAS bf16x8*)(Kt + (16 * dt + n) * 24 + 8 * q); else a = (bf16x8){0, 0, 0, 0, 0, 0, 0, 0};
              S[dt] = __builtin_amdgcn_mfma_f32_16x16x32_bf16(a, bv, S[dt], 0, 0, 0); } }
        float ss = (o[0] * o[0] + o[1] * o[1]) + (o[2] * o[2] + o[3] * o[3]); ss += __shfl_xor(ss, 16); ss += __shfl_xor(ss, 32);
        if (q == 0) SSP[w * 16 + n] = ss;
        __syncthreads();
        float tots = 0.f;
#pragma unroll
        for (int k = 0; k < 8; ++k) tots += SSP[k * 16 + n];
        const float rstd = 1.0f / sqrtf(tots * (1.0f / 128.0f) + EPS);
        const f32x4 ng = *(const f32x4*)(F.in[IN_HNG] + e0);
        const float g0 = bf2f((bf16_t)(gt.x & 0xffff)), g1 = bf2f((bf16_t)(gt.x >> 16)), g2 = bf2f((bf16_t)(gt.y & 0xffff)), g3 = bf2f((bf16_t)(gt.y >> 16));
        v2u ov; ov.x = cvt_pk_bf16(o[0] * rstd * ng[0] * fsilu(g0), o[1] * rstd * ng[1] * fsilu(g1)); ov.y = cvt_pk_bf16(o[2] * rstd * ng[2] * fsilu(g2), o[3] * rstd * ng[3] * fsilu(g3));
        *(v2u*)(mix + (t0 + n) * D + e0) = ov;
    }
    __syncthreads();
}

constexpr int LG_P = 65;
__device__ __forceinline__ void p5_router(Frame& F) {
    unsigned char* ws = F.ws; const float* x2 = (const float*)(ws + WS_X2); const float* mod = (const float*)(ws + WS_MOD); const float* g2 = F.in[IN_N2G];
    const bf16_t* rwh = (const bf16_t*)(ws + WS_RW); const bf16_t* rwl = rwh + 64 * 1024; bf16_t* H2 = (bf16_t*)(ws + WS_H2);
    int* TOPI = (int*)(ws + WS_TOPI); float* TOPW = (float*)(ws + WS_TOPW); int* ROWL = (int*)(ws + WS_ROWL); int* ERANK = (int*)(ws + WS_ERANK); unsigned* ECNT = F.ctl + CW_ECNT;
    LAS float* LG = (LAS float*)F.lds;
    LAS float* GS = LG + 64 * LG_P;
    LAS float* WSL = GS + 512;
    LAS int* EI = (LAS int*)(WSL + 512);
    LAS unsigned* LCNT = (LAS unsigned*)(EI + 512);
    LAS unsigned* LBASE = LCNT + 64;
    LAS float* GSL = (LAS float*)(LBASE + 64);
    LAS float* SHL = GSL + 1024;
    const int r = F.lane & 15, q = F.lane >> 4, rt = F.wave & 3, eh = F.wave >> 2;
    for (int unit = F.vcu; unit < T / 64; unit += F.G) {
        const int row0 = unit * 64, b = row0 / SEQ, row = row0 + 16 * rt + r;
        __syncthreads();
        if (F.tid < 64) LCNT[F.tid] = 0u;
        for (int k = F.tid; k < 1024; k += NTHR) { GSL[k] = g2[k] * (1.0f + mod[(size_t)b * 6144 + 4 * 1024 + k]); SHL[k] = mod[(size_t)b * 6144 + 3 * 1024 + k]; }
        const float* xr = x2 + (size_t)row * D + 8 * q;
        float ss = 0.f;
#pragma unroll 8
        for (int s = 0; s < 32; ++s) { const f32x4 a = *(const f32x4*)(xr + 32 * s), c = *(const f32x4*)(xr + 32 * s + 4); ss += (a.x * a.x + a.y * a.y) + (a.z * a.z + a.w * a.w) + (c.x * c.x + c.y * c.y) + (c.z * c.z + c.w * c.w); }
        ss += __shfl_xor(ss, 16); ss += __shfl_xor(ss, 32);
        const float rstd = 1.0f / sqrtf(ss * (1.0f / D) + EPS);
        __syncthreads();
#ifndef PROBE_R7
#define PROBE_R7 0
#endif
        f32x4 acc[2];
        for (int rep7_ = 0; rep7_ <= PROBE_R7; ++rep7_) {
        acc[0] = (f32x4){0.f, 0.f, 0.f, 0.f}; acc[1] = acc[0];
        const bf16_t* rwh0 = rwh + ((size_t)(2 * eh) * 64 + F.lane) * 8; const bf16_t* rwl0 = rwl + ((size_t)(2 * eh) * 64 + F.lane) * 8;
#pragma unroll 1
        for (int s4 = 0; s4 < 32; s4 += 4) {
            f32x4 xa[4][2]; bf16x8 bh[4][2], bl[4][2];
#pragma unroll
            for (int u = 0; u < 4; ++u) { const int s = s4 + u; xa[u][0] = *(const f32x4*)(xr + 32 * s); xa[u][1] = *(const f32x4*)(xr + 32 * s + 4);
                bh[u][0] = *(const bf16x8*)(rwh0 + (size_t)s * 2048); bl[u][0] = *(const bf16x8*)(rwl0 + (size_t)s * 2048); bh[u][1] = *(const bf16x8*)(rwh0 + (size_t)s * 2048 + 512); bl[u][1] = *(const bf16x8*)(rwl0 + (size_t)s * 2048 + 512); }
#pragma unroll
            for (int u = 0; u < 4; ++u) { const int s = s4 + u; float gv[8], sh[8];
                *(f32x4*)&gv[0] = *(const LAS f32x4*)(GSL + 32 * s + 8 * q); *(f32x4*)&gv[4] = *(const LAS f32x4*)(GSL + 32 * s + 8 * q + 4);
                *(f32x4*)&sh[0] = *(const LAS f32x4*)(SHL + 32 * s + 8 * q); *(f32x4*)&sh[4] = *(const LAS f32x4*)(SHL + 32 * s + 8 * q + 4);
                bf16x8 ahi, alo;
#pragma unroll
                for (int j = 0; j < 8; ++j) { const float h = xa[u][j >> 2][j & 3] * rstd * gv[j] + sh[j]; const bf16_t hb = f2bf(h); ahi[j] = (short)hb; alo[j] = (short)f2bf(h - bf2f(hb)); }
                if (eh == 0) *(bf16x8*)(H2 + (size_t)row * D + 32 * s + 8 * q) = ahi;
                acc[0] = __builtin_amdgcn_mfma_f32_16x16x32_bf16(ahi, bh[u][0], acc[0], 0, 0, 0); acc[0] = __builtin_amdgcn_mfma_f32_16x16x32_bf16(ahi, bl[u][0], acc[0], 0, 0, 0); acc[0] = __builtin_amdgcn_mfma_f32_16x16x32_bf16(alo, bh[u][0], acc[0], 0, 0, 0);
                acc[1] = __builtin_amdgcn_mfma_f32_16x16x32_bf16(ahi, bh[u][1], acc[1], 0, 0, 0); acc[1] = __builtin_amdgcn_mfma_f32_16x16x32_bf16(ahi, bl[u][1], acc[1], 0, 0, 0); acc[1] = __builtin_amdgcn_mfma_f32_16x16x32_bf16(alo, bh[u][1], acc[1], 0, 0, 0); }
        }
        }
#pragma unroll
        for (int nt = 0; nt < 2; ++nt)
#pragma unroll
            for (int i = 0; i < 4; ++i) LG[(16 * rt + 4 * q + i) * LG_P + 32 * eh + 16 * nt + r] = acc[nt][i];
        __syncthreads();
        const int t = F.tid >> 3, g = F.tid & 7; const float* rb = F.in[IN_RB];
        float sc8[8], ch8[8]; float a1 = -3e38f, a2 = -3e38f;
#pragma unroll
        for (int j = 0; j < 8; ++j) { const float s_ = 1.0f / (1.0f + expf(-LG[t * LG_P + 8 * g + j])); sc8[j] = s_; const float c_ = s_ + rb[8 * g + j]; ch8[j] = c_; if (c_ > a1) { a2 = a1; a1 = c_; } else if (c_ > a2) a2 = c_; }
        GS[t * 8 + g] = a1 + a2;
        __syncthreads();
#pragma unroll
        for (int j = 0; j < 8; ++j) LG[t * LG_P + 8 * g + j] = ch8[j];
        int grank = 0; const float myg = GS[t * 8 + g];
#pragma unroll
        for (int k = 0; k < 8; ++k) { const float o = GS[t * 8 + k]; if (o > myg || (o == myg && k < g)) ++grank; }
        const bool gsel = grank < 4;
        const unsigned long long bal = __ballot(gsel); const unsigned gmask = (unsigned)(bal >> (F.lane & ~7)) & 0xffu;
        __syncthreads();
        if (gsel) {
            int rk[8];
#pragma unroll
            for (int j = 0; j < 8; ++j) rk[j] = 0;
            for (int k = 0; k < 8; ++k) { if (!((gmask >> k) & 1u)) continue;
#pragma unroll
                for (int jj = 0; jj < 8; ++jj) { const float o = LG[t * LG_P + 8 * k + jj]; const int oe = 8 * k + jj;
#pragma unroll
                    for (int j = 0; j < 8; ++j) { if (o > ch8[j] || (o == ch8[j] && oe < 8 * g + j)) ++rk[j]; } } }
#pragma unroll
            for (int j = 0; j < 8; ++j) if (rk[j] < 8) { WSL[t * 8 + rk[j]] = sc8[j]; EI[t * 8 + rk[j]] = 8 * g + j; }
        }
        __syncthreads();
        float wsum = 0.f;
#pragma unroll
        for (int k = 0; k < 8; ++k) wsum += WSL[t * 8 + k];
        const int e = EI[t * 8 + g]; const float w = WSL[t * 8 + g] / wsum * 2.5f;
        const int aid = (row0 + t) * 8 + g;
        TOPI[aid] = e; TOPW[aid] = w;
        const unsigned lp = atomicAdd((unsigned*)&LCNT[e], 1u);
        __syncthreads();
        if (F.tid < 64) { const unsigned c = LCNT[F.tid]; LBASE[F.tid] = c ? atomicAdd(&ECNT[F.tid], c) : 0u; }
        __syncthreads();
        { const unsigned rk = LBASE[e] + lp; ROWL[(size_t)e * T + rk] = aid; ERANK[aid] = (int)rk; }
    }
    __syncthreads();
}


struct MoeTabs { LAS unsigned* cnt; LAS unsigned* tstart; LAS unsigned short* tex; int ntr; };
__device__ __forceinline__ MoeTabs moe_tabs_build(Frame& F) {
    MoeTabs Tb; Tb.cnt = (LAS unsigned*)(F.lds + LDSCTL_OFF + 512); Tb.tstart = Tb.cnt + 64; Tb.tex = (LAS unsigned short*)(Tb.tstart + 68);
    __syncthreads();
    if (F.tid < 64) { unsigned c = __hip_atomic_load(F.ctl + CW_ECNT + F.tid, RLX_AGENT); Tb.cnt[F.tid] = c > (unsigned)T ? (unsigned)T : c; }
    __syncthreads();
    if (F.tid == 0) { unsigned a = 0; for (int e = 0; e < 64; ++e) { Tb.tstart[e] = a; a += (Tb.cnt[e] + 255u) >> 8; } Tb.tstart[64] = a; }
    __syncthreads();
    Tb.ntr = (int)Tb.tstart[64];
    for (int tau = F.tid; tau < Tb.ntr; tau += NTHR) { int e = 0; for (int k = 0; k < 64; ++k) if (Tb.tstart[k] <= (unsigned)tau) e = k; Tb.tex[tau] = (unsigned short)e; }
    __syncthreads();
    return Tb;
}
__device__ __forceinline__ int xcd_chunk(int L, int n) { const int q = n / 8, r = n % 8, xcd = L % 8, off = L / 8; return (xcd < r ? xcd * (q + 1) : r * (q + 1) + (xcd - r) * q) + off; }
struct GateUpSched {
    MoeTabs Tb; const char* H2; const char* Wgu; const char* Wsgu; const int* rowl; int G, c;
    __device__ __forceinline__ bool next(int i, gm::Unit& u) const {
        const int nun = 2 * Tb.ntr + 2 * (T / 256); const long L = (long)i * G + c; if (L >= nun) return false;
        const int w = xcd_chunk((int)L, nun); u.A = H2;
        if (w < 2 * Tb.ntr) { const int tau = w >> 1; u.pn = w & 1; u.e = Tb.tex[tau]; u.m0 = 256 * (tau - (int)Tb.tstart[u.e]); u.pm = tau; u.B = Wgu + (size_t)u.e * 512 * 2048 + (size_t)u.pn * 256 * 2048; }
        else { const int s = w - 2 * Tb.ntr; u.pm = s >> 1; u.pn = s & 1; u.e = 64; u.m0 = 256 * u.pm; u.B = Wsgu + (size_t)u.pn * 256 * 2048; }
        return true;
    }
    __device__ __forceinline__ unsigned arow(const gm::Unit& u, int r) const {
        if (u.e == 64) return (unsigned)(u.m0 + r) * 2048u;
        const int idx = u.m0 + r; const int aid = idx < (int)Tb.cnt[u.e] ? rowl[(size_t)u.e * T + idx] : 0;
        return (unsigned)(aid >> 3) * 2048u;
    }
};
struct EpiSwiglu {
    static constexpr bool PERM = true;
    bf16_t* act; bf16_t* acts;
    __device__ __forceinline__ void operator()(const f32x4 (&acc)[2][2][4][2], const gm::Unit& u, int wr, int wc, int fr, int fq) const {
        bf16_t* O = (u.e == 64 ? acts : act) + (size_t)(u.pm * 256 + wr * 64 + fr) * 256 + 128 * u.pn + wc * 32 + 8 * fq;
#pragma unroll
        for (int ai = 0; ai < 2; ++ai)
#pragma unroll
            for (int m = 0; m < 4; ++m) { const f32x4 g0 = acc[ai][0][m][0], g1 = acc[ai][0][m][1], u0 = acc[ai][1][m][0], u1 = acc[ai][1][m][1];
                v4u w; w.x = cvt_pk_bf16(fsilu(g0[0]) * u0[0], fsilu(g0[1]) * u0[1]); w.y = cvt_pk_bf16(fsilu(g0[2]) * u0[2], fsilu(g0[3]) * u0[3]);
                w.z = cvt_pk_bf16(fsilu(g1[0]) * u1[0], fsilu(g1[1]) * u1[1]); w.w = cvt_pk_bf16(fsilu(g1[2]) * u1[2], fsilu(g1[3]) * u1[3]);
                *(v4u*)(O + (size_t)(ai * 128 + m * 16) * 256) = w; }
    }
};
struct DownSched {
    MoeTabs Tb; const char* act; const char* acts; const char* Wdn; const char* Wsdn; int G, c;
    __device__ __forceinline__ bool next(int i, gm::Unit& u) const {
        const int nun = 4 * Tb.ntr + 4 * (T / 256); const long L = (long)i * G + c; if (L >= nun) return false;
        const int w = xcd_chunk((int)L, nun);
        if (w < 4 * Tb.ntr) { const int tau = w >> 2; u.pn = w & 3; u.e = Tb.tex[tau]; u.m0 = 256 * (tau - (int)Tb.tstart[u.e]); u.pm = tau;
            u.A = act + (size_t)tau * 256 * 512; u.B = Wdn + (size_t)u.e * 1024 * 512 + (size_t)u.pn * 256 * 512; }
        else { const int s = w - 4 * Tb.ntr; u.pm = s >> 2; u.pn = s & 3; u.e = 64; u.m0 = 256 * u.pm; u.A = acts + (size_t)u.pm * 256 * 512; u.B = Wsdn + (size_t)u.pn * 256 * 512; }
        return true;
    }
    __device__ __forceinline__ unsigned arow(const gm::Unit&, int r) const { return (unsigned)r * 512u; }
};
typedef float f32x2_t __attribute__((ext_vector_type(2)));
__device__ __forceinline__ unsigned pk4_fp8(float a, float b, float c, float d) {
    a = fminf(fmaxf(a * 16.0f, -448.0f), 448.0f); b = fminf(fmaxf(b * 16.0f, -448.0f), 448.0f); c = fminf(fmaxf(c * 16.0f, -448.0f), 448.0f); d = fminf(fmaxf(d * 16.0f, -448.0f), 448.0f);
    int w = __builtin_amdgcn_cvt_pk_fp8_f32(a, b, 0, false); w = __builtin_amdgcn_cvt_pk_fp8_f32(c, d, w, true); return (unsigned)w;
}
struct EpiDown {
    static constexpr bool PERM = true;
    unsigned char* Y8; bf16_t* YS;
    __device__ __forceinline__ void operator()(const f32x4 (&acc)[2][2][4][2], const gm::Unit& u, int wr, int wc, int fr, int fq) const {
        const size_t off = (size_t)(u.pm * 256 + wr * 64 + fr) * 1024 + u.pn * 256 + wc * 32 + 8 * fq;
        if (u.e == 64) {
#pragma unroll
            for (int ai = 0; ai < 2; ++ai)
#pragma unroll
                for (int m = 0; m < 4; ++m)
#pragma unroll
                    for (int bj = 0; bj < 2; ++bj) { const f32x4 v0 = acc[ai][bj][m][0], v1 = acc[ai][bj][m][1];
                        v4u w; w.x = cvt_pk_bf16(v0[0], v0[1]); w.y = cvt_pk_bf16(v0[2], v0[3]); w.z = cvt_pk_bf16(v1[0], v1[1]); w.w = cvt_pk_bf16(v1[2], v1[3]);
                        *(v4u*)(YS + off + (size_t)(ai * 128 + m * 16) * 1024 + bj * 128) = w; }
        } else {
#pragma unroll
            for (int ai = 0; ai < 2; ++ai)
#pragma unroll
                for (int m = 0; m < 4; ++m)
#pragma unroll
                    for (int bj = 0; bj < 2; ++bj) { const f32x4 v0 = acc[ai][bj][m][0], v1 = acc[ai][bj][m][1];
                        *(v2u*)(Y8 + off + (size_t)(ai * 128 + m * 16) * 1024 + bj * 128) = (v2u){pk4_fp8(v0[0], v0[1], v0[2], v0[3]), pk4_fp8(v1[0], v1[1], v1[2], v1[3])}; }
        }
    }
};

__device__ __forceinline__ void p8_final(Frame& F) {
    unsigned char* ws = F.ws; const unsigned char* Y = (const unsigned char*)(ws + WS_Y); const bf16_t* YS = (const bf16_t*)(ws + WS_YS);
    const float* x2 = (const float*)(ws + WS_X2); const float* mod = (const float*)(ws + WS_MOD); const float* fg = F.in[IN_FG];
    const int* TOPI = (const int*)(ws + WS_TOPI); const float* TOPW = (const float*)(ws + WS_TOPW); const int* ERANK = (const int*)(ws + WS_ERANK);
    const MoeTabs Tb = moe_tabs_build(F);
    const int w = F.wave;
    for (int unit = F.vcu; unit < T / 64; unit += F.G) {
        const int row0 = unit * 64 + 8 * w, b = row0 / SEQ;
        const int aid = row0 * 8 + F.lane; const int e = TOPI[aid]; const float wl = TOPW[aid]; const unsigned prl = 256u * Tb.tstart[e] + (unsigned)ERANK[aid];
        v2u ybA[8]; v4u ysA; v2u ybB[8]; v4u ysB;
#define P10_LOAD(yb, ysb, rr_, sg_) do { const int t_ = row0 + (rr_); _Pragma("unroll") for (int sl = 0; sl < 8; ++sl) { const unsigned pr_ = (unsigned)__shfl((int)prl, (rr_) * 8 + sl); \
            yb[sl] = *(const v2u*)(Y + (size_t)pr_ * 1024 + (sg_) * 512 + 8 * F.lane); } \
            ysb = *(const v4u*)(YS + (size_t)t_ * 1024 + (sg_) * 512 + 8 * F.lane); } while (0)
#define P10_HALF(yb, ysb, rr_, sg_) do { const int t = row0 + (rr_); float moe[8]; \
            { const unsigned vw[4] = {ysb.x, ysb.y, ysb.z, ysb.w}; \
                _Pragma("unroll") for (int k = 0; k < 4; ++k) { moe[2 * k] = bf2f((bf16_t)(vw[k] & 0xffff)); moe[2 * k + 1] = bf2f((bf16_t)(vw[k] >> 16)); } } \
            _Pragma("unroll") for (int sl = 0; sl < 8; ++sl) { const float wgt = __shfl(wl, (rr_) * 8 + sl) * 0.0625f; \
                const f32x2_t d0 = __builtin_amdgcn_cvt_pk_f32_fp8((int)yb[sl].x, false), d1 = __builtin_amdgcn_cvt_pk_f32_fp8((int)yb[sl].x, true), d2 = __builtin_amdgcn_cvt_pk_f32_fp8((int)yb[sl].y, false), d3 = __builtin_amdgcn_cvt_pk_f32_fp8((int)yb[sl].y, true); \
                moe[0] += wgt * d0[0]; moe[1] += wgt * d0[1]; moe[2] += wgt * d1[0]; moe[3] += wgt * d1[1]; moe[4] += wgt * d2[0]; moe[5] += wgt * d2[1]; moe[6] += wgt * d3[0]; moe[7] += wgt * d3[1]; } \
            _Pragma("unroll") for (int h = 0; h < 2; ++h) { const int c0 = (sg_) * 512 + 8 * F.lane + 4 * h; \
                const f32x4 xv = *(const f32x4*)(x2 + (size_t)t * D + c0), gv = *(const f32x4*)(mod + (size_t)b * 6144 + 5 * 1024 + c0); \
                _Pragma("unroll") for (int j = 0; j < 4; ++j) { const float v = xv[j] + gv[j] * moe[4 * h + j]; x3[(sg_) * 8 + 4 * h + j] = v; ss += v * v; } } } while (0)
        P10_LOAD(ybA, ysA, 0, 0);
#pragma unroll 1
        for (int rr = 0; rr < 8; ++rr) {
            float x3[16]; float ss = 0.f;
            P10_LOAD(ybB, ysB, rr, 1);
            P10_HALF(ybA, ysA, rr, 0);
            if (rr < 7) P10_LOAD(ybA, ysA, rr + 1, 0);
            P10_HALF(ybB, ysB, rr, 1);
            const int t = row0 + rr;
            const float rstd = 1.0f / sqrtf(wave_sum(ss) * (1.0f / D) + EPS);
#pragma unroll
            for (int sg = 0; sg < 2; ++sg)
#pragma unroll
                for (int h = 0; h < 2; ++h) { const int c0 = sg * 512 + 8 * F.lane + 4 * h; const f32x4 gg = *(const f32x4*)(fg + c0); f32x4 o;
#pragma unroll
                    for (int j = 0; j < 4; ++j) o[j] = x3[sg * 8 + 4 * h + j] * rstd * gg[j];
                    *(f32x4*)(F.out + (size_t)t * D + c0) = o; }
        }
#undef P10_HALF
#undef P10_LOAD
    }
    __syncthreads();
}

__device__ __forceinline__ float fgelu_tanh(float z) { const float u = 0.7978845608028654f * (z + 0.044715f * z * z * z); const float e = __expf(2.0f * u); return 0.5f * z * (1.0f + (e - 1.0f) / (e + 1.0f)); }
__device__ __forceinline__ float fgelu_safe(float z) { const float u = 0.7978845608028654f * (z + 0.044715f * z * z * z); const float uc = fminf(fmaxf(u, -15.f), 15.f); const float e = fexp(2.0f * uc); return 0.5f * z * (1.0f + (e - 1.0f) / (e + 1.0f)); }

__device__ __forceinline__ void cmp_unit(Frame& F, int unit) {
    unsigned char* ws = F.ws; const bf16_t* proj = (const bf16_t*)(ws + WS_PROJ);
    const int kv = unit >> 6, mb = unit & 63; const bf16_t* W1T = (const bf16_t*)(ws + (kv ? WS_W1VT : WS_W1KT)); const int coloff = kv ? C_VC : C_KC;
    const float* b1f = (const float*)(ws + WS_B1F) + kv * 256;
    const int w = F.wave, n = F.lane & 15, q = F.lane >> 4;
    LAS bf16_t* HID = (LAS bf16_t*)F.lds;
    size_t base[2];
#pragma unroll
    for (int rt = 0; rt < 2; ++rt) { const int R = 32 * mb + 16 * rt + n, bg = R >> 8; int c = R & 255; if (c > 254) c = 254; base[rt] = ((size_t)(bg >> 1) * SEQ + 16 * c) * LDP + coloff + (bg & 1) * 64; }
    f32x4 acc[2][2];
#pragma unroll
    for (int rt = 0; rt < 2; ++rt)
#pragma unroll
        for (int ct = 0; ct < 2; ++ct) acc[rt][ct] = (f32x4){0.f, 0.f, 0.f, 0.f};
    __syncthreads();
#pragma unroll 8
    for (int s = 0; s < 64; ++s) { const int ltok = s >> 1, dd = 32 * (s & 1) + 8 * q; bf16x8 a[2], bb[2];
#pragma unroll
        for (int rt = 0; rt < 2; ++rt) a[rt] = *(const bf16x8*)(proj + base[rt] + (size_t)ltok * LDP + dd);
#pragma unroll
        for (int ct = 0; ct < 2; ++ct) bb[ct] = *(const bf16x8*)(W1T + ((size_t)(s * 16 + 2 * w + ct) * 64 + F.lane) * 8);
#pragma unroll
        for (int rt = 0; rt < 2; ++rt)
#pragma unroll
            for (int ct = 0; ct < 2; ++ct) acc[rt][ct] = __builtin_amdgcn_mfma_f32_16x16x32_bf16(bb[ct], a[rt], acc[rt][ct], 0, 0, 0); }
#pragma unroll
    for (int rt = 0; rt < 2; ++rt)
#pragma unroll
        for (int ct = 0; ct < 2; ++ct) { const int col = 32 * w + 16 * ct + 4 * q; const f32x4 bv = *(const f32x4*)(b1f + col); const f32x4 v = acc[rt][ct] + bv;
            v2u o; o.x = cvt_pk_bf16(fgelu_safe(v[0]), fgelu_safe(v[1])); o.y = cvt_pk_bf16(fgelu_safe(v[2]), fgelu_safe(v[3]));
            *(LAS v2u*)(HID + (16 * rt + n) * 264 + col) = o; }
    __syncthreads();
    { const int rt = w & 1, ct = w >> 1; f32x4 o = (f32x4){0.f, 0.f, 0.f, 0.f};
      const bf16_t* w2f = (const bf16_t*)(ws + WS_W2T) + (size_t)kv * 16384;
#pragma unroll
      for (int s = 0; s < 8; ++s) { const bf16x8 a = *(const LAS bf16x8*)(HID + (16 * rt + n) * 264 + 32 * s + 8 * q); const bf16x8 bw = *(const bf16x8*)(w2f + ((size_t)(s * 4 + ct) * 64 + F.lane) * 8);
          o = __builtin_amdgcn_mfma_f32_16x16x32_bf16(bw, a, o, 0, 0, 0); }
      const int R = 32 * mb + 16 * rt + n, bg = R >> 8, c = R & 255, d0 = 16 * ct + 4 * q;
      if (c == 255) o = (f32x4){0.f, 0.f, 0.f, 0.f};
      if (kv == 0) { v2u ov; ov.x = cvt_pk_bf16(o[0], o[1]); ov.y = cvt_pk_bf16(o[2], o[3]); *(v2u*)((bf16_t*)(ws + WS_KCMP) + ((size_t)bg * 256 + c) * 64 + d0) = ov; }
      else { bf16_t* vt = (bf16_t*)(ws + WS_VCMPT) + (size_t)bg * 64 * 256 + c;
#pragma unroll
          for (int r = 0; r < 4; ++r) vt[(size_t)(d0 + r) * 256] = f2bf(o[r]); } }
    __syncthreads();
}

__device__ __forceinline__ void kv_prep_unit(Frame& F, int unit) {
    unsigned char* ws = F.ws; const bf16_t* proj = (const bf16_t*)(ws + WS_PROJ); const float* cs = (const float*)(ws + WS_CS); const float* sn = (const float*)(ws + WS_SN);
    const int b = unit >> 6, tile = unit & 63; const size_t tok0 = (size_t)b * SEQ + 64 * tile;
#pragma unroll
    for (int it = 0; it < 2; ++it) { const int id = F.tid + 512 * it; const int c = id & 3, g = (id >> 2) & 1, wh = (id >> 3) & 1, tk = id >> 4; const int pos = 64 * tile + tk;
        const bf16_t* src = proj + (tok0 + tk) * LDP + (wh ? C_KW : C_KS) + g * 64 + 8 * c; const v4u lo = *(const v4u*)src, hi = *(const v4u*)(src + 32);
        const f32x4 c0 = *(const f32x4*)(cs + pos * 32 + 8 * c), c1 = *(const f32x4*)(cs + pos * 32 + 8 * c + 4), s0 = *(const f32x4*)(sn + pos * 32 + 8 * c), s1 = *(const f32x4*)(sn + pos * 32 + 8 * c + 4);
        float a[8], bb[8], co[8], si[8];
        const unsigned lw[4] = {lo.x, lo.y, lo.z, lo.w}, hw[4] = {hi.x, hi.y, hi.z, hi.w};
#pragma unroll
        for (int k = 0; k < 4; ++k) { a[2 * k] = bf2f((bf16_t)(lw[k] & 0xffff)); a[2 * k + 1] = bf2f((bf16_t)(lw[k] >> 16)); bb[2 * k] = bf2f((bf16_t)(hw[k] & 0xffff)); bb[2 * k + 1] = bf2f((bf16_t)(hw[k] >> 16)); co[k] = c0[k]; co[4 + k] = c1[k]; si[k] = s0[k]; si[4 + k] = s1[k]; }
        unsigned olp[4], ohp[4];
#pragma unroll
        for (int k = 0; k < 4; ++k) { olp[k] = pk2(a[2 * k] * co[2 * k] - bb[2 * k] * si[2 * k], a[2 * k + 1] * co[2 * k + 1] - bb[2 * k + 1] * si[2 * k + 1]);
            ohp[k] = pk2(bb[2 * k] * co[2 * k] + a[2 * k] * si[2 * k], bb[2 * k + 1] * co[2 * k + 1] + a[2 * k + 1] * si[2 * k + 1]); }
        bf16_t* dst = (bf16_t*)(ws + (wh ? WS_KWR : WS_KSR)) + (((size_t)(b * 2 + g) * SEQ) + pos) * 64 + 8 * c; *(v4u*)dst = (v4u){olp[0], olp[1], olp[2], olp[3]}; *(v4u*)(dst + 32) = (v4u){ohp[0], ohp[1], ohp[2], ohp[3]}; }
    LAS bf16_t* TL = (LAS bf16_t*)F.lds;
    v4u vin[4];
#pragma unroll
    for (int m = 0; m < 4; ++m) { const int wh = m >> 1, g = m & 1, tk = F.tid >> 3, c = F.tid & 7; vin[m] = *(const v4u*)(proj + (tok0 + tk) * LDP + (wh ? C_VW : C_VS) + g * 64 + 8 * c); }
#pragma unroll
    for (int m = 0; m < 4; ++m) { const int wh = m >> 1, g = m & 1;
        __syncthreads();
        { const int tk = F.tid >> 3, c = F.tid & 7; *(LAS v4u*)(TL + tk * 72 + 8 * c) = vin[m]; }
        __syncthreads();
        { const int d = F.tid >> 3, sc = F.tid & 7; unsigned short e[8];
#pragma unroll
          for (int i = 0; i < 8; ++i) e[i] = TL[(8 * sc + i) * 72 + d];
          v4u o; o.x = e[0] | ((unsigned)e[1] << 16); o.y = e[2] | ((unsigned)e[3] << 16); o.z = e[4] | ((unsigned)e[5] << 16); o.w = e[6] | ((unsigned)e[7] << 16);
          *(v4u*)((bf16_t*)(ws + (wh ? WS_VWT : WS_VST)) + ((size_t)(b * 2 + g) * 64 + d) * SEQ + 64 * tile + 8 * sc) = o; } }
    __syncthreads();
}

constexpr int ATT_VB = 32768, ATT_PSL = 65536, ATT_OUTA = 65536, ATT_SELM = LDSCTL_OFF + 512, ATT_UNI = ATT_SELM + 512, ATT_TL = ATT_UNI + 16, ATT_NT = ATT_TL + 80;
constexpr float ATT_QS = 0.125f * 1.4426950408889634f;
__device__ __forceinline__ int att_swz(int row, int c) { return row * 128 + ((c ^ ((row >> 1) & 7)) << 4); }
struct TileSrc { const bf16_t* K; int kpitch; const bf16_t* V; int vpitch; };
__device__ __forceinline__ void att_load(const TileSrc& s, int tid, v4u& kr, v4u& vr) { const int row = tid >> 3, c = tid & 7; kr = *(const v4u*)(s.K + (size_t)row * s.kpitch + 8 * c); vr = *(const v4u*)(s.V + (size_t)row * s.vpitch + 8 * c); }
__device__ __forceinline__ void att_store(LAS unsigned char* lds, int buf, int tid, const v4u& kr, const v4u& vr) {
    const int row = tid >> 3, c = tid & 7;
    *(LAS v4u*)(lds + buf * 8192 + att_swz(row, c)) = kr;
    const int s16 = c >> 1, half = c & 1;
    *(LAS v2u*)(lds + ATT_VB + buf * 8192 + att_swz(row, 2 * s16) + half * 8) = (v2u){vr.x, vr.y};
    *(LAS v2u*)(lds + ATT_VB + buf * 8192 + att_swz(row, 2 * s16 + 1) + half * 8) = (v2u){vr.z, vr.w};
}
__device__ __forceinline__ void att_qk(const LAS unsigned char* kb, const bf16x8 (&qf)[4], f32x16 (&s)[2], int i, int hh, const f32x16& ini0, const f32x16& ini1) {
    bf16x8 kf[2][4];
#pragma unroll
    for (int kt = 0; kt < 2; ++kt)
#pragma unroll
        for (int st = 0; st < 4; ++st) kf[kt][st] = *(const LAS bf16x8*)(kb + att_swz(32 * kt + i, 2 * st + hh));
    __builtin_amdgcn_s_setprio(1);
#pragma unroll
    for (int st = 0; st < 4; ++st)
#pragma unroll
        for (int kt = 0; kt < 2; ++kt) s[kt] = __builtin_amdgcn_mfma_f32_32x32x16_bf16(kf[kt][st], qf[st], st == 0 ? (kt ? ini1 : ini0) : s[kt], 0, 0, 0);
    __builtin_amdgcn_s_setprio(0);
}
__device__ __forceinline__ void att_vload(const LAS unsigned char* vb, bf16x8 (&vf)[4][2], int i, int hh) {
#pragma unroll
    for (int ks = 0; ks < 4; ++ks)
#pragma unroll
        for (int dt = 0; dt < 2; ++dt) vf[ks][dt] = *(const LAS bf16x8*)(vb + att_swz(32 * dt + i, 2 * ks + hh));
}
__device__ __forceinline__ void att_pv(const bf16x8 (&vf)[4][2], const f32x16 (&p)[2], f32x16 (&o)[2]) {
    __builtin_amdgcn_s_setprio(1);
#pragma unroll
    for (int kt = 0; kt < 2; ++kt)
#pragma unroll
        for (int s = 0; s < 2; ++s) { const v4u pb = (v4u){cvt_pk_bf16(p[kt][8 * s], p[kt][8 * s + 1]), cvt_pk_bf16(p[kt][8 * s + 2], p[kt][8 * s + 3]), cvt_pk_bf16(p[kt][8 * s + 4], p[kt][8 * s + 5]), cvt_pk_bf16(p[kt][8 * s + 6], p[kt][8 * s + 7])};
            const bf16x8 bf = __builtin_bit_cast(bf16x8, pb);
#pragma unroll
            for (int dt = 0; dt < 2; ++dt) o[dt] = __builtin_amdgcn_mfma_f32_32x32x16_bf16(vf[2 * kt + s][dt], bf, o[dt], 0, 0, 0); }
    __builtin_amdgcn_s_setprio(0);
}
__device__ __forceinline__ void att_ini(f32x16 (&ini)[2], bool uniform, float base, int lo, int hi, int hh) {
    if (uniform) {
#pragma unroll
        for (int r = 0; r < 16; ++r) ini[0][r] = base;
        ini[1] = ini[0];
    } else {
        const unsigned span = (unsigned)(hi - lo);
#pragma unroll
        for (int kt = 0; kt < 2; ++kt)
#pragma unroll
            for (int r = 0; r < 16; ++r) { const int kk = 32 * kt + (r & 3) + 8 * (r >> 2) + 4 * hh; ini[kt][r] = ((unsigned)(kk - lo) <= span && hi >= lo) ? base : -1e30f; }
    }
}
#define ATT_KEY(kt, r, hh) (32 * (kt) + ((r) & 3) + 8 * ((r) >> 2) + 4 * (hh))

__device__ __forceinline__ void att_unit(Frame& F, int unit) {
    unsigned char* ws = F.ws; const bf16_t* proj = (const bf16_t*)(ws + WS_PROJ); bf16_t* mix = (bf16_t*)(ws + WS_MIX);
    const int qb = unit & 63, bg = unit >> 6, b = bg >> 1, g = bg & 1;
    const int w = F.wave, i = F.lane & 31, hh = F.lane >> 5, head = i >> 3, tloc = i & 7, tt = 8 * w + tloc; const int pos = 64 * qb + tt; const size_t tok = (size_t)b * SEQ + pos;
    LAS unsigned char* lds = F.lds; LAS float* PSL = (LAS float*)(lds + ATT_PSL); LAS unsigned* SELM = (LAS unsigned*)(lds + ATT_SELM); LAS unsigned* UNI = (LAS unsigned*)(lds + ATT_UNI);
    LAS unsigned char* TL = lds + ATT_TL; LAS int* NTL = (LAS int*)(lds + ATT_NT);
    const bf16_t* kcmp = (const bf16_t*)(ws + WS_KCMP) + (size_t)bg * 256 * 64; const bf16_t* vcmpt = (const bf16_t*)(ws + WS_VCMPT) + (size_t)bg * 64 * 256;
    const bf16_t* ksr = (const bf16_t*)(ws + WS_KSR) + (size_t)bg * SEQ * 64; const bf16_t* vst = (const bf16_t*)(ws + WS_VST) + (size_t)bg * 64 * SEQ;
    const bf16_t* kwr = (const bf16_t*)(ws + WS_KWR) + (size_t)bg * SEQ * 64; const bf16_t* vwt = (const bf16_t*)(ws + WS_VWT) + (size_t)bg * 64 * SEQ;
    __syncthreads();
    for (int k = F.tid; k < 64 * 64; k += NTHR) PSL[k] = 0.f;
    if (F.tid < 2) UNI[F.tid] = 0u;
    bf16x8 qf[4];
    const bf16_t* qp = proj + tok * LDP + C_NQ + (4 * g + head) * 64 + 8 * hh;
    { float qraw[4][8];
#pragma unroll
      for (int st = 0; st < 4; ++st) { const v4u v = *(const v4u*)(qp + 16 * st); const unsigned vw[4] = {v.x, v.y, v.z, v.w};
#pragma unroll
          for (int k = 0; k < 4; ++k) { qraw[st][2 * k] = bf2f((bf16_t)(vw[k] & 0xffff)); qraw[st][2 * k + 1] = bf2f((bf16_t)(vw[k] >> 16)); } }
#pragma unroll
      for (int st = 0; st < 4; ++st) { const v4u o = (v4u){cvt_pk_bf16(qraw[st][0] * ATT_QS, qraw[st][1] * ATT_QS), cvt_pk_bf16(qraw[st][2] * ATT_QS, qraw[st][3] * ATT_QS), cvt_pk_bf16(qraw[st][4] * ATT_QS, qraw[st][5] * ATT_QS), cvt_pk_bf16(qraw[st][6] * ATT_QS, qraw[st][7] * ATT_QS)};
          qf[st] = __builtin_bit_cast(bf16x8, o); } }
    LAS float* OUTA = (LAS float*)(lds + ATT_OUTA) + (size_t)w * 32 * 64 + F.lane;
    const float* gl = nullptr; (void)gl;
    const float gate0 = fsigmoid(bf2f(proj[tok * LDP + C_NG + (4 * g + head) * 3 + 0])), gate1 = fsigmoid(bf2f(proj[tok * LDP + C_NG + (4 * g + head) * 3 + 1])), gate2 = fsigmoid(bf2f(proj[tok * LDP + C_NG + (4 * g + head) * 3 + 2]));
    v4u kr, vr; f32x16 s[2]; f32x16 ocmp[2];
#ifndef PROBE_ATT
#define PROBE_ATT 0
#endif
    for (int rep1_ = 0; rep1_ < (PROBE_ATT == 1 ? 2 : 1); ++rep1_) {
    const int ncu = (4 * qb + 3) < 255 ? (4 * qb + 3) : 255, ntile = (ncu + 63) >> 6;
    const int ncv = pos >= 31 ? ((pos - 31) >> 4) + 1 : 0;
    const int ncv_min = qb >= 1 ? 4 * qb - 1 : 0;
    float m = -1e30f, l = 0.f;
    {
        int cur = 0; { TileSrc ts{kcmp, 64, vcmpt, 256}; att_load(ts, F.tid, kr, vr); att_store(lds, 0, F.tid, kr, vr); }
        __syncthreads();
        for (int T_ = 0; T_ < ntile; ++T_) {
            const bool more = T_ + 1 < ntile;
            if (more) { TileSrc ts{kcmp + (size_t)(T_ + 1) * 64 * 64, 64, vcmpt + (T_ + 1) * 64, 256}; att_load(ts, F.tid, kr, vr); }
            { f32x16 ini[2]; att_ini(ini, 64 * T_ + 64 <= ncv_min, 0.f, 0, ncv - 1 - 64 * T_, hh); att_qk(lds + cur * 8192, qf, s, i, hh, ini[0], ini[1]); }
            float tm = -1e30f;
#pragma unroll
            for (int kt = 0; kt < 2; ++kt)
#pragma unroll
                for (int r = 0; r < 16; ++r) tm = fmaxf(tm, s[kt][r]);
            tm = fmaxf(tm, __shfl_xor(tm, 32));
            const float mn = fmaxf(m, tm); l *= fexp2(m - mn);
#pragma unroll
            for (int kt = 0; kt < 2; ++kt)
#pragma unroll
                for (int r = 0; r < 16; ++r) l += fexp2(s[kt][r] - mn);
            m = mn;
            if (more) att_store(lds, cur ^ 1, F.tid, kr, vr);
            __syncthreads(); cur ^= 1;
        }
        l += __shfl_xor(l, 32);
    }
    {
        const float rl = (ncv > 0 && l > 0.f) ? 1.0f / l : 0.f;
        f32x16 o[2];
#pragma unroll
        for (int k = 0; k < 16; ++k) { o[0][k] = 0.f; o[1][k] = 0.f; }
        float carry = 0.f;
        int cur = 0; { TileSrc ts{kcmp, 64, vcmpt, 256}; att_load(ts, F.tid, kr, vr); att_store(lds, 0, F.tid, kr, vr); }
        __syncthreads();
        for (int T_ = 0; T_ < ntile; ++T_) {
            const bool more = T_ + 1 < ntile;
            if (more) { TileSrc ts{kcmp + (size_t)(T_ + 1) * 64 * 64, 64, vcmpt + (T_ + 1) * 64, 256}; att_load(ts, F.tid, kr, vr); }
            bf16x8 vf[4][2];
            { f32x16 ini[2]; att_ini(ini, 64 * T_ + 64 <= ncv_min, -m, 0, ncv - 1 - 64 * T_, hh); att_qk(lds + cur * 8192, qf, s, i, hh, ini[0], ini[1]); }
            att_vload(lds + ATT_VB + cur * 8192, vf, i, hh);
#pragma unroll
            for (int kt = 0; kt < 2; ++kt)
#pragma unroll
                for (int r = 0; r < 16; ++r) s[kt][r] = fexp2(s[kt][r]) * rl;
            att_pv(vf, s, o);
            float ps[8];
#pragma unroll
            for (int kt = 0; kt < 2; ++kt)
#pragma unroll
                for (int gi = 0; gi < 4; ++gi) ps[4 * kt + gi] = (s[kt][4 * gi] + s[kt][4 * gi + 1]) + (s[kt][4 * gi + 2] + 0.5f * s[kt][4 * gi + 3]);
            float nc = 0.f;
#pragma unroll
            for (int sl = 0; sl < 8; ++sl) { const float x = 0.5f * s[sl >> 2][4 * (sl & 3) + 3]; const float y = __shfl_xor(x, 32);
                if (hh == 1) ps[sl] += y; else { if (sl < 7) ps[sl + 1] += y; else nc = y; } }
            if (hh == 0) { ps[0] += carry; carry = nc; }
#pragma unroll
            for (int sl = 0; sl < 8; ++sl) { float v = ps[sl]; v += __shfl_xor(v, 8); v += __shfl_xor(v, 16); ps[sl] = v; }
            if (head == 0) {
#pragma unroll
                for (int sl = 0; sl < 8; ++sl) PSL[tt * 64 + 16 * T_ + 2 * sl + hh] = ps[sl]; }
            if (more) att_store(lds, cur ^ 1, F.tid, kr, vr);
            __syncthreads(); cur ^= 1;
        }
#pragma unroll
        for (int dt = 0; dt < 2; ++dt)
#pragma unroll
            for (int k = 0; k < 16; ++k) ocmp[dt][k] = gate0 * o[dt][k];
    }
    __syncthreads();
#pragma unroll 1
    for (int tl = 0; tl < 8; ++tl) {
        const int t = 8 * w + tl, j = F.lane; const bool fj = (j == 0) || (j == qb) || (j == qb - 1);
        const unsigned key = fj ? 0xFFFFFFFFu : (j <= qb ? __float_as_uint(PSL[t * 64 + j]) + 1u : 0u);
        unsigned thr = 0u;
#pragma unroll 1
        for (int bit = 31; bit >= 0; --bit) { const unsigned cand = thr | (1u << bit); if (__popcll(__ballot(key >= cand)) >= NSEL) thr = cand; }
        const unsigned long long gt = __ballot(key > thr), eq = __ballot(key == thr); const int need = NSEL - __popcll(gt);
        const int below = __popcll(eq & ((1ull << j) - 1ull));
        const bool sel = (key > 0u) && ((key > thr) || (key == thr && below < need));
        const unsigned long long msk = __ballot(sel);
        if (F.lane == 0) { const unsigned lo = (unsigned)msk, hi = (unsigned)(msk >> 32); SELM[2 * t] = lo; SELM[2 * t + 1] = hi; atomicOr((unsigned*)&UNI[0], lo); atomicOr((unsigned*)&UNI[1], hi); }
    }
    __syncthreads();
    }
    const unsigned sel0 = SELM[2 * tt], sel1 = SELM[2 * tt + 1];
#pragma unroll
    for (int dt = 0; dt < 2; ++dt)
#pragma unroll
        for (int k = 0; k < 16; ++k) OUTA[(dt * 16 + k) * 64] = ocmp[dt][k];
    { const float* csp = (const float*)(ws + WS_CS) + pos * 32 + 8 * hh; const float* snp = (const float*)(ws + WS_SN) + pos * 32 + 8 * hh;
      float qraw[4][8];
#pragma unroll
      for (int st = 0; st < 4; ++st) { const v4u v = *(const v4u*)(qp + 16 * st); const unsigned vw[4] = {v.x, v.y, v.z, v.w};
#pragma unroll
          for (int k = 0; k < 4; ++k) { qraw[st][2 * k] = bf2f((bf16_t)(vw[k] & 0xffff)); qraw[st][2 * k + 1] = bf2f((bf16_t)(vw[k] >> 16)); } }
#pragma unroll
      for (int st = 0; st < 2; ++st) { float co[8], si[8]; *(f32x4*)&co[0] = *(const f32x4*)(csp + 16 * st); *(f32x4*)&co[4] = *(const f32x4*)(csp + 16 * st + 4); *(f32x4*)&si[0] = *(const f32x4*)(snp + 16 * st); *(f32x4*)&si[4] = *(const f32x4*)(snp + 16 * st + 4);
          float rl_[8], rh_[8];
#pragma unroll
          for (int k = 0; k < 8; ++k) { rl_[k] = (qraw[st][k] * co[k] - qraw[st + 2][k] * si[k]) * ATT_QS; rh_[k] = (qraw[st + 2][k] * co[k] + qraw[st][k] * si[k]) * ATT_QS; }
          qf[st] = __builtin_bit_cast(bf16x8, (v4u){cvt_pk_bf16(rl_[0], rl_[1]), cvt_pk_bf16(rl_[2], rl_[3]), cvt_pk_bf16(rl_[4], rl_[5]), cvt_pk_bf16(rl_[6], rl_[7])});
          qf[st + 2] = __builtin_bit_cast(bf16x8, (v4u){cvt_pk_bf16(rh_[0], rh_[1]), cvt_pk_bf16(rh_[2], rh_[3]), cvt_pk_bf16(rh_[4], rh_[5]), cvt_pk_bf16(rh_[6], rh_[7])}); } }
    for (int rep2_ = 0; rep2_ < (PROBE_ATT == 2 ? 2 : 1); ++rep2_)
#pragma unroll 1
    for (int br = 0; br < 2; ++br) {
        if (F.tid == 0) { int nl = 0;
            if (br == 0) { const unsigned u0 = UNI[0], u1 = UNI[1]; for (int j = 0; j <= qb; ++j) { const bool on = j < 32 ? ((u0 >> j) & 1u) : ((u1 >> (j - 32)) & 1u); if (on) TL[nl++] = (unsigned char)j; } }
            else { for (int j = (qb >= 8 ? qb - 8 : 0); j <= qb; ++j) TL[nl++] = (unsigned char)j; }
            NTL[0] = nl; }
        __syncthreads();
        const int nl = NTL[0]; const bf16_t* Kg = br ? kwr : ksr; const bf16_t* Vg = br ? vwt : vst;
        float mm = 0.f, ll = 0.f; bool started = false; f32x16 o[2];
#pragma unroll
        for (int k = 0; k < 16; ++k) { o[0][k] = 0.f; o[1][k] = 0.f; }
#define ATT_BODY \
            bool lane_on; int lo_k, hi_k;     \
            if (br == 0) { lane_on = j < 32 ? ((sel0 >> j) & 1u) : ((sel1 >> (j - 32)) & 1u); lo_k = 0; hi_k = (j == qb) ? tt : 63; } \
            else { lane_on = true; lo_k = (j == qb - 8) ? tt + 1 : 0; hi_k = (j == qb) ? tt : 63; if (lo_k > hi_k) lane_on = false; } \
            const bool full = (j != qb) && (br == 0 || j != qb - 8);               \
            if (__any(lane_on)) { \
                bf16x8 vf[4][2]; \
                { f32x16 ini[2]; att_ini(ini, full, lane_on ? -mm : -1e30f, lo_k, lane_on ? hi_k : -1, hh); att_qk(lds + kslot * 8192, qf, s, i, hh, ini[0], ini[1]); } \
                att_vload(lds + ATT_VB + kslot * 8192, vf, i, hh); \
                float tm = -1e30f; \
_Pragma("unroll") \
                for (int kt = 0; kt < 2; ++kt) \
_Pragma("unroll") \
                    for (int r = 0; r < 16; ++r) tm = fmaxf(tm, s[kt][r]); \
                tm = fmaxf(tm, __shfl_xor(tm, 32)); \
                const bool first = !started && (tm > -1e29f); started = started || first; \
                const bool upd = first || (tm > 8.0f); \
                if (__any(upd)) { \
                    const float delta = upd ? tm : 0.f, al = fexp2(-delta); mm += delta; ll *= al; \
_Pragma("unroll") \
                    for (int dt = 0; dt < 2; ++dt) \
_Pragma("unroll") \
                        for (int k = 0; k < 16; ++k) o[dt][k] *= al; \
_Pragma("unroll") \
                    for (int kt = 0; kt < 2; ++kt) \
_Pragma("unroll") \
                        for (int r = 0; r < 16; ++r) s[kt][r] -= delta; \
                } \
_Pragma("unroll") \
                for (int kt = 0; kt < 2; ++kt) \
_Pragma("unroll") \
                    for (int r = 0; r < 16; ++r) { const float pv_ = fexp2(s[kt][r]); s[kt][r] = pv_; ll += pv_; } \
                att_pv(vf, s, o); \
            }
        v4u kr2, vr2;
        const int np = (nl + 1) >> 1;
#define ATT_LOADPAIR(p_) do { { const int ja = TL[2 * (p_)]; TileSrc ts{Kg + (size_t)ja * 64 * 64, 64, Vg + (size_t)ja * 64, SEQ}; att_load(ts, F.tid, kr, vr); } \
            if (2 * (p_) + 1 < nl) { const int jb = TL[2 * (p_) + 1]; TileSrc ts{Kg + (size_t)jb * 64 * 64, 64, Vg + (size_t)jb * 64, SEQ}; att_load(ts, F.tid, kr2, vr2); } } while (0)
#define ATT_STOREPAIR(p_, c_) do { att_store(lds, 2 * (c_), F.tid, kr, vr); if (2 * (p_) + 1 < nl) att_store(lds, 2 * (c_) + 1, F.tid, kr2, vr2); } while (0)
        ATT_LOADPAIR(0); ATT_STOREPAIR(0, 0);
        if (np > 1) ATT_LOADPAIR(1);
        __syncthreads();
        int cur = 0;
        for (int p = 0; p < np; ++p) {
            if (p + 1 < np) ATT_STOREPAIR(p + 1, cur ^ 1);
            if (p + 2 < np) ATT_LOADPAIR(p + 2);
#pragma unroll 1
            for (int t2 = 0; t2 < 2; ++t2) { const int it = 2 * p + t2; if (it < nl) { const int j = TL[it]; const int kslot = 2 * cur + t2;
                ATT_BODY
            } }
            __syncthreads(); cur ^= 1;
        }
#undef ATT_LOADPAIR
#undef ATT_STOREPAIR
#undef ATT_BODY
        ll += __shfl_xor(ll, 32);
        const float sc_ = rep2_ ? 0.f : (br ? gate2 : gate1) / ll;
#pragma unroll
        for (int dt = 0; dt < 2; ++dt)
#pragma unroll
            for (int k = 0; k < 16; ++k) OUTA[(dt * 16 + k) * 64] += sc_ * o[dt][k];
    }
    { bf16_t* op = mix + tok * D + 512 + (4 * g + head) * 64 + 4 * hh;
#pragma unroll
      for (int dt = 0; dt < 2; ++dt)
#pragma unroll
          for (int gi = 0; gi < 4; ++gi) { const float a0 = OUTA[(dt * 16 + 4 * gi) * 64], a1 = OUTA[(dt * 16 + 4 * gi + 1) * 64], a2 = OUTA[(dt * 16 + 4 * gi + 2) * 64], a3 = OUTA[(dt * 16 + 4 * gi + 3) * 64];
              v2u ov; ov.x = cvt_pk_bf16(a0, a1); ov.y = cvt_pk_bf16(a2, a3); *(v2u*)(op + 32 * dt + 8 * gi) = ov; } }
    __syncthreads();
}

__global__ void __launch_bounds__(NTHR, 2) mk_fwd(Args args) {
    extern __shared__ __attribute__((aligned(16))) unsigned char lds_raw[];
    Frame F;
    F.lds = (LAS unsigned char*)lds_raw; F.MISC = (volatile LAS unsigned*)(F.lds + MISC_OFF);
    F.tid = threadIdx.x; F.lane = F.tid & 63; F.wave = __builtin_amdgcn_readfirstlane(F.tid >> 6);
    F.G = gridDim.x; { const int bx = blockIdx.x; F.vcu = (F.G % 8 == 0) ? (bx % 8) * (F.G / 8) + bx / 8 : bx; }
    F.ws = args.ws; F.ctl = (unsigned*)(args.ws + WS_CTL); F.out = args.out;
#pragma unroll
    for (int i = 0; i < 25; ++i) F.in[i] = args.in[i];
    for (int u = F.tid; u < (LDS_BYTES - LDSCTL_OFF) / 4; u += NTHR) ((LAS unsigned*)(F.lds + LDSCTL_OFF))[u] = 0u;
    __syncthreads();
    const int lo = args.ph_lo, hi = args.ph_hi;
    XcdBarrier bar = xcd_barrier_post(F.ctl + CW_BAR + lo * XCD_BAR_WORDS, F.MISC + 8);
#define IN_PH(k) (lo <= (k) && (k) < hi)
#define SEAM(k) do { if (IN_PH(k) && IN_PH((k) + 1)) xcd_barrier(bar); } while (0)
#define RUNP(k, BODY) do { if (IN_PH(k)) { BODY; if (PROBE_REP == (k)) { xcd_barrier(bar); BODY; } } } while (0)
#define BODY0 p0_prologue(F)
#define BODY1 p1a_norm(F)
#define BODY2 { gm::DenseSched S{(const char*)(F.ws + WS_XN), (const char*)(F.ws + WS_WINT), T / 256, LDP / 256, F.G, (int)blockIdx.x, 2048u, 1024u}; \
        gm::EpiBf16 E{(bf16_t*)(F.ws + WS_PROJ), LDP}; gm::gemm_phase<gm::EpiBf16, gm::DenseSched>(F.lds, S, E, 1024, 128u); }
#define BODY3 { if (F.G == 256) { if (F.vcu < 128) cmp_unit(F, F.vcu); else { const int u0 = 2 * (F.vcu - 128); hg_passA(F, u0); hg_passA(F, u0 + 1); kv_prep_unit(F, u0); kv_prep_unit(F, u0 + 1); } } \
        else { for (int u = F.vcu; u < 128; u += F.G) cmp_unit(F, u); for (int u = F.vcu; u < 256; u += F.G) hg_passA(F, u); for (int u = F.vcu; u < 256; u += F.G) kv_prep_unit(F, u); } }
#define BODY4 { for (int u = F.vcu; u < 256; u += F.G) hg_passC(F, u); }
#define BODY5 { for (int c = F.vcu; c < 256; c += F.G) { const int bg = c >> 5, k = c & 31; att_unit(F, bg * 64 + 63 - k); att_unit(F, bg * 64 + k); } }
#define BODY6 { gm::DenseSched S{(const char*)(F.ws + WS_MIX), (const char*)(F.ws + WS_WOUTT), T / 256, 4, F.G, (int)blockIdx.x, 2048u, 1024u}; \
        gm::EpiRes E{F.in[IN_X], (const float*)(F.ws + WS_MOD), 2, (float*)(F.ws + WS_X2)}; gm::gemm_phase<gm::EpiRes, gm::DenseSched>(F.lds, S, E, 1024, 128u); }
#define BODY7 p5_router(F)
#define BODY8 { const MoeTabs Tb = moe_tabs_build(F); \
        GateUpSched S{Tb, (const char*)(F.ws + WS_H2), (const char*)(F.ws + WS_WGUT), (const char*)(F.ws + WS_WSGUT), (const int*)(F.ws + WS_ROWL), F.G, (int)blockIdx.x}; \
        EpiSwiglu E{(bf16_t*)(F.ws + WS_ACT), (bf16_t*)(F.ws + WS_ACTS)}; gm::gemm_phase<EpiSwiglu, GateUpSched>(F.lds, S, E, 1024, 128u); }
#define BODY9 { const MoeTabs Tb = moe_tabs_build(F); DownSched S{Tb, (const char*)(F.ws + WS_ACT), (const char*)(F.ws + WS_ACTS), (const char*)(F.ws + WS_WDNT), (const char*)(F.ws + WS_WSDNT), F.G, (int)blockIdx.x}; \
        EpiDown E{(unsigned char*)(F.ws + WS_Y), (bf16_t*)(F.ws + WS_YS)}; gm::gemm_phase<EpiDown, DownSched>(F.lds, S, E, 256, 128u); }
#define BODY10 p8_final(F)
    RUNP(0, BODY0); SEAM(0);
    RUNP(1, BODY1); SEAM(1);
    RUNP(2, BODY2); SEAM(2);
    RUNP(3, BODY3); SEAM(3);
    RUNP(4, BODY4); SEAM(4);
    RUNP(5, BODY5); SEAM(5);
    RUNP(6, BODY6); SEAM(6);
    RUNP(7, BODY7); SEAM(7);
    RUNP(8, BODY8); SEAM(8);
    RUNP(9, BODY9); SEAM(9);
    RUNP(10, BODY10);
#undef IN_PH
#undef SEAM
#undef RUNP
}
#ifndef ONE_LAUNCH
#define ONE_LAUNCH 1
#endif
#ifndef OPT_S1
#define OPT_S1 1
#endif
#ifndef OPT_S2B
#define OPT_S2B 1
#endif
#ifndef OPT_S2A
#define OPT_S2A 1
#endif
#ifndef OPT_S5
#define OPT_S5 1
#endif
#ifndef OPT_S3
#define OPT_S3 1
#endif
#ifndef OPT_S4
#define OPT_S4 1
#endif
static void launch_mk(const nv::In& I, void* const* d_in, float* out, unsigned char* ws, int lo, int hi, int grid, hipStream_t stream) {
    Args a{}; for (int i = 0; i < 25; ++i) a.in[i] = (const float*)d_in[i];
    a.out = out; a.ws = ws; a.ph_lo = lo; a.ph_hi = hi; a.rep = 0; a.pad = 0;
    hipLaunchKernelGGL(mk_fwd, dim3(grid), dim3(NTHR), LDS_BYTES, stream, a);
}
extern "C" void kernel_launch(void* const* d_in, const int* in_sizes, int n_in, void* d_out, int out_size, void* d_ws, size_t ws_size, hipStream_t stream) {
    static int grid = 0;
    if (grid == 0) {
        if (ws_size < WS_END || n_in != 25) { fprintf(stderr, "kernel_launch: ws %zu < %zu or n_in %d != 25\n", ws_size, (size_t)WS_END, n_in); grid = -1; return; }
        int dev = 0, cus = 0;
        if (hipGetDevice(&dev) != hipSuccess || hipDeviceGetAttribute(&cus, hipDeviceAttributeMultiprocessorCount, dev) != hipSuccess) { grid = -1; return; }
        if (hipFuncSetAttribute((const void*)mk_fwd, hipFuncAttributeMaxDynamicSharedMemorySize, LDS_BYTES) != hipSuccess) { fprintf(stderr, "kernel_launch: hipFuncSetAttribute failed\n"); grid = -1; return; }
        int per_cu = 0; (void)hipOccupancyMaxActiveBlocksPerMultiprocessor(&per_cu, (const void*)mk_fwd, NTHR, LDS_BYTES); (void)hipGetLastError();
        if (per_cu < 1) fprintf(stderr, "kernel_launch: occupancy query says %d blocks/CU\n", per_cu);
        grid = cus;
    }
    if (grid < 0) return;
    unsigned char* ws = (unsigned char*)d_ws; float* out = (float*)d_out;
    nv::In I; I.set(d_in);
    (void)hipMemsetAsync(ws + WS_CTL, 0, CTL_ZERO_BYTES, stream);
#if ONE_LAUNCH
    launch_mk(I, d_in, out, ws, 0, 11, grid, stream);
#else
#if OPT_S1
    launch_mk(I, d_in, out, ws, 0, 3, grid, stream);
#else
    nv::s1_naive(I, ws, stream);
#endif
#if OPT_S2A
    launch_mk(I, d_in, out, ws, 3, OPT_S2B ? 6 : 5, grid, stream);
#endif
    if (!OPT_S2A || !OPT_S2B) nv::s2_naive(I, ws, stream, !OPT_S2A, !OPT_S2B);
#if OPT_S3
    launch_mk(I, d_in, out, ws, 6, OPT_S4 ? 8 : 7, grid, stream);
#else
    nv::s3_naive(I, ws, stream);
#endif
#if OPT_S4
    if (!OPT_S3) launch_mk(I, d_in, out, ws, 7, 8, grid, stream);
#else
    nv::s4_naive(I, ws, stream);
#endif
#if OPT_S5
    launch_mk(I, d_in, out, ws, 8, 11, grid, stream);
#else
    nv::s5_naive(I, ws, out, stream);
#endif
#endif
}
#endif
```

```cpp
#ifndef CPU_EMU
#include <hip/hip_runtime.h>
#endif
#include <cstdio>
#include <cstdint>
#include <cmath>

#ifndef BATCH
#define BATCH 4
#endif
#ifndef SEQ
#define SEQ 4096
#endif

#ifdef CPU_EMU
struct dim3e { unsigned x, y, z; };
static thread_local dim3e threadIdx, blockIdx, blockDim, gridDim;
#define __global__
#define __device__
#define __host__
#define __forceinline__ inline
#define __launch_bounds__(...)
typedef int hipStream_t;
template <class F> static void cpu_launch(unsigned grid, unsigned block, F f) {
#pragma omp parallel for schedule(dynamic, 1)
    for (long b = 0; b < (long)grid; ++b) {
        blockIdx = {(unsigned)b, 0, 0}; blockDim = {block, 1, 1}; gridDim = {grid, 1, 1};
        for (unsigned t = 0; t < block; ++t) { threadIdx = {t, 0, 0}; f(); }
    }
}
static int g_launch_limit = 1 << 30, g_launch_count = 0;
#define LAUNCH(kern, grid, block, ...) do { if (g_launch_count++ < g_launch_limit) cpu_launch((unsigned)(grid), (unsigned)(block), [&]() { kern(__VA_ARGS__); }); } while (0)
#else
#define LAUNCH(kern, grid, block, ...) kern<<<dim3((unsigned)(grid)), dim3((unsigned)(block)), 0, stream>>>(__VA_ARGS__)
#endif

typedef unsigned short bf16_t;
constexpr int D = 1024, T = BATCH * SEQ, INC = 3352, LDP = 3584;
constexpr int C_HQ = 0, C_HF = 512, C_HI = 1024, C_HGT = 1536, C_NQ = 2048, C_KC = 2560, C_VC = 2688, C_KS = 2816, C_VS = 2944, C_KW = 3072, C_VW = 3200, C_NG = 3328;
constexpr int NCMP = (SEQ - 32) / 16 + 1, NSB = SEQ / 64, NSEL = NSB < 16 ? NSB : 16;
constexpr float EPS = 1e-6f;

constexpr size_t MiB = 1u << 20, KiB = 1u << 10;
constexpr size_t WS_CTL = 0, CTL_ZERO_BYTES = 1 * MiB;
constexpr size_t WS_MODP = 1 * MiB;
constexpr size_t WS_MOD = 2 * MiB + 512 * KiB;
constexpr size_t WS_B1F = WS_MOD + 128 * KiB;
constexpr size_t WS_CS = 2 * MiB + 768 * KiB, WS_SN = WS_CS + 512 * KiB;
constexpr size_t WS_WDNT = 4 * MiB;
constexpr size_t WS_WSDNT = 36 * MiB;
constexpr size_t WS_X2 = 37 * MiB;
constexpr size_t WS_ACT = 101 * MiB;
constexpr size_t WS_ACTS = 173 * MiB;
constexpr size_t WS_ROWL = 181 * MiB;
constexpr size_t WS_TOPI = 189 * MiB, WS_TOPW = WS_TOPI + 512 * KiB;
constexpr size_t WS_ERANK = 185 * MiB;
constexpr size_t WS_WGUT = 190 * MiB;
constexpr size_t WS_WSGUT = 254 * MiB;
constexpr size_t WS_WINT = 255 * MiB;
constexpr size_t WS_WOUTT = 262 * MiB;
constexpr size_t WS_W1KT = 264 * MiB, WS_W1VT = 265 * MiB;
constexpr size_t WS_W2T = 266 * MiB;
constexpr size_t WS_RW = 267 * MiB;
constexpr size_t WS_XN = 268 * MiB;
constexpr size_t WS_H2 = WS_XN;
constexpr size_t WS_PROJ = 300 * MiB;
constexpr size_t WS_KSR = 412 * MiB, WS_KWR = 416 * MiB;
constexpr size_t WS_VST = 420 * MiB, WS_VWT = 424 * MiB;
constexpr size_t WS_KCMP = 428 * MiB, WS_VCMPT = WS_KCMP + 256 * KiB;
constexpr size_t WS_U = 429 * MiB, WS_DD = 445 * MiB;
constexpr size_t WS_MIX = 446 * MiB;
constexpr size_t WS_Y = 190 * MiB;
constexpr size_t WS_YS = 478 * MiB;
constexpr size_t WS_END = 512 * MiB;
constexpr size_t NV_H = 37 * MiB, NV_RSTD = 101 * MiB;
constexpr size_t NV_F = 37 * MiB, NV_ORAW = 69 * MiB, NV_OWIN = 101 * MiB, NV_KSR = 133 * MiB, NV_KWR = 141 * MiB, NV_PS = 149 * MiB, NV_SEL = 157 * MiB,
                 NV_HID = 158 * MiB, NV_KCMP = 160 * MiB, NV_VCMP = 160 * MiB + 512 * KiB, NV_CS = 161 * MiB, NV_SN = 161 * MiB + 512 * KiB, NV_QROT = 478 * MiB;
constexpr size_t NV_H2F = 300 * MiB, NV_LG = 364 * MiB, NV_RSTD2 = 368 * MiB;
constexpr size_t NV_ACT = 300 * MiB, NV_ACTS = 101 * MiB, NV_X3 = 446 * MiB, NV_RSTD3 = 510 * MiB;

__host__ __device__ __forceinline__ float bf2f(bf16_t v) { union { unsigned u; float f; } c; c.u = (unsigned)v << 16; return c.f; }
__host__ __device__ __forceinline__ bf16_t f2bf(float f) { union { unsigned u; float f; } c; c.f = f; unsigned u = c.u; return (bf16_t)((u + 0x7fffu + ((u >> 16) & 1u)) >> 16); }

namespace nv {
__device__ __forceinline__ float sigmoidf_(float z) { return 1.0f / (1.0f + expf(-z)); }
__device__ __forceinline__ float siluf_(float z) { return z * sigmoidf_(z); }
__device__ __forceinline__ float gelu_tanh(float z) { return 0.5f * z * (1.0f + tanhf(0.7978845608028654f * (z + 0.044715f * z * z * z))); }
__device__ __forceinline__ long gtid() { return (long)blockIdx.x * blockDim.x + threadIdx.x; }
#define PJ(row, col) bf2f(proj[(size_t)(row) * LDP + (col)])

__global__ void k_mod(const float* c, const float* w_ada, const float* b_ada, float* mod) {
    long i = gtid(); if (i >= BATCH * 6144) return; int b = (int)(i / 6144), n = (int)(i % 6144);
    float acc = b_ada[n];
    for (int k = 0; k < D; ++k) acc += siluf_(c[b * D + k]) * w_ada[(size_t)k * 6144 + n];
    mod[i] = acc;
}
__global__ void k_rowrstd(const float* x, float* rstd, int rows) {
    long r = gtid(); if (r >= rows) return; float s = 0.f;
    for (int k = 0; k < D; ++k) { float v = x[(size_t)r * D + k]; s += v * v; }
    rstd[r] = 1.0f / sqrtf(s / D + EPS);
}
__global__ void k_modnorm(const float* x, const float* rstd, const float* g, const float* mod, int sh_chunk, int sc_chunk, float* hf, bf16_t* hb) {
    long i = gtid(); if (i >= (long)T * D) return; int r = (int)(i / D), k = (int)(i % D), b = r / SEQ;
    float v = x[i] * rstd[r] * g[k] * (1.0f + mod[b * 6144 + sc_chunk * D + k]) + mod[b * 6144 + sh_chunk * D + k];
    if (hf) hf[i] = v; if (hb) hb[i] = f2bf(v);
}
__global__ void k_gemm_nn_bf(const float* A, int lda, const float* Bm, int ldb, bf16_t* C, int ldc, int M, int N, int K) {
    long i = gtid(); if (i >= (long)M * N) return; int m = (int)(i / N), n = (int)(i % N);
    float acc = 0.f; const float* a = A + (size_t)m * lda;
    for (int k = 0; k < K; ++k) acc += a[k] * Bm[(size_t)k * ldb + n];
    C[(size_t)m * ldc + n] = f2bf(acc);
}
__global__ void k_gemm_nn(const float* A, int lda, const float* Bm, int ldb, float* C, int ldc, int M, int N, int K) {
    long i = gtid(); if (i >= (long)M * N) return; int m = (int)(i / N), n = (int)(i % N);
    float acc = 0.f; const float* a = A + (size_t)m * lda;
    for (int k = 0; k < K; ++k) acc += a[k] * Bm[(size_t)k * ldb + n];
    C[(size_t)m * ldc + n] = acc;
}
__global__ void k_hgf(const bf16_t* proj, const float* lbl, float* F) {
    long i = gtid(); if (i >= (long)T * 512) return; int r = (int)(i / 512), j = (int)(i % 512);
    float l0 = lbl[j], l1 = lbl[512 + j]; float mx = fmaxf(l0, l1); float e0 = expf(l0 - mx), e1 = expf(l1 - mx); float lb = e0 / (e0 + e1);
    F[i] = lb + (1.0f - lb) * sigmoidf_(PJ(r, C_HF + j));
}
__global__ void __launch_bounds__(64) k_hgrn(const bf16_t* proj, const float* F, float* Oraw) {
    long i = gtid(); if (i >= BATCH * 4 * 128) return; int e = (int)(i % 128), h = (int)((i / 128) % 4), b = (int)(i / 512);
    float S[128];
#pragma unroll
    for (int d = 0; d < 128; ++d) S[d] = 0.f;
    for (int t = 0; t < SEQ; ++t) {
        size_t row = (size_t)b * SEQ + t; const bf16_t* p = proj + row * LDP; const float* f = F + row * 512 + h * 128;
        float v = bf2f(p[C_HI + h * 128 + e]), o = 0.f;
#pragma unroll
        for (int d = 0; d < 128; ++d) { float ff = f[d]; S[d] = ff * S[d] + (1.0f - ff) * v; o += S[d] * bf2f(p[C_HQ + h * 128 + d]); }
        Oraw[row * 512 + h * 128 + e] = o * 0.08838834764831845f;
    }
}
__global__ void k_hgnorm(const float* Oraw, const bf16_t* proj, const float* ng, bf16_t* mix) {
    long i = gtid(); if (i >= (long)T * 4) return; size_t row = (size_t)(i / 4); int h = (int)(i % 4);
    const float* o = Oraw + row * 512 + h * 128; float s = 0.f;
    for (int e = 0; e < 128; ++e) s += o[e] * o[e];
    float r = 1.0f / sqrtf(s / 128 + EPS);
    for (int e = 0; e < 128; ++e) mix[row * D + h * 128 + e] = f2bf(o[e] * r * ng[h * 128 + e] * siluf_(PJ(row, C_HGT + h * 128 + e)));
}
__global__ void k_cmp_hidden(const bf16_t* proj, int coloff, const float* pe, const float* w1, const float* b1, float* hid) {
    long i = gtid(); if (i >= (long)BATCH * 2 * NCMP * 256) return; int j = (int)(i % 256); long r = i / 256; int c = (int)(r % NCMP), g = (int)((r / NCMP) % 2), b = (int)(r / (NCMP * 2));
    float acc = b1[j];
    for (int l = 0; l < 32; ++l) { const bf16_t* p = proj + ((size_t)b * SEQ + 16 * c + l) * LDP + coloff + g * 64;
        for (int d = 0; d < 64; ++d) acc += (bf2f(p[d]) + pe[l * 64 + d]) * w1[(size_t)(l * 64 + d) * 256 + j]; }
    hid[i] = gelu_tanh(acc);
}
__global__ void k_cmp_out(const float* hid, const float* w2, float* out) {
    long i = gtid(); if (i >= (long)BATCH * 2 * NCMP * 64) return; int d = (int)(i % 64); long r = i / 64;
    float acc = 0.f; for (int j = 0; j < 256; ++j) acc += hid[r * 256 + j] * w2[j * 64 + d];
    out[i] = acc;
}
__global__ void k_rope_tab(float* cs, float* sn) {
    long i = gtid(); if (i >= (long)SEQ * 32) return; int pos = (int)(i / 32), k = (int)(i % 32);
    float inv = powf(10000.0f, -(float)k / 32.0f); float ang = (float)pos * inv; cs[i] = cosf(ang); sn[i] = sinf(ang);
}
__global__ void k_rope_apply(const bf16_t* proj, int coloff, int nh, const float* cs, const float* sn, float* dst) {
    long i = gtid(); if (i >= (long)T * nh * 32) return; int k = (int)(i % 32); int h = (int)((i / 32) % nh); size_t row = (size_t)(i / (32 * nh)); int pos = (int)(row % SEQ);
    float t1 = PJ(row, coloff + h * 64 + k), t2 = PJ(row, coloff + h * 64 + k + 32), co = cs[pos * 32 + k], si = sn[pos * 32 + k];
    dst[row * (nh * 64) + h * 64 + k] = t1 * co - t2 * si; dst[row * (nh * 64) + h * 64 + k + 32] = t2 * co + t1 * si;
}
__global__ void __launch_bounds__(64) k_cmp_attn(const bf16_t* proj, const float* kcmp, const float* vcmp, float* ocmp, float* PS) {
    long i = gtid(); if (i >= (long)BATCH * 2 * SEQ) return; int s = (int)(i % SEQ), g = (int)((i / SEQ) % 2), b = (int)(i / (2 * SEQ));
    size_t row = (size_t)b * SEQ + s; float* ps = PS + (size_t)i * 64;
    for (int j = 0; j < 64; ++j) ps[j] = 0.f;
    int ncv = s >= 31 ? (s - 31) / 16 + 1 : 0; if (ncv > NCMP) ncv = NCMP;
    const float* kc = kcmp + (size_t)(b * 2 + g) * NCMP * 64; const float* vc = vcmp + (size_t)(b * 2 + g) * NCMP * 64;
    for (int hh = 0; hh < 4; ++hh) {
        int head = g * 4 + hh;
        float q[64], o[64];
#pragma unroll
        for (int d = 0; d < 64; ++d) { q[d] = PJ(row, C_NQ + head * 64 + d); o[d] = 0.f; }
        float m = -3.0e38f, l = 0.f;
        for (int c = 0; c < ncv; ++c) { float sc = 0.f;
#pragma unroll
            for (int d = 0; d < 64; ++d) sc += q[d] * kc[c * 64 + d];
            sc *= 0.125f; float mn = fmaxf(m, sc); l = l * expf(m - mn) + expf(sc - mn); m = mn; }
        for (int c = 0; c < ncv; ++c) { float sc = 0.f;
#pragma unroll
            for (int d = 0; d < 64; ++d) sc += q[d] * kc[c * 64 + d];
            sc *= 0.125f; float p = expf(sc - m) / l;
#pragma unroll
            for (int d = 0; d < 64; ++d) o[d] += p * vc[c * 64 + d];
            int c0 = 16 * c, c1 = 16 * c + 32;
            for (int j = c0 / 64; j <= (c1 - 1) / 64 && j < NSB; ++j) { int lo = c0 > 64 * j ? c0 : 64 * j, hi = c1 < 64 * j + 64 ? c1 : 64 * j + 64; if (hi > lo) ps[j] += p * (float)(hi - lo) / 32.0f; } }
#pragma unroll
        for (int d = 0; d < 64; ++d) ocmp[row * 512 + head * 64 + d] = o[d];
    }
}
__global__ void k_select(const float* PS, unsigned* SEL) {
    long i = gtid(); if (i >= (long)BATCH * 2 * SEQ) return; int s = (int)(i % SEQ); const float* ps = PS + (size_t)i * 64; int cur = s / 64;
    unsigned m0 = 0, m1 = 0;
    for (int j = 0; j < NSB; ++j) {
        bool fj = (j == 0) || (j == cur) || (j == cur - 1); float sj = fj ? 1e30f : (j <= cur ? ps[j] : -1e30f);
        int rank = 0;
        for (int k = 0; k < NSB; ++k) { bool fk = (k == 0) || (k == cur) || (k == cur - 1); float sk = fk ? 1e30f : (k <= cur ? ps[k] : -1e30f); if (sk > sj || (sk == sj && k < j)) ++rank; }
        if (rank < NSEL && sj > -1e29f) { if (j < 32) m0 |= 1u << j; else m1 |= 1u << (j - 32); }
    }
    SEL[i * 2] = m0; SEL[i * 2 + 1] = m1;
}
__global__ void __launch_bounds__(64) k_attn_naive(const float* qrot, const float* krot, const bf16_t* proj, int vcol, const unsigned* SEL, int mode, float* out) {
    long i = gtid(); if (i >= (long)BATCH * 8 * SEQ) return; int s = (int)(i % SEQ), head = (int)((i / SEQ) % 8), b = (int)(i / (8 * SEQ)); int g = head / 4;
    size_t row = (size_t)b * SEQ + s; float q[64], o[64];
#pragma unroll
    for (int d = 0; d < 64; ++d) { q[d] = qrot[row * 512 + head * 64 + d]; o[d] = 0.f; }
    float m = -3.0e38f, l = 0.f;
    unsigned m0 = 0, m1 = 0; if (mode == 0) { size_t si = ((size_t)(b * 2 + g) * SEQ + s) * 2; m0 = SEL[si]; m1 = SEL[si + 1]; }
    int k0 = mode == 0 ? 0 : (s - 511 > 0 ? s - 511 : 0);
    for (int key = k0; key <= s; ++key) {
        if (mode == 0) { int j = key / 64; bool sel = j < 32 ? ((m0 >> j) & 1u) : ((m1 >> (j - 32)) & 1u); if (!sel) { key = j * 64 + 63; continue; } }
        size_t kr = (size_t)b * SEQ + key; const float* kp = krot + kr * 128 + g * 64;
        float sc = 0.f;
#pragma unroll
        for (int d = 0; d < 64; ++d) sc += q[d] * kp[d];
        sc *= 0.125f; float mn = fmaxf(m, sc), a = expf(m - mn), p = expf(sc - mn); l = l * a + p; m = mn;
#pragma unroll
        for (int d = 0; d < 64; ++d) o[d] = o[d] * a + p * PJ(kr, vcol + g * 64 + d);
    }
#pragma unroll
    for (int d = 0; d < 64; ++d) out[row * 512 + head * 64 + d] = o[d] / l;
}
__global__ void k_nsa_combine(const bf16_t* proj, const float* ocmp, const float* oslc, const float* owin, bf16_t* mix) {
    long i = gtid(); if (i >= (long)T * 512) return; size_t row = (size_t)(i / 512); int c = (int)(i % 512), head = c / 64;
    mix[row * D + 512 + c] = f2bf(sigmoidf_(PJ(row, C_NG + head * 3)) * ocmp[i] + sigmoidf_(PJ(row, C_NG + head * 3 + 1)) * oslc[i] + sigmoidf_(PJ(row, C_NG + head * 3 + 2)) * owin[i]);
}
__global__ void k_proj_res(const bf16_t* A, const float* W, const float* x, const float* mod, int chunk, float* out) {
    long i = gtid(); if (i >= (long)T * D) return; int r = (int)(i / D), n = (int)(i % D), b = r / SEQ;
    float acc = 0.f; const bf16_t* a = A + (size_t)r * D;
    for (int k = 0; k < D; ++k) acc += bf2f(a[k]) * W[(size_t)k * D + n];
    out[i] = x[i] + mod[b * 6144 + chunk * D + n] * acc;
}
__global__ void __launch_bounds__(64) k_route(const float* LG, const float* bias, int* TOPI, float* TOPW) {
    long t = gtid(); if (t >= T) return; const float* lg = LG + (size_t)t * 64;
    float gs[8];
#pragma unroll
    for (int gI = 0; gI < 8; ++gI) { float a = -3e38f, b2 = -3e38f;
        for (int e = 0; e < 8; ++e) { float ch = sigmoidf_(lg[gI * 8 + e]) + bias[gI * 8 + e]; if (ch > a) { b2 = a; a = ch; } else if (ch > b2) b2 = ch; }
        gs[gI] = a + b2; }
    unsigned gmask = 0;
#pragma unroll
    for (int gI = 0; gI < 8; ++gI) { int rank = 0;
#pragma unroll
        for (int k = 0; k < 8; ++k) if (gs[k] > gs[gI] || (gs[k] == gs[gI] && k < gI)) ++rank;
        if (rank < 4) gmask |= 1u << gI; }
    int n = 0; float wsum = 0.f;
    for (int e = 0; e < 64; ++e) { if (!((gmask >> (e / 8)) & 1u)) continue; float se = sigmoidf_(lg[e]), ce = se + bias[e]; int rank = 0;
        for (int k = 0; k < 64; ++k) { if (!((gmask >> (k / 8)) & 1u)) continue; float ck = sigmoidf_(lg[k]) + bias[k]; if (ck > ce || (ck == ce && k < e)) ++rank; }
        if (rank < 8 && n < 8) { TOPI[t * 8 + n] = e; TOPW[t * 8 + n] = se; wsum += se; ++n; } }
    for (int k = 0; k < 8; ++k) TOPW[t * 8 + k] = TOPW[t * 8 + k] / wsum * 2.5f;
}
__global__ void k_moe_act(const bf16_t* h2, const float* Wgu, const int* TOPI, float* ACT, long nA) {
    long i = gtid(); if (i >= nA * 256) return; long a = i / 256; int j = (int)(i % 256); long t = TOPI ? a / 8 : a; int e = TOPI ? TOPI[a] : 0;
    const bf16_t* hp = h2 + (size_t)t * D; const float* w = Wgu + (size_t)e * D * 512; float gq = 0.f, u = 0.f;
    for (int k = 0; k < D; ++k) { float hv = bf2f(hp[k]); gq += hv * w[(size_t)k * 512 + j]; u += hv * w[(size_t)k * 512 + 256 + j]; }
    ACT[i] = siluf_(gq) * u;
}
__global__ void k_moe_out(const float* ACT, const float* ACTS, const float* Wdn, const float* Wsd, const int* TOPI, const float* TOPW, const float* x2, const float* mod, float* x3) {
    long i = gtid(); if (i >= (long)T * D) return; long t = i / D; int n = (int)(i % D), b = (int)(t / SEQ);
    float acc = 0.f;
    for (int sl = 0; sl < 8; ++sl) { int e = TOPI[t * 8 + sl]; const float* a = ACT + (size_t)(t * 8 + sl) * 256; const float* w = Wdn + (size_t)e * 256 * D; float y = 0.f;
        for (int k = 0; k < 256; ++k) y += a[k] * w[(size_t)k * D + n];
        acc += TOPW[t * 8 + sl] * y; }
    { const float* a = ACTS + (size_t)t * 256; float y = 0.f; for (int k = 0; k < 256; ++k) y += a[k] * Wsd[(size_t)k * D + n]; acc += y; }
    x3[i] = x2[i] + mod[b * 6144 + 5 * D + n] * acc;
}
__global__ void k_final(const float* x3, const float* rstd, const float* g, float* out) {
    long i = gtid(); if (i >= (long)T * D) return; out[i] = x3[i] * rstd[i / D] * g[i % D];
}
#undef PJ

struct In { const float *x, *c, *w_ada, *b_ada, *n1g, *w_in, *lbl, *hng, *pek, *w1k, *b1k, *w2k, *pev, *w1v, *b1v, *w2v, *w_out, *n2g, *rw, *rb, *wgu, *wdn, *wsgu, *wsdn, *fg;
    void set(void* const* d) { const float** p = (const float**)this; for (int i = 0; i < 25; ++i) p[i] = (const float*)d[i]; } };
#define NBK(n, tb) (((long)(n) + (tb) - 1) / (tb))
template <class Tp> static Tp* wsp(unsigned char* ws, size_t off) { return (Tp*)(ws + off); }
static void s1_naive(const In& I, unsigned char* ws, hipStream_t stream) {
    float* mod = wsp<float>(ws, WS_MOD); float* h = wsp<float>(ws, NV_H); float* rstd = wsp<float>(ws, NV_RSTD); bf16_t* proj = wsp<bf16_t>(ws, WS_PROJ);
    LAUNCH(k_mod, NBK(BATCH * 6144, 256), 256, I.c, I.w_ada, I.b_ada, mod);
    LAUNCH(k_rowrstd, NBK(T, 256), 256, I.x, rstd, T);
    LAUNCH(k_modnorm, NBK((long)T * D, 256), 256, I.x, rstd, I.n1g, mod, 0, 1, h, (bf16_t*)nullptr);
    LAUNCH(k_gemm_nn_bf, NBK((long)T * INC, 256), 256, h, D, I.w_in, INC, proj, LDP, T, INC, D);
}
static void s2_naive(const In& I, unsigned char* ws, hipStream_t stream, bool do_hg = true, bool do_nsa = true) {
    const bf16_t* proj = wsp<bf16_t>(ws, WS_PROJ); bf16_t* mix = wsp<bf16_t>(ws, WS_MIX);
    float *F = wsp<float>(ws, NV_F), *oraw = wsp<float>(ws, NV_ORAW), *owin = wsp<float>(ws, NV_OWIN), *ksr = wsp<float>(ws, NV_KSR), *kwr = wsp<float>(ws, NV_KWR), *PS = wsp<float>(ws, NV_PS);
    float *hid = wsp<float>(ws, NV_HID), *kcmp = wsp<float>(ws, NV_KCMP), *vcmp = wsp<float>(ws, NV_VCMP), *cs = wsp<float>(ws, NV_CS), *sn = wsp<float>(ws, NV_SN), *qrot = wsp<float>(ws, NV_QROT);
    unsigned* sel = wsp<unsigned>(ws, NV_SEL); float *ocmp = F, *oslc = oraw;
    if (do_hg) {
    LAUNCH(k_hgf, NBK((long)T * 512, 256), 256, proj, I.lbl, F);
    LAUNCH(k_hgrn, NBK(BATCH * 512, 64), 64, proj, F, oraw);
    LAUNCH(k_hgnorm, NBK((long)T * 4, 256), 256, oraw, proj, I.hng, mix);
    }
    if (!do_nsa) return;
    LAUNCH(k_cmp_hidden, NBK((long)BATCH * 2 * NCMP * 256, 256), 256, proj, C_KC, I.pek, I.w1k, I.b1k, hid);
    LAUNCH(k_cmp_out, NBK((long)BATCH * 2 * NCMP * 64, 256), 256, hid, I.w2k, kcmp);
    LAUNCH(k_cmp_hidden, NBK((long)BATCH * 2 * NCMP * 256, 256), 256, proj, C_VC, I.pev, I.w1v, I.b1v, hid);
    LAUNCH(k_cmp_out, NBK((long)BATCH * 2 * NCMP * 64, 256), 256, hid, I.w2v, vcmp);
    LAUNCH(k_rope_tab, NBK(SEQ * 32, 256), 256, cs, sn);
    LAUNCH(k_rope_apply, NBK((long)T * 8 * 32, 256), 256, proj, C_NQ, 8, cs, sn, qrot);
    LAUNCH(k_rope_apply, NBK((long)T * 2 * 32, 256), 256, proj, C_KS, 2, cs, sn, ksr);
    LAUNCH(k_rope_apply, NBK((long)T * 2 * 32, 256), 256, proj, C_KW, 2, cs, sn, kwr);
    LAUNCH(k_cmp_attn, NBK((long)BATCH * 2 * SEQ, 64), 64, proj, kcmp, vcmp, ocmp, PS);
    LAUNCH(k_select, NBK((long)BATCH * 2 * SEQ, 256), 256, PS, sel);
    LAUNCH(k_attn_naive, NBK((long)BATCH * 8 * SEQ, 64), 64, qrot, ksr, proj, C_VS, sel, 0, oslc);
    LAUNCH(k_attn_naive, NBK((long)BATCH * 8 * SEQ, 64), 64, qrot, kwr, proj, C_VW, sel, 1, owin);
    LAUNCH(k_nsa_combine, NBK((long)T * 512, 256), 256, proj, ocmp, oslc, owin, mix);
}
static void s3_naive(const In& I, unsigned char* ws, hipStream_t stream) {
    LAUNCH(k_proj_res, NBK((long)T * D, 256), 256, wsp<bf16_t>(ws, WS_MIX), I.w_out, I.x, wsp<float>(ws, WS_MOD), 2, wsp<float>(ws, WS_X2));
}
static void s4_naive(const In& I, unsigned char* ws, hipStream_t stream) {
    float *x2 = wsp<float>(ws, WS_X2), *rstd = wsp<float>(ws, NV_RSTD2), *h2f = wsp<float>(ws, NV_H2F), *lg = wsp<float>(ws, NV_LG), *mod = wsp<float>(ws, WS_MOD);
    LAUNCH(k_rowrstd, NBK(T, 256), 256, x2, rstd, T);
    LAUNCH(k_modnorm, NBK((long)T * D, 256), 256, x2, rstd, I.n2g, mod, 3, 4, h2f, wsp<bf16_t>(ws, WS_H2));
    LAUNCH(k_gemm_nn, NBK((long)T * 64, 256), 256, h2f, D, I.rw, 64, lg, 64, T, 64, D);
    LAUNCH(k_route, NBK(T, 64), 64, lg, I.rb, wsp<int>(ws, WS_TOPI), wsp<float>(ws, WS_TOPW));
}
static void s5_naive(const In& I, unsigned char* ws, float* out, hipStream_t stream) {
    float *act = wsp<float>(ws, NV_ACT), *acts = wsp<float>(ws, NV_ACTS), *x3 = wsp<float>(ws, NV_X3), *rstd = wsp<float>(ws, NV_RSTD3);
    const bf16_t* h2 = wsp<bf16_t>(ws, WS_H2); const int* topi = wsp<int>(ws, WS_TOPI);
    LAUNCH(k_moe_act, NBK((long)T * 8 * 256, 256), 256, h2, I.wgu, topi, act, (long)T * 8);
    LAUNCH(k_moe_act, NBK((long)T * 256, 256), 256, h2, I.wsgu, (const int*)nullptr, acts, (long)T);
    LAUNCH(k_moe_out, NBK((long)T * D, 256), 256, act, acts, I.wdn, I.wsdn, topi, wsp<float>(ws, WS_TOPW), wsp<float>(ws, WS_X2), wsp<float>(ws, WS_MOD), x3);
    LAUNCH(k_rowrstd, NBK(T, 256), 256, x3, rstd, T);
    LAUNCH(k_final, NBK((long)T * D, 256), 256, x3, rstd, I.fg, out);
}
}
#ifndef CPU_EMU
#define GAS __attribute__((address_space(1)))
#define LAS __attribute__((address_space(3)))
typedef unsigned v4u __attribute__((ext_vector_type(4)));
typedef unsigned v2u __attribute__((ext_vector_type(2)));
typedef float f32x4 __attribute__((ext_vector_type(4)));
typedef float f32x2 __attribute__((ext_vector_type(2)));
typedef float f32x16 __attribute__((ext_vector_type(16)));
typedef short bf16x8 __attribute__((ext_vector_type(8)));
typedef short bf16x4 __attribute__((ext_vector_type(4)));
typedef GAS unsigned gu32;
#define RLX_AGENT __ATOMIC_RELAXED, __HIP_MEMORY_SCOPE_AGENT
#define LDS_WAIT() asm volatile("s_waitcnt lgkmcnt(0)" ::: "memory")
#define VM_WAIT() asm volatile("s_waitcnt vmcnt(0)" ::: "memory")
constexpr int NWAVES = 8, NTHR = 512;
__device__ __forceinline__ unsigned pk2(float lo, float hi) { return (unsigned)f2bf(lo) | ((unsigned)f2bf(hi) << 16); }
__device__ __forceinline__ unsigned cvt_pk_bf16(float lo, float hi) { unsigned r; asm volatile("v_cvt_pk_bf16_f32 %0, %1, %2" : "=v"(r) : "v"(lo), "v"(hi)); return r; }
__device__ __forceinline__ float fexp2(float x) { return __builtin_amdgcn_exp2f(__builtin_amdgcn_fmed3f(x, -120.0f, 3.0e38f)); }
__device__ __forceinline__ float fexp(float x) { return __builtin_amdgcn_exp2f(fmaxf(x * 1.4426950408889634f, -120.0f)); }
__device__ __forceinline__ float fsigmoid(float z) { return 1.0f / (1.0f + __builtin_amdgcn_exp2f(fminf(fmaxf(-z * 1.4426950408889634f, -120.0f), 120.0f))); }
__device__ __forceinline__ float fsilu(float z) { return z / (1.0f + __builtin_amdgcn_exp2f(fminf(fmaxf(-z * 1.4426950408889634f, -120.0f), 120.0f))); }
__device__ __forceinline__ float wave_sum(float v) {
#pragma unroll
    for (int o = 1; o < 64; o <<= 1) v += __shfl_xor(v, o);
    return v;
}

#define XB_TMO      128
#define XB_XCNT(j)  (256  + 64 * (j))
#define XB_XSUB(j)  (1280 + 64 * (j))
#define XB_XGEN(j)  (2304 + 64 * (j))
#define XB_TOP      3328
#define XB_TOPGEN   3392
#define XCD_BAR_WORDS 3456
#define XB_SPIN_CAP (1u << 18)
__device__ __forceinline__ unsigned xb_ld(unsigned* p)              { return __hip_atomic_load(p, __ATOMIC_RELAXED, __HIP_MEMORY_SCOPE_AGENT); }
__device__ __forceinline__ unsigned xb_add(unsigned* p, unsigned v) { return __hip_atomic_fetch_add(p, v, __ATOMIC_RELAXED, __HIP_MEMORY_SCOPE_AGENT); }
__device__ __forceinline__ unsigned xb_xcc_id() { return (unsigned)__builtin_amdgcn_s_getreg((3 << 11) | 20) & 0xFu; }
#define XB_SPIN(cond, bar) do { unsigned _sp = 0; while (cond) { __builtin_amdgcn_s_sleep(1); \
    if ((++_sp & 255u) == 0u) { if (xb_ld(&(bar)[XB_TMO])) break; if (_sp > XB_SPIN_CAP) { atomicAdd(&(bar)[XB_TMO], 1u); break; } } } } while (0)
struct XcdBarrier { unsigned* bar; unsigned x; volatile LAS unsigned* st; };
__device__ __forceinline__ XcdBarrier xcd_barrier_post(unsigned* bar, volatile LAS unsigned* st) {
    XcdBarrier b; b.bar = bar; b.x = xb_xcc_id(); b.st = st;
    if (threadIdx.x == 0) (void)xb_add(&bar[XB_XCNT(b.x)], 1u);
    return b;
}
__device__ __forceinline__ void xcd_barrier_complete(unsigned* bar, unsigned x, unsigned& nloc, unsigned& nx) {
    const unsigned G = gridDim.x * gridDim.y * gridDim.z;
    unsigned sum, cnt, mine, sp = 0u;
    for (;;) {
        sum = 0u; cnt = 0u; mine = 0u;
#pragma unroll
        for (unsigned j = 0; j < 16; ++j) { const unsigned c = xb_ld(&bar[XB_XCNT(j)]); sum += c; cnt += (c > 0u) ? 1u : 0u; mine = (j == x) ? c : mine; }
        if (sum == G) break;
        __builtin_amdgcn_s_sleep(1);
        if ((++sp & 255u) == 0u) { if (xb_ld(&bar[XB_TMO])) break; if (sp > XB_SPIN_CAP) { atomicAdd(&bar[XB_TMO], 1u); break; } }
    }
    nloc = mine > 0u ? mine : 1u; nx = cnt > 0u ? cnt : 1u;
}
__device__ __forceinline__ void xcd_barrier(const XcdBarrier& b) {
    asm volatile("s_waitcnt vmcnt(0)" ::: "memory");
    __syncthreads();
    if (threadIdx.x == 0) {
        unsigned* bar = b.bar;
        __builtin_amdgcn_s_waitcnt(0);
        unsigned nloc = b.st[0], nx = b.st[1];
        if (nloc == 0u) { xcd_barrier_complete(bar, b.x, nloc, nx); b.st[0] = nloc; b.st[1] = nx; }
        const unsigned old = xb_add(&bar[XB_XSUB(b.x)], 1u);
        const unsigned gen = old / nloc;
        if (old + 1u == (gen + 1u) * nloc) {
            __builtin_amdgcn_fence(__ATOMIC_RELEASE, "agent");
            asm volatile("s_waitcnt vmcnt(0)" ::: "memory");
            const unsigned og = xb_add(&bar[XB_TOP], 1u);
            const unsigned tg = og / nx;
            if (og + 1u == (tg + 1u) * nx) xb_add(&bar[XB_TOPGEN], 1u);
            else XB_SPIN(xb_ld(&bar[XB_TOPGEN]) == tg, bar);
            __builtin_amdgcn_fence(__ATOMIC_ACQUIRE, "agent");
            xb_add(&bar[XB_XGEN(b.x)], 1u);
            asm volatile("s_waitcnt vmcnt(0)" ::: "memory");
        } else {
            XB_SPIN(xb_ld(&bar[XB_XGEN(b.x)]) == gen, bar);
            __builtin_amdgcn_fence(__ATOMIC_ACQUIRE, "agent");
            asm volatile("s_waitcnt vmcnt(0)" ::: "memory");
        }
    }
    __syncthreads();
}

namespace gm {
constexpr int BM = 256, BK = 64, HALF = 128, HTB = HALF * BK * 2, STAGE_BYTES = 8 * HTB, NXCD = 8, WGM = 8;
__host__ __device__ __forceinline__ int lds_byte(int r, int c) { const int st = (r >> 4) * 2 + (c >> 5), rr = r & 15, cc = c & 31, ob = rr * 64 + cc * 2; return st * 1024 + (ob ^ (((ob >> 9) & 1) << 5)); }
__host__ __device__ __forceinline__ void stage_rc(int b, int& R, int& C) { const int st = b / 1024, sb = b % 1024, swz = sb ^ (((sb >> 9) & 1) << 5); R = (st >> 1) * 16 + swz / 64; C = (st & 1) * 32 + (swz % 64) / 2; }
__host__ __device__ __forceinline__ int perm32(int rho) { const int n = rho >> 4, i = rho & 15; return 8 * (i >> 2) + 4 * n + (i & 3); }

struct Unit { int pm, pn; const char* A; const char* B; int e, m0; };

__device__ __forceinline__ bool static_tile(int nM, int nN, int G, int c, int i, int& pm, int& pn) {
    const int nwg = nM * nN; const long L = (long)i * G + c; if (L >= nwg) return false;
    int wgid = (int)L; { const int q = nwg / NXCD, r = nwg % NXCD, xcd = wgid % NXCD, off = wgid / NXCD; wgid = (xcd < r ? xcd * (q + 1) : r * (q + 1) + (xcd - r) * q) + off; }
    const int nig = WGM * nN, gid = wgid / nig, fm = gid * WGM, gsz = (nM - fm) < WGM ? (nM - fm) : WGM;
    pm = fm + ((wgid % nig) % gsz); pn = (wgid % nig) / gsz; return true;
}
struct DenseSched {
    const char* A; const char* Bt; int nM, nN, G, c; unsigned lda_b, K;
    __device__ __forceinline__ bool next(int i, Unit& u) const { int pm, pn; if (!static_tile(nM, nN, G, c, i, pm, pn)) return false; u.pm = pm; u.pn = pn; u.A = A + (size_t)pm * BM * lda_b; u.B = Bt + (size_t)pn * BM * K * 2; u.e = 0; u.m0 = 0; return true; }
    __device__ __forceinline__ unsigned arow(const Unit&, int r) const { return (unsigned)r * lda_b; }
};

template <class Epi, class Sched>
__device__ __forceinline__ void gemm_phase(LAS unsigned char* lds, const Sched& S, const Epi& E, const int K, const unsigned kstepA) {
    const int tid = threadIdx.x, wid = __builtin_amdgcn_readfirstlane(tid >> 6), lane = tid & 63, wr = wid >> 2, wc = wid & 3, fr = lane & 15, fq = lane >> 4;
    const int nt = K / BK;
    int R0, C0; stage_rc(tid * 16, R0, C0);
    unsigned voffB[2];
#pragma unroll
    for (int i = 0; i < 2; ++i) { const int R = R0 + 64 * i; const int Rb = Epi::PERM ? ((R & ~31) + perm32(R & 31)) : R; voffB[i] = (unsigned)(Rb * K + C0) * 2u; }
    const unsigned ca = (unsigned)C0 * 2u;
    const size_t kstepB = (size_t)(BK * 2);
    const size_t hstepB = (size_t)HALF * K * 2;
    const unsigned ldsw = (unsigned)wid * 1024u;
    const int aoff = lds_byte(wr * 64 + fr, fq * 8), boff = lds_byte(wc * 32 + fr, fq * 8);
#define GM_SA(b, h) (((b) * 2 + (h)) * HTB)
#define GM_SB(b, h) ((4 + (b) * 2 + (h)) * HTB)
#define GM_STAGEB(bufoff, gbase) do { _Pragma("unroll") for (int _i = 0; _i < 2; ++_i) \
        __builtin_amdgcn_global_load_lds((const unsigned*)((const char*)(gbase) + voffB[_i]), (LAS unsigned*)(lds + (bufoff) + ldsw + _i * 8192), 16, 0, 0); } while (0)
#define GM_STAGEA(bufoff, abase, offs, h, kb) do { _Pragma("unroll") for (int _i = 0; _i < 2; ++_i) \
        __builtin_amdgcn_global_load_lds((const unsigned*)((const char*)(abase) + (offs)[2 * (h) + _i] + (kb)), (LAS unsigned*)(lds + (bufoff) + ldsw + _i * 8192), 16, 0, 0); } while (0)
#define GM_LDA(dst, b, h) do { _Pragma("unroll") for (int m = 0; m < 4; ++m) _Pragma("unroll") for (int k = 0; k < 2; ++k) dst[m][k] = *(const LAS bf16x8*)(lds + GM_SA(b, h) + aoff + m * 2048 + k * 1024); } while (0)
#define GM_LDB(dst, b, h) do { _Pragma("unroll") for (int n = 0; n < 2; ++n) _Pragma("unroll") for (int k = 0; k < 2; ++k) dst[n][k] = *(const LAS bf16x8*)(lds + GM_SB(b, h) + boff + n * 2048 + k * 1024); } while (0)
#define GM_MMA(ai, bj, At, Bt) do { __builtin_amdgcn_s_setprio(1); _Pragma("unroll") for (int m = 0; m < 4; ++m) _Pragma("unroll") for (int n = 0; n < 2; ++n) _Pragma("unroll") for (int k = 0; k < 2; ++k) \
        acc[ai][bj][m][n] = __builtin_amdgcn_mfma_f32_16x16x32_bf16(Bt[n][k], At[m][k], acc[ai][bj][m][n], 0, 0, 0); __builtin_amdgcn_s_setprio(0); } while (0)
#define GM_WAIT_V(n) asm volatile("s_waitcnt vmcnt(" #n ")" ::: "memory")
#define GM_WAIT_L(n) asm volatile("s_waitcnt lgkmcnt(" #n ")" ::: "memory")
#define GM_BAR __builtin_amdgcn_s_barrier()
#define GM_SCHED __builtin_amdgcn_sched_barrier(0)
    Unit cur, nxt; int ui = 0;
    if (!S.next(0, cur)) return;
    unsigned coff[4], noff[4];
#pragma unroll
    for (int q = 0; q < 4; ++q) { coff[q] = S.arow(cur, R0 + 64 * q) + ca; noff[q] = coff[q]; }
    f32x4 acc[2][2][4][2];
#pragma unroll
    for (int a = 0; a < 2; ++a)
#pragma unroll
        for (int b = 0; b < 2; ++b)
#pragma unroll
            for (int m = 0; m < 4; ++m)
#pragma unroll
                for (int n = 0; n < 2; ++n) acc[a][b][m][n] = (f32x4){0.f, 0.f, 0.f, 0.f};
    bf16x8 At[4][2], B0[2][2], B1[2][2];
    const char* cA = cur.A; const char* cB = cur.B;
    GM_STAGEB(GM_SB(0, 0), cB); GM_STAGEB(GM_SB(0, 1), cB + hstepB); GM_STAGEA(GM_SA(0, 0), cA, coff, 0, 0u); GM_STAGEA(GM_SA(0, 1), cA, coff, 1, 0u);
    if (wr == 1) GM_BAR;
    GM_WAIT_V(2); GM_BAR;
    GM_STAGEB(GM_SB(1, 0), cB + kstepB); GM_STAGEA(GM_SA(1, 0), cA, coff, 0, kstepA); GM_STAGEB(GM_SB(1, 1), cB + hstepB + kstepB);
    GM_WAIT_V(6); GM_BAR;
    for (;;) {
        const bool has_next = S.next(ui + 1, nxt);
        const char* nA = has_next ? nxt.A : cA; const char* nB = has_next ? nxt.B : cB;
        if (has_next) {
#pragma unroll
            for (int q = 0; q < 4; ++q) noff[q] = S.arow(nxt, R0 + 64 * q) + ca;
        } else {
#pragma unroll
            for (int q = 0; q < 4; ++q) noff[q] = coff[q];
        }
#pragma unroll 1
        for (int t = 0; t < nt; t += 2) {
            const bool last = (t == nt - 2);
            const unsigned k1 = (unsigned)(t + 1) * kstepA;
            const char* a2 = last ? nA : cA; const unsigned k2 = last ? 0u : (unsigned)(t + 2) * kstepA, k3 = k2 + kstepA;
            unsigned o2[4];
#pragma unroll
            for (int q = 0; q < 4; ++q) o2[q] = last ? noff[q] : coff[q];
            const char* b2 = last ? nB : cB + (size_t)(t + 2) * kstepB; const char* b3 = b2 + kstepB;
            GM_LDB(B0, 0, 0); GM_LDB(B1, 0, 1); GM_SCHED; GM_LDA(At, 0, 0); GM_STAGEA(GM_SA(1, 1), cA, coff, 1, k1);
            GM_WAIT_V(8); GM_WAIT_L(0); GM_BAR; GM_MMA(0, 0, At, B0); GM_MMA(0, 1, At, B1); GM_BAR; GM_SCHED;
            GM_LDA(At, 0, 1); GM_STAGEB(GM_SB(0, 0), b2); GM_STAGEB(GM_SB(0, 1), b2 + hstepB); GM_STAGEA(GM_SA(0, 0), a2, o2, 0, k2);
            GM_WAIT_V(8); GM_WAIT_L(0); GM_BAR; GM_MMA(1, 0, At, B0); GM_MMA(1, 1, At, B1); GM_BAR; GM_SCHED;
            GM_LDB(B0, 1, 0); GM_LDB(B1, 1, 1); GM_SCHED; GM_LDA(At, 1, 0); GM_STAGEA(GM_SA(0, 1), a2, o2, 1, k2);
            GM_WAIT_V(8); GM_WAIT_L(0); GM_BAR; GM_MMA(0, 0, At, B0); GM_MMA(0, 1, At, B1); GM_BAR; GM_SCHED;
            GM_LDA(At, 1, 1); GM_STAGEB(GM_SB(1, 0), b3); GM_STAGEB(GM_SB(1, 1), b3 + hstepB); GM_STAGEA(GM_SA(1, 0), a2, o2, 0, k3);
            GM_WAIT_V(8); GM_WAIT_L(0); GM_BAR; GM_MMA(1, 0, At, B0); GM_MMA(1, 1, At, B1); GM_BAR; GM_SCHED;
        }
        if (wr == 0) GM_BAR;
        E(acc, cur, wr, wc, fr, fq);
        if (!has_next) break;
#pragma unroll
        for (int a = 0; a < 2; ++a)
#pragma unroll
            for (int b = 0; b < 2; ++b)
#pragma unroll
                for (int m = 0; m < 4; ++m)
#pragma unroll
                    for (int n = 0; n < 2; ++n) acc[a][b][m][n] = (f32x4){0.f, 0.f, 0.f, 0.f};
        cur = nxt; cA = nA; cB = nB; ++ui;
#pragma unroll
        for (int q = 0; q < 4; ++q) coff[q] = noff[q];
        if (wr == 1) GM_BAR;
    }
    GM_WAIT_V(0);
    GM_BAR;
#undef GM_SA
#undef GM_SB
#undef GM_STAGEA
#undef GM_STAGEB
#undef GM_LDA
#undef GM_LDB
#undef GM_MMA
#undef GM_WAIT_V
#undef GM_WAIT_L
#undef GM_BAR
#undef GM_SCHED
}

struct EpiBf16 {
    static constexpr bool PERM = true;
    bf16_t* O; int ldc;
    __device__ __forceinline__ void operator()(const f32x4 (&acc)[2][2][4][2], const Unit& u, int wr, int wc, int fr, int fq) const {
        const int row0 = u.pm * BM + wr * 64 + fr, col0 = u.pn * BM + wc * 32 + 8 * fq;
#pragma unroll
        for (int ai = 0; ai < 2; ++ai)
#pragma unroll
            for (int m = 0; m < 4; ++m) { bf16_t* rowp = O + (size_t)(row0 + ai * HALF + m * 16) * ldc + col0;
#pragma unroll
                for (int bj = 0; bj < 2; ++bj) { const f32x4 v0 = acc[ai][bj][m][0], v1 = acc[ai][bj][m][1];
                    v4u w; w.x = cvt_pk_bf16(v0[0], v0[1]); w.y = cvt_pk_bf16(v0[2], v0[3]); w.z = cvt_pk_bf16(v1[0], v1[1]); w.w = cvt_pk_bf16(v1[2], v1[3]);
                    *(v4u*)(rowp + bj * HALF) = w; } }
    }
};
struct EpiRes {
    static constexpr bool PERM = false;
    const float* x; const float* mod; int chunk; float* out;
    __device__ __forceinline__ void operator()(const f32x4 (&acc)[2][2][4][2], const Unit& u, int wr, int wc, int fr, int fq) const {
        const int row0 = u.pm * BM + wr * 64 + fr, col0 = u.pn * BM + wc * 32 + 4 * fq; const int b = (u.pm * BM) / SEQ;
        f32x4 gv[2][2];
#pragma unroll
        for (int bj = 0; bj < 2; ++bj)
#pragma unroll
            for (int n = 0; n < 2; ++n) gv[bj][n] = *(const f32x4*)(mod + (size_t)b * 6144 + chunk * 1024 + col0 + bj * HALF + n * 16);
#pragma unroll
        for (int ai = 0; ai < 2; ++ai)
#pragma unroll
            for (int m = 0; m < 4; ++m) { const size_t off = (size_t)(row0 + ai * HALF + m * 16) * 1024 + col0;
#pragma unroll
                for (int bj = 0; bj < 2; ++bj)
#pragma unroll
                    for (int n = 0; n < 2; ++n) { const f32x4 xv = *(const f32x4*)(x + off + bj * HALF + n * 16); *(f32x4*)(out + off + bj * HALF + n * 16) = xv + gv[bj][n] * acc[ai][bj][m][n]; } }
    }
};
}
#ifndef PROBE_REP
#define PROBE_REP -1
#endif
constexpr int RING_BYTES = 131072, LDSCTL_OFF = RING_BYTES, MISC_OFF = LDSCTL_OFF + 320, LDS_BYTES = 147456;
constexpr int CW_BAR = 4096;
constexpr int CW_ECNT = 65536;

struct Args { const float* in[25]; float* out; unsigned char* ws; int ph_lo, ph_hi, rep, pad; };
struct Frame {
    LAS unsigned char* lds; volatile LAS unsigned* MISC; unsigned* ctl; unsigned char* ws;
    int tid, lane, wave, vcu, G;
    const float* in[25]; float* out;
};
#define IN_X 0
#define IN_C 1
#define IN_WADA 2
#define IN_BADA 3
#define IN_N1G 4
#define IN_WIN 5
#define IN_LBL 6
#define IN_HNG 7
#define IN_PEK 8
#define IN_W1K 9
#define IN_B1K 10
#define IN_W2K 11
#define IN_PEV 12
#define IN_W1V 13
#define IN_B1V 14
#define IN_W2V 15
#define IN_WOUT 16
#define IN_N2G 17
#define IN_RW 18
#define IN_RB 19
#define IN_WGU 20
#define IN_WDN 21
#define IN_WSGU 22
#define IN_WSDN 23
#define IN_FG 24

template <bool FRAG = false> __device__ __forceinline__ void p0_transpose_item(const float* W, int K, int N, bf16_t* WT, int drow0, int k0, int n0, LAS float* scr, int lane) {
    const int kq = lane >> 3, nq = lane & 7; const int nn = n0 + 4 * nq; const bool ok = nn < N;
    f32x4 v[8];
#pragma unroll
    for (int i = 0; i < 8; ++i) v[i] = ok ? *(const f32x4*)(W + (size_t)(k0 + 8 * i + kq) * N + nn) : (f32x4){0.f, 0.f, 0.f, 0.f};
#pragma unroll
    for (int i = 0; i < 8; ++i) { LAS float* d = scr + (8 * i + kq) * 33 + 4 * nq; d[0] = v[i][0]; d[1] = v[i][1]; d[2] = v[i][2]; d[3] = v[i][3]; }
    LDS_WAIT(); asm volatile("" ::: "memory");
    const int c = lane & 7;
#pragma unroll
    for (int j = 0; j < 4; ++j) { const int n = (lane >> 3) + 8 * j; const LAS float* s = scr + (8 * c) * 33 + n;
        v4u o; o.x = pk2(s[0 * 33], s[1 * 33]); o.y = pk2(s[2 * 33], s[3 * 33]); o.z = pk2(s[4 * 33], s[5 * 33]); o.w = pk2(s[6 * 33], s[7 * 33]);
        if (FRAG) { const int kk = k0 + 8 * c, col = drow0 + n; *(v4u*)(WT + ((size_t)((kk >> 5) * (N / 16) + (col >> 4)) * 64 + ((kk & 31) >> 3) * 16 + (col & 15)) * 8) = o; }
        else *(v4u*)(WT + (size_t)(drow0 + n) * K + k0 + 8 * c) = o; }
    LDS_WAIT(); asm volatile("" ::: "memory");
}
__device__ __forceinline__ int gu_row(int n) { const int j = n & 255; return (j >> 7) * 256 + ((n >> 8) << 7) + (j & 127); }

__device__ __forceinline__ void p0_prologue(Frame& F) {
    unsigned char* ws = F.ws;
    if (F.vcu < 256) {
        LAS float* ca = (LAS float*)F.lds;
        const int ks = F.vcu >> 4, cg = F.vcu & 15;
        if (F.tid < 256) { const int b = F.tid >> 6, k = F.tid & 63; ca[F.tid] = fsilu(F.in[IN_C][b * D + ks * 64 + k]); }
        __syncthreads();
        if (F.tid < 384) { const int n = cg * 384 + F.tid; const float* w = F.in[IN_WADA] + (size_t)(ks * 64) * 6144 + n; float a0 = 0.f, a1 = 0.f, a2 = 0.f, a3 = 0.f;
#pragma unroll 8
            for (int k = 0; k < 64; ++k) { const float wv = w[(size_t)k * 6144]; a0 += ca[k] * wv; a1 += ca[64 + k] * wv; a2 += ca[128 + k] * wv; a3 += ca[192 + k] * wv; }
            float* mp = (float*)(ws + WS_MODP) + (size_t)ks * 4 * 6144 + n; mp[0] = a0; mp[6144] = a1; mp[2 * 6144] = a2; mp[3 * 6144] = a3; }
        __syncthreads();
    }
    { float* cs = (float*)(ws + WS_CS); float* sn = (float*)(ws + WS_SN);
      for (int i = F.vcu * NTHR + F.tid; i < SEQ * 32; i += F.G * NTHR) { const int pos = i >> 5, k = i & 31; const float inv = powf(10000.0f, -(float)k / 32.0f); const float ang = (float)pos * inv; cs[i] = cosf(ang); sn[i] = sinf(ang); } }
    LAS float* scr = (LAS float*)(F.lds + 4096 + F.wave * 8704);
    const int gw = F.vcu * NWAVES + F.wave, NGW = F.G * NWAVES;
    constexpr int I_IN = 16 * 105, I_OUT = 16 * 32, I_GU = 16 * 16, I_DN = 4 * 32, I_W1 = 32 * 8;
    constexpr int NIT = I_IN + I_OUT + 64 * I_GU + 64 * I_DN + I_GU + I_DN + 2 * I_W1;
    for (int it = gw; it < NIT; it += NGW) {
        int r = it;
        if (r < I_IN) { const int kb = r / 105, nb = r % 105; p0_transpose_item(F.in[IN_WIN], 1024, INC, (bf16_t*)(ws + WS_WINT), 32 * nb, 64 * kb, 32 * nb, scr, F.lane); continue; } r -= I_IN;
        if (r < I_OUT) { const int kb = r / 32, nb = r % 32; p0_transpose_item(F.in[IN_WOUT], 1024, 1024, (bf16_t*)(ws + WS_WOUTT), 32 * nb, 64 * kb, 32 * nb, scr, F.lane); continue; } r -= I_OUT;
        if (r < 64 * I_GU) { const int e = r / I_GU, q = r % I_GU, kb = q / 16, nb = q % 16;
            p0_transpose_item(F.in[IN_WGU] + (size_t)e * 1024 * 512, 1024, 512, (bf16_t*)(ws + WS_WGUT) + (size_t)e * 512 * 1024, gu_row(32 * nb), 64 * kb, 32 * nb, scr, F.lane); continue; } r -= 64 * I_GU;
        if (r < 64 * I_DN) { const int e = r / I_DN, q = r % I_DN, kb = q / 32, nb = q % 32;
            p0_transpose_item(F.in[IN_WDN] + (size_t)e * 256 * 1024, 256, 1024, (bf16_t*)(ws + WS_WDNT) + (size_t)e * 1024 * 256, 32 * nb, 64 * kb, 32 * nb, scr, F.lane); continue; } r -= 64 * I_DN;
        if (r < I_GU) { const int kb = r / 16, nb = r % 16; p0_transpose_item(F.in[IN_WSGU], 1024, 512, (bf16_t*)(ws + WS_WSGUT), gu_row(32 * nb), 64 * kb, 32 * nb, scr, F.lane); continue; } r -= I_GU;
        if (r < I_DN) { const int kb = r / 32, nb = r % 32; p0_transpose_item(F.in[IN_WSDN], 256, 1024, (bf16_t*)(ws + WS_WSDNT), 32 * nb, 64 * kb, 32 * nb, scr, F.lane); continue; } r -= I_DN;
        { const int kv = r / I_W1, q = r % I_W1, kb = q / 8, nb = q % 8;
          p0_transpose_item<true>(F.in[kv ? IN_W1V : IN_W1K], 2048, 256, (bf16_t*)(ws + (kv ? WS_W1VT : WS_W1KT)), 32 * nb, 64 * kb, 32 * nb, scr, F.lane); }
    }
    { v4u* z = (v4u*)((bf16_t*)(ws + WS_WINT) + (size_t)3360 * 1024); const int n16 = 224 * 1024 * 2 / 16;
      for (int i = F.vcu * NTHR + F.tid; i < n16; i += F.G * NTHR) z[i] = (v4u){0u, 0u, 0u, 0u}; }
    { bf16_t* w2f = (bf16_t*)(ws + WS_W2T);
      for (int i = F.vcu * NTHR + F.tid; i < 2 * 256 * 64; i += F.G * NTHR) { const int kv = i >> 14, r = i & 16383, k = r >> 6, dd = r & 63; const float v = F.in[kv ? IN_W2V : IN_W2K][r];
          w2f[(size_t)kv * 16384 + ((size_t)((k >> 5) * 4 + (dd >> 4)) * 64 + ((k & 31) >> 3) * 16 + (dd & 15)) * 8 + (k & 7)] = f2bf(v); } }
    { bf16_t* hi = (bf16_t*)(ws + WS_RW); bf16_t* lo = hi + 64 * 1024; const float* rw = F.in[IN_RW];
      for (int i = F.vcu * NTHR + F.tid; i < 64 * 1024; i += F.G * NTHR) { const int k = i >> 6, e = i & 63; const float w = rw[i]; const bf16_t h = f2bf(w);
          const size_t o = ((size_t)((k >> 5) * 4 + (e >> 4)) * 64 + ((k & 31) >> 3) * 16 + (e & 15)) * 8 + (k & 7); hi[o] = h; lo[o] = f2bf(w - bf2f(h)); } }
}

__device__ __forceinline__ void p1a_norm(Frame& F) {
    unsigned char* ws = F.ws; const float* modp = (const float*)(ws + WS_MODP); const float* bada = F.in[IN_BADA];
    for (int i = F.vcu * NTHR + F.tid; i < BATCH * 6144; i += F.G * NTHR) { float a = bada[i % 6144];
#pragma unroll
        for (int ks = 0; ks < 16; ++ks) a += modp[(size_t)ks * 4 * 6144 + i];
        ((float*)(ws + WS_MOD))[i] = a; }
    for (int o = F.vcu * NWAVES + F.wave; o < 512; o += F.G * NWAVES) { const int kv = o >> 8, j = o & 255; const float* pe = F.in[kv ? IN_PEV : IN_PEK];
        const bf16_t* wf = (const bf16_t*)(ws + (kv ? WS_W1VT : WS_W1KT)); float a = 0.f;
#pragma unroll
        for (int i = 0; i < 4; ++i) { const int cid = F.lane + 64 * i, s = cid >> 2, q = cid & 3; const v4u wv = *(const v4u*)(wf + ((size_t)(s * 16 + (j >> 4)) * 64 + q * 16 + (j & 15)) * 8);
            const f32x4 p0 = *(const f32x4*)(pe + 32 * s + 8 * q), p1 = *(const f32x4*)(pe + 32 * s + 8 * q + 4);
            a += bf2f((bf16_t)(wv.x & 0xffff)) * p0[0] + bf2f((bf16_t)(wv.x >> 16)) * p0[1] + bf2f((bf16_t)(wv.y & 0xffff)) * p0[2] + bf2f((bf16_t)(wv.y >> 16)) * p0[3]
               + bf2f((bf16_t)(wv.z & 0xffff)) * p1[0] + bf2f((bf16_t)(wv.z >> 16)) * p1[1] + bf2f((bf16_t)(wv.w & 0xffff)) * p1[2] + bf2f((bf16_t)(wv.w >> 16)) * p1[3]; }
        a = wave_sum(a); if (F.lane == 0) ((float*)(ws + WS_B1F))[o] = a + F.in[kv ? IN_B1V : IN_B1K][j]; }
    LAS float* sh = (LAS float*)F.lds; LAS float* sc = sh + 1024;
    const float* g1 = F.in[IN_N1G]; const float* x = F.in[IN_X]; bf16_t* xn = (bf16_t*)(ws + WS_XN);
    for (int chunk = F.vcu; chunk < T / 64; chunk += F.G) {
        const int b = (chunk * 64) / SEQ;
        __syncthreads();
        for (int i = F.tid; i < 2048; i += NTHR) { const int col = i; float a = bada[col];
#pragma unroll
            for (int ks = 0; ks < 16; ++ks) a += modp[(size_t)(ks * 4 + b) * 6144 + col];
            sh[i] = a; }
        __syncthreads();
#pragma unroll 1
        for (int rr = 0; rr < 8; ++rr) {
            const int row = chunk * 64 + F.wave * 8 + rr; const f32x4* xr = (const f32x4*)(x + (size_t)row * D) + F.lane;
            f32x4 v[4]; float s = 0.f;
#pragma unroll
            for (int j = 0; j < 4; ++j) { v[j] = xr[64 * j]; s += (v[j].x * v[j].x + v[j].y * v[j].y) + (v[j].z * v[j].z + v[j].w * v[j].w); }
            const float rstd = 1.0f / sqrtf(wave_sum(s) * (1.0f / D) + EPS);
            unsigned long long* o8 = (unsigned long long*)(xn + (size_t)row * D) + F.lane;
#pragma unroll
            for (int j = 0; j < 4; ++j) { const int c0 = 4 * F.lane + 256 * j; const f32x4 g = *(const f32x4*)(g1 + c0);
                const float h0 = v[j].x * rstd * g.x * (1.0f + sc[c0]) + sh[c0], h1 = v[j].y * rstd * g.y * (1.0f + sc[c0 + 1]) + sh[c0 + 1];
                const float h2 = v[j].z * rstd * g.z * (1.0f + sc[c0 + 2]) + sh[c0 + 2], h3 = v[j].w * rstd * g.w * (1.0f + sc[c0 + 3]) + sh[c0 + 3];
                o8[64 * j] = (unsigned long long)pk2(h0, h1) | ((unsigned long long)pk2(h2, h3) << 32); }
        }
    }
    __syncthreads();
}


__device__ __forceinline__ float hg_lb(const float* lbl, int j) { return 1.0f / (1.0f + expf(lbl[512 + j] - lbl[j])); }
__device__ __forceinline__ void hg_passA(Frame& F, int unit) {
    unsigned char* ws = F.ws; const bf16_t* proj = (const bf16_t*)(ws + WS_PROJ); float* U = (float*)(ws + WS_U) + (size_t)unit * 16384; float* Dd = (float*)(ws + WS_DD) + (size_t)unit * 128;
    const int b = unit >> 6, h = (unit >> 4) & 3, J = unit & 15; const size_t tok0 = (size_t)b * SEQ + 256 * J;
    const int d = F.tid & 127, g = F.tid >> 7;
    LAS unsigned char* KT = F.lds; LAS unsigned char* VT = F.lds + 65536; LAS float* segtot = (LAS float*)(F.lds + LDSCTL_OFF + 512);
    const float lb = hg_lb(F.in[IN_LBL], h * 128 + d);
    const bf16_t* pf = proj + (tok0 + 64 * g) * LDP + C_HF + h * 128 + d; const bf16_t* pv = proj + (tok0 + 64 * g) * LDP + C_HI + h * 128 + d;
    __syncthreads();
    float fs[64]; unsigned short vraw[64];
#pragma unroll
    for (int s = 0; s < 64; ++s) { fs[s] = bf2f(pf[(size_t)s * LDP]); vraw[s] = pv[(size_t)s * LDP]; }
    float sum = 0.f;
#pragma unroll
    for (int s = 0; s < 64; ++s) { const float f = lb + (1.0f - lb) * fsigmoid(fs[s]); fs[s] = f; sum += __logf(f); }
    segtot[g * 128 + d] = sum;
    __syncthreads();
    float off = 0.f, Bt = 0.f;
#pragma unroll
    for (int k = 0; k < 4; ++k) { const float v = segtot[k * 128 + d]; Bt += v; if (k < g) off += v; }
    float run = off;
#pragma unroll
    for (int s8 = 0; s8 < 8; ++s8) { unsigned kk[4], vv[4];
#pragma unroll
        for (int i = 0; i < 4; ++i) { float kt[2];
#pragma unroll
            for (int j = 0; j < 2; ++j) { const int s = 8 * s8 + 2 * i + j; const float f = fs[s]; run += __logf(f); kt[j] = (1.0f - f) * fexp(Bt - run); }
            kk[i] = pk2(kt[0], kt[1]); vv[i] = (unsigned)vraw[8 * s8 + 2 * i] | ((unsigned)vraw[8 * s8 + 2 * i + 1] << 16); }
        const int c = (8 * g + s8) ^ (d & 31);
        *(LAS v4u*)(KT + d * 512 + c * 16) = (v4u){kk[0], kk[1], kk[2], kk[3]}; *(LAS v4u*)(VT + d * 512 + c * 16) = (v4u){vv[0], vv[1], vv[2], vv[3]}; }
    if (g == 0) Dd[d] = fexp(Bt);
    __syncthreads();
    const int dt = F.wave >> 1, et0 = 2 * (F.wave & 1), i = F.lane & 31, hh = F.lane >> 5;
    f32x16 acc[2];
#pragma unroll
    for (int k = 0; k < 16; ++k) { acc[0][k] = 0.f; acc[1][k] = 0.f; }
#pragma unroll 4
    for (int st = 0; st < 16; ++st) { const int ch = 2 * st + hh;
        const bf16x8 a = *(const LAS bf16x8*)(KT + (32 * dt + i) * 512 + ((ch ^ i) & 31) * 16);
#pragma unroll
        for (int t = 0; t < 2; ++t) { const bf16x8 bv = *(const LAS bf16x8*)(VT + (32 * (et0 + t) + i) * 512 + ((ch ^ i) & 31) * 16);
            acc[t] = __builtin_amdgcn_mfma_f32_32x32x16_bf16(a, bv, acc[t], 0, 0, 0); } }
#pragma unroll
    for (int t = 0; t < 2; ++t)
#pragma unroll
        for (int r = 0; r < 16; ++r) U[(size_t)(32 * dt + (r & 3) + 8 * (r >> 2) + 4 * hh) * 128 + 32 * (et0 + t) + i] = acc[t][r];
    __syncthreads();
}
__device__ __forceinline__ void hg_passC(Frame& F, int unit) {
    unsigned char* ws = F.ws; const bf16_t* proj = (const bf16_t*)(ws + WS_PROJ); bf16_t* mix = (bf16_t*)(ws + WS_MIX);
    const float* Uall = (const float*)(ws + WS_U); const float* Dall = (const float*)(ws + WS_DD);
    const int b = unit >> 6, h = (unit >> 4) & 3, J = unit & 15; const size_t tok0 = (size_t)b * SEQ + 256 * J;
    const int w = F.wave, n = F.lane & 15, q = F.lane >> 4;
    LAS bf16_t* Qs = (LAS bf16_t*)F.lds; LAS bf16_t* Kh = Qs + 16 * 136; LAS bf16_t* Kt = Kh + 16 * 136; LAS bf16_t* Vt = Kt + 128 * 24;
    LAS float* G = (LAS float*)(Vt + 128 * 24); LAS float* TQ = G + 128; LAS float* SSP = TQ + 512;
    f32x4 S[8];
#pragma unroll
    for (int dt = 0; dt < 8; ++dt) S[dt] = (f32x4){0.f, 0.f, 0.f, 0.f};
#ifndef PROBE_HGC
#define PROBE_HGC 0
#endif
    for (int rp_ = 0; rp_ < (PROBE_HGC == 1 ? 2 : 1); ++rp_) {
#pragma unroll
    for (int dt = 0; dt < 8; ++dt) S[dt] = (f32x4){0.f, 0.f, 0.f, 0.f};
    {
        LAS float* WJ = (LAS float*)F.lds;
        __syncthreads();
        if (F.tid < 128) { float wgt = 1.0f; for (int j = J - 1; j >= 0; --j) { WJ[j * 128 + F.tid] = wgt; wgt *= Dall[(size_t)(unit - J + j) * 128 + F.tid]; } }
        __syncthreads();
#pragma unroll 2
        for (int j = 0; j < J; ++j) { const float* Uj = Uall + (size_t)(unit - J + j) * 16384;
#pragma unroll
            for (int dt = 0; dt < 8; ++dt) { const f32x4 wv = *(const LAS f32x4*)(WJ + j * 128 + 16 * dt + 4 * q);
#pragma unroll
                for (int r = 0; r < 4; ++r) S[dt][r] += wv[r] * Uj[(size_t)(16 * dt + 4 * q + r) * 128 + 16 * w + n]; } }
        __syncthreads();
    }
    }
    const int d = F.tid & 127, tq = F.tid >> 7; const float lb = hg_lb(F.in[IN_LBL], h * 128 + d);
    const float ngv0 = 0.f; (void)ngv0;
    unsigned short rf[4], rq[4], rv[4]; v2u rgate;
    const int e0 = h * 128 + 16 * w + 4 * q;
#pragma unroll
    for (int i = 0; i < 4; ++i) { const bf16_t* pr = proj + (tok0 + 4 * tq + i) * LDP + h * 128 + d; rf[i] = pr[C_HF]; rq[i] = pr[C_HQ]; rv[i] = pr[C_HI]; }
    rgate = *(const v2u*)(proj + (tok0 + n) * LDP + C_HGT + e0);
#pragma unroll 1
    for (int blk = 0; blk < 16; ++blk) {
        const size_t t0 = tok0 + 16 * blk;
        __syncthreads();
        float fv[4], pr[4], qv[4]; unsigned short vb[4]; float tot = 1.f;
#pragma unroll
        for (int i = 0; i < 4; ++i) { const float f = lb + (1.0f - lb) * fsigmoid(bf2f(rf[i])); fv[i] = f; tot *= f; pr[i] = tot; qv[i] = bf2f(rq[i]) * 0.08838834764831845f; vb[i] = rv[i]; }
        const v2u gt = rgate;
        if (blk < 15) {
#pragma unroll
            for (int i = 0; i < 4; ++i) { const bf16_t* pr_ = proj + (t0 + 16 + 4 * tq + i) * LDP + h * 128 + d; rf[i] = pr_[C_HF]; rq[i] = pr_[C_HQ]; rv[i] = pr_[C_HI]; }
            rgate = *(const v2u*)(proj + (t0 + 16 + n) * LDP + C_HGT + e0); }
        TQ[tq * 128 + d] = tot;
        __syncthreads();
        float off = 1.f, cc = 1.f;
#pragma unroll
        for (int k = 0; k < 4; ++k) { const float v = TQ[k * 128 + d]; cc *= v; if (k < tq) off *= v; }
        { unsigned kt2[2], v2[2];
#pragma unroll
          for (int i = 0; i < 4; ++i) { const float eb = off * pr[i], inv = __builtin_amdgcn_rcpf(eb); const int t = 4 * tq + i; const float kf = 1.0f - fv[i];
              Qs[t * 136 + d] = f2bf(qv[i] * eb); Kh[t * 136 + d] = f2bf(kf * inv);
              const unsigned short kb = f2bf(kf * cc * inv);
              if (i & 1) { kt2[i >> 1] |= (unsigned)kb << 16; v2[i >> 1] |= (unsigned)vb[i] << 16; } else { kt2[i >> 1] = kb; v2[i >> 1] = vb[i]; } }
          *(LAS v2u*)(Kt + d * 24 + 4 * tq) = (v2u){kt2[0], kt2[1]}; *(LAS v2u*)(Vt + d * 24 + 4 * tq) = (v2u){v2[0], v2[1]}; }
        if (tq == 0) G[d] = cc;
        __syncthreads();
        f32x4 pt = (f32x4){0.f, 0.f, 0.f, 0.f};
#pragma unroll
        for (int st = 0; st < 4; ++st) { const bf16x8 a = *(const LAS bf16x8*)(Kh + n * 136 + 32 * st + 8 * q), bq = *(const LAS bf16x8*)(Qs + n * 136 + 32 * st + 8 * q);
            pt = __builtin_amdgcn_mfma_f32_16x16x32_bf16(a, bq, pt, 0, 0, 0); }
        bf16x8 pB;
#pragma unroll
        for (int r = 0; r < 4; ++r) { pB[r] = (short)f2bf((4 * q + r) <= n ? pt[r] : 0.f); pB[4 + r] = 0; }
        f32x4 o = (f32x4){0.f, 0.f, 0.f, 0.f};
#pragma unroll
        for (int st = 0; st < 4; ++st) { bf16x8 a, bq;
            const v2u s0 = (v2u){cvt_pk_bf16(S[2 * st][0], S[2 * st][1]), cvt_pk_bf16(S[2 * st][2], S[2 * st][3])}, s1 = (v2u){cvt_pk_bf16(S[2 * st + 1][0], S[2 * st + 1][1]), cvt_pk_bf16(S[2 * st + 1][2], S[2 * st + 1][3])};
            a = __builtin_bit_cast(bf16x8, (v4u){s0.x, s0.y, s1.x, s1.y});
            const v2u q0 = *(const LAS v2u*)(Qs + n * 136 + 32 * st + 4 * q), q1 = *(const LAS v2u*)(Qs + n * 136 + 32 * st + 16 + 4 * q);
            bq = __builtin_bit_cast(bf16x8, (v4u){q0.x, q0.y, q1.x, q1.y});
            o = __builtin_amdgcn_mfma_f32_16x16x32_bf16(a, bq, o, 0, 0, 0); }
        { const v2u va = *(const LAS v2u*)(Vt + (16 * w + n) * 24 + 4 * q); const bf16x8 a = __builtin_bit_cast(bf16x8, (v4u){va.x, va.y, 0u, 0u});
          o = __builtin_amdgcn_mfma_f32_16x16x32_bf16(a, pB, o, 0, 0, 0); }
        { bf16x8 bv; if (q < 2) bv = *(const LAS bf16x8*)(Vt + (16 * w + n) * 24 + 8 * q); else bv = (bf16x8){0, 0, 0, 0, 0, 0, 0, 0};
#pragma unroll
          for (int dt = 0; dt < 8; ++dt) { const f32x4 gv = *(const LAS f32x4*)(G + 16 * dt + 4 * q); S[dt] = S[dt] * gv;
              bf16x8 a; if (q < 2) a = *(const LAS bf16x8*)(Kt + (16 * dt + n) * 24 + 8 * q); else a = (bf16x8){0, 0, 0, 0, 0, 0, 0, 0};
              S[dt] = __builtin_amdgcn_mfma_f32_16x16x32_bf16(a, bv, S[dt], 0, 0, 0); } }
        float ss = (o[0] * o[0] + o[1] * o[1]) + (o[2] * o[2] + o[3] * o[3]); ss += __shfl_xor(ss, 16); ss += __shfl_xor(ss, 32);
        if (q == 0) SSP[w * 16 + n] = ss;
        __syncthreads();
        float tots = 0.f;
#pragma unroll
        for (int k = 0; k < 8; ++k) tots += SSP[k * 16 + n];
        const float rstd = 1.0f / sqrtf(tots * (1.0f / 128.0f) + EPS);
        const f32x4 ng = *(const f32x4*)(F.in[IN_HNG] + e0);
        const float g0 = bf2f((bf16_t)(gt.x & 0xffff)), g1 = bf2f((bf16_t)(gt.x >> 16)), g2 = bf2f((bf16_t)(gt.y & 0xffff)), g3 = bf2f((bf16_t)(gt.y >> 16));
        v2u ov; ov.x = cvt_pk_bf16(o[0] * rstd * ng[0] * fsilu(g0), o[1] * rstd * ng[1] * fsilu(g1)); ov.y = cvt_pk_bf16(o[2] * rstd * ng[2] * fsilu(g2), o[3] * rstd * ng[3] * fsilu(g3));
        *(v2u*)(mix + (t0 + n) * D + e0) = ov;
    }
    __syncthreads();
}

constexpr int LG_P = 65;
__device__ __forceinline__ void p5_router(Frame& F) {
    unsigned char* ws = F.ws; const float* x2 = (const float*)(ws + WS_X2); const float* mod = (const float*)(ws + WS_MOD); const float* g2 = F.in[IN_N2G];
    const bf16_t* rwh = (const bf16_t*)(ws + WS_RW); const bf16_t* rwl = rwh + 64 * 1024; bf16_t* H2 = (bf16_t*)(ws + WS_H2);
    int* TOPI = (int*)(ws + WS_TOPI); float* TOPW = (float*)(ws + WS_TOPW); int* ROWL = (int*)(ws + WS_ROWL); int* ERANK = (int*)(ws + WS_ERANK); unsigned* ECNT = F.ctl + CW_ECNT;
    LAS float* LG = (LAS float*)F.lds;
    LAS float* GS = LG + 64 * LG_P;
    LAS float* WSL = GS + 512;
    LAS int* EI = (LAS int*)(WSL + 512);
    LAS unsigned* LCNT = (LAS unsigned*)(EI + 512);
    LAS unsigned* LBASE = LCNT + 64;
    LAS float* GSL = (LAS float*)(LBASE + 64);
    LAS float* SHL = GSL + 1024;
    const int r = F.lane & 15, q = F.lane >> 4, rt = F.wave & 3, eh = F.wave >> 2;
    for (int unit = F.vcu; unit < T / 64; unit += F.G) {
        const int row0 = unit * 64, b = row0 / SEQ, row = row0 + 16 * rt + r;
        __syncthreads();
        if (F.tid < 64) LCNT[F.tid] = 0u;
        for (int k = F.tid; k < 1024; k += NTHR) { GSL[k] = g2[k] * (1.0f + mod[(size_t)b * 6144 + 4 * 1024 + k]); SHL[k] = mod[(size_t)b * 6144 + 3 * 1024 + k]; }
        const float* xr = x2 + (size_t)row * D + 8 * q;
        float ss = 0.f;
#pragma unroll 8
        for (int s = 0; s < 32; ++s) { const f32x4 a = *(const f32x4*)(xr + 32 * s), c = *(const f32x4*)(xr + 32 * s + 4); ss += (a.x * a.x + a.y * a.y) + (a.z * a.z + a.w * a.w) + (c.x * c.x + c.y * c.y) + (c.z * c.z + c.w * c.w); }
        ss += __shfl_xor(ss, 16); ss += __shfl_xor(ss, 32);
        const float rstd = 1.0f / sqrtf(ss * (1.0f / D) + EPS);
        __syncthreads();
#ifndef PROBE_R7
#define PROBE_R7 0
#endif
        f32x4 acc[2];
        for (int rep7_ = 0; rep7_ <= PROBE_R7; ++rep7_) {
        acc[0] = (f32x4){0.f, 0.f, 0.f, 0.f}; acc[1] = acc[0];
        const bf16_t* rwh0 = rwh + ((size_t)(2 * eh) * 64 + F.lane) * 8; const bf16_t* rwl0 = rwl + ((size_t)(2 * eh) * 64 + F.lane) * 8;
#pragma unroll 1
        for (int s4 = 0; s4 < 32; s4 += 4) {
            f32x4 xa[4][2]; bf16x8 bh[4][2], bl[4][2];
#pragma unroll
            for (int u = 0; u < 4; ++u) { const int s = s4 + u; xa[u][0] = *(const f32x4*)(xr + 32 * s); xa[u][1] = *(const f32x4*)(xr + 32 * s + 4);
                bh[u][0] = *(const bf16x8*)(rwh0 + (size_t)s * 2048); bl[u][0] = *(const bf16x8*)(rwl0 + (size_t)s * 2048); bh[u][1] = *(const bf16x8*)(rwh0 + (size_t)s * 2048 + 512); bl[u][1] = *(const bf16x8*)(rwl0 + (size_t)s * 2048 + 512); }
#pragma unroll
            for (int u = 0; u < 4; ++u) { const int s = s4 + u; float gv[8], sh[8];
                *(f32x4*)&gv[0] = *(const LAS f32x4*)(GSL + 32 * s + 8 * q); *(f32x4*)&gv[4] = *(const LAS f32x4*)(GSL + 32 * s + 8 * q + 4);
                *(f32x4*)&sh[0] = *(const LAS f32x4*)(SHL + 32 * s + 8 * q); *(f32x4*)&sh[4] = *(const LAS f32x4*)(SHL + 32 * s + 8 * q + 4);
                bf16x8 ahi, alo;
#pragma unroll
                for (int j = 0; j < 8; ++j) { const float h = xa[u][j >> 2][j & 3] * rstd * gv[j] + sh[j]; const bf16_t hb = f2bf(h); ahi[j] = (short)hb; alo[j] = (short)f2bf(h - bf2f(hb)); }
                if (eh == 0) *(bf16x8*)(H2 + (size_t)row * D + 32 * s + 8 * q) = ahi;
                acc[0] = __builtin_amdgcn_mfma_f32_16x16x32_bf16(ahi, bh[u][0], acc[0], 0, 0, 0); acc[0] = __builtin_amdgcn_mfma_f32_16x16x32_bf16(ahi, bl[u][0], acc[0], 0, 0, 0); acc[0] = __builtin_amdgcn_mfma_f32_16x16x32_bf16(alo, bh[u][0], acc[0], 0, 0, 0);
                acc[1] = __builtin_amdgcn_mfma_f32_16x16x32_bf16(ahi, bh[u][1], acc[1], 0, 0, 0); acc[1] = __builtin_amdgcn_mfma_f32_16x16x32_bf16(ahi, bl[u][1], acc[1], 0, 0, 0); acc[1] = __builtin_amdgcn_mfma_f32_16x16x32_bf16(alo, bh[u][1], acc[1], 0, 0, 0); }
        }
        }
#pragma unroll
        for (int nt = 0; nt < 2; ++nt)
#pragma unroll
            for (int i = 0; i < 4; ++i) LG[(16 * rt + 4 * q + i) * LG_P + 32 * eh + 16 * nt + r] = acc[nt][i];
        __syncthreads();
        const int t = F.tid >> 3, g = F.tid & 7; const float* rb = F.in[IN_RB];
        float sc8[8], ch8[8]; float a1 = -3e38f, a2 = -3e38f;
#pragma unroll
        for (int j = 0; j < 8; ++j) { const float s_ = 1.0f / (1.0f + expf(-LG[t * LG_P + 8 * g + j])); sc8[j] = s_; const float c_ = s_ + rb[8 * g + j]; ch8[j] = c_; if (c_ > a1) { a2 = a1; a1 = c_; } else if (c_ > a2) a2 = c_; }
        GS[t * 8 + g] = a1 + a2;
        __syncthreads();
#pragma unroll
        for (int j = 0; j < 8; ++j) LG[t * LG_P + 8 * g + j] = ch8[j];
        int grank = 0; const float myg = GS[t * 8 + g];
#pragma unroll
        for (int k = 0; k < 8; ++k) { const float o = GS[t * 8 + k]; if (o > myg || (o == myg && k < g)) ++grank; }
        const bool gsel = grank < 4;
        const unsigned long long bal = __ballot(gsel); const unsigned gmask = (unsigned)(bal >> (F.lane & ~7)) & 0xffu;
        __syncthreads();
        if (gsel) {
            int rk[8];
#pragma unroll
            for (int j = 0; j < 8; ++j) rk[j] = 0;
            for (int k = 0; k < 8; ++k) { if (!((gmask >> k) & 1u)) continue;
#pragma unroll
                for (int jj = 0; jj < 8; ++jj) { const float o = LG[t * LG_P + 8 * k + jj]; const int oe = 8 * k + jj;
#pragma unroll
                    for (int j = 0; j < 8; ++j) { if (o > ch8[j] || (o == ch8[j] && oe < 8 * g + j)) ++rk[j]; } } }
#pragma unroll
            for (int j = 0; j < 8; ++j) if (rk[j] < 8) { WSL[t * 8 + rk[j]] = sc8[j]; EI[t * 8 + rk[j]] = 8 * g + j; }
        }
        __syncthreads();
        float wsum = 0.f;
#pragma unroll
        for (int k = 0; k < 8; ++k) wsum += WSL[t * 8 + k];
        const int e = EI[t * 8 + g]; const float w = WSL[t * 8 + g] / wsum * 2.5f;
        const int aid = (row0 + t) * 8 + g;
        TOPI[aid] = e; TOPW[aid] = w;
        const unsigned lp = atomicAdd((unsigned*)&LCNT[e], 1u);
        __syncthreads();
        if (F.tid < 64) { const unsigned c = LCNT[F.tid]; LBASE[F.tid] = c ? atomicAdd(&ECNT[F.tid], c) : 0u; }
        __syncthreads();
        { const unsigned rk = LBASE[e] + lp; ROWL[(size_t)e * T + rk] = aid; ERANK[aid] = (int)rk; }
    }
    __syncthreads();
}


struct MoeTabs { LAS unsigned* cnt; LAS unsigned* tstart; LAS unsigned short* tex; int ntr; };
__device__ __forceinline__ MoeTabs moe_tabs_build(Frame& F) {
    MoeTabs Tb; Tb.cnt = (LAS unsigned*)(F.lds + LDSCTL_OFF + 512); Tb.tstart = Tb.cnt + 64; Tb.tex = (LAS unsigned short*)(Tb.tstart + 68);
    __syncthreads();
    if (F.tid < 64) { unsigned c = __hip_atomic_load(F.ctl + CW_ECNT + F.tid, RLX_AGENT); Tb.cnt[F.tid] = c > (unsigned)T ? (unsigned)T : c; }
    __syncthreads();
    if (F.tid == 0) { unsigned a = 0; for (int e = 0; e < 64; ++e) { Tb.tstart[e] = a; a += (Tb.cnt[e] + 255u) >> 8; } Tb.tstart[64] = a; }
    __syncthreads();
    Tb.ntr = (int)Tb.tstart[64];
    for (int tau = F.tid; tau < Tb.ntr; tau += NTHR) { int e = 0; for (int k = 0; k < 64; ++k) if (Tb.tstart[k] <= (unsigned)tau) e = k; Tb.tex[tau] = (unsigned short)e; }
    __syncthreads();
    return Tb;
}
__device__ __forceinline__ int xcd_chunk(int L, int n) { const int q = n / 8, r = n % 8, xcd = L % 8, off = L / 8; return (xcd < r ? xcd * (q + 1) : r * (q + 1) + (xcd - r) * q) + off; }
struct GateUpSched {
    MoeTabs Tb; const char* H2; const char* Wgu; const char* Wsgu; const int* rowl; int G, c;
    __device__ __forceinline__ bool next(int i, gm::Unit& u) const {
        const int nun = 2 * Tb.ntr + 2 * (T / 256); const long L = (long)i * G + c; if (L >= nun) return false;
        const int w = xcd_chunk((int)L, nun); u.A = H2;
        if (w < 2 * Tb.ntr) { const int tau = w >> 1; u.pn = w & 1; u.e = Tb.tex[tau]; u.m0 = 256 * (tau - (int)Tb.tstart[u.e]); u.pm = tau; u.B = Wgu + (size_t)u.e * 512 * 2048 + (size_t)u.pn * 256 * 2048; }
        else { const int s = w - 2 * Tb.ntr; u.pm = s >> 1; u.pn = s & 1; u.e = 64; u.m0 = 256 * u.pm; u.B = Wsgu + (size_t)u.pn * 256 * 2048; }
        return true;
    }
    __device__ __forceinline__ unsigned arow(const gm::Unit& u, int r) const {
        if (u.e == 64) return (unsigned)(u.m0 + r) * 2048u;
        const int idx = u.m0 + r; const int aid = idx < (int)Tb.cnt[u.e] ? rowl[(size_t)u.e * T + idx] : 0;
        return (unsigned)(aid >> 3) * 2048u;
    }
};
struct EpiSwiglu {
    static constexpr bool PERM = true;
    bf16_t* act; bf16_t* acts;
    __device__ __forceinline__ void operator()(const f32x4 (&acc)[2][2][4][2], const gm::Unit& u, int wr, int wc, int fr, int fq) const {
        bf16_t* O = (u.e == 64 ? acts : act) + (size_t)(u.pm * 256 + wr * 64 + fr) * 256 + 128 * u.pn + wc * 32 + 8 * fq;
#pragma unroll
        for (int ai = 0; ai < 2; ++ai)
#pragma unroll
            for (int m = 0; m < 4; ++m) { const f32x4 g0 = acc[ai][0][m][0], g1 = acc[ai][0][m][1], u0 = acc[ai][1][m][0], u1 = acc[ai][1][m][1];
                v4u w; w.x = cvt_pk_bf16(fsilu(g0[0]) * u0[0], fsilu(g0[1]) * u0[1]); w.y = cvt_pk_bf16(fsilu(g0[2]) * u0[2], fsilu(g0[3]) * u0[3]);
                w.z = cvt_pk_bf16(fsilu(g1[0]) * u1[0], fsilu(g1[1]) * u1[1]); w.w = cvt_pk_bf16(fsilu(g1[2]) * u1[2], fsilu(g1[3]) * u1[3]);
                *(v4u*)(O + (size_t)(ai * 128 + m * 16) * 256) = w; }
    }
};
struct DownSched {
    MoeTabs Tb; const char* act; const char* acts; const char* Wdn; const char* Wsdn; int G, c;
    __device__ __forceinline__ bool next(int i, gm::Unit& u) const {
        const int nun = 4 * Tb.ntr + 4 * (T / 256); const long L = (long)i * G + c; if (L >= nun) return false;
        const int w = xcd_chunk((int)L, nun);
        if (w < 4 * Tb.ntr) { const int tau = w >> 2; u.pn = w & 3; u.e = Tb.tex[tau]; u.m0 = 256 * (tau - (int)Tb.tstart[u.e]); u.pm = tau;
            u.A = act + (size_t)tau * 256 * 512; u.B = Wdn + (size_t)u.e * 1024 * 512 + (size_t)u.pn * 256 * 512; }
        else { const int s = w - 4 * Tb.ntr; u.pm = s >> 2; u.pn = s & 3; u.e = 64; u.m0 = 256 * u.pm; u.A = acts + (size_t)u.pm * 256 * 512; u.B = Wsdn + (size_t)u.pn * 256 * 512; }
        return true;
    }
    __device__ __forceinline__ unsigned arow(const gm::Unit&, int r) const { return (unsigned)r * 512u; }
};
typedef float f32x2_t __attribute__((ext_vector_type(2)));
__device__ __forceinline__ unsigned pk4_fp8(float a, float b, float c, float d) {
    a = fminf(fmaxf(a * 16.0f, -448.0f), 448.0f); b = fminf(fmaxf(b * 16.0f, -448.0f), 448.0f); c = fminf(fmaxf(c * 16.0f, -448.0f), 448.0f); d = fminf(fmaxf(d * 16.0f, -448.0f), 448.0f);
    int w = __builtin_amdgcn_cvt_pk_fp8_f32(a, b, 0, false); w = __builtin_amdgcn_cvt_pk_fp8_f32(c, d, w, true); return (unsigned)w;
}
struct EpiDown {
    static constexpr bool PERM = true;
    unsigned char* Y8; bf16_t* YS;
    __device__ __forceinline__ void operator()(const f32x4 (&acc)[2][2][4][2], const gm::Unit& u, int wr, int wc, int fr, int fq) const {
        const size_t off = (size_t)(u.pm * 256 + wr * 64 + fr) * 1024 + u.pn * 256 + wc * 32 + 8 * fq;
        if (u.e == 64) {
#pragma unroll
            for (int ai = 0; ai < 2; ++ai)
#pragma unroll
                for (int m = 0; m < 4; ++m)
#pragma unroll
                    for (int bj = 0; bj < 2; ++bj) { const f32x4 v0 = acc[ai][bj][m][0], v1 = acc[ai][bj][m][1];
                        v4u w; w.x = cvt_pk_bf16(v0[0], v0[1]); w.y = cvt_pk_bf16(v0[2], v0[3]); w.z = cvt_pk_bf16(v1[0], v1[1]); w.w = cvt_pk_bf16(v1[2], v1[3]);
                        *(v4u*)(YS + off + (size_t)(ai * 128 + m * 16) * 1024 + bj * 128) = w; }
        } else {
#pragma unroll
            for (int ai = 0; ai < 2; ++ai)
#pragma unroll
                for (int m = 0; m < 4; ++m)
#pragma unroll
                    for (int bj = 0; bj < 2; ++bj) { const f32x4 v0 = acc[ai][bj][m][0], v1 = acc[ai][bj][m][1];
                        *(v2u*)(Y8 + off + (size_t)(ai * 128 + m * 16) * 1024 + bj * 128) = (v2u){pk4_fp8(v0[0], v0[1], v0[2], v0[3]), pk4_fp8(v1[0], v1[1], v1[2], v1[3])}; }
        }
    }
};

__device__ __forceinline__ void p8_final(Frame& F) {
    unsigned char* ws = F.ws; const unsigned char* Y = (const unsigned char*)(ws + WS_Y); const bf16_t* YS = (const bf16_t*)(ws + WS_YS);
    const float* x2 = (const float*)(ws + WS_X2); const float* mod = (const float*)(ws + WS_MOD); const float* fg = F.in[IN_FG];
    const int* TOPI = (const int*)(ws + WS_TOPI); const float* TOPW = (const float*)(ws + WS_TOPW); const int* ERANK = (const int*)(ws + WS_ERANK);
    const MoeTabs Tb = moe_tabs_build(F);
    const int w = F.wave;
    for (int unit = F.vcu; unit < T / 64; unit += F.G) {
        const int row0 = unit * 64 + 8 * w, b = row0 / SEQ;
        const int aid = row0 * 8 + F.lane; const int e = TOPI[aid]; const float wl = TOPW[aid]; const unsigned prl = 256u * Tb.tstart[e] + (unsigned)ERANK[aid];
        v2u ybA[8]; v4u ysA; v2u ybB[8]; v4u ysB;
#define P10_LOAD(yb, ysb, rr_, sg_) do { const int t_ = row0 + (rr_); _Pragma("unroll") for (int sl = 0; sl < 8; ++sl) { const unsigned pr_ = (unsigned)__shfl((int)prl, (rr_) * 8 + sl); \
            yb[sl] = *(const v2u*)(Y + (size_t)pr_ * 1024 + (sg_) * 512 + 8 * F.lane); } \
            ysb = *(const v4u*)(YS + (size_t)t_ * 1024 + (sg_) * 512 + 8 * F.lane); } while (0)
#define P10_HALF(yb, ysb, rr_, sg_) do { const int t = row0 + (rr_); float moe[8]; \
            { const unsigned vw[4] = {ysb.x, ysb.y, ysb.z, ysb.w}; \
                _Pragma("unroll") for (int k = 0; k < 4; ++k) { moe[2 * k] = bf2f((bf16_t)(vw[k] & 0xffff)); moe[2 * k + 1] = bf2f((bf16_t)(vw[k] >> 16)); } } \
            _Pragma("unroll") for (int sl = 0; sl < 8; ++sl) { const float wgt = __shfl(wl, (rr_) * 8 + sl) * 0.0625f; \
                const f32x2_t d0 = __builtin_amdgcn_cvt_pk_f32_fp8((int)yb[sl].x, false), d1 = __builtin_amdgcn_cvt_pk_f32_fp8((int)yb[sl].x, true), d2 = __builtin_amdgcn_cvt_pk_f32_fp8((int)yb[sl].y, false), d3 = __builtin_amdgcn_cvt_pk_f32_fp8((int)yb[sl].y, true); \
                moe[0] += wgt * d0[0]; moe[1] += wgt * d0[1]; moe[2] += wgt * d1[0]; moe[3] += wgt * d1[1]; moe[4] += wgt * d2[0]; moe[5] += wgt * d2[1]; moe[6] += wgt * d3[0]; moe[7] += wgt * d3[1]; } \
            _Pragma("unroll") for (int h = 0; h < 2; ++h) { const int c0 = (sg_) * 512 + 8 * F.lane + 4 * h; \
                const f32x4 xv = *(const f32x4*)(x2 + (size_t)t * D + c0), gv = *(const f32x4*)(mod + (size_t)b * 6144 + 5 * 1024 + c0); \
                _Pragma("unroll") for (int j = 0; j < 4; ++j) { const float v = xv[j] + gv[j] * moe[4 * h + j]; x3[(sg_) * 8 + 4 * h + j] = v; ss += v * v; } } } while (0)
        P10_LOAD(ybA, ysA, 0, 0);
#pragma unroll 1
        for (int rr = 0; rr < 8; ++rr) {
            float x3[16]; float ss = 0.f;
            P10_LOAD(ybB, ysB, rr, 1);
            P10_HALF(ybA, ysA, rr, 0);
            if (rr < 7) P10_LOAD(ybA, ysA, rr + 1, 0);
            P10_HALF(ybB, ysB, rr, 1);
            const int t = row0 + rr;
            const float rstd = 1.0f / sqrtf(wave_sum(ss) * (1.0f / D) + EPS);
#pragma unroll
            for (int sg = 0; sg < 2; ++sg)
#pragma unroll
                for (int h = 0; h < 2; ++h) { const int c0 = sg * 512 + 8 * F.lane + 4 * h; const f32x4 gg = *(const f32x4*)(fg + c0); f32x4 o;
#pragma unroll
                    for (int j = 0; j < 4; ++j) o[j] = x3[sg * 8 + 4 * h + j] * rstd * gg[j];
                    *(f32x4*)(F.out + (size_t)t * D + c0) = o; }
        }
#undef P10_HALF
#undef P10_LOAD
    }
    __syncthreads();
}

__device__ __forceinline__ float fgelu_tanh(float z) { const float u = 0.7978845608028654f * (z + 0.044715f * z * z * z); const float e = __expf(2.0f * u); return 0.5f * z * (1.0f + (e - 1.0f) / (e + 1.0f)); }
__device__ __forceinline__ float fgelu_safe(float z) { const float u = 0.7978845608028654f * (z + 0.044715f * z * z * z); const float uc = fminf(fmaxf(u, -15.f), 15.f); const float e = fexp(2.0f * uc); return 0.5f * z * (1.0f + (e - 1.0f) / (e + 1.0f)); }

__device__ __forceinline__ void cmp_unit(Frame& F, int unit) {
    unsigned char* ws = F.ws; const bf16_t* proj = (const bf16_t*)(ws + WS_PROJ);
    const int kv = unit >> 6, mb = unit & 63; const bf16_t* W1T = (const bf16_t*)(ws + (kv ? WS_W1VT : WS_W1KT)); const int coloff = kv ? C_VC : C_KC;
    const float* b1f = (const float*)(ws + WS_B1F) + kv * 256;
    const int w = F.wave, n = F.lane & 15, q = F.lane >> 4;
    LAS bf16_t* HID = (LAS bf16_t*)F.lds;
    size_t base[2];
#pragma unroll
    for (int rt = 0; rt < 2; ++rt) { const int R = 32 * mb + 16 * rt + n, bg = R >> 8; int c = R & 255; if (c > 254) c = 254; base[rt] = ((size_t)(bg >> 1) * SEQ + 16 * c) * LDP + coloff + (bg & 1) * 64; }
    f32x4 acc[2][2];
#pragma unroll
    for (int rt = 0; rt < 2; ++rt)
#pragma unroll
        for (int ct = 0; ct < 2; ++ct) acc[rt][ct] = (f32x4){0.f, 0.f, 0.f, 0.f};
    __syncthreads();
#pragma unroll 8
    for (int s = 0; s < 64; ++s) { const int ltok = s >> 1, dd = 32 * (s & 1) + 8 * q; bf16x8 a[2], bb[2];
#pragma unroll
        for (int rt = 0; rt < 2; ++rt) a[rt] = *(const bf16x8*)(proj + base[rt] + (size_t)ltok * LDP + dd);
#pragma unroll
        for (int ct = 0; ct < 2; ++ct) bb[ct] = *(const bf16x8*)(W1T + ((size_t)(s * 16 + 2 * w + ct) * 64 + F.lane) * 8);
#pragma unroll
        for (int rt = 0; rt < 2; ++rt)
#pragma unroll
            for (int ct = 0; ct < 2; ++ct) acc[rt][ct] = __builtin_amdgcn_mfma_f32_16x16x32_bf16(bb[ct], a[rt], acc[rt][ct], 0, 0, 0); }
#pragma unroll
    for (int rt = 0; rt < 2; ++rt)
#pragma unroll
        for (int ct = 0; ct < 2; ++ct) { const int col = 32 * w + 16 * ct + 4 * q; const f32x4 bv = *(const f32x4*)(b1f + col); const f32x4 v = acc[rt][ct] + bv;
            v2u o; o.x = cvt_pk_bf16(fgelu_safe(v[0]), fgelu_safe(v[1])); o.y = cvt_pk_bf16(fgelu_safe(v[2]), fgelu_safe(v[3]));
            *(LAS v2u*)(HID + (16 * rt + n) * 264 + col) = o; }
    __syncthreads();
    { const int rt = w & 1, ct = w >> 1; f32x4 o = (f32x4){0.f, 0.f, 0.f, 0.f};
      const bf16_t* w2f = (const bf16_t*)(ws + WS_W2T) + (size_t)kv * 16384;
#pragma unroll
      for (int s = 0; s < 8; ++s) { const bf16x8 a = *(const LAS bf16x8*)(HID + (16 * rt + n) * 264 + 32 * s + 8 * q); const bf16x8 bw = *(const bf16x8*)(w2f + ((size_t)(s * 4 + ct) * 64 + F.lane) * 8);
          o = __builtin_amdgcn_mfma_f32_16x16x32_bf16(bw, a, o, 0, 0, 0); }
      const int R = 32 * mb + 16 * rt + n, bg = R >> 8, c = R & 255, d0 = 16 * ct + 4 * q;
      if (c == 255) o = (f32x4){0.f, 0.f, 0.f, 0.f};
      if (kv == 0) { v2u ov; ov.x = cvt_pk_bf16(o[0], o[1]); ov.y = cvt_pk_bf16(o[2], o[3]); *(v2u*)((bf16_t*)(ws + WS_KCMP) + ((size_t)bg * 256 + c) * 64 + d0) = ov; }
      else { bf16_t* vt = (bf16_t*)(ws + WS_VCMPT) + (size_t)bg * 64 * 256 + c;
#pragma unroll
          for (int r = 0; r < 4; ++r) vt[(size_t)(d0 + r) * 256] = f2bf(o[r]); } }
    __syncthreads();
}

__device__ __forceinline__ void kv_prep_unit(Frame& F, int unit) {
    unsigned char* ws = F.ws; const bf16_t* proj = (const bf16_t*)(ws + WS_PROJ); const float* cs = (const float*)(ws + WS_CS); const float* sn = (const float*)(ws + WS_SN);
    const int b = unit >> 6, tile = unit & 63; const size_t tok0 = (size_t)b * SEQ + 64 * tile;
#pragma unroll
    for (int it = 0; it < 2; ++it) { const int id = F.tid + 512 * it; const int c = id & 3, g = (id >> 2) & 1, wh = (id >> 3) & 1, tk = id >> 4; const int pos = 64 * tile + tk;
        const bf16_t* src = proj + (tok0 + tk) * LDP + (wh ? C_KW : C_KS) + g * 64 + 8 * c; const v4u lo = *(const v4u*)src, hi = *(const v4u*)(src + 32);
        const f32x4 c0 = *(const f32x4*)(cs + pos * 32 + 8 * c), c1 = *(const f32x4*)(cs + pos * 32 + 8 * c + 4), s0 = *(const f32x4*)(sn + pos * 32 + 8 * c), s1 = *(const f32x4*)(sn + pos * 32 + 8 * c + 4);
        float a[8], bb[8], co[8], si[8];
        const unsigned lw[4] = {lo.x, lo.y, lo.z, lo.w}, hw[4] = {hi.x, hi.y, hi.z, hi.w};
#pragma unroll
        for (int k = 0; k < 4; ++k) { a[2 * k] = bf2f((bf16_t)(lw[k] & 0xffff)); a[2 * k + 1] = bf2f((bf16_t)(lw[k] >> 16)); bb[2 * k] = bf2f((bf16_t)(hw[k] & 0xffff)); bb[2 * k + 1] = bf2f((bf16_t)(hw[k] >> 16)); co[k] = c0[k]; co[4 + k] = c1[k]; si[k] = s0[k]; si[4 + k] = s1[k]; }
        unsigned olp[4], ohp[4];
#pragma unroll
        for (int k = 0; k < 4; ++k) { olp[k] = pk2(a[2 * k] * co[2 * k] - bb[2 * k] * si[2 * k], a[2 * k + 1] * co[2 * k + 1] - bb[2 * k + 1] * si[2 * k + 1]);
            ohp[k] = pk2(bb[2 * k] * co[2 * k] + a[2 * k] * si[2 * k], bb[2 * k + 1] * co[2 * k + 1] + a[2 * k + 1] * si[2 * k + 1]); }
        bf16_t* dst = (bf16_t*)(ws + (wh ? WS_KWR : WS_KSR)) + (((size_t)(b * 2 + g) * SEQ) + pos) * 64 + 8 * c; *(v4u*)dst = (v4u){olp[0], olp[1], olp[2], olp[3]}; *(v4u*)(dst + 32) = (v4u){ohp[0], ohp[1], ohp[2], ohp[3]}; }
    LAS bf16_t* TL = (LAS bf16_t*)F.lds;
    v4u vin[4];
#pragma unroll
    for (int m = 0; m < 4; ++m) { const int wh = m >> 1, g = m & 1, tk = F.tid >> 3, c = F.tid & 7; vin[m] = *(const v4u*)(proj + (tok0 + tk) * LDP + (wh ? C_VW : C_VS) + g * 64 + 8 * c); }
#pragma unroll
    for (int m = 0; m < 4; ++m) { const int wh = m >> 1, g = m & 1;
        __syncthreads();
        { const int tk = F.tid >> 3, c = F.tid & 7; *(LAS v4u*)(TL + tk * 72 + 8 * c) = vin[m]; }
        __syncthreads();
        { const int d = F.tid >> 3, sc = F.tid & 7; unsigned short e[8];
#pragma unroll
          for (int i = 0; i < 8; ++i) e[i] = TL[(8 * sc + i) * 72 + d];
          v4u o; o.x = e[0] | ((unsigned)e[1] << 16); o.y = e[2] | ((unsigned)e[3] << 16); o.z = e[4] | ((unsigned)e[5] << 16); o.w = e[6] | ((unsigned)e[7] << 16);
          *(v4u*)((bf16_t*)(ws + (wh ? WS_VWT : WS_VST)) + ((size_t)(b * 2 + g) * 64 + d) * SEQ + 64 * tile + 8 * sc) = o; } }
    __syncthreads();
}

constexpr int ATT_VB = 32768, ATT_PSL = 65536, ATT_OUTA = 65536, ATT_SELM = LDSCTL_OFF + 512, ATT_UNI = ATT_SELM + 512, ATT_TL = ATT_UNI + 16, ATT_NT = ATT_TL + 80;
constexpr float ATT_QS = 0.125f * 1.4426950408889634f;
#ifndef ATT_MASKOFF
#define ATT_MASKOFF 200.0f
#endif
__device__ __forceinline__ int att_swz(int row, int c) { return row * 128 + ((c ^ ((row >> 1) & 7)) << 4); }
struct TileSrc { const bf16_t* K; int kpitch; const bf16_t* V; int vpitch; };
__device__ __forceinline__ void att_load(const TileSrc& s, int tid, v4u& kr, v4u& vr) { const int row = tid >> 3, c = tid & 7; kr = *(const v4u*)(s.K + (size_t)row * s.kpitch + 8 * c); vr = *(const v4u*)(s.V + (size_t)row * s.vpitch + 8 * c); }
__device__ __forceinline__ void att_store(LAS unsigned char* lds, int buf, int tid, const v4u& kr, const v4u& vr) {
    const int row = tid >> 3, c = tid & 7;
    *(LAS v4u*)(lds + buf * 8192 + att_swz(row, c)) = kr;
    const int s16 = c >> 1, half = c & 1;
    *(LAS v2u*)(lds + ATT_VB + buf * 8192 + att_swz(row, 2 * s16) + half * 8) = (v2u){vr.x, vr.y};
    *(LAS v2u*)(lds + ATT_VB + buf * 8192 + att_swz(row, 2 * s16 + 1) + half * 8) = (v2u){vr.z, vr.w};
}
__device__ __forceinline__ void att_qk(const LAS unsigned char* kb, const bf16x8 (&qf)[4], f32x16 (&s)[2], int i, int hh, const f32x16& ini0, const f32x16& ini1) {
    bf16x8 kf[2][4];
#pragma unroll
    for (int kt = 0; kt < 2; ++kt)
#pragma unroll
        for (int st = 0; st < 4; ++st) kf[kt][st] = *(const LAS bf16x8*)(kb + att_swz(32 * kt + i, 2 * st + hh));
    __builtin_amdgcn_s_setprio(1);
#pragma unroll
    for (int st = 0; st < 4; ++st)
#pragma unroll
        for (int kt = 0; kt < 2; ++kt) s[kt] = __builtin_amdgcn_mfma_f32_32x32x16_bf16(kf[kt][st], qf[st], st == 0 ? (kt ? ini1 : ini0) : s[kt], 0, 0, 0);
    __builtin_amdgcn_s_setprio(0);
}
__device__ __forceinline__ void att_vload(const LAS unsigned char* vb, bf16x8 (&vf)[4][2], int i, int hh) {
#pragma unroll
    for (int ks = 0; ks < 4; ++ks)
#pragma unroll
        for (int dt = 0; dt < 2; ++dt) vf[ks][dt] = *(const LAS bf16x8*)(vb + att_swz(32 * dt + i, 2 * ks + hh));
}
__device__ __forceinline__ void att_pv(const bf16x8 (&vf)[4][2], const f32x16 (&p)[2], f32x16 (&o)[2]) {
    __builtin_amdgcn_s_setprio(1);
#pragma unroll
    for (int kt = 0; kt < 2; ++kt)
#pragma unroll
        for (int s = 0; s < 2; ++s) { const v4u pb = (v4u){cvt_pk_bf16(p[kt][8 * s], p[kt][8 * s + 1]), cvt_pk_bf16(p[kt][8 * s + 2], p[kt][8 * s + 3]), cvt_pk_bf16(p[kt][8 * s + 4], p[kt][8 * s + 5]), cvt_pk_bf16(p[kt][8 * s + 6], p[kt][8 * s + 7])};
            const bf16x8 bf = __builtin_bit_cast(bf16x8, pb);
#pragma unroll
            for (int dt = 0; dt < 2; ++dt) o[dt] = __builtin_amdgcn_mfma_f32_32x32x16_bf16(vf[2 * kt + s][dt], bf, o[dt], 0, 0, 0); }
    __builtin_amdgcn_s_setprio(0);
}
__device__ __forceinline__ void att_ini(f32x16 (&ini)[2], bool uniform, float base, int lo, int hi, int hh, float masked = -1e30f) {
    if (uniform) {
#pragma unroll
        for (int r = 0; r < 16; ++r) ini[0][r] = base;
        ini[1] = ini[0];
    } else {
        const unsigned span = (unsigned)(hi - lo);
#pragma unroll
        for (int kt = 0; kt < 2; ++kt)
#pragma unroll
            for (int r = 0; r < 16; ++r) { const int kk = 32 * kt + (r & 3) + 8 * (r >> 2) + 4 * hh; ini[kt][r] = ((unsigned)(kk - lo) <= span && hi >= lo) ? base : masked; }
    }
}
#define ATT_KEY(kt, r, hh) (32 * (kt) + ((r) & 3) + 8 * ((r) >> 2) + 4 * (hh))

__device__ __forceinline__ void att_unit(Frame& F, int unit) {
    unsigned char* ws = F.ws; const bf16_t* proj = (const bf16_t*)(ws + WS_PROJ); bf16_t* mix = (bf16_t*)(ws + WS_MIX);
    const int qb = unit & 63, bg = unit >> 6, b = bg >> 1, g = bg & 1;
    const int w = F.wave, i = F.lane & 31, hh = F.lane >> 5, head = i >> 3, tloc = i & 7, tt = 8 * w + tloc; const int pos = 64 * qb + tt; const size_t tok = (size_t)b * SEQ + pos;
    LAS unsigned char* lds = F.lds; LAS float* PSL = (LAS float*)(lds + ATT_PSL); LAS unsigned* SELM = (LAS unsigned*)(lds + ATT_SELM); LAS unsigned* UNI = (LAS unsigned*)(lds + ATT_UNI);
    LAS unsigned char* TL = lds + ATT_TL; LAS int* NTL = (LAS int*)(lds + ATT_NT);
    const bf16_t* kcmp = (const bf16_t*)(ws + WS_KCMP) + (size_t)bg * 256 * 64; const bf16_t* vcmpt = (const bf16_t*)(ws + WS_VCMPT) + (size_t)bg * 64 * 256;
    const bf16_t* ksr = (const bf16_t*)(ws + WS_KSR) + (size_t)bg * SEQ * 64; const bf16_t* vst = (const bf16_t*)(ws + WS_VST) + (size_t)bg * 64 * SEQ;
    const bf16_t* kwr = (const bf16_t*)(ws + WS_KWR) + (size_t)bg * SEQ * 64; const bf16_t* vwt = (const bf16_t*)(ws + WS_VWT) + (size_t)bg * 64 * SEQ;
    __syncthreads();
    for (int k = F.tid; k < 64 * 64; k += NTHR) PSL[k] = 0.f;
    if (F.tid < 2) UNI[F.tid] = 0u;
    bf16x8 qf[4];
    const bf16_t* qp = proj + tok * LDP + C_NQ + (4 * g + head) * 64 + 8 * hh;
    { float qraw[4][8];
#pragma unroll
      for (int st = 0; st < 4; ++st) { const v4u v = *(const v4u*)(qp + 16 * st); const unsigned vw[4] = {v.x, v.y, v.z, v.w};
#pragma unroll
          for (int k = 0; k < 4; ++k) { qraw[st][2 * k] = bf2f((bf16_t)(vw[k] & 0xffff)); qraw[st][2 * k + 1] = bf2f((bf16_t)(vw[k] >> 16)); } }
#pragma unroll
      for (int st = 0; st < 4; ++st) { const v4u o = (v4u){cvt_pk_bf16(qraw[st][0] * ATT_QS, qraw[st][1] * ATT_QS), cvt_pk_bf16(qraw[st][2] * ATT_QS, qraw[st][3] * ATT_QS), cvt_pk_bf16(qraw[st][4] * ATT_QS, qraw[st][5] * ATT_QS), cvt_pk_bf16(qraw[st][6] * ATT_QS, qraw[st][7] * ATT_QS)};
          qf[st] = __builtin_bit_cast(bf16x8, o); } }
    LAS float* OUTA = (LAS float*)(lds + ATT_OUTA) + (size_t)w * 32 * 64 + F.lane;
    const float* gl = nullptr; (void)gl;
    const float gate0 = fsigmoid(bf2f(proj[tok * LDP + C_NG + (4 * g + head) * 3 + 0])), gate1 = fsigmoid(bf2f(proj[tok * LDP + C_NG + (4 * g + head) * 3 + 1])), gate2 = fsigmoid(bf2f(proj[tok * LDP + C_NG + (4 * g + head) * 3 + 2]));
    v4u kr, vr; f32x16 s[2]; f32x16 ocmp[2];
#ifndef PROBE_ATT
#define PROBE_ATT 0
#endif
    for (int rep1_ = 0; rep1_ < (PROBE_ATT == 1 ? 2 : 1); ++rep1_) {
    const int ncu = (4 * qb + 3) < 255 ? (4 * qb + 3) : 255, ntile = (ncu + 63) >> 6;
    const int ncv = pos >= 31 ? ((pos - 31) >> 4) + 1 : 0;
    const int ncv_min = qb >= 1 ? 4 * qb - 1 : 0;
    float m = -1e30f, l = 0.f;
    {
        int cur = 0; { TileSrc ts{kcmp, 64, vcmpt, 256}; att_load(ts, F.tid, kr, vr); att_store(lds, 0, F.tid, kr, vr); }
        __syncthreads();
        for (int T_ = 0; T_ < ntile; ++T_) {
            const bool more = T_ + 1 < ntile;
            if (more) { TileSrc ts{kcmp + (size_t)(T_ + 1) * 64 * 64, 64, vcmpt + (T_ + 1) * 64, 256}; att_load(ts, F.tid, kr, vr); }
            { f32x16 ini[2]; att_ini(ini, 64 * T_ + 64 <= ncv_min, 0.f, 0, ncv - 1 - 64 * T_, hh, -ATT_MASKOFF); att_qk(lds + cur * 8192, qf, s, i, hh, ini[0], ini[1]); }
            float tm = -1e30f;
#pragma unroll
            for (int kt = 0; kt < 2; ++kt)
#pragma unroll
                for (int r = 0; r < 16; ++r) tm = fmaxf(tm, s[kt][r]);
            tm = fmaxf(tm, __shfl_xor(tm, 32));
            const float mn = fmaxf(m, tm); l *= fexp2(m - mn);
#pragma unroll
            for (int kt = 0; kt < 2; ++kt)
#pragma unroll
                for (int r = 0; r < 16; ++r) l += __builtin_amdgcn_exp2f(s[kt][r] - mn);
            m = mn;
            if (more) att_store(lds, cur ^ 1, F.tid, kr, vr);
            __syncthreads(); cur ^= 1;
        }
        l += __shfl_xor(l, 32);
    }
    {
        const float rl = (ncv > 0 && l > 0.f) ? 1.0f / l : 0.f;
        f32x16 o[2];
#pragma unroll
        for (int k = 0; k < 16; ++k) { o[0][k] = 0.f; o[1][k] = 0.f; }
        float carry = 0.f;
        int cur = 0; { TileSrc ts{kcmp, 64, vcmpt, 256}; att_load(ts, F.tid, kr, vr); att_store(lds, 0, F.tid, kr, vr); }
        __syncthreads();
        for (int T_ = 0; T_ < ntile; ++T_) {
            const bool more = T_ + 1 < ntile;
            if (more) { TileSrc ts{kcmp + (size_t)(T_ + 1) * 64 * 64, 64, vcmpt + (T_ + 1) * 64, 256}; att_load(ts, F.tid, kr, vr); }
            bf16x8 vf[4][2];
            { f32x16 ini[2]; att_ini(ini, 64 * T_ + 64 <= ncv_min, -m, 0, ncv - 1 - 64 * T_, hh, -m - ATT_MASKOFF); att_qk(lds + cur * 8192, qf, s, i, hh, ini[0], ini[1]); }
            att_vload(lds + ATT_VB + cur * 8192, vf, i, hh);
#pragma unroll
            for (int kt = 0; kt < 2; ++kt)
#pragma unroll
                for (int r = 0; r < 16; ++r) s[kt][r] = __builtin_amdgcn_exp2f(s[kt][r]) * rl;
            att_pv(vf, s, o);
            float ps[8];
#pragma unroll
            for (int kt = 0; kt < 2; ++kt)
#pragma unroll
                for (int gi = 0; gi < 4; ++gi) ps[4 * kt + gi] = (s[kt][4 * gi] + s[kt][4 * gi + 1]) + (s[kt][4 * gi + 2] + 0.5f * s[kt][4 * gi + 3]);
            float nc = 0.f;
#pragma unroll
            for (int sl = 0; sl < 8; ++sl) { const float x = 0.5f * s[sl >> 2][4 * (sl & 3) + 3]; const float y = __shfl_xor(x, 32);
                if (hh == 1) ps[sl] += y; else { if (sl < 7) ps[sl + 1] += y; else nc = y; } }
            if (hh == 0) { ps[0] += carry; carry = nc; }
#pragma unroll
            for (int sl = 0; sl < 8; ++sl) { float v = ps[sl]; v += __shfl_xor(v, 8); v += __shfl_xor(v, 16); ps[sl] = v; }
            if (head == 0) {
#pragma unroll
                for (int sl = 0; sl < 8; ++sl) PSL[tt * 64 + 16 * T_ + 2 * sl + hh] = ps[sl]; }
            if (more) att_store(lds, cur ^ 1, F.tid, kr, vr);
            __syncthreads(); cur ^= 1;
        }
#pragma unroll
        for (int dt = 0; dt < 2; ++dt)
#pragma unroll
            for (int k = 0; k < 16; ++k) ocmp[dt][k] = gate0 * o[dt][k];
    }
    __syncthreads();
#pragma unroll 1
    for (int tl = 0; tl < 8; ++tl) {
        const int t = 8 * w + tl, j = F.lane; const bool fj = (j == 0) || (j == qb) || (j == qb - 1);
        const unsigned key = fj ? 0xFFFFFFFFu : (j <= qb ? __float_as_uint(PSL[t * 64 + j]) + 1u : 0u);
        unsigned thr = 0u;
#pragma unroll 1
        for (int bit = 31; bit >= 0; --bit) { const unsigned cand = thr | (1u << bit); if (__popcll(__ballot(key >= cand)) >= NSEL) thr = cand; }
        const unsigned long long gt = __ballot(key > thr), eq = __ballot(key == thr); const int need = NSEL - __popcll(gt);
        const int below = __popcll(eq & ((1ull << j) - 1ull));
        const bool sel = (key > 0u) && ((key > thr) || (key == thr && below < need));
        const unsigned long long msk = __ballot(sel);
        if (F.lane == 0) { const unsigned lo = (unsigned)msk, hi = (unsigned)(msk >> 32); SELM[2 * t] = lo; SELM[2 * t + 1] = hi; atomicOr((unsigned*)&UNI[0], lo); atomicOr((unsigned*)&UNI[1], hi); }
    }
    __syncthreads();
    }
    const unsigned sel0 = SELM[2 * tt], sel1 = SELM[2 * tt + 1];
#pragma unroll
    for (int dt = 0; dt < 2; ++dt)
#pragma unroll
        for (int k = 0; k < 16; ++k) OUTA[(dt * 16 + k) * 64] = ocmp[dt][k];
    { const float* csp = (const float*)(ws + WS_CS) + pos * 32 + 8 * hh; const float* snp = (const float*)(ws + WS_SN) + pos * 32 + 8 * hh;
      float qraw[4][8];
#pragma unroll
      for (int st = 0; st < 4; ++st) { const v4u v = *(const v4u*)(qp + 16 * st); const unsigned vw[4] = {v.x, v.y, v.z, v.w};
#pragma unroll
          for (int k = 0; k < 4; ++k) { qraw[st][2 * k] = bf2f((bf16_t)(vw[k] & 0xffff)); qraw[st][2 * k + 1] = bf2f((bf16_t)(vw[k] >> 16)); } }
#pragma unroll
      for (int st = 0; st < 2; ++st) { float co[8], si[8]; *(f32x4*)&co[0] = *(const f32x4*)(csp + 16 * st); *(f32x4*)&co[4] = *(const f32x4*)(csp + 16 * st + 4); *(f32x4*)&si[0] = *(const f32x4*)(snp + 16 * st); *(f32x4*)&si[4] = *(const f32x4*)(snp + 16 * st + 4);
          float rl_[8], rh_[8];
#pragma unroll
          for (int k = 0; k < 8; ++k) { rl_[k] = (qraw[st][k] * co[k] - qraw[st + 2][k] * si[k]) * ATT_QS; rh_[k] = (qraw[st + 2][k] * co[k] + qraw[st][k] * si[k]) * ATT_QS; }
          qf[st] = __builtin_bit_cast(bf16x8, (v4u){cvt_pk_bf16(rl_[0], rl_[1]), cvt_pk_bf16(rl_[2], rl_[3]), cvt_pk_bf16(rl_[4], rl_[5]), cvt_pk_bf16(rl_[6], rl_[7])});
          qf[st + 2] = __builtin_bit_cast(bf16x8, (v4u){cvt_pk_bf16(rh_[0], rh_[1]), cvt_pk_bf16(rh_[2], rh_[3]), cvt_pk_bf16(rh_[4], rh_[5]), cvt_pk_bf16(rh_[6], rh_[7])}); } }
    for (int rep2_ = 0; rep2_ < (PROBE_ATT == 2 ? 2 : 1); ++rep2_)
#pragma unroll 1
    for (int br = 0; br < 2; ++br) {
        if (F.wave == 0) {
            const int j = F.lane; bool on;
            if (br == 0) { const unsigned u0 = UNI[0], u1 = UNI[1]; on = (j <= qb) && (j < 32 ? ((u0 >> j) & 1u) : ((u1 >> (j - 32)) & 1u)); }
            else on = (j <= qb) && (j >= qb - 8);
            const unsigned long long bm = __ballot(on);
            if (on) TL[__popcll(bm & ((1ull << j) - 1ull))] = (unsigned char)j;
            if (j == 0) NTL[0] = __popcll(bm); }
        __syncthreads();
        const int nl = NTL[0]; const bf16_t* Kg = br ? kwr : ksr; const bf16_t* Vg = br ? vwt : vst;
        float mm = 0.f, ll = 0.f; bool started = false; f32x16 o[2];
#pragma unroll
        for (int k = 0; k < 16; ++k) { o[0][k] = 0.f; o[1][k] = 0.f; }
#define ATT_BODY \
            bool lane_on; int lo_k, hi_k;     \
            if (br == 0) { lane_on = j < 32 ? ((sel0 >> j) & 1u) : ((sel1 >> (j - 32)) & 1u); lo_k = 0; hi_k = (j == qb) ? tt : 63; } \
            else { lane_on = true; lo_k = (j == qb - 8) ? tt + 1 : 0; hi_k = (j == qb) ? tt : 63; if (lo_k > hi_k) lane_on = false; } \
            const bool full = (j != qb) && (br == 0 || j != qb - 8);               \
            if (__any(lane_on)) { \
                bf16x8 vf[4][2]; \
                { f32x16 ini[2]; att_ini(ini, full, lane_on ? -mm : -mm - ATT_MASKOFF, lo_k, lane_on ? hi_k : -1, hh, -mm - ATT_MASKOFF); att_qk(lds + kslot * 8192, qf, s, i, hh, ini[0], ini[1]); } \
                att_vload(lds + ATT_VB + kslot * 8192, vf, i, hh); \
                float tm = -1e30f; \
_Pragma("unroll") \
                for (int kt = 0; kt < 2; ++kt) \
_Pragma("unroll") \
                    for (int r = 0; r < 16; ++r) tm = fmaxf(tm, s[kt][r]); \
                tm = fmaxf(tm, __shfl_xor(tm, 32)); \
                const bool first = !started && (tm > -0.5f * ATT_MASKOFF); started = started || first; \
                const bool upd = first || (tm > 8.0f); \
                if (__any(upd)) { \
                    const float delta = upd ? tm : 0.f, al = fexp2(-delta); mm += delta; ll *= al; \
_Pragma("unroll") \
                    for (int dt = 0; dt < 2; ++dt) \
_Pragma("unroll") \
                        for (int k = 0; k < 16; ++k) o[dt][k] *= al; \
_Pragma("unroll") \
                    for (int kt = 0; kt < 2; ++kt) \
_Pragma("unroll") \
                        for (int r = 0; r < 16; ++r) s[kt][r] -= delta; \
                } \
_Pragma("unroll") \
                for (int kt = 0; kt < 2; ++kt) \
_Pragma("unroll") \
                    for (int r = 0; r < 16; ++r) { const float pv_ = __builtin_amdgcn_exp2f(s[kt][r]); s[kt][r] = pv_; ll += pv_; } \
                att_pv(vf, s, o); \
            }
        v4u kr2, vr2;
        const int np = (nl + 1) >> 1;
#define ATT_LOADPAIR(p_) do { { const int ja = TL[2 * (p_)]; TileSrc ts{Kg + (size_t)ja * 64 * 64, 64, Vg + (size_t)ja * 64, SEQ}; att_load(ts, F.tid, kr, vr); } \
            if (2 * (p_) + 1 < nl) { const int jb = TL[2 * (p_) + 1]; TileSrc ts{Kg + (size_t)jb * 64 * 64, 64, Vg + (size_t)jb * 64, SEQ}; att_load(ts, F.tid, kr2, vr2); } } while (0)
#define ATT_STOREPAIR(p_, c_) do { att_store(lds, 2 * (c_), F.tid, kr, vr); if (2 * (p_) + 1 < nl) att_store(lds, 2 * (c_) + 1, F.tid, kr2, vr2); } while (0)
        ATT_LOADPAIR(0); ATT_STOREPAIR(0, 0);
        if (np > 1) ATT_LOADPAIR(1);
        __syncthreads();
        int cur = 0;
        for (int p = 0; p < np; ++p) {
            if (p + 1 < np) ATT_STOREPAIR(p + 1, cur ^ 1);
            if (p + 2 < np) ATT_LOADPAIR(p + 2);
#pragma unroll 1
            for (int t2 = 0; t2 < 2; ++t2) { const int it = 2 * p + t2; if (it < nl) { const int j = TL[it]; const int kslot = 2 * cur + t2;
                ATT_BODY
            } }
            __syncthreads(); cur ^= 1;
        }
#undef ATT_LOADPAIR
#undef ATT_STOREPAIR
#undef ATT_BODY
        ll += __shfl_xor(ll, 32);
        const float sc_ = rep2_ ? 0.f : (br ? gate2 : gate1) / ll;
#pragma unroll
        for (int dt = 0; dt < 2; ++dt)
#pragma unroll
            for (int k = 0; k < 16; ++k) OUTA[(dt * 16 + k) * 64] += sc_ * o[dt][k];
    }
    { bf16_t* op = mix + tok * D + 512 + (4 * g + head) * 64 + 4 * hh;
#pragma unroll
      for (int dt = 0; dt < 2; ++dt)
#pragma unroll
          for (int gi = 0; gi < 4; ++gi) { const float a0 = OUTA[(dt * 16 + 4 * gi) * 64], a1 = OUTA[(dt * 16 + 4 * gi + 1) * 64], a2 = OUTA[(dt * 16 + 4 * gi + 2) * 64], a3 = OUTA[(dt * 16 + 4 * gi + 3) * 64];
              v2u ov; ov.x = cvt_pk_bf16(a0, a1); ov.y = cvt_pk_bf16(a2, a3); *(v2u*)(op + 32 * dt + 8 * gi) = ov; } }
    __syncthreads();
}

__global__ void __launch_bounds__(NTHR, 2) mk_fwd(Args args) {
    extern __shared__ __attribute__((aligned(16))) unsigned char lds_raw[];
    Frame F;
    F.lds = (LAS unsigned char*)lds_raw; F.MISC = (volatile LAS unsigned*)(F.lds + MISC_OFF);
    F.tid = threadIdx.x; F.lane = F.tid & 63; F.wave = __builtin_amdgcn_readfirstlane(F.tid >> 6);
    F.G = gridDim.x; { const int bx = blockIdx.x; F.vcu = (F.G % 8 == 0) ? (bx % 8) * (F.G / 8) + bx / 8 : bx; }
    F.ws = args.ws; F.ctl = (unsigned*)(args.ws + WS_CTL); F.out = args.out;
#pragma unroll
    for (int i = 0; i < 25; ++i) F.in[i] = args.in[i];
    for (int u = F.tid; u < (LDS_BYTES - LDSCTL_OFF) / 4; u += NTHR) ((LAS unsigned*)(F.lds + LDSCTL_OFF))[u] = 0u;
    __syncthreads();
    const int lo = args.ph_lo, hi = args.ph_hi;
    XcdBarrier bar = xcd_barrier_post(F.ctl + CW_BAR + lo * XCD_BAR_WORDS, F.MISC + 8);
#define IN_PH(k) (lo <= (k) && (k) < hi)
#define SEAM(k) do { if (IN_PH(k) && IN_PH((k) + 1)) xcd_barrier(bar); } while (0)
#define RUNP(k, BODY) do { if (IN_PH(k)) { BODY; if (PROBE_REP == (k)) { xcd_barrier(bar); BODY; } } } while (0)
#define BODY0 p0_prologue(F)
#define BODY1 p1a_norm(F)
#define BODY2 { gm::DenseSched S{(const char*)(F.ws + WS_XN), (const char*)(F.ws + WS_WINT), T / 256, LDP / 256, F.G, (int)blockIdx.x, 2048u, 1024u}; \
        gm::EpiBf16 E{(bf16_t*)(F.ws + WS_PROJ), LDP}; gm::gemm_phase<gm::EpiBf16, gm::DenseSched>(F.lds, S, E, 1024, 128u); }
#define BODY3 { if (F.G == 256) { if (F.vcu < 128) cmp_unit(F, F.vcu); else { const int u0 = 2 * (F.vcu - 128); hg_passA(F, u0); hg_passA(F, u0 + 1); kv_prep_unit(F, u0); kv_prep_unit(F, u0 + 1); } } \
        else { for (int u = F.vcu; u < 128; u += F.G) cmp_unit(F, u); for (int u = F.vcu; u < 256; u += F.G) hg_passA(F, u); for (int u = F.vcu; u < 256; u += F.G) kv_prep_unit(F, u); } }
#define BODY4 { for (int u = F.vcu; u < 256; u += F.G) hg_passC(F, u); }
#define BODY5 { for (int c = F.vcu; c < 256; c += F.G) { const int bg = c >> 5, k = c & 31; att_unit(F, bg * 64 + 63 - k); att_unit(F, bg * 64 + k); } }
#define BODY6 { gm::DenseSched S{(const char*)(F.ws + WS_MIX), (const char*)(F.ws + WS_WOUTT), T / 256, 4, F.G, (int)blockIdx.x, 2048u, 1024u}; \
        gm::EpiRes E{F.in[IN_X], (const float*)(F.ws + WS_MOD), 2, (float*)(F.ws + WS_X2)}; gm::gemm_phase<gm::EpiRes, gm::DenseSched>(F.lds, S, E, 1024, 128u); }
#define BODY7 p5_router(F)
#define BODY8 { const MoeTabs Tb = moe_tabs_build(F); \
        GateUpSched S{Tb, (const char*)(F.ws + WS_H2), (const char*)(F.ws + WS_WGUT), (const char*)(F.ws + WS_WSGUT), (const int*)(F.ws + WS_ROWL), F.G, (int)blockIdx.x}; \
        EpiSwiglu E{(bf16_t*)(F.ws + WS_ACT), (bf16_t*)(F.ws + WS_ACTS)}; gm::gemm_phase<EpiSwiglu, GateUpSched>(F.lds, S, E, 1024, 128u); }
#define BODY9 { const MoeTabs Tb = moe_tabs_build(F); DownSched S{Tb, (const char*)(F.ws + WS_ACT), (const char*)(F.ws + WS_ACTS), (const char*)(F.ws + WS_WDNT), (const char*)(F.ws + WS_WSDNT), F.G, (int)blockIdx.x}; \
        EpiDown E{(unsigned char*)(F.ws + WS_Y), (bf16_t*)(F.ws + WS_YS)}; gm::gemm_phase<EpiDown, DownSched>(F.lds, S, E, 256, 128u); }
#define BODY10 p8_final(F)
    RUNP(0, BODY0); SEAM(0);
    RUNP(1, BODY1); SEAM(1);
    RUNP(2, BODY2); SEAM(2);
    RUNP(3, BODY3); SEAM(3);
    RUNP(4, BODY4); SEAM(4);
    RUNP(5, BODY5); SEAM(5);
    RUNP(6, BODY6); SEAM(6);
    RUNP(7, BODY7); SEAM(7);
    RUNP(8, BODY8); SEAM(8);
    RUNP(9, BODY9); SEAM(9);
    RUNP(10, BODY10);
#undef IN_PH
#undef SEAM
#undef RUNP
}
#ifndef ONE_LAUNCH
#define ONE_LAUNCH 1
#endif
#ifndef OPT_S1
#define OPT_S1 1
#endif
#ifndef OPT_S2B
#define OPT_S2B 1
#endif
#ifndef OPT_S2A
#define OPT_S2A 1
#endif
#ifndef OPT_S5
#define OPT_S5 1
#endif
#ifndef OPT_S3
#define OPT_S3 1
#endif
#ifndef OPT_S4
#define OPT_S4 1
#endif
static void launch_mk(const nv::In& I, void* const* d_in, float* out, unsigned char* ws, int lo, int hi, int grid, hipStream_t stream) {
    Args a{}; for (int i = 0; i < 25; ++i) a.in[i] = (const float*)d_in[i];
    a.out = out; a.ws = ws; a.ph_lo = lo; a.ph_hi = hi; a.rep = 0; a.pad = 0;
    hipLaunchKernelGGL(mk_fwd, dim3(grid), dim3(NTHR), LDS_BYTES, stream, a);
}
extern "C" void kernel_launch(void* const* d_in, const int* in_sizes, int n_in, void* d_out, int out_size, void* d_ws, size_t ws_size, hipStream_t stream) {
    static int grid = 0;
    if (grid == 0) {
        if (ws_size < WS_END || n_in != 25) { fprintf(stderr, "kernel_launch: ws %zu < %zu or n_in %d != 25\n", ws_size, (size_t)WS_END, n_in); grid = -1; return; }
        int dev = 0, cus = 0;
        if (hipGetDevice(&dev) != hipSuccess || hipDeviceGetAttribute(&cus, hipDeviceAttributeMultiprocessorCount, dev) != hipSuccess) { grid = -1; return; }
        if (hipFuncSetAttribute((const void*)mk_fwd, hipFuncAttributeMaxDynamicSharedMemorySize, LDS_BYTES) != hipSuccess) { fprintf(stderr, "kernel_launch: hipFuncSetAttribute failed\n"); grid = -1; return; }
        int per_cu = 0; (void)hipOccupancyMaxActiveBlocksPerMultiprocessor(&per_cu, (const void*)mk_fwd, NTHR, LDS_BYTES); (void)hipGetLastError();
        if (per_cu < 1) fprintf(stderr, "kernel_launch: occupancy query says %d blocks/CU\n", per_cu);
        grid = cus;
    }
    if (grid < 0) return;
    unsigned char* ws = (unsigned char*)d_ws; float* out = (float*)d_out;
    nv::In I; I.set(d_in);
    (void)hipMemsetAsync(ws + WS_CTL, 0, CTL_ZERO_BYTES, stream);
#if ONE_LAUNCH
    launch_mk(I, d_in, out, ws, 0, 11, grid, stream);
#else
#if OPT_S1
    launch_mk(I, d_in, out, ws, 0, 3, grid, stream);
#else
    nv::s1_naive(I, ws, stream);
#endif
#if OPT_S2A
    launch_mk(I, d_in, out, ws, 3, OPT_S2B ? 6 : 5, grid, stream);
#endif
    if (!OPT_S2A || !OPT_S2B) nv::s2_naive(I, ws, stream, !OPT_S2A, !OPT_S2B);
#if OPT_S3
    launch_mk(I, d_in, out, ws, 6, OPT_S4 ? 8 : 7, grid, stream);
#else
    nv::s3_naive(I, ws, stream);
#endif
#if OPT_S4
    if (!OPT_S3) launch_mk(I, d_in, out, ws, 7, 8, grid, stream);
#else
    nv::s4_naive(I, ws, stream);
#endif
#if OPT_S5
    launch_mk(I, d_in, out, ws, 8, 11, grid, stream);
#else
    nv::s5_naive(I, ws, out, stream);
#endif
#endif
}
#endif
```

```cpp
#ifndef CPU_EMU
#include <hip/hip_runtime.h>
#endif
#include <cstdio>
#include <cstdint>
#include <cmath>

#ifndef BATCH
#define BATCH 4
#endif
#ifndef SEQ
#define SEQ 4096
#endif

#ifdef CPU_EMU
struct dim3e { unsigned x, y, z; };
static thread_local dim3e threadIdx, blockIdx, blockDim, gridDim;
#define __global__
#define __device__
#define __host__
#define __forceinline__ inline
#define __launch_bounds__(...)
typedef int hipStream_t;
template <class F> static void cpu_launch(unsigned grid, unsigned block, F f) {
#pragma omp parallel for schedule(dynamic, 1)
    for (long b = 0; b < (long)grid; ++b) {
        blockIdx = {(unsigned)b, 0, 0}; blockDim = {block, 1, 1}; gridDim = {grid, 1, 1};
        for (unsigned t = 0; t < block; ++t) { threadIdx = {t, 0, 0}; f(); }
    }
}
static int g_launch_limit = 1 << 30, g_launch_count = 0;
#define LAUNCH(kern, grid, block, ...) do { if (g_launch_count++ < g_launch_limit) cpu_launch((unsigned)(grid), (unsigned)(block), [&]() { kern(__VA_ARGS__); }); } while (0)
#else
#define LAUNCH(kern, grid, block, ...) kern<<<dim3((unsigned)(grid)), dim3((unsigned)(block)), 0, stream>>>(__VA_ARGS__)
#endif

typedef unsigned short bf16_t;
constexpr int D = 1024, T = BATCH * SEQ, INC = 3352, LDP = 3584;
constexpr int C_HQ = 0, C_HF = 512, C_HI = 1024, C_HGT = 1536, C_NQ = 2048, C_KC = 2560, C_VC = 2688, C_KS = 2816, C_VS = 2944, C_KW = 3072, C_VW = 3200, C_NG = 3328;
constexpr int NCMP = (SEQ - 32) / 16 + 1, NSB = SEQ / 64, NSEL = NSB < 16 ? NSB : 16;
constexpr float EPS = 1e-6f;

constexpr size_t MiB = 1u << 20, KiB = 1u << 10;
constexpr size_t WS_CTL = 0, CTL_ZERO_BYTES = 1 * MiB;
constexpr size_t WS_MODP = 1 * MiB;
constexpr size_t WS_MOD = 2 * MiB + 512 * KiB;
constexpr size_t WS_B1F = WS_MOD + 128 * KiB;
constexpr size_t WS_CS = 2 * MiB + 768 * KiB, WS_SN = WS_CS + 512 * KiB;
constexpr size_t WS_WDNT = 4 * MiB;
constexpr size_t WS_WSDNT = 36 * MiB;
constexpr size_t WS_X2 = 37 * MiB;
constexpr size_t WS_ACT = 101 * MiB;
constexpr size_t WS_ACTS = 173 * MiB;
constexpr size_t WS_ROWL = 181 * MiB;
constexpr size_t WS_TOPI = 189 * MiB, WS_TOPW = WS_TOPI + 512 * KiB;
constexpr size_t WS_ERANK = 185 * MiB;
constexpr size_t WS_WGUT = 190 * MiB;
constexpr size_t WS_WSGUT = 254 * MiB;
constexpr size_t WS_WINT = 255 * MiB;
constexpr size_t WS_WOUTT = 262 * MiB;
constexpr size_t WS_W1KT = 264 * MiB, WS_W1VT = 265 * MiB;
constexpr size_t WS_W2T = 266 * MiB;
constexpr size_t WS_RW = 267 * MiB;
constexpr size_t WS_XN = 268 * MiB;
constexpr size_t WS_H2 = WS_XN;
constexpr size_t WS_PROJ = 300 * MiB;
constexpr size_t WS_KSR = 412 * MiB, WS_KWR = 416 * MiB;
constexpr size_t WS_VST = 420 * MiB, WS_VWT = 424 * MiB;
constexpr size_t WS_KCMP = 428 * MiB, WS_VCMPT = WS_KCMP + 256 * KiB;
constexpr size_t WS_U = 429 * MiB, WS_DD = 445 * MiB;
constexpr size_t WS_MIX = 446 * MiB;
constexpr size_t WS_Y = 190 * MiB;
constexpr size_t WS_YS = 478 * MiB;
constexpr size_t WS_END = 512 * MiB;
constexpr size_t NV_H = 37 * MiB, NV_RSTD = 101 * MiB;
constexpr size_t NV_F = 37 * MiB, NV_ORAW = 69 * MiB, NV_OWIN = 101 * MiB, NV_KSR = 133 * MiB, NV_KWR = 141 * MiB, NV_PS = 149 * MiB, NV_SEL = 157 * MiB,
                 NV_HID = 158 * MiB, NV_KCMP = 160 * MiB, NV_VCMP = 160 * MiB + 512 * KiB, NV_CS = 161 * MiB, NV_SN = 161 * MiB + 512 * KiB, NV_QROT = 478 * MiB;
constexpr size_t NV_H2F = 300 * MiB, NV_LG = 364 * MiB, NV_RSTD2 = 368 * MiB;
constexpr size_t NV_ACT = 300 * MiB, NV_ACTS = 101 * MiB, NV_X3 = 446 * MiB, NV_RSTD3 = 510 * MiB;

__host__ __device__ __forceinline__ float bf2f(bf16_t v) { union { unsigned u; float f; } c; c.u = (unsigned)v << 16; return c.f; }
__host__ __device__ __forceinline__ bf16_t f2bf(float f) { union { unsigned u; float f; } c; c.f = f; unsigned u = c.u; return (bf16_t)((u + 0x7fffu + ((u >> 16) & 1u)) >> 16); }

namespace nv {
__device__ __forceinline__ float sigmoidf_(float z) { return 1.0f / (1.0f + expf(-z)); }
__device__ __forceinline__ float siluf_(float z) { return z * sigmoidf_(z); }
__device__ __forceinline__ float gelu_tanh(float z) { return 0.5f * z * (1.0f + tanhf(0.7978845608028654f * (z + 0.044715f * z * z * z))); }
__device__ __forceinline__ long gtid() { return (long)blockIdx.x * blockDim.x + threadIdx.x; }
#define PJ(row, col) bf2f(proj[(size_t)(row) * LDP + (col)])

__global__ void k_mod(const float* c, const float* w_ada, const float* b_ada, float* mod) {
    long i = gtid(); if (i >= BATCH * 6144) return; int b = (int)(i / 6144), n = (int)(i % 6144);
    float acc = b_ada[n];
    for (int k = 0; k < D; ++k) acc += siluf_(c[b * D + k]) * w_ada[(size_t)k * 6144 + n];
    mod[i] = acc;
}
__global__ void k_rowrstd(const float* x, float* rstd, int rows) {
    long r = gtid(); if (r >= rows) return; float s = 0.f;
    for (int k = 0; k < D; ++k) { float v = x[(size_t)r * D + k]; s += v * v; }
    rstd[r] = 1.0f / sqrtf(s / D + EPS);
}
__global__ void k_modnorm(const float* x, const float* rstd, const float* g, const float* mod, int sh_chunk, int sc_chunk, float* hf, bf16_t* hb) {
    long i = gtid(); if (i >= (long)T * D) return; int r = (int)(i / D), k = (int)(i % D), b = r / SEQ;
    float v = x[i] * rstd[r] * g[k] * (1.0f + mod[b * 6144 + sc_chunk * D + k]) + mod[b * 6144 + sh_chunk * D + k];
    if (hf) hf[i] = v; if (hb) hb[i] = f2bf(v);
}
__global__ void k_gemm_nn_bf(const float* A, int lda, const float* Bm, int ldb, bf16_t* C, int ldc, int M, int N, int K) {
    long i = gtid(); if (i >= (long)M * N) return; int m = (int)(i / N), n = (int)(i % N);
    float acc = 0.f; const float* a = A + (size_t)m * lda;
    for (int k = 0; k < K; ++k) acc += a[k] * Bm[(size_t)k * ldb + n];
    C[(size_t)m * ldc + n] = f2bf(acc);
}
__global__ void k_gemm_nn(const float* A, int lda, const float* Bm, int ldb, float* C, int ldc, int M, int N, int K) {
    long i = gtid(); if (i >= (long)M * N) return; int m = (int)(i / N), n = (int)(i % N);
    float acc = 0.f; const float* a = A + (size_t)m * lda;
    for (int k = 0; k < K; ++k) acc += a[k] * Bm[(size_t)k * ldb + n];
    C[(size_t)m * ldc + n] = acc;
}
__global__ void k_hgf(const bf16_t* proj, const float* lbl, float* F) {
    long i = gtid(); if (i >= (long)T * 512) return; int r = (int)(i / 512), j = (int)(i % 512);
    float l0 = lbl[j], l1 = lbl[512 + j]; float mx = fmaxf(l0, l1); float e0 = expf(l0 - mx), e1 = expf(l1 - mx); float lb = e0 / (e0 + e1);
    F[i] = lb + (1.0f - lb) * sigmoidf_(PJ(r, C_HF + j));
}
__global__ void __launch_bounds__(64) k_hgrn(const bf16_t* proj, const float* F, float* Oraw) {
    long i = gtid(); if (i >= BATCH * 4 * 128) return; int e = (int)(i % 128), h = (int)((i / 128) % 4), b = (int)(i / 512);
    float S[128];
#pragma unroll
    for (int d = 0; d < 128; ++d) S[d] = 0.f;
    for (int t = 0; t < SEQ; ++t) {
        size_t row = (size_t)b * SEQ + t; const bf16_t* p = proj + row * LDP; const float* f = F + row * 512 + h * 128;
        float v = bf2f(p[C_HI + h * 128 + e]), o = 0.f;
#pragma unroll
        for (int d = 0; d < 128; ++d) { float ff = f[d]; S[d] = ff * S[d] + (1.0f - ff) * v; o += S[d] * bf2f(p[C_HQ + h * 128 + d]); }
        Oraw[row * 512 + h * 128 + e] = o * 0.08838834764831845f;
    }
}
__global__ void k_hgnorm(const float* Oraw, const bf16_t* proj, const float* ng, bf16_t* mix) {
    long i = gtid(); if (i >= (long)T * 4) return; size_t row = (size_t)(i / 4); int h = (int)(i % 4);
    const float* o = Oraw + row * 512 + h * 128; float s = 0.f;
    for (int e = 0; e < 128; ++e) s += o[e] * o[e];
    float r = 1.0f / sqrtf(s / 128 + EPS);
    for (int e = 0; e < 128; ++e) mix[row * D + h * 128 + e] = f2bf(o[e] * r * ng[h * 128 + e] * siluf_(PJ(row, C_HGT + h * 128 + e)));
}
__global__ void k_cmp_hidden(const bf16_t* proj, int coloff, const float* pe, const float* w1, const float* b1, float* hid) {
    long i = gtid(); if (i >= (long)BATCH * 2 * NCMP * 256) return; int j = (int)(i % 256); long r = i / 256; int c = (int)(r % NCMP), g = (int)((r / NCMP) % 2), b = (int)(r / (NCMP * 2));
    float acc = b1[j];
    for (int l = 0; l < 32; ++l) { const bf16_t* p = proj + ((size_t)b * SEQ + 16 * c + l) * LDP + coloff + g * 64;
        for (int d = 0; d < 64; ++d) acc += (bf2f(p[d]) + pe[l * 64 + d]) * w1[(size_t)(l * 64 + d) * 256 + j]; }
    hid[i] = gelu_tanh(acc);
}
__global__ void k_cmp_out(const float* hid, const float* w2, float* out) {
    long i = gtid(); if (i >= (long)BATCH * 2 * NCMP * 64) return; int d = (int)(i % 64); long r = i / 64;
    float acc = 0.f; for (int j = 0; j < 256; ++j) acc += hid[r * 256 + j] * w2[j * 64 + d];
    out[i] = acc;
}
__global__ void k_rope_tab(float* cs, float* sn) {
    long i = gtid(); if (i >= (long)SEQ * 32) return; int pos = (int)(i / 32), k = (int)(i % 32);
    float inv = powf(10000.0f, -(float)k / 32.0f); float ang = (float)pos * inv; cs[i] = cosf(ang); sn[i] = sinf(ang);
}
__global__ void k_rope_apply(const bf16_t* proj, int coloff, int nh, const float* cs, const float* sn, float* dst) {
    long i = gtid(); if (i >= (long)T * nh * 32) return; int k = (int)(i % 32); int h = (int)((i / 32) % nh); size_t row = (size_t)(i / (32 * nh)); int pos = (int)(row % SEQ);
    float t1 = PJ(row, coloff + h * 64 + k), t2 = PJ(row, coloff + h * 64 + k + 32), co = cs[pos * 32 + k], si = sn[pos * 32 + k];
    dst[row * (nh * 64) + h * 64 + k] = t1 * co - t2 * si; dst[row * (nh * 64) + h * 64 + k + 32] = t2 * co + t1 * si;
}
__global__ void __launch_bounds__(64) k_cmp_attn(const bf16_t* proj, const float* kcmp, const float* vcmp, float* ocmp, float* PS) {
    long i = gtid(); if (i >= (long)BATCH * 2 * SEQ) return; int s = (int)(i % SEQ), g = (int)((i / SEQ) % 2), b = (int)(i / (2 * SEQ));
    size_t row = (size_t)b * SEQ + s; float* ps = PS + (size_t)i * 64;
    for (int j = 0; j < 64; ++j) ps[j] = 0.f;
    int ncv = s >= 31 ? (s - 31) / 16 + 1 : 0; if (ncv > NCMP) ncv = NCMP;
    const float* kc = kcmp + (size_t)(b * 2 + g) * NCMP * 64; const float* vc = vcmp + (size_t)(b * 2 + g) * NCMP * 64;
    for (int hh = 0; hh < 4; ++hh) {
        int head = g * 4 + hh;
        float q[64], o[64];
#pragma unroll
        for (int d = 0; d < 64; ++d) { q[d] = PJ(row, C_NQ + head * 64 + d); o[d] = 0.f; }
        float m = -3.0e38f, l = 0.f;
        for (int c = 0; c < ncv; ++c) { float sc = 0.f;
#pragma unroll
            for (int d = 0; d < 64; ++d) sc += q[d] * kc[c * 64 + d];
            sc *= 0.125f; float mn = fmaxf(m, sc); l = l * expf(m - mn) + expf(sc - mn); m = mn; }
        for (int c = 0; c < ncv; ++c) { float sc = 0.f;
#pragma unroll
            for (int d = 0; d < 64; ++d) sc += q[d] * kc[c * 64 + d];
            sc *= 0.125f; float p = expf(sc - m) / l;
#pragma unroll
            for (int d = 0; d < 64; ++d) o[d] += p * vc[c * 64 + d];
            int c0 = 16 * c, c1 = 16 * c + 32;
            for (int j = c0 / 64; j <= (c1 - 1) / 64 && j < NSB; ++j) { int lo = c0 > 64 * j ? c0 : 64 * j, hi = c1 < 64 * j + 64 ? c1 : 64 * j + 64; if (hi > lo) ps[j] += p * (float)(hi - lo) / 32.0f; } }
#pragma unroll
        for (int d = 0; d < 64; ++d) ocmp[row * 512 + head * 64 + d] = o[d];
    }
}
__global__ void k_select(const float* PS, unsigned* SEL) {
    long i = gtid(); if (i >= (long)BATCH * 2 * SEQ) return; int s = (int)(i % SEQ); const float* ps = PS + (size_t)i * 64; int cur = s / 64;
    unsigned m0 = 0, m1 = 0;
    for (int j = 0; j < NSB; ++j) {
        bool fj = (j == 0) || (j == cur) || (j == cur - 1); float sj = fj ? 1e30f : (j <= cur ? ps[j] : -1e30f);
        int rank = 0;
        for (int k = 0; k < NSB; ++k) { bool fk = (k == 0) || (k == cur) || (k == cur - 1); float sk = fk ? 1e30f : (k <= cur ? ps[k] : -1e30f); if (sk > sj || (sk == sj && k < j)) ++rank; }
        if (rank < NSEL && sj > -1e29f) { if (j < 32) m0 |= 1u << j; else m1 |= 1u << (j - 32); }
    }
    SEL[i * 2] = m0; SEL[i * 2 + 1] = m1;
}
__global__ void __launch_bounds__(64) k_attn_naive(const float* qrot, const float* krot, const bf16_t* proj, int vcol, const unsigned* SEL, int mode, float* out) {
    long i = gtid(); if (i >= (long)BATCH * 8 * SEQ) return; int s = (int)(i % SEQ), head = (int)((i / SEQ) % 8), b = (int)(i / (8 * SEQ)); int g = head / 4;
    size_t row = (size_t)b * SEQ + s; float q[64], o[64];
#pragma unroll
    for (int d = 0; d < 64; ++d) { q[d] = qrot[row * 512 + head * 64 + d]; o[d] = 0.f; }
    float m = -3.0e38f, l = 0.f;
    unsigned m0 = 0, m1 = 0; if (mode == 0) { size_t si = ((size_t)(b * 2 + g) * SEQ + s) * 2; m0 = SEL[si]; m1 = SEL[si + 1]; }
    int k0 = mode == 0 ? 0 : (s - 511 > 0 ? s - 511 : 0);
    for (int key = k0; key <= s; ++key) {
        if (mode == 0) { int j = key / 64; bool sel = j < 32 ? ((m0 >> j) & 1u) : ((m1 >> (j - 32)) & 1u); if (!sel) { key = j * 64 + 63; continue; } }
        size_t kr = (size_t)b * SEQ + key; const float* kp = krot + kr * 128 + g * 64;
        float sc = 0.f;
#pragma unroll
        for (int d = 0; d < 64; ++d) sc += q[d] * kp[d];
        sc *= 0.125f; float mn = fmaxf(m, sc), a = expf(m - mn), p = expf(sc - mn); l = l * a + p; m = mn;
#pragma unroll
        for (int d = 0; d < 64; ++d) o[d] = o[d] * a + p * PJ(kr, vcol + g * 64 + d);
    }
#pragma unroll
    for (int d = 0; d < 64; ++d) out[row * 512 + head * 64 + d] = o[d] / l;
}
__global__ void k_nsa_combine(const bf16_t* proj, const float* ocmp, const float* oslc, const float* owin, bf16_t* mix) {
    long i = gtid(); if (i >= (long)T * 512) return; size_t row = (size_t)(i / 512); int c = (int)(i % 512), head = c / 64;
    mix[row * D + 512 + c] = f2bf(sigmoidf_(PJ(row, C_NG + head * 3)) * ocmp[i] + sigmoidf_(PJ(row, C_NG + head * 3 + 1)) * oslc[i] + sigmoidf_(PJ(row, C_NG + head * 3 + 2)) * owin[i]);
}
__global__ void k_proj_res(const bf16_t* A, const float* W, const float* x, const float* mod, int chunk, float* out) {
    long i = gtid(); if (i >= (long)T * D) return; int r = (int)(i / D), n = (int)(i % D), b = r / SEQ;
    float acc = 0.f; const bf16_t* a = A + (size_t)r * D;
    for (int k = 0; k < D; ++k) acc += bf2f(a[k]) * W[(size_t)k * D + n];
    out[i] = x[i] + mod[b * 6144 + chunk * D + n] * acc;
}
__global__ void __launch_bounds__(64) k_route(const float* LG, const float* bias, int* TOPI, float* TOPW) {
    long t = gtid(); if (t >= T) return; const float* lg = LG + (size_t)t * 64;
    float gs[8];
#pragma unroll
    for (int gI = 0; gI < 8; ++gI) { float a = -3e38f, b2 = -3e38f;
        for (int e = 0; e < 8; ++e) { float ch = sigmoidf_(lg[gI * 8 + e]) + bias[gI * 8 + e]; if (ch > a) { b2 = a; a = ch; } else if (ch > b2) b2 = ch; }
        gs[gI] = a + b2; }
    unsigned gmask = 0;
#pragma unroll
    for (int gI = 0; gI < 8; ++gI) { int rank = 0;
#pragma unroll
        for (int k = 0; k < 8; ++k) if (gs[k] > gs[gI] || (gs[k] == gs[gI] && k < gI)) ++rank;
        if (rank < 4) gmask |= 1u << gI; }
    int n = 0; float wsum = 0.f;
    for (int e = 0; e < 64; ++e) { if (!((gmask >> (e / 8)) & 1u)) continue; float se = sigmoidf_(lg[e]), ce = se + bias[e]; int rank = 0;
        for (int k = 0; k < 64; ++k) { if (!((gmask >> (k / 8)) & 1u)) continue; float ck = sigmoidf_(lg[k]) + bias[k]; if (ck > ce || (ck == ce && k < e)) ++rank; }
        if (rank < 8 && n < 8) { TOPI[t * 8 + n] = e; TOPW[t * 8 + n] = se; wsum += se; ++n; } }
    for (int k = 0; k < 8; ++k) TOPW[t * 8 + k] = TOPW[t * 8 + k] / wsum * 2.5f;
}
__global__ void k_moe_act(const bf16_t* h2, const float* Wgu, const int* TOPI, float* ACT, long nA) {
    long i = gtid(); if (i >= nA * 256) return; long a = i / 256; int j = (int)(i % 256); long t = TOPI ? a / 8 : a; int e = TOPI ? TOPI[a] : 0;
    const bf16_t* hp = h2 + (size_t)t * D; const float* w = Wgu + (size_t)e * D * 512; float gq = 0.f, u = 0.f;
    for (int k = 0; k < D; ++k) { float hv = bf2f(hp[k]); gq += hv * w[(size_t)k * 512 + j]; u += hv * w[(size_t)k * 512 + 256 + j]; }
    ACT[i] = siluf_(gq) * u;
}
__global__ void k_moe_out(const float* ACT, const float* ACTS, const float* Wdn, const float* Wsd, const int* TOPI, const float* TOPW, const float* x2, const float* mod, float* x3) {
    long i = gtid(); if (i >= (long)T * D) return; long t = i / D; int n = (int)(i % D), b = (int)(t / SEQ);
    float acc = 0.f;
    for (int sl = 0; sl < 8; ++sl) { int e = TOPI[t * 8 + sl]; const float* a = ACT + (size_t)(t * 8 + sl) * 256; const float* w = Wdn + (size_t)e * 256 * D; float y = 0.f;
        for (int k = 0; k < 256; ++k) y += a[k] * w[(size_t)k * D + n];
        acc += TOPW[t * 8 + sl] * y; }
    { const float* a = ACTS + (size_t)t * 256; float y = 0.f; for (int k = 0; k < 256; ++k) y += a[k] * Wsd[(size_t)k * D + n]; acc += y; }
    x3[i] = x2[i] + mod[b * 6144 + 5 * D + n] * acc;
}
__global__ void k_final(const float* x3, const float* rstd, const float* g, float* out) {
    long i = gtid(); if (i >= (long)T * D) return; out[i] = x3[i] * rstd[i / D] * g[i % D];
}
#undef PJ

struct In { const float *x, *c, *w_ada, *b_ada, *n1g, *w_in, *lbl, *hng, *pek, *w1k, *b1k, *w2k, *pev, *w1v, *b1v, *w2v, *w_out, *n2g, *rw, *rb, *wgu, *wdn, *wsgu, *wsdn, *fg;
    void set(void* const* d) { const float** p = (const float**)this; for (int i = 0; i < 25; ++i) p[i] = (const float*)d[i]; } };
#define NBK(n, tb) (((long)(n) + (tb) - 1) / (tb))
template <class Tp> static Tp* wsp(unsigned char* ws, size_t off) { return (Tp*)(ws + off); }
static void s1_naive(const In& I, unsigned char* ws, hipStream_t stream) {
    float* mod = wsp<float>(ws, WS_MOD); float* h = wsp<float>(ws, NV_H); float* rstd = wsp<float>(ws, NV_RSTD); bf16_t* proj = wsp<bf16_t>(ws, WS_PROJ);
    LAUNCH(k_mod, NBK(BATCH * 6144, 256), 256, I.c, I.w_ada, I.b_ada, mod);
    LAUNCH(k_rowrstd, NBK(T, 256), 256, I.x, rstd, T);
    LAUNCH(k_modnorm, NBK((long)T * D, 256), 256, I.x, rstd, I.n1g, mod, 0, 1, h, (bf16_t*)nullptr);
    LAUNCH(k_gemm_nn_bf, NBK((long)T * INC, 256), 256, h, D, I.w_in, INC, proj, LDP, T, INC, D);
}
static void s2_naive(const In& I, unsigned char* ws, hipStream_t stream, bool do_hg = true, bool do_nsa = true) {
    const bf16_t* proj = wsp<bf16_t>(ws, WS_PROJ); bf16_t* mix = wsp<bf16_t>(ws, WS_MIX);
    float *F = wsp<float>(ws, NV_F), *oraw = wsp<float>(ws, NV_ORAW), *owin = wsp<float>(ws, NV_OWIN), *ksr = wsp<float>(ws, NV_KSR), *kwr = wsp<float>(ws, NV_KWR), *PS = wsp<float>(ws, NV_PS);
    float *hid = wsp<float>(ws, NV_HID), *kcmp = wsp<float>(ws, NV_KCMP), *vcmp = wsp<float>(ws, NV_VCMP), *cs = wsp<float>(ws, NV_CS), *sn = wsp<float>(ws, NV_SN), *qrot = wsp<float>(ws, NV_QROT);
    unsigned* sel = wsp<unsigned>(ws, NV_SEL); float *ocmp = F, *oslc = oraw;
    if (do_hg) {
    LAUNCH(k_hgf, NBK((long)T * 512, 256), 256, proj, I.lbl, F);
    LAUNCH(k_hgrn, NBK(BATCH * 512, 64), 64, proj, F, oraw);
    LAUNCH(k_hgnorm, NBK((long)T * 4, 256), 256, oraw, proj, I.hng, mix);
    }
    if (!do_nsa) return;
    LAUNCH(k_cmp_hidden, NBK((long)BATCH * 2 * NCMP * 256, 256), 256, proj, C_KC, I.pek, I.w1k, I.b1k, hid);
    LAUNCH(k_cmp_out, NBK((long)BATCH * 2 * NCMP * 64, 256), 256, hid, I.w2k, kcmp);
    LAUNCH(k_cmp_hidden, NBK((long)BATCH * 2 * NCMP * 256, 256), 256, proj, C_VC, I.pev, I.w1v, I.b1v, hid);
    LAUNCH(k_cmp_out, NBK((long)BATCH * 2 * NCMP * 64, 256), 256, hid, I.w2v, vcmp);
    LAUNCH(k_rope_tab, NBK(SEQ * 32, 256), 256, cs, sn);
    LAUNCH(k_rope_apply, NBK((long)T * 8 * 32, 256), 256, proj, C_NQ, 8, cs, sn, qrot);
    LAUNCH(k_rope_apply, NBK((long)T * 2 * 32, 256), 256, proj, C_KS, 2, cs, sn, ksr);
    LAUNCH(k_rope_apply, NBK((long)T * 2 * 32, 256), 256, proj, C_KW, 2, cs, sn, kwr);
    LAUNCH(k_cmp_attn, NBK((long)BATCH * 2 * SEQ, 64), 64, proj, kcmp, vcmp, ocmp, PS);
    LAUNCH(k_select, NBK((long)BATCH * 2 * SEQ, 256), 256, PS, sel);
    LAUNCH(k_attn_naive, NBK((long)BATCH * 8 * SEQ, 64), 64, qrot, ksr, proj, C_VS, sel, 0, oslc);
    LAUNCH(k_attn_naive, NBK((long)BATCH * 8 * SEQ, 64), 64, qrot, kwr, proj, C_VW, sel, 1, owin);
    LAUNCH(k_nsa_combine, NBK((long)T * 512, 256), 256, proj, ocmp, oslc, owin, mix);
}
static void s3_naive(const In& I, unsigned char* ws, hipStream_t stream) {
    LAUNCH(k_proj_res, NBK((long)T * D, 256), 256, wsp<bf16_t>(ws, WS_MIX), I.w_out, I.x, wsp<float>(ws, WS_MOD), 2, wsp<float>(ws, WS_X2));
}
static void s4_naive(const In& I, unsigned char* ws, hipStream_t stream) {
    float *x2 = wsp<float>(ws, WS_X2), *rstd = wsp<float>(ws, NV_RSTD2), *h2f = wsp<float>(ws, NV_H2F), *lg = wsp<float>(ws, NV_LG), *mod = wsp<float>(ws, WS_MOD);
    LAUNCH(k_rowrstd, NBK(T, 256), 256, x2, rstd, T);
    LAUNCH(k_modnorm, NBK((long)T * D, 256), 256, x2, rstd, I.n2g, mod, 3, 4, h2f, wsp<bf16_t>(ws, WS_H2));
    LAUNCH(k_gemm_nn, NBK((long)T * 64, 256), 256, h2f, D, I.rw, 64, lg, 64, T, 64, D);
    LAUNCH(k_route, NBK(T, 64), 64, lg, I.rb, wsp<int>(ws, WS_TOPI), wsp<float>(ws, WS_TOPW));
}
static void s5_naive(const In& I, unsigned char* ws, float* out, hipStream_t stream) {
    float *act = wsp<float>(ws, NV_ACT), *acts = wsp<float>(ws, NV_ACTS), *x3 = wsp<float>(ws, NV_X3), *rstd = wsp<float>(ws, NV_RSTD3);
    const bf16_t* h2 = wsp<bf16_t>(ws, WS_H2); const int* topi = wsp<int>(ws, WS_TOPI);
    LAUNCH(k_moe_act, NBK((long)T * 8 * 256, 256), 256, h2, I.wgu, topi, act, (long)T * 8);
    LAUNCH(k_moe_act, NBK((long)T * 256, 256), 256, h2, I.wsgu, (const int*)nullptr, acts, (long)T);
    LAUNCH(k_moe_out, NBK((long)T * D, 256), 256, act, acts, I.wdn, I.wsdn, topi, wsp<float>(ws, WS_TOPW), wsp<float>(ws, WS_X2), wsp<float>(ws, WS_MOD), x3);
    LAUNCH(k_rowrstd, NBK(T, 256), 256, x3, rstd, T);
    LAUNCH(k_final, NBK((long)T * D, 256), 256, x3, rstd, I.fg, out);
}
}
#ifndef CPU_EMU
#define GAS __attribute__((address_space(1)))
#define LAS __attribute__((address_space(3)))
typedef unsigned v4u __attribute__((ext_vector_type(4)));
typedef unsigned v2u __attribute__((ext_vector_type(2)));
typedef float f32x4 __attribute__((ext_vector_type(4)));
typedef float f32x2 __attribute__((ext_vector_type(2)));
typedef float f32x16 __attribute__((ext_vector_type(16)));
typedef short bf16x8 __attribute__((ext_vector_type(8)));
typedef short bf16x4 __attribute__((ext_vector_type(4)));
typedef long i64x2 __attribute__((ext_vector_type(2)));
typedef int v8i __attribute__((ext_vector_type(8)));
typedef int v4i __attribute__((ext_vector_type(4)));
typedef GAS unsigned gu32;
#define RLX_AGENT __ATOMIC_RELAXED, __HIP_MEMORY_SCOPE_AGENT
#define LDS_WAIT() asm volatile("s_waitcnt lgkmcnt(0)" ::: "memory")
#define VM_WAIT() asm volatile("s_waitcnt vmcnt(0)" ::: "memory")
constexpr int NWAVES = 8, NTHR = 512;
__device__ __forceinline__ unsigned pk2(float lo, float hi) { return (unsigned)f2bf(lo) | ((unsigned)f2bf(hi) << 16); }
__device__ __forceinline__ unsigned cvt_pk_bf16(float lo, float hi) { unsigned r; asm volatile("v_cvt_pk_bf16_f32 %0, %1, %2" : "=v"(r) : "v"(lo), "v"(hi)); return r; }
__device__ __forceinline__ float fexp2(float x) { return __builtin_amdgcn_exp2f(__builtin_amdgcn_fmed3f(x, -120.0f, 3.0e38f)); }
__device__ __forceinline__ float fexp(float x) { return __builtin_amdgcn_exp2f(fmaxf(x * 1.4426950408889634f, -120.0f)); }
__device__ __forceinline__ float fsigmoid(float z) { return 1.0f / (1.0f + __builtin_amdgcn_exp2f(fminf(fmaxf(-z * 1.4426950408889634f, -120.0f), 120.0f))); }
__device__ __forceinline__ float fsilu(float z) { return z / (1.0f + __builtin_amdgcn_exp2f(fminf(fmaxf(-z * 1.4426950408889634f, -120.0f), 120.0f))); }
__device__ __forceinline__ unsigned pk4_e4m3(float a, float b, float c, float d, float sc) {
    a = __builtin_amdgcn_fmed3f(a * sc, -448.0f, 448.0f); b = __builtin_amdgcn_fmed3f(b * sc, -448.0f, 448.0f); c = __builtin_amdgcn_fmed3f(c * sc, -448.0f, 448.0f); d = __builtin_amdgcn_fmed3f(d * sc, -448.0f, 448.0f);
    int w = __builtin_amdgcn_cvt_pk_fp8_f32(a, b, 0, false); w = __builtin_amdgcn_cvt_pk_fp8_f32(c, d, w, true); return (unsigned)w;
}
__device__ __forceinline__ float wave_sum(float v) {
#pragma unroll
    for (int o = 1; o < 64; o <<= 1) v += __shfl_xor(v, o);
    return v;
}

#define XB_TMO      128
#define XB_XCNT(j)  (256  + 64 * (j))
#define XB_XSUB(j)  (1280 + 64 * (j))
#define XB_XGEN(j)  (2304 + 64 * (j))
#define XB_TOP      3328
#define XB_TOPGEN   3392
#define XCD_BAR_WORDS 3456
#define XB_SPIN_CAP (1u << 18)
__device__ __forceinline__ unsigned xb_ld(unsigned* p)              { return __hip_atomic_load(p, __ATOMIC_RELAXED, __HIP_MEMORY_SCOPE_AGENT); }
__device__ __forceinline__ unsigned xb_add(unsigned* p, unsigned v) { return __hip_atomic_fetch_add(p, v, __ATOMIC_RELAXED, __HIP_MEMORY_SCOPE_AGENT); }
__device__ __forceinline__ unsigned xb_xcc_id() { return (unsigned)__builtin_amdgcn_s_getreg((3 << 11) | 20) & 0xFu; }
#define XB_SPIN(cond, bar) do { unsigned _sp = 0; while (cond) { __builtin_amdgcn_s_sleep(1); \
    if ((++_sp & 255u) == 0u) { if (xb_ld(&(bar)[XB_TMO])) break; if (_sp > XB_SPIN_CAP) { atomicAdd(&(bar)[XB_TMO], 1u); break; } } } } while (0)
struct XcdBarrier { unsigned* bar; unsigned x; volatile LAS unsigned* st; };
__device__ __forceinline__ XcdBarrier xcd_barrier_post(unsigned* bar, volatile LAS unsigned* st) {
    XcdBarrier b; b.bar = bar; b.x = xb_xcc_id(); b.st = st;
    if (threadIdx.x == 0) (void)xb_add(&bar[XB_XCNT(b.x)], 1u);
    return b;
}
__device__ __forceinline__ void xcd_barrier_complete(unsigned* bar, unsigned x, unsigned& nloc, unsigned& nx) {
    const unsigned G = gridDim.x * gridDim.y * gridDim.z;
    unsigned sum, cnt, mine, sp = 0u;
    for (;;) {
        sum = 0u; cnt = 0u; mine = 0u;
#pragma unroll
        for (unsigned j = 0; j < 16; ++j) { const unsigned c = xb_ld(&bar[XB_XCNT(j)]); sum += c; cnt += (c > 0u) ? 1u : 0u; mine = (j == x) ? c : mine; }
        if (sum == G) break;
        __builtin_amdgcn_s_sleep(1);
        if ((++sp & 255u) == 0u) { if (xb_ld(&bar[XB_TMO])) break; if (sp > XB_SPIN_CAP) { atomicAdd(&bar[XB_TMO], 1u); break; } }
    }
    nloc = mine > 0u ? mine : 1u; nx = cnt > 0u ? cnt : 1u;
}
__device__ __forceinline__ void xcd_barrier(const XcdBarrier& b) {
    asm volatile("s_waitcnt vmcnt(0)" ::: "memory");
    __syncthreads();
    if (threadIdx.x == 0) {
        unsigned* bar = b.bar;
        __builtin_amdgcn_s_waitcnt(0);
        unsigned nloc = b.st[0], nx = b.st[1];
        if (nloc == 0u) { xcd_barrier_complete(bar, b.x, nloc, nx); b.st[0] = nloc; b.st[1] = nx; }
        const unsigned old = xb_add(&bar[XB_XSUB(b.x)], 1u);
        const unsigned gen = old / nloc;
        if (old + 1u == (gen + 1u) * nloc) {
            __builtin_amdgcn_fence(__ATOMIC_RELEASE, "agent");
            asm volatile("s_waitcnt vmcnt(0)" ::: "memory");
            const unsigned og = xb_add(&bar[XB_TOP], 1u);
            const unsigned tg = og / nx;
            if (og + 1u == (tg + 1u) * nx) xb_add(&bar[XB_TOPGEN], 1u);
            else XB_SPIN(xb_ld(&bar[XB_TOPGEN]) == tg, bar);
            __builtin_amdgcn_fence(__ATOMIC_ACQUIRE, "agent");
            xb_add(&bar[XB_XGEN(b.x)], 1u);
            asm volatile("s_waitcnt vmcnt(0)" ::: "memory");
        } else {
            XB_SPIN(xb_ld(&bar[XB_XGEN(b.x)]) == gen, bar);
            __builtin_amdgcn_fence(__ATOMIC_ACQUIRE, "agent");
            asm volatile("s_waitcnt vmcnt(0)" ::: "memory");
        }
    }
    __syncthreads();
}

namespace gm {
constexpr int BM = 256, BK = 64, HALF = 128, HTB = HALF * BK * 2, STAGE_BYTES = 8 * HTB, NXCD = 8, WGM = 8;
__host__ __device__ __forceinline__ int lds_byte(int r, int c) { const int st = (r >> 4) * 2 + (c >> 5), rr = r & 15, cc = c & 31, ob = rr * 64 + cc * 2; return st * 1024 + (ob ^ (((ob >> 9) & 1) << 5)); }
__host__ __device__ __forceinline__ void stage_rc(int b, int& R, int& C) { const int st = b / 1024, sb = b % 1024, swz = sb ^ (((sb >> 9) & 1) << 5); R = (st >> 1) * 16 + swz / 64; C = (st & 1) * 32 + (swz % 64) / 2; }
__host__ __device__ __forceinline__ int perm32(int rho) { const int n = rho >> 4, i = rho & 15; return 8 * (i >> 2) + 4 * n + (i & 3); }

struct Unit { int pm, pn; const char* A; const char* B; int e, m0; };

__device__ __forceinline__ bool static_tile(int nM, int nN, int G, int c, int i, int& pm, int& pn) {
    const int nwg = nM * nN; const long L = (long)i * G + c; if (L >= nwg) return false;
    int wgid = (int)L; { const int q = nwg / NXCD, r = nwg % NXCD, xcd = wgid % NXCD, off = wgid / NXCD; wgid = (xcd < r ? xcd * (q + 1) : r * (q + 1) + (xcd - r) * q) + off; }
    const int nig = WGM * nN, gid = wgid / nig, fm = gid * WGM, gsz = (nM - fm) < WGM ? (nM - fm) : WGM;
    pm = fm + ((wgid % nig) % gsz); pn = (wgid % nig) / gsz; return true;
}
struct DenseSched {
    const char* A; const char* Bt; int nM, nN, G, c; unsigned lda_b, K;
    __device__ __forceinline__ bool next(int i, Unit& u) const { int pm, pn; if (!static_tile(nM, nN, G, c, i, pm, pn)) return false; u.pm = pm; u.pn = pn; u.A = A + (size_t)pm * BM * lda_b; u.B = Bt + (size_t)pn * BM * K * 2; u.e = 0; u.m0 = 0; return true; }
    __device__ __forceinline__ unsigned arow(const Unit&, int r) const { return (unsigned)r * lda_b; }
};

template <class Epi, class Sched, bool FP8 = false>
__device__ __forceinline__ void gemm_phase(LAS unsigned char* lds, const Sched& S, const Epi& E, const int K, const unsigned kstepA) {
    const int tid = threadIdx.x, wid = __builtin_amdgcn_readfirstlane(tid >> 6), lane = tid & 63, wr = wid >> 2, wc = wid & 3, fr = lane & 15, fq = lane >> 4;
    const int nt = K / BK;
    int R0, C0; stage_rc(tid * 16, R0, C0);
    unsigned voffB[2];
#pragma unroll
    for (int i = 0; i < 2; ++i) { const int R = R0 + 64 * i; const int Rb = Epi::PERM ? ((R & ~31) + perm32(R & 31)) : R; voffB[i] = (unsigned)(Rb * K + C0) * 2u; }
    const unsigned ca = (unsigned)C0 * 2u;
    const size_t kstepB = (size_t)(BK * 2);
    const size_t hstepB = (size_t)HALF * K * 2;
    const unsigned ldsw = (unsigned)wid * 1024u;
    const int aoff = lds_byte(wr * 64 + fr, fq * 8), boff = lds_byte(wc * 32 + fr, fq * 8);
#define GM_SA(b, h) (((b) * 2 + (h)) * HTB)
#define GM_SB(b, h) ((4 + (b) * 2 + (h)) * HTB)
#define GM_STAGEB(bufoff, gbase) do { _Pragma("unroll") for (int _i = 0; _i < 2; ++_i) \
        __builtin_amdgcn_global_load_lds((const unsigned*)((const char*)(gbase) + voffB[_i]), (LAS unsigned*)(lds + (bufoff) + ldsw + _i * 8192), 16, 0, 0); } while (0)
#define GM_STAGEA(bufoff, abase, offs, h, kb) do { _Pragma("unroll") for (int _i = 0; _i < 2; ++_i) \
        __builtin_amdgcn_global_load_lds((const unsigned*)((const char*)(abase) + (offs)[2 * (h) + _i] + (kb)), (LAS unsigned*)(lds + (bufoff) + ldsw + _i * 8192), 16, 0, 0); } while (0)
#define GM_LDA(dst, b, h) do { _Pragma("unroll") for (int m = 0; m < 4; ++m) _Pragma("unroll") for (int k = 0; k < 2; ++k) dst[m][k] = *(const LAS bf16x8*)(lds + GM_SA(b, h) + aoff + m * 2048 + k * 1024); } while (0)
#define GM_LDB(dst, b, h) do { _Pragma("unroll") for (int n = 0; n < 2; ++n) _Pragma("unroll") for (int k = 0; k < 2; ++k) dst[n][k] = *(const LAS bf16x8*)(lds + GM_SB(b, h) + boff + n * 2048 + k * 1024); } while (0)
#define GM_MMA(ai, bj, At, Bt) do { __builtin_amdgcn_s_setprio(1); _Pragma("unroll") for (int m = 0; m < 4; ++m) _Pragma("unroll") for (int n = 0; n < 2; ++n) _Pragma("unroll") for (int k = 0; k < 2; ++k) { \
        if constexpr (FP8) { const i64x2 b2_ = __builtin_bit_cast(i64x2, Bt[n][k]), a2_ = __builtin_bit_cast(i64x2, At[m][k]); \
            acc[ai][bj][m][n] = __builtin_amdgcn_mfma_f32_16x16x32_fp8_fp8(b2_[0], a2_[0], acc[ai][bj][m][n], 0, 0, 0); acc[ai][bj][m][n] = __builtin_amdgcn_mfma_f32_16x16x32_fp8_fp8(b2_[1], a2_[1], acc[ai][bj][m][n], 0, 0, 0); } \
        else acc[ai][bj][m][n] = __builtin_amdgcn_mfma_f32_16x16x32_bf16(Bt[n][k], At[m][k], acc[ai][bj][m][n], 0, 0, 0); } __builtin_amdgcn_s_setprio(0); } while (0)
#define GM_WAIT_V(n) asm volatile("s_waitcnt vmcnt(" #n ")" ::: "memory")
#define GM_WAIT_L(n) asm volatile("s_waitcnt lgkmcnt(" #n ")" ::: "memory")
#define GM_BAR __builtin_amdgcn_s_barrier()
#define GM_SCHED __builtin_amdgcn_sched_barrier(0)
    Unit cur, nxt; int ui = 0;
    if (!S.next(0, cur)) return;
    unsigned coff[4], noff[4];
#pragma unroll
    for (int q = 0; q < 4; ++q) { coff[q] = S.arow(cur, R0 + 64 * q) + ca; noff[q] = coff[q]; }
    f32x4 acc[2][2][4][2];
#pragma unroll
    for (int a = 0; a < 2; ++a)
#pragma unroll
        for (int b = 0; b < 2; ++b)
#pragma unroll
            for (int m = 0; m < 4; ++m)
#pragma unroll
                for (int n = 0; n < 2; ++n) acc[a][b][m][n] = (f32x4){0.f, 0.f, 0.f, 0.f};
    bf16x8 At[4][2], B0[2][2], B1[2][2];
    const char* cA = cur.A; const char* cB = cur.B;
    GM_STAGEB(GM_SB(0, 0), cB); GM_STAGEB(GM_SB(0, 1), cB + hstepB); GM_STAGEA(GM_SA(0, 0), cA, coff, 0, 0u); GM_STAGEA(GM_SA(0, 1), cA, coff, 1, 0u);
    if (wr == 1) GM_BAR;
    GM_WAIT_V(2); GM_BAR;
    GM_STAGEB(GM_SB(1, 0), cB + kstepB); GM_STAGEA(GM_SA(1, 0), cA, coff, 0, kstepA); GM_STAGEB(GM_SB(1, 1), cB + hstepB + kstepB);
    GM_WAIT_V(6); GM_BAR;
    for (;;) {
        const bool has_next = S.next(ui + 1, nxt);
        const char* nA = has_next ? nxt.A : cA; const char* nB = has_next ? nxt.B : cB;
        if (has_next) {
#pragma unroll
            for (int q = 0; q < 4; ++q) noff[q] = S.arow(nxt, R0 + 64 * q) + ca;
        } else {
#pragma unroll
            for (int q = 0; q < 4; ++q) noff[q] = coff[q];
        }
#pragma unroll 1
        for (int t = 0; t < nt; t += 2) {
            const bool last = (t == nt - 2);
            const unsigned k1 = (unsigned)(t + 1) * kstepA;
            const char* a2 = last ? nA : cA; const unsigned k2 = last ? 0u : (unsigned)(t + 2) * kstepA, k3 = k2 + kstepA;
            unsigned o2[4];
#pragma unroll
            for (int q = 0; q < 4; ++q) o2[q] = last ? noff[q] : coff[q];
            const char* b2 = last ? nB : cB + (size_t)(t + 2) * kstepB; const char* b3 = b2 + kstepB;
            GM_LDB(B0, 0, 0); GM_LDB(B1, 0, 1); GM_SCHED; GM_LDA(At, 0, 0); GM_STAGEA(GM_SA(1, 1), cA, coff, 1, k1);
            GM_WAIT_V(8); GM_WAIT_L(0); GM_BAR; GM_MMA(0, 0, At, B0); GM_MMA(0, 1, At, B1); GM_BAR; GM_SCHED;
            GM_LDA(At, 0, 1); GM_STAGEB(GM_SB(0, 0), b2); GM_STAGEB(GM_SB(0, 1), b2 + hstepB); GM_STAGEA(GM_SA(0, 0), a2, o2, 0, k2);
            GM_WAIT_V(8); GM_WAIT_L(0); GM_BAR; GM_MMA(1, 0, At, B0); GM_MMA(1, 1, At, B1); GM_BAR; GM_SCHED;
            GM_LDB(B0, 1, 0); GM_LDB(B1, 1, 1); GM_SCHED; GM_LDA(At, 1, 0); GM_STAGEA(GM_SA(0, 1), a2, o2, 1, k2);
            GM_WAIT_V(8); GM_WAIT_L(0); GM_BAR; GM_MMA(0, 0, At, B0); GM_MMA(0, 1, At, B1); GM_BAR; GM_SCHED;
            GM_LDA(At, 1, 1); GM_STAGEB(GM_SB(1, 0), b3); GM_STAGEB(GM_SB(1, 1), b3 + hstepB); GM_STAGEA(GM_SA(1, 0), a2, o2, 0, k3);
            GM_WAIT_V(8); GM_WAIT_L(0); GM_BAR; GM_MMA(1, 0, At, B0); GM_MMA(1, 1, At, B1); GM_BAR; GM_SCHED;
        }
        if (wr == 0) GM_BAR;
        E(acc, cur, wr, wc, fr, fq);
        if (!has_next) break;
#pragma unroll
        for (int a = 0; a < 2; ++a)
#pragma unroll
            for (int b = 0; b < 2; ++b)
#pragma unroll
                for (int m = 0; m < 4; ++m)
#pragma unroll
                    for (int n = 0; n < 2; ++n) acc[a][b][m][n] = (f32x4){0.f, 0.f, 0.f, 0.f};
        cur = nxt; cA = nA; cB = nB; ++ui;
#pragma unroll
        for (int q = 0; q < 4; ++q) coff[q] = noff[q];
        if (wr == 1) GM_BAR;
    }
    GM_WAIT_V(0);
    GM_BAR;
#undef GM_SA
#undef GM_SB
#undef GM_STAGEA
#undef GM_STAGEB
#undef GM_LDA
#undef GM_LDB
#undef GM_MMA
#undef GM_WAIT_V
#undef GM_WAIT_L
#undef GM_BAR
#undef GM_SCHED
}

struct EpiBf16 {
    static constexpr bool PERM = true;
    bf16_t* O; int ldc;
    __device__ __forceinline__ void operator()(const f32x4 (&acc)[2][2][4][2], const Unit& u, int wr, int wc, int fr, int fq) const {
        const int row0 = u.pm * BM + wr * 64 + fr, col0 = u.pn * BM + wc * 32 + 8 * fq;
#pragma unroll
        for (int ai = 0; ai < 2; ++ai)
#pragma unroll
            for (int m = 0; m < 4; ++m) { bf16_t* rowp = O + (size_t)(row0 + ai * HALF + m * 16) * ldc + col0;
#pragma unroll
                for (int bj = 0; bj < 2; ++bj) { const f32x4 v0 = acc[ai][bj][m][0], v1 = acc[ai][bj][m][1];
                    v4u w; w.x = cvt_pk_bf16(v0[0], v0[1]); w.y = cvt_pk_bf16(v0[2], v0[3]); w.z = cvt_pk_bf16(v1[0], v1[1]); w.w = cvt_pk_bf16(v1[2], v1[3]);
                    *(v4u*)(rowp + bj * HALF) = w; } }
    }
};
struct EpiRes {
    static constexpr bool PERM = false;
    const float* x; const float* mod; int chunk; float* out;
    __device__ __forceinline__ void operator()(const f32x4 (&acc)[2][2][4][2], const Unit& u, int wr, int wc, int fr, int fq) const {
        const int row0 = u.pm * BM + wr * 64 + fr, col0 = u.pn * BM + wc * 32 + 4 * fq; const int b = (u.pm * BM) / SEQ;
        f32x4 gv[2][2];
#pragma unroll
        for (int bj = 0; bj < 2; ++bj)
#pragma unroll
            for (int n = 0; n < 2; ++n) gv[bj][n] = *(const f32x4*)(mod + (size_t)b * 6144 + chunk * 1024 + col0 + bj * HALF + n * 16);
#pragma unroll
        for (int ai = 0; ai < 2; ++ai)
#pragma unroll
            for (int m = 0; m < 4; ++m) { const size_t off = (size_t)(row0 + ai * HALF + m * 16) * 1024 + col0;
#pragma unroll
                for (int bj = 0; bj < 2; ++bj)
#pragma unroll
                    for (int n = 0; n < 2; ++n) { const f32x4 xv = *(const f32x4*)(x + off + bj * HALF + n * 16); *(f32x4*)(out + off + bj * HALF + n * 16) = xv + gv[bj][n] * acc[ai][bj][m][n]; } }
    }
};
}
#ifndef PROBE_REP
#define PROBE_REP -1
#endif
#ifndef PROBE_P3
#define PROBE_P3 0
#endif
constexpr int RING_BYTES = 131072, LDSCTL_OFF = RING_BYTES, MISC_OFF = LDSCTL_OFF + 320, LDS_BYTES = 147456;
constexpr float WGU_SCALE = 32.0f, WDN_SCALE = 16.0f, ACT_SCALE = 8.0f;
constexpr int CW_BAR = 4096;
constexpr int CW_ECNT = 65536;

struct Args { const float* in[25]; float* out; unsigned char* ws; int ph_lo, ph_hi, rep, pad; };
struct Frame {
    LAS unsigned char* lds; volatile LAS unsigned* MISC; unsigned* ctl; unsigned char* ws;
    int tid, lane, wave, vcu, G;
    const float* in[25]; float* out;
};
#define IN_X 0
#define IN_C 1
#define IN_WADA 2
#define IN_BADA 3
#define IN_N1G 4
#define IN_WIN 5
#define IN_LBL 6
#define IN_HNG 7
#define IN_PEK 8
#define IN_W1K 9
#define IN_B1K 10
#define IN_W2K 11
#define IN_PEV 12
#define IN_W1V 13
#define IN_B1V 14
#define IN_W2V 15
#define IN_WOUT 16
#define IN_N2G 17
#define IN_RW 18
#define IN_RB 19
#define IN_WGU 20
#define IN_WDN 21
#define IN_WSGU 22
#define IN_WSDN 23
#define IN_FG 24

template <bool FRAG = false, bool F8 = false> __device__ __forceinline__ void p0_transpose_item(const float* W, int K, int N, bf16_t* WT, int drow0, int k0, int n0, LAS float* scr, int lane, float f8scale = 1.0f) {
    const int kq = lane >> 3, nq = lane & 7; const int nn = n0 + 4 * nq; const bool ok = nn < N;
    f32x4 v[8];
#pragma unroll
    for (int i = 0; i < 8; ++i) v[i] = ok ? *(const f32x4*)(W + (size_t)(k0 + 8 * i + kq) * N + nn) : (f32x4){0.f, 0.f, 0.f, 0.f};
#pragma unroll
    for (int i = 0; i < 8; ++i) { LAS float* d = scr + (8 * i + kq) * 33 + 4 * nq; d[0] = v[i][0]; d[1] = v[i][1]; d[2] = v[i][2]; d[3] = v[i][3]; }
    LDS_WAIT(); asm volatile("" ::: "memory");
    const int c = lane & 7;
#pragma unroll
    for (int j = 0; j < 4; ++j) { const int n = (lane >> 3) + 8 * j; const LAS float* s = scr + (8 * c) * 33 + n;
        v4u o; o.x = pk2(s[0 * 33], s[1 * 33]); o.y = pk2(s[2 * 33], s[3 * 33]); o.z = pk2(s[4 * 33], s[5 * 33]); o.w = pk2(s[6 * 33], s[7 * 33]);
        if (F8) { *(v2u*)((unsigned char*)WT + (size_t)(drow0 + n) * K + k0 + 8 * c) = (v2u){pk4_e4m3(s[0 * 33], s[1 * 33], s[2 * 33], s[3 * 33], f8scale), pk4_e4m3(s[4 * 33], s[5 * 33], s[6 * 33], s[7 * 33], f8scale)}; }
        else if (FRAG) { const int kk = k0 + 8 * c, col = drow0 + n; *(v4u*)(WT + ((size_t)((kk >> 5) * (N / 16) + (col >> 4)) * 64 + ((kk & 31) >> 3) * 16 + (col & 15)) * 8) = o; }
        else *(v4u*)(WT + (size_t)(drow0 + n) * K + k0 + 8 * c) = o; }
    LDS_WAIT(); asm volatile("" ::: "memory");
}
__device__ __forceinline__ int gu_row(int n) { const int j = n & 255; return (j >> 7) * 256 + ((n >> 8) << 7) + (j & 127); }

__device__ __forceinline__ void p0_prologue(Frame& F) {
    unsigned char* ws = F.ws;
    if (F.vcu < 256) {
        LAS float* ca = (LAS float*)F.lds;
        const int ks = F.vcu >> 4, cg = F.vcu & 15;
        if (F.tid < 256) { const int b = F.tid >> 6, k = F.tid & 63; ca[F.tid] = fsilu(F.in[IN_C][b * D + ks * 64 + k]); }
        __syncthreads();
        if (F.tid < 384) { const int n = cg * 384 + F.tid; const float* w = F.in[IN_WADA] + (size_t)(ks * 64) * 6144 + n; float a0 = 0.f, a1 = 0.f, a2 = 0.f, a3 = 0.f;
#pragma unroll 8
            for (int k = 0; k < 64; ++k) { const float wv = w[(size_t)k * 6144]; a0 += ca[k] * wv; a1 += ca[64 + k] * wv; a2 += ca[128 + k] * wv; a3 += ca[192 + k] * wv; }
            float* mp = (float*)(ws + WS_MODP) + (size_t)ks * 4 * 6144 + n; mp[0] = a0; mp[6144] = a1; mp[2 * 6144] = a2; mp[3 * 6144] = a3; }
        __syncthreads();
    }
    { float* cs = (float*)(ws + WS_CS); float* sn = (float*)(ws + WS_SN);
      for (int i = F.vcu * NTHR + F.tid; i < SEQ * 32; i += F.G * NTHR) { const int pos = i >> 5, k = i & 31; const float inv = powf(10000.0f, -(float)k / 32.0f); const float ang = (float)pos * inv; cs[i] = cosf(ang); sn[i] = sinf(ang); } }
    LAS float* scr = (LAS float*)(F.lds + 4096 + F.wave * 8704);
    const int gw = F.vcu * NWAVES + F.wave, NGW = F.G * NWAVES;
    constexpr int I_IN = 16 * 105, I_OUT = 16 * 32, I_GU = 16 * 16, I_DN = 4 * 32, I_W1 = 32 * 8;
    constexpr int NIT = I_IN + I_OUT + 64 * I_GU + 64 * I_DN + I_GU + I_DN + 2 * I_W1;
    for (int it = gw; it < NIT; it += NGW) {
        int r = it;
        if (r < I_IN) { const int kb = r / 105, nb = r % 105; p0_transpose_item(F.in[IN_WIN], 1024, INC, (bf16_t*)(ws + WS_WINT), 32 * nb, 64 * kb, 32 * nb, scr, F.lane); continue; } r -= I_IN;
        if (r < I_OUT) { const int kb = r / 32, nb = r % 32; p0_transpose_item(F.in[IN_WOUT], 1024, 1024, (bf16_t*)(ws + WS_WOUTT), 32 * nb, 64 * kb, 32 * nb, scr, F.lane); continue; } r -= I_OUT;
        if (r < 64 * I_GU) { const int e = r / I_GU, q = r % I_GU, kb = q / 16, nb = q % 16;
            p0_transpose_item<false, true>(F.in[IN_WGU] + (size_t)e * 1024 * 512, 1024, 512, (bf16_t*)(ws + WS_WGUT + (size_t)e * 512 * 1024), gu_row(32 * nb), 64 * kb, 32 * nb, scr, F.lane, WGU_SCALE); continue; } r -= 64 * I_GU;
        if (r < 64 * I_DN) { const int e = r / I_DN, q = r % I_DN, kb = q / 32, nb = q % 32;
            p0_transpose_item<false, true>(F.in[IN_WDN] + (size_t)e * 256 * 1024, 256, 1024, (bf16_t*)(ws + WS_WDNT + (size_t)e * 1024 * 256), 32 * nb, 64 * kb, 32 * nb, scr, F.lane, WDN_SCALE); continue; } r -= 64 * I_DN;
        if (r < I_GU) { const int kb = r / 16, nb = r % 16; p0_transpose_item<false, true>(F.in[IN_WSGU], 1024, 512, (bf16_t*)(ws + WS_WSGUT), gu_row(32 * nb), 64 * kb, 32 * nb, scr, F.lane, WGU_SCALE); continue; } r -= I_GU;
        if (r < I_DN) { const int kb = r / 32, nb = r % 32; p0_transpose_item<false, true>(F.in[IN_WSDN], 256, 1024, (bf16_t*)(ws + WS_WSDNT), 32 * nb, 64 * kb, 32 * nb, scr, F.lane, WDN_SCALE); continue; } r -= I_DN;
        { const int kv = r / I_W1, q = r % I_W1, kb = q / 8, nb = q % 8;
          p0_transpose_item<true>(F.in[kv ? IN_W1V : IN_W1K], 2048, 256, (bf16_t*)(ws + (kv ? WS_W1VT : WS_W1KT)), 32 * nb, 64 * kb, 32 * nb, scr, F.lane); }
    }
    { v4u* z = (v4u*)((bf16_t*)(ws + WS_WINT) + (size_t)3360 * 1024); const int n16 = 224 * 1024 * 2 / 16;
      for (int i = F.vcu * NTHR + F.tid; i < n16; i += F.G * NTHR) z[i] = (v4u){0u, 0u, 0u, 0u}; }
    { bf16_t* w2f = (bf16_t*)(ws + WS_W2T);
      for (int i = F.vcu * NTHR + F.tid; i < 2 * 256 * 64; i += F.G * NTHR) { const int kv = i >> 14, r = i & 16383, k = r >> 6, dd = r & 63; const float v = F.in[kv ? IN_W2V : IN_W2K][r];
          w2f[(size_t)kv * 16384 + ((size_t)((k >> 5) * 4 + (dd >> 4)) * 64 + ((k & 31) >> 3) * 16 + (dd & 15)) * 8 + (k & 7)] = f2bf(v); } }
    { bf16_t* hi = (bf16_t*)(ws + WS_RW); bf16_t* lo = hi + 64 * 1024; const float* rw = F.in[IN_RW];
      for (int i = F.vcu * NTHR + F.tid; i < 64 * 1024; i += F.G * NTHR) { const int k = i >> 6, e = i & 63; const float w = rw[i]; const bf16_t h = f2bf(w);
          const size_t o = ((size_t)((k >> 5) * 4 + (e >> 4)) * 64 + ((k & 31) >> 3) * 16 + (e & 15)) * 8 + (k & 7); hi[o] = h; lo[o] = f2bf(w - bf2f(h)); } }
}

__device__ __forceinline__ void p1a_norm(Frame& F) {
    unsigned char* ws = F.ws; const float* modp = (const float*)(ws + WS_MODP); const float* bada = F.in[IN_BADA];
    for (int i = F.vcu * NTHR + F.tid; i < BATCH * 6144; i += F.G * NTHR) { float a = bada[i % 6144];
#pragma unroll
        for (int ks = 0; ks < 16; ++ks) a += modp[(size_t)ks * 4 * 6144 + i];
        ((float*)(ws + WS_MOD))[i] = a; }
    for (int o = F.vcu * NWAVES + F.wave; o < 512; o += F.G * NWAVES) { const int kv = o >> 8, j = o & 255; const float* pe = F.in[kv ? IN_PEV : IN_PEK];
        const bf16_t* wf = (const bf16_t*)(ws + (kv ? WS_W1VT : WS_W1KT)); float a = 0.f;
#pragma unroll
        for (int i = 0; i < 4; ++i) { const int cid = F.lane + 64 * i, s = cid >> 2, q = cid & 3; const v4u wv = *(const v4u*)(wf + ((size_t)(s * 16 + (j >> 4)) * 64 + q * 16 + (j & 15)) * 8);
            const f32x4 p0 = *(const f32x4*)(pe + 32 * s + 8 * q), p1 = *(const f32x4*)(pe + 32 * s + 8 * q + 4);
            a += bf2f((bf16_t)(wv.x & 0xffff)) * p0[0] + bf2f((bf16_t)(wv.x >> 16)) * p0[1] + bf2f((bf16_t)(wv.y & 0xffff)) * p0[2] + bf2f((bf16_t)(wv.y >> 16)) * p0[3]
               + bf2f((bf16_t)(wv.z & 0xffff)) * p1[0] + bf2f((bf16_t)(wv.z >> 16)) * p1[1] + bf2f((bf16_t)(wv.w & 0xffff)) * p1[2] + bf2f((bf16_t)(wv.w >> 16)) * p1[3]; }
        a = wave_sum(a); if (F.lane == 0) ((float*)(ws + WS_B1F))[o] = a + F.in[kv ? IN_B1V : IN_B1K][j]; }
    LAS float* sh = (LAS float*)F.lds; LAS float* sc = sh + 1024;
    const float* g1 = F.in[IN_N1G]; const float* x = F.in[IN_X]; bf16_t* xn = (bf16_t*)(ws + WS_XN);
    for (int chunk = F.vcu; chunk < T / 64; chunk += F.G) {
        const int b = (chunk * 64) / SEQ;
        __syncthreads();
        for (int i = F.tid; i < 2048; i += NTHR) { const int col = i; float a = bada[col];
#pragma unroll
            for (int ks = 0; ks < 16; ++ks) a += modp[(size_t)(ks * 4 + b) * 6144 + col];
            sh[i] = a; }
        __syncthreads();
#pragma unroll 1
        for (int rr = 0; rr < 8; ++rr) {
            const int row = chunk * 64 + F.wave * 8 + rr; const f32x4* xr = (const f32x4*)(x + (size_t)row * D) + F.lane;
            f32x4 v[4]; float s = 0.f;
#pragma unroll
            for (int j = 0; j < 4; ++j) { v[j] = xr[64 * j]; s += (v[j].x * v[j].x + v[j].y * v[j].y) + (v[j].z * v[j].z + v[j].w * v[j].w); }
            const float rstd = 1.0f / sqrtf(wave_sum(s) * (1.0f / D) + EPS);
            unsigned long long* o8 = (unsigned long long*)(xn + (size_t)row * D) + F.lane;
#pragma unroll
            for (int j = 0; j < 4; ++j) { const int c0 = 4 * F.lane + 256 * j; const f32x4 g = *(const f32x4*)(g1 + c0);
                const float h0 = v[j].x * rstd * g.x * (1.0f + sc[c0]) + sh[c0], h1 = v[j].y * rstd * g.y * (1.0f + sc[c0 + 1]) + sh[c0 + 1];
                const float h2 = v[j].z * rstd * g.z * (1.0f + sc[c0 + 2]) + sh[c0 + 2], h3 = v[j].w * rstd * g.w * (1.0f + sc[c0 + 3]) + sh[c0 + 3];
                o8[64 * j] = (unsigned long long)pk2(h0, h1) | ((unsigned long long)pk2(h2, h3) << 32); }
        }
    }
    __syncthreads();
}


__device__ __forceinline__ float hg_lb(const float* lbl, int j) { return 1.0f / (1.0f + expf(lbl[512 + j] - lbl[j])); }
__device__ __forceinline__ void hg_passA(Frame& F, int unit) {
    unsigned char* ws = F.ws; const bf16_t* proj = (const bf16_t*)(ws + WS_PROJ); float* U = (float*)(ws + WS_U) + (size_t)unit * 16384; float* Dd = (float*)(ws + WS_DD) + (size_t)unit * 128;
    const int b = unit >> 6, h = (unit >> 4) & 3, J = unit & 15; const size_t tok0 = (size_t)b * SEQ + 256 * J;
    const int d = F.tid & 127, g = F.tid >> 7;
    LAS unsigned char* KT = F.lds; LAS unsigned char* VT = F.lds + 65536; LAS float* segtot = (LAS float*)(F.lds + LDSCTL_OFF + 512);
    const float lb = hg_lb(F.in[IN_LBL], h * 128 + d);
    const bf16_t* pf = proj + (tok0 + 64 * g) * LDP + C_HF + h * 128 + d; const bf16_t* pv = proj + (tok0 + 64 * g) * LDP + C_HI + h * 128 + d;
    __syncthreads();
    float fs[64]; unsigned short vraw[64];
#pragma unroll
    for (int s = 0; s < 64; ++s) { fs[s] = bf2f(pf[(size_t)s * LDP]); vraw[s] = pv[(size_t)s * LDP]; }
    float sum = 0.f;
#pragma unroll
    for (int s = 0; s < 64; ++s) { const float f = lb + (1.0f - lb) * fsigmoid(fs[s]); fs[s] = f; sum += __logf(f); }
    segtot[g * 128 + d] = sum;
    __syncthreads();
    float off = 0.f, Bt = 0.f;
#pragma unroll
    for (int k = 0; k < 4; ++k) { const float v = segtot[k * 128 + d]; Bt += v; if (k < g) off += v; }
    float run = off;
#pragma unroll
    for (int s8 = 0; s8 < 8; ++s8) { unsigned kk[4], vv[4];
#pragma unroll
        for (int i = 0; i < 4; ++i) { float kt[2];
#pragma unroll
            for (int j = 0; j < 2; ++j) { const int s = 8 * s8 + 2 * i + j; const float f = fs[s]; run += __logf(f); kt[j] = (1.0f - f) * fexp(Bt - run); }
            kk[i] = pk2(kt[0], kt[1]); vv[i] = (unsigned)vraw[8 * s8 + 2 * i] | ((unsigned)vraw[8 * s8 + 2 * i + 1] << 16); }
        const int c = (8 * g + s8) ^ (d & 31);
        *(LAS v4u*)(KT + d * 512 + c * 16) = (v4u){kk[0], kk[1], kk[2], kk[3]}; *(LAS v4u*)(VT + d * 512 + c * 16) = (v4u){vv[0], vv[1], vv[2], vv[3]}; }
    if (g == 0) Dd[d] = fexp(Bt);
    __syncthreads();
    const int dt = F.wave >> 1, et0 = 2 * (F.wave & 1), i = F.lane & 31, hh = F.lane >> 5;
    f32x16 acc[2];
#pragma unroll
    for (int k = 0; k < 16; ++k) { acc[0][k] = 0.f; acc[1][k] = 0.f; }
#pragma unroll 4
    for (int st = 0; st < 16; ++st) { const int ch = 2 * st + hh;
        const bf16x8 a = *(const LAS bf16x8*)(KT + (32 * dt + i) * 512 + ((ch ^ i) & 31) * 16);
#pragma unroll
        for (int t = 0; t < 2; ++t) { const bf16x8 bv = *(const LAS bf16x8*)(VT + (32 * (et0 + t) + i) * 512 + ((ch ^ i) & 31) * 16);
            acc[t] = __builtin_amdgcn_mfma_f32_32x32x16_bf16(a, bv, acc[t], 0, 0, 0); } }
#pragma unroll
    for (int t = 0; t < 2; ++t)
#pragma unroll
        for (int r = 0; r < 16; ++r) U[(size_t)(32 * dt + (r & 3) + 8 * (r >> 2) + 4 * hh) * 128 + 32 * (et0 + t) + i] = acc[t][r];
    __syncthreads();
}
__device__ __forceinline__ unsigned short bf16_rne(float x) { return (unsigned short)(cvt_pk_bf16(x, 0.f) & 0xffffu); }
__device__ __forceinline__ void hg_passC(Frame& F, int unit) {
    unsigned char* ws = F.ws; const bf16_t* proj = (const bf16_t*)(ws + WS_PROJ); bf16_t* mix = (bf16_t*)(ws + WS_MIX);
    const float* Uall = (const float*)(ws + WS_U); const float* Dall = (const float*)(ws + WS_DD);
    const int b = unit >> 6, h = (unit >> 4) & 3, J = unit & 15; const size_t tok0 = (size_t)b * SEQ + 256 * J;
    const int w = F.wave, n = F.lane & 15, q = F.lane >> 4;
    LAS bf16_t* QS = (LAS bf16_t*)F.lds; LAS bf16_t* KH = (LAS bf16_t*)(F.lds + 17408); LAS bf16_t* KT = (LAS bf16_t*)(F.lds + 34816); LAS bf16_t* VT = (LAS bf16_t*)(F.lds + 59392);
    LAS float* G = (LAS float*)(F.lds + 83968); LAS unsigned char* PT = F.lds + 86016; LAS float* SSP = (LAS float*)(F.lds + 88064);
    f32x4 S[8];
#pragma unroll
    for (int dt = 0; dt < 8; ++dt) S[dt] = (f32x4){0.f, 0.f, 0.f, 0.f};
    {
        LAS float* WJ = (LAS float*)F.lds;
        __syncthreads();
        if (F.tid < 128) { float dv[16];
#pragma unroll
            for (int j = 0; j < 16; ++j) dv[j] = (j < J) ? Dall[(size_t)(unit - J + j) * 128 + F.tid] : 1.0f;
            float wgt = 1.0f;
#pragma unroll
            for (int j = 15; j >= 0; --j) { if (j < J) { WJ[j * 128 + F.tid] = wgt; wgt *= dv[j]; } } }
        __syncthreads();
#pragma unroll 4
        for (int j = 0; j < J; ++j) { const float* Uj = Uall + (size_t)(unit - J + j) * 16384;
#pragma unroll
            for (int dt = 0; dt < 8; ++dt) { const f32x4 wv = *(const LAS f32x4*)(WJ + j * 128 + 16 * dt + 4 * q);
#pragma unroll
                for (int r = 0; r < 4; ++r) S[dt][r] += wv[r] * Uj[(size_t)(16 * dt + 4 * q + r) * 128 + 16 * w + n]; } }
        __syncthreads();
    }
    const int d = F.tid & 127, bk = F.tid >> 7; const float lb = hg_lb(F.in[IN_LBL], h * 128 + d);
    const int e0 = h * 128 + 16 * w + 4 * q; const f32x4 ng = *(const f32x4*)(F.in[IN_HNG] + e0);
    unsigned short rf[16], rq[16], rv[16]; v2u rg[4];
#define HG_LOAD(qt_) do { const bf16_t* pr_ = proj + (tok0 + 64 * (qt_) + 16 * bk) * LDP + h * 128 + d; \
        _Pragma("unroll") for (int i = 0; i < 16; ++i) { rf[i] = pr_[(size_t)i * LDP + C_HF]; rq[i] = pr_[(size_t)i * LDP + C_HQ]; rv[i] = pr_[(size_t)i * LDP + C_HI]; } \
        _Pragma("unroll") for (int bb = 0; bb < 4; ++bb) rg[bb] = *(const v2u*)(proj + (tok0 + 64 * (qt_) + 16 * bb + n) * LDP + C_HGT + e0); } while (0)
    HG_LOAD(0);
#pragma unroll 1
    for (int qt = 0; qt < 4; ++qt) {
        const size_t t0 = tok0 + 64 * qt;
        { float fv[16], E[16]; float run = 1.f;
#pragma unroll
          for (int i = 0; i < 16; ++i) { const float f = lb + (1.0f - lb) * fsigmoid(bf2f(rf[i])); fv[i] = f; run *= f; E[i] = run; }
          const float cc = run; unsigned kt[8], vv[8];
#pragma unroll
          for (int i = 0; i < 16; ++i) { const float inv = __builtin_amdgcn_rcpf(E[i]), kf = 1.0f - fv[i];
              QS[(bk * 16 + i) * 136 + d] = bf16_rne(bf2f(rq[i]) * 0.08838834764831845f * E[i]); KH[(bk * 16 + i) * 136 + d] = bf16_rne(kf * inv);
              const unsigned kb = bf16_rne(kf * cc * inv);
              if (i & 1) { kt[i >> 1] |= kb << 16; vv[i >> 1] |= (unsigned)rv[i] << 16; } else { kt[i >> 1] = kb; vv[i >> 1] = rv[i]; } }
          LAS v4u* kp = (LAS v4u*)(KT + (bk * 128 + d) * 24); kp[0] = (v4u){kt[0], kt[1], kt[2], kt[3]}; kp[1] = (v4u){kt[4], kt[5], kt[6], kt[7]};
          LAS v4u* vp = (LAS v4u*)(VT + (bk * 128 + d) * 24); vp[0] = (v4u){vv[0], vv[1], vv[2], vv[3]}; vp[1] = (v4u){vv[4], vv[5], vv[6], vv[7]};
          G[bk * 128 + d] = cc; }
        v2u gq[4];
#pragma unroll
        for (int bb = 0; bb < 4; ++bb) gq[bb] = rg[bb];
        if (qt < 3) HG_LOAD(qt + 1);
        __syncthreads();
        if (w < 4) { f32x4 pt = (f32x4){0.f, 0.f, 0.f, 0.f};
#pragma unroll
            for (int st = 0; st < 4; ++st) { const bf16x8 a = *(const LAS bf16x8*)(KH + (w * 16 + n) * 136 + 32 * st + 8 * q), bq = *(const LAS bf16x8*)(QS + (w * 16 + n) * 136 + 32 * st + 8 * q);
                pt = __builtin_amdgcn_mfma_f32_16x16x32_bf16(a, bq, pt, 0, 0, 0); }
            v2u o; o.x = cvt_pk_bf16((4 * q + 0) <= n ? pt[0] : 0.f, (4 * q + 1) <= n ? pt[1] : 0.f); o.y = cvt_pk_bf16((4 * q + 2) <= n ? pt[2] : 0.f, (4 * q + 3) <= n ? pt[3] : 0.f);
            *(LAS v2u*)(PT + (w * 64 + F.lane) * 8) = o; }
        __syncthreads();
        f32x4 ob[4]; float ssb[4];
#pragma unroll
        for (int bb = 0; bb < 4; ++bb) {
            f32x4 o = (f32x4){0.f, 0.f, 0.f, 0.f};
#pragma unroll
            for (int st = 0; st < 4; ++st) {
                const v2u s0 = (v2u){cvt_pk_bf16(S[2 * st][0], S[2 * st][1]), cvt_pk_bf16(S[2 * st][2], S[2 * st][3])}, s1 = (v2u){cvt_pk_bf16(S[2 * st + 1][0], S[2 * st + 1][1]), cvt_pk_bf16(S[2 * st + 1][2], S[2 * st + 1][3])};
                const bf16x8 a = __builtin_bit_cast(bf16x8, (v4u){s0.x, s0.y, s1.x, s1.y});
                const v2u q0 = *(const LAS v2u*)(QS + (bb * 16 + n) * 136 + 32 * st + 4 * q), q1 = *(const LAS v2u*)(QS + (bb * 16 + n) * 136 + 32 * st + 16 + 4 * q);
                const bf16x8 bq = __builtin_bit_cast(bf16x8, (v4u){q0.x, q0.y, q1.x, q1.y});
                o = __builtin_amdgcn_mfma_f32_16x16x32_bf16(a, bq, o, 0, 0, 0); }
            { const v2u va = *(const LAS v2u*)(VT + (bb * 128 + 16 * w + n) * 24 + 4 * q); const bf16x8 a = __builtin_bit_cast(bf16x8, (v4u){va.x, va.y, 0u, 0u});
              const v2u pb = *(const LAS v2u*)(PT + (bb * 64 + F.lane) * 8); const bf16x8 pB = __builtin_bit_cast(bf16x8, (v4u){pb.x, pb.y, 0u, 0u});
              o = __builtin_amdgcn_mfma_f32_16x16x32_bf16(a, pB, o, 0, 0, 0); }
            { bf16x8 bv; if (q < 2) bv = *(const LAS bf16x8*)(VT + (bb * 128 + 16 * w + n) * 24 + 8 * q); else bv = (bf16x8){0, 0, 0, 0, 0, 0, 0, 0};
#pragma unroll
              for (int dt = 0; dt < 8; ++dt) { const f32x4 gv = *(const LAS f32x4*)(G + bb * 128 + 16 * dt + 4 * q); S[dt] = S[dt] * gv;
                  bf16x8 a; if (q < 2) a = *(const LAS bf16x8*)(KT + (bb * 128 + 16 * dt + n) * 24 + 8 * q); else a = (bf16x8){0, 0, 0, 0, 0, 0, 0, 0};
                  S[dt] = __builtin_amdgcn_mfma_f32_16x16x32_bf16(a, bv, S[dt], 0, 0, 0); } }
            float ss = (o[0] * o[0] + o[1] * o[1]) + (o[2] * o[2] + o[3] * o[3]); ss += __shfl_xor(ss, 16); ss += __shfl_xor(ss, 32);
            ob[bb] = o; ssb[bb] = ss;
        }
        if (q == 0) {
#pragma unroll
            for (int bb = 0; bb < 4; ++bb) SSP[w * 64 + 16 * bb + n] = ssb[bb]; }
        __syncthreads();
#pragma unroll
        for (int bb = 0; bb < 4; ++bb) { float tots = 0.f;
#pragma unroll
            for (int k = 0; k < 8; ++k) tots += SSP[k * 64 + 16 * bb + n];
            const float rstd = 1.0f / sqrtf(tots * (1.0f / 128.0f) + EPS); const v2u gt = gq[bb];
            const float g0 = bf2f((bf16_t)(gt.x & 0xffff)), g1 = bf2f((bf16_t)(gt.x >> 16)), g2 = bf2f((bf16_t)(gt.y & 0xffff)), g3 = bf2f((bf16_t)(gt.y >> 16));
            v2u ov; ov.x = cvt_pk_bf16(ob[bb][0] * rstd * ng[0] * fsilu(g0), ob[bb][1] * rstd * ng[1] * fsilu(g1)); ov.y = cvt_pk_bf16(ob[bb][2] * rstd * ng[2] * fsilu(g2), ob[bb][3] * rstd * ng[3] * fsilu(g3));
            *(v2u*)(mix + (t0 + 16 * bb + n) * D + e0) = ov; }
    }
#undef HG_LOAD
    __syncthreads();
}

constexpr int LG_P = 65;
__device__ __forceinline__ void p5_router(Frame& F) {
    unsigned char* ws = F.ws; const float* x2 = (const float*)(ws + WS_X2); const float* mod = (const float*)(ws + WS_MOD); const float* g2 = F.in[IN_N2G];
    const bf16_t* rwh = (const bf16_t*)(ws + WS_RW); const bf16_t* rwl = rwh + 64 * 1024; bf16_t* H2 = (bf16_t*)(ws + WS_H2);
    int* TOPI = (int*)(ws + WS_TOPI); float* TOPW = (float*)(ws + WS_TOPW); int* ROWL = (int*)(ws + WS_ROWL); int* ERANK = (int*)(ws + WS_ERANK); unsigned* ECNT = F.ctl + CW_ECNT;
    LAS float* LG = (LAS float*)F.lds;
    LAS float* GS = LG + 64 * LG_P;
    LAS float* WSL = GS + 512;
    LAS int* EI = (LAS int*)(WSL + 512);
    LAS unsigned* LCNT = (LAS unsigned*)(EI + 512);
    LAS unsigned* LBASE = LCNT + 64;
    LAS float* GSL = (LAS float*)(LBASE + 64);
    LAS float* SHL = GSL + 1024;
    const int r = F.lane & 15, q = F.lane >> 4, rt = F.wave & 3, eh = F.wave >> 2;
    for (int unit = F.vcu; unit < T / 64; unit += F.G) {
        const int row0 = unit * 64, b = row0 / SEQ, row = row0 + 16 * rt + r;
        __syncthreads();
        if (F.tid < 64) LCNT[F.tid] = 0u;
        for (int k = F.tid; k < 1024; k += NTHR) { GSL[k] = g2[k] * (1.0f + mod[(size_t)b * 6144 + 4 * 1024 + k]); SHL[k] = mod[(size_t)b * 6144 + 3 * 1024 + k]; }
        const float* xr = x2 + (size_t)row * D + 8 * q;
        float ss = 0.f;
#pragma unroll 8
        for (int s = 0; s < 32; ++s) { const f32x4 a = *(const f32x4*)(xr + 32 * s), c = *(const f32x4*)(xr + 32 * s + 4); ss += (a.x * a.x + a.y * a.y) + (a.z * a.z + a.w * a.w) + (c.x * c.x + c.y * c.y) + (c.z * c.z + c.w * c.w); }
        ss += __shfl_xor(ss, 16); ss += __shfl_xor(ss, 32);
        const float rstd = 1.0f / sqrtf(ss * (1.0f / D) + EPS);
        __syncthreads();
#ifndef PROBE_R7
#define PROBE_R7 0
#endif
        f32x4 acc[2];
        for (int rep7_ = 0; rep7_ <= PROBE_R7; ++rep7_) {
        acc[0] = (f32x4){0.f, 0.f, 0.f, 0.f}; acc[1] = acc[0];
        const bf16_t* rwh0 = rwh + ((size_t)(2 * eh) * 64 + F.lane) * 8; const bf16_t* rwl0 = rwl + ((size_t)(2 * eh) * 64 + F.lane) * 8;
#pragma unroll 1
        for (int s4 = 0; s4 < 32; s4 += 4) {
            f32x4 xa[4][2]; bf16x8 bh[4][2], bl[4][2];
#pragma unroll
            for (int u = 0; u < 4; ++u) { const int s = s4 + u; xa[u][0] = *(const f32x4*)(xr + 32 * s); xa[u][1] = *(const f32x4*)(xr + 32 * s + 4);
                bh[u][0] = *(const bf16x8*)(rwh0 + (size_t)s * 2048); bl[u][0] = *(const bf16x8*)(rwl0 + (size_t)s * 2048); bh[u][1] = *(const bf16x8*)(rwh0 + (size_t)s * 2048 + 512); bl[u][1] = *(const bf16x8*)(rwl0 + (size_t)s * 2048 + 512); }
            __builtin_amdgcn_sched_barrier(0);
#pragma unroll
            for (int u = 0; u < 4; ++u) { const int s = s4 + u; float gv[8], sh[8];
                *(f32x4*)&gv[0] = *(const LAS f32x4*)(GSL + 32 * s + 8 * q); *(f32x4*)&gv[4] = *(const LAS f32x4*)(GSL + 32 * s + 8 * q + 4);
                *(f32x4*)&sh[0] = *(const LAS f32x4*)(SHL + 32 * s + 8 * q); *(f32x4*)&sh[4] = *(const LAS f32x4*)(SHL + 32 * s + 8 * q + 4);
                bf16x8 ahi, alo; float hf[8];
#pragma unroll
                for (int j = 0; j < 8; ++j) { const float h = xa[u][j >> 2][j & 3] * rstd * gv[j] + sh[j]; hf[j] = h; const bf16_t hb = f2bf(h); ahi[j] = (short)hb; alo[j] = (short)f2bf(h - bf2f(hb)); }
                if (eh == 0) *(v2u*)((unsigned char*)H2 + (size_t)row * D + 32 * s + 8 * q) = (v2u){pk4_e4m3(hf[0], hf[1], hf[2], hf[3], 1.0f), pk4_e4m3(hf[4], hf[5], hf[6], hf[7], 1.0f)};
                acc[0] = __builtin_amdgcn_mfma_f32_16x16x32_bf16(ahi, bh[u][0], acc[0], 0, 0, 0); acc[0] = __builtin_amdgcn_mfma_f32_16x16x32_bf16(ahi, bl[u][0], acc[0], 0, 0, 0); acc[0] = __builtin_amdgcn_mfma_f32_16x16x32_bf16(alo, bh[u][0], acc[0], 0, 0, 0);
                acc[1] = __builtin_amdgcn_mfma_f32_16x16x32_bf16(ahi, bh[u][1], acc[1], 0, 0, 0); acc[1] = __builtin_amdgcn_mfma_f32_16x16x32_bf16(ahi, bl[u][1], acc[1], 0, 0, 0); acc[1] = __builtin_amdgcn_mfma_f32_16x16x32_bf16(alo, bh[u][1], acc[1], 0, 0, 0); }
        }
        }
#pragma unroll
        for (int nt = 0; nt < 2; ++nt)
#pragma unroll
            for (int i = 0; i < 4; ++i) LG[(16 * rt + 4 * q + i) * LG_P + 32 * eh + 16 * nt + r] = acc[nt][i];
        __syncthreads();
        const int t = F.tid >> 3, g = F.tid & 7; const float* rb = F.in[IN_RB];
        float sc8[8], ch8[8]; float a1 = -3e38f, a2 = -3e38f;
#pragma unroll
        for (int j = 0; j < 8; ++j) { const float s_ = 1.0f / (1.0f + expf(-LG[t * LG_P + 8 * g + j])); sc8[j] = s_; const float c_ = s_ + rb[8 * g + j]; ch8[j] = c_; if (c_ > a1) { a2 = a1; a1 = c_; } else if (c_ > a2) a2 = c_; }
        GS[t * 8 + g] = a1 + a2;
        __syncthreads();
#pragma unroll
        for (int j = 0; j < 8; ++j) LG[t * LG_P + 8 * g + j] = ch8[j];
        int grank = 0; const float myg = GS[t * 8 + g];
#pragma unroll
        for (int k = 0; k < 8; ++k) { const float o = GS[t * 8 + k]; if (o > myg || (o == myg && k < g)) ++grank; }
        const bool gsel = grank < 4;
        const unsigned long long bal = __ballot(gsel); const unsigned gmask = (unsigned)(bal >> (F.lane & ~7)) & 0xffu;
        __syncthreads();
        if (gsel) {
            int rk[8];
#pragma unroll
            for (int j = 0; j < 8; ++j) rk[j] = 0;
            for (int k = 0; k < 8; ++k) { if (!((gmask >> k) & 1u)) continue;
#pragma unroll
                for (int jj = 0; jj < 8; ++jj) { const float o = LG[t * LG_P + 8 * k + jj]; const int oe = 8 * k + jj;
#pragma unroll
                    for (int j = 0; j < 8; ++j) { if (o > ch8[j] || (o == ch8[j] && oe < 8 * g + j)) ++rk[j]; } } }
#pragma unroll
            for (int j = 0; j < 8; ++j) if (rk[j] < 8) { WSL[t * 8 + rk[j]] = sc8[j]; EI[t * 8 + rk[j]] = 8 * g + j; }
        }
        __syncthreads();
        float wsum = 0.f;
#pragma unroll
        for (int k = 0; k < 8; ++k) wsum += WSL[t * 8 + k];
        const int e = EI[t * 8 + g]; const float w = WSL[t * 8 + g] / wsum * 2.5f;
        const int aid = (row0 + t) * 8 + g;
        TOPI[aid] = e; TOPW[aid] = w;
        const unsigned lp = atomicAdd((unsigned*)&LCNT[e], 1u);
        __syncthreads();
        if (F.tid < 64) { const unsigned c = LCNT[F.tid]; LBASE[F.tid] = c ? atomicAdd(&ECNT[F.tid], c) : 0u; }
        __syncthreads();
        { const unsigned rk = LBASE[e] + lp; ROWL[(size_t)e * T + rk] = aid; ERANK[aid] = (int)rk; }
    }
    __syncthreads();
}


struct MoeTabs { LAS unsigned* cnt; LAS unsigned* tstart; LAS unsigned short* tex; int ntr; };
__device__ __forceinline__ MoeTabs moe_tabs_build(Frame& F) {
    MoeTabs Tb; Tb.cnt = (LAS unsigned*)(F.lds + LDSCTL_OFF + 512); Tb.tstart = Tb.cnt + 64; Tb.tex = (LAS unsigned short*)(Tb.tstart + 68);
    __syncthreads();
    if (F.tid < 64) { unsigned c = __hip_atomic_load(F.ctl + CW_ECNT + F.tid, RLX_AGENT); Tb.cnt[F.tid] = c > (unsigned)T ? (unsigned)T : c; }
    __syncthreads();
    if (F.tid == 0) { unsigned a = 0; for (int e = 0; e < 64; ++e) { Tb.tstart[e] = a; a += (Tb.cnt[e] + 255u) >> 8; } Tb.tstart[64] = a; }
    __syncthreads();
    Tb.ntr = (int)Tb.tstart[64];
    for (int tau = F.tid; tau < Tb.ntr; tau += NTHR) { int e = 0; for (int k = 0; k < 64; ++k) if (Tb.tstart[k] <= (unsigned)tau) e = k; Tb.tex[tau] = (unsigned short)e; }
    __syncthreads();
    return Tb;
}
__device__ __forceinline__ int xcd_chunk(int L, int n) { const int q = n / 8, r = n % 8, xcd = L % 8, off = L / 8; return (xcd < r ? xcd * (q + 1) : r * (q + 1) + (xcd - r) * q) + off; }
struct GateUpSched {
    MoeTabs Tb; const char* H2; const char* Wgu; const char* Wsgu; const int* rowl; int G, c;
    __device__ __forceinline__ bool next(int i, gm::Unit& u) const {
        const int nun = 2 * Tb.ntr + 2 * (T / 256); const long L = (long)i * G + c; if (L >= nun) return false;
        const int w = xcd_chunk((int)L, nun); u.A = H2;
        if (w < 2 * Tb.ntr) { const int tau = w >> 1; u.pn = w & 1; u.e = Tb.tex[tau]; u.m0 = 256 * (tau - (int)Tb.tstart[u.e]); u.pm = tau; u.B = Wgu + (size_t)u.e * 512 * 1024 + (size_t)u.pn * 256 * 1024; }
        else { const int s = w - 2 * Tb.ntr; u.pm = s >> 1; u.pn = s & 1; u.e = 64; u.m0 = 256 * u.pm; u.B = Wsgu + (size_t)u.pn * 256 * 1024; }
        return true;
    }
    __device__ __forceinline__ unsigned arow(const gm::Unit& u, int r) const {
        if (u.e == 64) return (unsigned)(u.m0 + r) * 1024u;
        const int idx = u.m0 + r; const int aid = idx < (int)Tb.cnt[u.e] ? rowl[(size_t)u.e * T + idx] : 0;
        return (unsigned)(aid >> 3) * 1024u;
    }
};
struct EpiSwiglu {
    static constexpr bool PERM = true;
    unsigned char* act; unsigned char* acts;
    __device__ __forceinline__ void operator()(const f32x4 (&acc)[2][2][4][2], const gm::Unit& u, int wr, int wc, int fr, int fq) const {
        unsigned char* O = (u.e == 64 ? acts : act) + (size_t)(u.pm * 256 + wr * 64 + fr) * 256 + 128 * u.pn + wc * 32 + 8 * fq; const float is = 1.0f / WGU_SCALE;
#pragma unroll
        for (int ai = 0; ai < 2; ++ai)
#pragma unroll
            for (int m = 0; m < 4; ++m) { const f32x4 g0 = acc[ai][0][m][0] * is, g1 = acc[ai][0][m][1] * is, u0 = acc[ai][1][m][0] * is, u1 = acc[ai][1][m][1] * is;
                *(v2u*)(O + (size_t)(ai * 128 + m * 16) * 256) = (v2u){pk4_e4m3(fsilu(g0[0]) * u0[0], fsilu(g0[1]) * u0[1], fsilu(g0[2]) * u0[2], fsilu(g0[3]) * u0[3], ACT_SCALE),
                                                                      pk4_e4m3(fsilu(g1[0]) * u1[0], fsilu(g1[1]) * u1[1], fsilu(g1[2]) * u1[2], fsilu(g1[3]) * u1[3], ACT_SCALE)}; }
    }
};
struct DownSched {
    MoeTabs Tb; const char* act; const char* acts; const char* Wdn; const char* Wsdn; int G, c;
    __device__ __forceinline__ bool next(int i, gm::Unit& u) const {
        const int nun = 4 * Tb.ntr + 4 * (T / 256); const long L = (long)i * G + c; if (L >= nun) return false;
        const int w = xcd_chunk((int)L, nun);
        if (w < 4 * Tb.ntr) { const int tau = w >> 2; u.pn = w & 3; u.e = Tb.tex[tau]; u.m0 = 256 * (tau - (int)Tb.tstart[u.e]); u.pm = tau;
            u.A = act + (size_t)tau * 256 * 256; u.B = Wdn + (size_t)u.e * 1024 * 256 + (size_t)u.pn * 256 * 256; }
        else { const int s = w - 4 * Tb.ntr; u.pm = s >> 2; u.pn = s & 3; u.e = 64; u.m0 = 256 * u.pm; u.A = acts + (size_t)u.pm * 256 * 256; u.B = Wsdn + (size_t)u.pn * 256 * 256; }
        return true;
    }
    __device__ __forceinline__ unsigned arow(const gm::Unit&, int r) const { return (unsigned)r * 256u; }
};
typedef float f32x2_t __attribute__((ext_vector_type(2)));
__device__ __forceinline__ unsigned pk4_fp8(float a, float b, float c, float d) {
    a = fminf(fmaxf(a * 16.0f, -448.0f), 448.0f); b = fminf(fmaxf(b * 16.0f, -448.0f), 448.0f); c = fminf(fmaxf(c * 16.0f, -448.0f), 448.0f); d = fminf(fmaxf(d * 16.0f, -448.0f), 448.0f);
    int w = __builtin_amdgcn_cvt_pk_fp8_f32(a, b, 0, false); w = __builtin_amdgcn_cvt_pk_fp8_f32(c, d, w, true); return (unsigned)w;
}
struct EpiDown {
    static constexpr bool PERM = true;
    unsigned char* Y8; bf16_t* YS;
    __device__ __forceinline__ void operator()(const f32x4 (&acc)[2][2][4][2], const gm::Unit& u, int wr, int wc, int fr, int fq) const {
        const size_t off = (size_t)(u.pm * 256 + wr * 64 + fr) * 1024 + u.pn * 256 + wc * 32 + 8 * fq;
        if (u.e == 64) {
#pragma unroll
            for (int ai = 0; ai < 2; ++ai)
#pragma unroll
                for (int m = 0; m < 4; ++m)
#pragma unroll
                    for (int bj = 0; bj < 2; ++bj) { const f32x4 v0 = acc[ai][bj][m][0] * (1.0f / (WDN_SCALE * ACT_SCALE)), v1 = acc[ai][bj][m][1] * (1.0f / (WDN_SCALE * ACT_SCALE));
                        v4u w; w.x = cvt_pk_bf16(v0[0], v0[1]); w.y = cvt_pk_bf16(v0[2], v0[3]); w.z = cvt_pk_bf16(v1[0], v1[1]); w.w = cvt_pk_bf16(v1[2], v1[3]);
                        *(v4u*)(YS + off + (size_t)(ai * 128 + m * 16) * 1024 + bj * 128) = w; }
        } else {
#pragma unroll
            for (int ai = 0; ai < 2; ++ai)
#pragma unroll
                for (int m = 0; m < 4; ++m)
#pragma unroll
                    for (int bj = 0; bj < 2; ++bj) { const f32x4 v0 = acc[ai][bj][m][0] * (1.0f / (WDN_SCALE * ACT_SCALE)), v1 = acc[ai][bj][m][1] * (1.0f / (WDN_SCALE * ACT_SCALE));
                        *(v2u*)(Y8 + off + (size_t)(ai * 128 + m * 16) * 1024 + bj * 128) = (v2u){pk4_fp8(v0[0], v0[1], v0[2], v0[3]), pk4_fp8(v1[0], v1[1], v1[2], v1[3])}; }
        }
    }
};

__device__ __forceinline__ void p8_final(Frame& F) {
    unsigned char* ws = F.ws; const unsigned char* Y = (const unsigned char*)(ws + WS_Y); const bf16_t* YS = (const bf16_t*)(ws + WS_YS);
    const float* x2 = (const float*)(ws + WS_X2); const float* mod = (const float*)(ws + WS_MOD); const float* fg = F.in[IN_FG];
    const int* TOPI = (const int*)(ws + WS_TOPI); const float* TOPW = (const float*)(ws + WS_TOPW); const int* ERANK = (const int*)(ws + WS_ERANK);
    const MoeTabs Tb = moe_tabs_build(F);
    const int w = F.wave;
    for (int unit = F.vcu; unit < T / 64; unit += F.G) {
        const int row0 = unit * 64 + 8 * w, b = row0 / SEQ;
        const int aid = row0 * 8 + F.lane; const int e = TOPI[aid]; const float wl = TOPW[aid]; const unsigned prl = 256u * Tb.tstart[e] + (unsigned)ERANK[aid];
        v2u ybA[8]; v4u ysA; v2u ybB[8]; v4u ysB;
#define P10_LOAD(yb, ysb, rr_, sg_) do { const int t_ = row0 + (rr_); _Pragma("unroll") for (int sl = 0; sl < 8; ++sl) { const unsigned pr_ = (unsigned)__shfl((int)prl, (rr_) * 8 + sl); \
            yb[sl] = *(const v2u*)(Y + (size_t)pr_ * 1024 + (sg_) * 512 + 8 * F.lane); } \
            ysb = *(const v4u*)(YS + (size_t)t_ * 1024 + (sg_) * 512 + 8 * F.lane); } while (0)
#define P10_HALF(yb, ysb, rr_, sg_) do { const int t = row0 + (rr_); float moe[8]; \
            { const unsigned vw[4] = {ysb.x, ysb.y, ysb.z, ysb.w}; \
                _Pragma("unroll") for (int k = 0; k < 4; ++k) { moe[2 * k] = bf2f((bf16_t)(vw[k] & 0xffff)); moe[2 * k + 1] = bf2f((bf16_t)(vw[k] >> 16)); } } \
            _Pragma("unroll") for (int sl = 0; sl < 8; ++sl) { const float wgt = __shfl(wl, (rr_) * 8 + sl) * 0.0625f; \
                const f32x2_t d0 = __builtin_amdgcn_cvt_pk_f32_fp8((int)yb[sl].x, false), d1 = __builtin_amdgcn_cvt_pk_f32_fp8((int)yb[sl].x, true), d2 = __builtin_amdgcn_cvt_pk_f32_fp8((int)yb[sl].y, false), d3 = __builtin_amdgcn_cvt_pk_f32_fp8((int)yb[sl].y, true); \
                moe[0] += wgt * d0[0]; moe[1] += wgt * d0[1]; moe[2] += wgt * d1[0]; moe[3] += wgt * d1[1]; moe[4] += wgt * d2[0]; moe[5] += wgt * d2[1]; moe[6] += wgt * d3[0]; moe[7] += wgt * d3[1]; } \
            _Pragma("unroll") for (int h = 0; h < 2; ++h) { const int c0 = (sg_) * 512 + 8 * F.lane + 4 * h; \
                const f32x4 xv = *(const f32x4*)(x2 + (size_t)t * D + c0), gv = *(const f32x4*)(mod + (size_t)b * 6144 + 5 * 1024 + c0); \
                _Pragma("unroll") for (int j = 0; j < 4; ++j) { const float v = xv[j] + gv[j] * moe[4 * h + j]; x3[(sg_) * 8 + 4 * h + j] = v; ss += v * v; } } } while (0)
        P10_LOAD(ybA, ysA, 0, 0);
#pragma unroll 1
        for (int rr = 0; rr < 8; ++rr) {
            float x3[16]; float ss = 0.f;
            P10_LOAD(ybB, ysB, rr, 1);
            P10_HALF(ybA, ysA, rr, 0);
            if (rr < 7) P10_LOAD(ybA, ysA, rr + 1, 0);
            P10_HALF(ybB, ysB, rr, 1);
            const int t = row0 + rr;
            const float rstd = 1.0f / sqrtf(wave_sum(ss) * (1.0f / D) + EPS);
#pragma unroll
            for (int sg = 0; sg < 2; ++sg)
#pragma unroll
                for (int h = 0; h < 2; ++h) { const int c0 = sg * 512 + 8 * F.lane + 4 * h; const f32x4 gg = *(const f32x4*)(fg + c0); f32x4 o;
#pragma unroll
                    for (int j = 0; j < 4; ++j) o[j] = x3[sg * 8 + 4 * h + j] * rstd * gg[j];
                    *(f32x4*)(F.out + (size_t)t * D + c0) = o; }
        }
#undef P10_HALF
#undef P10_LOAD
    }
    __syncthreads();
}

__device__ __forceinline__ float fgelu_tanh(float z) { const float u = 0.7978845608028654f * (z + 0.044715f * z * z * z); const float e = __expf(2.0f * u); return 0.5f * z * (1.0f + (e - 1.0f) / (e + 1.0f)); }
__device__ __forceinline__ float fgelu_safe(float z) { const float u = 0.7978845608028654f * (z + 0.044715f * z * z * z); const float uc = fminf(fmaxf(u, -15.f), 15.f); const float e = fexp(2.0f * uc); return 0.5f * z * (1.0f + (e - 1.0f) / (e + 1.0f)); }

__device__ __forceinline__ void cmp_unit(Frame& F, int unit) {
    unsigned char* ws = F.ws; const bf16_t* proj = (const bf16_t*)(ws + WS_PROJ);
    const int kv = unit >> 6, mb = unit & 63; const bf16_t* W1T = (const bf16_t*)(ws + (kv ? WS_W1VT : WS_W1KT)); const int coloff = kv ? C_VC : C_KC;
    const float* b1f = (const float*)(ws + WS_B1F) + kv * 256;
    const int w = F.wave, n = F.lane & 15, q = F.lane >> 4;
    LAS bf16_t* HID = (LAS bf16_t*)F.lds;
    size_t base[2];
#pragma unroll
    for (int rt = 0; rt < 2; ++rt) { const int R = 32 * mb + 16 * rt + n, bg = R >> 8; int c = R & 255; if (c > 254) c = 254; base[rt] = ((size_t)(bg >> 1) * SEQ + 16 * c) * LDP + coloff + (bg & 1) * 64; }
    f32x4 acc[2][2];
#pragma unroll
    for (int rt = 0; rt < 2; ++rt)
#pragma unroll
        for (int ct = 0; ct < 2; ++ct) acc[rt][ct] = (f32x4){0.f, 0.f, 0.f, 0.f};
    __syncthreads();
#pragma unroll 1
    for (int s8 = 0; s8 < 64; s8 += 8) {
        bf16x8 a[8][2], bb[8][2];
#pragma unroll
        for (int u = 0; u < 8; ++u) { const int s = s8 + u, ltok = s >> 1, dd = 32 * (s & 1) + 8 * q;
#pragma unroll
            for (int rt = 0; rt < 2; ++rt) a[u][rt] = *(const bf16x8*)(proj + base[rt] + (size_t)ltok * LDP + dd);
#pragma unroll
            for (int ct = 0; ct < 2; ++ct) bb[u][ct] = *(const bf16x8*)(W1T + ((size_t)(s * 16 + 2 * w + ct) * 64 + F.lane) * 8); }
        __builtin_amdgcn_sched_barrier(0);
#pragma unroll
        for (int u = 0; u < 8; ++u)
#pragma unroll
            for (int rt = 0; rt < 2; ++rt)
#pragma unroll
                for (int ct = 0; ct < 2; ++ct) acc[rt][ct] = __builtin_amdgcn_mfma_f32_16x16x32_bf16(bb[u][ct], a[u][rt], acc[rt][ct], 0, 0, 0);
    }
#pragma unroll
    for (int rt = 0; rt < 2; ++rt)
#pragma unroll
        for (int ct = 0; ct < 2; ++ct) { const int col = 32 * w + 16 * ct + 4 * q; const f32x4 bv = *(const f32x4*)(b1f + col); const f32x4 v = acc[rt][ct] + bv;
            v2u o; o.x = cvt_pk_bf16(fgelu_safe(v[0]), fgelu_safe(v[1])); o.y = cvt_pk_bf16(fgelu_safe(v[2]), fgelu_safe(v[3]));
            *(LAS v2u*)(HID + (16 * rt + n) * 264 + col) = o; }
    __syncthreads();
    { const int rt = w & 1, ct = w >> 1; f32x4 o = (f32x4){0.f, 0.f, 0.f, 0.f};
      const bf16_t* w2f = (const bf16_t*)(ws + WS_W2T) + (size_t)kv * 16384;
#pragma unroll
      for (int s = 0; s < 8; ++s) { const bf16x8 a = *(const LAS bf16x8*)(HID + (16 * rt + n) * 264 + 32 * s + 8 * q); const bf16x8 bw = *(const bf16x8*)(w2f + ((size_t)(s * 4 + ct) * 64 + F.lane) * 8);
          o = __builtin_amdgcn_mfma_f32_16x16x32_bf16(bw, a, o, 0, 0, 0); }
      const int R = 32 * mb + 16 * rt + n, bg = R >> 8, c = R & 255, d0 = 16 * ct + 4 * q;
      if (c == 255) o = (f32x4){0.f, 0.f, 0.f, 0.f};
      if (kv == 0) { v2u ov; ov.x = cvt_pk_bf16(o[0], o[1]); ov.y = cvt_pk_bf16(o[2], o[3]); *(v2u*)((bf16_t*)(ws + WS_KCMP) + ((size_t)bg * 256 + c) * 64 + d0) = ov; }
      else { bf16_t* vt = (bf16_t*)(ws + WS_VCMPT) + (size_t)bg * 64 * 256 + c;
#pragma unroll
          for (int r = 0; r < 4; ++r) vt[(size_t)(d0 + r) * 256] = f2bf(o[r]); } }
    __syncthreads();
}

__device__ __forceinline__ void kv_prep_unit(Frame& F, int unit) {
    unsigned char* ws = F.ws; const bf16_t* proj = (const bf16_t*)(ws + WS_PROJ); const float* cs = (const float*)(ws + WS_CS); const float* sn = (const float*)(ws + WS_SN);
    const int b = unit >> 6, tile = unit & 63; const size_t tok0 = (size_t)b * SEQ + 64 * tile;
#pragma unroll
    for (int it = 0; it < 2; ++it) { const int id = F.tid + 512 * it; const int c = id & 3, g = (id >> 2) & 1, wh = (id >> 3) & 1, tk = id >> 4; const int pos = 64 * tile + tk;
        const bf16_t* src = proj + (tok0 + tk) * LDP + (wh ? C_KW : C_KS) + g * 64 + 8 * c; const v4u lo = *(const v4u*)src, hi = *(const v4u*)(src + 32);
        const f32x4 c0 = *(const f32x4*)(cs + pos * 32 + 8 * c), c1 = *(const f32x4*)(cs + pos * 32 + 8 * c + 4), s0 = *(const f32x4*)(sn + pos * 32 + 8 * c), s1 = *(const f32x4*)(sn + pos * 32 + 8 * c + 4);
        float a[8], bb[8], co[8], si[8];
        const unsigned lw[4] = {lo.x, lo.y, lo.z, lo.w}, hw[4] = {hi.x, hi.y, hi.z, hi.w};
#pragma unroll
        for (int k = 0; k < 4; ++k) { a[2 * k] = bf2f((bf16_t)(lw[k] & 0xffff)); a[2 * k + 1] = bf2f((bf16_t)(lw[k] >> 16)); bb[2 * k] = bf2f((bf16_t)(hw[k] & 0xffff)); bb[2 * k + 1] = bf2f((bf16_t)(hw[k] >> 16)); co[k] = c0[k]; co[4 + k] = c1[k]; si[k] = s0[k]; si[4 + k] = s1[k]; }
        unsigned olp[4], ohp[4];
#pragma unroll
        for (int k = 0; k < 4; ++k) { olp[k] = pk2(a[2 * k] * co[2 * k] - bb[2 * k] * si[2 * k], a[2 * k + 1] * co[2 * k + 1] - bb[2 * k + 1] * si[2 * k + 1]);
            ohp[k] = pk2(bb[2 * k] * co[2 * k] + a[2 * k] * si[2 * k], bb[2 * k + 1] * co[2 * k + 1] + a[2 * k + 1] * si[2 * k + 1]); }
        bf16_t* dst = (bf16_t*)(ws + (wh ? WS_KWR : WS_KSR)) + (((size_t)(b * 2 + g) * SEQ) + pos) * 64 + 8 * c; *(v4u*)dst = (v4u){olp[0], olp[1], olp[2], olp[3]}; *(v4u*)(dst + 32) = (v4u){ohp[0], ohp[1], ohp[2], ohp[3]}; }
    LAS bf16_t* TL = (LAS bf16_t*)F.lds;
    v4u vin[4];
#pragma unroll
    for (int m = 0; m < 4; ++m) { const int wh = m >> 1, g = m & 1, tk = F.tid >> 3, c = F.tid & 7; vin[m] = *(const v4u*)(proj + (tok0 + tk) * LDP + (wh ? C_VW : C_VS) + g * 64 + 8 * c); }
#pragma unroll
    for (int m = 0; m < 4; ++m) { const int wh = m >> 1, g = m & 1;
        __syncthreads();
        { const int tk = F.tid >> 3, c = F.tid & 7; *(LAS v4u*)(TL + tk * 72 + 8 * c) = vin[m]; }
        __syncthreads();
        { const int d = F.tid >> 3, sc = F.tid & 7; unsigned short e[8];
#pragma unroll
          for (int i = 0; i < 8; ++i) e[i] = TL[(8 * sc + i) * 72 + d];
          v4u o; o.x = e[0] | ((unsigned)e[1] << 16); o.y = e[2] | ((unsigned)e[3] << 16); o.z = e[4] | ((unsigned)e[5] << 16); o.w = e[6] | ((unsigned)e[7] << 16);
          *(v4u*)((bf16_t*)(ws + (wh ? WS_VWT : WS_VST)) + ((size_t)(b * 2 + g) * 64 + d) * SEQ + 64 * tile + 8 * sc) = o; } }
    __syncthreads();
}

constexpr int ATT_VB = 32768, ATT_PSL = 65536, ATT_OUTA = 65536, ATT_SELM = LDSCTL_OFF + 512, ATT_UNI = ATT_SELM + 512, ATT_TL = ATT_UNI + 16, ATT_NT = ATT_TL + 80;
constexpr float ATT_QS = 0.125f * 1.4426950408889634f;
#ifndef ATT_MASKOFF
#define ATT_MASKOFF 200.0f
#endif
__device__ __forceinline__ int att_swz(int row, int c) { return row * 128 + ((c ^ ((row >> 1) & 7)) << 4); }
struct TileSrc { const bf16_t* K; int kpitch; const bf16_t* V; int vpitch; };
__device__ __forceinline__ void att_load(const TileSrc& s, int tid, v4u& kr, v4u& vr) { const int row = tid >> 3, c = tid & 7; kr = *(const v4u*)(s.K + (size_t)row * s.kpitch + 8 * c); vr = *(const v4u*)(s.V + (size_t)row * s.vpitch + 8 * c); }
__device__ __forceinline__ void att_store(LAS unsigned char* lds, int buf, int tid, const v4u& kr, const v4u& vr) {
    const int row = tid >> 3, c = tid & 7;
    *(LAS v4u*)(lds + buf * 8192 + att_swz(row, c)) = kr;
    const int s16 = c >> 1, half = c & 1;
    *(LAS v2u*)(lds + ATT_VB + buf * 8192 + att_swz(row, 2 * s16) + half * 8) = (v2u){vr.x, vr.y};
    *(LAS v2u*)(lds + ATT_VB + buf * 8192 + att_swz(row, 2 * s16 + 1) + half * 8) = (v2u){vr.z, vr.w};
}
__device__ __forceinline__ void att_qk(const LAS unsigned char* kb, const bf16x8 (&qf)[4], f32x16 (&s)[2], int i, int hh, const f32x16& ini0, const f32x16& ini1) {
    bf16x8 kf[2][4];
#pragma unroll
    for (int kt = 0; kt < 2; ++kt)
#pragma unroll
        for (int st = 0; st < 4; ++st) kf[kt][st] = *(const LAS bf16x8*)(kb + att_swz(32 * kt + i, 2 * st + hh));
    __builtin_amdgcn_s_setprio(1);
#pragma unroll
    for (int st = 0; st < 4; ++st)
#pragma unroll
        for (int kt = 0; kt < 2; ++kt) s[kt] = __builtin_amdgcn_mfma_f32_32x32x16_bf16(kf[kt][st], qf[st], st == 0 ? (kt ? ini1 : ini0) : s[kt], 0, 0, 0);
    __builtin_amdgcn_s_setprio(0);
}
__device__ __forceinline__ void att_vload(const LAS unsigned char* vb, bf16x8 (&vf)[4][2], int i, int hh) {
#pragma unroll
    for (int ks = 0; ks < 4; ++ks)
#pragma unroll
        for (int dt = 0; dt < 2; ++dt) vf[ks][dt] = *(const LAS bf16x8*)(vb + att_swz(32 * dt + i, 2 * ks + hh));
}
__device__ __forceinline__ void att_pv(const bf16x8 (&vf)[4][2], const f32x16 (&p)[2], f32x16 (&o)[2]) {
    __builtin_amdgcn_s_setprio(1);
#pragma unroll
    for (int kt = 0; kt < 2; ++kt)
#pragma unroll
        for (int s = 0; s < 2; ++s) { const v4u pb = (v4u){cvt_pk_bf16(p[kt][8 * s], p[kt][8 * s + 1]), cvt_pk_bf16(p[kt][8 * s + 2], p[kt][8 * s + 3]), cvt_pk_bf16(p[kt][8 * s + 4], p[kt][8 * s + 5]), cvt_pk_bf16(p[kt][8 * s + 6], p[kt][8 * s + 7])};
            const bf16x8 bf = __builtin_bit_cast(bf16x8, pb);
#pragma unroll
            for (int dt = 0; dt < 2; ++dt) o[dt] = __builtin_amdgcn_mfma_f32_32x32x16_bf16(vf[2 * kt + s][dt], bf, o[dt], 0, 0, 0); }
    __builtin_amdgcn_s_setprio(0);
}
__device__ __forceinline__ void att_ini(f32x16 (&ini)[2], bool uniform, float base, int lo, int hi, int hh, float masked = -1e30f) {
    if (uniform) {
#pragma unroll
        for (int r = 0; r < 16; ++r) ini[0][r] = base;
        ini[1] = ini[0];
    } else {
        const unsigned span = (unsigned)(hi - lo);
#pragma unroll
        for (int kt = 0; kt < 2; ++kt)
#pragma unroll
            for (int r = 0; r < 16; ++r) { const int kk = 32 * kt + (r & 3) + 8 * (r >> 2) + 4 * hh; ini[kt][r] = ((unsigned)(kk - lo) <= span && hi >= lo) ? base : masked; }
    }
}
#define ATT_KEY(kt, r, hh) (32 * (kt) + ((r) & 3) + 8 * ((r) >> 2) + 4 * (hh))

__device__ __forceinline__ void att_unit(Frame& F, int unit) {
    unsigned char* ws = F.ws; const bf16_t* proj = (const bf16_t*)(ws + WS_PROJ); bf16_t* mix = (bf16_t*)(ws + WS_MIX);
    const int qb = unit & 63, bg = unit >> 6, b = bg >> 1, g = bg & 1;
    const int w = F.wave, i = F.lane & 31, hh = F.lane >> 5, head = i >> 3, tloc = i & 7, tt = 8 * w + tloc; const int pos = 64 * qb + tt; const size_t tok = (size_t)b * SEQ + pos;
    LAS unsigned char* lds = F.lds; LAS float* PSL = (LAS float*)(lds + ATT_PSL); LAS unsigned* SELM = (LAS unsigned*)(lds + ATT_SELM); LAS unsigned* UNI = (LAS unsigned*)(lds + ATT_UNI);
    LAS unsigned char* TL = lds + ATT_TL; LAS int* NTL = (LAS int*)(lds + ATT_NT);
    const bf16_t* kcmp = (const bf16_t*)(ws + WS_KCMP) + (size_t)bg * 256 * 64; const bf16_t* vcmpt = (const bf16_t*)(ws + WS_VCMPT) + (size_t)bg * 64 * 256;
    const bf16_t* ksr = (const bf16_t*)(ws + WS_KSR) + (size_t)bg * SEQ * 64; const bf16_t* vst = (const bf16_t*)(ws + WS_VST) + (size_t)bg * 64 * SEQ;
    const bf16_t* kwr = (const bf16_t*)(ws + WS_KWR) + (size_t)bg * SEQ * 64; const bf16_t* vwt = (const bf16_t*)(ws + WS_VWT) + (size_t)bg * 64 * SEQ;
    __syncthreads();
    for (int k = F.tid; k < 64 * 64; k += NTHR) PSL[k] = 0.f;
    if (F.tid < 2) UNI[F.tid] = 0u;
    bf16x8 qf[4];
    const bf16_t* qp = proj + tok * LDP + C_NQ + (4 * g + head) * 64 + 8 * hh;
    { float qraw[4][8];
#pragma unroll
      for (int st = 0; st < 4; ++st) { const v4u v = *(const v4u*)(qp + 16 * st); const unsigned vw[4] = {v.x, v.y, v.z, v.w};
#pragma unroll
          for (int k = 0; k < 4; ++k) { qraw[st][2 * k] = bf2f((bf16_t)(vw[k] & 0xffff)); qraw[st][2 * k + 1] = bf2f((bf16_t)(vw[k] >> 16)); } }
#pragma unroll
      for (int st = 0; st < 4; ++st) { const v4u o = (v4u){cvt_pk_bf16(qraw[st][0] * ATT_QS, qraw[st][1] * ATT_QS), cvt_pk_bf16(qraw[st][2] * ATT_QS, qraw[st][3] * ATT_QS), cvt_pk_bf16(qraw[st][4] * ATT_QS, qraw[st][5] * ATT_QS), cvt_pk_bf16(qraw[st][6] * ATT_QS, qraw[st][7] * ATT_QS)};
          qf[st] = __builtin_bit_cast(bf16x8, o); } }
    LAS float* OUTA = (LAS float*)(lds + ATT_OUTA) + (size_t)w * 32 * 64 + F.lane;
    const float* gl = nullptr; (void)gl;
    const float gate0 = fsigmoid(bf2f(proj[tok * LDP + C_NG + (4 * g + head) * 3 + 0])), gate1 = fsigmoid(bf2f(proj[tok * LDP + C_NG + (4 * g + head) * 3 + 1])), gate2 = fsigmoid(bf2f(proj[tok * LDP + C_NG + (4 * g + head) * 3 + 2]));
    v4u kr, vr; f32x16 s[2]; f32x16 ocmp[2];
#ifndef PROBE_ATT
#define PROBE_ATT 0
#endif
    for (int rep1_ = 0; rep1_ < (PROBE_ATT == 1 ? 2 : 1); ++rep1_) {
    const int ncu = (4 * qb + 3) < 255 ? (4 * qb + 3) : 255, ntile = (ncu + 63) >> 6;
    const int ncv = pos >= 31 ? ((pos - 31) >> 4) + 1 : 0;
    const int ncv_min = qb >= 1 ? 4 * qb - 1 : 0;
    float m = -1e30f, l = 0.f;
    {
        int cur = 0; { TileSrc ts{kcmp, 64, vcmpt, 256}; att_load(ts, F.tid, kr, vr); att_store(lds, 0, F.tid, kr, vr); }
        __syncthreads();
        for (int T_ = 0; T_ < ntile; ++T_) {
            const bool more = T_ + 1 < ntile;
            if (more) { TileSrc ts{kcmp + (size_t)(T_ + 1) * 64 * 64, 64, vcmpt + (T_ + 1) * 64, 256}; att_load(ts, F.tid, kr, vr); }
            { f32x16 ini[2]; att_ini(ini, 64 * T_ + 64 <= ncv_min, 0.f, 0, ncv - 1 - 64 * T_, hh, -ATT_MASKOFF); att_qk(lds + cur * 8192, qf, s, i, hh, ini[0], ini[1]); }
            float tm = -1e30f;
#pragma unroll
            for (int kt = 0; kt < 2; ++kt)
#pragma unroll
                for (int r = 0; r < 16; ++r) tm = fmaxf(tm, s[kt][r]);
            tm = fmaxf(tm, __shfl_xor(tm, 32));
            const float mn = fmaxf(m, tm); l *= fexp2(m - mn);
#pragma unroll
            for (int kt = 0; kt < 2; ++kt)
#pragma unroll
                for (int r = 0; r < 16; ++r) l += __builtin_amdgcn_exp2f(s[kt][r] - mn);
            m = mn;
            if (more) att_store(lds, cur ^ 1, F.tid, kr, vr);
            __syncthreads(); cur ^= 1;
        }
        l += __shfl_xor(l, 32);
    }
    {
        const float rl = (ncv > 0 && l > 0.f) ? 1.0f / l : 0.f;
        f32x16 o[2];
#pragma unroll
        for (int k = 0; k < 16; ++k) { o[0][k] = 0.f; o[1][k] = 0.f; }
        float carry = 0.f;
        int cur = 0; { TileSrc ts{kcmp, 64, vcmpt, 256}; att_load(ts, F.tid, kr, vr); att_store(lds, 0, F.tid, kr, vr); }
        __syncthreads();
        for (int T_ = 0; T_ < ntile; ++T_) {
            const bool more = T_ + 1 < ntile;
            if (more) { TileSrc ts{kcmp + (size_t)(T_ + 1) * 64 * 64, 64, vcmpt + (T_ + 1) * 64, 256}; att_load(ts, F.tid, kr, vr); }
            bf16x8 vf[4][2];
            { f32x16 ini[2]; att_ini(ini, 64 * T_ + 64 <= ncv_min, -m, 0, ncv - 1 - 64 * T_, hh, -m - ATT_MASKOFF); att_qk(lds + cur * 8192, qf, s, i, hh, ini[0], ini[1]); }
            att_vload(lds + ATT_VB + cur * 8192, vf, i, hh);
#pragma unroll
            for (int kt = 0; kt < 2; ++kt)
#pragma unroll
                for (int r = 0; r < 16; ++r) s[kt][r] = __builtin_amdgcn_exp2f(s[kt][r]) * rl;
            att_pv(vf, s, o);
            float ps[8];
#pragma unroll
            for (int kt = 0; kt < 2; ++kt)
#pragma unroll
                for (int gi = 0; gi < 4; ++gi) ps[4 * kt + gi] = (s[kt][4 * gi] + s[kt][4 * gi + 1]) + (s[kt][4 * gi + 2] + 0.5f * s[kt][4 * gi + 3]);
            float nc = 0.f;
#pragma unroll
            for (int sl = 0; sl < 8; ++sl) { const float x = 0.5f * s[sl >> 2][4 * (sl & 3) + 3]; const float y = __shfl_xor(x, 32);
                if (hh == 1) ps[sl] += y; else { if (sl < 7) ps[sl + 1] += y; else nc = y; } }
            if (hh == 0) { ps[0] += carry; carry = nc; }
#pragma unroll
            for (int sl = 0; sl < 8; ++sl) { float v = ps[sl]; v += __shfl_xor(v, 8); v += __shfl_xor(v, 16); ps[sl] = v; }
            if (head == 0) {
#pragma unroll
                for (int sl = 0; sl < 8; ++sl) PSL[tt * 64 + 16 * T_ + 2 * sl + hh] = ps[sl]; }
            if (more) att_store(lds, cur ^ 1, F.tid, kr, vr);
            __syncthreads(); cur ^= 1;
        }
#pragma unroll
        for (int dt = 0; dt < 2; ++dt)
#pragma unroll
            for (int k = 0; k < 16; ++k) ocmp[dt][k] = gate0 * o[dt][k];
    }
    __syncthreads();
#pragma unroll 1
    for (int tl = 0; tl < 8; ++tl) {
        const int t = 8 * w + tl, j = F.lane; const bool fj = (j == 0) || (j == qb) || (j == qb - 1);
        const unsigned key = fj ? 0xFFFFFFFFu : (j <= qb ? __float_as_uint(PSL[t * 64 + j]) + 1u : 0u);
        unsigned thr = 0u;
#pragma unroll 1
        for (int bit = 31; bit >= 0; --bit) { const unsigned cand = thr | (1u << bit); if (__popcll(__ballot(key >= cand)) >= NSEL) thr = cand; }
        const unsigned long long gt = __ballot(key > thr), eq = __ballot(key == thr); const int need = NSEL - __popcll(gt);
        const int below = __popcll(eq & ((1ull << j) - 1ull));
        const bool sel = (key > 0u) && ((key > thr) || (key == thr && below < need));
        const unsigned long long msk = __ballot(sel);
        if (F.lane == 0) { const unsigned lo = (unsigned)msk, hi = (unsigned)(msk >> 32); SELM[2 * t] = lo; SELM[2 * t + 1] = hi; atomicOr((unsigned*)&UNI[0], lo); atomicOr((unsigned*)&UNI[1], hi); }
    }
    __syncthreads();
    }
    const unsigned sel0 = SELM[2 * tt], sel1 = SELM[2 * tt + 1];
#pragma unroll
    for (int dt = 0; dt < 2; ++dt)
#pragma unroll
        for (int k = 0; k < 16; ++k) OUTA[(dt * 16 + k) * 64] = ocmp[dt][k];
    { const float* csp = (const float*)(ws + WS_CS) + pos * 32 + 8 * hh; const float* snp = (const float*)(ws + WS_SN) + pos * 32 + 8 * hh;
      float qraw[4][8];
#pragma unroll
      for (int st = 0; st < 4; ++st) { const v4u v = *(const v4u*)(qp + 16 * st); const unsigned vw[4] = {v.x, v.y, v.z, v.w};
#pragma unroll
          for (int k = 0; k < 4; ++k) { qraw[st][2 * k] = bf2f((bf16_t)(vw[k] & 0xffff)); qraw[st][2 * k + 1] = bf2f((bf16_t)(vw[k] >> 16)); } }
#pragma unroll
      for (int st = 0; st < 2; ++st) { float co[8], si[8]; *(f32x4*)&co[0] = *(const f32x4*)(csp + 16 * st); *(f32x4*)&co[4] = *(const f32x4*)(csp + 16 * st + 4); *(f32x4*)&si[0] = *(const f32x4*)(snp + 16 * st); *(f32x4*)&si[4] = *(const f32x4*)(snp + 16 * st + 4);
          float rl_[8], rh_[8];
#pragma unroll
          for (int k = 0; k < 8; ++k) { rl_[k] = (qraw[st][k] * co[k] - qraw[st + 2][k] * si[k]) * ATT_QS; rh_[k] = (qraw[st + 2][k] * co[k] + qraw[st][k] * si[k]) * ATT_QS; }
          qf[st] = __builtin_bit_cast(bf16x8, (v4u){cvt_pk_bf16(rl_[0], rl_[1]), cvt_pk_bf16(rl_[2], rl_[3]), cvt_pk_bf16(rl_[4], rl_[5]), cvt_pk_bf16(rl_[6], rl_[7])});
          qf[st + 2] = __builtin_bit_cast(bf16x8, (v4u){cvt_pk_bf16(rh_[0], rh_[1]), cvt_pk_bf16(rh_[2], rh_[3]), cvt_pk_bf16(rh_[4], rh_[5]), cvt_pk_bf16(rh_[6], rh_[7])}); } }
    for (int rep2_ = 0; rep2_ < (PROBE_ATT == 2 ? 2 : 1); ++rep2_)
#pragma unroll 1
    for (int br = 0; br < 2; ++br) {
        if (F.wave == 0) {
            const int j = F.lane; bool on;
            if (br == 0) { const unsigned u0 = UNI[0], u1 = UNI[1]; on = (j <= qb) && (j < 32 ? ((u0 >> j) & 1u) : ((u1 >> (j - 32)) & 1u)); }
            else on = (j <= qb) && (j >= qb - 8);
            const unsigned long long bm = __ballot(on);
            if (on) TL[__popcll(bm & ((1ull << j) - 1ull))] = (unsigned char)j;
            if (j == 0) NTL[0] = __popcll(bm); }
        __syncthreads();
        const int nl = NTL[0]; const bf16_t* Kg = br ? kwr : ksr; const bf16_t* Vg = br ? vwt : vst;
        float mm = 0.f, ll = 0.f; bool started = false; f32x16 o[2];
#pragma unroll
        for (int k = 0; k < 16; ++k) { o[0][k] = 0.f; o[1][k] = 0.f; }
#define ATT_BODY \
            bool lane_on; int lo_k, hi_k;     \
            if (br == 0) { lane_on = j < 32 ? ((sel0 >> j) & 1u) : ((sel1 >> (j - 32)) & 1u); lo_k = 0; hi_k = (j == qb) ? tt : 63; } \
            else { lane_on = true; lo_k = (j == qb - 8) ? tt + 1 : 0; hi_k = (j == qb) ? tt : 63; if (lo_k > hi_k) lane_on = false; } \
            const bool full = (j != qb) && (br == 0 || j != qb - 8);               \
            if (__any(lane_on)) { \
                bf16x8 vf[4][2]; \
                { f32x16 ini[2]; att_ini(ini, full, lane_on ? -mm : -mm - ATT_MASKOFF, lo_k, lane_on ? hi_k : -1, hh, -mm - ATT_MASKOFF); att_qk(lds + kslot * 8192, qf, s, i, hh, ini[0], ini[1]); } \
                att_vload(lds + ATT_VB + kslot * 8192, vf, i, hh); \
                float tm = -1e30f; \
_Pragma("unroll") \
                for (int kt = 0; kt < 2; ++kt) \
_Pragma("unroll") \
                    for (int r = 0; r < 16; ++r) tm = fmaxf(tm, s[kt][r]); \
                tm = fmaxf(tm, __shfl_xor(tm, 32)); \
                const bool first = !started && (tm > -0.5f * ATT_MASKOFF); started = started || first; \
                const bool upd = first || (tm > 8.0f); \
                if (__any(upd)) { \
                    const float delta = upd ? tm : 0.f, al = fexp2(-delta); mm += delta; ll *= al; \
_Pragma("unroll") \
                    for (int dt = 0; dt < 2; ++dt) \
_Pragma("unroll") \
                        for (int k = 0; k < 16; ++k) o[dt][k] *= al; \
_Pragma("unroll") \
                    for (int kt = 0; kt < 2; ++kt) \
_Pragma("unroll") \
                        for (int r = 0; r < 16; ++r) s[kt][r] -= delta; \
                } \
_Pragma("unroll") \
                for (int kt = 0; kt < 2; ++kt) \
_Pragma("unroll") \
                    for (int r = 0; r < 16; ++r) { const float pv_ = __builtin_amdgcn_exp2f(s[kt][r]); s[kt][r] = pv_; ll += pv_; } \
                att_pv(vf, s, o); \
            }
        v4u kr2, vr2;
        const int np = (nl + 1) >> 1;
#define ATT_LOADPAIR(p_) do { { const int ja = TL[2 * (p_)]; TileSrc ts{Kg + (size_t)ja * 64 * 64, 64, Vg + (size_t)ja * 64, SEQ}; att_load(ts, F.tid, kr, vr); } \
            if (2 * (p_) + 1 < nl) { const int jb = TL[2 * (p_) + 1]; TileSrc ts{Kg + (size_t)jb * 64 * 64, 64, Vg + (size_t)jb * 64, SEQ}; att_load(ts, F.tid, kr2, vr2); } } while (0)
#define ATT_STOREPAIR(p_, c_) do { att_store(lds, 2 * (c_), F.tid, kr, vr); if (2 * (p_) + 1 < nl) att_store(lds, 2 * (c_) + 1, F.tid, kr2, vr2); } while (0)
        ATT_LOADPAIR(0); ATT_STOREPAIR(0, 0);
        if (np > 1) ATT_LOADPAIR(1);
        __syncthreads();
        int cur = 0;
        for (int p = 0; p < np; ++p) {
            if (p + 1 < np) ATT_STOREPAIR(p + 1, cur ^ 1);
            if (p + 2 < np) ATT_LOADPAIR(p + 2);
#pragma unroll 1
            for (int t2 = 0; t2 < 2; ++t2) { const int it = 2 * p + t2; if (it < nl) { const int j = TL[it]; const int kslot = 2 * cur + t2;
                ATT_BODY
            } }
            __syncthreads(); cur ^= 1;
        }
#undef ATT_LOADPAIR
#undef ATT_STOREPAIR
#undef ATT_BODY
        ll += __shfl_xor(ll, 32);
        const float sc_ = rep2_ ? 0.f : (br ? gate2 : gate1) / ll;
#pragma unroll
        for (int dt = 0; dt < 2; ++dt)
#pragma unroll
            for (int k = 0; k < 16; ++k) OUTA[(dt * 16 + k) * 64] += sc_ * o[dt][k];
    }
    { bf16_t* op = mix + tok * D + 512 + (4 * g + head) * 64 + 4 * hh;
#pragma unroll
      for (int dt = 0; dt < 2; ++dt)
#pragma unroll
          for (int gi = 0; gi < 4; ++gi) { const float a0 = OUTA[(dt * 16 + 4 * gi) * 64], a1 = OUTA[(dt * 16 + 4 * gi + 1) * 64], a2 = OUTA[(dt * 16 + 4 * gi + 2) * 64], a3 = OUTA[(dt * 16 + 4 * gi + 3) * 64];
              v2u ov; ov.x = cvt_pk_bf16(a0, a1); ov.y = cvt_pk_bf16(a2, a3); *(v2u*)(op + 32 * dt + 8 * gi) = ov; } }
    __syncthreads();
}

__global__ void __launch_bounds__(NTHR, 2) mk_fwd(Args args) {
    extern __shared__ __attribute__((aligned(16))) unsigned char lds_raw[];
    Frame F;
    F.lds = (LAS unsigned char*)lds_raw; F.MISC = (volatile LAS unsigned*)(F.lds + MISC_OFF);
    F.tid = threadIdx.x; F.lane = F.tid & 63; F.wave = __builtin_amdgcn_readfirstlane(F.tid >> 6);
    F.G = gridDim.x; { const int bx = blockIdx.x; F.vcu = (F.G % 8 == 0) ? (bx % 8) * (F.G / 8) + bx / 8 : bx; }
    F.ws = args.ws; F.ctl = (unsigned*)(args.ws + WS_CTL); F.out = args.out;
#pragma unroll
    for (int i = 0; i < 25; ++i) F.in[i] = args.in[i];
    for (int u = F.tid; u < (LDS_BYTES - LDSCTL_OFF) / 4; u += NTHR) ((LAS unsigned*)(F.lds + LDSCTL_OFF))[u] = 0u;
    __syncthreads();
    const int lo = args.ph_lo, hi = args.ph_hi;
    XcdBarrier bar = xcd_barrier_post(F.ctl + CW_BAR + lo * XCD_BAR_WORDS, F.MISC + 8);
#define IN_PH(k) (lo <= (k) && (k) < hi)
#define SEAM(k) do { if (IN_PH(k) && IN_PH((k) + 1)) xcd_barrier(bar); } while (0)
#define RUNP(k, BODY) do { if (IN_PH(k)) { BODY; if (PROBE_REP == (k)) { xcd_barrier(bar); BODY; } } } while (0)
#define BODY0 p0_prologue(F)
#define BODY1 p1a_norm(F)
#define BODY2 { gm::DenseSched S{(const char*)(F.ws + WS_XN), (const char*)(F.ws + WS_WINT), T / 256, LDP / 256, F.G, (int)blockIdx.x, 2048u, 1024u}; \
        gm::EpiBf16 E{(bf16_t*)(F.ws + WS_PROJ), LDP}; gm::gemm_phase<gm::EpiBf16, gm::DenseSched>(F.lds, S, E, 1024, 128u); }
#define BODY3 { if (F.G == 256) { if (F.vcu < 128) { cmp_unit(F, F.vcu); if (PROBE_P3 == 1) cmp_unit(F, F.vcu); } else { const int u0 = 2 * (F.vcu - 128); hg_passA(F, u0); hg_passA(F, u0 + 1); if (PROBE_P3 == 2) { hg_passA(F, u0); hg_passA(F, u0 + 1); } kv_prep_unit(F, u0); kv_prep_unit(F, u0 + 1); if (PROBE_P3 == 3) { kv_prep_unit(F, u0); kv_prep_unit(F, u0 + 1); } } } \
        else { for (int u = F.vcu; u < 128; u += F.G) cmp_unit(F, u); for (int u = F.vcu; u < 256; u += F.G) hg_passA(F, u); for (int u = F.vcu; u < 256; u += F.G) kv_prep_unit(F, u); } }
#define BODY4 { for (int u = F.vcu; u < 256; u += F.G) hg_passC(F, u); }
#define BODY5 { for (int c = F.vcu; c < 256; c += F.G) { const int bg = c >> 5, k = c & 31; att_unit(F, bg * 64 + 63 - k); att_unit(F, bg * 64 + k); } }
#define BODY6 { gm::DenseSched S{(const char*)(F.ws + WS_MIX), (const char*)(F.ws + WS_WOUTT), T / 256, 4, F.G, (int)blockIdx.x, 2048u, 1024u}; \
        gm::EpiRes E{F.in[IN_X], (const float*)(F.ws + WS_MOD), 2, (float*)(F.ws + WS_X2)}; gm::gemm_phase<gm::EpiRes, gm::DenseSched>(F.lds, S, E, 1024, 128u); }
#define BODY7 p5_router(F)
#define BODY8 { const MoeTabs Tb = moe_tabs_build(F); \
        GateUpSched S{Tb, (const char*)(F.ws + WS_H2), (const char*)(F.ws + WS_WGUT), (const char*)(F.ws + WS_WSGUT), (const int*)(F.ws + WS_ROWL), F.G, (int)blockIdx.x}; \
        EpiSwiglu E{F.ws + WS_ACT, F.ws + WS_ACTS}; gm::gemm_phase<EpiSwiglu, GateUpSched, true>(F.lds, S, E, 512, 128u); }
#define BODY9 { const MoeTabs Tb = moe_tabs_build(F); DownSched S{Tb, (const char*)(F.ws + WS_ACT), (const char*)(F.ws + WS_ACTS), (const char*)(F.ws + WS_WDNT), (const char*)(F.ws + WS_WSDNT), F.G, (int)blockIdx.x}; \
        EpiDown E{(unsigned char*)(F.ws + WS_Y), (bf16_t*)(F.ws + WS_YS)}; gm::gemm_phase<EpiDown, DownSched, true>(F.lds, S, E, 128, 128u); }
#define BODY10 p8_final(F)
    RUNP(0, BODY0); SEAM(0);
    RUNP(1, BODY1); SEAM(1);
    RUNP(2, BODY2); SEAM(2);
    RUNP(3, BODY3); SEAM(3);
    RUNP(4, BODY4); SEAM(4);
    RUNP(5, BODY5); SEAM(5);
    RUNP(6, BODY6); SEAM(6);
    RUNP(7, BODY7); SEAM(7);
    RUNP(8, BODY8); SEAM(8);
    RUNP(9, BODY9); SEAM(9);
    RUNP(10, BODY10);
#undef IN_PH
#undef SEAM
#undef RUNP
}
#ifndef ONE_LAUNCH
#define ONE_LAUNCH 1
#endif
#ifndef OPT_S1
#define OPT_S1 1
#endif
#ifndef OPT_S2B
#define OPT_S2B 1
#endif
#ifndef OPT_S2A
#define OPT_S2A 1
#endif
#ifndef OPT_S5
#define OPT_S5 1
#endif
#ifndef OPT_S3
#define OPT_S3 1
#endif
#ifndef OPT_S4
#define OPT_S4 1
#endif
static void launch_mk(const nv::In& I, void* const* d_in, float* out, unsigned char* ws, int lo, int hi, int grid, hipStream_t stream) {
    Args a{}; for (int i = 0; i < 25; ++i) a.in[i] = (const float*)d_in[i];
    a.out = out; a.ws = ws; a.ph_lo = lo; a.ph_hi = hi; a.rep = 0; a.pad = 0;
    hipLaunchKernelGGL(mk_fwd, dim3(grid), dim3(NTHR), LDS_BYTES, stream, a);
}
extern "C" void kernel_launch(void* const* d_in, const int* in_sizes, int n_in, void* d_out, int out_size, void* d_ws, size_t ws_size, hipStream_t stream) {
    static int grid = 0;
    if (grid == 0) {
        if (ws_size < WS_END || n_in != 25) { fprintf(stderr, "kernel_launch: ws %zu < %zu or n_in %d != 25\n", ws_size, (size_t)WS_END, n_in); grid = -1; return; }
        int dev = 0, cus = 0;
        if (hipGetDevice(&dev) != hipSuccess || hipDeviceGetAttribute(&cus, hipDeviceAttributeMultiprocessorCount, dev) != hipSuccess) { grid = -1; return; }
        if (hipFuncSetAttribute((const void*)mk_fwd, hipFuncAttributeMaxDynamicSharedMemorySize, LDS_BYTES) != hipSuccess) { fprintf(stderr, "kernel_launch: hipFuncSetAttribute failed\n"); grid = -1; return; }
        int per_cu = 0; (void)hipOccupancyMaxActiveBlocksPerMultiprocessor(&per_cu, (const void*)mk_fwd, NTHR, LDS_BYTES); (void)hipGetLastError();
        if (per_cu < 1) fprintf(stderr, "kernel_launch: occupancy query says %d blocks/CU\n", per_cu);
        grid = cus;
    }
    if (grid < 0) return;
    unsigned char* ws = (unsigned char*)d_ws; float* out = (float*)d_out;
    nv::In I; I.set(d_in);
    (void)hipMemsetAsync(ws + WS_CTL, 0, CTL_ZERO_BYTES, stream);
#if ONE_LAUNCH
    launch_mk(I, d_in, out, ws, 0, 11, grid, stream);
#else
#if OPT_S1
    launch_mk(I, d_in, out, ws, 0, 3, grid, stream);
#else
    nv::s1_naive(I, ws, stream);
#endif
#if OPT_S2A
    launch_mk(I, d_in, out, ws, 3, OPT_S2B ? 6 : 5, grid, stream);
#endif
    if (!OPT_S2A || !OPT_S2B) nv::s2_naive(I, ws, stream, !OPT_S2A, !OPT_S2B);
#if OPT_S3
    launch_mk(I, d_in, out, ws, 6, OPT_S4 ? 8 : 7, grid, stream);
#else
    nv::s3_naive(I, ws, stream);
#endif
#if OPT_S4
    if (!OPT_S3) launch_mk(I, d_in, out, ws, 7, 8, grid, stream);
#else
    nv::s4_naive(I, ws, stream);
#endif
#if OPT_S5
    launch_mk(I, d_in, out, ws, 8, 11, grid, stream);
#else
    nv::s5_naive(I, ws, out, stream);
#endif
#endif
}
#endif
```

```cpp
#ifndef CPU_EMU
#include <hip/hip_runtime.h>
#endif
#include <cstdio>
#include <cstdint>
#include <cmath>

#ifndef BATCH
#define BATCH 4
#endif
#ifndef SEQ
#define SEQ 4096
#endif

#ifdef CPU_EMU
struct dim3e { unsigned x, y, z; };
static thread_local dim3e threadIdx, blockIdx, blockDim, gridDim;
#define __global__
#define __device__
#define __host__
#define __forceinline__ inline
#define __launch_bounds__(...)
typedef int hipStream_t;
template <class F> static void cpu_launch(unsigned grid, unsigned block, F f) {
#pragma omp parallel for schedule(dynamic, 1)
    for (long b = 0; b < (long)grid; ++b) {
        blockIdx = {(unsigned)b, 0, 0}; blockDim = {block, 1, 1}; gridDim = {grid, 1, 1};
        for (unsigned t = 0; t < block; ++t) { threadIdx = {t, 0, 0}; f(); }
    }
}
static int g_launch_limit = 1 << 30, g_launch_count = 0;
#define LAUNCH(kern, grid, block, ...) do { if (g_launch_count++ < g_launch_limit) cpu_launch((unsigned)(grid), (unsigned)(block), [&]() { kern(__VA_ARGS__); }); } while (0)
#else
#define LAUNCH(kern, grid, block, ...) kern<<<dim3((unsigned)(grid)), dim3((unsigned)(block)), 0, stream>>>(__VA_ARGS__)
#endif

typedef unsigned short bf16_t;
constexpr int D = 1024, T = BATCH * SEQ, INC = 3352, LDP = 3584;
constexpr int C_HQ = 0, C_HF = 512, C_HI = 1024, C_HGT = 1536, C_NQ = 2048, C_KC = 2560, C_VC = 2688, C_KS = 2816, C_VS = 2944, C_KW = 3072, C_VW = 3200, C_NG = 3328;
constexpr int NCMP = (SEQ - 32) / 16 + 1, NSB = SEQ / 64, NSEL = NSB < 16 ? NSB : 16;
constexpr float EPS = 1e-6f;

constexpr size_t MiB = 1u << 20, KiB = 1u << 10;
constexpr size_t WS_CTL = 0, CTL_ZERO_BYTES = 1 * MiB;
constexpr size_t WS_MODP = 1 * MiB;
constexpr size_t WS_MOD = 2 * MiB + 512 * KiB;
constexpr size_t WS_B1F = WS_MOD + 128 * KiB;
constexpr size_t WS_CS = 2 * MiB + 768 * KiB, WS_SN = WS_CS + 512 * KiB;
constexpr size_t WS_WDNT = 4 * MiB;
constexpr size_t WS_WSDNT = 36 * MiB;
constexpr size_t WS_X2 = 37 * MiB;
constexpr size_t WS_ACT = 101 * MiB;
constexpr size_t WS_ACTS = 173 * MiB;
constexpr size_t WS_ROWL = 181 * MiB;
constexpr size_t WS_TOPI = 189 * MiB, WS_TOPW = WS_TOPI + 512 * KiB;
constexpr size_t WS_ERANK = 185 * MiB;
constexpr size_t WS_SSQ = 186 * MiB;
constexpr size_t WS_WGUT = 190 * MiB;
constexpr size_t WS_WSGUT = 254 * MiB;
constexpr size_t WS_WINT = 255 * MiB;
constexpr size_t WS_WOUTT = 262 * MiB;
constexpr size_t WS_W1KT = 264 * MiB, WS_W1VT = 265 * MiB;
constexpr size_t WS_W2T = 266 * MiB;
constexpr size_t WS_RW = 267 * MiB;
constexpr size_t WS_XN = 268 * MiB;
constexpr size_t WS_H2 = WS_XN;
constexpr size_t WS_PROJ = 300 * MiB;
constexpr size_t WS_KSR = 412 * MiB, WS_KWR = 416 * MiB;
constexpr size_t WS_VST = 420 * MiB, WS_VWT = 424 * MiB;
constexpr size_t WS_KCMP = 428 * MiB, WS_VCMPT = WS_KCMP + 256 * KiB;
constexpr size_t WS_U = 429 * MiB, WS_DD = 445 * MiB;
constexpr size_t WS_MIX = 446 * MiB;
constexpr size_t WS_Y = 190 * MiB;
constexpr size_t WS_YS = 478 * MiB;
constexpr size_t WS_END = 512 * MiB;
constexpr size_t NV_H = 37 * MiB, NV_RSTD = 101 * MiB;
constexpr size_t NV_F = 37 * MiB, NV_ORAW = 69 * MiB, NV_OWIN = 101 * MiB, NV_KSR = 133 * MiB, NV_KWR = 141 * MiB, NV_PS = 149 * MiB, NV_SEL = 157 * MiB,
                 NV_HID = 158 * MiB, NV_KCMP = 160 * MiB, NV_VCMP = 160 * MiB + 512 * KiB, NV_CS = 161 * MiB, NV_SN = 161 * MiB + 512 * KiB, NV_QROT = 478 * MiB;
constexpr size_t NV_H2F = 300 * MiB, NV_LG = 364 * MiB, NV_RSTD2 = 368 * MiB;
constexpr size_t NV_ACT = 300 * MiB, NV_ACTS = 101 * MiB, NV_X3 = 446 * MiB, NV_RSTD3 = 510 * MiB;

__host__ __device__ __forceinline__ float bf2f(bf16_t v) { union { unsigned u; float f; } c; c.u = (unsigned)v << 16; return c.f; }
__host__ __device__ __forceinline__ bf16_t f2bf(float f) { union { unsigned u; float f; } c; c.f = f; unsigned u = c.u; return (bf16_t)((u + 0x7fffu + ((u >> 16) & 1u)) >> 16); }

namespace nv {
__device__ __forceinline__ float sigmoidf_(float z) { return 1.0f / (1.0f + expf(-z)); }
__device__ __forceinline__ float siluf_(float z) { return z * sigmoidf_(z); }
__device__ __forceinline__ float gelu_tanh(float z) { return 0.5f * z * (1.0f + tanhf(0.7978845608028654f * (z + 0.044715f * z * z * z))); }
__device__ __forceinline__ long gtid() { return (long)blockIdx.x * blockDim.x + threadIdx.x; }
#define PJ(row, col) bf2f(proj[(size_t)(row) * LDP + (col)])

__global__ void k_mod(const float* c, const float* w_ada, const float* b_ada, float* mod) {
    long i = gtid(); if (i >= BATCH * 6144) return; int b = (int)(i / 6144), n = (int)(i % 6144);
    float acc = b_ada[n];
    for (int k = 0; k < D; ++k) acc += siluf_(c[b * D + k]) * w_ada[(size_t)k * 6144 + n];
    mod[i] = acc;
}
__global__ void k_rowrstd(const float* x, float* rstd, int rows) {
    long r = gtid(); if (r >= rows) return; float s = 0.f;
    for (int k = 0; k < D; ++k) { float v = x[(size_t)r * D + k]; s += v * v; }
    rstd[r] = 1.0f / sqrtf(s / D + EPS);
}
__global__ void k_modnorm(const float* x, const float* rstd, const float* g, const float* mod, int sh_chunk, int sc_chunk, float* hf, bf16_t* hb) {
    long i = gtid(); if (i >= (long)T * D) return; int r = (int)(i / D), k = (int)(i % D), b = r / SEQ;
    float v = x[i] * rstd[r] * g[k] * (1.0f + mod[b * 6144 + sc_chunk * D + k]) + mod[b * 6144 + sh_chunk * D + k];
    if (hf) hf[i] = v; if (hb) hb[i] = f2bf(v);
}
__global__ void k_gemm_nn_bf(const float* A, int lda, const float* Bm, int ldb, bf16_t* C, int ldc, int M, int N, int K) {
    long i = gtid(); if (i >= (long)M * N) return; int m = (int)(i / N), n = (int)(i % N);
    float acc = 0.f; const float* a = A + (size_t)m * lda;
    for (int k = 0; k < K; ++k) acc += a[k] * Bm[(size_t)k * ldb + n];
    C[(size_t)m * ldc + n] = f2bf(acc);
}
__global__ void k_gemm_nn(const float* A, int lda, const float* Bm, int ldb, float* C, int ldc, int M, int N, int K) {
    long i = gtid(); if (i >= (long)M * N) return; int m = (int)(i / N), n = (int)(i % N);
    float acc = 0.f; const float* a = A + (size_t)m * lda;
    for (int k = 0; k < K; ++k) acc += a[k] * Bm[(size_t)k * ldb + n];
    C[(size_t)m * ldc + n] = acc;
}
__global__ void k_hgf(const bf16_t* proj, const float* lbl, float* F) {
    long i = gtid(); if (i >= (long)T * 512) return; int r = (int)(i / 512), j = (int)(i % 512);
    float l0 = lbl[j], l1 = lbl[512 + j]; float mx = fmaxf(l0, l1); float e0 = expf(l0 - mx), e1 = expf(l1 - mx); float lb = e0 / (e0 + e1);
    F[i] = lb + (1.0f - lb) * sigmoidf_(PJ(r, C_HF + j));
}
__global__ void __launch_bounds__(64) k_hgrn(const bf16_t* proj, const float* F, float* Oraw) {
    long i = gtid(); if (i >= BATCH * 4 * 128) return; int e = (int)(i % 128), h = (int)((i / 128) % 4), b = (int)(i / 512);
    float S[128];
#pragma unroll
    for (int d = 0; d < 128; ++d) S[d] = 0.f;
    for (int t = 0; t < SEQ; ++t) {
        size_t row = (size_t)b * SEQ + t; const bf16_t* p = proj + row * LDP; const float* f = F + row * 512 + h * 128;
        float v = bf2f(p[C_HI + h * 128 + e]), o = 0.f;
#pragma unroll
        for (int d = 0; d < 128; ++d) { float ff = f[d]; S[d] = ff * S[d] + (1.0f - ff) * v; o += S[d] * bf2f(p[C_HQ + h * 128 + d]); }
        Oraw[row * 512 + h * 128 + e] = o * 0.08838834764831845f;
    }
}
__global__ void k_hgnorm(const float* Oraw, const bf16_t* proj, const float* ng, bf16_t* mix) {
    long i = gtid(); if (i >= (long)T * 4) return; size_t row = (size_t)(i / 4); int h = (int)(i % 4);
    const float* o = Oraw + row * 512 + h * 128; float s = 0.f;
    for (int e = 0; e < 128; ++e) s += o[e] * o[e];
    float r = 1.0f / sqrtf(s / 128 + EPS);
    for (int e = 0; e < 128; ++e) mix[row * D + h * 128 + e] = f2bf(o[e] * r * ng[h * 128 + e] * siluf_(PJ(row, C_HGT + h * 128 + e)));
}
__global__ void k_cmp_hidden(const bf16_t* proj, int coloff, const float* pe, const float* w1, const float* b1, float* hid) {
    long i = gtid(); if (i >= (long)BATCH * 2 * NCMP * 256) return; int j = (int)(i % 256); long r = i / 256; int c = (int)(r % NCMP), g = (int)((r / NCMP) % 2), b = (int)(r / (NCMP * 2));
    float acc = b1[j];
    for (int l = 0; l < 32; ++l) { const bf16_t* p = proj + ((size_t)b * SEQ + 16 * c + l) * LDP + coloff + g * 64;
        for (int d = 0; d < 64; ++d) acc += (bf2f(p[d]) + pe[l * 64 + d]) * w1[(size_t)(l * 64 + d) * 256 + j]; }
    hid[i] = gelu_tanh(acc);
}
__global__ void k_cmp_out(const float* hid, const float* w2, float* out) {
    long i = gtid(); if (i >= (long)BATCH * 2 * NCMP * 64) return; int d = (int)(i % 64); long r = i / 64;
    float acc = 0.f; for (int j = 0; j < 256; ++j) acc += hid[r * 256 + j] * w2[j * 64 + d];
    out[i] = acc;
}
__global__ void k_rope_tab(float* cs, float* sn) {
    long i = gtid(); if (i >= (long)SEQ * 32) return; int pos = (int)(i / 32), k = (int)(i % 32);
    float inv = powf(10000.0f, -(float)k / 32.0f); float ang = (float)pos * inv; cs[i] = cosf(ang); sn[i] = sinf(ang);
}
__global__ void k_rope_apply(const bf16_t* proj, int coloff, int nh, const float* cs, const float* sn, float* dst) {
    long i = gtid(); if (i >= (long)T * nh * 32) return; int k = (int)(i % 32); int h = (int)((i / 32) % nh); size_t row = (size_t)(i / (32 * nh)); int pos = (int)(row % SEQ);
    float t1 = PJ(row, coloff + h * 64 + k), t2 = PJ(row, coloff + h * 64 + k + 32), co = cs[pos * 32 + k], si = sn[pos * 32 + k];
    dst[row * (nh * 64) + h * 64 + k] = t1 * co - t2 * si; dst[row * (nh * 64) + h * 64 + k + 32] = t2 * co + t1 * si;
}
__global__ void __launch_bounds__(64) k_cmp_attn(const bf16_t* proj, const float* kcmp, const float* vcmp, float* ocmp, float* PS) {
    long i = gtid(); if (i >= (long)BATCH * 2 * SEQ) return; int s = (int)(i % SEQ), g = (int)((i / SEQ) % 2), b = (int)(i / (2 * SEQ));
    size_t row = (size_t)b * SEQ + s; float* ps = PS + (size_t)i * 64;
    for (int j = 0; j < 64; ++j) ps[j] = 0.f;
    int ncv = s >= 31 ? (s - 31) / 16 + 1 : 0; if (ncv > NCMP) ncv = NCMP;
    const float* kc = kcmp + (size_t)(b * 2 + g) * NCMP * 64; const float* vc = vcmp + (size_t)(b * 2 + g) * NCMP * 64;
    for (int hh = 0; hh < 4; ++hh) {
        int head = g * 4 + hh;
        float q[64], o[64];
#pragma unroll
        for (int d = 0; d < 64; ++d) { q[d] = PJ(row, C_NQ + head * 64 + d); o[d] = 0.f; }
        float m = -3.0e38f, l = 0.f;
        for (int c = 0; c < ncv; ++c) { float sc = 0.f;
#pragma unroll
            for (int d = 0; d < 64; ++d) sc += q[d] * kc[c * 64 + d];
            sc *= 0.125f; float mn = fmaxf(m, sc); l = l * expf(m - mn) + expf(sc - mn); m = mn; }
        for (int c = 0; c < ncv; ++c) { float sc = 0.f;
#pragma unroll
            for (int d = 0; d < 64; ++d) sc += q[d] * kc[c * 64 + d];
            sc *= 0.125f; float p = expf(sc - m) / l;
#pragma unroll
            for (int d = 0; d < 64; ++d) o[d] += p * vc[c * 64 + d];
            int c0 = 16 * c, c1 = 16 * c + 32;
            for (int j = c0 / 64; j <= (c1 - 1) / 64 && j < NSB; ++j) { int lo = c0 > 64 * j ? c0 : 64 * j, hi = c1 < 64 * j + 64 ? c1 : 64 * j + 64; if (hi > lo) ps[j] += p * (float)(hi - lo) / 32.0f; } }
#pragma unroll
        for (int d = 0; d < 64; ++d) ocmp[row * 512 + head * 64 + d] = o[d];
    }
}
__global__ void k_select(const float* PS, unsigned* SEL) {
    long i = gtid(); if (i >= (long)BATCH * 2 * SEQ) return; int s = (int)(i % SEQ); const float* ps = PS + (size_t)i * 64; int cur = s / 64;
    unsigned m0 = 0, m1 = 0;
    for (int j = 0; j < NSB; ++j) {
        bool fj = (j == 0) || (j == cur) || (j == cur - 1); float sj = fj ? 1e30f : (j <= cur ? ps[j] : -1e30f);
        int rank = 0;
        for (int k = 0; k < NSB; ++k) { bool fk = (k == 0) || (k == cur) || (k == cur - 1); float sk = fk ? 1e30f : (k <= cur ? ps[k] : -1e30f); if (sk > sj || (sk == sj && k < j)) ++rank; }
        if (rank < NSEL && sj > -1e29f) { if (j < 32) m0 |= 1u << j; else m1 |= 1u << (j - 32); }
    }
    SEL[i * 2] = m0; SEL[i * 2 + 1] = m1;
}
__global__ void __launch_bounds__(64) k_attn_naive(const float* qrot, const float* krot, const bf16_t* proj, int vcol, const unsigned* SEL, int mode, float* out) {
    long i = gtid(); if (i >= (long)BATCH * 8 * SEQ) return; int s = (int)(i % SEQ), head = (int)((i / SEQ) % 8), b = (int)(i / (8 * SEQ)); int g = head / 4;
    size_t row = (size_t)b * SEQ + s; float q[64], o[64];
#pragma unroll
    for (int d = 0; d < 64; ++d) { q[d] = qrot[row * 512 + head * 64 + d]; o[d] = 0.f; }
    float m = -3.0e38f, l = 0.f;
    unsigned m0 = 0, m1 = 0; if (mode == 0) { size_t si = ((size_t)(b * 2 + g) * SEQ + s) * 2; m0 = SEL[si]; m1 = SEL[si + 1]; }
    int k0 = mode == 0 ? 0 : (s - 511 > 0 ? s - 511 : 0);
    for (int key = k0; key <= s; ++key) {
        if (mode == 0) { int j = key / 64; bool sel = j < 32 ? ((m0 >> j) & 1u) : ((m1 >> (j - 32)) & 1u); if (!sel) { key = j * 64 + 63; continue; } }
        size_t kr = (size_t)b * SEQ + key; const float* kp = krot + kr * 128 + g * 64;
        float sc = 0.f;
#pragma unroll
        for (int d = 0; d < 64; ++d) sc += q[d] * kp[d];
        sc *= 0.125f; float mn = fmaxf(m, sc), a = expf(m - mn), p = expf(sc - mn); l = l * a + p; m = mn;
#pragma unroll
        for (int d = 0; d < 64; ++d) o[d] = o[d] * a + p * PJ(kr, vcol + g * 64 + d);
    }
#pragma unroll
    for (int d = 0; d < 64; ++d) out[row * 512 + head * 64 + d] = o[d] / l;
}
__global__ void k_nsa_combine(const bf16_t* proj, const float* ocmp, const float* oslc, const float* owin, bf16_t* mix) {
    long i = gtid(); if (i >= (long)T * 512) return; size_t row = (size_t)(i / 512); int c = (int)(i % 512), head = c / 64;
    mix[row * D + 512 + c] = f2bf(sigmoidf_(PJ(row, C_NG + head * 3)) * ocmp[i] + sigmoidf_(PJ(row, C_NG + head * 3 + 1)) * oslc[i] + sigmoidf_(PJ(row, C_NG + head * 3 + 2)) * owin[i]);
}
__global__ void k_proj_res(const bf16_t* A, const float* W, const float* x, const float* mod, int chunk, float* out) {
    long i = gtid(); if (i >= (long)T * D) return; int r = (int)(i / D), n = (int)(i % D), b = r / SEQ;
    float acc = 0.f; const bf16_t* a = A + (size_t)r * D;
    for (int k = 0; k < D; ++k) acc += bf2f(a[k]) * W[(size_t)k * D + n];
    out[i] = x[i] + mod[b * 6144 + chunk * D + n] * acc;
}
__global__ void __launch_bounds__(64) k_route(const float* LG, const float* bias, int* TOPI, float* TOPW) {
    long t = gtid(); if (t >= T) return; const float* lg = LG + (size_t)t * 64;
    float gs[8];
#pragma unroll
    for (int gI = 0; gI < 8; ++gI) { float a = -3e38f, b2 = -3e38f;
        for (int e = 0; e < 8; ++e) { float ch = sigmoidf_(lg[gI * 8 + e]) + bias[gI * 8 + e]; if (ch > a) { b2 = a; a = ch; } else if (ch > b2) b2 = ch; }
        gs[gI] = a + b2; }
    unsigned gmask = 0;
#pragma unroll
    for (int gI = 0; gI < 8; ++gI) { int rank = 0;
#pragma unroll
        for (int k = 0; k < 8; ++k) if (gs[k] > gs[gI] || (gs[k] == gs[gI] && k < gI)) ++rank;
        if (rank < 4) gmask |= 1u << gI; }
    int n = 0; float wsum = 0.f;
    for (int e = 0; e < 64; ++e) { if (!((gmask >> (e / 8)) & 1u)) continue; float se = sigmoidf_(lg[e]), ce = se + bias[e]; int rank = 0;
        for (int k = 0; k < 64; ++k) { if (!((gmask >> (k / 8)) & 1u)) continue; float ck = sigmoidf_(lg[k]) + bias[k]; if (ck > ce || (ck == ce && k < e)) ++rank; }
        if (rank < 8 && n < 8) { TOPI[t * 8 + n] = e; TOPW[t * 8 + n] = se; wsum += se; ++n; } }
    for (int k = 0; k < 8; ++k) TOPW[t * 8 + k] = TOPW[t * 8 + k] / wsum * 2.5f;
}
__global__ void k_moe_act(const bf16_t* h2, const float* Wgu, const int* TOPI, float* ACT, long nA) {
    long i = gtid(); if (i >= nA * 256) return; long a = i / 256; int j = (int)(i % 256); long t = TOPI ? a / 8 : a; int e = TOPI ? TOPI[a] : 0;
    const bf16_t* hp = h2 + (size_t)t * D; const float* w = Wgu + (size_t)e * D * 512; float gq = 0.f, u = 0.f;
    for (int k = 0; k < D; ++k) { float hv = bf2f(hp[k]); gq += hv * w[(size_t)k * 512 + j]; u += hv * w[(size_t)k * 512 + 256 + j]; }
    ACT[i] = siluf_(gq) * u;
}
__global__ void k_moe_out(const float* ACT, const float* ACTS, const float* Wdn, const float* Wsd, const int* TOPI, const float* TOPW, const float* x2, const float* mod, float* x3) {
    long i = gtid(); if (i >= (long)T * D) return; long t = i / D; int n = (int)(i % D), b = (int)(t / SEQ);
    float acc = 0.f;
    for (int sl = 0; sl < 8; ++sl) { int e = TOPI[t * 8 + sl]; const float* a = ACT + (size_t)(t * 8 + sl) * 256; const float* w = Wdn + (size_t)e * 256 * D; float y = 0.f;
        for (int k = 0; k < 256; ++k) y += a[k] * w[(size_t)k * D + n];
        acc += TOPW[t * 8 + sl] * y; }
    { const float* a = ACTS + (size_t)t * 256; float y = 0.f; for (int k = 0; k < 256; ++k) y += a[k] * Wsd[(size_t)k * D + n]; acc += y; }
    x3[i] = x2[i] + mod[b * 6144 + 5 * D + n] * acc;
}
__global__ void k_final(const float* x3, const float* rstd, const float* g, float* out) {
    long i = gtid(); if (i >= (long)T * D) return; out[i] = x3[i] * rstd[i / D] * g[i % D];
}
#undef PJ

struct In { const float *x, *c, *w_ada, *b_ada, *n1g, *w_in, *lbl, *hng, *pek, *w1k, *b1k, *w2k, *pev, *w1v, *b1v, *w2v, *w_out, *n2g, *rw, *rb, *wgu, *wdn, *wsgu, *wsdn, *fg;
    void set(void* const* d) { const float** p = (const float**)this; for (int i = 0; i < 25; ++i) p[i] = (const float*)d[i]; } };
#define NBK(n, tb) (((long)(n) + (tb) - 1) / (tb))
template <class Tp> static Tp* wsp(unsigned char* ws, size_t off) { return (Tp*)(ws + off); }
static void s1_naive(const In& I, unsigned char* ws, hipStream_t stream) {
    float* mod = wsp<float>(ws, WS_MOD); float* h = wsp<float>(ws, NV_H); float* rstd = wsp<float>(ws, NV_RSTD); bf16_t* proj = wsp<bf16_t>(ws, WS_PROJ);
    LAUNCH(k_mod, NBK(BATCH * 6144, 256), 256, I.c, I.w_ada, I.b_ada, mod);
    LAUNCH(k_rowrstd, NBK(T, 256), 256, I.x, rstd, T);
    LAUNCH(k_modnorm, NBK((long)T * D, 256), 256, I.x, rstd, I.n1g, mod, 0, 1, h, (bf16_t*)nullptr);
    LAUNCH(k_gemm_nn_bf, NBK((long)T * INC, 256), 256, h, D, I.w_in, INC, proj, LDP, T, INC, D);
}
static void s2_naive(const In& I, unsigned char* ws, hipStream_t stream, bool do_hg = true, bool do_nsa = true) {
    const bf16_t* proj = wsp<bf16_t>(ws, WS_PROJ); bf16_t* mix = wsp<bf16_t>(ws, WS_MIX);
    float *F = wsp<float>(ws, NV_F), *oraw = wsp<float>(ws, NV_ORAW), *owin = wsp<float>(ws, NV_OWIN), *ksr = wsp<float>(ws, NV_KSR), *kwr = wsp<float>(ws, NV_KWR), *PS = wsp<float>(ws, NV_PS);
    float *hid = wsp<float>(ws, NV_HID), *kcmp = wsp<float>(ws, NV_KCMP), *vcmp = wsp<float>(ws, NV_VCMP), *cs = wsp<float>(ws, NV_CS), *sn = wsp<float>(ws, NV_SN), *qrot = wsp<float>(ws, NV_QROT);
    unsigned* sel = wsp<unsigned>(ws, NV_SEL); float *ocmp = F, *oslc = oraw;
    if (do_hg) {
    LAUNCH(k_hgf, NBK((long)T * 512, 256), 256, proj, I.lbl, F);
    LAUNCH(k_hgrn, NBK(BATCH * 512, 64), 64, proj, F, oraw);
    LAUNCH(k_hgnorm, NBK((long)T * 4, 256), 256, oraw, proj, I.hng, mix);
    }
    if (!do_nsa) return;
    LAUNCH(k_cmp_hidden, NBK((long)BATCH * 2 * NCMP * 256, 256), 256, proj, C_KC, I.pek, I.w1k, I.b1k, hid);
    LAUNCH(k_cmp_out, NBK((long)BATCH * 2 * NCMP * 64, 256), 256, hid, I.w2k, kcmp);
    LAUNCH(k_cmp_hidden, NBK((long)BATCH * 2 * NCMP * 256, 256), 256, proj, C_VC, I.pev, I.w1v, I.b1v, hid);
    LAUNCH(k_cmp_out, NBK((long)BATCH * 2 * NCMP * 64, 256), 256, hid, I.w2v, vcmp);
    LAUNCH(k_rope_tab, NBK(SEQ * 32, 256), 256, cs, sn);
    LAUNCH(k_rope_apply, NBK((long)T * 8 * 32, 256), 256, proj, C_NQ, 8, cs, sn, qrot);
    LAUNCH(k_rope_apply, NBK((long)T * 2 * 32, 256), 256, proj, C_KS, 2, cs, sn, ksr);
    LAUNCH(k_rope_apply, NBK((long)T * 2 * 32, 256), 256, proj, C_KW, 2, cs, sn, kwr);
    LAUNCH(k_cmp_attn, NBK((long)BATCH * 2 * SEQ, 64), 64, proj, kcmp, vcmp, ocmp, PS);
    LAUNCH(k_select, NBK((long)BATCH * 2 * SEQ, 256), 256, PS, sel);
    LAUNCH(k_attn_naive, NBK((long)BATCH * 8 * SEQ, 64), 64, qrot, ksr, proj, C_VS, sel, 0, oslc);
    LAUNCH(k_attn_naive, NBK((long)BATCH * 8 * SEQ, 64), 64, qrot, kwr, proj, C_VW, sel, 1, owin);
    LAUNCH(k_nsa_combine, NBK((long)T * 512, 256), 256, proj, ocmp, oslc, owin, mix);
}
static void s3_naive(const In& I, unsigned char* ws, hipStream_t stream) {
    LAUNCH(k_proj_res, NBK((long)T * D, 256), 256, wsp<bf16_t>(ws, WS_MIX), I.w_out, I.x, wsp<float>(ws, WS_MOD), 2, wsp<float>(ws, WS_X2));
}
static void s4_naive(const In& I, unsigned char* ws, hipStream_t stream) {
    float *x2 = wsp<float>(ws, WS_X2), *rstd = wsp<float>(ws, NV_RSTD2), *h2f = wsp<float>(ws, NV_H2F), *lg = wsp<float>(ws, NV_LG), *mod = wsp<float>(ws, WS_MOD);
    LAUNCH(k_rowrstd, NBK(T, 256), 256, x2, rstd, T);
    LAUNCH(k_modnorm, NBK((long)T * D, 256), 256, x2, rstd, I.n2g, mod, 3, 4, h2f, wsp<bf16_t>(ws, WS_H2));
    LAUNCH(k_gemm_nn, NBK((long)T * 64, 256), 256, h2f, D, I.rw, 64, lg, 64, T, 64, D);
    LAUNCH(k_route, NBK(T, 64), 64, lg, I.rb, wsp<int>(ws, WS_TOPI), wsp<float>(ws, WS_TOPW));
}
static void s5_naive(const In& I, unsigned char* ws, float* out, hipStream_t stream) {
    float *act = wsp<float>(ws, NV_ACT), *acts = wsp<float>(ws, NV_ACTS), *x3 = wsp<float>(ws, NV_X3), *rstd = wsp<float>(ws, NV_RSTD3);
    const bf16_t* h2 = wsp<bf16_t>(ws, WS_H2); const int* topi = wsp<int>(ws, WS_TOPI);
    LAUNCH(k_moe_act, NBK((long)T * 8 * 256, 256), 256, h2, I.wgu, topi, act, (long)T * 8);
    LAUNCH(k_moe_act, NBK((long)T * 256, 256), 256, h2, I.wsgu, (const int*)nullptr, acts, (long)T);
    LAUNCH(k_moe_out, NBK((long)T * D, 256), 256, act, acts, I.wdn, I.wsdn, topi, wsp<float>(ws, WS_TOPW), wsp<float>(ws, WS_X2), wsp<float>(ws, WS_MOD), x3);
    LAUNCH(k_rowrstd, NBK(T, 256), 256, x3, rstd, T);
    LAUNCH(k_final, NBK((long)T * D, 256), 256, x3, rstd, I.fg, out);
}
}
#ifndef CPU_EMU
#define GAS __attribute__((address_space(1)))
#define LAS __attribute__((address_space(3)))
typedef unsigned v4u __attribute__((ext_vector_type(4)));
typedef unsigned v2u __attribute__((ext_vector_type(2)));
typedef float f32x4 __attribute__((ext_vector_type(4)));
typedef float f32x2 __attribute__((ext_vector_type(2)));
typedef float f32x16 __attribute__((ext_vector_type(16)));
typedef short bf16x8 __attribute__((ext_vector_type(8)));
typedef short bf16x4 __attribute__((ext_vector_type(4)));
typedef long i64x2 __attribute__((ext_vector_type(2)));
typedef int v8i __attribute__((ext_vector_type(8)));
typedef int v4i __attribute__((ext_vector_type(4)));
typedef GAS unsigned gu32;
#define RLX_AGENT __ATOMIC_RELAXED, __HIP_MEMORY_SCOPE_AGENT
#define LDS_WAIT() asm volatile("s_waitcnt lgkmcnt(0)" ::: "memory")
#define VM_WAIT() asm volatile("s_waitcnt vmcnt(0)" ::: "memory")
constexpr int NWAVES = 8, NTHR = 512;
__device__ __forceinline__ unsigned pk2(float lo, float hi) { return (unsigned)f2bf(lo) | ((unsigned)f2bf(hi) << 16); }
__device__ __forceinline__ unsigned cvt_pk_bf16(float lo, float hi) { unsigned r; asm volatile("v_cvt_pk_bf16_f32 %0, %1, %2" : "=v"(r) : "v"(lo), "v"(hi)); return r; }
__device__ __forceinline__ float fexp2(float x) { return __builtin_amdgcn_exp2f(__builtin_amdgcn_fmed3f(x, -120.0f, 3.0e38f)); }
__device__ __forceinline__ float fexp(float x) { return __builtin_amdgcn_exp2f(fmaxf(x * 1.4426950408889634f, -120.0f)); }
__device__ __forceinline__ float fsigmoid(float z) { return __builtin_amdgcn_rcpf(1.0f + __builtin_amdgcn_exp2f(__builtin_amdgcn_fmed3f(z * -1.4426950408889634f, -120.0f, 120.0f))); }
__device__ __forceinline__ float fsilu(float z) { return z * __builtin_amdgcn_rcpf(1.0f + __builtin_amdgcn_exp2f(__builtin_amdgcn_fmed3f(z * -1.4426950408889634f, -120.0f, 120.0f))); }
__device__ __forceinline__ unsigned pk4_e4m3(float a, float b, float c, float d, float sc) {
    a = __builtin_amdgcn_fmed3f(a * sc, -448.0f, 448.0f); b = __builtin_amdgcn_fmed3f(b * sc, -448.0f, 448.0f); c = __builtin_amdgcn_fmed3f(c * sc, -448.0f, 448.0f); d = __builtin_amdgcn_fmed3f(d * sc, -448.0f, 448.0f);
    int w = __builtin_amdgcn_cvt_pk_fp8_f32(a, b, 0, false); w = __builtin_amdgcn_cvt_pk_fp8_f32(c, d, w, true); return (unsigned)w;
}
__device__ __forceinline__ float wave_sum(float v) {
#pragma unroll
    for (int o = 1; o < 64; o <<= 1) v += __shfl_xor(v, o);
    return v;
}

#define XB_TMO      128
#define XB_XCNT(j)  (256  + 64 * (j))
#define XB_XSUB(j)  (1280 + 64 * (j))
#define XB_XGEN(j)  (2304 + 64 * (j))
#define XB_TOP      3328
#define XB_TOPGEN   3392
#define XCD_BAR_WORDS 3456
#define XB_SPIN_CAP (1u << 18)
__device__ __forceinline__ unsigned xb_ld(unsigned* p)              { return __hip_atomic_load(p, __ATOMIC_RELAXED, __HIP_MEMORY_SCOPE_AGENT); }
__device__ __forceinline__ unsigned xb_add(unsigned* p, unsigned v) { return __hip_atomic_fetch_add(p, v, __ATOMIC_RELAXED, __HIP_MEMORY_SCOPE_AGENT); }
__device__ __forceinline__ unsigned xb_xcc_id() { return (unsigned)__builtin_amdgcn_s_getreg((3 << 11) | 20) & 0xFu; }
#define XB_SPIN(cond, bar) do { unsigned _sp = 0; while (cond) { __builtin_amdgcn_s_sleep(1); \
    if ((++_sp & 255u) == 0u) { if (xb_ld(&(bar)[XB_TMO])) break; if (_sp > XB_SPIN_CAP) { atomicAdd(&(bar)[XB_TMO], 1u); break; } } } } while (0)
struct XcdBarrier { unsigned* bar; unsigned x; volatile LAS unsigned* st; };
__device__ __forceinline__ XcdBarrier xcd_barrier_post(unsigned* bar, volatile LAS unsigned* st) {
    XcdBarrier b; b.bar = bar; b.x = xb_xcc_id(); b.st = st;
    if (threadIdx.x == 0) (void)xb_add(&bar[XB_XCNT(b.x)], 1u);
    return b;
}
__device__ __forceinline__ void xcd_barrier_complete(unsigned* bar, unsigned x, unsigned& nloc, unsigned& nx) {
    const unsigned G = gridDim.x * gridDim.y * gridDim.z;
    unsigned sum, cnt, mine, sp = 0u;
    for (;;) {
        sum = 0u; cnt = 0u; mine = 0u;
#pragma unroll
        for (unsigned j = 0; j < 16; ++j) { const unsigned c = xb_ld(&bar[XB_XCNT(j)]); sum += c; cnt += (c > 0u) ? 1u : 0u; mine = (j == x) ? c : mine; }
        if (sum == G) break;
        __builtin_amdgcn_s_sleep(1);
        if ((++sp & 255u) == 0u) { if (xb_ld(&bar[XB_TMO])) break; if (sp > XB_SPIN_CAP) { atomicAdd(&bar[XB_TMO], 1u); break; } }
    }
    nloc = mine > 0u ? mine : 1u; nx = cnt > 0u ? cnt : 1u;
}
__device__ __forceinline__ void xcd_barrier(const XcdBarrier& b) {
    asm volatile("s_waitcnt vmcnt(0)" ::: "memory");
    __syncthreads();
    if (threadIdx.x == 0) {
        unsigned* bar = b.bar;
        __builtin_amdgcn_s_waitcnt(0);
        unsigned nloc = b.st[0], nx = b.st[1];
        if (nloc == 0u) { xcd_barrier_complete(bar, b.x, nloc, nx); b.st[0] = nloc; b.st[1] = nx; }
        const unsigned old = xb_add(&bar[XB_XSUB(b.x)], 1u);
        const unsigned gen = old / nloc;
        if (old + 1u == (gen + 1u) * nloc) {
            __builtin_amdgcn_fence(__ATOMIC_RELEASE, "agent");
            asm volatile("s_waitcnt vmcnt(0)" ::: "memory");
            const unsigned og = xb_add(&bar[XB_TOP], 1u);
            const unsigned tg = og / nx;
            if (og + 1u == (tg + 1u) * nx) xb_add(&bar[XB_TOPGEN], 1u);
            else XB_SPIN(xb_ld(&bar[XB_TOPGEN]) == tg, bar);
            __builtin_amdgcn_fence(__ATOMIC_ACQUIRE, "agent");
            xb_add(&bar[XB_XGEN(b.x)], 1u);
            asm volatile("s_waitcnt vmcnt(0)" ::: "memory");
        } else {
            XB_SPIN(xb_ld(&bar[XB_XGEN(b.x)]) == gen, bar);
            __builtin_amdgcn_fence(__ATOMIC_ACQUIRE, "agent");
            asm volatile("s_waitcnt vmcnt(0)" ::: "memory");
        }
    }
    __syncthreads();
}

namespace gm {
constexpr int BM = 256, BK = 64, HALF = 128, HTB = HALF * BK * 2, STAGE_BYTES = 8 * HTB, NXCD = 8, WGM = 8;
__host__ __device__ __forceinline__ int lds_byte(int r, int c) { const int st = (r >> 4) * 2 + (c >> 5), rr = r & 15, cc = c & 31, ob = rr * 64 + cc * 2; return st * 1024 + (ob ^ (((ob >> 9) & 1) << 5)); }
__host__ __device__ __forceinline__ void stage_rc(int b, int& R, int& C) { const int st = b / 1024, sb = b % 1024, swz = sb ^ (((sb >> 9) & 1) << 5); R = (st >> 1) * 16 + swz / 64; C = (st & 1) * 32 + (swz % 64) / 2; }
__host__ __device__ __forceinline__ int perm32(int rho) { const int n = rho >> 4, i = rho & 15; return 8 * (i >> 2) + 4 * n + (i & 3); }

struct Unit { int pm, pn; const char* A; const char* B; int e, m0; };

__device__ __forceinline__ bool static_tile(int nM, int nN, int G, int c, int i, int& pm, int& pn) {
    const int nwg = nM * nN; const long L = (long)i * G + c; if (L >= nwg) return false;
    int wgid = (int)L; { const int q = nwg / NXCD, r = nwg % NXCD, xcd = wgid % NXCD, off = wgid / NXCD; wgid = (xcd < r ? xcd * (q + 1) : r * (q + 1) + (xcd - r) * q) + off; }
    const int nig = WGM * nN, gid = wgid / nig, fm = gid * WGM, gsz = (nM - fm) < WGM ? (nM - fm) : WGM;
    pm = fm + ((wgid % nig) % gsz); pn = (wgid % nig) / gsz; return true;
}
struct DenseSched {
    const char* A; const char* Bt; int nM, nN, G, c; unsigned lda_b, K;
    __device__ __forceinline__ bool next(int i, Unit& u) const { int pm, pn; if (!static_tile(nM, nN, G, c, i, pm, pn)) return false; u.pm = pm; u.pn = pn; u.A = A + (size_t)pm * BM * lda_b; u.B = Bt + (size_t)pn * BM * K * 2; u.e = 0; u.m0 = 0; return true; }
    __device__ __forceinline__ unsigned arow(const Unit&, int r) const { return (unsigned)r * lda_b; }
};

template <class Epi, class Sched, bool FP8 = false>
__device__ __forceinline__ void gemm_phase(LAS unsigned char* lds, const Sched& S, const Epi& E, const int K, const unsigned kstepA) {
    const int tid = threadIdx.x, wid = __builtin_amdgcn_readfirstlane(tid >> 6), lane = tid & 63, wr = wid >> 2, wc = wid & 3, fr = lane & 15, fq = lane >> 4;
    const int nt = K / BK;
    int R0, C0; stage_rc(tid * 16, R0, C0);
    unsigned voffB[2];
#pragma unroll
    for (int i = 0; i < 2; ++i) { const int R = R0 + 64 * i; const int Rb = Epi::PERM ? ((R & ~31) + perm32(R & 31)) : R; voffB[i] = (unsigned)(Rb * K + C0) * 2u; }
    const unsigned ca = (unsigned)C0 * 2u;
    const size_t kstepB = (size_t)(BK * 2);
    const size_t hstepB = (size_t)HALF * K * 2;
    const unsigned ldsw = (unsigned)wid * 1024u;
    const int aoff = lds_byte(wr * 64 + fr, fq * 8), boff = lds_byte(wc * 32 + fr, fq * 8);
#define GM_SA(b, h) (((b) * 2 + (h)) * HTB)
#define GM_SB(b, h) ((4 + (b) * 2 + (h)) * HTB)
#define GM_STAGEB(bufoff, gbase) do { _Pragma("unroll") for (int _i = 0; _i < 2; ++_i) \
        __builtin_amdgcn_global_load_lds((const unsigned*)((const char*)(gbase) + voffB[_i]), (LAS unsigned*)(lds + (bufoff) + ldsw + _i * 8192), 16, 0, 0); } while (0)
#define GM_STAGEA(bufoff, abase, offs, h, kb) do { _Pragma("unroll") for (int _i = 0; _i < 2; ++_i) \
        __builtin_amdgcn_global_load_lds((const unsigned*)((const char*)(abase) + (offs)[2 * (h) + _i] + (kb)), (LAS unsigned*)(lds + (bufoff) + ldsw + _i * 8192), 16, 0, 0); } while (0)
#define GM_LDA(dst, b, h) do { _Pragma("unroll") for (int m = 0; m < 4; ++m) _Pragma("unroll") for (int k = 0; k < 2; ++k) dst[m][k] = *(const LAS bf16x8*)(lds + GM_SA(b, h) + aoff + m * 2048 + k * 1024); } while (0)
#define GM_LDB(dst, b, h) do { _Pragma("unroll") for (int n = 0; n < 2; ++n) _Pragma("unroll") for (int k = 0; k < 2; ++k) dst[n][k] = *(const LAS bf16x8*)(lds + GM_SB(b, h) + boff + n * 2048 + k * 1024); } while (0)
#define GM_MMA(ai, bj, At, Bt) do { __builtin_amdgcn_s_setprio(1); _Pragma("unroll") for (int m = 0; m < 4; ++m) _Pragma("unroll") for (int n = 0; n < 2; ++n) _Pragma("unroll") for (int k = 0; k < 2; ++k) { \
        if constexpr (FP8) { const i64x2 b2_ = __builtin_bit_cast(i64x2, Bt[n][k]), a2_ = __builtin_bit_cast(i64x2, At[m][k]); \
            acc[ai][bj][m][n] = __builtin_amdgcn_mfma_f32_16x16x32_fp8_fp8(b2_[0], a2_[0], acc[ai][bj][m][n], 0, 0, 0); acc[ai][bj][m][n] = __builtin_amdgcn_mfma_f32_16x16x32_fp8_fp8(b2_[1], a2_[1], acc[ai][bj][m][n], 0, 0, 0); } \
        else acc[ai][bj][m][n] = __builtin_amdgcn_mfma_f32_16x16x32_bf16(Bt[n][k], At[m][k], acc[ai][bj][m][n], 0, 0, 0); } __builtin_amdgcn_s_setprio(0); } while (0)
#define GM_WAIT_V(n) asm volatile("s_waitcnt vmcnt(" #n ")" ::: "memory")
#define GM_WAIT_L(n) asm volatile("s_waitcnt lgkmcnt(" #n ")" ::: "memory")
#define GM_BAR __builtin_amdgcn_s_barrier()
#define GM_SCHED __builtin_amdgcn_sched_barrier(0)
    Unit cur, nxt; int ui = 0;
    if (!S.next(0, cur)) return;
    unsigned coff[4], noff[4];
#pragma unroll
    for (int q = 0; q < 4; ++q) { coff[q] = S.arow(cur, R0 + 64 * q) + ca; noff[q] = coff[q]; }
    f32x4 acc[2][2][4][2];
#pragma unroll
    for (int a = 0; a < 2; ++a)
#pragma unroll
        for (int b = 0; b < 2; ++b)
#pragma unroll
            for (int m = 0; m < 4; ++m)
#pragma unroll
                for (int n = 0; n < 2; ++n) acc[a][b][m][n] = (f32x4){0.f, 0.f, 0.f, 0.f};
    bf16x8 At[4][2], B0[2][2], B1[2][2];
    const char* cA = cur.A; const char* cB = cur.B;
    GM_STAGEB(GM_SB(0, 0), cB); GM_STAGEB(GM_SB(0, 1), cB + hstepB); GM_STAGEA(GM_SA(0, 0), cA, coff, 0, 0u); GM_STAGEA(GM_SA(0, 1), cA, coff, 1, 0u);
    if (wr == 1) GM_BAR;
    GM_WAIT_V(2); GM_BAR;
    GM_STAGEB(GM_SB(1, 0), cB + kstepB); GM_STAGEA(GM_SA(1, 0), cA, coff, 0, kstepA); GM_STAGEB(GM_SB(1, 1), cB + hstepB + kstepB);
    GM_WAIT_V(6); GM_BAR;
    for (;;) {
        const bool has_next = S.next(ui + 1, nxt);
        const char* nA = has_next ? nxt.A : cA; const char* nB = has_next ? nxt.B : cB;
        if (has_next) {
#pragma unroll
            for (int q = 0; q < 4; ++q) noff[q] = S.arow(nxt, R0 + 64 * q) + ca;
        } else {
#pragma unroll
            for (int q = 0; q < 4; ++q) noff[q] = coff[q];
        }
#pragma unroll 1
        for (int t = 0; t < nt; t += 2) {
            const bool last = (t == nt - 2);
            const unsigned k1 = (unsigned)(t + 1) * kstepA;
            const char* a2 = last ? nA : cA; const unsigned k2 = last ? 0u : (unsigned)(t + 2) * kstepA, k3 = k2 + kstepA;
            unsigned o2[4];
#pragma unroll
            for (int q = 0; q < 4; ++q) o2[q] = last ? noff[q] : coff[q];
            const char* b2 = last ? nB : cB + (size_t)(t + 2) * kstepB; const char* b3 = b2 + kstepB;
            GM_LDB(B0, 0, 0); GM_LDB(B1, 0, 1); GM_SCHED; GM_LDA(At, 0, 0); GM_STAGEA(GM_SA(1, 1), cA, coff, 1, k1);
            GM_WAIT_V(8); GM_WAIT_L(0); GM_BAR; GM_MMA(0, 0, At, B0); GM_MMA(0, 1, At, B1); GM_BAR; GM_SCHED;
            GM_LDA(At, 0, 1); GM_STAGEB(GM_SB(0, 0), b2); GM_STAGEB(GM_SB(0, 1), b2 + hstepB); GM_STAGEA(GM_SA(0, 0), a2, o2, 0, k2);
            GM_WAIT_V(8); GM_WAIT_L(0); GM_BAR; GM_MMA(1, 0, At, B0); GM_MMA(1, 1, At, B1); GM_BAR; GM_SCHED;
            GM_LDB(B0, 1, 0); GM_LDB(B1, 1, 1); GM_SCHED; GM_LDA(At, 1, 0); GM_STAGEA(GM_SA(0, 1), a2, o2, 1, k2);
            GM_WAIT_V(8); GM_WAIT_L(0); GM_BAR; GM_MMA(0, 0, At, B0); GM_MMA(0, 1, At, B1); GM_BAR; GM_SCHED;
            GM_LDA(At, 1, 1); GM_STAGEB(GM_SB(1, 0), b3); GM_STAGEB(GM_SB(1, 1), b3 + hstepB); GM_STAGEA(GM_SA(1, 0), a2, o2, 0, k3);
            GM_WAIT_V(8); GM_WAIT_L(0); GM_BAR; GM_MMA(1, 0, At, B0); GM_MMA(1, 1, At, B1); GM_BAR; GM_SCHED;
        }
        if (wr == 0) GM_BAR;
        E(acc, cur, wr, wc, fr, fq);
        if (!has_next) break;
#pragma unroll
        for (int a = 0; a < 2; ++a)
#pragma unroll
            for (int b = 0; b < 2; ++b)
#pragma unroll
                for (int m = 0; m < 4; ++m)
#pragma unroll
                    for (int n = 0; n < 2; ++n) acc[a][b][m][n] = (f32x4){0.f, 0.f, 0.f, 0.f};
        cur = nxt; cA = nA; cB = nB; ++ui;
#pragma unroll
        for (int q = 0; q < 4; ++q) coff[q] = noff[q];
        if (wr == 1) GM_BAR;
    }
    GM_WAIT_V(0);
    GM_BAR;
#undef GM_SA
#undef GM_SB
#undef GM_STAGEA
#undef GM_STAGEB
#undef GM_LDA
#undef GM_LDB
#undef GM_MMA
#undef GM_WAIT_V
#undef GM_WAIT_L
#undef GM_BAR
#undef GM_SCHED
}

struct EpiBf16 {
    static constexpr bool PERM = true;
    bf16_t* O; int ldc;
    __device__ __forceinline__ void operator()(const f32x4 (&acc)[2][2][4][2], const Unit& u, int wr, int wc, int fr, int fq) const {
        const int row0 = u.pm * BM + wr * 64 + fr, col0 = u.pn * BM + wc * 32 + 8 * fq;
#pragma unroll
        for (int ai = 0; ai < 2; ++ai)
#pragma unroll
            for (int m = 0; m < 4; ++m) { bf16_t* rowp = O + (size_t)(row0 + ai * HALF + m * 16) * ldc + col0;
#pragma unroll
                for (int bj = 0; bj < 2; ++bj) { const f32x4 v0 = acc[ai][bj][m][0], v1 = acc[ai][bj][m][1];
                    v4u w; w.x = cvt_pk_bf16(v0[0], v0[1]); w.y = cvt_pk_bf16(v0[2], v0[3]); w.z = cvt_pk_bf16(v1[0], v1[1]); w.w = cvt_pk_bf16(v1[2], v1[3]);
                    *(v4u*)(rowp + bj * HALF) = w; } }
    }
};
struct EpiRes {
    static constexpr bool PERM = false;
    const float* x; const float* mod; int chunk; float* out; float* ssq;
    __device__ __forceinline__ void operator()(const f32x4 (&acc)[2][2][4][2], const Unit& u, int wr, int wc, int fr, int fq) const {
        const int row0 = u.pm * BM + wr * 64 + fr, col0 = u.pn * BM + wc * 32 + 4 * fq; const int b = (u.pm * BM) / SEQ;
        f32x4 gv[2][2];
#pragma unroll
        for (int bj = 0; bj < 2; ++bj)
#pragma unroll
            for (int n = 0; n < 2; ++n) gv[bj][n] = *(const f32x4*)(mod + (size_t)b * 6144 + chunk * 1024 + col0 + bj * HALF + n * 16);
#pragma unroll
        for (int ai = 0; ai < 2; ++ai)
#pragma unroll
            for (int m = 0; m < 4; ++m) { const size_t off = (size_t)(row0 + ai * HALF + m * 16) * 1024 + col0; float sq = 0.f;
#pragma unroll
                for (int bj = 0; bj < 2; ++bj)
#pragma unroll
                    for (int n = 0; n < 2; ++n) { const f32x4 xv = *(const f32x4*)(x + off + bj * HALF + n * 16); const f32x4 o = xv + gv[bj][n] * acc[ai][bj][m][n]; *(f32x4*)(out + off + bj * HALF + n * 16) = o;
                        sq += (o[0] * o[0] + o[1] * o[1]) + (o[2] * o[2] + o[3] * o[3]); }
                sq += __shfl_xor(sq, 16); sq += __shfl_xor(sq, 32);
                if (fq == 0) ssq[(size_t)(row0 + ai * HALF + m * 16) * 16 + u.pn * 4 + wc] = sq; }
    }
};
}
#ifndef PROBE_REP
#define PROBE_REP -1
#endif
#ifndef PROBE_P3
#define PROBE_P3 0
#endif
constexpr int RING_BYTES = 131072, LDSCTL_OFF = RING_BYTES, MISC_OFF = LDSCTL_OFF + 320, LDS_BYTES = 147456;
constexpr float WGU_SCALE = 32.0f, WDN_SCALE = 16.0f, ACT_SCALE = 8.0f;
constexpr int CW_BAR = 4096;
constexpr int CW_ECNT = 65536;

struct Args { const float* in[25]; float* out; unsigned char* ws; int ph_lo, ph_hi, rep, pad; };
struct Frame {
    LAS unsigned char* lds; volatile LAS unsigned* MISC; unsigned* ctl; unsigned char* ws;
    int tid, lane, wave, vcu, G;
    const float* in[25]; float* out;
};
#define IN_X 0
#define IN_C 1
#define IN_WADA 2
#define IN_BADA 3
#define IN_N1G 4
#define IN_WIN 5
#define IN_LBL 6
#define IN_HNG 7
#define IN_PEK 8
#define IN_W1K 9
#define IN_B1K 10
#define IN_W2K 11
#define IN_PEV 12
#define IN_W1V 13
#define IN_B1V 14
#define IN_W2V 15
#define IN_WOUT 16
#define IN_N2G 17
#define IN_RW 18
#define IN_RB 19
#define IN_WGU 20
#define IN_WDN 21
#define IN_WSGU 22
#define IN_WSDN 23
#define IN_FG 24

template <bool FRAG = false, bool F8 = false> __device__ __forceinline__ void p0_transpose_item(const float* W, int K, int N, bf16_t* WT, int drow0, int k0, int n0, LAS float* scr, int lane, float f8scale = 1.0f) {
    const int kq = lane >> 3, nq = lane & 7; const int nn = n0 + 4 * nq; const bool ok = nn < N;
    f32x4 v[8];
#pragma unroll
    for (int i = 0; i < 8; ++i) v[i] = ok ? *(const f32x4*)(W + (size_t)(k0 + 8 * i + kq) * N + nn) : (f32x4){0.f, 0.f, 0.f, 0.f};
#pragma unroll
    for (int i = 0; i < 8; ++i) { LAS float* d = scr + (8 * i + kq) * 33 + 4 * nq; d[0] = v[i][0]; d[1] = v[i][1]; d[2] = v[i][2]; d[3] = v[i][3]; }
    LDS_WAIT(); asm volatile("" ::: "memory");
    const int c = lane & 7;
#pragma unroll
    for (int j = 0; j < 4; ++j) { const int n = (lane >> 3) + 8 * j; const LAS float* s = scr + (8 * c) * 33 + n;
        v4u o; o.x = pk2(s[0 * 33], s[1 * 33]); o.y = pk2(s[2 * 33], s[3 * 33]); o.z = pk2(s[4 * 33], s[5 * 33]); o.w = pk2(s[6 * 33], s[7 * 33]);
        if (F8) { *(v2u*)((unsigned char*)WT + (size_t)(drow0 + n) * K + k0 + 8 * c) = (v2u){pk4_e4m3(s[0 * 33], s[1 * 33], s[2 * 33], s[3 * 33], f8scale), pk4_e4m3(s[4 * 33], s[5 * 33], s[6 * 33], s[7 * 33], f8scale)}; }
        else if (FRAG) { const int kk = k0 + 8 * c, col = drow0 + n; *(v4u*)(WT + ((size_t)((kk >> 5) * (N / 16) + (col >> 4)) * 64 + ((kk & 31) >> 3) * 16 + (col & 15)) * 8) = o; }
        else *(v4u*)(WT + (size_t)(drow0 + n) * K + k0 + 8 * c) = o; }
    LDS_WAIT(); asm volatile("" ::: "memory");
}
__device__ __forceinline__ int gu_row(int n) { const int j = n & 255; return (j >> 7) * 256 + ((n >> 8) << 7) + (j & 127); }

__device__ __forceinline__ void p0_prologue(Frame& F) {
    unsigned char* ws = F.ws;
    if (F.vcu < 256) {
        LAS float* ca = (LAS float*)F.lds;
        const int ks = F.vcu >> 4, cg = F.vcu & 15;
        if (F.tid < 256) { const int b = F.tid >> 6, k = F.tid & 63; ca[F.tid] = fsilu(F.in[IN_C][b * D + ks * 64 + k]); }
        __syncthreads();
        if (F.tid < 384) { const int n = cg * 384 + F.tid; const float* w = F.in[IN_WADA] + (size_t)(ks * 64) * 6144 + n; float a0 = 0.f, a1 = 0.f, a2 = 0.f, a3 = 0.f;
#pragma unroll 8
            for (int k = 0; k < 64; ++k) { const float wv = w[(size_t)k * 6144]; a0 += ca[k] * wv; a1 += ca[64 + k] * wv; a2 += ca[128 + k] * wv; a3 += ca[192 + k] * wv; }
            float* mp = (float*)(ws + WS_MODP) + (size_t)ks * 4 * 6144 + n; mp[0] = a0; mp[6144] = a1; mp[2 * 6144] = a2; mp[3 * 6144] = a3; }
        __syncthreads();
    }
    { float* cs = (float*)(ws + WS_CS); float* sn = (float*)(ws + WS_SN);
      for (int i = F.vcu * NTHR + F.tid; i < SEQ * 32; i += F.G * NTHR) { const int pos = i >> 5, k = i & 31; const float inv = powf(10000.0f, -(float)k / 32.0f); const float ang = (float)pos * inv; cs[i] = cosf(ang); sn[i] = sinf(ang); } }
    LAS float* scr = (LAS float*)(F.lds + 4096 + F.wave * 8704);
    const int gw = F.vcu * NWAVES + F.wave, NGW = F.G * NWAVES;
    constexpr int I_IN = 16 * 105, I_OUT = 16 * 32, I_GU = 16 * 16, I_DN = 4 * 32, I_W1 = 32 * 8;
    constexpr int NIT = I_IN + I_OUT + 64 * I_GU + 64 * I_DN + I_GU + I_DN + 2 * I_W1;
    for (int it = gw; it < NIT; it += NGW) {
        int r = it;
        if (r < I_IN) { const int kb = r / 105, nb = r % 105; p0_transpose_item(F.in[IN_WIN], 1024, INC, (bf16_t*)(ws + WS_WINT), 32 * nb, 64 * kb, 32 * nb, scr, F.lane); continue; } r -= I_IN;
        if (r < I_OUT) { const int kb = r / 32, nb = r % 32; p0_transpose_item(F.in[IN_WOUT], 1024, 1024, (bf16_t*)(ws + WS_WOUTT), 32 * nb, 64 * kb, 32 * nb, scr, F.lane); continue; } r -= I_OUT;
        if (r < 64 * I_GU) { const int e = r / I_GU, q = r % I_GU, kb = q / 16, nb = q % 16;
            p0_transpose_item<false, true>(F.in[IN_WGU] + (size_t)e * 1024 * 512, 1024, 512, (bf16_t*)(ws + WS_WGUT + (size_t)e * 512 * 1024), gu_row(32 * nb), 64 * kb, 32 * nb, scr, F.lane, WGU_SCALE); continue; } r -= 64 * I_GU;
        if (r < 64 * I_DN) { const int e = r / I_DN, q = r % I_DN, kb = q / 32, nb = q % 32;
            p0_transpose_item<false, true>(F.in[IN_WDN] + (size_t)e * 256 * 1024, 256, 1024, (bf16_t*)(ws + WS_WDNT + (size_t)e * 1024 * 256), 32 * nb, 64 * kb, 32 * nb, scr, F.lane, WDN_SCALE); continue; } r -= 64 * I_DN;
        if (r < I_GU) { const int kb = r / 16, nb = r % 16; p0_transpose_item<false, true>(F.in[IN_WSGU], 1024, 512, (bf16_t*)(ws + WS_WSGUT), gu_row(32 * nb), 64 * kb, 32 * nb, scr, F.lane, WGU_SCALE); continue; } r -= I_GU;
        if (r < I_DN) { const int kb = r / 32, nb = r % 32; p0_transpose_item<false, true>(F.in[IN_WSDN], 256, 1024, (bf16_t*)(ws + WS_WSDNT), 32 * nb, 64 * kb, 32 * nb, scr, F.lane, WDN_SCALE); continue; } r -= I_DN;
        { const int kv = r / I_W1, q = r % I_W1, kb = q / 8, nb = q % 8;
          p0_transpose_item<true>(F.in[kv ? IN_W1V : IN_W1K], 2048, 256, (bf16_t*)(ws + (kv ? WS_W1VT : WS_W1KT)), 32 * nb, 64 * kb, 32 * nb, scr, F.lane); }
    }
    { v4u* z = (v4u*)((bf16_t*)(ws + WS_WINT) + (size_t)3360 * 1024); const int n16 = 224 * 1024 * 2 / 16;
      for (int i = F.vcu * NTHR + F.tid; i < n16; i += F.G * NTHR) z[i] = (v4u){0u, 0u, 0u, 0u}; }
    { bf16_t* w2f = (bf16_t*)(ws + WS_W2T);
      for (int i = F.vcu * NTHR + F.tid; i < 2 * 256 * 64; i += F.G * NTHR) { const int kv = i >> 14, r = i & 16383, k = r >> 6, dd = r & 63; const float v = F.in[kv ? IN_W2V : IN_W2K][r];
          w2f[(size_t)kv * 16384 + ((size_t)((k >> 5) * 4 + (dd >> 4)) * 64 + ((k & 31) >> 3) * 16 + (dd & 15)) * 8 + (k & 7)] = f2bf(v); } }
    { bf16_t* hi = (bf16_t*)(ws + WS_RW); bf16_t* lo = hi + 64 * 1024; const float* rw = F.in[IN_RW];
      for (int i = F.vcu * NTHR + F.tid; i < 64 * 1024; i += F.G * NTHR) { const int k = i >> 6, e = i & 63; const float w = rw[i]; const bf16_t h = f2bf(w);
          const size_t o = ((size_t)((k >> 5) * 4 + (e >> 4)) * 64 + ((k & 31) >> 3) * 16 + (e & 15)) * 8 + (k & 7); hi[o] = h; lo[o] = f2bf(w - bf2f(h)); } }
}

__device__ __forceinline__ void p1a_norm(Frame& F) {
    unsigned char* ws = F.ws; const float* modp = (const float*)(ws + WS_MODP); const float* bada = F.in[IN_BADA];
    for (int i = F.vcu * NTHR + F.tid; i < BATCH * 6144; i += F.G * NTHR) { float a = bada[i % 6144];
#pragma unroll
        for (int ks = 0; ks < 16; ++ks) a += modp[(size_t)ks * 4 * 6144 + i];
        ((float*)(ws + WS_MOD))[i] = a; }
    for (int o = F.vcu * NWAVES + F.wave; o < 512; o += F.G * NWAVES) { const int kv = o >> 8, j = o & 255; const float* pe = F.in[kv ? IN_PEV : IN_PEK];
        const bf16_t* wf = (const bf16_t*)(ws + (kv ? WS_W1VT : WS_W1KT)); float a = 0.f;
#pragma unroll
        for (int i = 0; i < 4; ++i) { const int cid = F.lane + 64 * i, s = cid >> 2, q = cid & 3; const v4u wv = *(const v4u*)(wf + ((size_t)(s * 16 + (j >> 4)) * 64 + q * 16 + (j & 15)) * 8);
            const f32x4 p0 = *(const f32x4*)(pe + 32 * s + 8 * q), p1 = *(const f32x4*)(pe + 32 * s + 8 * q + 4);
            a += bf2f((bf16_t)(wv.x & 0xffff)) * p0[0] + bf2f((bf16_t)(wv.x >> 16)) * p0[1] + bf2f((bf16_t)(wv.y & 0xffff)) * p0[2] + bf2f((bf16_t)(wv.y >> 16)) * p0[3]
               + bf2f((bf16_t)(wv.z & 0xffff)) * p1[0] + bf2f((bf16_t)(wv.z >> 16)) * p1[1] + bf2f((bf16_t)(wv.w & 0xffff)) * p1[2] + bf2f((bf16_t)(wv.w >> 16)) * p1[3]; }
        a = wave_sum(a); if (F.lane == 0) ((float*)(ws + WS_B1F))[o] = a + F.in[kv ? IN_B1V : IN_B1K][j]; }
    LAS float* sh = (LAS float*)F.lds; LAS float* sc = sh + 1024;
    const float* g1 = F.in[IN_N1G]; const float* x = F.in[IN_X]; bf16_t* xn = (bf16_t*)(ws + WS_XN);
    for (int chunk = F.vcu; chunk < T / 64; chunk += F.G) {
        const int b = (chunk * 64) / SEQ;
        __syncthreads();
        for (int i = F.tid; i < 2048; i += NTHR) { const int col = i; float a = bada[col];
#pragma unroll
            for (int ks = 0; ks < 16; ++ks) a += modp[(size_t)(ks * 4 + b) * 6144 + col];
            sh[i] = a; }
        __syncthreads();
#pragma unroll 1
        for (int rr = 0; rr < 8; ++rr) {
            const int row = chunk * 64 + F.wave * 8 + rr; const f32x4* xr = (const f32x4*)(x + (size_t)row * D) + F.lane;
            f32x4 v[4]; float s = 0.f;
#pragma unroll
            for (int j = 0; j < 4; ++j) { v[j] = xr[64 * j]; s += (v[j].x * v[j].x + v[j].y * v[j].y) + (v[j].z * v[j].z + v[j].w * v[j].w); }
            const float rstd = 1.0f / sqrtf(wave_sum(s) * (1.0f / D) + EPS);
            unsigned long long* o8 = (unsigned long long*)(xn + (size_t)row * D) + F.lane;
#pragma unroll
            for (int j = 0; j < 4; ++j) { const int c0 = 4 * F.lane + 256 * j; const f32x4 g = *(const f32x4*)(g1 + c0);
                const float h0 = v[j].x * rstd * g.x * (1.0f + sc[c0]) + sh[c0], h1 = v[j].y * rstd * g.y * (1.0f + sc[c0 + 1]) + sh[c0 + 1];
                const float h2 = v[j].z * rstd * g.z * (1.0f + sc[c0 + 2]) + sh[c0 + 2], h3 = v[j].w * rstd * g.w * (1.0f + sc[c0 + 3]) + sh[c0 + 3];
                o8[64 * j] = (unsigned long long)pk2(h0, h1) | ((unsigned long long)pk2(h2, h3) << 32); }
        }
    }
    __syncthreads();
}


__device__ __forceinline__ float hg_lb(const float* lbl, int j) { return 1.0f / (1.0f + expf(lbl[512 + j] - lbl[j])); }
__device__ __forceinline__ void hg_passA(Frame& F, int unit) {
    unsigned char* ws = F.ws; const bf16_t* proj = (const bf16_t*)(ws + WS_PROJ); float* U = (float*)(ws + WS_U) + (size_t)unit * 16384; float* Dd = (float*)(ws + WS_DD) + (size_t)unit * 128;
    const int b = unit >> 6, h = (unit >> 4) & 3, J = unit & 15; const size_t tok0 = (size_t)b * SEQ + 256 * J;
    const int d = F.tid & 127, g = F.tid >> 7;
    LAS unsigned char* KT = F.lds; LAS unsigned char* VT = F.lds + 65536; LAS float* segtot = (LAS float*)(F.lds + LDSCTL_OFF + 512);
    const float lb = hg_lb(F.in[IN_LBL], h * 128 + d);
    const bf16_t* pf = proj + (tok0 + 64 * g) * LDP + C_HF + h * 128 + d; const bf16_t* pv = proj + (tok0 + 64 * g) * LDP + C_HI + h * 128 + d;
    __syncthreads();
    float fs[64]; unsigned short vraw[64];
#pragma unroll
    for (int s = 0; s < 64; ++s) { fs[s] = bf2f(pf[(size_t)s * LDP]); vraw[s] = pv[(size_t)s * LDP]; }
    float sum = 0.f;
#pragma unroll
    for (int s = 0; s < 64; ++s) { const float f = lb + (1.0f - lb) * fsigmoid(fs[s]); fs[s] = f; sum += __logf(f); }
    segtot[g * 128 + d] = sum;
    __syncthreads();
    float off = 0.f, Bt = 0.f;
#pragma unroll
    for (int k = 0; k < 4; ++k) { const float v = segtot[k * 128 + d]; Bt += v; if (k < g) off += v; }
    float run = off;
#pragma unroll
    for (int s8 = 0; s8 < 8; ++s8) { unsigned kk[4], vv[4];
#pragma unroll
        for (int i = 0; i < 4; ++i) { float kt[2];
#pragma unroll
            for (int j = 0; j < 2; ++j) { const int s = 8 * s8 + 2 * i + j; const float f = fs[s]; run += __logf(f); kt[j] = (1.0f - f) * fexp(Bt - run); }
            kk[i] = pk2(kt[0], kt[1]); vv[i] = (unsigned)vraw[8 * s8 + 2 * i] | ((unsigned)vraw[8 * s8 + 2 * i + 1] << 16); }
        const int c = (8 * g + s8) ^ (d & 31);
        *(LAS v4u*)(KT + d * 512 + c * 16) = (v4u){kk[0], kk[1], kk[2], kk[3]}; *(LAS v4u*)(VT + d * 512 + c * 16) = (v4u){vv[0], vv[1], vv[2], vv[3]}; }
    if (g == 0) Dd[d] = fexp(Bt);
    __syncthreads();
    const int dt = F.wave >> 1, et0 = 2 * (F.wave & 1), i = F.lane & 31, hh = F.lane >> 5;
    f32x16 acc[2];
#pragma unroll
    for (int k = 0; k < 16; ++k) { acc[0][k] = 0.f; acc[1][k] = 0.f; }
#pragma unroll 4
    for (int st = 0; st < 16; ++st) { const int ch = 2 * st + hh;
        const bf16x8 a = *(const LAS bf16x8*)(KT + (32 * dt + i) * 512 + ((ch ^ i) & 31) * 16);
#pragma unroll
        for (int t = 0; t < 2; ++t) { const bf16x8 bv = *(const LAS bf16x8*)(VT + (32 * (et0 + t) + i) * 512 + ((ch ^ i) & 31) * 16);
            acc[t] = __builtin_amdgcn_mfma_f32_32x32x16_bf16(a, bv, acc[t], 0, 0, 0); } }
#pragma unroll
    for (int t = 0; t < 2; ++t)
#pragma unroll
        for (int r = 0; r < 16; ++r) U[(size_t)(32 * dt + (r & 3) + 8 * (r >> 2) + 4 * hh) * 128 + 32 * (et0 + t) + i] = acc[t][r];
    __syncthreads();
}
__device__ __forceinline__ unsigned short bf16_rne(float x) { return (unsigned short)(cvt_pk_bf16(x, 0.f) & 0xffffu); }
__device__ __forceinline__ void hg_passC(Frame& F, int unit) {
    unsigned char* ws = F.ws; const bf16_t* proj = (const bf16_t*)(ws + WS_PROJ); bf16_t* mix = (bf16_t*)(ws + WS_MIX);
    const float* Uall = (const float*)(ws + WS_U); const float* Dall = (const float*)(ws + WS_DD);
    const int b = unit >> 6, h = (unit >> 4) & 3, J = unit & 15; const size_t tok0 = (size_t)b * SEQ + 256 * J;
    const int w = F.wave, n = F.lane & 15, q = F.lane >> 4;
    LAS bf16_t* QS = (LAS bf16_t*)F.lds; LAS bf16_t* KH = (LAS bf16_t*)(F.lds + 17408); LAS bf16_t* KT = (LAS bf16_t*)(F.lds + 34816); LAS bf16_t* VT = (LAS bf16_t*)(F.lds + 59392);
    LAS float* G = (LAS float*)(F.lds + 83968); LAS unsigned char* PT = F.lds + 86016; LAS float* SSP = (LAS float*)(F.lds + 88064);
    f32x4 S[8];
#pragma unroll
    for (int dt = 0; dt < 8; ++dt) S[dt] = (f32x4){0.f, 0.f, 0.f, 0.f};
    {
        LAS float* WJ = (LAS float*)F.lds;
        __syncthreads();
        if (F.tid < 128) { float dv[16];
#pragma unroll
            for (int j = 0; j < 16; ++j) dv[j] = (j < J) ? Dall[(size_t)(unit - J + j) * 128 + F.tid] : 1.0f;
            float wgt = 1.0f;
#pragma unroll
            for (int j = 15; j >= 0; --j) { if (j < J) { WJ[j * 128 + F.tid] = wgt; wgt *= dv[j]; } } }
        __syncthreads();
#pragma unroll 4
        for (int j = 0; j < J; ++j) { const float* Uj = Uall + (size_t)(unit - J + j) * 16384;
#pragma unroll
            for (int dt = 0; dt < 8; ++dt) { const f32x4 wv = *(const LAS f32x4*)(WJ + j * 128 + 16 * dt + 4 * q);
#pragma unroll
                for (int r = 0; r < 4; ++r) S[dt][r] += wv[r] * Uj[(size_t)(16 * dt + 4 * q + r) * 128 + 16 * w + n]; } }
        __syncthreads();
    }
    const int d = F.tid & 127, bk = F.tid >> 7; const float lb = hg_lb(F.in[IN_LBL], h * 128 + d);
    const int e0 = h * 128 + 16 * w + 4 * q; const f32x4 ng = *(const f32x4*)(F.in[IN_HNG] + e0);
    unsigned short rf[16], rq[16], rv[16]; v2u rg[4];
#define HG_LOAD(qt_) do { const bf16_t* pr_ = proj + (tok0 + 64 * (qt_) + 16 * bk) * LDP + h * 128 + d; \
        _Pragma("unroll") for (int i = 0; i < 16; ++i) { rf[i] = pr_[(size_t)i * LDP + C_HF]; rq[i] = pr_[(size_t)i * LDP + C_HQ]; rv[i] = pr_[(size_t)i * LDP + C_HI]; } \
        _Pragma("unroll") for (int bb = 0; bb < 4; ++bb) rg[bb] = *(const v2u*)(proj + (tok0 + 64 * (qt_) + 16 * bb + n) * LDP + C_HGT + e0); } while (0)
    HG_LOAD(0);
#pragma unroll 1
    for (int qt = 0; qt < 4; ++qt) {
        const size_t t0 = tok0 + 64 * qt;
        { float fv[16], E[16]; float run = 1.f;
#pragma unroll
          for (int i = 0; i < 16; ++i) { const float f = lb + (1.0f - lb) * fsigmoid(bf2f(rf[i])); fv[i] = f; run *= f; E[i] = run; }
          const float cc = run; unsigned kt[8], vv[8];
#pragma unroll
          for (int i = 0; i < 16; ++i) { const float inv = __builtin_amdgcn_rcpf(E[i]), kf = 1.0f - fv[i];
              QS[(bk * 16 + i) * 136 + d] = bf16_rne(bf2f(rq[i]) * 0.08838834764831845f * E[i]); KH[(bk * 16 + i) * 136 + d] = bf16_rne(kf * inv);
              const unsigned kb = bf16_rne(kf * cc * inv);
              if (i & 1) { kt[i >> 1] |= kb << 16; vv[i >> 1] |= (unsigned)rv[i] << 16; } else { kt[i >> 1] = kb; vv[i >> 1] = rv[i]; } }
          LAS v4u* kp = (LAS v4u*)(KT + (bk * 128 + d) * 24); kp[0] = (v4u){kt[0], kt[1], kt[2], kt[3]}; kp[1] = (v4u){kt[4], kt[5], kt[6], kt[7]};
          LAS v4u* vp = (LAS v4u*)(VT + (bk * 128 + d) * 24); vp[0] = (v4u){vv[0], vv[1], vv[2], vv[3]}; vp[1] = (v4u){vv[4], vv[5], vv[6], vv[7]};
          G[bk * 128 + d] = cc; }
        v2u gq[4];
#pragma unroll
        for (int bb = 0; bb < 4; ++bb) gq[bb] = rg[bb];
        if (qt < 3) HG_LOAD(qt + 1);
        __syncthreads();
        if (w < 4) { f32x4 pt = (f32x4){0.f, 0.f, 0.f, 0.f};
#pragma unroll
            for (int st = 0; st < 4; ++st) { const bf16x8 a = *(const LAS bf16x8*)(KH + (w * 16 + n) * 136 + 32 * st + 8 * q), bq = *(const LAS bf16x8*)(QS + (w * 16 + n) * 136 + 32 * st + 8 * q);
                pt = __builtin_amdgcn_mfma_f32_16x16x32_bf16(a, bq, pt, 0, 0, 0); }
            v2u o; o.x = cvt_pk_bf16((4 * q + 0) <= n ? pt[0] : 0.f, (4 * q + 1) <= n ? pt[1] : 0.f); o.y = cvt_pk_bf16((4 * q + 2) <= n ? pt[2] : 0.f, (4 * q + 3) <= n ? pt[3] : 0.f);
            *(LAS v2u*)(PT + (w * 64 + F.lane) * 8) = o; }
        __syncthreads();
        f32x4 ob[4]; float ssb[4];
#pragma unroll
        for (int bb = 0; bb < 4; ++bb) {
            f32x4 o = (f32x4){0.f, 0.f, 0.f, 0.f};
#pragma unroll
            for (int st = 0; st < 4; ++st) {
                const v2u s0 = (v2u){cvt_pk_bf16(S[2 * st][0], S[2 * st][1]), cvt_pk_bf16(S[2 * st][2], S[2 * st][3])}, s1 = (v2u){cvt_pk_bf16(S[2 * st + 1][0], S[2 * st + 1][1]), cvt_pk_bf16(S[2 * st + 1][2], S[2 * st + 1][3])};
                const bf16x8 a = __builtin_bit_cast(bf16x8, (v4u){s0.x, s0.y, s1.x, s1.y});
                const v2u q0 = *(const LAS v2u*)(QS + (bb * 16 + n) * 136 + 32 * st + 4 * q), q1 = *(const LAS v2u*)(QS + (bb * 16 + n) * 136 + 32 * st + 16 + 4 * q);
                const bf16x8 bq = __builtin_bit_cast(bf16x8, (v4u){q0.x, q0.y, q1.x, q1.y});
                o = __builtin_amdgcn_mfma_f32_16x16x32_bf16(a, bq, o, 0, 0, 0); }
            { const v2u va = *(const LAS v2u*)(VT + (bb * 128 + 16 * w + n) * 24 + 4 * q); const bf16x8 a = __builtin_bit_cast(bf16x8, (v4u){va.x, va.y, 0u, 0u});
              const v2u pb = *(const LAS v2u*)(PT + (bb * 64 + F.lane) * 8); const bf16x8 pB = __builtin_bit_cast(bf16x8, (v4u){pb.x, pb.y, 0u, 0u});
              o = __builtin_amdgcn_mfma_f32_16x16x32_bf16(a, pB, o, 0, 0, 0); }
            { bf16x8 bv; if (q < 2) bv = *(const LAS bf16x8*)(VT + (bb * 128 + 16 * w + n) * 24 + 8 * q); else bv = (bf16x8){0, 0, 0, 0, 0, 0, 0, 0};
#pragma unroll
              for (int dt = 0; dt < 8; ++dt) { const f32x4 gv = *(const LAS f32x4*)(G + bb * 128 + 16 * dt + 4 * q); S[dt] = S[dt] * gv;
                  bf16x8 a; if (q < 2) a = *(const LAS bf16x8*)(KT + (bb * 128 + 16 * dt + n) * 24 + 8 * q); else a = (bf16x8){0, 0, 0, 0, 0, 0, 0, 0};
                  S[dt] = __builtin_amdgcn_mfma_f32_16x16x32_bf16(a, bv, S[dt], 0, 0, 0); } }
            float ss = (o[0] * o[0] + o[1] * o[1]) + (o[2] * o[2] + o[3] * o[3]); ss += __shfl_xor(ss, 16); ss += __shfl_xor(ss, 32);
            ob[bb] = o; ssb[bb] = ss;
        }
        if (q == 0) {
#pragma unroll
            for (int bb = 0; bb < 4; ++bb) SSP[w * 64 + 16 * bb + n] = ssb[bb]; }
        __syncthreads();
#pragma unroll
        for (int bb = 0; bb < 4; ++bb) { float tots = 0.f;
#pragma unroll
            for (int k = 0; k < 8; ++k) tots += SSP[k * 64 + 16 * bb + n];
            const float rstd = 1.0f / sqrtf(tots * (1.0f / 128.0f) + EPS); const v2u gt = gq[bb];
            const float g0 = bf2f((bf16_t)(gt.x & 0xffff)), g1 = bf2f((bf16_t)(gt.x >> 16)), g2 = bf2f((bf16_t)(gt.y & 0xffff)), g3 = bf2f((bf16_t)(gt.y >> 16));
            v2u ov; ov.x = cvt_pk_bf16(ob[bb][0] * rstd * ng[0] * fsilu(g0), ob[bb][1] * rstd * ng[1] * fsilu(g1)); ov.y = cvt_pk_bf16(ob[bb][2] * rstd * ng[2] * fsilu(g2), ob[bb][3] * rstd * ng[3] * fsilu(g3));
            *(v2u*)(mix + (t0 + 16 * bb + n) * D + e0) = ov; }
    }
#undef HG_LOAD
    __syncthreads();
}

constexpr int LG_P = 65;
__device__ __forceinline__ void p5_router(Frame& F) {
    unsigned char* ws = F.ws; const float* x2 = (const float*)(ws + WS_X2); const float* mod = (const float*)(ws + WS_MOD); const float* g2 = F.in[IN_N2G];
    const bf16_t* rwh = (const bf16_t*)(ws + WS_RW); const bf16_t* rwl = rwh + 64 * 1024; bf16_t* H2 = (bf16_t*)(ws + WS_H2);
    int* TOPI = (int*)(ws + WS_TOPI); float* TOPW = (float*)(ws + WS_TOPW); int* ROWL = (int*)(ws + WS_ROWL); int* ERANK = (int*)(ws + WS_ERANK); unsigned* ECNT = F.ctl + CW_ECNT;
    LAS float* LG = (LAS float*)F.lds;
    LAS float* GS = LG + 64 * LG_P;
    LAS float* WSL = GS + 512;
    LAS int* EI = (LAS int*)(WSL + 512);
    LAS unsigned* LCNT = (LAS unsigned*)(EI + 512);
    LAS unsigned* LBASE = LCNT + 64;
    LAS float* GSL = (LAS float*)(LBASE + 64);
    LAS float* SHL = GSL + 1024;
    const int r = F.lane & 15, q = F.lane >> 4, rt = F.wave & 3, eh = F.wave >> 2;
    for (int unit = F.vcu; unit < T / 64; unit += F.G) {
        const int row0 = unit * 64, b = row0 / SEQ, row = row0 + 16 * rt + r;
        __syncthreads();
        if (F.tid < 64) LCNT[F.tid] = 0u;
        for (int k = F.tid; k < 1024; k += NTHR) { GSL[k] = g2[k] * (1.0f + mod[(size_t)b * 6144 + 4 * 1024 + k]); SHL[k] = mod[(size_t)b * 6144 + 3 * 1024 + k]; }
        const float* xr = x2 + (size_t)row * D + 8 * q;
        float ss; { const f32x4* sp = (const f32x4*)((const float*)(ws + WS_SSQ) + (size_t)row * 16); const f32x4 s0 = sp[0], s1 = sp[1], s2 = sp[2], s3 = sp[3];
            ss = ((s0[0] + s0[1]) + (s0[2] + s0[3])) + ((s1[0] + s1[1]) + (s1[2] + s1[3])) + ((s2[0] + s2[1]) + (s2[2] + s2[3])) + ((s3[0] + s3[1]) + (s3[2] + s3[3])); }
        const float rstd = 1.0f / sqrtf(ss * (1.0f / D) + EPS);
        __syncthreads();
#ifndef PROBE_R7
#define PROBE_R7 0
#endif
        f32x4 acc[2];
        for (int rep7_ = 0; rep7_ <= PROBE_R7; ++rep7_) {
        acc[0] = (f32x4){0.f, 0.f, 0.f, 0.f}; acc[1] = acc[0];
        const bf16_t* rwh0 = rwh + ((size_t)(2 * eh) * 64 + F.lane) * 8; const bf16_t* rwl0 = rwl + ((size_t)(2 * eh) * 64 + F.lane) * 8;
#pragma unroll 1
        for (int s4 = 0; s4 < 32; s4 += 4) {
            f32x4 xa[4][2]; bf16x8 bh[4][2], bl[4][2];
#pragma unroll
            for (int u = 0; u < 4; ++u) { const int s = s4 + u; xa[u][0] = *(const f32x4*)(xr + 32 * s); xa[u][1] = *(const f32x4*)(xr + 32 * s + 4);
                bh[u][0] = *(const bf16x8*)(rwh0 + (size_t)s * 2048); bl[u][0] = *(const bf16x8*)(rwl0 + (size_t)s * 2048); bh[u][1] = *(const bf16x8*)(rwh0 + (size_t)s * 2048 + 512); bl[u][1] = *(const bf16x8*)(rwl0 + (size_t)s * 2048 + 512); }
            __builtin_amdgcn_sched_barrier(0);
#pragma unroll
            for (int u = 0; u < 4; ++u) { const int s = s4 + u; float gv[8], sh[8];
                *(f32x4*)&gv[0] = *(const LAS f32x4*)(GSL + 32 * s + 8 * q); *(f32x4*)&gv[4] = *(const LAS f32x4*)(GSL + 32 * s + 8 * q + 4);
                *(f32x4*)&sh[0] = *(const LAS f32x4*)(SHL + 32 * s + 8 * q); *(f32x4*)&sh[4] = *(const LAS f32x4*)(SHL + 32 * s + 8 * q + 4);
                bf16x8 ahi, alo; float hf[8];
#pragma unroll
                for (int j = 0; j < 8; ++j) { const float h = xa[u][j >> 2][j & 3] * rstd * gv[j] + sh[j]; hf[j] = h; const bf16_t hb = f2bf(h); ahi[j] = (short)hb; alo[j] = (short)f2bf(h - bf2f(hb)); }
                if (eh == 0) *(v2u*)((unsigned char*)H2 + (size_t)row * D + 32 * s + 8 * q) = (v2u){pk4_e4m3(hf[0], hf[1], hf[2], hf[3], 1.0f), pk4_e4m3(hf[4], hf[5], hf[6], hf[7], 1.0f)};
                acc[0] = __builtin_amdgcn_mfma_f32_16x16x32_bf16(ahi, bh[u][0], acc[0], 0, 0, 0); acc[0] = __builtin_amdgcn_mfma_f32_16x16x32_bf16(ahi, bl[u][0], acc[0], 0, 0, 0); acc[0] = __builtin_amdgcn_mfma_f32_16x16x32_bf16(alo, bh[u][0], acc[0], 0, 0, 0);
                acc[1] = __builtin_amdgcn_mfma_f32_16x16x32_bf16(ahi, bh[u][1], acc[1], 0, 0, 0); acc[1] = __builtin_amdgcn_mfma_f32_16x16x32_bf16(ahi, bl[u][1], acc[1], 0, 0, 0); acc[1] = __builtin_amdgcn_mfma_f32_16x16x32_bf16(alo, bh[u][1], acc[1], 0, 0, 0); }
        }
        }
#pragma unroll
        for (int nt = 0; nt < 2; ++nt)
#pragma unroll
            for (int i = 0; i < 4; ++i) LG[(16 * rt + 4 * q + i) * LG_P + 32 * eh + 16 * nt + r] = acc[nt][i];
        __syncthreads();
        const int t = F.tid >> 3, g = F.tid & 7; const float* rb = F.in[IN_RB];
        float sc8[8], ch8[8]; float a1 = -3e38f, a2 = -3e38f;
#pragma unroll
        for (int j = 0; j < 8; ++j) { const float s_ = 1.0f / (1.0f + expf(-LG[t * LG_P + 8 * g + j])); sc8[j] = s_; const float c_ = s_ + rb[8 * g + j]; ch8[j] = c_; if (c_ > a1) { a2 = a1; a1 = c_; } else if (c_ > a2) a2 = c_; }
        GS[t * 8 + g] = a1 + a2;
        __syncthreads();
#pragma unroll
        for (int j = 0; j < 8; ++j) LG[t * LG_P + 8 * g + j] = ch8[j];
        int grank = 0; const float myg = GS[t * 8 + g];
#pragma unroll
        for (int k = 0; k < 8; ++k) { const float o = GS[t * 8 + k]; if (o > myg || (o == myg && k < g)) ++grank; }
        const bool gsel = grank < 4;
        const unsigned long long bal = __ballot(gsel); const unsigned gmask = (unsigned)(bal >> (F.lane & ~7)) & 0xffu;
        __syncthreads();
        if (gsel) {
            int rk[8];
#pragma unroll
            for (int j = 0; j < 8; ++j) rk[j] = 0;
            for (int k = 0; k < 8; ++k) { if (!((gmask >> k) & 1u)) continue;
#pragma unroll
                for (int jj = 0; jj < 8; ++jj) { const float o = LG[t * LG_P + 8 * k + jj]; const int oe = 8 * k + jj;
#pragma unroll
                    for (int j = 0; j < 8; ++j) { if (o > ch8[j] || (o == ch8[j] && oe < 8 * g + j)) ++rk[j]; } } }
#pragma unroll
            for (int j = 0; j < 8; ++j) if (rk[j] < 8) { WSL[t * 8 + rk[j]] = sc8[j]; EI[t * 8 + rk[j]] = 8 * g + j; }
        }
        __syncthreads();
        float wsum = 0.f;
#pragma unroll
        for (int k = 0; k < 8; ++k) wsum += WSL[t * 8 + k];
        const int e = EI[t * 8 + g]; const float w = WSL[t * 8 + g] / wsum * 2.5f;
        const int aid = (row0 + t) * 8 + g;
        TOPI[aid] = e; TOPW[aid] = w;
        const unsigned lp = atomicAdd((unsigned*)&LCNT[e], 1u);
        __syncthreads();
        if (F.tid < 64) { const unsigned c = LCNT[F.tid]; LBASE[F.tid] = c ? atomicAdd(&ECNT[F.tid], c) : 0u; }
        __syncthreads();
        { const unsigned rk = LBASE[e] + lp; ROWL[(size_t)e * T + rk] = aid; ERANK[aid] = (int)rk; }
    }
    __syncthreads();
}


struct MoeTabs { LAS unsigned* cnt; LAS unsigned* tstart; LAS unsigned short* tex; int ntr; };
__device__ __forceinline__ MoeTabs moe_tabs_build(Frame& F) {
    MoeTabs Tb; Tb.cnt = (LAS unsigned*)(F.lds + LDSCTL_OFF + 512); Tb.tstart = Tb.cnt + 64; Tb.tex = (LAS unsigned short*)(Tb.tstart + 68);
    __syncthreads();
    if (F.tid < 64) { unsigned c = __hip_atomic_load(F.ctl + CW_ECNT + F.tid, RLX_AGENT); Tb.cnt[F.tid] = c > (unsigned)T ? (unsigned)T : c; }
    __syncthreads();
    if (F.tid == 0) { unsigned a = 0; for (int e = 0; e < 64; ++e) { Tb.tstart[e] = a; a += (Tb.cnt[e] + 255u) >> 8; } Tb.tstart[64] = a; }
    __syncthreads();
    Tb.ntr = (int)Tb.tstart[64];
    for (int tau = F.tid; tau < Tb.ntr; tau += NTHR) { int e = 0; for (int k = 0; k < 64; ++k) if (Tb.tstart[k] <= (unsigned)tau) e = k; Tb.tex[tau] = (unsigned short)e; }
    __syncthreads();
    return Tb;
}
__device__ __forceinline__ int xcd_chunk(int L, int n) { const int q = n / 8, r = n % 8, xcd = L % 8, off = L / 8; return (xcd < r ? xcd * (q + 1) : r * (q + 1) + (xcd - r) * q) + off; }
struct GateUpSched {
    MoeTabs Tb; const char* H2; const char* Wgu; const char* Wsgu; const int* rowl; int G, c;
    __device__ __forceinline__ bool next(int i, gm::Unit& u) const {
        const int nun = 2 * Tb.ntr + 2 * (T / 256); const long L = (long)i * G + c; if (L >= nun) return false;
        const int w = xcd_chunk((int)L, nun); u.A = H2;
        if (w < 2 * Tb.ntr) { const int tau = w >> 1; u.pn = w & 1; u.e = Tb.tex[tau]; u.m0 = 256 * (tau - (int)Tb.tstart[u.e]); u.pm = tau; u.B = Wgu + (size_t)u.e * 512 * 1024 + (size_t)u.pn * 256 * 1024; }
        else { const int s = w - 2 * Tb.ntr; u.pm = s >> 1; u.pn = s & 1; u.e = 64; u.m0 = 256 * u.pm; u.B = Wsgu + (size_t)u.pn * 256 * 1024; }
        return true;
    }
    __device__ __forceinline__ unsigned arow(const gm::Unit& u, int r) const {
        if (u.e == 64) return (unsigned)(u.m0 + r) * 1024u;
        const int idx = u.m0 + r; const int aid = idx < (int)Tb.cnt[u.e] ? rowl[(size_t)u.e * T + idx] : 0;
        return (unsigned)(aid >> 3) * 1024u;
    }
};
struct EpiSwiglu {
    static constexpr bool PERM = true;
    unsigned char* act; unsigned char* acts;
    __device__ __forceinline__ void operator()(const f32x4 (&acc)[2][2][4][2], const gm::Unit& u, int wr, int wc, int fr, int fq) const {
        unsigned char* O = (u.e == 64 ? acts : act) + (size_t)(u.pm * 256 + wr * 64 + fr) * 256 + 128 * u.pn + wc * 32 + 8 * fq; const float is = 1.0f / WGU_SCALE;
#pragma unroll
        for (int ai = 0; ai < 2; ++ai)
#pragma unroll
            for (int m = 0; m < 4; ++m) { const f32x4 g0 = acc[ai][0][m][0] * is, g1 = acc[ai][0][m][1] * is, u0 = acc[ai][1][m][0] * is, u1 = acc[ai][1][m][1] * is;
                *(v2u*)(O + (size_t)(ai * 128 + m * 16) * 256) = (v2u){pk4_e4m3(fsilu(g0[0]) * u0[0], fsilu(g0[1]) * u0[1], fsilu(g0[2]) * u0[2], fsilu(g0[3]) * u0[3], ACT_SCALE),
                                                                      pk4_e4m3(fsilu(g1[0]) * u1[0], fsilu(g1[1]) * u1[1], fsilu(g1[2]) * u1[2], fsilu(g1[3]) * u1[3], ACT_SCALE)}; }
    }
};
struct DownSched {
    MoeTabs Tb; const char* act; const char* acts; const char* Wdn; const char* Wsdn; int G, c;
    __device__ __forceinline__ bool next(int i, gm::Unit& u) const {
        const int nun = 4 * Tb.ntr + 4 * (T / 256); const long L = (long)i * G + c; if (L >= nun) return false;
        const int w = xcd_chunk((int)L, nun);
        if (w < 4 * Tb.ntr) { const int tau = w >> 2; u.pn = w & 3; u.e = Tb.tex[tau]; u.m0 = 256 * (tau - (int)Tb.tstart[u.e]); u.pm = tau;
            u.A = act + (size_t)tau * 256 * 256; u.B = Wdn + (size_t)u.e * 1024 * 256 + (size_t)u.pn * 256 * 256; }
        else { const int s = w - 4 * Tb.ntr; u.pm = s >> 2; u.pn = s & 3; u.e = 64; u.m0 = 256 * u.pm; u.A = acts + (size_t)u.pm * 256 * 256; u.B = Wsdn + (size_t)u.pn * 256 * 256; }
        return true;
    }
    __device__ __forceinline__ unsigned arow(const gm::Unit&, int r) const { return (unsigned)r * 256u; }
};
typedef float f32x2_t __attribute__((ext_vector_type(2)));
__device__ __forceinline__ unsigned pk4_fp8(float a, float b, float c, float d) {
    a = fminf(fmaxf(a * 16.0f, -448.0f), 448.0f); b = fminf(fmaxf(b * 16.0f, -448.0f), 448.0f); c = fminf(fmaxf(c * 16.0f, -448.0f), 448.0f); d = fminf(fmaxf(d * 16.0f, -448.0f), 448.0f);
    int w = __builtin_amdgcn_cvt_pk_fp8_f32(a, b, 0, false); w = __builtin_amdgcn_cvt_pk_fp8_f32(c, d, w, true); return (unsigned)w;
}
struct EpiDown {
    static constexpr bool PERM = true;
    unsigned char* Y8; bf16_t* YS;
    __device__ __forceinline__ void operator()(const f32x4 (&acc)[2][2][4][2], const gm::Unit& u, int wr, int wc, int fr, int fq) const {
        const size_t off = (size_t)(u.pm * 256 + wr * 64 + fr) * 1024 + u.pn * 256 + wc * 32 + 8 * fq;
        if (u.e == 64) {
#pragma unroll
            for (int ai = 0; ai < 2; ++ai)
#pragma unroll
                for (int m = 0; m < 4; ++m)
#pragma unroll
                    for (int bj = 0; bj < 2; ++bj) { const f32x4 v0 = acc[ai][bj][m][0] * (1.0f / (WDN_SCALE * ACT_SCALE)), v1 = acc[ai][bj][m][1] * (1.0f / (WDN_SCALE * ACT_SCALE));
                        v4u w; w.x = cvt_pk_bf16(v0[0], v0[1]); w.y = cvt_pk_bf16(v0[2], v0[3]); w.z = cvt_pk_bf16(v1[0], v1[1]); w.w = cvt_pk_bf16(v1[2], v1[3]);
                        *(v4u*)(YS + off + (size_t)(ai * 128 + m * 16) * 1024 + bj * 128) = w; }
        } else {
#pragma unroll
            for (int ai = 0; ai < 2; ++ai)
#pragma unroll
                for (int m = 0; m < 4; ++m)
#pragma unroll
                    for (int bj = 0; bj < 2; ++bj) { const f32x4 v0 = acc[ai][bj][m][0] * (1.0f / (WDN_SCALE * ACT_SCALE)), v1 = acc[ai][bj][m][1] * (1.0f / (WDN_SCALE * ACT_SCALE));
                        *(v2u*)(Y8 + off + (size_t)(ai * 128 + m * 16) * 1024 + bj * 128) = (v2u){pk4_fp8(v0[0], v0[1], v0[2], v0[3]), pk4_fp8(v1[0], v1[1], v1[2], v1[3])}; }
        }
    }
};

__device__ __forceinline__ void p8_final(Frame& F) {
    unsigned char* ws = F.ws; const unsigned char* Y = (const unsigned char*)(ws + WS_Y); const bf16_t* YS = (const bf16_t*)(ws + WS_YS);
    const float* x2 = (const float*)(ws + WS_X2); const float* mod = (const float*)(ws + WS_MOD); const float* fg = F.in[IN_FG];
    const int* TOPI = (const int*)(ws + WS_TOPI); const float* TOPW = (const float*)(ws + WS_TOPW); const int* ERANK = (const int*)(ws + WS_ERANK);
    const MoeTabs Tb = moe_tabs_build(F);
    const int w = F.wave;
    for (int unit = F.vcu; unit < T / 64; unit += F.G) {
        const int row0 = unit * 64 + 8 * w, b = row0 / SEQ;
        const int aid = row0 * 8 + F.lane; const int e = TOPI[aid]; const float wl = TOPW[aid]; const unsigned prl = 256u * Tb.tstart[e] + (unsigned)ERANK[aid];
        v2u ybA[8]; v4u ysA; v2u ybB[8]; v4u ysB;
#define P10_LOAD(yb, ysb, rr_, sg_) do { const int t_ = row0 + (rr_); _Pragma("unroll") for (int sl = 0; sl < 8; ++sl) { const unsigned pr_ = (unsigned)__shfl((int)prl, (rr_) * 8 + sl); \
            yb[sl] = *(const v2u*)(Y + (size_t)pr_ * 1024 + (sg_) * 512 + 8 * F.lane); } \
            ysb = *(const v4u*)(YS + (size_t)t_ * 1024 + (sg_) * 512 + 8 * F.lane); } while (0)
#define P10_HALF(yb, ysb, rr_, sg_) do { const int t = row0 + (rr_); float moe[8]; \
            { const unsigned vw[4] = {ysb.x, ysb.y, ysb.z, ysb.w}; \
                _Pragma("unroll") for (int k = 0; k < 4; ++k) { moe[2 * k] = bf2f((bf16_t)(vw[k] & 0xffff)); moe[2 * k + 1] = bf2f((bf16_t)(vw[k] >> 16)); } } \
            _Pragma("unroll") for (int sl = 0; sl < 8; ++sl) { const float wgt = __shfl(wl, (rr_) * 8 + sl) * 0.0625f; \
                const f32x2_t d0 = __builtin_amdgcn_cvt_pk_f32_fp8((int)yb[sl].x, false), d1 = __builtin_amdgcn_cvt_pk_f32_fp8((int)yb[sl].x, true), d2 = __builtin_amdgcn_cvt_pk_f32_fp8((int)yb[sl].y, false), d3 = __builtin_amdgcn_cvt_pk_f32_fp8((int)yb[sl].y, true); \
                moe[0] += wgt * d0[0]; moe[1] += wgt * d0[1]; moe[2] += wgt * d1[0]; moe[3] += wgt * d1[1]; moe[4] += wgt * d2[0]; moe[5] += wgt * d2[1]; moe[6] += wgt * d3[0]; moe[7] += wgt * d3[1]; } \
            _Pragma("unroll") for (int h = 0; h < 2; ++h) { const int c0 = (sg_) * 512 + 8 * F.lane + 4 * h; \
                const f32x4 xv = *(const f32x4*)(x2 + (size_t)t * D + c0), gv = *(const f32x4*)(mod + (size_t)b * 6144 + 5 * 1024 + c0); \
                _Pragma("unroll") for (int j = 0; j < 4; ++j) { const float v = xv[j] + gv[j] * moe[4 * h + j]; x3[(sg_) * 8 + 4 * h + j] = v; ss += v * v; } } } while (0)
        P10_LOAD(ybA, ysA, 0, 0);
#pragma unroll 1
        for (int rr = 0; rr < 8; ++rr) {
            float x3[16]; float ss = 0.f;
            P10_LOAD(ybB, ysB, rr, 1);
            P10_HALF(ybA, ysA, rr, 0);
            if (rr < 7) P10_LOAD(ybA, ysA, rr + 1, 0);
            P10_HALF(ybB, ysB, rr, 1);
            const int t = row0 + rr;
            const float rstd = 1.0f / sqrtf(wave_sum(ss) * (1.0f / D) + EPS);
#pragma unroll
            for (int sg = 0; sg < 2; ++sg)
#pragma unroll
                for (int h = 0; h < 2; ++h) { const int c0 = sg * 512 + 8 * F.lane + 4 * h; const f32x4 gg = *(const f32x4*)(fg + c0); f32x4 o;
#pragma unroll
                    for (int j = 0; j < 4; ++j) o[j] = x3[sg * 8 + 4 * h + j] * rstd * gg[j];
                    *(f32x4*)(F.out + (size_t)t * D + c0) = o; }
        }
#undef P10_HALF
#undef P10_LOAD
    }
    __syncthreads();
}

__device__ __forceinline__ float fgelu_tanh(float z) { const float u = 0.7978845608028654f * (z + 0.044715f * z * z * z); const float e = __expf(2.0f * u); return 0.5f * z * (1.0f + (e - 1.0f) / (e + 1.0f)); }
__device__ __forceinline__ float fgelu_safe(float z) { const float u = 0.7978845608028654f * (z + 0.044715f * z * z * z); const float uc = fminf(fmaxf(u, -15.f), 15.f); const float e = fexp(2.0f * uc); return 0.5f * z * (1.0f + (e - 1.0f) / (e + 1.0f)); }

__device__ __forceinline__ void cmp_unit(Frame& F, int unit) {
    unsigned char* ws = F.ws; const bf16_t* proj = (const bf16_t*)(ws + WS_PROJ);
    const int kv = unit >> 6, mb = unit & 63; const bf16_t* W1T = (const bf16_t*)(ws + (kv ? WS_W1VT : WS_W1KT)); const int coloff = kv ? C_VC : C_KC;
    const float* b1f = (const float*)(ws + WS_B1F) + kv * 256;
    const int w = F.wave, n = F.lane & 15, q = F.lane >> 4;
    LAS bf16_t* HID = (LAS bf16_t*)F.lds;
    size_t base[2];
#pragma unroll
    for (int rt = 0; rt < 2; ++rt) { const int R = 32 * mb + 16 * rt + n, bg = R >> 8; int c = R & 255; if (c > 254) c = 254; base[rt] = ((size_t)(bg >> 1) * SEQ + 16 * c) * LDP + coloff + (bg & 1) * 64; }
    f32x4 acc[2][2];
#pragma unroll
    for (int rt = 0; rt < 2; ++rt)
#pragma unroll
        for (int ct = 0; ct < 2; ++ct) acc[rt][ct] = (f32x4){0.f, 0.f, 0.f, 0.f};
    __syncthreads();
#pragma unroll 1
    for (int s8 = 0; s8 < 64; s8 += 8) {
        bf16x8 a[8][2], bb[8][2];
#pragma unroll
        for (int u = 0; u < 8; ++u) { const int s = s8 + u, ltok = s >> 1, dd = 32 * (s & 1) + 8 * q;
#pragma unroll
            for (int rt = 0; rt < 2; ++rt) a[u][rt] = *(const bf16x8*)(proj + base[rt] + (size_t)ltok * LDP + dd);
#pragma unroll
            for (int ct = 0; ct < 2; ++ct) bb[u][ct] = *(const bf16x8*)(W1T + ((size_t)(s * 16 + 2 * w + ct) * 64 + F.lane) * 8); }
        __builtin_amdgcn_sched_barrier(0);
#pragma unroll
        for (int u = 0; u < 8; ++u)
#pragma unroll
            for (int rt = 0; rt < 2; ++rt)
#pragma unroll
                for (int ct = 0; ct < 2; ++ct) acc[rt][ct] = __builtin_amdgcn_mfma_f32_16x16x32_bf16(bb[u][ct], a[u][rt], acc[rt][ct], 0, 0, 0);
    }
#pragma unroll
    for (int rt = 0; rt < 2; ++rt)
#pragma unroll
        for (int ct = 0; ct < 2; ++ct) { const int col = 32 * w + 16 * ct + 4 * q; const f32x4 bv = *(const f32x4*)(b1f + col); const f32x4 v = acc[rt][ct] + bv;
            v2u o; o.x = cvt_pk_bf16(fgelu_safe(v[0]), fgelu_safe(v[1])); o.y = cvt_pk_bf16(fgelu_safe(v[2]), fgelu_safe(v[3]));
            *(LAS v2u*)(HID + (16 * rt + n) * 264 + col) = o; }
    __syncthreads();
    { const int rt = w & 1, ct = w >> 1; f32x4 o = (f32x4){0.f, 0.f, 0.f, 0.f};
      const bf16_t* w2f = (const bf16_t*)(ws + WS_W2T) + (size_t)kv * 16384;
#pragma unroll
      for (int s = 0; s < 8; ++s) { const bf16x8 a = *(const LAS bf16x8*)(HID + (16 * rt + n) * 264 + 32 * s + 8 * q); const bf16x8 bw = *(const bf16x8*)(w2f + ((size_t)(s * 4 + ct) * 64 + F.lane) * 8);
          o = __builtin_amdgcn_mfma_f32_16x16x32_bf16(bw, a, o, 0, 0, 0); }
      const int R = 32 * mb + 16 * rt + n, bg = R >> 8, c = R & 255, d0 = 16 * ct + 4 * q;
      if (c == 255) o = (f32x4){0.f, 0.f, 0.f, 0.f};
      if (kv == 0) { v2u ov; ov.x = cvt_pk_bf16(o[0], o[1]); ov.y = cvt_pk_bf16(o[2], o[3]); *(v2u*)((bf16_t*)(ws + WS_KCMP) + ((size_t)bg * 256 + c) * 64 + d0) = ov; }
      else { bf16_t* vt = (bf16_t*)(ws + WS_VCMPT) + (size_t)bg * 64 * 256 + c;
#pragma unroll
          for (int r = 0; r < 4; ++r) vt[(size_t)(d0 + r) * 256] = f2bf(o[r]); } }
    __syncthreads();
}

__device__ __forceinline__ void kv_prep_unit(Frame& F, int unit) {
    unsigned char* ws = F.ws; const bf16_t* proj = (const bf16_t*)(ws + WS_PROJ); const float* cs = (const float*)(ws + WS_CS); const float* sn = (const float*)(ws + WS_SN);
    const int b = unit >> 6, tile = unit & 63; const size_t tok0 = (size_t)b * SEQ + 64 * tile;
#pragma unroll
    for (int it = 0; it < 2; ++it) { const int id = F.tid + 512 * it; const int c = id & 3, g = (id >> 2) & 1, wh = (id >> 3) & 1, tk = id >> 4; const int pos = 64 * tile + tk;
        const bf16_t* src = proj + (tok0 + tk) * LDP + (wh ? C_KW : C_KS) + g * 64 + 8 * c; const v4u lo = *(const v4u*)src, hi = *(const v4u*)(src + 32);
        const f32x4 c0 = *(const f32x4*)(cs + pos * 32 + 8 * c), c1 = *(const f32x4*)(cs + pos * 32 + 8 * c + 4), s0 = *(const f32x4*)(sn + pos * 32 + 8 * c), s1 = *(const f32x4*)(sn + pos * 32 + 8 * c + 4);
        float a[8], bb[8], co[8], si[8];
        const unsigned lw[4] = {lo.x, lo.y, lo.z, lo.w}, hw[4] = {hi.x, hi.y, hi.z, hi.w};
#pragma unroll
        for (int k = 0; k < 4; ++k) { a[2 * k] = bf2f((bf16_t)(lw[k] & 0xffff)); a[2 * k + 1] = bf2f((bf16_t)(lw[k] >> 16)); bb[2 * k] = bf2f((bf16_t)(hw[k] & 0xffff)); bb[2 * k + 1] = bf2f((bf16_t)(hw[k] >> 16)); co[k] = c0[k]; co[4 + k] = c1[k]; si[k] = s0[k]; si[4 + k] = s1[k]; }
        unsigned olp[4], ohp[4];
#pragma unroll
        for (int k = 0; k < 4; ++k) { olp[k] = pk2(a[2 * k] * co[2 * k] - bb[2 * k] * si[2 * k], a[2 * k + 1] * co[2 * k + 1] - bb[2 * k + 1] * si[2 * k + 1]);
            ohp[k] = pk2(bb[2 * k] * co[2 * k] + a[2 * k] * si[2 * k], bb[2 * k + 1] * co[2 * k + 1] + a[2 * k + 1] * si[2 * k + 1]); }
        bf16_t* dst = (bf16_t*)(ws + (wh ? WS_KWR : WS_KSR)) + (((size_t)(b * 2 + g) * SEQ) + pos) * 64 + 8 * c; *(v4u*)dst = (v4u){olp[0], olp[1], olp[2], olp[3]}; *(v4u*)(dst + 32) = (v4u){ohp[0], ohp[1], ohp[2], ohp[3]}; }
    LAS bf16_t* TL = (LAS bf16_t*)F.lds;
    v4u vin[4];
#pragma unroll
    for (int m = 0; m < 4; ++m) { const int wh = m >> 1, g = m & 1, tk = F.tid >> 3, c = F.tid & 7; vin[m] = *(const v4u*)(proj + (tok0 + tk) * LDP + (wh ? C_VW : C_VS) + g * 64 + 8 * c); }
#pragma unroll
    for (int m = 0; m < 4; ++m) { const int wh = m >> 1, g = m & 1;
        __syncthreads();
        { const int tk = F.tid >> 3, c = F.tid & 7; *(LAS v4u*)(TL + tk * 72 + 8 * c) = vin[m]; }
        __syncthreads();
        { const int d = F.tid >> 3, sc = F.tid & 7; unsigned short e[8];
#pragma unroll
          for (int i = 0; i < 8; ++i) e[i] = TL[(8 * sc + i) * 72 + d];
          v4u o; o.x = e[0] | ((unsigned)e[1] << 16); o.y = e[2] | ((unsigned)e[3] << 16); o.z = e[4] | ((unsigned)e[5] << 16); o.w = e[6] | ((unsigned)e[7] << 16);
          *(v4u*)((bf16_t*)(ws + (wh ? WS_VWT : WS_VST)) + ((size_t)(b * 2 + g) * 64 + d) * SEQ + 64 * tile + 8 * sc) = o; } }
    __syncthreads();
}

constexpr int ATT_VB = 32768, ATT_PSL = 65536, ATT_OUTA = 65536, ATT_SELM = LDSCTL_OFF + 512, ATT_UNI = ATT_SELM + 512, ATT_TL = ATT_UNI + 16, ATT_NT = ATT_TL + 80;
constexpr float ATT_QS = 0.125f * 1.4426950408889634f;
#ifndef ATT_MASKOFF
#define ATT_MASKOFF 200.0f
#endif
__device__ __forceinline__ int att_swz(int row, int c) { return row * 128 + ((c ^ ((row >> 1) & 7)) << 4); }
struct TileSrc { const bf16_t* K; int kpitch; const bf16_t* V; int vpitch; };
__device__ __forceinline__ void att_load(const TileSrc& s, int tid, v4u& kr, v4u& vr) { const int row = tid >> 3, c = tid & 7; kr = *(const v4u*)(s.K + (size_t)row * s.kpitch + 8 * c); vr = *(const v4u*)(s.V + (size_t)row * s.vpitch + 8 * c); }
__device__ __forceinline__ void att_store(LAS unsigned char* lds, int buf, int tid, const v4u& kr, const v4u& vr) {
    const int row = tid >> 3, c = tid & 7;
    *(LAS v4u*)(lds + buf * 8192 + att_swz(row, c)) = kr;
    const int s16 = c >> 1, half = c & 1;
    *(LAS v2u*)(lds + ATT_VB + buf * 8192 + att_swz(row, 2 * s16) + half * 8) = (v2u){vr.x, vr.y};
    *(LAS v2u*)(lds + ATT_VB + buf * 8192 + att_swz(row, 2 * s16 + 1) + half * 8) = (v2u){vr.z, vr.w};
}
__device__ __forceinline__ void att_qk(const LAS unsigned char* kb, const bf16x8 (&qf)[4], f32x16 (&s)[2], int i, int hh, const f32x16& ini0, const f32x16& ini1) {
    bf16x8 kf[2][4];
#pragma unroll
    for (int kt = 0; kt < 2; ++kt)
#pragma unroll
        for (int st = 0; st < 4; ++st) kf[kt][st] = *(const LAS bf16x8*)(kb + att_swz(32 * kt + i, 2 * st + hh));
    __builtin_amdgcn_s_setprio(1);
#pragma unroll
    for (int st = 0; st < 4; ++st)
#pragma unroll
        for (int kt = 0; kt < 2; ++kt) s[kt] = __builtin_amdgcn_mfma_f32_32x32x16_bf16(kf[kt][st], qf[st], st == 0 ? (kt ? ini1 : ini0) : s[kt], 0, 0, 0);
    __builtin_amdgcn_s_setprio(0);
}
__device__ __forceinline__ void att_vload(const LAS unsigned char* vb, bf16x8 (&vf)[4][2], int i, int hh) {
#pragma unroll
    for (int ks = 0; ks < 4; ++ks)
#pragma unroll
        for (int dt = 0; dt < 2; ++dt) vf[ks][dt] = *(const LAS bf16x8*)(vb + att_swz(32 * dt + i, 2 * ks + hh));
}
__device__ __forceinline__ void att_pv(const bf16x8 (&vf)[4][2], const f32x16 (&p)[2], f32x16 (&o)[2]) {
    __builtin_amdgcn_s_setprio(1);
#pragma unroll
    for (int kt = 0; kt < 2; ++kt)
#pragma unroll
        for (int s = 0; s < 2; ++s) { const v4u pb = (v4u){cvt_pk_bf16(p[kt][8 * s], p[kt][8 * s + 1]), cvt_pk_bf16(p[kt][8 * s + 2], p[kt][8 * s + 3]), cvt_pk_bf16(p[kt][8 * s + 4], p[kt][8 * s + 5]), cvt_pk_bf16(p[kt][8 * s + 6], p[kt][8 * s + 7])};
            const bf16x8 bf = __builtin_bit_cast(bf16x8, pb);
#pragma unroll
            for (int dt = 0; dt < 2; ++dt) o[dt] = __builtin_amdgcn_mfma_f32_32x32x16_bf16(vf[2 * kt + s][dt], bf, o[dt], 0, 0, 0); }
    __builtin_amdgcn_s_setprio(0);
}
__device__ __forceinline__ void att_ini(f32x16 (&ini)[2], bool uniform, float base, int lo, int hi, int hh, float masked = -1e30f) {
    if (uniform) {
#pragma unroll
        for (int r = 0; r < 16; ++r) ini[0][r] = base;
        ini[1] = ini[0];
    } else {
        const unsigned span = (unsigned)(hi - lo);
#pragma unroll
        for (int kt = 0; kt < 2; ++kt)
#pragma unroll
            for (int r = 0; r < 16; ++r) { const int kk = 32 * kt + (r & 3) + 8 * (r >> 2) + 4 * hh; ini[kt][r] = ((unsigned)(kk - lo) <= span && hi >= lo) ? base : masked; }
    }
}
#define ATT_KEY(kt, r, hh) (32 * (kt) + ((r) & 3) + 8 * ((r) >> 2) + 4 * (hh))

__device__ __forceinline__ void att_unit(Frame& F, int unit) {
    unsigned char* ws = F.ws; const bf16_t* proj = (const bf16_t*)(ws + WS_PROJ); bf16_t* mix = (bf16_t*)(ws + WS_MIX);
    const int qb = unit & 63, bg = unit >> 6, b = bg >> 1, g = bg & 1;
    const int w = F.wave, i = F.lane & 31, hh = F.lane >> 5, head = i >> 3, tloc = i & 7, tt = 8 * w + tloc; const int pos = 64 * qb + tt; const size_t tok = (size_t)b * SEQ + pos;
    LAS unsigned char* lds = F.lds; LAS float* PSL = (LAS float*)(lds + ATT_PSL); LAS unsigned* SELM = (LAS unsigned*)(lds + ATT_SELM); LAS unsigned* UNI = (LAS unsigned*)(lds + ATT_UNI);
    LAS unsigned char* TL = lds + ATT_TL; LAS int* NTL = (LAS int*)(lds + ATT_NT);
    const bf16_t* kcmp = (const bf16_t*)(ws + WS_KCMP) + (size_t)bg * 256 * 64; const bf16_t* vcmpt = (const bf16_t*)(ws + WS_VCMPT) + (size_t)bg * 64 * 256;
    const bf16_t* ksr = (const bf16_t*)(ws + WS_KSR) + (size_t)bg * SEQ * 64; const bf16_t* vst = (const bf16_t*)(ws + WS_VST) + (size_t)bg * 64 * SEQ;
    const bf16_t* kwr = (const bf16_t*)(ws + WS_KWR) + (size_t)bg * SEQ * 64; const bf16_t* vwt = (const bf16_t*)(ws + WS_VWT) + (size_t)bg * 64 * SEQ;
    __syncthreads();
    for (int k = F.tid; k < 64 * 64; k += NTHR) PSL[k] = 0.f;
    if (F.tid < 2) UNI[F.tid] = 0u;
    bf16x8 qf[4];
    const bf16_t* qp = proj + tok * LDP + C_NQ + (4 * g + head) * 64 + 8 * hh;
    { float qraw[4][8];
#pragma unroll
      for (int st = 0; st < 4; ++st) { const v4u v = *(const v4u*)(qp + 16 * st); const unsigned vw[4] = {v.x, v.y, v.z, v.w};
#pragma unroll
          for (int k = 0; k < 4; ++k) { qraw[st][2 * k] = bf2f((bf16_t)(vw[k] & 0xffff)); qraw[st][2 * k + 1] = bf2f((bf16_t)(vw[k] >> 16)); } }
#pragma unroll
      for (int st = 0; st < 4; ++st) { const v4u o = (v4u){cvt_pk_bf16(qraw[st][0] * ATT_QS, qraw[st][1] * ATT_QS), cvt_pk_bf16(qraw[st][2] * ATT_QS, qraw[st][3] * ATT_QS), cvt_pk_bf16(qraw[st][4] * ATT_QS, qraw[st][5] * ATT_QS), cvt_pk_bf16(qraw[st][6] * ATT_QS, qraw[st][7] * ATT_QS)};
          qf[st] = __builtin_bit_cast(bf16x8, o); } }
    LAS float* OUTA = (LAS float*)(lds + ATT_OUTA) + (size_t)w * 32 * 64 + F.lane;
    const float* gl = nullptr; (void)gl;
    const float gate0 = fsigmoid(bf2f(proj[tok * LDP + C_NG + (4 * g + head) * 3 + 0])), gate1 = fsigmoid(bf2f(proj[tok * LDP + C_NG + (4 * g + head) * 3 + 1])), gate2 = fsigmoid(bf2f(proj[tok * LDP + C_NG + (4 * g + head) * 3 + 2]));
    v4u kr, vr; f32x16 s[2]; f32x16 ocmp[2];
#ifndef PROBE_ATT
#define PROBE_ATT 0
#endif
    for (int rep1_ = 0; rep1_ < (PROBE_ATT == 1 ? 2 : 1); ++rep1_) {
    const int ncu = (4 * qb + 3) < 255 ? (4 * qb + 3) : 255, ntile = (ncu + 63) >> 6;
    const int ncv = pos >= 31 ? ((pos - 31) >> 4) + 1 : 0;
    const int ncv_min = qb >= 1 ? 4 * qb - 1 : 0;
    float m = -1e30f, l = 0.f;
    {
        int cur = 0; { TileSrc ts{kcmp, 64, vcmpt, 256}; att_load(ts, F.tid, kr, vr); att_store(lds, 0, F.tid, kr, vr); }
        __syncthreads();
        for (int T_ = 0; T_ < ntile; ++T_) {
            const bool more = T_ + 1 < ntile;
            if (more) { TileSrc ts{kcmp + (size_t)(T_ + 1) * 64 * 64, 64, vcmpt + (T_ + 1) * 64, 256}; att_load(ts, F.tid, kr, vr); }
            { f32x16 ini[2]; att_ini(ini, 64 * T_ + 64 <= ncv_min, 0.f, 0, ncv - 1 - 64 * T_, hh, -ATT_MASKOFF); att_qk(lds + cur * 8192, qf, s, i, hh, ini[0], ini[1]); }
            float tm = -1e30f;
#pragma unroll
            for (int kt = 0; kt < 2; ++kt)
#pragma unroll
                for (int r = 0; r < 16; ++r) tm = fmaxf(tm, s[kt][r]);
            tm = fmaxf(tm, __shfl_xor(tm, 32));
            const float mn = fmaxf(m, tm); l *= fexp2(m - mn);
#pragma unroll
            for (int kt = 0; kt < 2; ++kt)
#pragma unroll
                for (int r = 0; r < 16; ++r) l += __builtin_amdgcn_exp2f(s[kt][r] - mn);
            m = mn;
            if (more) att_store(lds, cur ^ 1, F.tid, kr, vr);
            __syncthreads(); cur ^= 1;
        }
        l += __shfl_xor(l, 32);
    }
    {
        const float rl = (ncv > 0 && l > 0.f) ? 1.0f / l : 0.f;
        f32x16 o[2];
#pragma unroll
        for (int k = 0; k < 16; ++k) { o[0][k] = 0.f; o[1][k] = 0.f; }
        float carry = 0.f;
        int cur = 0; { TileSrc ts{kcmp, 64, vcmpt, 256}; att_load(ts, F.tid, kr, vr); att_store(lds, 0, F.tid, kr, vr); }
        __syncthreads();
        for (int T_ = 0; T_ < ntile; ++T_) {
            const bool more = T_ + 1 < ntile;
            if (more) { TileSrc ts{kcmp + (size_t)(T_ + 1) * 64 * 64, 64, vcmpt + (T_ + 1) * 64, 256}; att_load(ts, F.tid, kr, vr); }
            bf16x8 vf[4][2];
            { f32x16 ini[2]; att_ini(ini, 64 * T_ + 64 <= ncv_min, -m, 0, ncv - 1 - 64 * T_, hh, -m - ATT_MASKOFF); att_qk(lds + cur * 8192, qf, s, i, hh, ini[0], ini[1]); }
            att_vload(lds + ATT_VB + cur * 8192, vf, i, hh);
#pragma unroll
            for (int kt = 0; kt < 2; ++kt)
#pragma unroll
                for (int r = 0; r < 16; ++r) s[kt][r] = __builtin_amdgcn_exp2f(s[kt][r]) * rl;
            att_pv(vf, s, o);
            float ps[8];
#pragma unroll
            for (int kt = 0; kt < 2; ++kt)
#pragma unroll
                for (int gi = 0; gi < 4; ++gi) ps[4 * kt + gi] = (s[kt][4 * gi] + s[kt][4 * gi + 1]) + (s[kt][4 * gi + 2] + 0.5f * s[kt][4 * gi + 3]);
            float nc = 0.f;
#pragma unroll
            for (int sl = 0; sl < 8; ++sl) { const float x = 0.5f * s[sl >> 2][4 * (sl & 3) + 3]; const float y = __shfl_xor(x, 32);
                if (hh == 1) ps[sl] += y; else { if (sl < 7) ps[sl + 1] += y; else nc = y; } }
            if (hh == 0) { ps[0] += carry; carry = nc; }
#pragma unroll
            for (int sl = 0; sl < 8; ++sl) { float v = ps[sl]; v += __shfl_xor(v, 8); v += __shfl_xor(v, 16); ps[sl] = v; }
            if (head == 0) {
#pragma unroll
                for (int sl = 0; sl < 8; ++sl) PSL[tt * 64 + 16 * T_ + 2 * sl + hh] = ps[sl]; }
            if (more) att_store(lds, cur ^ 1, F.tid, kr, vr);
            __syncthreads(); cur ^= 1;
        }
#pragma unroll
        for (int dt = 0; dt < 2; ++dt)
#pragma unroll
            for (int k = 0; k < 16; ++k) ocmp[dt][k] = gate0 * o[dt][k];
    }
    __syncthreads();
#pragma unroll 1
    for (int tl = 0; tl < 8; ++tl) {
        const int t = 8 * w + tl, j = F.lane; const bool fj = (j == 0) || (j == qb) || (j == qb - 1);
        const unsigned key = fj ? 0xFFFFFFFFu : (j <= qb ? __float_as_uint(PSL[t * 64 + j]) + 1u : 0u);
        unsigned thr = 0u;
#pragma unroll 1
        for (int bit = 31; bit >= 0; --bit) { const unsigned cand = thr | (1u << bit); if (__popcll(__ballot(key >= cand)) >= NSEL) thr = cand; }
        const unsigned long long gt = __ballot(key > thr), eq = __ballot(key == thr); const int need = NSEL - __popcll(gt);
        const int below = __popcll(eq & ((1ull << j) - 1ull));
        const bool sel = (key > 0u) && ((key > thr) || (key == thr && below < need));
        const unsigned long long msk = __ballot(sel);
        if (F.lane == 0) { const unsigned lo = (unsigned)msk, hi = (unsigned)(msk >> 32); SELM[2 * t] = lo; SELM[2 * t + 1] = hi; atomicOr((unsigned*)&UNI[0], lo); atomicOr((unsigned*)&UNI[1], hi); }
    }
    __syncthreads();
    }
    const unsigned sel0 = SELM[2 * tt], sel1 = SELM[2 * tt + 1];
#pragma unroll
    for (int dt = 0; dt < 2; ++dt)
#pragma unroll
        for (int k = 0; k < 16; ++k) OUTA[(dt * 16 + k) * 64] = ocmp[dt][k];
    { const float* csp = (const float*)(ws + WS_CS) + pos * 32 + 8 * hh; const float* snp = (const float*)(ws + WS_SN) + pos * 32 + 8 * hh;
      float qraw[4][8];
#pragma unroll
      for (int st = 0; st < 4; ++st) { const v4u v = *(const v4u*)(qp + 16 * st); const unsigned vw[4] = {v.x, v.y, v.z, v.w};
#pragma unroll
          for (int k = 0; k < 4; ++k) { qraw[st][2 * k] = bf2f((bf16_t)(vw[k] & 0xffff)); qraw[st][2 * k + 1] = bf2f((bf16_t)(vw[k] >> 16)); } }
#pragma unroll
      for (int st = 0; st < 2; ++st) { float co[8], si[8]; *(f32x4*)&co[0] = *(const f32x4*)(csp + 16 * st); *(f32x4*)&co[4] = *(const f32x4*)(csp + 16 * st + 4); *(f32x4*)&si[0] = *(const f32x4*)(snp + 16 * st); *(f32x4*)&si[4] = *(const f32x4*)(snp + 16 * st + 4);
          float rl_[8], rh_[8];
#pragma unroll
          for (int k = 0; k < 8; ++k) { rl_[k] = (qraw[st][k] * co[k] - qraw[st + 2][k] * si[k]) * ATT_QS; rh_[k] = (qraw[st + 2][k] * co[k] + qraw[st][k] * si[k]) * ATT_QS; }
          qf[st] = __builtin_bit_cast(bf16x8, (v4u){cvt_pk_bf16(rl_[0], rl_[1]), cvt_pk_bf16(rl_[2], rl_[3]), cvt_pk_bf16(rl_[4], rl_[5]), cvt_pk_bf16(rl_[6], rl_[7])});
          qf[st + 2] = __builtin_bit_cast(bf16x8, (v4u){cvt_pk_bf16(rh_[0], rh_[1]), cvt_pk_bf16(rh_[2], rh_[3]), cvt_pk_bf16(rh_[4], rh_[5]), cvt_pk_bf16(rh_[6], rh_[7])}); } }
    for (int rep2_ = 0; rep2_ < (PROBE_ATT == 2 ? 2 : 1); ++rep2_)
#pragma unroll 1
    for (int br = 0; br < 2; ++br) {
        if (F.wave == 0) {
            const int j = F.lane; bool on;
            if (br == 0) { const unsigned u0 = UNI[0], u1 = UNI[1]; on = (j <= qb) && (j < 32 ? ((u0 >> j) & 1u) : ((u1 >> (j - 32)) & 1u)); }
            else on = (j <= qb) && (j >= qb - 8);
            const unsigned long long bm = __ballot(on);
            if (on) TL[__popcll(bm & ((1ull << j) - 1ull))] = (unsigned char)j;
            if (j == 0) NTL[0] = __popcll(bm); }
        __syncthreads();
        const int nl = NTL[0]; const bf16_t* Kg = br ? kwr : ksr; const bf16_t* Vg = br ? vwt : vst;
        float mm = 0.f, ll = 0.f; bool started = false; f32x16 o[2];
#pragma unroll
        for (int k = 0; k < 16; ++k) { o[0][k] = 0.f; o[1][k] = 0.f; }
#define ATT_BODY \
            bool lane_on; int lo_k, hi_k;     \
            if (br == 0) { lane_on = j < 32 ? ((sel0 >> j) & 1u) : ((sel1 >> (j - 32)) & 1u); lo_k = 0; hi_k = (j == qb) ? tt : 63; } \
            else { lane_on = true; lo_k = (j == qb - 8) ? tt + 1 : 0; hi_k = (j == qb) ? tt : 63; if (lo_k > hi_k) lane_on = false; } \
            const bool full = (j != qb) && (br == 0 || j != qb - 8);               \
            if (__any(lane_on)) { \
                bf16x8 vf[4][2]; \
                { f32x16 ini[2]; att_ini(ini, full, lane_on ? -mm : -mm - ATT_MASKOFF, lo_k, lane_on ? hi_k : -1, hh, -mm - ATT_MASKOFF); att_qk(lds + kslot * 8192, qf, s, i, hh, ini[0], ini[1]); } \
                att_vload(lds + ATT_VB + kslot * 8192, vf, i, hh); \
                float tm = -1e30f; \
_Pragma("unroll") \
                for (int kt = 0; kt < 2; ++kt) \
_Pragma("unroll") \
                    for (int r = 0; r < 16; ++r) tm = fmaxf(tm, s[kt][r]); \
                tm = fmaxf(tm, __shfl_xor(tm, 32)); \
                const bool first = !started && (tm > -0.5f * ATT_MASKOFF); started = started || first; \
                const bool upd = first || (tm > 8.0f); \
                if (__any(upd)) { \
                    const float delta = upd ? tm : 0.f, al = fexp2(-delta); mm += delta; ll *= al; \
_Pragma("unroll") \
                    for (int dt = 0; dt < 2; ++dt) \
_Pragma("unroll") \
                        for (int k = 0; k < 16; ++k) o[dt][k] *= al; \
_Pragma("unroll") \
                    for (int kt = 0; kt < 2; ++kt) \
_Pragma("unroll") \
                        for (int r = 0; r < 16; ++r) s[kt][r] -= delta; \
                } \
_Pragma("unroll") \
                for (int kt = 0; kt < 2; ++kt) \
_Pragma("unroll") \
                    for (int r = 0; r < 16; ++r) { const float pv_ = __builtin_amdgcn_exp2f(s[kt][r]); s[kt][r] = pv_; ll += pv_; } \
                att_pv(vf, s, o); \
            }
        v4u kr2, vr2;
        const int np = (nl + 1) >> 1;
#define ATT_LOADPAIR(p_) do { { const int ja = TL[2 * (p_)]; TileSrc ts{Kg + (size_t)ja * 64 * 64, 64, Vg + (size_t)ja * 64, SEQ}; att_load(ts, F.tid, kr, vr); } \
            if (2 * (p_) + 1 < nl) { const int jb = TL[2 * (p_) + 1]; TileSrc ts{Kg + (size_t)jb * 64 * 64, 64, Vg + (size_t)jb * 64, SEQ}; att_load(ts, F.tid, kr2, vr2); } } while (0)
#define ATT_STOREPAIR(p_, c_) do { att_store(lds, 2 * (c_), F.tid, kr, vr); if (2 * (p_) + 1 < nl) att_store(lds, 2 * (c_) + 1, F.tid, kr2, vr2); } while (0)
        ATT_LOADPAIR(0); ATT_STOREPAIR(0, 0);
        if (np > 1) ATT_LOADPAIR(1);
        __syncthreads();
        int cur = 0;
        for (int p = 0; p < np; ++p) {
            if (p + 1 < np) ATT_STOREPAIR(p + 1, cur ^ 1);
            if (p + 2 < np) ATT_LOADPAIR(p + 2);
#pragma unroll 1
            for (int t2 = 0; t2 < 2; ++t2) { const int it = 2 * p + t2; if (it < nl) { const int j = TL[it]; const int kslot = 2 * cur + t2;
                ATT_BODY
            } }
            __syncthreads(); cur ^= 1;
        }
#undef ATT_LOADPAIR
#undef ATT_STOREPAIR
#undef ATT_BODY
        ll += __shfl_xor(ll, 32);
        const float sc_ = rep2_ ? 0.f : (br ? gate2 : gate1) / ll;
#pragma unroll
        for (int dt = 0; dt < 2; ++dt)
#pragma unroll
            for (int k = 0; k < 16; ++k) OUTA[(dt * 16 + k) * 64] += sc_ * o[dt][k];
    }
    { bf16_t* op = mix + tok * D + 512 + (4 * g + head) * 64 + 4 * hh;
#pragma unroll
      for (int dt = 0; dt < 2; ++dt)
#pragma unroll
          for (int gi = 0; gi < 4; ++gi) { const float a0 = OUTA[(dt * 16 + 4 * gi) * 64], a1 = OUTA[(dt * 16 + 4 * gi + 1) * 64], a2 = OUTA[(dt * 16 + 4 * gi + 2) * 64], a3 = OUTA[(dt * 16 + 4 * gi + 3) * 64];
              v2u ov; ov.x = cvt_pk_bf16(a0, a1); ov.y = cvt_pk_bf16(a2, a3); *(v2u*)(op + 32 * dt + 8 * gi) = ov; } }
    __syncthreads();
}

__global__ void __launch_bounds__(NTHR, 2) mk_fwd(Args args) {
    extern __shared__ __attribute__((aligned(16))) unsigned char lds_raw[];
    Frame F;
    F.lds = (LAS unsigned char*)lds_raw; F.MISC = (volatile LAS unsigned*)(F.lds + MISC_OFF);
    F.tid = threadIdx.x; F.lane = F.tid & 63; F.wave = __builtin_amdgcn_readfirstlane(F.tid >> 6);
    F.G = gridDim.x; { const int bx = blockIdx.x; F.vcu = (F.G % 8 == 0) ? (bx % 8) * (F.G / 8) + bx / 8 : bx; }
    F.ws = args.ws; F.ctl = (unsigned*)(args.ws + WS_CTL); F.out = args.out;
#pragma unroll
    for (int i = 0; i < 25; ++i) F.in[i] = args.in[i];
    for (int u = F.tid; u < (LDS_BYTES - LDSCTL_OFF) / 4; u += NTHR) ((LAS unsigned*)(F.lds + LDSCTL_OFF))[u] = 0u;
    __syncthreads();
    const int lo = args.ph_lo, hi = args.ph_hi;
    XcdBarrier bar = xcd_barrier_post(F.ctl + CW_BAR + lo * XCD_BAR_WORDS, F.MISC + 8);
#define IN_PH(k) (lo <= (k) && (k) < hi)
#define SEAM(k) do { if (IN_PH(k) && IN_PH((k) + 1)) xcd_barrier(bar); } while (0)
#define RUNP(k, BODY) do { if (IN_PH(k)) { BODY; if (PROBE_REP == (k)) { xcd_barrier(bar); BODY; } } } while (0)
#define BODY0 p0_prologue(F)
#define BODY1 p1a_norm(F)
#define BODY2 { gm::DenseSched S{(const char*)(F.ws + WS_XN), (const char*)(F.ws + WS_WINT), T / 256, LDP / 256, F.G, (int)blockIdx.x, 2048u, 1024u}; \
        gm::EpiBf16 E{(bf16_t*)(F.ws + WS_PROJ), LDP}; gm::gemm_phase<gm::EpiBf16, gm::DenseSched>(F.lds, S, E, 1024, 128u); }
#define BODY3 { if (F.G == 256) { if (F.vcu < 128) { cmp_unit(F, F.vcu); if (PROBE_P3 == 1) cmp_unit(F, F.vcu); } else { const int u0 = 2 * (F.vcu - 128); hg_passA(F, u0); hg_passA(F, u0 + 1); if (PROBE_P3 == 2) { hg_passA(F, u0); hg_passA(F, u0 + 1); } kv_prep_unit(F, u0); kv_prep_unit(F, u0 + 1); if (PROBE_P3 == 3) { kv_prep_unit(F, u0); kv_prep_unit(F, u0 + 1); } } } \
        else { for (int u = F.vcu; u < 128; u += F.G) cmp_unit(F, u); for (int u = F.vcu; u < 256; u += F.G) hg_passA(F, u); for (int u = F.vcu; u < 256; u += F.G) kv_prep_unit(F, u); } }
#define BODY4 { for (int u = F.vcu; u < 256; u += F.G) hg_passC(F, u); }
#define BODY5 { for (int c = F.vcu; c < 256; c += F.G) { const int bg = c >> 5, k = c & 31; att_unit(F, bg * 64 + 63 - k); att_unit(F, bg * 64 + k); } }
#define BODY6 { gm::DenseSched S{(const char*)(F.ws + WS_MIX), (const char*)(F.ws + WS_WOUTT), T / 256, 4, F.G, (int)blockIdx.x, 2048u, 1024u}; \
        gm::EpiRes E{F.in[IN_X], (const float*)(F.ws + WS_MOD), 2, (float*)(F.ws + WS_X2), (float*)(F.ws + WS_SSQ)}; gm::gemm_phase<gm::EpiRes, gm::DenseSched>(F.lds, S, E, 1024, 128u); }
#define BODY7 p5_router(F)
#define BODY8 { const MoeTabs Tb = moe_tabs_build(F); \
        GateUpSched S{Tb, (const char*)(F.ws + WS_H2), (const char*)(F.ws + WS_WGUT), (const char*)(F.ws + WS_WSGUT), (const int*)(F.ws + WS_ROWL), F.G, (int)blockIdx.x}; \
        EpiSwiglu E{F.ws + WS_ACT, F.ws + WS_ACTS}; gm::gemm_phase<EpiSwiglu, GateUpSched, true>(F.lds, S, E, 512, 128u); }
#define BODY9 { const MoeTabs Tb = moe_tabs_build(F); DownSched S{Tb, (const char*)(F.ws + WS_ACT), (const char*)(F.ws + WS_ACTS), (const char*)(F.ws + WS_WDNT), (const char*)(F.ws + WS_WSDNT), F.G, (int)blockIdx.x}; \
        EpiDown E{(unsigned char*)(F.ws + WS_Y), (bf16_t*)(F.ws + WS_YS)}; gm::gemm_phase<EpiDown, DownSched, true>(F.lds, S, E, 128, 128u); }
#define BODY10 p8_final(F)
    RUNP(0, BODY0); SEAM(0);
    RUNP(1, BODY1); SEAM(1);
    RUNP(2, BODY2); SEAM(2);
    RUNP(3, BODY3); SEAM(3);
    RUNP(4, BODY4); SEAM(4);
    RUNP(5, BODY5); SEAM(5);
    RUNP(6, BODY6); SEAM(6);
    RUNP(7, BODY7); SEAM(7);
    RUNP(8, BODY8); SEAM(8);
    RUNP(9, BODY9); SEAM(9);
    RUNP(10, BODY10);
#undef IN_PH
#undef SEAM
#undef RUNP
}
#ifndef ONE_LAUNCH
#define ONE_LAUNCH 1
#endif
#ifndef OPT_S1
#define OPT_S1 1
#endif
#ifndef OPT_S2B
#define OPT_S2B 1
#endif
#ifndef OPT_S2A
#define OPT_S2A 1
#endif
#ifndef OPT_S5
#define OPT_S5 1
#endif
#ifndef OPT_S3
#define OPT_S3 1
#endif
#ifndef OPT_S4
#define OPT_S4 1
#endif
static void launch_mk(const nv::In& I, void* const* d_in, float* out, unsigned char* ws, int lo, int hi, int grid, hipStream_t stream) {
    Args a{}; for (int i = 0; i < 25; ++i) a.in[i] = (const float*)d_in[i];
    a.out = out; a.ws = ws; a.ph_lo = lo; a.ph_hi = hi; a.rep = 0; a.pad = 0;
    hipLaunchKernelGGL(mk_fwd, dim3(grid), dim3(NTHR), LDS_BYTES, stream, a);
}
extern "C" void kernel_launch(void* const* d_in, const int* in_sizes, int n_in, void* d_out, int out_size, void* d_ws, size_t ws_size, hipStream_t stream) {
    static int grid = 0;
    if (grid == 0) {
        if (ws_size < WS_END || n_in != 25) { fprintf(stderr, "kernel_launch: ws %zu < %zu or n_in %d != 25\n", ws_size, (size_t)WS_END, n_in); grid = -1; return; }
        int dev = 0, cus = 0;
        if (hipGetDevice(&dev) != hipSuccess || hipDeviceGetAttribute(&cus, hipDeviceAttributeMultiprocessorCount, dev) != hipSuccess) { grid = -1; return; }
        if (hipFuncSetAttribute((const void*)mk_fwd, hipFuncAttributeMaxDynamicSharedMemorySize, LDS_BYTES) != hipSuccess) { fprintf(stderr, "kernel_launch: hipFuncSetAttribute failed\n"); grid = -1; return; }
        int per_cu = 0; (void)hipOccupancyMaxActiveBlocksPerMultiprocessor(&per_cu, (const void*)mk_fwd, NTHR, LDS_BYTES); (void)hipGetLastError();
        if (per_cu < 1) fprintf(stderr, "kernel_launch: occupancy query says %d blocks/CU\n", per_cu);
        grid = cus;
    }
    if (grid < 0) return;
    unsigned char* ws = (unsigned char*)d_ws; float* out = (float*)d_out;
    nv::In I; I.set(d_in);
    (void)hipMemsetAsync(ws + WS_CTL, 0, CTL_ZERO_BYTES, stream);
#if ONE_LAUNCH
    launch_mk(I, d_in, out, ws, 0, 11, grid, stream);
#else
#if OPT_S1
    launch_mk(I, d_in, out, ws, 0, 3, grid, stream);
#else
    nv::s1_naive(I, ws, stream);
#endif
#if OPT_S2A
    launch_mk(I, d_in, out, ws, 3, OPT_S2B ? 6 : 5, grid, stream);
#endif
    if (!OPT_S2A || !OPT_S2B) nv::s2_naive(I, ws, stream, !OPT_S2A, !OPT_S2B);
#if OPT_S3
    launch_mk(I, d_in, out, ws, 6, OPT_S4 ? 8 : 7, grid, stream);
#else
    nv::s3_naive(I, ws, stream);
#endif
#if OPT_S4
    if (!OPT_S3) launch_mk(I, d_in, out, ws, 7, 8, grid, stream);
#else
    nv::s4_naive(I, ws, stream);
#endif
#if OPT_S5
    launch_mk(I, d_in, out, ws, 8, 11, grid, stream);
#else
    nv::s5_naive(I, ws, out, stream);
#endif
#endif
}
#endif
```

```cpp
#ifndef CPU_EMU
#include <hip/hip_runtime.h>
#endif
#include <cstdio>
#include <cstdint>
#include <cmath>

#ifndef BATCH
#define BATCH 4
#endif
#ifndef SEQ
#define SEQ 4096
#endif

#ifdef CPU_EMU
struct dim3e { unsigned x, y, z; };
static thread_local dim3e threadIdx, blockIdx, blockDim, gridDim;
#define __global__
#define __device__
#define __host__
#define __forceinline__ inline
#define __launch_bounds__(...)
typedef int hipStream_t;
template <class F> static void cpu_launch(unsigned grid, unsigned block, F f) {
#pragma omp parallel for schedule(dynamic, 1)
    for (long b = 0; b < (long)grid; ++b) {
        blockIdx = {(unsigned)b, 0, 0}; blockDim = {block, 1, 1}; gridDim = {grid, 1, 1};
        for (unsigned t = 0; t < block; ++t) { threadIdx = {t, 0, 0}; f(); }
    }
}
static int g_launch_limit = 1 << 30, g_launch_count = 0;
#define LAUNCH(kern, grid, block, ...) do { if (g_launch_count++ < g_launch_limit) cpu_launch((unsigned)(grid), (unsigned)(block), [&]() { kern(__VA_ARGS__); }); } while (0)
#else
#define LAUNCH(kern, grid, block, ...) kern<<<dim3((unsigned)(grid)), dim3((unsigned)(block)), 0, stream>>>(__VA_ARGS__)
#endif

typedef unsigned short bf16_t;
constexpr int D = 1024, T = BATCH * SEQ, INC = 3352, LDP = 3584;
constexpr int C_HQ = 0, C_HF = 512, C_HI = 1024, C_HGT = 1536, C_NQ = 2048, C_KC = 2560, C_VC = 2688, C_KS = 2816, C_VS = 2944, C_KW = 3072, C_VW = 3200, C_NG = 3328;
constexpr int NCMP = (SEQ - 32) / 16 + 1, NSB = SEQ / 64, NSEL = NSB < 16 ? NSB : 16;
constexpr float EPS = 1e-6f;

constexpr size_t MiB = 1u << 20, KiB = 1u << 10;
constexpr size_t WS_CTL = 0, CTL_ZERO_BYTES = 1 * MiB;
constexpr size_t WS_MODP = 1 * MiB;
constexpr size_t WS_MOD = 2 * MiB + 512 * KiB;
constexpr size_t WS_B1F = WS_MOD + 128 * KiB;
constexpr size_t WS_CS = 2 * MiB + 768 * KiB, WS_SN = WS_CS + 512 * KiB;
constexpr size_t WS_WDNT = 4 * MiB;
constexpr size_t WS_WSDNT = 36 * MiB;
constexpr size_t WS_X2 = 37 * MiB;
constexpr size_t WS_ACT = 101 * MiB;
constexpr size_t WS_ACTS = 173 * MiB;
constexpr size_t WS_ROWL = 181 * MiB;
constexpr size_t WS_TOPI = 189 * MiB, WS_TOPW = WS_TOPI + 512 * KiB;
constexpr size_t WS_ERANK = 185 * MiB;
constexpr size_t WS_SSQ = 186 * MiB;
constexpr size_t WS_WGUT = 190 * MiB;
constexpr size_t WS_WSGUT = 254 * MiB;
constexpr size_t WS_WINT = 255 * MiB;
constexpr size_t WS_WOUTT = 262 * MiB;
constexpr size_t WS_W1KT = 264 * MiB, WS_W1VT = 265 * MiB;
constexpr size_t WS_W2T = 266 * MiB;
constexpr size_t WS_RW = 267 * MiB;
constexpr size_t WS_XN = 268 * MiB;
constexpr size_t WS_H2 = WS_XN;
constexpr size_t WS_PROJ = 300 * MiB;
constexpr size_t WS_KSR = 412 * MiB, WS_KWR = 416 * MiB;
constexpr size_t WS_VST = 420 * MiB, WS_VWT = 424 * MiB;
constexpr size_t WS_KCMP = 428 * MiB, WS_VCMPT = WS_KCMP + 256 * KiB;
constexpr size_t WS_U = 429 * MiB, WS_DD = 445 * MiB;
constexpr size_t WS_MIX = 446 * MiB;
constexpr size_t WS_Y = 190 * MiB;
constexpr size_t WS_YS = 478 * MiB;
constexpr size_t WS_END = 512 * MiB;
constexpr size_t NV_H = 37 * MiB, NV_RSTD = 101 * MiB;
constexpr size_t NV_F = 37 * MiB, NV_ORAW = 69 * MiB, NV_OWIN = 101 * MiB, NV_KSR = 133 * MiB, NV_KWR = 141 * MiB, NV_PS = 149 * MiB, NV_SEL = 157 * MiB,
                 NV_HID = 158 * MiB, NV_KCMP = 160 * MiB, NV_VCMP = 160 * MiB + 512 * KiB, NV_CS = 161 * MiB, NV_SN = 161 * MiB + 512 * KiB, NV_QROT = 478 * MiB;
constexpr size_t NV_H2F = 300 * MiB, NV_LG = 364 * MiB, NV_RSTD2 = 368 * MiB;
constexpr size_t NV_ACT = 300 * MiB, NV_ACTS = 101 * MiB, NV_X3 = 446 * MiB, NV_RSTD3 = 510 * MiB;

__host__ __device__ __forceinline__ float bf2f(bf16_t v) { union { unsigned u; float f; } c; c.u = (unsigned)v << 16; return c.f; }
__host__ __device__ __forceinline__ bf16_t f2bf(float f) { union { unsigned u; float f; } c; c.f = f; unsigned u = c.u; return (bf16_t)((u + 0x7fffu + ((u >> 16) & 1u)) >> 16); }

namespace nv {
__device__ __forceinline__ float sigmoidf_(float z) { return 1.0f / (1.0f + expf(-z)); }
__device__ __forceinline__ float siluf_(float z) { return z * sigmoidf_(z); }
__device__ __forceinline__ float gelu_tanh(float z) { return 0.5f * z * (1.0f + tanhf(0.7978845608028654f * (z + 0.044715f * z * z * z))); }
__device__ __forceinline__ long gtid() { return (long)blockIdx.x * blockDim.x + threadIdx.x; }
#define PJ(row, col) bf2f(proj[(size_t)(row) * LDP + (col)])

__global__ void k_mod(const float* c, const float* w_ada, const float* b_ada, float* mod) {
    long i = gtid(); if (i >= BATCH * 6144) return; int b = (int)(i / 6144), n = (int)(i % 6144);
    float acc = b_ada[n];
    for (int k = 0; k < D; ++k) acc += siluf_(c[b * D + k]) * w_ada[(size_t)k * 6144 + n];
    mod[i] = acc;
}
__global__ void k_rowrstd(const float* x, float* rstd, int rows) {
    long r = gtid(); if (r >= rows) return; float s = 0.f;
    for (int k = 0; k < D; ++k) { float v = x[(size_t)r * D + k]; s += v * v; }
    rstd[r] = 1.0f / sqrtf(s / D + EPS);
}
__global__ void k_modnorm(const float* x, const float* rstd, const float* g, const float* mod, int sh_chunk, int sc_chunk, float* hf, bf16_t* hb) {
    long i = gtid(); if (i >= (long)T * D) return; int r = (int)(i / D), k = (int)(i % D), b = r / SEQ;
    float v = x[i] * rstd[r] * g[k] * (1.0f + mod[b * 6144 + sc_chunk * D + k]) + mod[b * 6144 + sh_chunk * D + k];
    if (hf) hf[i] = v; if (hb) hb[i] = f2bf(v);
}
__global__ void k_gemm_nn_bf(const float* A, int lda, const float* Bm, int ldb, bf16_t* C, int ldc, int M, int N, int K) {
    long i = gtid(); if (i >= (long)M * N) return; int m = (int)(i / N), n = (int)(i % N);
    float acc = 0.f; const float* a = A + (size_t)m * lda;
    for (int k = 0; k < K; ++k) acc += a[k] * Bm[(size_t)k * ldb + n];
    C[(size_t)m * ldc + n] = f2bf(acc);
}
__global__ void k_gemm_nn(const float* A, int lda, const float* Bm, int ldb, float* C, int ldc, int M, int N, int K) {
    long i = gtid(); if (i >= (long)M * N) return; int m = (int)(i / N), n = (int)(i % N);
    float acc = 0.f; const float* a = A + (size_t)m * lda;
    for (int k = 0; k < K; ++k) acc += a[k] * Bm[(size_t)k * ldb + n];
    C[(size_t)m * ldc + n] = acc;
}
__global__ void k_hgf(const bf16_t* proj, const float* lbl, float* F) {
    long i = gtid(); if (i >= (long)T * 512) return; int r = (int)(i / 512), j = (int)(i % 512);
    float l0 = lbl[j], l1 = lbl[512 + j]; float mx = fmaxf(l0, l1); float e0 = expf(l0 - mx), e1 = expf(l1 - mx); float lb = e0 / (e0 + e1);
    F[i] = lb + (1.0f - lb) * sigmoidf_(PJ(r, C_HF + j));
}
__global__ void __launch_bounds__(64) k_hgrn(const bf16_t* proj, const float* F, float* Oraw) {
    long i = gtid(); if (i >= BATCH * 4 * 128) return; int e = (int)(i % 128), h = (int)((i / 128) % 4), b = (int)(i / 512);
    float S[128];
#pragma unroll
    for (int d = 0; d < 128; ++d) S[d] = 0.f;
    for (int t = 0; t < SEQ; ++t) {
        size_t row = (size_t)b * SEQ + t; const bf16_t* p = proj + row * LDP; const float* f = F + row * 512 + h * 128;
        float v = bf2f(p[C_HI + h * 128 + e]), o = 0.f;
#pragma unroll
        for (int d = 0; d < 128; ++d) { float ff = f[d]; S[d] = ff * S[d] + (1.0f - ff) * v; o += S[d] * bf2f(p[C_HQ + h * 128 + d]); }
        Oraw[row * 512 + h * 128 + e] = o * 0.08838834764831845f;
    }
}
__global__ void k_hgnorm(const float* Oraw, const bf16_t* proj, const float* ng, bf16_t* mix) {
    long i = gtid(); if (i >= (long)T * 4) return; size_t row = (size_t)(i / 4); int h = (int)(i % 4);
    const float* o = Oraw + row * 512 + h * 128; float s = 0.f;
    for (int e = 0; e < 128; ++e) s += o[e] * o[e];
    float r = 1.0f / sqrtf(s / 128 + EPS);
    for (int e = 0; e < 128; ++e) mix[row * D + h * 128 + e] = f2bf(o[e] * r * ng[h * 128 + e] * siluf_(PJ(row, C_HGT + h * 128 + e)));
}
__global__ void k_cmp_hidden(const bf16_t* proj, int coloff, const float* pe, const float* w1, const float* b1, float* hid) {
    long i = gtid(); if (i >= (long)BATCH * 2 * NCMP * 256) return; int j = (int)(i % 256); long r = i / 256; int c = (int)(r % NCMP), g = (int)((r / NCMP) % 2), b = (int)(r / (NCMP * 2));
    float acc = b1[j];
    for (int l = 0; l < 32; ++l) { const bf16_t* p = proj + ((size_t)b * SEQ + 16 * c + l) * LDP + coloff + g * 64;
        for (int d = 0; d < 64; ++d) acc += (bf2f(p[d]) + pe[l * 64 + d]) * w1[(size_t)(l * 64 + d) * 256 + j]; }
    hid[i] = gelu_tanh(acc);
}
__global__ void k_cmp_out(const float* hid, const float* w2, float* out) {
    long i = gtid(); if (i >= (long)BATCH * 2 * NCMP * 64) return; int d = (int)(i % 64); long r = i / 64;
    float acc = 0.f; for (int j = 0; j < 256; ++j) acc += hid[r * 256 + j] * w2[j * 64 + d];
    out[i] = acc;
}
__global__ void k_rope_tab(float* cs, float* sn) {
    long i = gtid(); if (i >= (long)SEQ * 32) return; int pos = (int)(i / 32), k = (int)(i % 32);
    float inv = powf(10000.0f, -(float)k / 32.0f); float ang = (float)pos * inv; cs[i] = cosf(ang); sn[i] = sinf(ang);
}
__global__ void k_rope_apply(const bf16_t* proj, int coloff, int nh, const float* cs, const float* sn, float* dst) {
    long i = gtid(); if (i >= (long)T * nh * 32) return; int k = (int)(i % 32); int h = (int)((i / 32) % nh); size_t row = (size_t)(i / (32 * nh)); int pos = (int)(row % SEQ);
    float t1 = PJ(row, coloff + h * 64 + k), t2 = PJ(row, coloff + h * 64 + k + 32), co = cs[pos * 32 + k], si = sn[pos * 32 + k];
    dst[row * (nh * 64) + h * 64 + k] = t1 * co - t2 * si; dst[row * (nh * 64) + h * 64 + k + 32] = t2 * co + t1 * si;
}
__global__ void __launch_bounds__(64) k_cmp_attn(const bf16_t* proj, const float* kcmp, const float* vcmp, float* ocmp, float* PS) {
    long i = gtid(); if (i >= (long)BATCH * 2 * SEQ) return; int s = (int)(i % SEQ), g = (int)((i / SEQ) % 2), b = (int)(i / (2 * SEQ));
    size_t row = (size_t)b * SEQ + s; float* ps = PS + (size_t)i * 64;
    for (int j = 0; j < 64; ++j) ps[j] = 0.f;
    int ncv = s >= 31 ? (s - 31) / 16 + 1 : 0; if (ncv > NCMP) ncv = NCMP;
    const float* kc = kcmp + (size_t)(b * 2 + g) * NCMP * 64; const float* vc = vcmp + (size_t)(b * 2 + g) * NCMP * 64;
    for (int hh = 0; hh < 4; ++hh) {
        int head = g * 4 + hh;
        float q[64], o[64];
#pragma unroll
        for (int d = 0; d < 64; ++d) { q[d] = PJ(row, C_NQ + head * 64 + d); o[d] = 0.f; }
        float m = -3.0e38f, l = 0.f;
        for (int c = 0; c < ncv; ++c) { float sc = 0.f;
#pragma unroll
            for (int d = 0; d < 64; ++d) sc += q[d] * kc[c * 64 + d];
            sc *= 0.125f; float mn = fmaxf(m, sc); l = l * expf(m - mn) + expf(sc - mn); m = mn; }
        for (int c = 0; c < ncv; ++c) { float sc = 0.f;
#pragma unroll
            for (int d = 0; d < 64; ++d) sc += q[d] * kc[c * 64 + d];
            sc *= 0.125f; float p = expf(sc - m) / l;
#pragma unroll
            for (int d = 0; d < 64; ++d) o[d] += p * vc[c * 64 + d];
            int c0 = 16 * c, c1 = 16 * c + 32;
            for (int j = c0 / 64; j <= (c1 - 1) / 64 && j < NSB; ++j) { int lo = c0 > 64 * j ? c0 : 64 * j, hi = c1 < 64 * j + 64 ? c1 : 64 * j + 64; if (hi > lo) ps[j] += p * (float)(hi - lo) / 32.0f; } }
#pragma unroll
        for (int d = 0; d < 64; ++d) ocmp[row * 512 + head * 64 + d] = o[d];
    }
}
__global__ void k_select(const float* PS, unsigned* SEL) {
    long i = gtid(); if (i >= (long)BATCH * 2 * SEQ) return; int s = (int)(i % SEQ); const float* ps = PS + (size_t)i * 64; int cur = s / 64;
    unsigned m0 = 0, m1 = 0;
    for (int j = 0; j < NSB; ++j) {
        bool fj = (j == 0) || (j == cur) || (j == cur - 1); float sj = fj ? 1e30f : (j <= cur ? ps[j] : -1e30f);
        int rank = 0;
        for (int k = 0; k < NSB; ++k) { bool fk = (k == 0) || (k == cur) || (k == cur - 1); float sk = fk ? 1e30f : (k <= cur ? ps[k] : -1e30f); if (sk > sj || (sk == sj && k < j)) ++rank; }
        if (rank < NSEL && sj > -1e29f) { if (j < 32) m0 |= 1u << j; else m1 |= 1u << (j - 32); }
    }
    SEL[i * 2] = m0; SEL[i * 2 + 1] = m1;
}
__global__ void __launch_bounds__(64) k_attn_naive(const float* qrot, const float* krot, const bf16_t* proj, int vcol, const unsigned* SEL, int mode, float* out) {
    long i = gtid(); if (i >= (long)BATCH * 8 * SEQ) return; int s = (int)(i % SEQ), head = (int)((i / SEQ) % 8), b = (int)(i / (8 * SEQ)); int g = head / 4;
    size_t row = (size_t)b * SEQ + s; float q[64], o[64];
#pragma unroll
    for (int d = 0; d < 64; ++d) { q[d] = qrot[row * 512 + head * 64 + d]; o[d] = 0.f; }
    float m = -3.0e38f, l = 0.f;
    unsigned m0 = 0, m1 = 0; if (mode == 0) { size_t si = ((size_t)(b * 2 + g) * SEQ + s) * 2; m0 = SEL[si]; m1 = SEL[si + 1]; }
    int k0 = mode == 0 ? 0 : (s - 511 > 0 ? s - 511 : 0);
    for (int key = k0; key <= s; ++key) {
        if (mode == 0) { int j = key / 64; bool sel = j < 32 ? ((m0 >> j) & 1u) : ((m1 >> (j - 32)) & 1u); if (!sel) { key = j * 64 + 63; continue; } }
        size_t kr = (size_t)b * SEQ + key; const float* kp = krot + kr * 128 + g * 64;
        float sc = 0.f;
#pragma unroll
        for (int d = 0; d < 64; ++d) sc += q[d] * kp[d];
        sc *= 0.125f; float mn = fmaxf(m, sc), a = expf(m - mn), p = expf(sc - mn); l = l * a + p; m = mn;
#pragma unroll
        for (int d = 0; d < 64; ++d) o[d] = o[d] * a + p * PJ(kr, vcol + g * 64 + d);
    }
#pragma unroll
    for (int d = 0; d < 64; ++d) out[row * 512 + head * 64 + d] = o[d] / l;
}
__global__ void k_nsa_combine(const bf16_t* proj, const float* ocmp, const float* oslc, const float* owin, bf16_t* mix) {
    long i = gtid(); if (i >= (long)T * 512) return; size_t row = (size_t)(i / 512); int c = (int)(i % 512), head = c / 64;
    mix[row * D + 512 + c] = f2bf(sigmoidf_(PJ(row, C_NG + head * 3)) * ocmp[i] + sigmoidf_(PJ(row, C_NG + head * 3 + 1)) * oslc[i] + sigmoidf_(PJ(row, C_NG + head * 3 + 2)) * owin[i]);
}
__global__ void k_proj_res(const bf16_t* A, const float* W, const float* x, const float* mod, int chunk, float* out) {
    long i = gtid(); if (i >= (long)T * D) return; int r = (int)(i / D), n = (int)(i % D), b = r / SEQ;
    float acc = 0.f; const bf16_t* a = A + (size_t)r * D;
    for (int k = 0; k < D; ++k) acc += bf2f(a[k]) * W[(size_t)k * D + n];
    out[i] = x[i] + mod[b * 6144 + chunk * D + n] * acc;
}
__global__ void __launch_bounds__(64) k_route(const float* LG, const float* bias, int* TOPI, float* TOPW) {
    long t = gtid(); if (t >= T) return; const float* lg = LG + (size_t)t * 64;
    float gs[8];
#pragma unroll
    for (int gI = 0; gI < 8; ++gI) { float a = -3e38f, b2 = -3e38f;
        for (int e = 0; e < 8; ++e) { float ch = sigmoidf_(lg[gI * 8 + e]) + bias[gI * 8 + e]; if (ch > a) { b2 = a; a = ch; } else if (ch > b2) b2 = ch; }
        gs[gI] = a + b2; }
    unsigned gmask = 0;
#pragma unroll
    for (int gI = 0; gI < 8; ++gI) { int rank = 0;
#pragma unroll
        for (int k = 0; k < 8; ++k) if (gs[k] > gs[gI] || (gs[k] == gs[gI] && k < gI)) ++rank;
        if (rank < 4) gmask |= 1u << gI; }
    int n = 0; float wsum = 0.f;
    for (int e = 0; e < 64; ++e) { if (!((gmask >> (e / 8)) & 1u)) continue; float se = sigmoidf_(lg[e]), ce = se + bias[e]; int rank = 0;
        for (int k = 0; k < 64; ++k) { if (!((gmask >> (k / 8)) & 1u)) continue; float ck = sigmoidf_(lg[k]) + bias[k]; if (ck > ce || (ck == ce && k < e)) ++rank; }
        if (rank < 8 && n < 8) { TOPI[t * 8 + n] = e; TOPW[t * 8 + n] = se; wsum += se; ++n; } }
    for (int k = 0; k < 8; ++k) TOPW[t * 8 + k] = TOPW[t * 8 + k] / wsum * 2.5f;
}
__global__ void k_moe_act(const bf16_t* h2, const float* Wgu, const int* TOPI, float* ACT, long nA) {
    long i = gtid(); if (i >= nA * 256) return; long a = i / 256; int j = (int)(i % 256); long t = TOPI ? a / 8 : a; int e = TOPI ? TOPI[a] : 0;
    const bf16_t* hp = h2 + (size_t)t * D; const float* w = Wgu + (size_t)e * D * 512; float gq = 0.f, u = 0.f;
    for (int k = 0; k < D; ++k) { float hv = bf2f(hp[k]); gq += hv * w[(size_t)k * 512 + j]; u += hv * w[(size_t)k * 512 + 256 + j]; }
    ACT[i] = siluf_(gq) * u;
}
__global__ void k_moe_out(const float* ACT, const float* ACTS, const float* Wdn, const float* Wsd, const int* TOPI, const float* TOPW, const float* x2, const float* mod, float* x3) {
    long i = gtid(); if (i >= (long)T * D) return; long t = i / D; int n = (int)(i % D), b = (int)(t / SEQ);
    float acc = 0.f;
    for (int sl = 0; sl < 8; ++sl) { int e = TOPI[t * 8 + sl]; const float* a = ACT + (size_t)(t * 8 + sl) * 256; const float* w = Wdn + (size_t)e * 256 * D; float y = 0.f;
        for (int k = 0; k < 256; ++k) y += a[k] * w[(size_t)k * D + n];
        acc += TOPW[t * 8 + sl] * y; }
    { const float* a = ACTS + (size_t)t * 256; float y = 0.f; for (int k = 0; k < 256; ++k) y += a[k] * Wsd[(size_t)k * D + n]; acc += y; }
    x3[i] = x2[i] + mod[b * 6144 + 5 * D + n] * acc;
}
__global__ void k_final(const float* x3, const float* rstd, const float* g, float* out) {
    long i = gtid(); if (i >= (long)T * D) return; out[i] = x3[i] * rstd[i / D] * g[i % D];
}
#undef PJ

struct In { const float *x, *c, *w_ada, *b_ada, *n1g, *w_in, *lbl, *hng, *pek, *w1k, *b1k, *w2k, *pev, *w1v, *b1v, *w2v, *w_out, *n2g, *rw, *rb, *wgu, *wdn, *wsgu, *wsdn, *fg;
    void set(void* const* d) { const float** p = (const float**)this; for (int i = 0; i < 25; ++i) p[i] = (const float*)d[i]; } };
#define NBK(n, tb) (((long)(n) + (tb) - 1) / (tb))
template <class Tp> static Tp* wsp(unsigned char* ws, size_t off) { return (Tp*)(ws + off); }
static void s1_naive(const In& I, unsigned char* ws, hipStream_t stream) {
    float* mod = wsp<float>(ws, WS_MOD); float* h = wsp<float>(ws, NV_H); float* rstd = wsp<float>(ws, NV_RSTD); bf16_t* proj = wsp<bf16_t>(ws, WS_PROJ);
    LAUNCH(k_mod, NBK(BATCH * 6144, 256), 256, I.c, I.w_ada, I.b_ada, mod);
    LAUNCH(k_rowrstd, NBK(T, 256), 256, I.x, rstd, T);
    LAUNCH(k_modnorm, NBK((long)T * D, 256), 256, I.x, rstd, I.n1g, mod, 0, 1, h, (bf16_t*)nullptr);
    LAUNCH(k_gemm_nn_bf, NBK((long)T * INC, 256), 256, h, D, I.w_in, INC, proj, LDP, T, INC, D);
}
static void s2_naive(const In& I, unsigned char* ws, hipStream_t stream, bool do_hg = true, bool do_nsa = true) {
    const bf16_t* proj = wsp<bf16_t>(ws, WS_PROJ); bf16_t* mix = wsp<bf16_t>(ws, WS_MIX);
    float *F = wsp<float>(ws, NV_F), *oraw = wsp<float>(ws, NV_ORAW), *owin = wsp<float>(ws, NV_OWIN), *ksr = wsp<float>(ws, NV_KSR), *kwr = wsp<float>(ws, NV_KWR), *PS = wsp<float>(ws, NV_PS);
    float *hid = wsp<float>(ws, NV_HID), *kcmp = wsp<float>(ws, NV_KCMP), *vcmp = wsp<float>(ws, NV_VCMP), *cs = wsp<float>(ws, NV_CS), *sn = wsp<float>(ws, NV_SN), *qrot = wsp<float>(ws, NV_QROT);
    unsigned* sel = wsp<unsigned>(ws, NV_SEL); float *ocmp = F, *oslc = oraw;
    if (do_hg) {
    LAUNCH(k_hgf, NBK((long)T * 512, 256), 256, proj, I.lbl, F);
    LAUNCH(k_hgrn, NBK(BATCH * 512, 64), 64, proj, F, oraw);
    LAUNCH(k_hgnorm, NBK((long)T * 4, 256), 256, oraw, proj, I.hng, mix);
    }
    if (!do_nsa) return;
    LAUNCH(k_cmp_hidden, NBK((long)BATCH * 2 * NCMP * 256, 256), 256, proj, C_KC, I.pek, I.w1k, I.b1k, hid);
    LAUNCH(k_cmp_out, NBK((long)BATCH * 2 * NCMP * 64, 256), 256, hid, I.w2k, kcmp);
    LAUNCH(k_cmp_hidden, NBK((long)BATCH * 2 * NCMP * 256, 256), 256, proj, C_VC, I.pev, I.w1v, I.b1v, hid);
    LAUNCH(k_cmp_out, NBK((long)BATCH * 2 * NCMP * 64, 256), 256, hid, I.w2v, vcmp);
    LAUNCH(k_rope_tab, NBK(SEQ * 32, 256), 256, cs, sn);
    LAUNCH(k_rope_apply, NBK((long)T * 8 * 32, 256), 256, proj, C_NQ, 8, cs, sn, qrot);
    LAUNCH(k_rope_apply, NBK((long)T * 2 * 32, 256), 256, proj, C_KS, 2, cs, sn, ksr);
    LAUNCH(k_rope_apply, NBK((long)T * 2 * 32, 256), 256, proj, C_KW, 2, cs, sn, kwr);
    LAUNCH(k_cmp_attn, NBK((long)BATCH * 2 * SEQ, 64), 64, proj, kcmp, vcmp, ocmp, PS);
    LAUNCH(k_select, NBK((long)BATCH * 2 * SEQ, 256), 256, PS, sel);
    LAUNCH(k_attn_naive, NBK((long)BATCH * 8 * SEQ, 64), 64, qrot, ksr, proj, C_VS, sel, 0, oslc);
    LAUNCH(k_attn_naive, NBK((long)BATCH * 8 * SEQ, 64), 64, qrot, kwr, proj, C_VW, sel, 1, owin);
    LAUNCH(k_nsa_combine, NBK((long)T * 512, 256), 256, proj, ocmp, oslc, owin, mix);
}
static void s3_naive(const In& I, unsigned char* ws, hipStream_t stream) {
    LAUNCH(k_proj_res, NBK((long)T * D, 256), 256, wsp<bf16_t>(ws, WS_MIX), I.w_out, I.x, wsp<float>(ws, WS_MOD), 2, wsp<float>(ws, WS_X2));
}
static void s4_naive(const In& I, unsigned char* ws, hipStream_t stream) {
    float *x2 = wsp<float>(ws, WS_X2), *rstd = wsp<float>(ws, NV_RSTD2), *h2f = wsp<float>(ws, NV_H2F), *lg = wsp<float>(ws, NV_LG), *mod = wsp<float>(ws, WS_MOD);
    LAUNCH(k_rowrstd, NBK(T, 256), 256, x2, rstd, T);
    LAUNCH(k_modnorm, NBK((long)T * D, 256), 256, x2, rstd, I.n2g, mod, 3, 4, h2f, wsp<bf16_t>(ws, WS_H2));
    LAUNCH(k_gemm_nn, NBK((long)T * 64, 256), 256, h2f, D, I.rw, 64, lg, 64, T, 64, D);
    LAUNCH(k_route, NBK(T, 64), 64, lg, I.rb, wsp<int>(ws, WS_TOPI), wsp<float>(ws, WS_TOPW));
}
static void s5_naive(const In& I, unsigned char* ws, float* out, hipStream_t stream) {
    float *act = wsp<float>(ws, NV_ACT), *acts = wsp<float>(ws, NV_ACTS), *x3 = wsp<float>(ws, NV_X3), *rstd = wsp<float>(ws, NV_RSTD3);
    const bf16_t* h2 = wsp<bf16_t>(ws, WS_H2); const int* topi = wsp<int>(ws, WS_TOPI);
    LAUNCH(k_moe_act, NBK((long)T * 8 * 256, 256), 256, h2, I.wgu, topi, act, (long)T * 8);
    LAUNCH(k_moe_act, NBK((long)T * 256, 256), 256, h2, I.wsgu, (const int*)nullptr, acts, (long)T);
    LAUNCH(k_moe_out, NBK((long)T * D, 256), 256, act, acts, I.wdn, I.wsdn, topi, wsp<float>(ws, WS_TOPW), wsp<float>(ws, WS_X2), wsp<float>(ws, WS_MOD), x3);
    LAUNCH(k_rowrstd, NBK(T, 256), 256, x3, rstd, T);
    LAUNCH(k_final, NBK((long)T * D, 256), 256, x3, rstd, I.fg, out);
}
}
#ifndef CPU_EMU
#define GAS __attribute__((address_space(1)))
#define LAS __attribute__((address_space(3)))
typedef unsigned v4u __attribute__((ext_vector_type(4)));
typedef unsigned v2u __attribute__((ext_vector_type(2)));
typedef float f32x4 __attribute__((ext_vector_type(4)));
typedef float f32x2 __attribute__((ext_vector_type(2)));
typedef float f32x16 __attribute__((ext_vector_type(16)));
typedef short bf16x8 __attribute__((ext_vector_type(8)));
typedef short bf16x4 __attribute__((ext_vector_type(4)));
typedef long i64x2 __attribute__((ext_vector_type(2)));
typedef int v8i __attribute__((ext_vector_type(8)));
typedef int v4i __attribute__((ext_vector_type(4)));
typedef GAS unsigned gu32;
#define RLX_AGENT __ATOMIC_RELAXED, __HIP_MEMORY_SCOPE_AGENT
#define LDS_WAIT() asm volatile("s_waitcnt lgkmcnt(0)" ::: "memory")
#define VM_WAIT() asm volatile("s_waitcnt vmcnt(0)" ::: "memory")
constexpr int NWAVES = 8, NTHR = 512;
__device__ __forceinline__ unsigned pk2(float lo, float hi) { return (unsigned)f2bf(lo) | ((unsigned)f2bf(hi) << 16); }
__device__ __forceinline__ unsigned cvt_pk_bf16(float lo, float hi) { unsigned r; asm volatile("v_cvt_pk_bf16_f32 %0, %1, %2" : "=v"(r) : "v"(lo), "v"(hi)); return r; }
__device__ __forceinline__ float fexp2(float x) { return __builtin_amdgcn_exp2f(__builtin_amdgcn_fmed3f(x, -120.0f, 3.0e38f)); }
__device__ __forceinline__ float fexp(float x) { return __builtin_amdgcn_exp2f(fmaxf(x * 1.4426950408889634f, -120.0f)); }
__device__ __forceinline__ float fsigmoid(float z) { return __builtin_amdgcn_rcpf(1.0f + __builtin_amdgcn_exp2f(__builtin_amdgcn_fmed3f(z * -1.4426950408889634f, -120.0f, 120.0f))); }
__device__ __forceinline__ float fsilu(float z) { return z * __builtin_amdgcn_rcpf(1.0f + __builtin_amdgcn_exp2f(__builtin_amdgcn_fmed3f(z * -1.4426950408889634f, -120.0f, 120.0f))); }
__device__ __forceinline__ unsigned pk4_e4m3(float a, float b, float c, float d, float sc) {
    a = __builtin_amdgcn_fmed3f(a * sc, -448.0f, 448.0f); b = __builtin_amdgcn_fmed3f(b * sc, -448.0f, 448.0f); c = __builtin_amdgcn_fmed3f(c * sc, -448.0f, 448.0f); d = __builtin_amdgcn_fmed3f(d * sc, -448.0f, 448.0f);
    int w = __builtin_amdgcn_cvt_pk_fp8_f32(a, b, 0, false); w = __builtin_amdgcn_cvt_pk_fp8_f32(c, d, w, true); return (unsigned)w;
}
__device__ __forceinline__ float wave_sum(float v) {
#pragma unroll
    for (int o = 1; o < 64; o <<= 1) v += __shfl_xor(v, o);
    return v;
}

#define XB_TMO      128
#define XB_XCNT(j)  (256  + 64 * (j))
#define XB_XSUB(j)  (1280 + 64 * (j))
#define XB_XGEN(j)  (2304 + 64 * (j))
#define XB_TOP      3328
#define XB_TOPGEN   3392
#define XCD_BAR_WORDS 3456
#define XB_SPIN_CAP (1u << 18)
__device__ __forceinline__ unsigned xb_ld(unsigned* p)              { return __hip_atomic_load(p, __ATOMIC_RELAXED, __HIP_MEMORY_SCOPE_AGENT); }
__device__ __forceinline__ unsigned xb_add(unsigned* p, unsigned v) { return __hip_atomic_fetch_add(p, v, __ATOMIC_RELAXED, __HIP_MEMORY_SCOPE_AGENT); }
__device__ __forceinline__ unsigned xb_xcc_id() { return (unsigned)__builtin_amdgcn_s_getreg((3 << 11) | 20) & 0xFu; }
#define XB_SPIN(cond, bar) do { unsigned _sp = 0; while (cond) { __builtin_amdgcn_s_sleep(1); \
    if ((++_sp & 255u) == 0u) { if (xb_ld(&(bar)[XB_TMO])) break; if (_sp > XB_SPIN_CAP) { atomicAdd(&(bar)[XB_TMO], 1u); break; } } } } while (0)
struct XcdBarrier { unsigned* bar; unsigned x; volatile LAS unsigned* st; };
__device__ __forceinline__ XcdBarrier xcd_barrier_post(unsigned* bar, volatile LAS unsigned* st) {
    XcdBarrier b; b.bar = bar; b.x = xb_xcc_id(); b.st = st;
    if (threadIdx.x == 0) (void)xb_add(&bar[XB_XCNT(b.x)], 1u);
    return b;
}
__device__ __forceinline__ void xcd_barrier_complete(unsigned* bar, unsigned x, unsigned& nloc, unsigned& nx) {
    const unsigned G = gridDim.x * gridDim.y * gridDim.z;
    unsigned sum, cnt, mine, sp = 0u;
    for (;;) {
        sum = 0u; cnt = 0u; mine = 0u;
#pragma unroll
        for (unsigned j = 0; j < 16; ++j) { const unsigned c = xb_ld(&bar[XB_XCNT(j)]); sum += c; cnt += (c > 0u) ? 1u : 0u; mine = (j == x) ? c : mine; }
        if (sum == G) break;
        __builtin_amdgcn_s_sleep(1);
        if ((++sp & 255u) == 0u) { if (xb_ld(&bar[XB_TMO])) break; if (sp > XB_SPIN_CAP) { atomicAdd(&bar[XB_TMO], 1u); break; } }
    }
    nloc = mine > 0u ? mine : 1u; nx = cnt > 0u ? cnt : 1u;
}
__device__ __forceinline__ void xcd_barrier(const XcdBarrier& b) {
    asm volatile("s_waitcnt vmcnt(0)" ::: "memory");
    __syncthreads();
    if (threadIdx.x == 0) {
        unsigned* bar = b.bar;
        __builtin_amdgcn_s_waitcnt(0);
        unsigned nloc = b.st[0], nx = b.st[1];
        if (nloc == 0u) { xcd_barrier_complete(bar, b.x, nloc, nx); b.st[0] = nloc; b.st[1] = nx; }
        const unsigned old = xb_add(&bar[XB_XSUB(b.x)], 1u);
        const unsigned gen = old / nloc;
        if (old + 1u == (gen + 1u) * nloc) {
            __builtin_amdgcn_fence(__ATOMIC_RELEASE, "agent");
            asm volatile("s_waitcnt vmcnt(0)" ::: "memory");
            const unsigned og = xb_add(&bar[XB_TOP], 1u);
            const unsigned tg = og / nx;
            if (og + 1u == (tg + 1u) * nx) xb_add(&bar[XB_TOPGEN], 1u);
            else XB_SPIN(xb_ld(&bar[XB_TOPGEN]) == tg, bar);
            __builtin_amdgcn_fence(__ATOMIC_ACQUIRE, "agent");
            xb_add(&bar[XB_XGEN(b.x)], 1u);
            asm volatile("s_waitcnt vmcnt(0)" ::: "memory");
        } else {
            XB_SPIN(xb_ld(&bar[XB_XGEN(b.x)]) == gen, bar);
            __builtin_amdgcn_fence(__ATOMIC_ACQUIRE, "agent");
            asm volatile("s_waitcnt vmcnt(0)" ::: "memory");
        }
    }
    __syncthreads();
}

namespace gm {
constexpr int BM = 256, BK = 64, HALF = 128, HTB = HALF * BK * 2, STAGE_BYTES = 8 * HTB, NXCD = 8, WGM = 8;
__host__ __device__ __forceinline__ int lds_byte(int r, int c) { const int st = (r >> 4) * 2 + (c >> 5), rr = r & 15, cc = c & 31, ob = rr * 64 + cc * 2; return st * 1024 + (ob ^ (((ob >> 9) & 1) << 5)); }
__host__ __device__ __forceinline__ void stage_rc(int b, int& R, int& C) { const int st = b / 1024, sb = b % 1024, swz = sb ^ (((sb >> 9) & 1) << 5); R = (st >> 1) * 16 + swz / 64; C = (st & 1) * 32 + (swz % 64) / 2; }
__host__ __device__ __forceinline__ int perm32(int rho) { const int n = rho >> 4, i = rho & 15; return 8 * (i >> 2) + 4 * n + (i & 3); }

struct Unit { int pm, pn; const char* A; const char* B; int e, m0; };

__device__ __forceinline__ bool static_tile(int nM, int nN, int G, int c, int i, int& pm, int& pn) {
    const int nwg = nM * nN; const long L = (long)i * G + c; if (L >= nwg) return false;
    int wgid = (int)L; { const int q = nwg / NXCD, r = nwg % NXCD, xcd = wgid % NXCD, off = wgid / NXCD; wgid = (xcd < r ? xcd * (q + 1) : r * (q + 1) + (xcd - r) * q) + off; }
    const int nig = WGM * nN, gid = wgid / nig, fm = gid * WGM, gsz = (nM - fm) < WGM ? (nM - fm) : WGM;
    pm = fm + ((wgid % nig) % gsz); pn = (wgid % nig) / gsz; return true;
}
struct DenseSched {
    const char* A; const char* Bt; int nM, nN, G, c; unsigned lda_b, K;
    __device__ __forceinline__ bool next(int i, Unit& u) const { int pm, pn; if (!static_tile(nM, nN, G, c, i, pm, pn)) return false; u.pm = pm; u.pn = pn; u.A = A + (size_t)pm * BM * lda_b; u.B = Bt + (size_t)pn * BM * K * 2; u.e = 0; u.m0 = 0; return true; }
    __device__ __forceinline__ unsigned arow(const Unit&, int r) const { return (unsigned)r * lda_b; }
};

template <class Epi, class Sched, bool FP8 = false>
__device__ __forceinline__ void gemm_phase(LAS unsigned char* lds, const Sched& S, const Epi& E, const int K, const unsigned kstepA) {
    const int tid = threadIdx.x, wid = __builtin_amdgcn_readfirstlane(tid >> 6), lane = tid & 63, wr = wid >> 2, wc = wid & 3, fr = lane & 15, fq = lane >> 4;
    const int nt = K / BK;
    int R0, C0; stage_rc(tid * 16, R0, C0);
    unsigned voffB[2];
#pragma unroll
    for (int i = 0; i < 2; ++i) { const int R = R0 + 64 * i; const int Rb = Epi::PERM ? ((R & ~31) + perm32(R & 31)) : R; voffB[i] = (unsigned)(Rb * K + C0) * 2u; }
    const unsigned ca = (unsigned)C0 * 2u;
    const size_t kstepB = (size_t)(BK * 2);
    const size_t hstepB = (size_t)HALF * K * 2;
    const unsigned ldsw = (unsigned)wid * 1024u;
    const int aoff = lds_byte(wr * 64 + fr, fq * 8), boff = lds_byte(wc * 32 + fr, fq * 8);
#define GM_SA(b, h) (((b) * 2 + (h)) * HTB)
#define GM_SB(b, h) ((4 + (b) * 2 + (h)) * HTB)
#define GM_STAGEB(bufoff, gbase) do { _Pragma("unroll") for (int _i = 0; _i < 2; ++_i) \
        __builtin_amdgcn_global_load_lds((const unsigned*)((const char*)(gbase) + voffB[_i]), (LAS unsigned*)(lds + (bufoff) + ldsw + _i * 8192), 16, 0, 0); } while (0)
#define GM_STAGEA(bufoff, abase, offs, h, kb) do { _Pragma("unroll") for (int _i = 0; _i < 2; ++_i) \
        __builtin_amdgcn_global_load_lds((const unsigned*)((const char*)(abase) + (offs)[2 * (h) + _i] + (kb)), (LAS unsigned*)(lds + (bufoff) + ldsw + _i * 8192), 16, 0, 0); } while (0)
#define GM_LDA(dst, b, h) do { _Pragma("unroll") for (int m = 0; m < 4; ++m) _Pragma("unroll") for (int k = 0; k < 2; ++k) dst[m][k] = *(const LAS bf16x8*)(lds + GM_SA(b, h) + aoff + m * 2048 + k * 1024); } while (0)
#define GM_LDB(dst, b, h) do { _Pragma("unroll") for (int n = 0; n < 2; ++n) _Pragma("unroll") for (int k = 0; k < 2; ++k) dst[n][k] = *(const LAS bf16x8*)(lds + GM_SB(b, h) + boff + n * 2048 + k * 1024); } while (0)
#define GM_MMA(ai, bj, At, Bt) do { __builtin_amdgcn_s_setprio(1); _Pragma("unroll") for (int m = 0; m < 4; ++m) _Pragma("unroll") for (int n = 0; n < 2; ++n) _Pragma("unroll") for (int k = 0; k < 2; ++k) { \
        if constexpr (FP8) { const i64x2 b2_ = __builtin_bit_cast(i64x2, Bt[n][k]), a2_ = __builtin_bit_cast(i64x2, At[m][k]); \
            acc[ai][bj][m][n] = __builtin_amdgcn_mfma_f32_16x16x32_fp8_fp8(b2_[0], a2_[0], acc[ai][bj][m][n], 0, 0, 0); acc[ai][bj][m][n] = __builtin_amdgcn_mfma_f32_16x16x32_fp8_fp8(b2_[1], a2_[1], acc[ai][bj][m][n], 0, 0, 0); } \
        else acc[ai][bj][m][n] = __builtin_amdgcn_mfma_f32_16x16x32_bf16(Bt[n][k], At[m][k], acc[ai][bj][m][n], 0, 0, 0); } __builtin_amdgcn_s_setprio(0); } while (0)
#define GM_WAIT_V(n) asm volatile("s_waitcnt vmcnt(" #n ")" ::: "memory")
#define GM_WAIT_L(n) asm volatile("s_waitcnt lgkmcnt(" #n ")" ::: "memory")
#define GM_BAR __builtin_amdgcn_s_barrier()
#define GM_SCHED __builtin_amdgcn_sched_barrier(0)
    Unit cur, nxt; int ui = 0;
    if (!S.next(0, cur)) return;
    unsigned coff[4], noff[4];
#pragma unroll
    for (int q = 0; q < 4; ++q) { coff[q] = S.arow(cur, R0 + 64 * q) + ca; noff[q] = coff[q]; }
    f32x4 acc[2][2][4][2];
#pragma unroll
    for (int a = 0; a < 2; ++a)
#pragma unroll
        for (int b = 0; b < 2; ++b)
#pragma unroll
            for (int m = 0; m < 4; ++m)
#pragma unroll
                for (int n = 0; n < 2; ++n) acc[a][b][m][n] = (f32x4){0.f, 0.f, 0.f, 0.f};
    bf16x8 At[4][2], B0[2][2], B1[2][2];
    const char* cA = cur.A; const char* cB = cur.B;
    GM_STAGEB(GM_SB(0, 0), cB); GM_STAGEB(GM_SB(0, 1), cB + hstepB); GM_STAGEA(GM_SA(0, 0), cA, coff, 0, 0u); GM_STAGEA(GM_SA(0, 1), cA, coff, 1, 0u);
    if (wr == 1) GM_BAR;
    GM_WAIT_V(2); GM_BAR;
    GM_STAGEB(GM_SB(1, 0), cB + kstepB); GM_STAGEA(GM_SA(1, 0), cA, coff, 0, kstepA); GM_STAGEB(GM_SB(1, 1), cB + hstepB + kstepB);
    GM_WAIT_V(6); GM_BAR;
    for (;;) {
        const bool has_next = S.next(ui + 1, nxt);
        const char* nA = has_next ? nxt.A : cA; const char* nB = has_next ? nxt.B : cB;
        if (has_next) {
#pragma unroll
            for (int q = 0; q < 4; ++q) noff[q] = S.arow(nxt, R0 + 64 * q) + ca;
        } else {
#pragma unroll
            for (int q = 0; q < 4; ++q) noff[q] = coff[q];
        }
#pragma unroll 1
        for (int t = 0; t < nt; t += 2) {
            const bool last = (t == nt - 2);
            const unsigned k1 = (unsigned)(t + 1) * kstepA;
            const char* a2 = last ? nA : cA; const unsigned k2 = last ? 0u : (unsigned)(t + 2) * kstepA, k3 = k2 + kstepA;
            unsigned o2[4];
#pragma unroll
            for (int q = 0; q < 4; ++q) o2[q] = last ? noff[q] : coff[q];
            const char* b2 = last ? nB : cB + (size_t)(t + 2) * kstepB; const char* b3 = b2 + kstepB;
            GM_LDB(B0, 0, 0); GM_LDB(B1, 0, 1); GM_SCHED; GM_LDA(At, 0, 0); GM_STAGEA(GM_SA(1, 1), cA, coff, 1, k1);
            GM_WAIT_V(8); GM_WAIT_L(0); GM_BAR; GM_MMA(0, 0, At, B0); GM_MMA(0, 1, At, B1); GM_BAR; GM_SCHED;
            GM_LDA(At, 0, 1); GM_STAGEB(GM_SB(0, 0), b2); GM_STAGEB(GM_SB(0, 1), b2 + hstepB); GM_STAGEA(GM_SA(0, 0), a2, o2, 0, k2);
            GM_WAIT_V(8); GM_WAIT_L(0); GM_BAR; GM_MMA(1, 0, At, B0); GM_MMA(1, 1, At, B1); GM_BAR; GM_SCHED;
            GM_LDB(B0, 1, 0); GM_LDB(B1, 1, 1); GM_SCHED; GM_LDA(At, 1, 0); GM_STAGEA(GM_SA(0, 1), a2, o2, 1, k2);
            GM_WAIT_V(8); GM_WAIT_L(0); GM_BAR; GM_MMA(0, 0, At, B0); GM_MMA(0, 1, At, B1); GM_BAR; GM_SCHED;
            GM_LDA(At, 1, 1); GM_STAGEB(GM_SB(1, 0), b3); GM_STAGEB(GM_SB(1, 1), b3 + hstepB); GM_STAGEA(GM_SA(1, 0), a2, o2, 0, k3);
            GM_WAIT_V(8); GM_WAIT_L(0); GM_BAR; GM_MMA(1, 0, At, B0); GM_MMA(1, 1, At, B1); GM_BAR; GM_SCHED;
        }
        if (wr == 0) GM_BAR;
        E(acc, cur, wr, wc, fr, fq);
        if (!has_next) break;
#pragma unroll
        for (int a = 0; a < 2; ++a)
#pragma unroll
            for (int b = 0; b < 2; ++b)
#pragma unroll
                for (int m = 0; m < 4; ++m)
#pragma unroll
                    for (int n = 0; n < 2; ++n) acc[a][b][m][n] = (f32x4){0.f, 0.f, 0.f, 0.f};
        cur = nxt; cA = nA; cB = nB; ++ui;
#pragma unroll
        for (int q = 0; q < 4; ++q) coff[q] = noff[q];
        if (wr == 1) GM_BAR;
    }
    GM_WAIT_V(0);
    GM_BAR;
#undef GM_SA
#undef GM_SB
#undef GM_STAGEA
#undef GM_STAGEB
#undef GM_LDA
#undef GM_LDB
#undef GM_MMA
#undef GM_WAIT_V
#undef GM_WAIT_L
#undef GM_BAR
#undef GM_SCHED
}

struct EpiBf16 {
    static constexpr bool PERM = true;
    bf16_t* O; int ldc;
    __device__ __forceinline__ void operator()(const f32x4 (&acc)[2][2][4][2], const Unit& u, int wr, int wc, int fr, int fq) const {
        const int row0 = u.pm * BM + wr * 64 + fr, col0 = u.pn * BM + wc * 32 + 8 * fq;
#pragma unroll
        for (int ai = 0; ai < 2; ++ai)
#pragma unroll
            for (int m = 0; m < 4; ++m) { bf16_t* rowp = O + (size_t)(row0 + ai * HALF + m * 16) * ldc + col0;
#pragma unroll
                for (int bj = 0; bj < 2; ++bj) { const f32x4 v0 = acc[ai][bj][m][0], v1 = acc[ai][bj][m][1];
                    v4u w; w.x = cvt_pk_bf16(v0[0], v0[1]); w.y = cvt_pk_bf16(v0[2], v0[3]); w.z = cvt_pk_bf16(v1[0], v1[1]); w.w = cvt_pk_bf16(v1[2], v1[3]);
                    *(v4u*)(rowp + bj * HALF) = w; } }
    }
};
struct EpiRes {
    static constexpr bool PERM = false;
    const float* x; const float* mod; int chunk; float* out; float* ssq;
    __device__ __forceinline__ void operator()(const f32x4 (&acc)[2][2][4][2], const Unit& u, int wr, int wc, int fr, int fq) const {
        const int row0 = u.pm * BM + wr * 64 + fr, col0 = u.pn * BM + wc * 32 + 4 * fq; const int b = (u.pm * BM) / SEQ;
        f32x4 gv[2][2];
#pragma unroll
        for (int bj = 0; bj < 2; ++bj)
#pragma unroll
            for (int n = 0; n < 2; ++n) gv[bj][n] = *(const f32x4*)(mod + (size_t)b * 6144 + chunk * 1024 + col0 + bj * HALF + n * 16);
#pragma unroll
        for (int ai = 0; ai < 2; ++ai)
#pragma unroll
            for (int m = 0; m < 4; ++m) { const size_t off = (size_t)(row0 + ai * HALF + m * 16) * 1024 + col0; float sq = 0.f;
#pragma unroll
                for (int bj = 0; bj < 2; ++bj)
#pragma unroll
                    for (int n = 0; n < 2; ++n) { const f32x4 xv = *(const f32x4*)(x + off + bj * HALF + n * 16); const f32x4 o = xv + gv[bj][n] * acc[ai][bj][m][n]; *(f32x4*)(out + off + bj * HALF + n * 16) = o;
                        sq += (o[0] * o[0] + o[1] * o[1]) + (o[2] * o[2] + o[3] * o[3]); }
                sq += __shfl_xor(sq, 16); sq += __shfl_xor(sq, 32);
                if (fq == 0) ssq[(size_t)(row0 + ai * HALF + m * 16) * 16 + u.pn * 4 + wc] = sq; }
    }
};
}
#ifndef PROBE_REP
#define PROBE_REP -1
#endif
#ifndef PROBE_P3
#define PROBE_P3 0
#endif
constexpr int RING_BYTES = 131072, LDSCTL_OFF = RING_BYTES, MISC_OFF = LDSCTL_OFF + 320, LDS_BYTES = 147456;
constexpr float WGU_SCALE = 32.0f, WDN_SCALE = 16.0f, ACT_SCALE = 8.0f;
constexpr int CW_BAR = 4096;
constexpr int CW_ECNT = 65536;

struct Args { const float* in[25]; float* out; unsigned char* ws; int ph_lo, ph_hi, rep, pad; };
struct Frame {
    LAS unsigned char* lds; volatile LAS unsigned* MISC; unsigned* ctl; unsigned char* ws;
    int tid, lane, wave, vcu, G;
    const float* in[25]; float* out;
};
#define IN_X 0
#define IN_C 1
#define IN_WADA 2
#define IN_BADA 3
#define IN_N1G 4
#define IN_WIN 5
#define IN_LBL 6
#define IN_HNG 7
#define IN_PEK 8
#define IN_W1K 9
#define IN_B1K 10
#define IN_W2K 11
#define IN_PEV 12
#define IN_W1V 13
#define IN_B1V 14
#define IN_W2V 15
#define IN_WOUT 16
#define IN_N2G 17
#define IN_RW 18
#define IN_RB 19
#define IN_WGU 20
#define IN_WDN 21
#define IN_WSGU 22
#define IN_WSDN 23
#define IN_FG 24

#ifndef PROBE_TIME
#define PROBE_TIME -1
#endif
#define R7STAMP(k) do { if (PROBE_TIME >= 20 && blockIdx.x == 0 && F.tid == 0) ((volatile LAS unsigned long long*)(F.lds + LDSCTL_OFF + 8192))[k] = __builtin_amdgcn_s_memrealtime(); } while (0)
template <bool FRAG = false, bool F8 = false> __device__ __forceinline__ void p0_transpose_item(const float* W, int K, int N, bf16_t* WT, int drow0, int k0, int n0, LAS float* scr, int lane, float f8scale = 1.0f) {
    const int kq = lane >> 3, nq = lane & 7; const int nn = n0 + 4 * nq; const bool ok = nn < N;
    f32x4 v[8];
#pragma unroll
    for (int i = 0; i < 8; ++i) v[i] = ok ? *(const f32x4*)(W + (size_t)(k0 + 8 * i + kq) * N + nn) : (f32x4){0.f, 0.f, 0.f, 0.f};
#pragma unroll
    for (int i = 0; i < 8; ++i) { LAS float* d = scr + (8 * i + kq) * 33 + 4 * nq; d[0] = v[i][0]; d[1] = v[i][1]; d[2] = v[i][2]; d[3] = v[i][3]; }
    LDS_WAIT(); asm volatile("" ::: "memory");
    const int c = lane & 7;
#pragma unroll
    for (int j = 0; j < 4; ++j) { const int n = (lane >> 3) + 8 * j; const LAS float* s = scr + (8 * c) * 33 + n;
        v4u o; o.x = pk2(s[0 * 33], s[1 * 33]); o.y = pk2(s[2 * 33], s[3 * 33]); o.z = pk2(s[4 * 33], s[5 * 33]); o.w = pk2(s[6 * 33], s[7 * 33]);
        if (F8) { *(v2u*)((unsigned char*)WT + (size_t)(drow0 + n) * K + k0 + 8 * c) = (v2u){pk4_e4m3(s[0 * 33], s[1 * 33], s[2 * 33], s[3 * 33], f8scale), pk4_e4m3(s[4 * 33], s[5 * 33], s[6 * 33], s[7 * 33], f8scale)}; }
        else if (FRAG) { const int kk = k0 + 8 * c, col = drow0 + n; *(v4u*)(WT + ((size_t)((kk >> 5) * (N / 16) + (col >> 4)) * 64 + ((kk & 31) >> 3) * 16 + (col & 15)) * 8) = o; }
        else *(v4u*)(WT + (size_t)(drow0 + n) * K + k0 + 8 * c) = o; }
    LDS_WAIT(); asm volatile("" ::: "memory");
}
__device__ __forceinline__ int gu_row(int n) { const int j = n & 255; return (j >> 7) * 256 + ((n >> 8) << 7) + (j & 127); }

__device__ __forceinline__ void p0_prologue(Frame& F) {
    unsigned char* ws = F.ws;
    R7STAMP(30);
    if (F.vcu < 256) {
        LAS float* ca = (LAS float*)F.lds;
        const int ks = F.vcu >> 4, cg = F.vcu & 15;
        if (F.tid < 256) { const int b = F.tid >> 6, k = F.tid & 63; ca[F.tid] = fsilu(F.in[IN_C][b * D + ks * 64 + k]); }
        __syncthreads();
        if (F.tid < 384) { const int n = cg * 384 + F.tid; const float* w = F.in[IN_WADA] + (size_t)(ks * 64) * 6144 + n; float a0 = 0.f, a1 = 0.f, a2 = 0.f, a3 = 0.f;
            float wv[64];
#pragma unroll
            for (int k = 0; k < 64; ++k) wv[k] = w[(size_t)k * 6144];
            __builtin_amdgcn_sched_barrier(0);
#pragma unroll
            for (int k = 0; k < 64; ++k) { a0 += ca[k] * wv[k]; a1 += ca[64 + k] * wv[k]; a2 += ca[128 + k] * wv[k]; a3 += ca[192 + k] * wv[k]; }
            float* mp = (float*)(ws + WS_MODP) + (size_t)ks * 4 * 6144 + n; mp[0] = a0; mp[6144] = a1; mp[2 * 6144] = a2; mp[3 * 6144] = a3; }
        __syncthreads();
    }
    R7STAMP(31);
    { float* cs = (float*)(ws + WS_CS); float* sn = (float*)(ws + WS_SN);
      for (int i = F.vcu * NTHR + F.tid; i < SEQ * 32; i += F.G * NTHR) { const int pos = i >> 5, k = i & 31; const float inv = powf(10000.0f, -(float)k / 32.0f); const float ang = (float)pos * inv; cs[i] = cosf(ang); sn[i] = sinf(ang); } }
    R7STAMP(32);
    LAS float* scr = (LAS float*)(F.lds + 4096 + F.wave * 8704);
    const int gw = F.vcu * NWAVES + F.wave, NGW = F.G * NWAVES;
    constexpr int I_IN = 16 * 105, I_OUT = 16 * 32, I_GU = 16 * 16, I_DN = 4 * 32, I_W1 = 32 * 8;
    constexpr int NIT = I_IN + I_OUT + 64 * I_GU + 64 * I_DN + I_GU + I_DN + 2 * I_W1;
    struct TItem { const float* W; unsigned char* WT; int K, N, drow0, k0, n0, mode; float sc; };
    auto decode = [&](int it, TItem& t) {
        int r = it;
        if (r < I_IN) { const int kb = r / 105, nb = r % 105; t = TItem{F.in[IN_WIN], ws + WS_WINT, 1024, INC, 32 * nb, 64 * kb, 32 * nb, 0, 1.f}; return; } r -= I_IN;
        if (r < I_OUT) { const int kb = r / 32, nb = r % 32; t = TItem{F.in[IN_WOUT], ws + WS_WOUTT, 1024, 1024, 32 * nb, 64 * kb, 32 * nb, 0, 1.f}; return; } r -= I_OUT;
        if (r < 64 * I_GU) { const int e = r / I_GU, q = r % I_GU, kb = q / 16, nb = q % 16; t = TItem{F.in[IN_WGU] + (size_t)e * 1024 * 512, ws + WS_WGUT + (size_t)e * 512 * 1024, 1024, 512, gu_row(32 * nb), 64 * kb, 32 * nb, 1, WGU_SCALE}; return; } r -= 64 * I_GU;
        if (r < 64 * I_DN) { const int e = r / I_DN, q = r % I_DN, kb = q / 32, nb = q % 32; t = TItem{F.in[IN_WDN] + (size_t)e * 256 * 1024, ws + WS_WDNT + (size_t)e * 1024 * 256, 256, 1024, 32 * nb, 64 * kb, 32 * nb, 1, WDN_SCALE}; return; } r -= 64 * I_DN;
        if (r < I_GU) { const int kb = r / 16, nb = r % 16; t = TItem{F.in[IN_WSGU], ws + WS_WSGUT, 1024, 512, gu_row(32 * nb), 64 * kb, 32 * nb, 1, WGU_SCALE}; return; } r -= I_GU;
        if (r < I_DN) { const int kb = r / 32, nb = r % 32; t = TItem{F.in[IN_WSDN], ws + WS_WSDNT, 256, 1024, 32 * nb, 64 * kb, 32 * nb, 1, WDN_SCALE}; return; } r -= I_DN;
        { const int kv = r / I_W1, q = r % I_W1, kb = q / 8, nb = q % 8; t = TItem{F.in[kv ? IN_W1V : IN_W1K], ws + (kv ? WS_W1VT : WS_W1KT), 2048, 256, 32 * nb, 64 * kb, 32 * nb, 2, 1.f}; }
    };
    const int kq = F.lane >> 3, nq = F.lane & 7;
#define P0_LOAD(t, v) do { const int nn_ = (t).n0 + 4 * nq; const bool ok_ = nn_ < (t).N; _Pragma("unroll") for (int i = 0; i < 8; ++i) v[i] = ok_ ? *(const f32x4*)((t).W + (size_t)((t).k0 + 8 * i + kq) * (t).N + nn_) : (f32x4){0.f, 0.f, 0.f, 0.f}; } while (0)
#define P0_PROC(t, v) do { \
            _Pragma("unroll") for (int i = 0; i < 8; ++i) { LAS float* d = scr + (8 * i + kq) * 33 + 4 * nq; d[0] = v[i][0]; d[1] = v[i][1]; d[2] = v[i][2]; d[3] = v[i][3]; } \
            LDS_WAIT(); asm volatile("" ::: "memory"); \
            const int c = F.lane & 7; \
            _Pragma("unroll") for (int j = 0; j < 4; ++j) { const int n = (F.lane >> 3) + 8 * j; const LAS float* s = scr + (8 * c) * 33 + n; \
                if ((t).mode == 1) { *(v2u*)((t).WT + (size_t)((t).drow0 + n) * (t).K + (t).k0 + 8 * c) = (v2u){pk4_e4m3(s[0 * 33], s[1 * 33], s[2 * 33], s[3 * 33], (t).sc), pk4_e4m3(s[4 * 33], s[5 * 33], s[6 * 33], s[7 * 33], (t).sc)}; } \
                else { v4u o; o.x = pk2(s[0 * 33], s[1 * 33]); o.y = pk2(s[2 * 33], s[3 * 33]); o.z = pk2(s[4 * 33], s[5 * 33]); o.w = pk2(s[6 * 33], s[7 * 33]); \
                    if ((t).mode == 2) { const int kk = (t).k0 + 8 * c, col = (t).drow0 + n; *(v4u*)((bf16_t*)(t).WT + ((size_t)((kk >> 5) * ((t).N / 16) + (col >> 4)) * 64 + ((kk & 31) >> 3) * 16 + (col & 15)) * 8) = o; } \
                    else *(v4u*)((bf16_t*)(t).WT + (size_t)((t).drow0 + n) * (t).K + (t).k0 + 8 * c) = o; } } \
            LDS_WAIT(); asm volatile("" ::: "memory"); } while (0)
    if (gw < NIT) {
        TItem ta, tb; f32x4 va[8], vb[8]; decode(gw, ta); P0_LOAD(ta, va);
        for (int it = gw; it < NIT; it += 2 * NGW) {
            const bool hb = it + NGW < NIT;
            if (hb) { decode(it + NGW, tb); P0_LOAD(tb, vb); }
            P0_PROC(ta, va);
            if (!hb) break;
            if (it + 2 * NGW < NIT) { decode(it + 2 * NGW, ta); P0_LOAD(ta, va); }
            P0_PROC(tb, vb);
        }
    }
#undef P0_PROC
#undef P0_LOAD
    __syncthreads(); R7STAMP(33);
    { v4u* z = (v4u*)((bf16_t*)(ws + WS_WINT) + (size_t)3360 * 1024); const int n16 = 224 * 1024 * 2 / 16;
      for (int i = F.vcu * NTHR + F.tid; i < n16; i += F.G * NTHR) z[i] = (v4u){0u, 0u, 0u, 0u}; }
    { bf16_t* w2f = (bf16_t*)(ws + WS_W2T);
      for (int i = F.vcu * NTHR + F.tid; i < 2 * 256 * 64; i += F.G * NTHR) { const int kv = i >> 14, r = i & 16383, k = r >> 6, dd = r & 63; const float v = F.in[kv ? IN_W2V : IN_W2K][r];
          w2f[(size_t)kv * 16384 + ((size_t)((k >> 5) * 4 + (dd >> 4)) * 64 + ((k & 31) >> 3) * 16 + (dd & 15)) * 8 + (k & 7)] = f2bf(v); } }
    { bf16_t* hi = (bf16_t*)(ws + WS_RW); bf16_t* lo = hi + 64 * 1024; const float* rw = F.in[IN_RW];
      for (int i = F.vcu * NTHR + F.tid; i < 64 * 1024; i += F.G * NTHR) { const int k = i >> 6, e = i & 63; const float w = rw[i]; const bf16_t h = f2bf(w);
          const size_t o = ((size_t)((k >> 5) * 4 + (e >> 4)) * 64 + ((k & 31) >> 3) * 16 + (e & 15)) * 8 + (k & 7); hi[o] = h; lo[o] = f2bf(w - bf2f(h)); } }
}

__device__ __forceinline__ void p1a_norm(Frame& F) {
    unsigned char* ws = F.ws; const float* modp = (const float*)(ws + WS_MODP); const float* bada = F.in[IN_BADA];
    for (int i = F.vcu * NTHR + F.tid; i < BATCH * 6144; i += F.G * NTHR) { float a = bada[i % 6144];
#pragma unroll
        for (int ks = 0; ks < 16; ++ks) a += modp[(size_t)ks * 4 * 6144 + i];
        ((float*)(ws + WS_MOD))[i] = a; }
    for (int o = F.vcu * NWAVES + F.wave; o < 512; o += F.G * NWAVES) { const int kv = o >> 8, j = o & 255; const float* pe = F.in[kv ? IN_PEV : IN_PEK];
        const bf16_t* wf = (const bf16_t*)(ws + (kv ? WS_W1VT : WS_W1KT)); float a = 0.f;
#pragma unroll
        for (int i = 0; i < 4; ++i) { const int cid = F.lane + 64 * i, s = cid >> 2, q = cid & 3; const v4u wv = *(const v4u*)(wf + ((size_t)(s * 16 + (j >> 4)) * 64 + q * 16 + (j & 15)) * 8);
            const f32x4 p0 = *(const f32x4*)(pe + 32 * s + 8 * q), p1 = *(const f32x4*)(pe + 32 * s + 8 * q + 4);
            a += bf2f((bf16_t)(wv.x & 0xffff)) * p0[0] + bf2f((bf16_t)(wv.x >> 16)) * p0[1] + bf2f((bf16_t)(wv.y & 0xffff)) * p0[2] + bf2f((bf16_t)(wv.y >> 16)) * p0[3]
               + bf2f((bf16_t)(wv.z & 0xffff)) * p1[0] + bf2f((bf16_t)(wv.z >> 16)) * p1[1] + bf2f((bf16_t)(wv.w & 0xffff)) * p1[2] + bf2f((bf16_t)(wv.w >> 16)) * p1[3]; }
        a = wave_sum(a); if (F.lane == 0) ((float*)(ws + WS_B1F))[o] = a + F.in[kv ? IN_B1V : IN_B1K][j]; }
    LAS float* sh = (LAS float*)F.lds; LAS float* sc = sh + 1024;
    const float* g1 = F.in[IN_N1G]; const float* x = F.in[IN_X]; bf16_t* xn = (bf16_t*)(ws + WS_XN);
    for (int chunk = F.vcu; chunk < T / 64; chunk += F.G) {
        const int b = (chunk * 64) / SEQ;
        __syncthreads();
        for (int i = F.tid; i < 2048; i += NTHR) { const int col = i; float a = bada[col];
#pragma unroll
            for (int ks = 0; ks < 16; ++ks) a += modp[(size_t)(ks * 4 + b) * 6144 + col];
            sh[i] = a; }
        __syncthreads();
#pragma unroll 1
        for (int rr = 0; rr < 8; ++rr) {
            const int row = chunk * 64 + F.wave * 8 + rr; const f32x4* xr = (const f32x4*)(x + (size_t)row * D) + F.lane;
            f32x4 v[4]; float s = 0.f;
#pragma unroll
            for (int j = 0; j < 4; ++j) { v[j] = xr[64 * j]; s += (v[j].x * v[j].x + v[j].y * v[j].y) + (v[j].z * v[j].z + v[j].w * v[j].w); }
            const float rstd = 1.0f / sqrtf(wave_sum(s) * (1.0f / D) + EPS);
            unsigned long long* o8 = (unsigned long long*)(xn + (size_t)row * D) + F.lane;
#pragma unroll
            for (int j = 0; j < 4; ++j) { const int c0 = 4 * F.lane + 256 * j; const f32x4 g = *(const f32x4*)(g1 + c0);
                const float h0 = v[j].x * rstd * g.x * (1.0f + sc[c0]) + sh[c0], h1 = v[j].y * rstd * g.y * (1.0f + sc[c0 + 1]) + sh[c0 + 1];
                const float h2 = v[j].z * rstd * g.z * (1.0f + sc[c0 + 2]) + sh[c0 + 2], h3 = v[j].w * rstd * g.w * (1.0f + sc[c0 + 3]) + sh[c0 + 3];
                o8[64 * j] = (unsigned long long)pk2(h0, h1) | ((unsigned long long)pk2(h2, h3) << 32); }
        }
    }
    __syncthreads();
}


__device__ __forceinline__ float hg_lb(const float* lbl, int j) { return 1.0f / (1.0f + expf(lbl[512 + j] - lbl[j])); }
__device__ __forceinline__ void hg_passA(Frame& F, int unit) {
    unsigned char* ws = F.ws; const bf16_t* proj = (const bf16_t*)(ws + WS_PROJ); float* U = (float*)(ws + WS_U) + (size_t)unit * 16384; float* Dd = (float*)(ws + WS_DD) + (size_t)unit * 128;
    const int b = unit >> 6, h = (unit >> 4) & 3, J = unit & 15; const size_t tok0 = (size_t)b * SEQ + 256 * J;
    const int d = F.tid & 127, g = F.tid >> 7;
    LAS unsigned char* KT = F.lds; LAS unsigned char* VT = F.lds + 65536; LAS float* segtot = (LAS float*)(F.lds + LDSCTL_OFF + 512);
    const float lb = hg_lb(F.in[IN_LBL], h * 128 + d);
    const bf16_t* pf = proj + (tok0 + 64 * g) * LDP + C_HF + h * 128 + d; const bf16_t* pv = proj + (tok0 + 64 * g) * LDP + C_HI + h * 128 + d;
    __syncthreads();
    float fs[64]; unsigned short vraw[64];
#pragma unroll
    for (int s = 0; s < 64; ++s) { fs[s] = bf2f(pf[(size_t)s * LDP]); vraw[s] = pv[(size_t)s * LDP]; }
    float prod = 1.f;
#pragma unroll
    for (int s = 0; s < 64; ++s) { const float f = lb + (1.0f - lb) * fsigmoid(fs[s]); fs[s] = f; prod *= f; }
    segtot[g * 128 + d] = prod;
    __syncthreads();
    float tail = 1.f, Bt = 1.f;
#pragma unroll
    for (int k = 0; k < 4; ++k) { const float v = segtot[k * 128 + d]; Bt *= v; if (k > g) tail *= v; }
    float run = tail;
#pragma unroll
    for (int s8 = 7; s8 >= 0; --s8) { unsigned kk[4], vv[4];
#pragma unroll
        for (int i = 3; i >= 0; --i) { float kt[2];
#pragma unroll
            for (int j = 1; j >= 0; --j) { const int s = 8 * s8 + 2 * i + j; const float f = fs[s]; kt[j] = (1.0f - f) * run; run *= f; }
            kk[i] = pk2(kt[0], kt[1]); vv[i] = (unsigned)vraw[8 * s8 + 2 * i] | ((unsigned)vraw[8 * s8 + 2 * i + 1] << 16); }
        const int c = (8 * g + s8) ^ (d & 31);
        *(LAS v4u*)(KT + d * 512 + c * 16) = (v4u){kk[0], kk[1], kk[2], kk[3]}; *(LAS v4u*)(VT + d * 512 + c * 16) = (v4u){vv[0], vv[1], vv[2], vv[3]}; }
    if (g == 0) Dd[d] = Bt;
    __syncthreads();
    const int dt = F.wave >> 1, et0 = 2 * (F.wave & 1), i = F.lane & 31, hh = F.lane >> 5;
    f32x16 acc[2];
#pragma unroll
    for (int k = 0; k < 16; ++k) { acc[0][k] = 0.f; acc[1][k] = 0.f; }
#pragma unroll 4
    for (int st = 0; st < 16; ++st) { const int ch = 2 * st + hh;
        const bf16x8 a = *(const LAS bf16x8*)(KT + (32 * dt + i) * 512 + ((ch ^ i) & 31) * 16);
#pragma unroll
        for (int t = 0; t < 2; ++t) { const bf16x8 bv = *(const LAS bf16x8*)(VT + (32 * (et0 + t) + i) * 512 + ((ch ^ i) & 31) * 16);
            acc[t] = __builtin_amdgcn_mfma_f32_32x32x16_bf16(a, bv, acc[t], 0, 0, 0); } }
#pragma unroll
    for (int t = 0; t < 2; ++t)
#pragma unroll
        for (int r = 0; r < 16; ++r) U[(size_t)(32 * dt + (r & 3) + 8 * (r >> 2) + 4 * hh) * 128 + 32 * (et0 + t) + i] = acc[t][r];
    __syncthreads();
}
__device__ __forceinline__ unsigned short bf16_rne(float x) { return (unsigned short)(cvt_pk_bf16(x, 0.f) & 0xffffu); }
__device__ __forceinline__ void hg_passC(Frame& F, int unit) {
    unsigned char* ws = F.ws; const bf16_t* proj = (const bf16_t*)(ws + WS_PROJ); bf16_t* mix = (bf16_t*)(ws + WS_MIX);
    const float* Uall = (const float*)(ws + WS_U); const float* Dall = (const float*)(ws + WS_DD);
    const int b = unit >> 6, h = (unit >> 4) & 3, J = unit & 15; const size_t tok0 = (size_t)b * SEQ + 256 * J;
    const int w = F.wave, n = F.lane & 15, q = F.lane >> 4;
    LAS bf16_t* QS = (LAS bf16_t*)F.lds; LAS bf16_t* KH = (LAS bf16_t*)(F.lds + 17408); LAS bf16_t* KT = (LAS bf16_t*)(F.lds + 34816); LAS bf16_t* VT = (LAS bf16_t*)(F.lds + 59392);
    LAS float* G = (LAS float*)(F.lds + 83968); LAS unsigned char* PT = F.lds + 86016; LAS float* SSP = (LAS float*)(F.lds + 88064);
    f32x4 S[8];
#pragma unroll
    for (int dt = 0; dt < 8; ++dt) S[dt] = (f32x4){0.f, 0.f, 0.f, 0.f};
    {
        LAS float* WJ = (LAS float*)F.lds;
        __syncthreads();
        if (F.tid < 128) { float dv[16];
#pragma unroll
            for (int j = 0; j < 16; ++j) dv[j] = (j < J) ? Dall[(size_t)(unit - J + j) * 128 + F.tid] : 1.0f;
            float wgt = 1.0f;
#pragma unroll
            for (int j = 15; j >= 0; --j) { if (j < J) { WJ[j * 128 + F.tid] = wgt; wgt *= dv[j]; } } }
        __syncthreads();
#pragma unroll 4
        for (int j = 0; j < J; ++j) { const float* Uj = Uall + (size_t)(unit - J + j) * 16384;
#pragma unroll
            for (int dt = 0; dt < 8; ++dt) { const f32x4 wv = *(const LAS f32x4*)(WJ + j * 128 + 16 * dt + 4 * q);
#pragma unroll
                for (int r = 0; r < 4; ++r) S[dt][r] += wv[r] * Uj[(size_t)(16 * dt + 4 * q + r) * 128 + 16 * w + n]; } }
        __syncthreads();
    }
    const int d = F.tid & 127, bk = F.tid >> 7; const float lb = hg_lb(F.in[IN_LBL], h * 128 + d);
    const int e0 = h * 128 + 16 * w + 4 * q; const f32x4 ng = *(const f32x4*)(F.in[IN_HNG] + e0);
    unsigned short rf[16], rq[16], rv[16]; v2u rg[4];
#define HG_LOAD(qt_) do { const bf16_t* pr_ = proj + (tok0 + 64 * (qt_) + 16 * bk) * LDP + h * 128 + d; \
        _Pragma("unroll") for (int i = 0; i < 16; ++i) { rf[i] = pr_[(size_t)i * LDP + C_HF]; rq[i] = pr_[(size_t)i * LDP + C_HQ]; rv[i] = pr_[(size_t)i * LDP + C_HI]; } \
        _Pragma("unroll") for (int bb = 0; bb < 4; ++bb) rg[bb] = *(const v2u*)(proj + (tok0 + 64 * (qt_) + 16 * bb + n) * LDP + C_HGT + e0); } while (0)
    HG_LOAD(0);
#pragma unroll 1
    for (int qt = 0; qt < 4; ++qt) {
        const size_t t0 = tok0 + 64 * qt;
        { float fv[16], E[16]; float run = 1.f;
#pragma unroll
          for (int i = 0; i < 16; ++i) { const float f = lb + (1.0f - lb) * fsigmoid(bf2f(rf[i])); fv[i] = f; run *= f; E[i] = run; }
          const float cc = run; unsigned kt[8], vv[8];
#pragma unroll
          for (int i = 0; i < 16; ++i) { const float inv = __builtin_amdgcn_rcpf(E[i]), kf = 1.0f - fv[i];
              QS[(bk * 16 + i) * 136 + d] = bf16_rne(bf2f(rq[i]) * 0.08838834764831845f * E[i]); KH[(bk * 16 + i) * 136 + d] = bf16_rne(kf * inv);
              const unsigned kb = bf16_rne(kf * cc * inv);
              if (i & 1) { kt[i >> 1] |= kb << 16; vv[i >> 1] |= (unsigned)rv[i] << 16; } else { kt[i >> 1] = kb; vv[i >> 1] = rv[i]; } }
          LAS v4u* kp = (LAS v4u*)(KT + (bk * 128 + d) * 24); kp[0] = (v4u){kt[0], kt[1], kt[2], kt[3]}; kp[1] = (v4u){kt[4], kt[5], kt[6], kt[7]};
          LAS v4u* vp = (LAS v4u*)(VT + (bk * 128 + d) * 24); vp[0] = (v4u){vv[0], vv[1], vv[2], vv[3]}; vp[1] = (v4u){vv[4], vv[5], vv[6], vv[7]};
          G[bk * 128 + d] = cc; }
        v2u gq[4];
#pragma unroll
        for (int bb = 0; bb < 4; ++bb) gq[bb] = rg[bb];
        if (qt < 3) HG_LOAD(qt + 1);
        __syncthreads();
        if (w < 4) { f32x4 pt = (f32x4){0.f, 0.f, 0.f, 0.f};
#pragma unroll
            for (int st = 0; st < 4; ++st) { const bf16x8 a = *(const LAS bf16x8*)(KH + (w * 16 + n) * 136 + 32 * st + 8 * q), bq = *(const LAS bf16x8*)(QS + (w * 16 + n) * 136 + 32 * st + 8 * q);
                pt = __builtin_amdgcn_mfma_f32_16x16x32_bf16(a, bq, pt, 0, 0, 0); }
            v2u o; o.x = cvt_pk_bf16((4 * q + 0) <= n ? pt[0] : 0.f, (4 * q + 1) <= n ? pt[1] : 0.f); o.y = cvt_pk_bf16((4 * q + 2) <= n ? pt[2] : 0.f, (4 * q + 3) <= n ? pt[3] : 0.f);
            *(LAS v2u*)(PT + (w * 64 + F.lane) * 8) = o; }
        __syncthreads();
        f32x4 ob[4]; float ssb[4];
#pragma unroll
        for (int bb = 0; bb < 4; ++bb) {
            f32x4 o = (f32x4){0.f, 0.f, 0.f, 0.f};
#pragma unroll
            for (int st = 0; st < 4; ++st) {
                const v2u s0 = (v2u){cvt_pk_bf16(S[2 * st][0], S[2 * st][1]), cvt_pk_bf16(S[2 * st][2], S[2 * st][3])}, s1 = (v2u){cvt_pk_bf16(S[2 * st + 1][0], S[2 * st + 1][1]), cvt_pk_bf16(S[2 * st + 1][2], S[2 * st + 1][3])};
                const bf16x8 a = __builtin_bit_cast(bf16x8, (v4u){s0.x, s0.y, s1.x, s1.y});
                const v2u q0 = *(const LAS v2u*)(QS + (bb * 16 + n) * 136 + 32 * st + 4 * q), q1 = *(const LAS v2u*)(QS + (bb * 16 + n) * 136 + 32 * st + 16 + 4 * q);
                const bf16x8 bq = __builtin_bit_cast(bf16x8, (v4u){q0.x, q0.y, q1.x, q1.y});
                o = __builtin_amdgcn_mfma_f32_16x16x32_bf16(a, bq, o, 0, 0, 0); }
            { const v2u va = *(const LAS v2u*)(VT + (bb * 128 + 16 * w + n) * 24 + 4 * q); const bf16x8 a = __builtin_bit_cast(bf16x8, (v4u){va.x, va.y, 0u, 0u});
              const v2u pb = *(const LAS v2u*)(PT + (bb * 64 + F.lane) * 8); const bf16x8 pB = __builtin_bit_cast(bf16x8, (v4u){pb.x, pb.y, 0u, 0u});
              o = __builtin_amdgcn_mfma_f32_16x16x32_bf16(a, pB, o, 0, 0, 0); }
            { bf16x8 bv; if (q < 2) bv = *(const LAS bf16x8*)(VT + (bb * 128 + 16 * w + n) * 24 + 8 * q); else bv = (bf16x8){0, 0, 0, 0, 0, 0, 0, 0};
#pragma unroll
              for (int dt = 0; dt < 8; ++dt) { const f32x4 gv = *(const LAS f32x4*)(G + bb * 128 + 16 * dt + 4 * q); S[dt] = S[dt] * gv;
                  bf16x8 a; if (q < 2) a = *(const LAS bf16x8*)(KT + (bb * 128 + 16 * dt + n) * 24 + 8 * q); else a = (bf16x8){0, 0, 0, 0, 0, 0, 0, 0};
                  S[dt] = __builtin_amdgcn_mfma_f32_16x16x32_bf16(a, bv, S[dt], 0, 0, 0); } }
            float ss = (o[0] * o[0] + o[1] * o[1]) + (o[2] * o[2] + o[3] * o[3]); ss += __shfl_xor(ss, 16); ss += __shfl_xor(ss, 32);
            ob[bb] = o; ssb[bb] = ss;
        }
        if (q == 0) {
#pragma unroll
            for (int bb = 0; bb < 4; ++bb) SSP[w * 64 + 16 * bb + n] = ssb[bb]; }
        __syncthreads();
#pragma unroll
        for (int bb = 0; bb < 4; ++bb) { float tots = 0.f;
#pragma unroll
            for (int k = 0; k < 8; ++k) tots += SSP[k * 64 + 16 * bb + n];
            const float rstd = 1.0f / sqrtf(tots * (1.0f / 128.0f) + EPS); const v2u gt = gq[bb];
            const float g0 = bf2f((bf16_t)(gt.x & 0xffff)), g1 = bf2f((bf16_t)(gt.x >> 16)), g2 = bf2f((bf16_t)(gt.y & 0xffff)), g3 = bf2f((bf16_t)(gt.y >> 16));
            v2u ov; ov.x = cvt_pk_bf16(ob[bb][0] * rstd * ng[0] * fsilu(g0), ob[bb][1] * rstd * ng[1] * fsilu(g1)); ov.y = cvt_pk_bf16(ob[bb][2] * rstd * ng[2] * fsilu(g2), ob[bb][3] * rstd * ng[3] * fsilu(g3));
            *(v2u*)(mix + (t0 + 16 * bb + n) * D + e0) = ov; }
    }
#undef HG_LOAD
    __syncthreads();
}

#ifndef PROBE_TIME
#define PROBE_TIME -1
#endif
constexpr int LG_P = 65;
__device__ __forceinline__ void p5_router(Frame& F) {
    unsigned char* ws = F.ws; const float* x2 = (const float*)(ws + WS_X2); const float* mod = (const float*)(ws + WS_MOD); const float* g2 = F.in[IN_N2G];
    const bf16_t* rwh = (const bf16_t*)(ws + WS_RW); const bf16_t* rwl = rwh + 64 * 1024; bf16_t* H2 = (bf16_t*)(ws + WS_H2);
    int* TOPI = (int*)(ws + WS_TOPI); float* TOPW = (float*)(ws + WS_TOPW); int* ROWL = (int*)(ws + WS_ROWL); int* ERANK = (int*)(ws + WS_ERANK); unsigned* ECNT = F.ctl + CW_ECNT;
    LAS float* LG = (LAS float*)F.lds;
    LAS float* GS = LG + 64 * LG_P;
    LAS float* WSL = GS + 512;
    LAS int* EI = (LAS int*)(WSL + 512);
    LAS unsigned* LCNT = (LAS unsigned*)(EI + 512);
    LAS unsigned* LBASE = LCNT + 64;
    LAS float* GSL = (LAS float*)(LBASE + 64);
    LAS float* SHL = GSL + 1024;
    LAS unsigned long long* KEY = (LAS unsigned long long*)(F.lds + 65536);
    const int r = F.lane & 15, q = F.lane >> 4, rt = F.wave & 3, eh = F.wave >> 2;
    for (int unit = F.vcu; unit < T / 64; unit += F.G) {
        const int row0 = unit * 64, b = row0 / SEQ, row = row0 + 16 * rt + r;
        __syncthreads();
        R7STAMP(20);
        if (F.tid < 64) LCNT[F.tid] = 0u;
        for (int k = F.tid; k < 1024; k += NTHR) { GSL[k] = g2[k] * (1.0f + mod[(size_t)b * 6144 + 4 * 1024 + k]); SHL[k] = mod[(size_t)b * 6144 + 3 * 1024 + k]; }
        const float* xr = x2 + (size_t)row * D + 8 * q;
        float ss; { const f32x4* sp = (const f32x4*)((const float*)(ws + WS_SSQ) + (size_t)row * 16); const f32x4 s0 = sp[0], s1 = sp[1], s2 = sp[2], s3 = sp[3];
            ss = ((s0[0] + s0[1]) + (s0[2] + s0[3])) + ((s1[0] + s1[1]) + (s1[2] + s1[3])) + ((s2[0] + s2[1]) + (s2[2] + s2[3])) + ((s3[0] + s3[1]) + (s3[2] + s3[3])); }
        const float rstd = 1.0f / sqrtf(ss * (1.0f / D) + EPS);
        __syncthreads();
#ifndef PROBE_R7
#define PROBE_R7 0
#endif
        f32x4 acc[2];
        for (int rep7_ = 0; rep7_ <= PROBE_R7; ++rep7_) {
        acc[0] = (f32x4){0.f, 0.f, 0.f, 0.f}; acc[1] = acc[0];
        const bf16_t* rwh0 = rwh + ((size_t)(2 * eh) * 64 + F.lane) * 8; const bf16_t* rwl0 = rwl + ((size_t)(2 * eh) * 64 + F.lane) * 8;
#pragma unroll 1
        for (int s4 = 0; s4 < 32; s4 += 4) {
            f32x4 xa[4][2]; bf16x8 bh[4][2], bl[4][2];
#pragma unroll
            for (int u = 0; u < 4; ++u) { const int s = s4 + u; xa[u][0] = *(const f32x4*)(xr + 32 * s); xa[u][1] = *(const f32x4*)(xr + 32 * s + 4);
                bh[u][0] = *(const bf16x8*)(rwh0 + (size_t)s * 2048); bl[u][0] = *(const bf16x8*)(rwl0 + (size_t)s * 2048); bh[u][1] = *(const bf16x8*)(rwh0 + (size_t)s * 2048 + 512); bl[u][1] = *(const bf16x8*)(rwl0 + (size_t)s * 2048 + 512); }
            __builtin_amdgcn_sched_barrier(0);
#pragma unroll
            for (int u = 0; u < 4; ++u) { const int s = s4 + u; float gv[8], sh[8];
                *(f32x4*)&gv[0] = *(const LAS f32x4*)(GSL + 32 * s + 8 * q); *(f32x4*)&gv[4] = *(const LAS f32x4*)(GSL + 32 * s + 8 * q + 4);
                *(f32x4*)&sh[0] = *(const LAS f32x4*)(SHL + 32 * s + 8 * q); *(f32x4*)&sh[4] = *(const LAS f32x4*)(SHL + 32 * s + 8 * q + 4);
                bf16x8 ahi, alo; float hf[8];
#pragma unroll
                for (int j = 0; j < 8; ++j) { const float h = xa[u][j >> 2][j & 3] * rstd * gv[j] + sh[j]; hf[j] = h; const bf16_t hb = f2bf(h); ahi[j] = (short)hb; alo[j] = (short)f2bf(h - bf2f(hb)); }
                if (eh == 0) *(v2u*)((unsigned char*)H2 + (size_t)row * D + 32 * s + 8 * q) = (v2u){pk4_e4m3(hf[0], hf[1], hf[2], hf[3], 1.0f), pk4_e4m3(hf[4], hf[5], hf[6], hf[7], 1.0f)};
                acc[0] = __builtin_amdgcn_mfma_f32_16x16x32_bf16(ahi, bh[u][0], acc[0], 0, 0, 0); acc[0] = __builtin_amdgcn_mfma_f32_16x16x32_bf16(ahi, bl[u][0], acc[0], 0, 0, 0); acc[0] = __builtin_amdgcn_mfma_f32_16x16x32_bf16(alo, bh[u][0], acc[0], 0, 0, 0);
                acc[1] = __builtin_amdgcn_mfma_f32_16x16x32_bf16(ahi, bh[u][1], acc[1], 0, 0, 0); acc[1] = __builtin_amdgcn_mfma_f32_16x16x32_bf16(ahi, bl[u][1], acc[1], 0, 0, 0); acc[1] = __builtin_amdgcn_mfma_f32_16x16x32_bf16(alo, bh[u][1], acc[1], 0, 0, 0); }
        }
        }
#pragma unroll
        for (int nt = 0; nt < 2; ++nt)
#pragma unroll
            for (int i = 0; i < 4; ++i) LG[(16 * rt + 4 * q + i) * LG_P + 32 * eh + 16 * nt + r] = acc[nt][i];
        __syncthreads();
        R7STAMP(21);
        const int t = F.tid >> 3, g = F.tid & 7; const float* rb = F.in[IN_RB];
        float sc8[8]; unsigned long long key8[8]; float a1 = -3e38f, a2 = -3e38f;
#pragma unroll
        for (int j = 0; j < 8; ++j) { const float s_ = fsigmoid(LG[t * LG_P + 8 * g + j]); sc8[j] = s_; const float c_ = s_ + rb[8 * g + j]; if (c_ > a1) { a2 = a1; a1 = c_; } else if (c_ > a2) a2 = c_;
            unsigned ub = __float_as_uint(c_); ub = (ub & 0x80000000u) ? ~ub : (ub | 0x80000000u);
            key8[j] = ((unsigned long long)ub << 8) | (unsigned)(63 - (8 * g + j)); }
        GS[t * 8 + g] = a1 + a2;
        __syncthreads();
#pragma unroll
        for (int j = 0; j < 8; ++j) KEY[t * 64 + 8 * g + j] = key8[j];
        int grank = 0; const float myg = GS[t * 8 + g];
#pragma unroll
        for (int k = 0; k < 8; ++k) { const float o = GS[t * 8 + k]; if (o > myg || (o == myg && k < g)) ++grank; }
        const bool gsel = grank < 4;
        const unsigned long long bal = __ballot(gsel); const unsigned gmask = (unsigned)(bal >> (F.lane & ~7)) & 0xffu;
        __syncthreads();
        if (gsel) {
            int rk[8];
#pragma unroll
            for (int j = 0; j < 8; ++j) rk[j] = 0;
            for (int k = 0; k < 8; ++k) { if (!((gmask >> k) & 1u)) continue;
#pragma unroll
                for (int jj = 0; jj < 8; ++jj) { const unsigned long long o = KEY[t * 64 + 8 * k + jj];
#pragma unroll
                    for (int j = 0; j < 8; ++j) rk[j] += (o > key8[j]) ? 1 : 0; } }
#pragma unroll
            for (int j = 0; j < 8; ++j) if (rk[j] < 8) { WSL[t * 8 + rk[j]] = sc8[j]; EI[t * 8 + rk[j]] = 8 * g + j; }
        }
        __syncthreads();
        float wsum = 0.f;
#pragma unroll
        for (int k = 0; k < 8; ++k) wsum += WSL[t * 8 + k];
        const int e = EI[t * 8 + g]; const float w = WSL[t * 8 + g] / wsum * 2.5f;
        const int aid = (row0 + t) * 8 + g;
        R7STAMP(22);
        TOPI[aid] = e; TOPW[aid] = w;
        const unsigned lp = atomicAdd((unsigned*)&LCNT[e], 1u);
        __syncthreads();
        if (F.tid < 64) { const unsigned c = LCNT[F.tid]; LBASE[F.tid] = c ? atomicAdd(&ECNT[F.tid], c) : 0u; }
        __syncthreads();
        { const unsigned rk = LBASE[e] + lp; ROWL[(size_t)e * T + rk] = aid; ERANK[aid] = (int)rk; }
        R7STAMP(23);
    }
    __syncthreads();
}


struct MoeTabs { LAS unsigned* cnt; LAS unsigned* tstart; LAS unsigned short* tex; int ntr; };
__device__ __forceinline__ MoeTabs moe_tabs_build(Frame& F) {
    MoeTabs Tb; Tb.cnt = (LAS unsigned*)(F.lds + LDSCTL_OFF + 512); Tb.tstart = Tb.cnt + 64; Tb.tex = (LAS unsigned short*)(Tb.tstart + 68);
    __syncthreads();
    if (F.tid < 64) { unsigned c = __hip_atomic_load(F.ctl + CW_ECNT + F.tid, RLX_AGENT); Tb.cnt[F.tid] = c > (unsigned)T ? (unsigned)T : c; }
    __syncthreads();
    if (F.tid == 0) { unsigned a = 0; for (int e = 0; e < 64; ++e) { Tb.tstart[e] = a; a += (Tb.cnt[e] + 255u) >> 8; } Tb.tstart[64] = a; }
    __syncthreads();
    Tb.ntr = (int)Tb.tstart[64];
    for (int tau = F.tid; tau < Tb.ntr; tau += NTHR) { int e = 0; for (int k = 0; k < 64; ++k) if (Tb.tstart[k] <= (unsigned)tau) e = k; Tb.tex[tau] = (unsigned short)e; }
    __syncthreads();
    return Tb;
}
__device__ __forceinline__ int xcd_chunk(int L, int n) { const int q = n / 8, r = n % 8, xcd = L % 8, off = L / 8; return (xcd < r ? xcd * (q + 1) : r * (q + 1) + (xcd - r) * q) + off; }
struct GateUpSched {
    MoeTabs Tb; const char* H2; const char* Wgu; const char* Wsgu; const int* rowl; int G, c;
    __device__ __forceinline__ bool next(int i, gm::Unit& u) const {
        const int nun = 2 * Tb.ntr + 2 * (T / 256); const long L = (long)i * G + c; if (L >= nun) return false;
        const int w = xcd_chunk((int)L, nun); u.A = H2;
        if (w < 2 * Tb.ntr) { const int tau = w >> 1; u.pn = w & 1; u.e = Tb.tex[tau]; u.m0 = 256 * (tau - (int)Tb.tstart[u.e]); u.pm = tau; u.B = Wgu + (size_t)u.e * 512 * 1024 + (size_t)u.pn * 256 * 1024; }
        else { const int s = w - 2 * Tb.ntr; u.pm = s >> 1; u.pn = s & 1; u.e = 64; u.m0 = 256 * u.pm; u.B = Wsgu + (size_t)u.pn * 256 * 1024; }
        return true;
    }
    __device__ __forceinline__ unsigned arow(const gm::Unit& u, int r) const {
        if (u.e == 64) return (unsigned)(u.m0 + r) * 1024u;
        const int idx = u.m0 + r; const int aid = idx < (int)Tb.cnt[u.e] ? rowl[(size_t)u.e * T + idx] : 0;
        return (unsigned)(aid >> 3) * 1024u;
    }
};
struct EpiSwiglu {
    static constexpr bool PERM = true;
    unsigned char* act; unsigned char* acts;
    __device__ __forceinline__ void operator()(const f32x4 (&acc)[2][2][4][2], const gm::Unit& u, int wr, int wc, int fr, int fq) const {
        unsigned char* O = (u.e == 64 ? acts : act) + (size_t)(u.pm * 256 + wr * 64 + fr) * 256 + 128 * u.pn + wc * 32 + 8 * fq; const float is = 1.0f / WGU_SCALE;
#pragma unroll
        for (int ai = 0; ai < 2; ++ai)
#pragma unroll
            for (int m = 0; m < 4; ++m) { const f32x4 g0 = acc[ai][0][m][0] * is, g1 = acc[ai][0][m][1] * is, u0 = acc[ai][1][m][0] * is, u1 = acc[ai][1][m][1] * is;
                *(v2u*)(O + (size_t)(ai * 128 + m * 16) * 256) = (v2u){pk4_e4m3(fsilu(g0[0]) * u0[0], fsilu(g0[1]) * u0[1], fsilu(g0[2]) * u0[2], fsilu(g0[3]) * u0[3], ACT_SCALE),
                                                                      pk4_e4m3(fsilu(g1[0]) * u1[0], fsilu(g1[1]) * u1[1], fsilu(g1[2]) * u1[2], fsilu(g1[3]) * u1[3], ACT_SCALE)}; }
    }
};
struct DownSched {
    MoeTabs Tb; const char* act; const char* acts; const char* Wdn; const char* Wsdn; int G, c;
    __device__ __forceinline__ bool next(int i, gm::Unit& u) const {
        const int nun = 4 * Tb.ntr + 4 * (T / 256); const long L = (long)i * G + c; if (L >= nun) return false;
        const int w = xcd_chunk((int)L, nun);
        if (w < 4 * Tb.ntr) { const int tau = w >> 2; u.pn = w & 3; u.e = Tb.tex[tau]; u.m0 = 256 * (tau - (int)Tb.tstart[u.e]); u.pm = tau;
            u.A = act + (size_t)tau * 256 * 256; u.B = Wdn + (size_t)u.e * 1024 * 256 + (size_t)u.pn * 256 * 256; }
        else { const int s = w - 4 * Tb.ntr; u.pm = s >> 2; u.pn = s & 3; u.e = 64; u.m0 = 256 * u.pm; u.A = acts + (size_t)u.pm * 256 * 256; u.B = Wsdn + (size_t)u.pn * 256 * 256; }
        return true;
    }
    __device__ __forceinline__ unsigned arow(const gm::Unit&, int r) const { return (unsigned)r * 256u; }
};
typedef float f32x2_t __attribute__((ext_vector_type(2)));
__device__ __forceinline__ unsigned pk4_fp8(float a, float b, float c, float d) {
    a = fminf(fmaxf(a * 16.0f, -448.0f), 448.0f); b = fminf(fmaxf(b * 16.0f, -448.0f), 448.0f); c = fminf(fmaxf(c * 16.0f, -448.0f), 448.0f); d = fminf(fmaxf(d * 16.0f, -448.0f), 448.0f);
    int w = __builtin_amdgcn_cvt_pk_fp8_f32(a, b, 0, false); w = __builtin_amdgcn_cvt_pk_fp8_f32(c, d, w, true); return (unsigned)w;
}
struct EpiDown {
    static constexpr bool PERM = true;
    unsigned char* Y8; bf16_t* YS;
    __device__ __forceinline__ void operator()(const f32x4 (&acc)[2][2][4][2], const gm::Unit& u, int wr, int wc, int fr, int fq) const {
        const size_t off = (size_t)(u.pm * 256 + wr * 64 + fr) * 1024 + u.pn * 256 + wc * 32 + 8 * fq;
        if (u.e == 64) {
#pragma unroll
            for (int ai = 0; ai < 2; ++ai)
#pragma unroll
                for (int m = 0; m < 4; ++m)
#pragma unroll
                    for (int bj = 0; bj < 2; ++bj) { const f32x4 v0 = acc[ai][bj][m][0] * (1.0f / (WDN_SCALE * ACT_SCALE)), v1 = acc[ai][bj][m][1] * (1.0f / (WDN_SCALE * ACT_SCALE));
                        v4u w; w.x = cvt_pk_bf16(v0[0], v0[1]); w.y = cvt_pk_bf16(v0[2], v0[3]); w.z = cvt_pk_bf16(v1[0], v1[1]); w.w = cvt_pk_bf16(v1[2], v1[3]);
                        *(v4u*)(YS + off + (size_t)(ai * 128 + m * 16) * 1024 + bj * 128) = w; }
        } else {
#pragma unroll
            for (int ai = 0; ai < 2; ++ai)
#pragma unroll
                for (int m = 0; m < 4; ++m)
#pragma unroll
                    for (int bj = 0; bj < 2; ++bj) { const f32x4 v0 = acc[ai][bj][m][0] * (1.0f / (WDN_SCALE * ACT_SCALE)), v1 = acc[ai][bj][m][1] * (1.0f / (WDN_SCALE * ACT_SCALE));
                        *(v2u*)(Y8 + off + (size_t)(ai * 128 + m * 16) * 1024 + bj * 128) = (v2u){pk4_fp8(v0[0], v0[1], v0[2], v0[3]), pk4_fp8(v1[0], v1[1], v1[2], v1[3])}; }
        }
    }
};

__device__ __forceinline__ void p8_final(Frame& F) {
    unsigned char* ws = F.ws; const unsigned char* Y = (const unsigned char*)(ws + WS_Y); const bf16_t* YS = (const bf16_t*)(ws + WS_YS);
    const float* x2 = (const float*)(ws + WS_X2); const float* mod = (const float*)(ws + WS_MOD); const float* fg = F.in[IN_FG];
    const int* TOPI = (const int*)(ws + WS_TOPI); const float* TOPW = (const float*)(ws + WS_TOPW); const int* ERANK = (const int*)(ws + WS_ERANK);
    const MoeTabs Tb = moe_tabs_build(F);
    const int w = F.wave;
    for (int unit = F.vcu; unit < T / 64; unit += F.G) {
        const int row0 = unit * 64 + 8 * w, b = row0 / SEQ;
        const int aid = row0 * 8 + F.lane; const int e = TOPI[aid]; const float wl = TOPW[aid]; const unsigned prl = 256u * Tb.tstart[e] + (unsigned)ERANK[aid];
        v2u ybA[8]; v4u ysA; v2u ybB[8]; v4u ysB;
#define P10_LOAD(yb, ysb, rr_, sg_) do { const int t_ = row0 + (rr_); _Pragma("unroll") for (int sl = 0; sl < 8; ++sl) { const unsigned pr_ = (unsigned)__shfl((int)prl, (rr_) * 8 + sl); \
            yb[sl] = *(const v2u*)(Y + (size_t)pr_ * 1024 + (sg_) * 512 + 8 * F.lane); } \
            ysb = *(const v4u*)(YS + (size_t)t_ * 1024 + (sg_) * 512 + 8 * F.lane); } while (0)
#define P10_HALF(yb, ysb, rr_, sg_) do { const int t = row0 + (rr_); float moe[8]; \
            { const unsigned vw[4] = {ysb.x, ysb.y, ysb.z, ysb.w}; \
                _Pragma("unroll") for (int k = 0; k < 4; ++k) { moe[2 * k] = bf2f((bf16_t)(vw[k] & 0xffff)); moe[2 * k + 1] = bf2f((bf16_t)(vw[k] >> 16)); } } \
            _Pragma("unroll") for (int sl = 0; sl < 8; ++sl) { const float wgt = __shfl(wl, (rr_) * 8 + sl) * 0.0625f; \
                const f32x2_t d0 = __builtin_amdgcn_cvt_pk_f32_fp8((int)yb[sl].x, false), d1 = __builtin_amdgcn_cvt_pk_f32_fp8((int)yb[sl].x, true), d2 = __builtin_amdgcn_cvt_pk_f32_fp8((int)yb[sl].y, false), d3 = __builtin_amdgcn_cvt_pk_f32_fp8((int)yb[sl].y, true); \
                moe[0] += wgt * d0[0]; moe[1] += wgt * d0[1]; moe[2] += wgt * d1[0]; moe[3] += wgt * d1[1]; moe[4] += wgt * d2[0]; moe[5] += wgt * d2[1]; moe[6] += wgt * d3[0]; moe[7] += wgt * d3[1]; } \
            _Pragma("unroll") for (int h = 0; h < 2; ++h) { const int c0 = (sg_) * 512 + 8 * F.lane + 4 * h; \
                const f32x4 xv = *(const f32x4*)(x2 + (size_t)t * D + c0), gv = *(const f32x4*)(mod + (size_t)b * 6144 + 5 * 1024 + c0); \
                _Pragma("unroll") for (int j = 0; j < 4; ++j) { const float v = xv[j] + gv[j] * moe[4 * h + j]; x3[(sg_) * 8 + 4 * h + j] = v; ss += v * v; } } } while (0)
        P10_LOAD(ybA, ysA, 0, 0);
#pragma unroll 1
        for (int rr = 0; rr < 8; ++rr) {
            float x3[16]; float ss = 0.f;
            P10_LOAD(ybB, ysB, rr, 1);
            P10_HALF(ybA, ysA, rr, 0);
            if (rr < 7) P10_LOAD(ybA, ysA, rr + 1, 0);
            P10_HALF(ybB, ysB, rr, 1);
            const int t = row0 + rr;
            const float rstd = 1.0f / sqrtf(wave_sum(ss) * (1.0f / D) + EPS);
#pragma unroll
            for (int sg = 0; sg < 2; ++sg)
#pragma unroll
                for (int h = 0; h < 2; ++h) { const int c0 = sg * 512 + 8 * F.lane + 4 * h; const f32x4 gg = *(const f32x4*)(fg + c0); f32x4 o;
#pragma unroll
                    for (int j = 0; j < 4; ++j) o[j] = x3[sg * 8 + 4 * h + j] * rstd * gg[j];
                    *(f32x4*)(F.out + (size_t)t * D + c0) = o; }
        }
#undef P10_HALF
#undef P10_LOAD
    }
    __syncthreads();
}

__device__ __forceinline__ float fgelu_tanh(float z) { const float u = 0.7978845608028654f * (z + 0.044715f * z * z * z); const float e = __expf(2.0f * u); return 0.5f * z * (1.0f + (e - 1.0f) / (e + 1.0f)); }
__device__ __forceinline__ float fgelu_safe(float z) { const float u = 0.7978845608028654f * (z + 0.044715f * z * z * z); const float uc = __builtin_amdgcn_fmed3f(u, -15.f, 15.f); const float e = fexp(2.0f * uc); return 0.5f * z * (1.0f + (e - 1.0f) / (e + 1.0f)); }

__device__ __forceinline__ void cmp_unit(Frame& F, int unit) {
    unsigned char* ws = F.ws; const bf16_t* proj = (const bf16_t*)(ws + WS_PROJ);
    const int kv = unit >> 6, mb = unit & 63; const bf16_t* W1T = (const bf16_t*)(ws + (kv ? WS_W1VT : WS_W1KT)); const int coloff = kv ? C_VC : C_KC;
    const float* b1f = (const float*)(ws + WS_B1F) + kv * 256;
    const int w = F.wave, n = F.lane & 15, q = F.lane >> 4;
    LAS bf16_t* HID = (LAS bf16_t*)F.lds;
    size_t base[2];
#pragma unroll
    for (int rt = 0; rt < 2; ++rt) { const int R = 32 * mb + 16 * rt + n, bg = R >> 8; int c = R & 255; if (c > 254) c = 254; base[rt] = ((size_t)(bg >> 1) * SEQ + 16 * c) * LDP + coloff + (bg & 1) * 64; }
    f32x4 acc[2][2];
#pragma unroll
    for (int rt = 0; rt < 2; ++rt)
#pragma unroll
        for (int ct = 0; ct < 2; ++ct) acc[rt][ct] = (f32x4){0.f, 0.f, 0.f, 0.f};
    __syncthreads();
#pragma unroll 1
    for (int s8 = 0; s8 < 64; s8 += 8) {
        bf16x8 a[8][2], bb[8][2];
#pragma unroll
        for (int u = 0; u < 8; ++u) { const int s = s8 + u, ltok = s >> 1, dd = 32 * (s & 1) + 8 * q;
#pragma unroll
            for (int rt = 0; rt < 2; ++rt) a[u][rt] = *(const bf16x8*)(proj + base[rt] + (size_t)ltok * LDP + dd);
#pragma unroll
            for (int ct = 0; ct < 2; ++ct) bb[u][ct] = *(const bf16x8*)(W1T + ((size_t)(s * 16 + 2 * w + ct) * 64 + F.lane) * 8); }
        __builtin_amdgcn_sched_barrier(0);
#pragma unroll
        for (int u = 0; u < 8; ++u)
#pragma unroll
            for (int rt = 0; rt < 2; ++rt)
#pragma unroll
                for (int ct = 0; ct < 2; ++ct) acc[rt][ct] = __builtin_amdgcn_mfma_f32_16x16x32_bf16(bb[u][ct], a[u][rt], acc[rt][ct], 0, 0, 0);
    }
#pragma unroll
    for (int rt = 0; rt < 2; ++rt)
#pragma unroll
        for (int ct = 0; ct < 2; ++ct) { const int col = 32 * w + 16 * ct + 4 * q; const f32x4 bv = *(const f32x4*)(b1f + col); const f32x4 v = acc[rt][ct] + bv;
            v2u o; o.x = cvt_pk_bf16(fgelu_safe(v[0]), fgelu_safe(v[1])); o.y = cvt_pk_bf16(fgelu_safe(v[2]), fgelu_safe(v[3]));
            *(LAS v2u*)(HID + (16 * rt + n) * 264 + col) = o; }
    __syncthreads();
    { const int rt = w & 1, ct = w >> 1; f32x4 o = (f32x4){0.f, 0.f, 0.f, 0.f};
      const bf16_t* w2f = (const bf16_t*)(ws + WS_W2T) + (size_t)kv * 16384;
#pragma unroll
      for (int s = 0; s < 8; ++s) { const bf16x8 a = *(const LAS bf16x8*)(HID + (16 * rt + n) * 264 + 32 * s + 8 * q); const bf16x8 bw = *(const bf16x8*)(w2f + ((size_t)(s * 4 + ct) * 64 + F.lane) * 8);
          o = __builtin_amdgcn_mfma_f32_16x16x32_bf16(bw, a, o, 0, 0, 0); }
      const int R = 32 * mb + 16 * rt + n, bg = R >> 8, c = R & 255, d0 = 16 * ct + 4 * q;
      if (c == 255) o = (f32x4){0.f, 0.f, 0.f, 0.f};
      if (kv == 0) { v2u ov; ov.x = cvt_pk_bf16(o[0], o[1]); ov.y = cvt_pk_bf16(o[2], o[3]); *(v2u*)((bf16_t*)(ws + WS_KCMP) + ((size_t)bg * 256 + c) * 64 + d0) = ov; }
      else { bf16_t* vt = (bf16_t*)(ws + WS_VCMPT) + (size_t)bg * 64 * 256 + c;
#pragma unroll
          for (int r = 0; r < 4; ++r) vt[(size_t)(d0 + r) * 256] = f2bf(o[r]); } }
    __syncthreads();
}

__device__ __forceinline__ void kv_prep_unit(Frame& F, int unit) {
    unsigned char* ws = F.ws; const bf16_t* proj = (const bf16_t*)(ws + WS_PROJ); const float* cs = (const float*)(ws + WS_CS); const float* sn = (const float*)(ws + WS_SN);
    const int b = unit >> 6, tile = unit & 63; const size_t tok0 = (size_t)b * SEQ + 64 * tile;
#pragma unroll
    for (int it = 0; it < 2; ++it) { const int id = F.tid + 512 * it; const int c = id & 3, g = (id >> 2) & 1, wh = (id >> 3) & 1, tk = id >> 4; const int pos = 64 * tile + tk;
        const bf16_t* src = proj + (tok0 + tk) * LDP + (wh ? C_KW : C_KS) + g * 64 + 8 * c; const v4u lo = *(const v4u*)src, hi = *(const v4u*)(src + 32);
        const f32x4 c0 = *(const f32x4*)(cs + pos * 32 + 8 * c), c1 = *(const f32x4*)(cs + pos * 32 + 8 * c + 4), s0 = *(const f32x4*)(sn + pos * 32 + 8 * c), s1 = *(const f32x4*)(sn + pos * 32 + 8 * c + 4);
        float a[8], bb[8], co[8], si[8];
        const unsigned lw[4] = {lo.x, lo.y, lo.z, lo.w}, hw[4] = {hi.x, hi.y, hi.z, hi.w};
#pragma unroll
        for (int k = 0; k < 4; ++k) { a[2 * k] = bf2f((bf16_t)(lw[k] & 0xffff)); a[2 * k + 1] = bf2f((bf16_t)(lw[k] >> 16)); bb[2 * k] = bf2f((bf16_t)(hw[k] & 0xffff)); bb[2 * k + 1] = bf2f((bf16_t)(hw[k] >> 16)); co[k] = c0[k]; co[4 + k] = c1[k]; si[k] = s0[k]; si[4 + k] = s1[k]; }
        unsigned olp[4], ohp[4];
#pragma unroll
        for (int k = 0; k < 4; ++k) { olp[k] = pk2(a[2 * k] * co[2 * k] - bb[2 * k] * si[2 * k], a[2 * k + 1] * co[2 * k + 1] - bb[2 * k + 1] * si[2 * k + 1]);
            ohp[k] = pk2(bb[2 * k] * co[2 * k] + a[2 * k] * si[2 * k], bb[2 * k + 1] * co[2 * k + 1] + a[2 * k + 1] * si[2 * k + 1]); }
        bf16_t* dst = (bf16_t*)(ws + (wh ? WS_KWR : WS_KSR)) + (((size_t)(b * 2 + g) * SEQ) + pos) * 64 + 8 * c; *(v4u*)dst = (v4u){olp[0], olp[1], olp[2], olp[3]}; *(v4u*)(dst + 32) = (v4u){ohp[0], ohp[1], ohp[2], ohp[3]}; }
    LAS bf16_t* TL = (LAS bf16_t*)F.lds;
    v4u vin[4];
#pragma unroll
    for (int m = 0; m < 4; ++m) { const int wh = m >> 1, g = m & 1, tk = F.tid >> 3, c = F.tid & 7; vin[m] = *(const v4u*)(proj + (tok0 + tk) * LDP + (wh ? C_VW : C_VS) + g * 64 + 8 * c); }
#pragma unroll
    for (int m = 0; m < 4; ++m) { const int wh = m >> 1, g = m & 1;
        __syncthreads();
        { const int tk = F.tid >> 3, c = F.tid & 7; *(LAS v4u*)(TL + tk * 72 + 8 * c) = vin[m]; }
        __syncthreads();
        { const int d = F.tid >> 3, sc = F.tid & 7; unsigned short e[8];
#pragma unroll
          for (int i = 0; i < 8; ++i) e[i] = TL[(8 * sc + i) * 72 + d];
          v4u o; o.x = e[0] | ((unsigned)e[1] << 16); o.y = e[2] | ((unsigned)e[3] << 16); o.z = e[4] | ((unsigned)e[5] << 16); o.w = e[6] | ((unsigned)e[7] << 16);
          *(v4u*)((bf16_t*)(ws + (wh ? WS_VWT : WS_VST)) + ((size_t)(b * 2 + g) * 64 + d) * SEQ + 64 * tile + 8 * sc) = o; } }
    __syncthreads();
}

constexpr int ATT_VB = 32768, ATT_PSL = 65536, ATT_OUTA = 65536, ATT_SELM = LDSCTL_OFF + 512, ATT_UNI = ATT_SELM + 512, ATT_TL = ATT_UNI + 16, ATT_NT = ATT_TL + 80;
constexpr float ATT_QS = 0.125f * 1.4426950408889634f;
#ifndef ATT_MASKOFF
#define ATT_MASKOFF 200.0f
#endif
__device__ __forceinline__ int att_swz(int row, int c) { return row * 128 + ((c ^ ((row >> 1) & 7)) << 4); }
struct TileSrc { const bf16_t* K; int kpitch; const bf16_t* V; int vpitch; };
__device__ __forceinline__ void att_load(const TileSrc& s, int tid, v4u& kr, v4u& vr) { const int row = tid >> 3, c = tid & 7; kr = *(const v4u*)(s.K + (size_t)row * s.kpitch + 8 * c); vr = *(const v4u*)(s.V + (size_t)row * s.vpitch + 8 * c); }
__device__ __forceinline__ void att_store(LAS unsigned char* lds, int buf, int tid, const v4u& kr, const v4u& vr) {
    const int row = tid >> 3, c = tid & 7;
    *(LAS v4u*)(lds + buf * 8192 + att_swz(row, c)) = kr;
    const int s16 = c >> 1, half = c & 1;
    *(LAS v2u*)(lds + ATT_VB + buf * 8192 + att_swz(row, 2 * s16) + half * 8) = (v2u){vr.x, vr.y};
    *(LAS v2u*)(lds + ATT_VB + buf * 8192 + att_swz(row, 2 * s16 + 1) + half * 8) = (v2u){vr.z, vr.w};
}
__device__ __forceinline__ void att_qk(const LAS unsigned char* kb, const bf16x8 (&qf)[4], f32x16 (&s)[2], int i, int hh, const f32x16& ini0, const f32x16& ini1) {
    bf16x8 kf[2][4];
#pragma unroll
    for (int kt = 0; kt < 2; ++kt)
#pragma unroll
        for (int st = 0; st < 4; ++st) kf[kt][st] = *(const LAS bf16x8*)(kb + att_swz(32 * kt + i, 2 * st + hh));
    __builtin_amdgcn_s_setprio(1);
#pragma unroll
    for (int st = 0; st < 4; ++st)
#pragma unroll
        for (int kt = 0; kt < 2; ++kt) s[kt] = __builtin_amdgcn_mfma_f32_32x32x16_bf16(kf[kt][st], qf[st], st == 0 ? (kt ? ini1 : ini0) : s[kt], 0, 0, 0);
    __builtin_amdgcn_s_setprio(0);
}
__device__ __forceinline__ void att_vload(const LAS unsigned char* vb, bf16x8 (&vf)[4][2], int i, int hh) {
#pragma unroll
    for (int ks = 0; ks < 4; ++ks)
#pragma unroll
        for (int dt = 0; dt < 2; ++dt) vf[ks][dt] = *(const LAS bf16x8*)(vb + att_swz(32 * dt + i, 2 * ks + hh));
}
__device__ __forceinline__ void att_pv(const bf16x8 (&vf)[4][2], const f32x16 (&p)[2], f32x16 (&o)[2]) {
    __builtin_amdgcn_s_setprio(1);
#pragma unroll
    for (int kt = 0; kt < 2; ++kt)
#pragma unroll
        for (int s = 0; s < 2; ++s) { const v4u pb = (v4u){cvt_pk_bf16(p[kt][8 * s], p[kt][8 * s + 1]), cvt_pk_bf16(p[kt][8 * s + 2], p[kt][8 * s + 3]), cvt_pk_bf16(p[kt][8 * s + 4], p[kt][8 * s + 5]), cvt_pk_bf16(p[kt][8 * s + 6], p[kt][8 * s + 7])};
            const bf16x8 bf = __builtin_bit_cast(bf16x8, pb);
#pragma unroll
            for (int dt = 0; dt < 2; ++dt) o[dt] = __builtin_amdgcn_mfma_f32_32x32x16_bf16(vf[2 * kt + s][dt], bf, o[dt], 0, 0, 0); }
    __builtin_amdgcn_s_setprio(0);
}
__device__ __forceinline__ void att_ini(f32x16 (&ini)[2], bool uniform, float base, int lo, int hi, int hh, float masked = -1e30f) {
    if (uniform) {
#pragma unroll
        for (int r = 0; r < 16; ++r) ini[0][r] = base;
        ini[1] = ini[0];
    } else {
        const unsigned span = (unsigned)(hi - lo);
#pragma unroll
        for (int kt = 0; kt < 2; ++kt)
#pragma unroll
            for (int r = 0; r < 16; ++r) { const int kk = 32 * kt + (r & 3) + 8 * (r >> 2) + 4 * hh; ini[kt][r] = ((unsigned)(kk - lo) <= span && hi >= lo) ? base : masked; }
    }
}
#define ATT_KEY(kt, r, hh) (32 * (kt) + ((r) & 3) + 8 * ((r) >> 2) + 4 * (hh))

__device__ __forceinline__ void att_unit(Frame& F, int unit) {
    unsigned char* ws = F.ws; const bf16_t* proj = (const bf16_t*)(ws + WS_PROJ); bf16_t* mix = (bf16_t*)(ws + WS_MIX);
    const int qb = unit & 63, bg = unit >> 6, b = bg >> 1, g = bg & 1;
    const int w = F.wave, i = F.lane & 31, hh = F.lane >> 5, head = i >> 3, tloc = i & 7, tt = 8 * w + tloc; const int pos = 64 * qb + tt; const size_t tok = (size_t)b * SEQ + pos;
    LAS unsigned char* lds = F.lds; LAS float* PSL = (LAS float*)(lds + ATT_PSL); LAS unsigned* SELM = (LAS unsigned*)(lds + ATT_SELM); LAS unsigned* UNI = (LAS unsigned*)(lds + ATT_UNI);
    LAS unsigned char* TL = lds + ATT_TL; LAS int* NTL = (LAS int*)(lds + ATT_NT);
    const bf16_t* kcmp = (const bf16_t*)(ws + WS_KCMP) + (size_t)bg * 256 * 64; const bf16_t* vcmpt = (const bf16_t*)(ws + WS_VCMPT) + (size_t)bg * 64 * 256;
    const bf16_t* ksr = (const bf16_t*)(ws + WS_KSR) + (size_t)bg * SEQ * 64; const bf16_t* vst = (const bf16_t*)(ws + WS_VST) + (size_t)bg * 64 * SEQ;
    const bf16_t* kwr = (const bf16_t*)(ws + WS_KWR) + (size_t)bg * SEQ * 64; const bf16_t* vwt = (const bf16_t*)(ws + WS_VWT) + (size_t)bg * 64 * SEQ;
    __syncthreads();
    for (int k = F.tid; k < 64 * 64; k += NTHR) PSL[k] = 0.f;
    if (F.tid < 2) UNI[F.tid] = 0u;
    bf16x8 qf[4];
    const bf16_t* qp = proj + tok * LDP + C_NQ + (4 * g + head) * 64 + 8 * hh;
    { float qraw[4][8];
#pragma unroll
      for (int st = 0; st < 4; ++st) { const v4u v = *(const v4u*)(qp + 16 * st); const unsigned vw[4] = {v.x, v.y, v.z, v.w};
#pragma unroll
          for (int k = 0; k < 4; ++k) { qraw[st][2 * k] = bf2f((bf16_t)(vw[k] & 0xffff)); qraw[st][2 * k + 1] = bf2f((bf16_t)(vw[k] >> 16)); } }
#pragma unroll
      for (int st = 0; st < 4; ++st) { const v4u o = (v4u){cvt_pk_bf16(qraw[st][0] * ATT_QS, qraw[st][1] * ATT_QS), cvt_pk_bf16(qraw[st][2] * ATT_QS, qraw[st][3] * ATT_QS), cvt_pk_bf16(qraw[st][4] * ATT_QS, qraw[st][5] * ATT_QS), cvt_pk_bf16(qraw[st][6] * ATT_QS, qraw[st][7] * ATT_QS)};
          qf[st] = __builtin_bit_cast(bf16x8, o); } }
    LAS float* OUTA = (LAS float*)(lds + ATT_OUTA) + (size_t)w * 32 * 64 + F.lane;
    const float* gl = nullptr; (void)gl;
    const float gate0 = fsigmoid(bf2f(proj[tok * LDP + C_NG + (4 * g + head) * 3 + 0])), gate1 = fsigmoid(bf2f(proj[tok * LDP + C_NG + (4 * g + head) * 3 + 1])), gate2 = fsigmoid(bf2f(proj[tok * LDP + C_NG + (4 * g + head) * 3 + 2]));
    v4u kr, vr; f32x16 s[2]; f32x16 ocmp[2];
#ifndef PROBE_ATT
#define PROBE_ATT 0
#endif
    for (int rep1_ = 0; rep1_ < (PROBE_ATT == 1 ? 2 : 1); ++rep1_) {
    const int ncu = (4 * qb + 3) < 255 ? (4 * qb + 3) : 255, ntile = (ncu + 63) >> 6;
    const int ncv = pos >= 31 ? ((pos - 31) >> 4) + 1 : 0;
    const int ncv_min = qb >= 1 ? 4 * qb - 1 : 0;
    float m = -1e30f, l = 0.f;
    {
        int cur = 0; { TileSrc ts{kcmp, 64, vcmpt, 256}; att_load(ts, F.tid, kr, vr); att_store(lds, 0, F.tid, kr, vr); }
        __syncthreads();
        for (int T_ = 0; T_ < ntile; ++T_) {
            const bool more = T_ + 1 < ntile;
            if (more) { TileSrc ts{kcmp + (size_t)(T_ + 1) * 64 * 64, 64, vcmpt + (T_ + 1) * 64, 256}; att_load(ts, F.tid, kr, vr); }
            { f32x16 ini[2]; att_ini(ini, 64 * T_ + 64 <= ncv_min, 0.f, 0, ncv - 1 - 64 * T_, hh, -ATT_MASKOFF); att_qk(lds + cur * 8192, qf, s, i, hh, ini[0], ini[1]); }
            float tm = -1e30f;
#pragma unroll
            for (int kt = 0; kt < 2; ++kt)
#pragma unroll
                for (int r = 0; r < 16; ++r) tm = fmaxf(tm, s[kt][r]);
            tm = fmaxf(tm, __shfl_xor(tm, 32));
            const float mn = fmaxf(m, tm); l *= fexp2(m - mn);
#pragma unroll
            for (int kt = 0; kt < 2; ++kt)
#pragma unroll
                for (int r = 0; r < 16; ++r) l += __builtin_amdgcn_exp2f(s[kt][r] - mn);
            m = mn;
            if (more) att_store(lds, cur ^ 1, F.tid, kr, vr);
            __syncthreads(); cur ^= 1;
        }
        l += __shfl_xor(l, 32);
    }
    {
        const float rl = (ncv > 0 && l > 0.f) ? 1.0f / l : 0.f;
        f32x16 o[2];
#pragma unroll
        for (int k = 0; k < 16; ++k) { o[0][k] = 0.f; o[1][k] = 0.f; }
        float carry = 0.f;
        int cur = 0; { TileSrc ts{kcmp, 64, vcmpt, 256}; att_load(ts, F.tid, kr, vr); att_store(lds, 0, F.tid, kr, vr); }
        __syncthreads();
        for (int T_ = 0; T_ < ntile; ++T_) {
            const bool more = T_ + 1 < ntile;
            if (more) { TileSrc ts{kcmp + (size_t)(T_ + 1) * 64 * 64, 64, vcmpt + (T_ + 1) * 64, 256}; att_load(ts, F.tid, kr, vr); }
            bf16x8 vf[4][2];
            { f32x16 ini[2]; att_ini(ini, 64 * T_ + 64 <= ncv_min, -m, 0, ncv - 1 - 64 * T_, hh, -m - ATT_MASKOFF); att_qk(lds + cur * 8192, qf, s, i, hh, ini[0], ini[1]); }
            att_vload(lds + ATT_VB + cur * 8192, vf, i, hh);
#pragma unroll
            for (int kt = 0; kt < 2; ++kt)
#pragma unroll
                for (int r = 0; r < 16; ++r) s[kt][r] = __builtin_amdgcn_exp2f(s[kt][r]) * rl;
            att_pv(vf, s, o);
            float ps[8];
#pragma unroll
            for (int kt = 0; kt < 2; ++kt)
#pragma unroll
                for (int gi = 0; gi < 4; ++gi) ps[4 * kt + gi] = (s[kt][4 * gi] + s[kt][4 * gi + 1]) + (s[kt][4 * gi + 2] + 0.5f * s[kt][4 * gi + 3]);
            float nc = 0.f;
#pragma unroll
            for (int sl = 0; sl < 8; ++sl) { const float x = 0.5f * s[sl >> 2][4 * (sl & 3) + 3]; const float y = __shfl_xor(x, 32);
                if (hh == 1) ps[sl] += y; else { if (sl < 7) ps[sl + 1] += y; else nc = y; } }
            if (hh == 0) { ps[0] += carry; carry = nc; }
#pragma unroll
            for (int sl = 0; sl < 8; ++sl) { float v = ps[sl]; v += __shfl_xor(v, 8); v += __shfl_xor(v, 16); ps[sl] = v; }
            if (head == 0) {
#pragma unroll
                for (int sl = 0; sl < 8; ++sl) PSL[tt * 64 + 16 * T_ + 2 * sl + hh] = ps[sl]; }
            if (more) att_store(lds, cur ^ 1, F.tid, kr, vr);
            __syncthreads(); cur ^= 1;
        }
#pragma unroll
        for (int dt = 0; dt < 2; ++dt)
#pragma unroll
            for (int k = 0; k < 16; ++k) ocmp[dt][k] = gate0 * o[dt][k];
    }
    __syncthreads();
#pragma unroll 1
    for (int tl = 0; tl < 8; ++tl) {
        const int t = 8 * w + tl, j = F.lane; const bool fj = (j == 0) || (j == qb) || (j == qb - 1);
        const unsigned key = fj ? 0xFFFFFFFFu : (j <= qb ? __float_as_uint(PSL[t * 64 + j]) + 1u : 0u);
        unsigned thr = 0u;
#pragma unroll 1
        for (int bit = 31; bit >= 0; --bit) { const unsigned cand = thr | (1u << bit); if (__popcll(__ballot(key >= cand)) >= NSEL) thr = cand; }
        const unsigned long long gt = __ballot(key > thr), eq = __ballot(key == thr); const int need = NSEL - __popcll(gt);
        const int below = __popcll(eq & ((1ull << j) - 1ull));
        const bool sel = (key > 0u) && ((key > thr) || (key == thr && below < need));
        const unsigned long long msk = __ballot(sel);
        if (F.lane == 0) { const unsigned lo = (unsigned)msk, hi = (unsigned)(msk >> 32); SELM[2 * t] = lo; SELM[2 * t + 1] = hi; atomicOr((unsigned*)&UNI[0], lo); atomicOr((unsigned*)&UNI[1], hi); }
    }
    __syncthreads();
    }
    const unsigned sel0 = SELM[2 * tt], sel1 = SELM[2 * tt + 1];
#pragma unroll
    for (int dt = 0; dt < 2; ++dt)
#pragma unroll
        for (int k = 0; k < 16; ++k) OUTA[(dt * 16 + k) * 64] = ocmp[dt][k];
    { const float* csp = (const float*)(ws + WS_CS) + pos * 32 + 8 * hh; const float* snp = (const float*)(ws + WS_SN) + pos * 32 + 8 * hh;
      float qraw[4][8];
#pragma unroll
      for (int st = 0; st < 4; ++st) { const v4u v = *(const v4u*)(qp + 16 * st); const unsigned vw[4] = {v.x, v.y, v.z, v.w};
#pragma unroll
          for (int k = 0; k < 4; ++k) { qraw[st][2 * k] = bf2f((bf16_t)(vw[k] & 0xffff)); qraw[st][2 * k + 1] = bf2f((bf16_t)(vw[k] >> 16)); } }
#pragma unroll
      for (int st = 0; st < 2; ++st) { float co[8], si[8]; *(f32x4*)&co[0] = *(const f32x4*)(csp + 16 * st); *(f32x4*)&co[4] = *(const f32x4*)(csp + 16 * st + 4); *(f32x4*)&si[0] = *(const f32x4*)(snp + 16 * st); *(f32x4*)&si[4] = *(const f32x4*)(snp + 16 * st + 4);
          float rl_[8], rh_[8];
#pragma unroll
          for (int k = 0; k < 8; ++k) { rl_[k] = (qraw[st][k] * co[k] - qraw[st + 2][k] * si[k]) * ATT_QS; rh_[k] = (qraw[st + 2][k] * co[k] + qraw[st][k] * si[k]) * ATT_QS; }
          qf[st] = __builtin_bit_cast(bf16x8, (v4u){cvt_pk_bf16(rl_[0], rl_[1]), cvt_pk_bf16(rl_[2], rl_[3]), cvt_pk_bf16(rl_[4], rl_[5]), cvt_pk_bf16(rl_[6], rl_[7])});
          qf[st + 2] = __builtin_bit_cast(bf16x8, (v4u){cvt_pk_bf16(rh_[0], rh_[1]), cvt_pk_bf16(rh_[2], rh_[3]), cvt_pk_bf16(rh_[4], rh_[5]), cvt_pk_bf16(rh_[6], rh_[7])}); } }
    for (int rep2_ = 0; rep2_ < (PROBE_ATT == 2 ? 2 : 1); ++rep2_)
#pragma unroll 1
    for (int br = 0; br < 2; ++br) {
        if (F.wave == 0) {
            const int j = F.lane; bool on;
            if (br == 0) { const unsigned u0 = UNI[0], u1 = UNI[1]; on = (j <= qb) && (j < 32 ? ((u0 >> j) & 1u) : ((u1 >> (j - 32)) & 1u)); }
            else on = (j <= qb) && (j >= qb - 8);
            const unsigned long long bm = __ballot(on);
            if (on) TL[__popcll(bm & ((1ull << j) - 1ull))] = (unsigned char)j;
            if (j == 0) NTL[0] = __popcll(bm); }
        __syncthreads();
        const int nl = NTL[0]; const bf16_t* Kg = br ? kwr : ksr; const bf16_t* Vg = br ? vwt : vst;
        float mm = 0.f, ll = 0.f; bool started = false; f32x16 o[2];
#pragma unroll
        for (int k = 0; k < 16; ++k) { o[0][k] = 0.f; o[1][k] = 0.f; }
#define ATT_BODY \
            bool lane_on; int lo_k, hi_k;     \
            if (br == 0) { lane_on = j < 32 ? ((sel0 >> j) & 1u) : ((sel1 >> (j - 32)) & 1u); lo_k = 0; hi_k = (j == qb) ? tt : 63; } \
            else { lane_on = true; lo_k = (j == qb - 8) ? tt + 1 : 0; hi_k = (j == qb) ? tt : 63; if (lo_k > hi_k) lane_on = false; } \
            const bool full = (j != qb) && (br == 0 || j != qb - 8);               \
            if (__any(lane_on)) { \
                bf16x8 vf[4][2]; \
                { f32x16 ini[2]; att_ini(ini, full, lane_on ? -mm : -mm - ATT_MASKOFF, lo_k, lane_on ? hi_k : -1, hh, -mm - ATT_MASKOFF); att_qk(lds + kslot * 8192, qf, s, i, hh, ini[0], ini[1]); } \
                att_vload(lds + ATT_VB + kslot * 8192, vf, i, hh); \
                float tm = -1e30f; \
_Pragma("unroll") \
                for (int kt = 0; kt < 2; ++kt) \
_Pragma("unroll") \
                    for (int r = 0; r < 16; ++r) tm = fmaxf(tm, s[kt][r]); \
                tm = fmaxf(tm, __shfl_xor(tm, 32)); \
                const bool first = !started && (tm > -0.5f * ATT_MASKOFF); started = started || first; \
                const bool upd = first || (tm > 8.0f); \
                if (__any(upd)) { \
                    const float delta = upd ? tm : 0.f, al = fexp2(-delta); mm += delta; ll *= al; \
_Pragma("unroll") \
                    for (int dt = 0; dt < 2; ++dt) \
_Pragma("unroll") \
                        for (int k = 0; k < 16; ++k) o[dt][k] *= al; \
_Pragma("unroll") \
                    for (int kt = 0; kt < 2; ++kt) \
_Pragma("unroll") \
                        for (int r = 0; r < 16; ++r) s[kt][r] -= delta; \
                } \
_Pragma("unroll") \
                for (int kt = 0; kt < 2; ++kt) \
_Pragma("unroll") \
                    for (int r = 0; r < 16; ++r) { const float pv_ = __builtin_amdgcn_exp2f(s[kt][r]); s[kt][r] = pv_; ll += pv_; } \
                att_pv(vf, s, o); \
            }
        v4u kr2, vr2;
        const int np = (nl + 1) >> 1;
#define ATT_LOADPAIR(p_) do { { const int ja = TL[2 * (p_)]; TileSrc ts{Kg + (size_t)ja * 64 * 64, 64, Vg + (size_t)ja * 64, SEQ}; att_load(ts, F.tid, kr, vr); } \
            if (2 * (p_) + 1 < nl) { const int jb = TL[2 * (p_) + 1]; TileSrc ts{Kg + (size_t)jb * 64 * 64, 64, Vg + (size_t)jb * 64, SEQ}; att_load(ts, F.tid, kr2, vr2); } } while (0)
#define ATT_STOREPAIR(p_, c_) do { att_store(lds, 2 * (c_), F.tid, kr, vr); if (2 * (p_) + 1 < nl) att_store(lds, 2 * (c_) + 1, F.tid, kr2, vr2); } while (0)
        ATT_LOADPAIR(0); ATT_STOREPAIR(0, 0);
        if (np > 1) ATT_LOADPAIR(1);
        __syncthreads();
        int cur = 0;
        for (int p = 0; p < np; ++p) {
            if (p + 1 < np) ATT_STOREPAIR(p + 1, cur ^ 1);
            if (p + 2 < np) ATT_LOADPAIR(p + 2);
#pragma unroll 1
            for (int t2 = 0; t2 < 2; ++t2) { const int it = 2 * p + t2; if (it < nl) { const int j = TL[it]; const int kslot = 2 * cur + t2;
                ATT_BODY
            } }
            __syncthreads(); cur ^= 1;
        }
#undef ATT_LOADPAIR
#undef ATT_STOREPAIR
#undef ATT_BODY
        ll += __shfl_xor(ll, 32);
        const float sc_ = rep2_ ? 0.f : (br ? gate2 : gate1) / ll;
#pragma unroll
        for (int dt = 0; dt < 2; ++dt)
#pragma unroll
            for (int k = 0; k < 16; ++k) OUTA[(dt * 16 + k) * 64] += sc_ * o[dt][k];
    }
    { bf16_t* op = mix + tok * D + 512 + (4 * g + head) * 64 + 4 * hh;
#pragma unroll
      for (int dt = 0; dt < 2; ++dt)
#pragma unroll
          for (int gi = 0; gi < 4; ++gi) { const float a0 = OUTA[(dt * 16 + 4 * gi) * 64], a1 = OUTA[(dt * 16 + 4 * gi + 1) * 64], a2 = OUTA[(dt * 16 + 4 * gi + 2) * 64], a3 = OUTA[(dt * 16 + 4 * gi + 3) * 64];
              v2u ov; ov.x = cvt_pk_bf16(a0, a1); ov.y = cvt_pk_bf16(a2, a3); *(v2u*)(op + 32 * dt + 8 * gi) = ov; } }
    __syncthreads();
}

__global__ void __launch_bounds__(NTHR, 2) mk_fwd(Args args) {
    extern __shared__ __attribute__((aligned(16))) unsigned char lds_raw[];
    Frame F;
    F.lds = (LAS unsigned char*)lds_raw; F.MISC = (volatile LAS unsigned*)(F.lds + MISC_OFF);
    F.tid = threadIdx.x; F.lane = F.tid & 63; F.wave = __builtin_amdgcn_readfirstlane(F.tid >> 6);
    F.G = gridDim.x; { const int bx = blockIdx.x; F.vcu = (F.G % 8 == 0) ? (bx % 8) * (F.G / 8) + bx / 8 : bx; }
    F.ws = args.ws; F.ctl = (unsigned*)(args.ws + WS_CTL); F.out = args.out;
#pragma unroll
    for (int i = 0; i < 25; ++i) F.in[i] = args.in[i];
    for (int u = F.tid; u < (LDS_BYTES - LDSCTL_OFF) / 4; u += NTHR) ((LAS unsigned*)(F.lds + LDSCTL_OFF))[u] = 0u;
    __syncthreads();
    const int lo = args.ph_lo, hi = args.ph_hi;
    XcdBarrier bar = xcd_barrier_post(F.ctl + CW_BAR + lo * XCD_BAR_WORDS, F.MISC + 8);
#define IN_PH(k) (lo <= (k) && (k) < hi)
#ifndef PROBE_TIME
#define PROBE_TIME -1
#endif
    volatile LAS unsigned long long* TS = (volatile LAS unsigned long long*)(F.lds + LDSCTL_OFF + 8192);
    if (PROBE_TIME >= 0 && blockIdx.x == 0 && F.tid == 0) TS[0] = __builtin_amdgcn_s_memrealtime();
#define SEAM(k) do { if (IN_PH(k) && IN_PH((k) + 1)) xcd_barrier(bar); if (PROBE_TIME >= 0 && blockIdx.x == 0 && F.tid == 0) TS[(k) + 1] = __builtin_amdgcn_s_memrealtime(); } while (0)
#define RUNP(k, BODY) do { if (IN_PH(k)) { BODY; if (PROBE_REP == (k)) { xcd_barrier(bar); BODY; } } } while (0)
#define BODY0 p0_prologue(F)
#define BODY1 p1a_norm(F)
#define BODY2 { gm::DenseSched S{(const char*)(F.ws + WS_XN), (const char*)(F.ws + WS_WINT), T / 256, LDP / 256, F.G, (int)blockIdx.x, 2048u, 1024u}; \
        gm::EpiBf16 E{(bf16_t*)(F.ws + WS_PROJ), LDP}; gm::gemm_phase<gm::EpiBf16, gm::DenseSched>(F.lds, S, E, 1024, 128u); }
#define BODY3 { if (F.G == 256) { if (F.vcu < 128) { cmp_unit(F, F.vcu); if (PROBE_P3 == 1) cmp_unit(F, F.vcu); } else { const int u0 = 2 * (F.vcu - 128); hg_passA(F, u0); hg_passA(F, u0 + 1); if (PROBE_P3 == 2) { hg_passA(F, u0); hg_passA(F, u0 + 1); } kv_prep_unit(F, u0); kv_prep_unit(F, u0 + 1); if (PROBE_P3 == 3) { kv_prep_unit(F, u0); kv_prep_unit(F, u0 + 1); } } } \
        else { for (int u = F.vcu; u < 128; u += F.G) cmp_unit(F, u); for (int u = F.vcu; u < 256; u += F.G) hg_passA(F, u); for (int u = F.vcu; u < 256; u += F.G) kv_prep_unit(F, u); } }
#define BODY4 { for (int u = F.vcu; u < 256; u += F.G) hg_passC(F, u); }
#define BODY5 { for (int c = F.vcu; c < 256; c += F.G) { const int bg = c >> 5, k = c & 31; att_unit(F, bg * 64 + 63 - k); att_unit(F, bg * 64 + k); } }
#define BODY6 { gm::DenseSched S{(const char*)(F.ws + WS_MIX), (const char*)(F.ws + WS_WOUTT), T / 256, 4, F.G, (int)blockIdx.x, 2048u, 1024u}; \
        gm::EpiRes E{F.in[IN_X], (const float*)(F.ws + WS_MOD), 2, (float*)(F.ws + WS_X2), (float*)(F.ws + WS_SSQ)}; gm::gemm_phase<gm::EpiRes, gm::DenseSched>(F.lds, S, E, 1024, 128u); }
#define BODY7 p5_router(F)
#define BODY8 { const MoeTabs Tb = moe_tabs_build(F); \
        GateUpSched S{Tb, (const char*)(F.ws + WS_H2), (const char*)(F.ws + WS_WGUT), (const char*)(F.ws + WS_WSGUT), (const int*)(F.ws + WS_ROWL), F.G, (int)blockIdx.x}; \
        EpiSwiglu E{F.ws + WS_ACT, F.ws + WS_ACTS}; gm::gemm_phase<EpiSwiglu, GateUpSched, true>(F.lds, S, E, 512, 128u); }
#define BODY9 { const MoeTabs Tb = moe_tabs_build(F); DownSched S{Tb, (const char*)(F.ws + WS_ACT), (const char*)(F.ws + WS_ACTS), (const char*)(F.ws + WS_WDNT), (const char*)(F.ws + WS_WSDNT), F.G, (int)blockIdx.x}; \
        EpiDown E{(unsigned char*)(F.ws + WS_Y), (bf16_t*)(F.ws + WS_YS)}; gm::gemm_phase<EpiDown, DownSched, true>(F.lds, S, E, 128, 128u); }
#define BODY10 p8_final(F)
    RUNP(0, BODY0); SEAM(0);
    RUNP(1, BODY1); SEAM(1);
    RUNP(2, BODY2); SEAM(2);
    RUNP(3, BODY3); SEAM(3);
    RUNP(4, BODY4); SEAM(4);
    RUNP(5, BODY5); SEAM(5);
    RUNP(6, BODY6); SEAM(6);
    RUNP(7, BODY7); SEAM(7);
    RUNP(8, BODY8); SEAM(8);
    RUNP(9, BODY9); SEAM(9);
    RUNP(10, BODY10);
    if (PROBE_TIME >= 0 && blockIdx.x == 0) { __syncthreads(); if (F.tid == 0) { const unsigned long long te = __builtin_amdgcn_s_memrealtime(); TS[11] = te;
        const unsigned long long dt = TS[PROBE_TIME + 1] - TS[PROBE_TIME]; while (__builtin_amdgcn_s_memrealtime() - te < (PROBE_TIME >= 20 ? 16ull : 4ull) * dt) __builtin_amdgcn_s_sleep(8); } }
#undef IN_PH
#undef SEAM
#undef RUNP
}
#ifndef ONE_LAUNCH
#define ONE_LAUNCH 1
#endif
#ifndef OPT_S1
#define OPT_S1 1
#endif
#ifndef OPT_S2B
#define OPT_S2B 1
#endif
#ifndef OPT_S2A
#define OPT_S2A 1
#endif
#ifndef OPT_S5
#define OPT_S5 1
#endif
#ifndef OPT_S3
#define OPT_S3 1
#endif
#ifndef OPT_S4
#define OPT_S4 1
#endif
static void launch_mk(const nv::In& I, void* const* d_in, float* out, unsigned char* ws, int lo, int hi, int grid, hipStream_t stream) {
    Args a{}; for (int i = 0; i < 25; ++i) a.in[i] = (const float*)d_in[i];
    a.out = out; a.ws = ws; a.ph_lo = lo; a.ph_hi = hi; a.rep = 0; a.pad = 0;
    hipLaunchKernelGGL(mk_fwd, dim3(grid), dim3(NTHR), LDS_BYTES, stream, a);
}
extern "C" void kernel_launch(void* const* d_in, const int* in_sizes, int n_in, void* d_out, int out_size, void* d_ws, size_t ws_size, hipStream_t stream) {
    static int grid = 0;
    if (grid == 0) {
        if (ws_size < WS_END || n_in != 25) { fprintf(stderr, "kernel_launch: ws %zu < %zu or n_in %d != 25\n", ws_size, (size_t)WS_END, n_in); grid = -1; return; }
        int dev = 0, cus = 0;
        if (hipGetDevice(&dev) != hipSuccess || hipDeviceGetAttribute(&cus, hipDeviceAttributeMultiprocessorCount, dev) != hipSuccess) { grid = -1; return; }
        if (hipFuncSetAttribute((const void*)mk_fwd, hipFuncAttributeMaxDynamicSharedMemorySize, LDS_BYTES) != hipSuccess) { fprintf(stderr, "kernel_launch: hipFuncSetAttribute failed\n"); grid = -1; return; }
        int per_cu = 0; (void)hipOccupancyMaxActiveBlocksPerMultiprocessor(&per_cu, (const void*)mk_fwd, NTHR, LDS_BYTES); (void)hipGetLastError();
        if (per_cu < 1) fprintf(stderr, "kernel_launch: occupancy query says %d blocks/CU\n", per_cu);
        grid = cus;
    }
    if (grid < 0) return;
    unsigned char* ws = (unsigned char*)d_ws; float* out = (float*)d_out;
    nv::In I; I.set(d_in);
    (void)hipMemsetAsync(ws + WS_CTL, 0, CTL_ZERO_BYTES, stream);
#if ONE_LAUNCH
    launch_mk(I, d_in, out, ws, 0, 11, grid, stream);
#else
#if OPT_S1
    launch_mk(I, d_in, out, ws, 0, 3, grid, stream);
#else
    nv::s1_naive(I, ws, stream);
#endif
#if OPT_S2A
    launch_mk(I, d_in, out, ws, 3, OPT_S2B ? 6 : 5, grid, stream);
#endif
    if (!OPT_S2A || !OPT_S2B) nv::s2_naive(I, ws, stream, !OPT_S2A, !OPT_S2B);
#if OPT_S3
    launch_mk(I, d_in, out, ws, 6, OPT_S4 ? 8 : 7, grid, stream);
#else
    nv::s3_naive(I, ws, stream);
#endif
#if OPT_S4
    if (!OPT_S3) launch_mk(I, d_in, out, ws, 7, 8, grid, stream);
#else
    nv::s4_naive(I, ws, stream);
#endif
#if OPT_S5
    launch_mk(I, d_in, out, ws, 8, 11, grid, stream);
#else
    nv::s5_naive(I, ws, out, stream);
#endif
#endif
}
#endif
```

```cpp
#ifndef CPU_EMU
#include <hip/hip_runtime.h>
#endif
#include <cstdio>
#include <cstdint>
#include <cmath>

#ifndef BATCH
#define BATCH 4
#endif
#ifndef SEQ
#define SEQ 4096
#endif

#ifdef CPU_EMU
struct dim3e { unsigned x, y, z; };
static thread_local dim3e threadIdx, blockIdx, blockDim, gridDim;
#define __global__
#define __device__
#define __host__
#define __forceinline__ inline
#define __launch_bounds__(...)
typedef int hipStream_t;
template <class F> static void cpu_launch(unsigned grid, unsigned block, F f) {
#pragma omp parallel for schedule(dynamic, 1)
    for (long b = 0; b < (long)grid; ++b) {
        blockIdx = {(unsigned)b, 0, 0}; blockDim = {block, 1, 1}; gridDim = {grid, 1, 1};
        for (unsigned t = 0; t < block; ++t) { threadIdx = {t, 0, 0}; f(); }
    }
}
static int g_launch_limit = 1 << 30, g_launch_count = 0;
#define LAUNCH(kern, grid, block, ...) do { if (g_launch_count++ < g_launch_limit) cpu_launch((unsigned)(grid), (unsigned)(block), [&]() { kern(__VA_ARGS__); }); } while (0)
#else
#define LAUNCH(kern, grid, block, ...) kern<<<dim3((unsigned)(grid)), dim3((unsigned)(block)), 0, stream>>>(__VA_ARGS__)
#endif

typedef unsigned short bf16_t;
constexpr int D = 1024, T = BATCH * SEQ, INC = 3352, LDP = 3584;
constexpr int C_HQ = 0, C_HF = 512, C_HI = 1024, C_HGT = 1536, C_NQ = 2048, C_KC = 2560, C_VC = 2688, C_KS = 2816, C_VS = 2944, C_KW = 3072, C_VW = 3200, C_NG = 3328;
constexpr int NCMP = (SEQ - 32) / 16 + 1, NSB = SEQ / 64, NSEL = NSB < 16 ? NSB : 16;
constexpr float EPS = 1e-6f;

constexpr size_t MiB = 1u << 20, KiB = 1u << 10;
constexpr size_t WS_CTL = 0, CTL_ZERO_BYTES = 1 * MiB;
constexpr size_t WS_MODP = 1 * MiB;
constexpr size_t WS_MOD = 2 * MiB + 512 * KiB;
constexpr size_t WS_B1F = WS_MOD + 128 * KiB;
constexpr size_t WS_CS = 2 * MiB + 768 * KiB, WS_SN = WS_CS + 512 * KiB;
constexpr size_t WS_WDNT = 4 * MiB;
constexpr size_t WS_WSDNT = 36 * MiB;
constexpr size_t WS_X2 = 37 * MiB;
constexpr size_t WS_ACT = 101 * MiB;
constexpr size_t WS_ACTS = 173 * MiB;
constexpr size_t WS_ROWL = 181 * MiB;
constexpr size_t WS_TOPI = 189 * MiB, WS_TOPW = WS_TOPI + 512 * KiB;
constexpr size_t WS_ERANK = 185 * MiB;
constexpr size_t WS_SSQ = 186 * MiB;
constexpr size_t WS_WGUT = 190 * MiB;
constexpr size_t WS_WSGUT = 254 * MiB;
constexpr size_t WS_WINT = 255 * MiB;
constexpr size_t WS_WOUTT = 262 * MiB;
constexpr size_t WS_W1KT = 264 * MiB, WS_W1VT = 265 * MiB;
constexpr size_t WS_W2T = 266 * MiB;
constexpr size_t WS_RW = 267 * MiB;
constexpr size_t WS_XN = 268 * MiB;
constexpr size_t WS_H2 = WS_XN;
constexpr size_t WS_PROJ = 300 * MiB;
constexpr size_t WS_KSR = 412 * MiB, WS_KWR = 416 * MiB;
constexpr size_t WS_VST = 420 * MiB, WS_VWT = 424 * MiB;
constexpr size_t WS_KCMP = 428 * MiB, WS_VCMPT = WS_KCMP + 256 * KiB;
constexpr size_t WS_U = 429 * MiB, WS_DD = 445 * MiB;
constexpr size_t WS_MIX = 446 * MiB;
constexpr size_t WS_Y = 190 * MiB;
constexpr size_t WS_YS = 478 * MiB;
constexpr size_t WS_END = 512 * MiB;
constexpr size_t NV_H = 37 * MiB, NV_RSTD = 101 * MiB;
constexpr size_t NV_F = 37 * MiB, NV_ORAW = 69 * MiB, NV_OWIN = 101 * MiB, NV_KSR = 133 * MiB, NV_KWR = 141 * MiB, NV_PS = 149 * MiB, NV_SEL = 157 * MiB,
                 NV_HID = 158 * MiB, NV_KCMP = 160 * MiB, NV_VCMP = 160 * MiB + 512 * KiB, NV_CS = 161 * MiB, NV_SN = 161 * MiB + 512 * KiB, NV_QROT = 478 * MiB;
constexpr size_t NV_H2F = 300 * MiB, NV_LG = 364 * MiB, NV_RSTD2 = 368 * MiB;
constexpr size_t NV_ACT = 300 * MiB, NV_ACTS = 101 * MiB, NV_X3 = 446 * MiB, NV_RSTD3 = 510 * MiB;

__host__ __device__ __forceinline__ float bf2f(bf16_t v) { union { unsigned u; float f; } c; c.u = (unsigned)v << 16; return c.f; }
__host__ __device__ __forceinline__ bf16_t f2bf(float f) { union { unsigned u; float f; } c; c.f = f; unsigned u = c.u; return (bf16_t)((u + 0x7fffu + ((u >> 16) & 1u)) >> 16); }

namespace nv {
__device__ __forceinline__ float sigmoidf_(float z) { return 1.0f / (1.0f + expf(-z)); }
__device__ __forceinline__ float siluf_(float z) { return z * sigmoidf_(z); }
__device__ __forceinline__ float gelu_tanh(float z) { return 0.5f * z * (1.0f + tanhf(0.7978845608028654f * (z + 0.044715f * z * z * z))); }
__device__ __forceinline__ long gtid() { return (long)blockIdx.x * blockDim.x + threadIdx.x; }
#define PJ(row, col) bf2f(proj[(size_t)(row) * LDP + (col)])

__global__ void k_mod(const float* c, const float* w_ada, const float* b_ada, float* mod) {
    long i = gtid(); if (i >= BATCH * 6144) return; int b = (int)(i / 6144), n = (int)(i % 6144);
    float acc = b_ada[n];
    for (int k = 0; k < D; ++k) acc += siluf_(c[b * D + k]) * w_ada[(size_t)k * 6144 + n];
    mod[i] = acc;
}
__global__ void k_rowrstd(const float* x, float* rstd, int rows) {
    long r = gtid(); if (r >= rows) return; float s = 0.f;
    for (int k = 0; k < D; ++k) { float v = x[(size_t)r * D + k]; s += v * v; }
    rstd[r] = 1.0f / sqrtf(s / D + EPS);
}
__global__ void k_modnorm(const float* x, const float* rstd, const float* g, const float* mod, int sh_chunk, int sc_chunk, float* hf, bf16_t* hb) {
    long i = gtid(); if (i >= (long)T * D) return; int r = (int)(i / D), k = (int)(i % D), b = r / SEQ;
    float v = x[i] * rstd[r] * g[k] * (1.0f + mod[b * 6144 + sc_chunk * D + k]) + mod[b * 6144 + sh_chunk * D + k];
    if (hf) hf[i] = v; if (hb) hb[i] = f2bf(v);
}
__global__ void k_gemm_nn_bf(const float* A, int lda, const float* Bm, int ldb, bf16_t* C, int ldc, int M, int N, int K) {
    long i = gtid(); if (i >= (long)M * N) return; int m = (int)(i / N), n = (int)(i % N);
    float acc = 0.f; const float* a = A + (size_t)m * lda;
    for (int k = 0; k < K; ++k) acc += a[k] * Bm[(size_t)k * ldb + n];
    C[(size_t)m * ldc + n] = f2bf(acc);
}
__global__ void k_gemm_nn(const float* A, int lda, const float* Bm, int ldb, float* C, int ldc, int M, int N, int K) {
    long i = gtid(); if (i >= (long)M * N) return; int m = (int)(i / N), n = (int)(i % N);
    float acc = 0.f; const float* a = A + (size_t)m * lda;
    for (int k = 0; k < K; ++k) acc += a[k] * Bm[(size_t)k * ldb + n];
    C[(size_t)m * ldc + n] = acc;
}
__global__ void k_hgf(const bf16_t* proj, const float* lbl, float* F) {
    long i = gtid(); if (i >= (long)T * 512) return; int r = (int)(i / 512), j = (int)(i % 512);
    float l0 = lbl[j], l1 = lbl[512 + j]; float mx = fmaxf(l0, l1); float e0 = expf(l0 - mx), e1 = expf(l1 - mx); float lb = e0 / (e0 + e1);
    F[i] = lb + (1.0f - lb) * sigmoidf_(PJ(r, C_HF + j));
}
__global__ void __launch_bounds__(64) k_hgrn(const bf16_t* proj, const float* F, float* Oraw) {
    long i = gtid(); if (i >= BATCH * 4 * 128) return; int e = (int)(i % 128), h = (int)((i / 128) % 4), b = (int)(i / 512);
    float S[128];
#pragma unroll
    for (int d = 0; d < 128; ++d) S[d] = 0.f;
    for (int t = 0; t < SEQ; ++t) {
        size_t row = (size_t)b * SEQ + t; const bf16_t* p = proj + row * LDP; const float* f = F + row * 512 + h * 128;
        float v = bf2f(p[C_HI + h * 128 + e]), o = 0.f;
#pragma unroll
        for (int d = 0; d < 128; ++d) { float ff = f[d]; S[d] = ff * S[d] + (1.0f - ff) * v; o += S[d] * bf2f(p[C_HQ + h * 128 + d]); }
        Oraw[row * 512 + h * 128 + e] = o * 0.08838834764831845f;
    }
}
__global__ void k_hgnorm(const float* Oraw, const bf16_t* proj, const float* ng, bf16_t* mix) {
    long i = gtid(); if (i >= (long)T * 4) return; size_t row = (size_t)(i / 4); int h = (int)(i % 4);
    const float* o = Oraw + row * 512 + h * 128; float s = 0.f;
    for (int e = 0; e < 128; ++e) s += o[e] * o[e];
    float r = 1.0f / sqrtf(s / 128 + EPS);
    for (int e = 0; e < 128; ++e) mix[row * D + h * 128 + e] = f2bf(o[e] * r * ng[h * 128 + e] * siluf_(PJ(row, C_HGT + h * 128 + e)));
}
__global__ void k_cmp_hidden(const bf16_t* proj, int coloff, const float* pe, const float* w1, const float* b1, float* hid) {
    long i = gtid(); if (i >= (long)BATCH * 2 * NCMP * 256) return; int j = (int)(i % 256); long r = i / 256; int c = (int)(r % NCMP), g = (int)((r / NCMP) % 2), b = (int)(r / (NCMP * 2));
    float acc = b1[j];
    for (int l = 0; l < 32; ++l) { const bf16_t* p = proj + ((size_t)b * SEQ + 16 * c + l) * LDP + coloff + g * 64;
        for (int d = 0; d < 64; ++d) acc += (bf2f(p[d]) + pe[l * 64 + d]) * w1[(size_t)(l * 64 + d) * 256 + j]; }
    hid[i] = gelu_tanh(acc);
}
__global__ void k_cmp_out(const float* hid, const float* w2, float* out) {
    long i = gtid(); if (i >= (long)BATCH * 2 * NCMP * 64) return; int d = (int)(i % 64); long r = i / 64;
    float acc = 0.f; for (int j = 0; j < 256; ++j) acc += hid[r * 256 + j] * w2[j * 64 + d];
    out[i] = acc;
}
__global__ void k_rope_tab(float* cs, float* sn) {
    long i = gtid(); if (i >= (long)SEQ * 32) return; int pos = (int)(i / 32), k = (int)(i % 32);
    float inv = powf(10000.0f, -(float)k / 32.0f); float ang = (float)pos * inv; cs[i] = cosf(ang); sn[i] = sinf(ang);
}
__global__ void k_rope_apply(const bf16_t* proj, int coloff, int nh, const float* cs, const float* sn, float* dst) {
    long i = gtid(); if (i >= (long)T * nh * 32) return; int k = (int)(i % 32); int h = (int)((i / 32) % nh); size_t row = (size_t)(i / (32 * nh)); int pos = (int)(row % SEQ);
    float t1 = PJ(row, coloff + h * 64 + k), t2 = PJ(row, coloff + h * 64 + k + 32), co = cs[pos * 32 + k], si = sn[pos * 32 + k];
    dst[row * (nh * 64) + h * 64 + k] = t1 * co - t2 * si; dst[row * (nh * 64) + h * 64 + k + 32] = t2 * co + t1 * si;
}
__global__ void __launch_bounds__(64) k_cmp_attn(const bf16_t* proj, const float* kcmp, const float* vcmp, float* ocmp, float* PS) {
    long i = gtid(); if (i >= (long)BATCH * 2 * SEQ) return; int s = (int)(i % SEQ), g = (int)((i / SEQ) % 2), b = (int)(i / (2 * SEQ));
    size_t row = (size_t)b * SEQ + s; float* ps = PS + (size_t)i * 64;
    for (int j = 0; j < 64; ++j) ps[j] = 0.f;
    int ncv = s >= 31 ? (s - 31) / 16 + 1 : 0; if (ncv > NCMP) ncv = NCMP;
    const float* kc = kcmp + (size_t)(b * 2 + g) * NCMP * 64; const float* vc = vcmp + (size_t)(b * 2 + g) * NCMP * 64;
    for (int hh = 0; hh < 4; ++hh) {
        int head = g * 4 + hh;
        float q[64], o[64];
#pragma unroll
        for (int d = 0; d < 64; ++d) { q[d] = PJ(row, C_NQ + head * 64 + d); o[d] = 0.f; }
        float m = -3.0e38f, l = 0.f;
        for (int c = 0; c < ncv; ++c) { float sc = 0.f;
#pragma unroll
            for (int d = 0; d < 64; ++d) sc += q[d] * kc[c * 64 + d];
            sc *= 0.125f; float mn = fmaxf(m, sc); l = l * expf(m - mn) + expf(sc - mn); m = mn; }
        for (int c = 0; c < ncv; ++c) { float sc = 0.f;
#pragma unroll
            for (int d = 0; d < 64; ++d) sc += q[d] * kc[c * 64 + d];
            sc *= 0.125f; float p = expf(sc - m) / l;
#pragma unroll
            for (int d = 0; d < 64; ++d) o[d] += p * vc[c * 64 + d];
            int c0 = 16 * c, c1 = 16 * c + 32;
            for (int j = c0 / 64; j <= (c1 - 1) / 64 && j < NSB; ++j) { int lo = c0 > 64 * j ? c0 : 64 * j, hi = c1 < 64 * j + 64 ? c1 : 64 * j + 64; if (hi > lo) ps[j] += p * (float)(hi - lo) / 32.0f; } }
#pragma unroll
        for (int d = 0; d < 64; ++d) ocmp[row * 512 + head * 64 + d] = o[d];
    }
}
__global__ void k_select(const float* PS, unsigned* SEL) {
    long i = gtid(); if (i >= (long)BATCH * 2 * SEQ) return; int s = (int)(i % SEQ); const float* ps = PS + (size_t)i * 64; int cur = s / 64;
    unsigned m0 = 0, m1 = 0;
    for (int j = 0; j < NSB; ++j) {
        bool fj = (j == 0) || (j == cur) || (j == cur - 1); float sj = fj ? 1e30f : (j <= cur ? ps[j] : -1e30f);
        int rank = 0;
        for (int k = 0; k < NSB; ++k) { bool fk = (k == 0) || (k == cur) || (k == cur - 1); float sk = fk ? 1e30f : (k <= cur ? ps[k] : -1e30f); if (sk > sj || (sk == sj && k < j)) ++rank; }
        if (rank < NSEL && sj > -1e29f) { if (j < 32) m0 |= 1u << j; else m1 |= 1u << (j - 32); }
    }
    SEL[i * 2] = m0; SEL[i * 2 + 1] = m1;
}
__global__ void __launch_bounds__(64) k_attn_naive(const float* qrot, const float* krot, const bf16_t* proj, int vcol, const unsigned* SEL, int mode, float* out) {
    long i = gtid(); if (i >= (long)BATCH * 8 * SEQ) return; int s = (int)(i % SEQ), head = (int)((i / SEQ) % 8), b = (int)(i / (8 * SEQ)); int g = head / 4;
    size_t row = (size_t)b * SEQ + s; float q[64], o[64];
#pragma unroll
    for (int d = 0; d < 64; ++d) { q[d] = qrot[row * 512 + head * 64 + d]; o[d] = 0.f; }
    float m = -3.0e38f, l = 0.f;
    unsigned m0 = 0, m1 = 0; if (mode == 0) { size_t si = ((size_t)(b * 2 + g) * SEQ + s) * 2; m0 = SEL[si]; m1 = SEL[si + 1]; }
    int k0 = mode == 0 ? 0 : (s - 511 > 0 ? s - 511 : 0);
    for (int key = k0; key <= s; ++key) {
        if (mode == 0) { int j = key / 64; bool sel = j < 32 ? ((m0 >> j) & 1u) : ((m1 >> (j - 32)) & 1u); if (!sel) { key = j * 64 + 63; continue; } }
        size_t kr = (size_t)b * SEQ + key; const float* kp = krot + kr * 128 + g * 64;
        float sc = 0.f;
#pragma unroll
        for (int d = 0; d < 64; ++d) sc += q[d] * kp[d];
        sc *= 0.125f; float mn = fmaxf(m, sc), a = expf(m - mn), p = expf(sc - mn); l = l * a + p; m = mn;
#pragma unroll
        for (int d = 0; d < 64; ++d) o[d] = o[d] * a + p * PJ(kr, vcol + g * 64 + d);
    }
#pragma unroll
    for (int d = 0; d < 64; ++d) out[row * 512 + head * 64 + d] = o[d] / l;
}
__global__ void k_nsa_combine(const bf16_t* proj, const float* ocmp, const float* oslc, const float* owin, bf16_t* mix) {
    long i = gtid(); if (i >= (long)T * 512) return; size_t row = (size_t)(i / 512); int c = (int)(i % 512), head = c / 64;
    mix[row * D + 512 + c] = f2bf(sigmoidf_(PJ(row, C_NG + head * 3)) * ocmp[i] + sigmoidf_(PJ(row, C_NG + head * 3 + 1)) * oslc[i] + sigmoidf_(PJ(row, C_NG + head * 3 + 2)) * owin[i]);
}
__global__ void k_proj_res(const bf16_t* A, const float* W, const float* x, const float* mod, int chunk, float* out) {
    long i = gtid(); if (i >= (long)T * D) return; int r = (int)(i / D), n = (int)(i % D), b = r / SEQ;
    float acc = 0.f; const bf16_t* a = A + (size_t)r * D;
    for (int k = 0; k < D; ++k) acc += bf2f(a[k]) * W[(size_t)k * D + n];
    out[i] = x[i] + mod[b * 6144 + chunk * D + n] * acc;
}
__global__ void __launch_bounds__(64) k_route(const float* LG, const float* bias, int* TOPI, float* TOPW) {
    long t = gtid(); if (t >= T) return; const float* lg = LG + (size_t)t * 64;
    float gs[8];
#pragma unroll
    for (int gI = 0; gI < 8; ++gI) { float a = -3e38f, b2 = -3e38f;
        for (int e = 0; e < 8; ++e) { float ch = sigmoidf_(lg[gI * 8 + e]) + bias[gI * 8 + e]; if (ch > a) { b2 = a; a = ch; } else if (ch > b2) b2 = ch; }
        gs[gI] = a + b2; }
    unsigned gmask = 0;
#pragma unroll
    for (int gI = 0; gI < 8; ++gI) { int rank = 0;
#pragma unroll
        for (int k = 0; k < 8; ++k) if (gs[k] > gs[gI] || (gs[k] == gs[gI] && k < gI)) ++rank;
        if (rank < 4) gmask |= 1u << gI; }
    int n = 0; float wsum = 0.f;
    for (int e = 0; e < 64; ++e) { if (!((gmask >> (e / 8)) & 1u)) continue; float se = sigmoidf_(lg[e]), ce = se + bias[e]; int rank = 0;
        for (int k = 0; k < 64; ++k) { if (!((gmask >> (k / 8)) & 1u)) continue; float ck = sigmoidf_(lg[k]) + bias[k]; if (ck > ce || (ck == ce && k < e)) ++rank; }
        if (rank < 8 && n < 8) { TOPI[t * 8 + n] = e; TOPW[t * 8 + n] = se; wsum += se; ++n; } }
    for (int k = 0; k < 8; ++k) TOPW[t * 8 + k] = TOPW[t * 8 + k] / wsum * 2.5f;
}
__global__ void k_moe_act(const bf16_t* h2, const float* Wgu, const int* TOPI, float* ACT, long nA) {
    long i = gtid(); if (i >= nA * 256) return; long a = i / 256; int j = (int)(i % 256); long t = TOPI ? a / 8 : a; int e = TOPI ? TOPI[a] : 0;
    const bf16_t* hp = h2 + (size_t)t * D; const float* w = Wgu + (size_t)e * D * 512; float gq = 0.f, u = 0.f;
    for (int k = 0; k < D; ++k) { float hv = bf2f(hp[k]); gq += hv * w[(size_t)k * 512 + j]; u += hv * w[(size_t)k * 512 + 256 + j]; }
    ACT[i] = siluf_(gq) * u;
}
__global__ void k_moe_out(const float* ACT, const float* ACTS, const float* Wdn, const float* Wsd, const int* TOPI, const float* TOPW, const float* x2, const float* mod, float* x3) {
    long i = gtid(); if (i >= (long)T * D) return; long t = i / D; int n = (int)(i % D), b = (int)(t / SEQ);
    float acc = 0.f;
    for (int sl = 0; sl < 8; ++sl) { int e = TOPI[t * 8 + sl]; const float* a = ACT + (size_t)(t * 8 + sl) * 256; const float* w = Wdn + (size_t)e * 256 * D; float y = 0.f;
        for (int k = 0; k < 256; ++k) y += a[k] * w[(size_t)k * D + n];
        acc += TOPW[t * 8 + sl] * y; }
    { const float* a = ACTS + (size_t)t * 256; float y = 0.f; for (int k = 0; k < 256; ++k) y += a[k] * Wsd[(size_t)k * D + n]; acc += y; }
    x3[i] = x2[i] + mod[b * 6144 + 5 * D + n] * acc;
}
__global__ void k_final(const float* x3, const float* rstd, const float* g, float* out) {
    long i = gtid(); if (i >= (long)T * D) return; out[i] = x3[i] * rstd[i / D] * g[i % D];
}
#undef PJ

struct In { const float *x, *c, *w_ada, *b_ada, *n1g, *w_in, *lbl, *hng, *pek, *w1k, *b1k, *w2k, *pev, *w1v, *b1v, *w2v, *w_out, *n2g, *rw, *rb, *wgu, *wdn, *wsgu, *wsdn, *fg;
    void set(void* const* d) { const float** p = (const float**)this; for (int i = 0; i < 25; ++i) p[i] = (const float*)d[i]; } };
#define NBK(n, tb) (((long)(n) + (tb) - 1) / (tb))
template <class Tp> static Tp* wsp(unsigned char* ws, size_t off) { return (Tp*)(ws + off); }
static void s1_naive(const In& I, unsigned char* ws, hipStream_t stream) {
    float* mod = wsp<float>(ws, WS_MOD); float* h = wsp<float>(ws, NV_H); float* rstd = wsp<float>(ws, NV_RSTD); bf16_t* proj = wsp<bf16_t>(ws, WS_PROJ);
    LAUNCH(k_mod, NBK(BATCH * 6144, 256), 256, I.c, I.w_ada, I.b_ada, mod);
    LAUNCH(k_rowrstd, NBK(T, 256), 256, I.x, rstd, T);
    LAUNCH(k_modnorm, NBK((long)T * D, 256), 256, I.x, rstd, I.n1g, mod, 0, 1, h, (bf16_t*)nullptr);
    LAUNCH(k_gemm_nn_bf, NBK((long)T * INC, 256), 256, h, D, I.w_in, INC, proj, LDP, T, INC, D);
}
static void s2_naive(const In& I, unsigned char* ws, hipStream_t stream, bool do_hg = true, bool do_nsa = true) {
    const bf16_t* proj = wsp<bf16_t>(ws, WS_PROJ); bf16_t* mix = wsp<bf16_t>(ws, WS_MIX);
    float *F = wsp<float>(ws, NV_F), *oraw = wsp<float>(ws, NV_ORAW), *owin = wsp<float>(ws, NV_OWIN), *ksr = wsp<float>(ws, NV_KSR), *kwr = wsp<float>(ws, NV_KWR), *PS = wsp<float>(ws, NV_PS);
    float *hid = wsp<float>(ws, NV_HID), *kcmp = wsp<float>(ws, NV_KCMP), *vcmp = wsp<float>(ws, NV_VCMP), *cs = wsp<float>(ws, NV_CS), *sn = wsp<float>(ws, NV_SN), *qrot = wsp<float>(ws, NV_QROT);
    unsigned* sel = wsp<unsigned>(ws, NV_SEL); float *ocmp = F, *oslc = oraw;
    if (do_hg) {
    LAUNCH(k_hgf, NBK((long)T * 512, 256), 256, proj, I.lbl, F);
    LAUNCH(k_hgrn, NBK(BATCH * 512, 64), 64, proj, F, oraw);
    LAUNCH(k_hgnorm, NBK((long)T * 4, 256), 256, oraw, proj, I.hng, mix);
    }
    if (!do_nsa) return;
    LAUNCH(k_cmp_hidden, NBK((long)BATCH * 2 * NCMP * 256, 256), 256, proj, C_KC, I.pek, I.w1k, I.b1k, hid);
    LAUNCH(k_cmp_out, NBK((long)BATCH * 2 * NCMP * 64, 256), 256, hid, I.w2k, kcmp);
    LAUNCH(k_cmp_hidden, NBK((long)BATCH * 2 * NCMP * 256, 256), 256, proj, C_VC, I.pev, I.w1v, I.b1v, hid);
    LAUNCH(k_cmp_out, NBK((long)BATCH * 2 * NCMP * 64, 256), 256, hid, I.w2v, vcmp);
    LAUNCH(k_rope_tab, NBK(SEQ * 32, 256), 256, cs, sn);
    LAUNCH(k_rope_apply, NBK((long)T * 8 * 32, 256), 256, proj, C_NQ, 8, cs, sn, qrot);
    LAUNCH(k_rope_apply, NBK((long)T * 2 * 32, 256), 256, proj, C_KS, 2, cs, sn, ksr);
    LAUNCH(k_rope_apply, NBK((long)T * 2 * 32, 256), 256, proj, C_KW, 2, cs, sn, kwr);
    LAUNCH(k_cmp_attn, NBK((long)BATCH * 2 * SEQ, 64), 64, proj, kcmp, vcmp, ocmp, PS);
    LAUNCH(k_select, NBK((long)BATCH * 2 * SEQ, 256), 256, PS, sel);
    LAUNCH(k_attn_naive, NBK((long)BATCH * 8 * SEQ, 64), 64, qrot, ksr, proj, C_VS, sel, 0, oslc);
    LAUNCH(k_attn_naive, NBK((long)BATCH * 8 * SEQ, 64), 64, qrot, kwr, proj, C_VW, sel, 1, owin);
    LAUNCH(k_nsa_combine, NBK((long)T * 512, 256), 256, proj, ocmp, oslc, owin, mix);
}
static void s3_naive(const In& I, unsigned char* ws, hipStream_t stream) {
    LAUNCH(k_proj_res, NBK((long)T * D, 256), 256, wsp<bf16_t>(ws, WS_MIX), I.w_out, I.x, wsp<float>(ws, WS_MOD), 2, wsp<float>(ws, WS_X2));
}
static void s4_naive(const In& I, unsigned char* ws, hipStream_t stream) {
    float *x2 = wsp<float>(ws, WS_X2), *rstd = wsp<float>(ws, NV_RSTD2), *h2f = wsp<float>(ws, NV_H2F), *lg = wsp<float>(ws, NV_LG), *mod = wsp<float>(ws, WS_MOD);
    LAUNCH(k_rowrstd, NBK(T, 256), 256, x2, rstd, T);
    LAUNCH(k_modnorm, NBK((long)T * D, 256), 256, x2, rstd, I.n2g, mod, 3, 4, h2f, wsp<bf16_t>(ws, WS_H2));
    LAUNCH(k_gemm_nn, NBK((long)T * 64, 256), 256, h2f, D, I.rw, 64, lg, 64, T, 64, D);
    LAUNCH(k_route, NBK(T, 64), 64, lg, I.rb, wsp<int>(ws, WS_TOPI), wsp<float>(ws, WS_TOPW));
}
static void s5_naive(const In& I, unsigned char* ws, float* out, hipStream_t stream) {
    float *act = wsp<float>(ws, NV_ACT), *acts = wsp<float>(ws, NV_ACTS), *x3 = wsp<float>(ws, NV_X3), *rstd = wsp<float>(ws, NV_RSTD3);
    const bf16_t* h2 = wsp<bf16_t>(ws, WS_H2); const int* topi = wsp<int>(ws, WS_TOPI);
    LAUNCH(k_moe_act, NBK((long)T * 8 * 256, 256), 256, h2, I.wgu, topi, act, (long)T * 8);
    LAUNCH(k_moe_act, NBK((long)T * 256, 256), 256, h2, I.wsgu, (const int*)nullptr, acts, (long)T);
    LAUNCH(k_moe_out, NBK((long)T * D, 256), 256, act, acts, I.wdn, I.wsdn, topi, wsp<float>(ws, WS_TOPW), wsp<float>(ws, WS_X2), wsp<float>(ws, WS_MOD), x3);
    LAUNCH(k_rowrstd, NBK(T, 256), 256, x3, rstd, T);
    LAUNCH(k_final, NBK((long)T * D, 256), 256, x3, rstd, I.fg, out);
}
}
#ifndef CPU_EMU
#define GAS __attribute__((address_space(1)))
#define LAS __attribute__((address_space(3)))
typedef unsigned v4u __attribute__((ext_vector_type(4)));
typedef unsigned v2u __attribute__((ext_vector_type(2)));
typedef float f32x4 __attribute__((ext_vector_type(4)));
typedef float f32x2 __attribute__((ext_vector_type(2)));
typedef float f32x16 __attribute__((ext_vector_type(16)));
typedef short bf16x8 __attribute__((ext_vector_type(8)));
typedef short bf16x4 __attribute__((ext_vector_type(4)));
typedef long i64x2 __attribute__((ext_vector_type(2)));
typedef int v8i __attribute__((ext_vector_type(8)));
typedef int v4i __attribute__((ext_vector_type(4)));
typedef GAS unsigned gu32;
#define RLX_AGENT __ATOMIC_RELAXED, __HIP_MEMORY_SCOPE_AGENT
#define LDS_WAIT() asm volatile("s_waitcnt lgkmcnt(0)" ::: "memory")
#define VM_WAIT() asm volatile("s_waitcnt vmcnt(0)" ::: "memory")
constexpr int NWAVES = 8, NTHR = 512;
__device__ __forceinline__ unsigned pk2(float lo, float hi) { return (unsigned)f2bf(lo) | ((unsigned)f2bf(hi) << 16); }
__device__ __forceinline__ unsigned cvt_pk_bf16(float lo, float hi) { unsigned r; asm volatile("v_cvt_pk_bf16_f32 %0, %1, %2" : "=v"(r) : "v"(lo), "v"(hi)); return r; }
__device__ __forceinline__ float fexp2(float x) { return __builtin_amdgcn_exp2f(__builtin_amdgcn_fmed3f(x, -120.0f, 3.0e38f)); }
__device__ __forceinline__ float fexp(float x) { return __builtin_amdgcn_exp2f(fmaxf(x * 1.4426950408889634f, -120.0f)); }
__device__ __forceinline__ float fsigmoid(float z) { return __builtin_amdgcn_rcpf(1.0f + __builtin_amdgcn_exp2f(__builtin_amdgcn_fmed3f(z * -1.4426950408889634f, -120.0f, 120.0f))); }
__device__ __forceinline__ float fsilu(float z) { return z * __builtin_amdgcn_rcpf(1.0f + __builtin_amdgcn_exp2f(__builtin_amdgcn_fmed3f(z * -1.4426950408889634f, -120.0f, 120.0f))); }
__device__ __forceinline__ unsigned pk4_e4m3(float a, float b, float c, float d, float sc) {
    a = __builtin_amdgcn_fmed3f(a * sc, -448.0f, 448.0f); b = __builtin_amdgcn_fmed3f(b * sc, -448.0f, 448.0f); c = __builtin_amdgcn_fmed3f(c * sc, -448.0f, 448.0f); d = __builtin_amdgcn_fmed3f(d * sc, -448.0f, 448.0f);
    int w = __builtin_amdgcn_cvt_pk_fp8_f32(a, b, 0, false); w = __builtin_amdgcn_cvt_pk_fp8_f32(c, d, w, true); return (unsigned)w;
}
__device__ __forceinline__ float wave_sum(float v) {
#pragma unroll
    for (int o = 1; o < 64; o <<= 1) v += __shfl_xor(v, o);
    return v;
}

#define XB_TMO      128
#define XB_XCNT(j)  (256  + 64 * (j))
#define XB_XSUB(j)  (1280 + 64 * (j))
#define XB_XGEN(j)  (2304 + 64 * (j))
#define XB_TOP      3328
#define XB_TOPGEN   3392
#define XCD_BAR_WORDS 3456
#define XB_SPIN_CAP (1u << 18)
__device__ __forceinline__ unsigned xb_ld(unsigned* p)              { return __hip_atomic_load(p, __ATOMIC_RELAXED, __HIP_MEMORY_SCOPE_AGENT); }
__device__ __forceinline__ unsigned xb_add(unsigned* p, unsigned v) { return __hip_atomic_fetch_add(p, v, __ATOMIC_RELAXED, __HIP_MEMORY_SCOPE_AGENT); }
__device__ __forceinline__ unsigned xb_xcc_id() { return (unsigned)__builtin_amdgcn_s_getreg((3 << 11) | 20) & 0xFu; }
#define XB_SPIN(cond, bar) do { unsigned _sp = 0; while (cond) { __builtin_amdgcn_s_sleep(1); \
    if ((++_sp & 255u) == 0u) { if (xb_ld(&(bar)[XB_TMO])) break; if (_sp > XB_SPIN_CAP) { atomicAdd(&(bar)[XB_TMO], 1u); break; } } } } while (0)
struct XcdBarrier { unsigned* bar; unsigned x; volatile LAS unsigned* st; };
__device__ __forceinline__ XcdBarrier xcd_barrier_post(unsigned* bar, volatile LAS unsigned* st) {
    XcdBarrier b; b.bar = bar; b.x = xb_xcc_id(); b.st = st;
    if (threadIdx.x == 0) (void)xb_add(&bar[XB_XCNT(b.x)], 1u);
    return b;
}
__device__ __forceinline__ void xcd_barrier_complete(unsigned* bar, unsigned x, unsigned& nloc, unsigned& nx) {
    const unsigned G = gridDim.x * gridDim.y * gridDim.z;
    unsigned sum, cnt, mine, sp = 0u;
    for (;;) {
        sum = 0u; cnt = 0u; mine = 0u;
#pragma unroll
        for (unsigned j = 0; j < 16; ++j) { const unsigned c = xb_ld(&bar[XB_XCNT(j)]); sum += c; cnt += (c > 0u) ? 1u : 0u; mine = (j == x) ? c : mine; }
        if (sum == G) break;
        __builtin_amdgcn_s_sleep(1);
        if ((++sp & 255u) == 0u) { if (xb_ld(&bar[XB_TMO])) break; if (sp > XB_SPIN_CAP) { atomicAdd(&bar[XB_TMO], 1u); break; } }
    }
    nloc = mine > 0u ? mine : 1u; nx = cnt > 0u ? cnt : 1u;
}
__device__ __forceinline__ void xcd_barrier(const XcdBarrier& b) {
    asm volatile("s_waitcnt vmcnt(0)" ::: "memory");
    __syncthreads();
    if (threadIdx.x == 0) {
        unsigned* bar = b.bar;
        __builtin_amdgcn_s_waitcnt(0);
        unsigned nloc = b.st[0], nx = b.st[1];
        if (nloc == 0u) { xcd_barrier_complete(bar, b.x, nloc, nx); b.st[0] = nloc; b.st[1] = nx; }
        const unsigned old = xb_add(&bar[XB_XSUB(b.x)], 1u);
        const unsigned gen = old / nloc;
        if (old + 1u == (gen + 1u) * nloc) {
            __builtin_amdgcn_fence(__ATOMIC_RELEASE, "agent");
            asm volatile("s_waitcnt vmcnt(0)" ::: "memory");
            const unsigned og = xb_add(&bar[XB_TOP], 1u);
            const unsigned tg = og / nx;
            if (og + 1u == (tg + 1u) * nx) xb_add(&bar[XB_TOPGEN], 1u);
            else XB_SPIN(xb_ld(&bar[XB_TOPGEN]) == tg, bar);
            __builtin_amdgcn_fence(__ATOMIC_ACQUIRE, "agent");
            xb_add(&bar[XB_XGEN(b.x)], 1u);
            asm volatile("s_waitcnt vmcnt(0)" ::: "memory");
        } else {
            XB_SPIN(xb_ld(&bar[XB_XGEN(b.x)]) == gen, bar);
            __builtin_amdgcn_fence(__ATOMIC_ACQUIRE, "agent");
            asm volatile("s_waitcnt vmcnt(0)" ::: "memory");
        }
    }
    __syncthreads();
}

namespace gm {
constexpr int BM = 256, BK = 64, HALF = 128, HTB = HALF * BK * 2, STAGE_BYTES = 8 * HTB, NXCD = 8, WGM = 8;
__host__ __device__ __forceinline__ int lds_byte(int r, int c) { const int st = (r >> 4) * 2 + (c >> 5), rr = r & 15, cc = c & 31, ob = rr * 64 + cc * 2; return st * 1024 + (ob ^ (((ob >> 9) & 1) << 5)); }
__host__ __device__ __forceinline__ void stage_rc(int b, int& R, int& C) { const int st = b / 1024, sb = b % 1024, swz = sb ^ (((sb >> 9) & 1) << 5); R = (st >> 1) * 16 + swz / 64; C = (st & 1) * 32 + (swz % 64) / 2; }
__host__ __device__ __forceinline__ int perm32(int rho) { const int n = rho >> 4, i = rho & 15; return 8 * (i >> 2) + 4 * n + (i & 3); }

struct Unit { int pm, pn; const char* A; const char* B; int e, m0; };

__device__ __forceinline__ bool static_tile(int nM, int nN, int G, int c, int i, int& pm, int& pn) {
    const int nwg = nM * nN; const long L = (long)i * G + c; if (L >= nwg) return false;
    int wgid = (int)L; { const int q = nwg / NXCD, r = nwg % NXCD, xcd = wgid % NXCD, off = wgid / NXCD; wgid = (xcd < r ? xcd * (q + 1) : r * (q + 1) + (xcd - r) * q) + off; }
    const int nig = WGM * nN, gid = wgid / nig, fm = gid * WGM, gsz = (nM - fm) < WGM ? (nM - fm) : WGM;
    pm = fm + ((wgid % nig) % gsz); pn = (wgid % nig) / gsz; return true;
}
struct DenseSched {
    const char* A; const char* Bt; int nM, nN, G, c; unsigned lda_b, K;
    __device__ __forceinline__ bool next(int i, Unit& u) const { int pm, pn; if (!static_tile(nM, nN, G, c, i, pm, pn)) return false; u.pm = pm; u.pn = pn; u.A = A + (size_t)pm * BM * lda_b; u.B = Bt + (size_t)pn * BM * K * 2; u.e = 0; u.m0 = 0; return true; }
    __device__ __forceinline__ unsigned arow(const Unit&, int r) const { return (unsigned)r * lda_b; }
};

template <class Epi, class Sched, bool FP8 = false, bool K128 = false, bool HALFA = false>
__device__ __forceinline__ void gemm_phase(LAS unsigned char* lds, const Sched& S, const Epi& E, const int K, const unsigned kstepA) {
    const int tid = threadIdx.x, wid = __builtin_amdgcn_readfirstlane(tid >> 6), lane = tid & 63, wr = wid >> 2, wc = wid & 3, fr = lane & 15, fq = lane >> 4;
    const int nt = K / BK;
    int R0, C0; stage_rc(tid * 16, R0, C0);
    unsigned voffB[2];
#pragma unroll
    for (int i = 0; i < 2; ++i) { const int R = R0 + 64 * i; const int Rb = Epi::PERM ? ((R & ~31) + perm32(R & 31)) : R; voffB[i] = (unsigned)(Rb * K + C0) * 2u; }
    const unsigned ca = (unsigned)C0 * 2u;
    const size_t kstepB = (size_t)(BK * 2);
    const size_t hstepB = (size_t)HALF * K * 2;
    const unsigned ldsw = (unsigned)wid * 1024u;
    const unsigned ldsbase = __builtin_amdgcn_readfirstlane((unsigned)(size_t)lds + ldsw);
    const int aoff = lds_byte(wr * 64 + fr, fq * 8), boff = lds_byte(wc * 32 + fr, fq * 8);
#define GM_SA(b, h) (((b) * 2 + (h)) * HTB)
#define GM_SB(b, h) ((4 + (b) * 2 + (h)) * HTB)
#define GM_DMA16(gptr_u, voff32, ldsaddr_u) asm volatile("s_mov_b32 m0, %2\n\ts_nop 0\n\tglobal_load_lds_dwordx4 %0, %1" :: "v"(voff32), "s"(gptr_u), "s"(ldsaddr_u) : "memory")
#define GM_STAGEB(bufoff, gbase) do { _Pragma("unroll") for (int _i = 0; _i < 2; ++_i) \
        GM_DMA16((const char*)(gbase), voffB[_i], ldsbase + (unsigned)((bufoff) + _i * 8192)); } while (0)
#define GM_STAGEA(bufoff, abase, offs, h, kb) do { const char* ab_ = (const char*)(abase) + (kb); _Pragma("unroll") for (int _i = 0; _i < 2; ++_i) \
        GM_DMA16(ab_, (offs)[2 * (h) + _i], ldsbase + (unsigned)((bufoff) + _i * 8192)); } while (0)
#define GM_STAGEA2(bufoff, abase, h, kb) do { const char* ab_ = (const char*)(abase) + (kb); _Pragma("unroll") for (int _i = 0; _i < 2; ++_i) \
        GM_DMA16(ab_, (last ? noff[2 * (h) + _i] : coff[2 * (h) + _i]), ldsbase + (unsigned)((bufoff) + _i * 8192)); } while (0)
#define GM_LDA(dst, b, h) do { _Pragma("unroll") for (int m = 0; m < 4; ++m) _Pragma("unroll") for (int k = 0; k < 2; ++k) dst[m][k] = *(const LAS bf16x8*)(lds + GM_SA(b, h) + aoff + m * 2048 + k * 1024); } while (0)
#define GM_LDB(dst, b, h) do { _Pragma("unroll") for (int n = 0; n < 2; ++n) _Pragma("unroll") for (int k = 0; k < 2; ++k) dst[n][k] = *(const LAS bf16x8*)(lds + GM_SB(b, h) + boff + n * 2048 + k * 1024); } while (0)
#ifndef GM_FP8_K128
#define GM_FP8_K128 1
#endif
typedef int i32x4_t __attribute__((ext_vector_type(4)));
typedef int i32x8_t __attribute__((ext_vector_type(8)));
#define GM_CAT8(x0, x1) __builtin_shufflevector(__builtin_bit_cast(i32x4_t, x0), __builtin_bit_cast(i32x4_t, x1), 0, 1, 2, 3, 4, 5, 6, 7)
#define GM_MMA(ai, bj, At, Bt) do { __builtin_amdgcn_s_setprio(1); _Pragma("unroll") for (int m = 0; m < 4; ++m) _Pragma("unroll") for (int n = 0; n < 2; ++n) { \
        if constexpr (FP8 && K128 && GM_FP8_K128) {   \
            acc[ai][bj][m][n] = __builtin_amdgcn_mfma_scale_f32_16x16x128_f8f6f4(GM_CAT8(Bt[n][0], Bt[n][1]), GM_CAT8(At[m][0], At[m][1]), acc[ai][bj][m][n], 0, 0, 0, 0x7f7f7f7f, 0, 0x7f7f7f7f); } \
        else { _Pragma("unroll") for (int k = 0; k < 2; ++k) { \
        if constexpr (FP8) { const i64x2 b2_ = __builtin_bit_cast(i64x2, Bt[n][k]), a2_ = __builtin_bit_cast(i64x2, At[m][k]); \
            acc[ai][bj][m][n] = __builtin_amdgcn_mfma_f32_16x16x32_fp8_fp8(b2_[0], a2_[0], acc[ai][bj][m][n], 0, 0, 0); acc[ai][bj][m][n] = __builtin_amdgcn_mfma_f32_16x16x32_fp8_fp8(b2_[1], a2_[1], acc[ai][bj][m][n], 0, 0, 0); } \
        else acc[ai][bj][m][n] = __builtin_amdgcn_mfma_f32_16x16x32_bf16(Bt[n][k], At[m][k], acc[ai][bj][m][n], 0, 0, 0); } } } __builtin_amdgcn_s_setprio(0); } while (0)
#define GM_LDA_H(dst, b, h, mb) do { _Pragma("unroll") for (int m = 0; m < 2; ++m) _Pragma("unroll") for (int k = 0; k < 2; ++k) dst[m][k] = *(const LAS bf16x8*)(lds + GM_SA(b, h) + aoff + ((mb) + m) * 2048 + k * 1024); } while (0)
#define GM_MMA_H(ai, bj, At, Bt, mb) do { _Pragma("unroll") for (int m = 0; m < 2; ++m) _Pragma("unroll") for (int n = 0; n < 2; ++n) \
        acc[ai][bj][(mb) + m][n] = __builtin_amdgcn_mfma_scale_f32_16x16x128_f8f6f4(GM_CAT8(Bt[n][0], Bt[n][1]), GM_CAT8(At[m][0], At[m][1]), acc[ai][bj][(mb) + m][n], 0, 0, 0, 0x7f7f7f7f, 0, 0x7f7f7f7f); } while (0)
#define GM_WAIT_V(n) asm volatile("s_waitcnt vmcnt(" #n ")" ::: "memory")
#define GM_WAIT_L(n) asm volatile("s_waitcnt lgkmcnt(" #n ")" ::: "memory")
#define GM_BAR __builtin_amdgcn_s_barrier()
#define GM_SCHED __builtin_amdgcn_sched_barrier(0)
    Unit cur, nxt; int ui = 0;
    if (!S.next(0, cur)) return;
    unsigned coff[4], noff[4];
#pragma unroll
    for (int q = 0; q < 4; ++q) { coff[q] = S.arow(cur, R0 + 64 * q) + ca; noff[q] = coff[q]; }
    f32x4 acc[2][2][4][2];
#pragma unroll
    for (int a = 0; a < 2; ++a)
#pragma unroll
        for (int b = 0; b < 2; ++b)
#pragma unroll
            for (int m = 0; m < 4; ++m)
#pragma unroll
                for (int n = 0; n < 2; ++n) acc[a][b][m][n] = (f32x4){0.f, 0.f, 0.f, 0.f};
    bf16x8 At[4][2], B0[2][2], B1[2][2];
    const char* cA = cur.A; const char* cB = cur.B;
    GM_STAGEB(GM_SB(0, 0), cB); GM_STAGEB(GM_SB(0, 1), cB + hstepB); GM_STAGEA(GM_SA(0, 0), cA, coff, 0, 0u); GM_STAGEA(GM_SA(0, 1), cA, coff, 1, 0u);
    if (wr == 1) GM_BAR;
    GM_WAIT_V(2); GM_BAR;
    GM_STAGEB(GM_SB(1, 0), cB + kstepB); GM_STAGEA(GM_SA(1, 0), cA, coff, 0, kstepA); GM_STAGEB(GM_SB(1, 1), cB + hstepB + kstepB);
    GM_WAIT_V(6); GM_BAR;
    for (;;) {
        const bool has_next = S.next(ui + 1, nxt);
        const char* nA = has_next ? nxt.A : cA; const char* nB = has_next ? nxt.B : cB;
        if (has_next) { int t2_ = tid, R0n_, C0n_; asm volatile("" : "+v"(t2_)); stage_rc(t2_ * 16, R0n_, C0n_);
#pragma unroll
            for (int q = 0; q < 4; ++q) noff[q] = S.arow(nxt, R0n_ + 64 * q) + (unsigned)C0n_ * 2u;
        } else {
#pragma unroll
            for (int q = 0; q < 4; ++q) noff[q] = coff[q];
        }
#pragma unroll 1
        for (int t = 0; t < nt; t += 2) {
            const bool last = (t == nt - 2);
            const unsigned k1 = (unsigned)(t + 1) * kstepA;
            const char* a2 = last ? nA : cA; const unsigned k2 = last ? 0u : (unsigned)(t + 2) * kstepA, k3 = k2 + kstepA;
            const char* b2 = last ? nB : cB + (size_t)(t + 2) * kstepB; const char* b3 = b2 + kstepB;
            if constexpr (HALFA) { GM_LDB(B0, 0, 0); GM_LDB(B1, 0, 1); GM_SCHED; GM_LDA_H(At, 0, 0, 0); GM_STAGEA(GM_SA(1, 1), cA, coff, 1, k1);
                GM_WAIT_V(8); GM_WAIT_L(0); GM_BAR; __builtin_amdgcn_s_setprio(1); GM_MMA_H(0, 0, At, B0, 0); GM_MMA_H(0, 1, At, B1, 0); GM_SCHED; GM_LDA_H(At, 0, 0, 2); GM_SCHED; GM_MMA_H(0, 0, At, B0, 2); GM_MMA_H(0, 1, At, B1, 2); __builtin_amdgcn_s_setprio(0); GM_BAR; GM_SCHED; } else {
            GM_LDB(B0, 0, 0); GM_LDB(B1, 0, 1); GM_SCHED; GM_LDA(At, 0, 0); GM_STAGEA(GM_SA(1, 1), cA, coff, 1, k1);
            GM_WAIT_V(8); GM_WAIT_L(0); GM_BAR; GM_MMA(0, 0, At, B0); GM_MMA(0, 1, At, B1); GM_BAR; GM_SCHED; }
            if constexpr (HALFA) { GM_LDA_H(At, 0, 1, 0); GM_STAGEB(GM_SB(0, 0), b2); GM_STAGEB(GM_SB(0, 1), b2 + hstepB); GM_STAGEA2(GM_SA(0, 0), a2, 0, k2);
                GM_WAIT_V(8); GM_WAIT_L(0); GM_BAR; __builtin_amdgcn_s_setprio(1); GM_MMA_H(1, 0, At, B0, 0); GM_MMA_H(1, 1, At, B1, 0); GM_SCHED; GM_LDA_H(At, 0, 1, 2); GM_SCHED; GM_MMA_H(1, 0, At, B0, 2); GM_MMA_H(1, 1, At, B1, 2); __builtin_amdgcn_s_setprio(0); GM_BAR; GM_SCHED; } else {
            GM_LDA(At, 0, 1); GM_STAGEB(GM_SB(0, 0), b2); GM_STAGEB(GM_SB(0, 1), b2 + hstepB); GM_STAGEA2(GM_SA(0, 0), a2, 0, k2);
            GM_WAIT_V(8); GM_WAIT_L(0); GM_BAR; GM_MMA(1, 0, At, B0); GM_MMA(1, 1, At, B1); GM_BAR; GM_SCHED; }
            if constexpr (HALFA) { GM_LDB(B0, 1, 0); GM_LDB(B1, 1, 1); GM_SCHED; GM_LDA_H(At, 1, 0, 0); GM_STAGEA2(GM_SA(0, 1), a2, 1, k2);
                GM_WAIT_V(8); GM_WAIT_L(0); GM_BAR; __builtin_amdgcn_s_setprio(1); GM_MMA_H(0, 0, At, B0, 0); GM_MMA_H(0, 1, At, B1, 0); GM_SCHED; GM_LDA_H(At, 1, 0, 2); GM_SCHED; GM_MMA_H(0, 0, At, B0, 2); GM_MMA_H(0, 1, At, B1, 2); __builtin_amdgcn_s_setprio(0); GM_BAR; GM_SCHED; } else {
            GM_LDB(B0, 1, 0); GM_LDB(B1, 1, 1); GM_SCHED; GM_LDA(At, 1, 0); GM_STAGEA2(GM_SA(0, 1), a2, 1, k2);
            GM_WAIT_V(8); GM_WAIT_L(0); GM_BAR; GM_MMA(0, 0, At, B0); GM_MMA(0, 1, At, B1); GM_BAR; GM_SCHED; }
            if constexpr (HALFA) { GM_LDA_H(At, 1, 1, 0); GM_STAGEB(GM_SB(1, 0), b3); GM_STAGEB(GM_SB(1, 1), b3 + hstepB); GM_STAGEA2(GM_SA(1, 0), a2, 0, k3);
                GM_WAIT_V(8); GM_WAIT_L(0); GM_BAR; __builtin_amdgcn_s_setprio(1); GM_MMA_H(1, 0, At, B0, 0); GM_MMA_H(1, 1, At, B1, 0); GM_SCHED; GM_LDA_H(At, 1, 1, 2); GM_SCHED; GM_MMA_H(1, 0, At, B0, 2); GM_MMA_H(1, 1, At, B1, 2); __builtin_amdgcn_s_setprio(0); GM_BAR; GM_SCHED; } else {
            GM_LDA(At, 1, 1); GM_STAGEB(GM_SB(1, 0), b3); GM_STAGEB(GM_SB(1, 1), b3 + hstepB); GM_STAGEA2(GM_SA(1, 0), a2, 0, k3);
            GM_WAIT_V(8); GM_WAIT_L(0); GM_BAR; GM_MMA(1, 0, At, B0); GM_MMA(1, 1, At, B1); GM_BAR; GM_SCHED; }
        }
        if (wr == 0) GM_BAR;
        { int l2_ = threadIdx.x & 63; asm volatile("" : "+v"(l2_)); E(acc, cur, wr, wc, l2_ & 15, l2_ >> 4); }
        if (!has_next) break;
#pragma unroll
        for (int a = 0; a < 2; ++a)
#pragma unroll
            for (int b = 0; b < 2; ++b)
#pragma unroll
                for (int m = 0; m < 4; ++m)
#pragma unroll
                    for (int n = 0; n < 2; ++n) acc[a][b][m][n] = (f32x4){0.f, 0.f, 0.f, 0.f};
        cur = nxt; cA = nA; cB = nB; ++ui;
#pragma unroll
        for (int q = 0; q < 4; ++q) coff[q] = noff[q];
        if (wr == 1) GM_BAR;
    }
    GM_WAIT_V(0);
    GM_BAR;
#undef GM_SA
#undef GM_SB
#undef GM_STAGEA
#undef GM_STAGEA2
#undef GM_STAGEB
#undef GM_DMA16
#undef GM_LDA
#undef GM_LDB
#undef GM_MMA
#undef GM_LDA_H
#undef GM_MMA_H
#undef GM_WAIT_V
#undef GM_WAIT_L
#undef GM_BAR
#undef GM_SCHED
}

struct EpiBf16 {
    static constexpr bool PERM = true;
    bf16_t* O; int ldc;
    __device__ __forceinline__ void operator()(const f32x4 (&acc)[2][2][4][2], const Unit& u, int wr, int wc, int fr, int fq) const {
        const int row0 = u.pm * BM + wr * 64 + fr, col0 = u.pn * BM + wc * 32 + 8 * fq;
#pragma unroll
        for (int ai = 0; ai < 2; ++ai)
#pragma unroll
            for (int m = 0; m < 4; ++m) { bf16_t* rowp = O + (size_t)(row0 + ai * HALF + m * 16) * ldc + col0;
#pragma unroll
                for (int bj = 0; bj < 2; ++bj) { const f32x4 v0 = acc[ai][bj][m][0], v1 = acc[ai][bj][m][1];
                    v4u w; w.x = cvt_pk_bf16(v0[0], v0[1]); w.y = cvt_pk_bf16(v0[2], v0[3]); w.z = cvt_pk_bf16(v1[0], v1[1]); w.w = cvt_pk_bf16(v1[2], v1[3]);
                    *(v4u*)(rowp + bj * HALF) = w; } }
    }
};
struct EpiRes {
    static constexpr bool PERM = false;
    const float* x; const float* mod; int chunk; bf16_t* out; float* ssq;
    __device__ __forceinline__ void operator()(const f32x4 (&acc)[2][2][4][2], const Unit& u, int wr, int wc, int fr, int fq) const {
        const int row0 = u.pm * BM + wr * 64 + fr, col0 = u.pn * BM + wc * 32 + 4 * fq; const int b = (u.pm * BM) / SEQ;
        f32x4 gv[2][2];
#pragma unroll
        for (int bj = 0; bj < 2; ++bj)
#pragma unroll
            for (int n = 0; n < 2; ++n) gv[bj][n] = *(const f32x4*)(mod + (size_t)b * 6144 + chunk * 1024 + col0 + bj * HALF + n * 16);
#pragma unroll
        for (int ai = 0; ai < 2; ++ai)
#pragma unroll
            for (int m = 0; m < 4; ++m) { const size_t off = (size_t)(row0 + ai * HALF + m * 16) * 1024 + col0; float sq = 0.f;
#pragma unroll
                for (int bj = 0; bj < 2; ++bj)
#pragma unroll
                    for (int n = 0; n < 2; ++n) { const f32x4 xv = *(const f32x4*)(x + off + bj * HALF + n * 16); const f32x4 o = xv + gv[bj][n] * acc[ai][bj][m][n]; *(v2u*)(out + off + bj * HALF + n * 16) = (v2u){cvt_pk_bf16(o[0], o[1]), cvt_pk_bf16(o[2], o[3])};
                        sq += (o[0] * o[0] + o[1] * o[1]) + (o[2] * o[2] + o[3] * o[3]); }
                sq += __shfl_xor(sq, 16); sq += __shfl_xor(sq, 32);
                if (fq == 0) ssq[(size_t)(row0 + ai * HALF + m * 16) * 16 + u.pn * 4 + wc] = sq; }
    }
};
}
#ifndef PROBE_REP
#define PROBE_REP -1
#endif
#ifndef PROBE_P3
#define PROBE_P3 0
#endif
constexpr int RING_BYTES = 131072, LDSCTL_OFF = 147456, MISC_OFF = LDSCTL_OFF + 320, LDS_BYTES = 163840;
constexpr float WGU_SCALE = 32.0f, WDN_SCALE = 16.0f, ACT_SCALE = 8.0f;
constexpr int CW_BAR = 4096;
constexpr int CW_KMAX = 65536 + 128;
constexpr int CW_HGCNT = 65536 + 320;
constexpr int CW_MODCNT = 65536 + 256;
constexpr int CW_ECNT = 65536;

struct Args { const float* in[25]; float* out; unsigned char* ws; int ph_lo, ph_hi, rep, pad; };
struct Frame {
    LAS unsigned char* lds; volatile LAS unsigned* MISC; unsigned* ctl; unsigned char* ws;
    int tid, lane, wave, vcu, G;
    const float* in[25]; float* out;
};
#define IN_X 0
#define IN_C 1
#define IN_WADA 2
#define IN_BADA 3
#define IN_N1G 4
#define IN_WIN 5
#define IN_LBL 6
#define IN_HNG 7
#define IN_PEK 8
#define IN_W1K 9
#define IN_B1K 10
#define IN_W2K 11
#define IN_PEV 12
#define IN_W1V 13
#define IN_B1V 14
#define IN_W2V 15
#define IN_WOUT 16
#define IN_N2G 17
#define IN_RW 18
#define IN_RB 19
#define IN_WGU 20
#define IN_WDN 21
#define IN_WSGU 22
#define IN_WSDN 23
#define IN_FG 24

#ifndef PROBE_TIME
#define PROBE_TIME -1
#endif
#define R7STAMP(k) do { if (PROBE_TIME >= 20 && blockIdx.x == 0 && F.tid == 0) ((volatile LAS unsigned long long*)(F.lds + LDSCTL_OFF + 8192))[k] = __builtin_amdgcn_s_memrealtime(); } while (0)
template <bool FRAG = false, bool F8 = false> __device__ __forceinline__ void p0_transpose_item(const float* W, int K, int N, bf16_t* WT, int drow0, int k0, int n0, LAS float* scr, int lane, float f8scale = 1.0f) {
    const int kq = lane >> 3, nq = lane & 7; const int nn = n0 + 4 * nq; const bool ok = nn < N;
    f32x4 v[8];
#pragma unroll
    for (int i = 0; i < 8; ++i) v[i] = ok ? *(const f32x4*)(W + (size_t)(k0 + 8 * i + kq) * N + nn) : (f32x4){0.f, 0.f, 0.f, 0.f};
#pragma unroll
    for (int i = 0; i < 8; ++i) { LAS float* d = scr + (8 * i + kq) * 33 + 4 * nq; d[0] = v[i][0]; d[1] = v[i][1]; d[2] = v[i][2]; d[3] = v[i][3]; }
    LDS_WAIT(); asm volatile("" ::: "memory");
    const int c = lane & 7;
#pragma unroll
    for (int j = 0; j < 4; ++j) { const int n = (lane >> 3) + 8 * j; const LAS float* s = scr + (8 * c) * 33 + n;
        v4u o; o.x = pk2(s[0 * 33], s[1 * 33]); o.y = pk2(s[2 * 33], s[3 * 33]); o.z = pk2(s[4 * 33], s[5 * 33]); o.w = pk2(s[6 * 33], s[7 * 33]);
        if (F8) { *(v2u*)((unsigned char*)WT + (size_t)(drow0 + n) * K + k0 + 8 * c) = (v2u){pk4_e4m3(s[0 * 33], s[1 * 33], s[2 * 33], s[3 * 33], f8scale), pk4_e4m3(s[4 * 33], s[5 * 33], s[6 * 33], s[7 * 33], f8scale)}; }
        else if (FRAG) { const int kk = k0 + 8 * c, col = drow0 + n; *(v4u*)(WT + ((size_t)((kk >> 5) * (N / 16) + (col >> 4)) * 64 + ((kk & 31) >> 3) * 16 + (col & 15)) * 8) = o; }
        else *(v4u*)(WT + (size_t)(drow0 + n) * K + k0 + 8 * c) = o; }
    LDS_WAIT(); asm volatile("" ::: "memory");
}
__device__ __forceinline__ int gu_row(int n) { const int j = n & 255; return (j >> 7) * 256 + ((n >> 8) << 7) + (j & 127); }

__device__ __forceinline__ int p2_fillers(int G) { const int nt = (T / 256) * (LDP / 256), R = (nt + G - 1) / G, nf = R * G - nt; return nf >= 64 ? nf : 0; }
__device__ __forceinline__ void xpose_fp8(Frame& F, int part, int wg, int nwg) {
    unsigned char* ws = F.ws;
    constexpr int X_GU = 4 * 8, X_DN = 16; constexpr int NXALL = 64 * X_GU + 64 * X_DN + X_GU + X_DN, NXDN0 = 64 * X_GU, NXDN = 64 * X_DN;
    const int NX = part == 0 ? NXALL : (part == 1 ? NXALL - NXDN : NXDN);
    {
      struct XItem { const float* W; unsigned char* WT; int N, K, k0, n0, drow0; float sc; };
      auto xdecode = [&](int v, XItem& t) { int r = part == 0 ? v : (part == 1 ? (v < NXDN0 ? v : v + NXDN) : v + NXDN0);
          if (r < 64 * X_GU) { const int e = r / X_GU, q = r % X_GU, kt = q >> 3, nt = q & 7; t = XItem{F.in[IN_WGU] + (size_t)e * 1024 * 512, ws + WS_WGUT + (size_t)e * 512 * 1024, 512, 1024, 256 * kt, 64 * nt, gu_row(64 * nt), WGU_SCALE}; return; } r -= 64 * X_GU;
          if (r < 64 * X_DN) { const int e = r / X_DN, nt = r % X_DN; t = XItem{F.in[IN_WDN] + (size_t)e * 256 * 1024, ws + WS_WDNT + (size_t)e * 1024 * 256, 1024, 256, 0, 64 * nt, 64 * nt, WDN_SCALE}; return; } r -= 64 * X_DN;
          if (r < X_GU) { const int kt = r >> 3, nt = r & 7; t = XItem{F.in[IN_WSGU], ws + WS_WSGUT, 512, 1024, 256 * kt, 64 * nt, gu_row(64 * nt), WGU_SCALE}; return; } r -= X_GU;
          t = XItem{F.in[IN_WSDN], ws + WS_WSDNT, 1024, 256, 0, 64 * r, 64 * r, WDN_SCALE}; };
      const int rg = F.tid >> 4, l16 = F.tid & 15;
#define X_LOAD(t, v) do { _Pragma("unroll") for (int i = 0; i < 8; ++i) v[i] = *(const f32x4*)((t).W + (size_t)((t).k0 + 128 * (i >> 2) + 4 * rg + (i & 3)) * (t).N + (t).n0 + 4 * l16); } while (0)
#define X_PROC(t, v, buf) do { LAS unsigned char* L_ = F.lds + (buf) * 16384; \
          _Pragma("unroll") for (int h = 0; h < 2; ++h) _Pragma("unroll") for (int c = 0; c < 4; ++c) { const int n_ = 4 * l16 + c, kd_ = 32 * h + rg; \
              *(LAS unsigned*)(L_ + n_ * 256 + ((kd_ ^ (4 * l16)) << 2)) = pk4_e4m3(v[4 * h][c], v[4 * h + 1][c], v[4 * h + 2][c], v[4 * h + 3][c], (t).sc); } \
          __syncthreads(); \
          _Pragma("unroll") for (int ps = 0; ps < 2; ++ps) { const int n_ = (F.tid >> 4) + 32 * ps, G_ = F.tid & 15; \
              const v4u d_ = *(const LAS v4u*)(L_ + n_ * 256 + ((G_ ^ ((n_ >> 2) & 15)) << 4)); \
              *(v4u*)((t).WT + (size_t)((t).drow0 + n_) * (t).K + (t).k0 + 16 * G_) = d_; } } while (0)
      if (wg < NX) {
          XItem ta, tb; f32x4 va[8], vb[8]; xdecode(wg, ta); X_LOAD(ta, va);
          for (int it = wg; it < NX; it += 2 * nwg) {
              const bool hb = it + nwg < NX;
              if (hb) { xdecode(it + nwg, tb); X_LOAD(tb, vb); }
              X_PROC(ta, va, 0);
              if (!hb) break;
              if (it + 2 * nwg < NX) { xdecode(it + 2 * nwg, ta); X_LOAD(ta, va); }
              X_PROC(tb, vb, 1);
          }
      }
#undef X_LOAD
#undef X_PROC
    }
}
__device__ __forceinline__ void p0_prologue(Frame& F) {
    unsigned char* ws = F.ws;
    R7STAMP(30);
    if (F.vcu < 256) {
        LAS float* ca = (LAS float*)F.lds;
        const int ks = F.vcu >> 4, cg = F.vcu & 15;
        if (F.tid < 256) { const int b = F.tid >> 6, k = F.tid & 63; ca[F.tid] = fsilu(F.in[IN_C][b * D + ks * 64 + k]); }
        __syncthreads();
        if (F.tid < 384) { const int n = cg * 384 + F.tid; const float* w = F.in[IN_WADA] + (size_t)(ks * 64) * 6144 + n; float a0 = 0.f, a1 = 0.f, a2 = 0.f, a3 = 0.f;
            float wv[64];
#pragma unroll
            for (int k = 0; k < 64; ++k) wv[k] = w[(size_t)k * 6144];
            __builtin_amdgcn_sched_barrier(0);
#pragma unroll
            for (int k = 0; k < 64; ++k) { a0 += ca[k] * wv[k]; a1 += ca[64 + k] * wv[k]; a2 += ca[128 + k] * wv[k]; a3 += ca[192 + k] * wv[k]; }
            float* mp = (float*)(ws + WS_MODP) + (size_t)ks * 4 * 6144 + n; mp[0] = a0; mp[6144] = a1; mp[2 * 6144] = a2; mp[3 * 6144] = a3; }
        asm volatile("s_waitcnt vmcnt(0)" ::: "memory");
        __syncthreads();
    }
    if (F.tid == 0) { __builtin_amdgcn_fence(__ATOMIC_RELEASE, "agent"); asm volatile("s_waitcnt vmcnt(0)" ::: "memory"); __hip_atomic_fetch_add(F.ctl + CW_MODCNT, 1u, RLX_AGENT); }
    R7STAMP(31);
    { float* cs = (float*)(ws + WS_CS); float* sn = (float*)(ws + WS_SN);
      for (int i = F.vcu * NTHR + F.tid; i < SEQ * 32; i += F.G * NTHR) { const int pos = i >> 5, k = i & 31; const float inv = powf(10000.0f, -(float)k / 32.0f); const float ang = (float)pos * inv; cs[i] = cosf(ang); sn[i] = sinf(ang); } }
    R7STAMP(32);
    LAS float* scr = (LAS float*)(F.lds + 4096 + F.wave * 8704);
    const int gw = F.vcu * NWAVES + F.wave, NGW = F.G * NWAVES;
    constexpr int I_IN = 16 * 105, I_OUT = 16 * 32, I_GU = 16 * 16, I_DN = 4 * 32, I_W1 = 32 * 8;
    constexpr int NIT = I_IN + I_OUT + 2 * I_W1;
    struct TItem { const float* W; unsigned char* WT; int K, N, drow0, k0, n0, mode; float sc; };
    auto decode = [&](int it, TItem& t) {
        int r = it;
        if (r < I_IN) { const int kb = r / 105, nb = r % 105; t = TItem{F.in[IN_WIN], ws + WS_WINT, 1024, INC, 32 * nb, 64 * kb, 32 * nb, 0, 1.f}; return; } r -= I_IN;
        if (r < I_OUT) { const int kb = r / 32, nb = r % 32; t = TItem{F.in[IN_WOUT], ws + WS_WOUTT, 1024, 1024, 32 * nb, 64 * kb, 32 * nb, 0, 1.f}; return; } r -= I_OUT;
        { const int kv = r / I_W1, q = r % I_W1, kb = q / 8, nb = q % 8; t = TItem{F.in[kv ? IN_W1V : IN_W1K], ws + (kv ? WS_W1VT : WS_W1KT), 2048, 256, 32 * nb, 64 * kb, 32 * nb, 2, 1.f}; }
    };
    const int kq = F.lane >> 3, nq = F.lane & 7;
#define P0_LOAD(t, v) do { const int nn_ = (t).n0 + 4 * nq; const bool ok_ = nn_ < (t).N; _Pragma("unroll") for (int i = 0; i < 8; ++i) v[i] = ok_ ? *(const f32x4*)((t).W + (size_t)((t).k0 + 8 * i + kq) * (t).N + nn_) : (f32x4){0.f, 0.f, 0.f, 0.f}; } while (0)
#define P0_PROC(t, v) do { \
            _Pragma("unroll") for (int i = 0; i < 8; ++i) { LAS float* d = scr + (8 * i + kq) * 33 + 4 * nq; d[0] = v[i][0]; d[1] = v[i][1]; d[2] = v[i][2]; d[3] = v[i][3]; } \
            LDS_WAIT(); asm volatile("" ::: "memory"); \
            const int c = F.lane & 7; \
            _Pragma("unroll") for (int j = 0; j < 4; ++j) { const int n = (F.lane >> 3) + 8 * j; const LAS float* s = scr + (8 * c) * 33 + n; \
                if ((t).mode == 1) { *(v2u*)((t).WT + (size_t)((t).drow0 + n) * (t).K + (t).k0 + 8 * c) = (v2u){pk4_e4m3(s[0 * 33], s[1 * 33], s[2 * 33], s[3 * 33], (t).sc), pk4_e4m3(s[4 * 33], s[5 * 33], s[6 * 33], s[7 * 33], (t).sc)}; } \
                else { v4u o; o.x = pk2(s[0 * 33], s[1 * 33]); o.y = pk2(s[2 * 33], s[3 * 33]); o.z = pk2(s[4 * 33], s[5 * 33]); o.w = pk2(s[6 * 33], s[7 * 33]); \
                    if ((t).mode == 2) { const int kk = (t).k0 + 8 * c, col = (t).drow0 + n; *(v4u*)((bf16_t*)(t).WT + ((size_t)((kk >> 5) * ((t).N / 16) + (col >> 4)) * 64 + ((kk & 31) >> 3) * 16 + (col & 15)) * 8) = o; } \
                    else *(v4u*)((bf16_t*)(t).WT + (size_t)((t).drow0 + n) * (t).K + (t).k0 + 8 * c) = o; } } \
            LDS_WAIT(); asm volatile("" ::: "memory"); } while (0)
    if (gw < NIT) {
        TItem ta, tb; f32x4 va[8], vb[8]; decode(gw, ta); P0_LOAD(ta, va);
        for (int it = gw; it < NIT; it += 2 * NGW) {
            const bool hb = it + NGW < NIT;
            if (hb) { decode(it + NGW, tb); P0_LOAD(tb, vb); }
            P0_PROC(ta, va);
            if (!hb) break;
            if (it + 2 * NGW < NIT) { decode(it + 2 * NGW, ta); P0_LOAD(ta, va); }
            P0_PROC(tb, vb);
        }
    }
#undef P0_PROC
#undef P0_LOAD
    __syncthreads();
    xpose_fp8(F, p2_fillers(F.G) > 0 ? 1 : 0, F.vcu, F.G);
    __syncthreads(); R7STAMP(33);
    { v4u* z = (v4u*)((bf16_t*)(ws + WS_WINT) + (size_t)3360 * 1024); const int n16 = 224 * 1024 * 2 / 16;
      for (int i = F.vcu * NTHR + F.tid; i < n16; i += F.G * NTHR) z[i] = (v4u){0u, 0u, 0u, 0u}; }
    { bf16_t* w2f = (bf16_t*)(ws + WS_W2T);
      for (int i = F.vcu * NTHR + F.tid; i < 2 * 256 * 64; i += F.G * NTHR) { const int kv = i >> 14, r = i & 16383, k = r >> 6, dd = r & 63; const float v = F.in[kv ? IN_W2V : IN_W2K][r];
          w2f[(size_t)kv * 16384 + ((size_t)((k >> 5) * 4 + (dd >> 4)) * 64 + ((k & 31) >> 3) * 16 + (dd & 15)) * 8 + (k & 7)] = f2bf(v); } }
    { bf16_t* hi = (bf16_t*)(ws + WS_RW); bf16_t* lo = hi + 64 * 1024; const float* rw = F.in[IN_RW];
      for (int i = F.vcu * NTHR + F.tid; i < 64 * 1024; i += F.G * NTHR) { const int k = i >> 6, e = i & 63; const float w = rw[i]; const bf16_t h = f2bf(w);
          const size_t o = ((size_t)((k >> 5) * 4 + (e >> 4)) * 64 + ((k & 31) >> 3) * 16 + (e & 15)) * 8 + (k & 7); hi[o] = h; lo[o] = f2bf(w - bf2f(h)); } }
}

__device__ __forceinline__ void p2_b1f(Frame& F) {
    unsigned char* ws = F.ws;
    for (int o = F.vcu * NWAVES + F.wave; o < 512; o += F.G * NWAVES) { const int kv = o >> 8, j = o & 255; const float* pe = F.in[kv ? IN_PEV : IN_PEK];
        const bf16_t* wf = (const bf16_t*)(ws + (kv ? WS_W1VT : WS_W1KT)); float a = 0.f;
#pragma unroll
        for (int i = 0; i < 4; ++i) { const int cid = F.lane + 64 * i, s = cid >> 2, q = cid & 3; const v4u wv = *(const v4u*)(wf + ((size_t)(s * 16 + (j >> 4)) * 64 + q * 16 + (j & 15)) * 8);
            const f32x4 p0 = *(const f32x4*)(pe + 32 * s + 8 * q), p1 = *(const f32x4*)(pe + 32 * s + 8 * q + 4);
            a += bf2f((bf16_t)(wv.x & 0xffff)) * p0[0] + bf2f((bf16_t)(wv.x >> 16)) * p0[1] + bf2f((bf16_t)(wv.y & 0xffff)) * p0[2] + bf2f((bf16_t)(wv.y >> 16)) * p0[3]
               + bf2f((bf16_t)(wv.z & 0xffff)) * p1[0] + bf2f((bf16_t)(wv.z >> 16)) * p1[1] + bf2f((bf16_t)(wv.w & 0xffff)) * p1[2] + bf2f((bf16_t)(wv.w >> 16)) * p1[3]; }
        a = wave_sum(a); if (F.lane == 0) ((float*)(ws + WS_B1F))[o] = a + F.in[kv ? IN_B1V : IN_B1K][j]; }
}
__device__ __forceinline__ void p1a_norm(Frame& F) {
    unsigned char* ws = F.ws; const float* modp = (const float*)(ws + WS_MODP); const float* bada = F.in[IN_BADA];
    if (F.tid == 0) { unsigned sp_ = 0u; while (__hip_atomic_load(F.ctl + CW_MODCNT, RLX_AGENT) < (unsigned)F.G && ++sp_ < (1u << 26)) __builtin_amdgcn_s_sleep(2); __builtin_amdgcn_fence(__ATOMIC_ACQUIRE, "agent"); }
    __syncthreads();
    for (int i = F.vcu * NTHR + F.tid; i < BATCH * 6144; i += F.G * NTHR) { float a = bada[i % 6144];
#pragma unroll
        for (int ks = 0; ks < 16; ++ks) a += modp[(size_t)ks * 4 * 6144 + i];
        ((float*)(ws + WS_MOD))[i] = a; }
    LAS float* sh = (LAS float*)F.lds; LAS float* sc = sh + 1024;
    const float* g1 = F.in[IN_N1G]; const float* x = F.in[IN_X]; bf16_t* xn = (bf16_t*)(ws + WS_XN);
    for (int chunk = F.vcu; chunk < T / 64; chunk += F.G) {
        const int b = (chunk * 64) / SEQ;
        __syncthreads();
#pragma unroll
        for (int i4 = 0; i4 < 2048 / NTHR; ++i4) { const int i = F.tid + NTHR * i4; const int col = i; float a = bada[col];
#pragma unroll
            for (int ks = 0; ks < 16; ++ks) a += modp[(size_t)(ks * 4 + b) * 6144 + col];
            sh[i] = a; }
        __syncthreads();
        f32x4 v[8][4];
#pragma unroll
        for (int rr = 0; rr < 8; ++rr) { const f32x4* xr = (const f32x4*)(x + (size_t)(chunk * 64 + F.wave * 8 + rr) * D) + F.lane;
#pragma unroll
            for (int j = 0; j < 4; ++j) v[rr][j] = xr[64 * j]; }
        __builtin_amdgcn_sched_barrier(0);
        f32x4 gs[4], sv[4];
#pragma unroll
        for (int j = 0; j < 4; ++j) { const int c0 = 4 * F.lane + 256 * j; const f32x4 g = *(const f32x4*)(g1 + c0); const f32x4 scv = *(const LAS f32x4*)(sc + c0); sv[j] = *(const LAS f32x4*)(sh + c0); gs[j] = g * (scv + 1.0f); }
#pragma unroll
        for (int rr = 0; rr < 8; ++rr) {
            const int row = chunk * 64 + F.wave * 8 + rr; float s = 0.f;
#pragma unroll
            for (int j = 0; j < 4; ++j) s += (v[rr][j].x * v[rr][j].x + v[rr][j].y * v[rr][j].y) + (v[rr][j].z * v[rr][j].z + v[rr][j].w * v[rr][j].w);
            const float rstd = 1.0f / sqrtf(wave_sum(s) * (1.0f / D) + EPS);
            unsigned long long* o8 = (unsigned long long*)(xn + (size_t)row * D) + F.lane;
#pragma unroll
            for (int j = 0; j < 4; ++j) { const f32x4 h = v[rr][j] * rstd * gs[j] + sv[j];
                o8[64 * j] = (unsigned long long)cvt_pk_bf16(h[0], h[1]) | ((unsigned long long)cvt_pk_bf16(h[2], h[3]) << 32); }
        }
    }
    __syncthreads();
}


__device__ __forceinline__ float hg_lb(const float* lbl, int j) { return 1.0f / (1.0f + expf(lbl[512 + j] - lbl[j])); }
__device__ __forceinline__ void hg_passA(Frame& F, int unit) {
    unsigned char* ws = F.ws; const bf16_t* proj = (const bf16_t*)(ws + WS_PROJ); float* U = (float*)(ws + WS_U) + (size_t)unit * 16384; float* Dd = (float*)(ws + WS_DD) + (size_t)unit * 128;
    const int b = unit >> 6, h = (unit >> 4) & 3, J = unit & 15; const size_t tok0 = (size_t)b * SEQ + 256 * J;
    const int d = F.tid & 127, g = F.tid >> 7;
    LAS unsigned char* KT = F.lds; LAS unsigned char* VT = F.lds + 65536; LAS float* segtot = (LAS float*)(F.lds + LDSCTL_OFF + 512);
    const float lb = hg_lb(F.in[IN_LBL], h * 128 + d);
    const bf16_t* pf = proj + (tok0 + 64 * g) * LDP + C_HF + h * 128 + d; const bf16_t* pv = proj + (tok0 + 64 * g) * LDP + C_HI + h * 128 + d;
    __syncthreads();
    float fs[64]; unsigned short vraw[64];
#pragma unroll
    for (int s = 0; s < 64; ++s) { fs[s] = bf2f(pf[(size_t)s * LDP]); vraw[s] = pv[(size_t)s * LDP]; }
    float prod = 1.f;
#pragma unroll
    for (int s = 0; s < 64; ++s) { const float f = lb + (1.0f - lb) * fsigmoid(fs[s]); fs[s] = f; prod *= f; }
    segtot[g * 128 + d] = prod;
    __syncthreads();
    float tail = 1.f, Bt = 1.f;
#pragma unroll
    for (int k = 0; k < 4; ++k) { const float v = segtot[k * 128 + d]; Bt *= v; if (k > g) tail *= v; }
    float run = tail;
#pragma unroll
    for (int s8 = 7; s8 >= 0; --s8) { unsigned kk[4], vv[4];
#pragma unroll
        for (int i = 3; i >= 0; --i) { float kt[2];
#pragma unroll
            for (int j = 1; j >= 0; --j) { const int s = 8 * s8 + 2 * i + j; const float f = fs[s]; kt[j] = (1.0f - f) * run; run *= f; }
            kk[i] = pk2(kt[0], kt[1]); vv[i] = (unsigned)vraw[8 * s8 + 2 * i] | ((unsigned)vraw[8 * s8 + 2 * i + 1] << 16); }
        const int c = (8 * g + s8) ^ (d & 31);
        *(LAS v4u*)(KT + d * 512 + c * 16) = (v4u){kk[0], kk[1], kk[2], kk[3]}; *(LAS v4u*)(VT + d * 512 + c * 16) = (v4u){vv[0], vv[1], vv[2], vv[3]}; }
    if (g == 0) __hip_atomic_store(Dd + d, Bt, RLX_AGENT);
    __syncthreads();
    const int dt = F.wave >> 1, et0 = 2 * (F.wave & 1), i = F.lane & 31, hh = F.lane >> 5;
    f32x16 acc[2];
#pragma unroll
    for (int k = 0; k < 16; ++k) { acc[0][k] = 0.f; acc[1][k] = 0.f; }
#pragma unroll 4
    for (int st = 0; st < 16; ++st) { const int ch = 2 * st + hh;
        const bf16x8 a = *(const LAS bf16x8*)(KT + (32 * dt + i) * 512 + ((ch ^ i) & 31) * 16);
#pragma unroll
        for (int t = 0; t < 2; ++t) { const bf16x8 bv = *(const LAS bf16x8*)(VT + (32 * (et0 + t) + i) * 512 + ((ch ^ i) & 31) * 16);
            acc[t] = __builtin_amdgcn_mfma_f32_32x32x16_bf16(a, bv, acc[t], 0, 0, 0); } }
#pragma unroll
    for (int t = 0; t < 2; ++t)
#pragma unroll
        for (int r = 0; r < 16; ++r) __hip_atomic_store(U + (size_t)(32 * dt + (r & 3) + 8 * (r >> 2) + 4 * hh) * 128 + 32 * (et0 + t) + i, acc[t][r], RLX_AGENT);
    asm volatile("s_waitcnt vmcnt(0)" ::: "memory");
    __syncthreads();
    if (F.tid == 0) __hip_atomic_fetch_add(F.ctl + CW_HGCNT + (unit >> 4), 1u, RLX_AGENT);
}
__device__ __forceinline__ unsigned short bf16_rne(float x) { return (unsigned short)(cvt_pk_bf16(x, 0.f) & 0xffffu); }
__device__ __forceinline__ void hg_scan(Frame& F, int wg) {
    float* Uall = (float*)(F.ws + WS_U); const float* Dall = (const float*)(F.ws + WS_DD);
    const int bh = wg >> 4, rblk = wg & 15, unit0 = (bh >> 2) * 64 + (bh & 3) * 16;
    if (F.tid == 0) { unsigned sp_ = 0u; while (__hip_atomic_load(F.ctl + CW_HGCNT + bh, RLX_AGENT) < 16u && ++sp_ < (1u << 26)) __builtin_amdgcn_s_sleep(2); __builtin_amdgcn_fence(__ATOMIC_ACQUIRE, "agent"); }
    __syncthreads();
    if (F.tid < 256) { const int row = 8 * rblk + (F.tid >> 5), col = (F.tid & 31) * 4;
        f32x4 u[15]; float dj[15];
#pragma unroll
        for (int j = 0; j < 15; ++j) { u[j] = __builtin_nontemporal_load((const f32x4*)(Uall + (size_t)(unit0 + j) * 16384 + (size_t)row * 128 + col)); dj[j] = __builtin_nontemporal_load(Dall + (size_t)(unit0 + j) * 128 + row); }
        f32x4 acc = (f32x4){0.f, 0.f, 0.f, 0.f};
#pragma unroll
        for (int j = 0; j < 15; ++j) { acc = acc * dj[j] + u[j]; *(f32x4*)(Uall + (size_t)(unit0 + j) * 16384 + (size_t)row * 128 + col) = acc; } }
}
__device__ __forceinline__ void hg_passC(Frame& F, int unit) {
    unsigned char* ws = F.ws; const bf16_t* proj = (const bf16_t*)(ws + WS_PROJ); bf16_t* mix = (bf16_t*)(ws + WS_MIX);
    const float* Uall = (const float*)(ws + WS_U); const float* Dall = (const float*)(ws + WS_DD);
    const int b = unit >> 6, h = (unit >> 4) & 3, J = unit & 15; const size_t tok0 = (size_t)b * SEQ + 256 * J;
    const int w = F.wave, n = F.lane & 15, q = F.lane >> 4;
    LAS bf16_t* QS = (LAS bf16_t*)F.lds; LAS bf16_t* KH = (LAS bf16_t*)(F.lds + 17408); LAS bf16_t* KT = (LAS bf16_t*)(F.lds + 34816); LAS bf16_t* VT = (LAS bf16_t*)(F.lds + 59392);
    LAS float* G = (LAS float*)(F.lds + 83968); LAS unsigned char* PT = F.lds + 86016; LAS float* SSP = (LAS float*)(F.lds + 88064);
    f32x4 S[8];
#pragma unroll
    for (int dt = 0; dt < 8; ++dt) S[dt] = (f32x4){0.f, 0.f, 0.f, 0.f};
    if (J > 0) { const float* S0 = Uall + (size_t)(unit - 1) * 16384;
#pragma unroll
        for (int dt = 0; dt < 8; ++dt)
#pragma unroll
            for (int r = 0; r < 4; ++r) S[dt][r] = S0[(size_t)(16 * dt + 4 * q + r) * 128 + 16 * w + n]; }
    __syncthreads();
    const int d = F.tid & 127, bk = F.tid >> 7; const float lb = hg_lb(F.in[IN_LBL], h * 128 + d);
    const int e0 = h * 128 + 16 * w + 4 * q; const f32x4 ng = *(const f32x4*)(F.in[IN_HNG] + e0);
    unsigned short rf[16], rq[16], rv[16]; v2u rg[4];
#define HG_LOAD(qt_) do { const bf16_t* pr_ = proj + (tok0 + 64 * (qt_) + 16 * bk) * LDP + h * 128 + d; \
        _Pragma("unroll") for (int i = 0; i < 16; ++i) { rf[i] = pr_[(size_t)i * LDP + C_HF]; rq[i] = pr_[(size_t)i * LDP + C_HQ]; rv[i] = pr_[(size_t)i * LDP + C_HI]; } \
        _Pragma("unroll") for (int bb = 0; bb < 4; ++bb) rg[bb] = *(const v2u*)(proj + (tok0 + 64 * (qt_) + 16 * bb + n) * LDP + C_HGT + e0); } while (0)
    HG_LOAD(0);
#pragma unroll 1
    for (int qt = 0; qt < 4; ++qt) {
        const size_t t0 = tok0 + 64 * qt;
        { float fv[16], E[16]; float run = 1.f;
#pragma unroll
          for (int i = 0; i < 16; ++i) { const float f = lb + (1.0f - lb) * fsigmoid(bf2f(rf[i])); fv[i] = f; run *= f; E[i] = run; }
          const float cc = run; unsigned kt[8], vv[8];
#pragma unroll
          for (int i = 0; i < 16; ++i) { const float inv = __builtin_amdgcn_rcpf(E[i]), kf = 1.0f - fv[i];
              QS[(bk * 16 + i) * 136 + d] = bf16_rne(bf2f(rq[i]) * 0.08838834764831845f * E[i]); KH[(bk * 16 + i) * 136 + d] = bf16_rne(kf * inv);
              const unsigned kb = bf16_rne(kf * cc * inv);
              if (i & 1) { kt[i >> 1] |= kb << 16; vv[i >> 1] |= (unsigned)rv[i] << 16; } else { kt[i >> 1] = kb; vv[i >> 1] = rv[i]; } }
          LAS v4u* kp = (LAS v4u*)(KT + (bk * 128 + d) * 24); kp[0] = (v4u){kt[0], kt[1], kt[2], kt[3]}; kp[1] = (v4u){kt[4], kt[5], kt[6], kt[7]};
          LAS v4u* vp = (LAS v4u*)(VT + (bk * 128 + d) * 24); vp[0] = (v4u){vv[0], vv[1], vv[2], vv[3]}; vp[1] = (v4u){vv[4], vv[5], vv[6], vv[7]};
          G[bk * 128 + d] = cc; }
        v2u gq[4];
#pragma unroll
        for (int bb = 0; bb < 4; ++bb) gq[bb] = rg[bb];
        if (qt < 3) HG_LOAD(qt + 1);
        __syncthreads();
        if (w < 4) { f32x4 pt = (f32x4){0.f, 0.f, 0.f, 0.f};
#pragma unroll
            for (int st = 0; st < 4; ++st) { const bf16x8 a = *(const LAS bf16x8*)(KH + (w * 16 + n) * 136 + 32 * st + 8 * q), bq = *(const LAS bf16x8*)(QS + (w * 16 + n) * 136 + 32 * st + 8 * q);
                pt = __builtin_amdgcn_mfma_f32_16x16x32_bf16(a, bq, pt, 0, 0, 0); }
            v2u o; o.x = cvt_pk_bf16((4 * q + 0) <= n ? pt[0] : 0.f, (4 * q + 1) <= n ? pt[1] : 0.f); o.y = cvt_pk_bf16((4 * q + 2) <= n ? pt[2] : 0.f, (4 * q + 3) <= n ? pt[3] : 0.f);
            *(LAS v2u*)(PT + (w * 64 + F.lane) * 8) = o; }
        __syncthreads();
        f32x4 ob[4]; float ssb[4];
#pragma unroll
        for (int bb = 0; bb < 4; ++bb) {
            f32x4 o = (f32x4){0.f, 0.f, 0.f, 0.f};
#pragma unroll
            for (int st = 0; st < 4; ++st) {
                const v2u s0 = (v2u){cvt_pk_bf16(S[2 * st][0], S[2 * st][1]), cvt_pk_bf16(S[2 * st][2], S[2 * st][3])}, s1 = (v2u){cvt_pk_bf16(S[2 * st + 1][0], S[2 * st + 1][1]), cvt_pk_bf16(S[2 * st + 1][2], S[2 * st + 1][3])};
                const bf16x8 a = __builtin_bit_cast(bf16x8, (v4u){s0.x, s0.y, s1.x, s1.y});
                const v2u q0 = *(const LAS v2u*)(QS + (bb * 16 + n) * 136 + 32 * st + 4 * q), q1 = *(const LAS v2u*)(QS + (bb * 16 + n) * 136 + 32 * st + 16 + 4 * q);
                const bf16x8 bq = __builtin_bit_cast(bf16x8, (v4u){q0.x, q0.y, q1.x, q1.y});
                o = __builtin_amdgcn_mfma_f32_16x16x32_bf16(a, bq, o, 0, 0, 0); }
            { const v2u va = *(const LAS v2u*)(VT + (bb * 128 + 16 * w + n) * 24 + 4 * q); const bf16x8 a = __builtin_bit_cast(bf16x8, (v4u){va.x, va.y, 0u, 0u});
              const v2u pb = *(const LAS v2u*)(PT + (bb * 64 + F.lane) * 8); const bf16x8 pB = __builtin_bit_cast(bf16x8, (v4u){pb.x, pb.y, 0u, 0u});
              o = __builtin_amdgcn_mfma_f32_16x16x32_bf16(a, pB, o, 0, 0, 0); }
            { bf16x8 bv; if (q < 2) bv = *(const LAS bf16x8*)(VT + (bb * 128 + 16 * w + n) * 24 + 8 * q); else bv = (bf16x8){0, 0, 0, 0, 0, 0, 0, 0};
#pragma unroll
              for (int dt = 0; dt < 8; ++dt) { const f32x4 gv = *(const LAS f32x4*)(G + bb * 128 + 16 * dt + 4 * q); S[dt] = S[dt] * gv;
                  bf16x8 a; if (q < 2) a = *(const LAS bf16x8*)(KT + (bb * 128 + 16 * dt + n) * 24 + 8 * q); else a = (bf16x8){0, 0, 0, 0, 0, 0, 0, 0};
                  S[dt] = __builtin_amdgcn_mfma_f32_16x16x32_bf16(a, bv, S[dt], 0, 0, 0); } }
            float ss = (o[0] * o[0] + o[1] * o[1]) + (o[2] * o[2] + o[3] * o[3]); ss += __shfl_xor(ss, 16); ss += __shfl_xor(ss, 32);
            ob[bb] = o; ssb[bb] = ss;
        }
        if (q == 0) {
#pragma unroll
            for (int bb = 0; bb < 4; ++bb) SSP[w * 64 + 16 * bb + n] = ssb[bb]; }
        __syncthreads();
#pragma unroll
        for (int bb = 0; bb < 4; ++bb) { float tots = 0.f;
#pragma unroll
            for (int k = 0; k < 8; ++k) tots += SSP[k * 64 + 16 * bb + n];
            const float rstd = 1.0f / sqrtf(tots * (1.0f / 128.0f) + EPS); const v2u gt = gq[bb];
            const float g0 = bf2f((bf16_t)(gt.x & 0xffff)), g1 = bf2f((bf16_t)(gt.x >> 16)), g2 = bf2f((bf16_t)(gt.y & 0xffff)), g3 = bf2f((bf16_t)(gt.y >> 16));
            v2u ov; ov.x = cvt_pk_bf16(ob[bb][0] * rstd * ng[0] * fsilu(g0), ob[bb][1] * rstd * ng[1] * fsilu(g1)); ov.y = cvt_pk_bf16(ob[bb][2] * rstd * ng[2] * fsilu(g2), ob[bb][3] * rstd * ng[3] * fsilu(g3));
            *(v2u*)(mix + (t0 + 16 * bb + n) * D + e0) = ov; }
    }
#undef HG_LOAD
    __syncthreads();
}

#ifndef PROBE_TIME
#define PROBE_TIME -1
#endif
constexpr int LG_P = 65;
__device__ __forceinline__ void p5_router(Frame& F) {
    unsigned char* ws = F.ws; const bf16_t* x2 = (const bf16_t*)(ws + WS_X2); const float* mod = (const float*)(ws + WS_MOD); const float* g2 = F.in[IN_N2G];
    const bf16_t* rwh = (const bf16_t*)(ws + WS_RW); const bf16_t* rwl = rwh + 64 * 1024; bf16_t* H2 = (bf16_t*)(ws + WS_H2);
    int* TOPI = (int*)(ws + WS_TOPI); float* TOPW = (float*)(ws + WS_TOPW); int* ROWL = (int*)(ws + WS_ROWL); int* ERANK = (int*)(ws + WS_ERANK); unsigned* ECNT = F.ctl + CW_ECNT;
    LAS float* LG = (LAS float*)F.lds;
    LAS float* GS = LG + 64 * LG_P;
    LAS float* WSL = GS + 512;
    LAS int* EI = (LAS int*)(WSL + 512);
    LAS unsigned* LCNT = (LAS unsigned*)(EI + 512);
    LAS unsigned* LBASE = LCNT + 64;
    LAS float* GSL = (LAS float*)(LBASE + 64);
    LAS float* SHL = GSL + 1024;
    LAS unsigned long long* KEY = (LAS unsigned long long*)(F.lds + 65536);
    const int r = F.lane & 15, q = F.lane >> 4, rt = F.wave & 3, eh = F.wave >> 2;
    for (int unit = F.vcu; unit < T / 64; unit += F.G) {
        const int row0 = unit * 64, b = row0 / SEQ, row = row0 + 16 * rt + r;
        __syncthreads();
        R7STAMP(20);
        if (F.tid < 64) LCNT[F.tid] = 0u;
        for (int k = F.tid; k < 1024; k += NTHR) { GSL[k] = g2[k] * (1.0f + mod[(size_t)b * 6144 + 4 * 1024 + k]); SHL[k] = mod[(size_t)b * 6144 + 3 * 1024 + k]; }
        const bf16_t* xr = x2 + (size_t)row * D + 8 * q;
        float ss; { const f32x4* sp = (const f32x4*)((const float*)(ws + WS_SSQ) + (size_t)row * 16); const f32x4 s0 = sp[0], s1 = sp[1], s2 = sp[2], s3 = sp[3];
            ss = ((s0[0] + s0[1]) + (s0[2] + s0[3])) + ((s1[0] + s1[1]) + (s1[2] + s1[3])) + ((s2[0] + s2[1]) + (s2[2] + s2[3])) + ((s3[0] + s3[1]) + (s3[2] + s3[3])); }
        const float rstd = 1.0f / sqrtf(ss * (1.0f / D) + EPS);
        __syncthreads();
#ifndef PROBE_R7
#define PROBE_R7 0
#endif
        f32x4 acc[2];
        for (int rep7_ = 0; rep7_ <= PROBE_R7; ++rep7_) {
        acc[0] = (f32x4){0.f, 0.f, 0.f, 0.f}; acc[1] = acc[0];
        const bf16_t* rwh0 = rwh + ((size_t)(2 * eh) * 64 + F.lane) * 8; const bf16_t* rwl0 = rwl + ((size_t)(2 * eh) * 64 + F.lane) * 8;
#pragma unroll 1
        for (int s4 = 0; s4 < 32; s4 += 4) {
            f32x4 xa[4][2]; v4u xraw[4]; bf16x8 bh[4][2], bl[4][2];
#pragma unroll
            for (int u = 0; u < 4; ++u) { const int s = s4 + u; xraw[u] = *(const v4u*)(xr + 32 * s);
                bh[u][0] = *(const bf16x8*)(rwh0 + (size_t)s * 2048); bl[u][0] = *(const bf16x8*)(rwl0 + (size_t)s * 2048); bh[u][1] = *(const bf16x8*)(rwh0 + (size_t)s * 2048 + 512); bl[u][1] = *(const bf16x8*)(rwl0 + (size_t)s * 2048 + 512); }
            __builtin_amdgcn_sched_barrier(0);
#pragma unroll
            for (int u = 0; u < 4; ++u) { const int s = s4 + u; float gv[8], sh[8];
                xa[u][0] = (f32x4){__uint_as_float(xraw[u].x << 16), __uint_as_float(xraw[u].x & 0xffff0000u), __uint_as_float(xraw[u].y << 16), __uint_as_float(xraw[u].y & 0xffff0000u)}; xa[u][1] = (f32x4){__uint_as_float(xraw[u].z << 16), __uint_as_float(xraw[u].z & 0xffff0000u), __uint_as_float(xraw[u].w << 16), __uint_as_float(xraw[u].w & 0xffff0000u)};
                *(f32x4*)&gv[0] = *(const LAS f32x4*)(GSL + 32 * s + 8 * q); *(f32x4*)&gv[4] = *(const LAS f32x4*)(GSL + 32 * s + 8 * q + 4);
                *(f32x4*)&sh[0] = *(const LAS f32x4*)(SHL + 32 * s + 8 * q); *(f32x4*)&sh[4] = *(const LAS f32x4*)(SHL + 32 * s + 8 * q + 4);
                bf16x8 ahi, alo; float hf[8];
#pragma unroll
                for (int j = 0; j < 8; ++j) { const float h = xa[u][j >> 2][j & 3] * rstd * gv[j] + sh[j]; hf[j] = h; const bf16_t hb = f2bf(h); ahi[j] = (short)hb; alo[j] = (short)f2bf(h - bf2f(hb)); }
                if (eh == 0) *(v2u*)((unsigned char*)H2 + (size_t)row * D + 32 * s + 8 * q) = (v2u){pk4_e4m3(hf[0], hf[1], hf[2], hf[3], 1.0f), pk4_e4m3(hf[4], hf[5], hf[6], hf[7], 1.0f)};
                acc[0] = __builtin_amdgcn_mfma_f32_16x16x32_bf16(ahi, bh[u][0], acc[0], 0, 0, 0); acc[0] = __builtin_amdgcn_mfma_f32_16x16x32_bf16(ahi, bl[u][0], acc[0], 0, 0, 0); acc[0] = __builtin_amdgcn_mfma_f32_16x16x32_bf16(alo, bh[u][0], acc[0], 0, 0, 0);
                acc[1] = __builtin_amdgcn_mfma_f32_16x16x32_bf16(ahi, bh[u][1], acc[1], 0, 0, 0); acc[1] = __builtin_amdgcn_mfma_f32_16x16x32_bf16(ahi, bl[u][1], acc[1], 0, 0, 0); acc[1] = __builtin_amdgcn_mfma_f32_16x16x32_bf16(alo, bh[u][1], acc[1], 0, 0, 0); }
        }
        }
#pragma unroll
        for (int nt = 0; nt < 2; ++nt)
#pragma unroll
            for (int i = 0; i < 4; ++i) LG[(16 * rt + 4 * q + i) * LG_P + 32 * eh + 16 * nt + r] = acc[nt][i];
        __syncthreads();
        R7STAMP(21);
        const int t = F.tid >> 3, g = F.tid & 7; const float* rb = F.in[IN_RB];
        float sc8[8]; unsigned long long key8[8]; float a1 = -3e38f, a2 = -3e38f;
#pragma unroll
        for (int j = 0; j < 8; ++j) { const float s_ = fsigmoid(LG[t * LG_P + 8 * g + j]); sc8[j] = s_; const float c_ = s_ + rb[8 * g + j]; if (c_ > a1) { a2 = a1; a1 = c_; } else if (c_ > a2) a2 = c_;
            unsigned ub = __float_as_uint(c_); ub = (ub & 0x80000000u) ? ~ub : (ub | 0x80000000u);
            key8[j] = ((unsigned long long)ub << 8) | (unsigned)(63 - (8 * g + j)); }
        GS[t * 8 + g] = a1 + a2;
        __syncthreads();
#pragma unroll
        for (int j = 0; j < 8; ++j) KEY[t * 64 + 8 * g + j] = key8[j];
        int grank = 0; const float myg = GS[t * 8 + g];
#pragma unroll
        for (int k = 0; k < 8; ++k) { const float o = GS[t * 8 + k]; if (o > myg || (o == myg && k < g)) ++grank; }
        const bool gsel = grank < 4;
        const unsigned long long bal = __ballot(gsel); const unsigned gmask = (unsigned)(bal >> (F.lane & ~7)) & 0xffu;
        __syncthreads();
        if (gsel) {
            int rk[8];
#pragma unroll
            for (int j = 0; j < 8; ++j) rk[j] = 0;
            for (int k = 0; k < 8; ++k) { if (!((gmask >> k) & 1u)) continue;
#pragma unroll
                for (int jj = 0; jj < 8; ++jj) { const unsigned long long o = KEY[t * 64 + 8 * k + jj];
#pragma unroll
                    for (int j = 0; j < 8; ++j) rk[j] += (o > key8[j]) ? 1 : 0; } }
#pragma unroll
            for (int j = 0; j < 8; ++j) if (rk[j] < 8) { WSL[t * 8 + rk[j]] = sc8[j]; EI[t * 8 + rk[j]] = 8 * g + j; }
        }
        __syncthreads();
        float wsum = 0.f;
#pragma unroll
        for (int k = 0; k < 8; ++k) wsum += WSL[t * 8 + k];
        const int e = EI[t * 8 + g]; const float w = WSL[t * 8 + g] / wsum * 2.5f;
        const int aid = (row0 + t) * 8 + g;
        R7STAMP(22);
        TOPI[aid] = e; TOPW[aid] = w;
        const unsigned lp = atomicAdd((unsigned*)&LCNT[e], 1u);
        __syncthreads();
        if (F.tid < 64) { const unsigned c = LCNT[F.tid]; LBASE[F.tid] = c ? atomicAdd(&ECNT[F.tid], c) : 0u; }
        __syncthreads();
        { const unsigned rk = LBASE[e] + lp; ROWL[(size_t)e * T + rk] = aid; ERANK[aid] = (int)rk; }
        R7STAMP(23);
    }
    __syncthreads();
}


struct MoeTabs { LAS unsigned* cnt; LAS unsigned* tstart; LAS unsigned short* tex; int ntr; };
__device__ __forceinline__ MoeTabs moe_tabs_build(Frame& F) {
    MoeTabs Tb; Tb.cnt = (LAS unsigned*)(F.lds + LDSCTL_OFF + 512); Tb.tstart = Tb.cnt + 64; Tb.tex = (LAS unsigned short*)(Tb.tstart + 68);
    __syncthreads();
    if (F.tid < 64) { unsigned c = __hip_atomic_load(F.ctl + CW_ECNT + F.tid, RLX_AGENT); Tb.cnt[F.tid] = c > (unsigned)T ? (unsigned)T : c; }
    __syncthreads();
    if (F.tid == 0) { unsigned a = 0; for (int e = 0; e < 64; ++e) { Tb.tstart[e] = a; a += (Tb.cnt[e] + 255u) >> 8; } Tb.tstart[64] = a; }
    __syncthreads();
    Tb.ntr = (int)Tb.tstart[64];
    for (int tau = F.tid; tau < Tb.ntr; tau += NTHR) { int e = 0; for (int k = 0; k < 64; ++k) if (Tb.tstart[k] <= (unsigned)tau) e = k; Tb.tex[tau] = (unsigned short)e; }
    __syncthreads();
    return Tb;
}
__device__ __forceinline__ int xcd_chunk(int L, int n) { const int q = n / 8, r = n % 8, xcd = L % 8, off = L / 8; return (xcd < r ? xcd * (q + 1) : r * (q + 1) + (xcd - r) * q) + off; }
struct GateUpSched {
    MoeTabs Tb; const char* H2; const char* Wgu; const char* Wsgu; const int* rowl; int G, c;
    __device__ __forceinline__ bool next(int i, gm::Unit& u) const {
        const int nun = 2 * Tb.ntr + 2 * (T / 256); const long L = (long)i * G + c; if (L >= nun) return false;
        const int w = xcd_chunk((int)L, nun); u.A = H2;
        if (w < 2 * Tb.ntr) { const int tau = w >> 1; u.pn = w & 1; u.e = Tb.tex[tau]; u.m0 = 256 * (tau - (int)Tb.tstart[u.e]); u.pm = tau; u.B = Wgu + (size_t)u.e * 512 * 1024 + (size_t)u.pn * 256 * 1024; }
        else { const int s = w - 2 * Tb.ntr; u.pm = s >> 1; u.pn = s & 1; u.e = 64; u.m0 = 256 * u.pm; u.B = Wsgu + (size_t)u.pn * 256 * 1024; }
        return true;
    }
    __device__ __forceinline__ unsigned arow(const gm::Unit& u, int r) const {
        if (u.e == 64) return (unsigned)(u.m0 + r) * 1024u;
        const int idx = u.m0 + r; const int aid = idx < (int)Tb.cnt[u.e] ? rowl[(size_t)u.e * T + idx] : 0;
        return (unsigned)(aid >> 3) * 1024u;
    }
};
struct EpiSwiglu {
    static constexpr bool PERM = true;
    unsigned char* act; unsigned char* acts;
    __device__ __forceinline__ void operator()(const f32x4 (&acc)[2][2][4][2], const gm::Unit& u, int wr, int wc, int fr, int fq) const {
        const int odd = fq & 1;
        unsigned char* O = (u.e == 64 ? acts : act) + (size_t)(u.pm * 256 + wr * 64 + fr) * 256 + 128 * u.pn + wc * 32 + 8 * (fq - odd); const float is = 1.0f / WGU_SCALE;
#pragma unroll
        for (int ai = 0; ai < 2; ++ai)
#pragma unroll
            for (int mp = 0; mp < 2; ++mp) { v2u pk[2];
#pragma unroll
                for (int mm = 0; mm < 2; ++mm) { const int m = 2 * mp + mm; const f32x4 g0 = acc[ai][0][m][0] * is, g1 = acc[ai][0][m][1] * is, u0 = acc[ai][1][m][0] * is, u1 = acc[ai][1][m][1] * is;
                    pk[mm] = (v2u){pk4_e4m3(fsilu(g0[0]) * u0[0], fsilu(g0[1]) * u0[1], fsilu(g0[2]) * u0[2], fsilu(g0[3]) * u0[3], ACT_SCALE),
                                   pk4_e4m3(fsilu(g1[0]) * u1[0], fsilu(g1[1]) * u1[1], fsilu(g1[2]) * u1[2], fsilu(g1[3]) * u1[3], ACT_SCALE)}; }
                const v2u snd = odd ? pk[0] : pk[1]; const v2u rcv = (v2u){(unsigned)__builtin_amdgcn_ds_swizzle((int)snd.x, 0x401f), (unsigned)__builtin_amdgcn_ds_swizzle((int)snd.y, 0x401f)}    ;
                const v4u o = odd ? (v4u){rcv.x, rcv.y, pk[1].x, pk[1].y} : (v4u){pk[0].x, pk[0].y, rcv.x, rcv.y};
                *(v4u*)(O + (size_t)(ai * 128 + (2 * mp + odd) * 16) * 256) = o; }
    }
};
struct DownSched {
    MoeTabs Tb; const char* act; const char* acts; const char* Wdn; const char* Wsdn; int G, c;
    __device__ __forceinline__ bool next(int i, gm::Unit& u) const {
        const int nun = 4 * Tb.ntr + 4 * (T / 256); const long L = (long)i * G + c; if (L >= nun) return false;
        const int w = xcd_chunk((int)L, nun);
        if (w < 4 * Tb.ntr) { const int tau = w >> 2; u.pn = w & 3; u.e = Tb.tex[tau]; u.m0 = 256 * (tau - (int)Tb.tstart[u.e]); u.pm = tau;
            u.A = act + (size_t)tau * 256 * 256; u.B = Wdn + (size_t)u.e * 1024 * 256 + (size_t)u.pn * 256 * 256; }
        else { const int s = w - 4 * Tb.ntr; u.pm = s >> 2; u.pn = s & 3; u.e = 64; u.m0 = 256 * u.pm; u.A = acts + (size_t)u.pm * 256 * 256; u.B = Wsdn + (size_t)u.pn * 256 * 256; }
        return true;
    }
    __device__ __forceinline__ unsigned arow(const gm::Unit&, int r) const { return (unsigned)r * 256u; }
};
typedef float f32x2_t __attribute__((ext_vector_type(2)));
__device__ __forceinline__ unsigned pk4_fp8(float a, float b, float c, float d) {
    a = fminf(fmaxf(a * 16.0f, -448.0f), 448.0f); b = fminf(fmaxf(b * 16.0f, -448.0f), 448.0f); c = fminf(fmaxf(c * 16.0f, -448.0f), 448.0f); d = fminf(fmaxf(d * 16.0f, -448.0f), 448.0f);
    int w = __builtin_amdgcn_cvt_pk_fp8_f32(a, b, 0, false); w = __builtin_amdgcn_cvt_pk_fp8_f32(c, d, w, true); return (unsigned)w;
}
struct EpiDown {
    static constexpr bool PERM = true;
    unsigned char* Y8; unsigned char* YS;
    __device__ __forceinline__ void operator()(const f32x4 (&acc)[2][2][4][2], const gm::Unit& u, int wr, int wc, int fr, int fq) const {
        const int odd = fq & 1;
        unsigned char* O = (u.e == 64 ? YS : Y8) + (size_t)(u.pm * 256 + wr * 64 + fr) * 1024 + u.pn * 256 + wc * 32 + 8 * (fq - odd);
        const float sc = 16.0f / (WDN_SCALE * ACT_SCALE);
#pragma unroll
        for (int ai = 0; ai < 2; ++ai)
#pragma unroll
            for (int mp = 0; mp < 2; ++mp)
#pragma unroll
                for (int bj = 0; bj < 2; ++bj) {
                    const f32x4 a0 = acc[ai][bj][2 * mp][0], a1 = acc[ai][bj][2 * mp][1], b0 = acc[ai][bj][2 * mp + 1][0], b1 = acc[ai][bj][2 * mp + 1][1];
                    const v2u p0 = (v2u){pk4_e4m3(a0[0], a0[1], a0[2], a0[3], sc), pk4_e4m3(a1[0], a1[1], a1[2], a1[3], sc)}, p1 = (v2u){pk4_e4m3(b0[0], b0[1], b0[2], b0[3], sc), pk4_e4m3(b1[0], b1[1], b1[2], b1[3], sc)};
                    const v2u snd = odd ? p0 : p1; const v2u rcv = (v2u){(unsigned)__builtin_amdgcn_ds_swizzle((int)snd.x, 0x401f), (unsigned)__builtin_amdgcn_ds_swizzle((int)snd.y, 0x401f)}    ;
                    const v4u o = odd ? (v4u){rcv.x, rcv.y, p1.x, p1.y} : (v4u){p0.x, p0.y, rcv.x, rcv.y};
                    *(v4u*)(O + (size_t)(ai * 128 + (2 * mp + odd) * 16) * 1024 + bj * 128) = o; }
    }
};

__device__ __forceinline__ void p8_final(Frame& F) {
    unsigned char* ws = F.ws; const unsigned char* Y = (const unsigned char*)(ws + WS_Y); const unsigned char* YS = (const unsigned char*)(ws + WS_YS);
    const bf16_t* x2 = (const bf16_t*)(ws + WS_X2); const float* mod = (const float*)(ws + WS_MOD); const float* fg = F.in[IN_FG];
    const int* TOPI = (const int*)(ws + WS_TOPI); const float* TOPW = (const float*)(ws + WS_TOPW); const int* ERANK = (const int*)(ws + WS_ERANK);
    const MoeTabs Tb = moe_tabs_build(F);
    const int w = F.wave;
    for (int unit = F.vcu; unit < T / 64; unit += F.G) {
        const int row0 = unit * 64 + 8 * w, b = row0 / SEQ;
        const int aid = row0 * 8 + F.lane; const int e = TOPI[aid]; const float wl = TOPW[aid]; const unsigned prl = 256u * Tb.tstart[e] + (unsigned)ERANK[aid];
        v2u ybA[8]; v2u ysA; v2u ybB[8]; v2u ysB;
#define P10_LOAD(yb, ysb, rr_, sg_) do { const int t_ = row0 + (rr_); _Pragma("unroll") for (int sl = 0; sl < 8; ++sl) { const unsigned pr_ = (unsigned)__shfl((int)prl, (rr_) * 8 + sl); \
            yb[sl] = *(const v2u*)(Y + (size_t)pr_ * 1024 + (sg_) * 512 + 8 * F.lane); } \
            ysb = *(const v2u*)(YS + (size_t)t_ * 1024 + (sg_) * 512 + 8 * F.lane); } while (0)
#define P10_HALF(yb, ysb, rr_, sg_) do { const int t = row0 + (rr_); float moe[8]; \
            { const f32x2_t d0 = __builtin_amdgcn_cvt_pk_f32_fp8((int)ysb.x, false), d1 = __builtin_amdgcn_cvt_pk_f32_fp8((int)ysb.x, true), d2 = __builtin_amdgcn_cvt_pk_f32_fp8((int)ysb.y, false), d3 = __builtin_amdgcn_cvt_pk_f32_fp8((int)ysb.y, true); \
              moe[0] = 0.0625f * d0[0]; moe[1] = 0.0625f * d0[1]; moe[2] = 0.0625f * d1[0]; moe[3] = 0.0625f * d1[1]; moe[4] = 0.0625f * d2[0]; moe[5] = 0.0625f * d2[1]; moe[6] = 0.0625f * d3[0]; moe[7] = 0.0625f * d3[1]; } \
            _Pragma("unroll") for (int sl = 0; sl < 8; ++sl) { const float wgt = __shfl(wl, (rr_) * 8 + sl) * 0.0625f; \
                const f32x2_t d0 = __builtin_amdgcn_cvt_pk_f32_fp8((int)yb[sl].x, false), d1 = __builtin_amdgcn_cvt_pk_f32_fp8((int)yb[sl].x, true), d2 = __builtin_amdgcn_cvt_pk_f32_fp8((int)yb[sl].y, false), d3 = __builtin_amdgcn_cvt_pk_f32_fp8((int)yb[sl].y, true); \
                moe[0] += wgt * d0[0]; moe[1] += wgt * d0[1]; moe[2] += wgt * d1[0]; moe[3] += wgt * d1[1]; moe[4] += wgt * d2[0]; moe[5] += wgt * d2[1]; moe[6] += wgt * d3[0]; moe[7] += wgt * d3[1]; } \
            const v4u xw_ = *(const v4u*)(x2 + (size_t)t * D + (sg_) * 512 + 8 * F.lane); \
            _Pragma("unroll") for (int h = 0; h < 2; ++h) { const int c0 = (sg_) * 512 + 8 * F.lane + 4 * h; const unsigned w0_ = h ? xw_.z : xw_.x, w1_ = h ? xw_.w : xw_.y; \
                const f32x4 xv = (f32x4){__uint_as_float(w0_ << 16), __uint_as_float(w0_ & 0xffff0000u), __uint_as_float(w1_ << 16), __uint_as_float(w1_ & 0xffff0000u)}, gv = *(const f32x4*)(mod + (size_t)b * 6144 + 5 * 1024 + c0); \
                _Pragma("unroll") for (int j = 0; j < 4; ++j) { const float v = xv[j] + gv[j] * moe[4 * h + j]; x3[(sg_) * 8 + 4 * h + j] = v; ss += v * v; } } } while (0)
        P10_LOAD(ybA, ysA, 0, 0);
#pragma unroll 1
        for (int rr = 0; rr < 8; ++rr) {
            float x3[16]; float ss = 0.f;
            P10_LOAD(ybB, ysB, rr, 1);
            P10_HALF(ybA, ysA, rr, 0);
            if (rr < 7) P10_LOAD(ybA, ysA, rr + 1, 0);
            P10_HALF(ybB, ysB, rr, 1);
            const int t = row0 + rr;
            const float rstd = 1.0f / sqrtf(wave_sum(ss) * (1.0f / D) + EPS);
#pragma unroll
            for (int sg = 0; sg < 2; ++sg)
#pragma unroll
                for (int h = 0; h < 2; ++h) { const int c0 = sg * 512 + 8 * F.lane + 4 * h; const f32x4 gg = *(const f32x4*)(fg + c0); f32x4 o;
#pragma unroll
                    for (int j = 0; j < 4; ++j) o[j] = x3[sg * 8 + 4 * h + j] * rstd * gg[j];
                    *(f32x4*)(F.out + (size_t)t * D + c0) = o; }
        }
#undef P10_HALF
#undef P10_LOAD
    }
    __syncthreads();
}

__device__ __forceinline__ float fgelu_tanh(float z) { const float u = 0.7978845608028654f * (z + 0.044715f * z * z * z); const float e = __expf(2.0f * u); return 0.5f * z * (1.0f + (e - 1.0f) / (e + 1.0f)); }
__device__ __forceinline__ float fgelu_safe(float z) { const float u = 0.7978845608028654f * (z + 0.044715f * z * z * z); const float uc = __builtin_amdgcn_fmed3f(u, -15.f, 15.f); const float e = fexp(2.0f * uc); return 0.5f * z * (1.0f + (e - 1.0f) / (e + 1.0f)); }

__device__ __forceinline__ void cmp_unit(Frame& F, int unit) {
    unsigned char* ws = F.ws; const bf16_t* proj = (const bf16_t*)(ws + WS_PROJ);
    const int kv = unit >> 6, mb = unit & 63; const bf16_t* W1T = (const bf16_t*)(ws + (kv ? WS_W1VT : WS_W1KT)); const int coloff = kv ? C_VC : C_KC;
    const float* b1f = (const float*)(ws + WS_B1F) + kv * 256;
    const int w = F.wave, n = F.lane & 15, q = F.lane >> 4;
    LAS bf16_t* HID = (LAS bf16_t*)F.lds;
    size_t base[2];
#pragma unroll
    for (int rt = 0; rt < 2; ++rt) { const int R = 32 * mb + 16 * rt + n, bg = R >> 8; int c = R & 255; if (c > 254) c = 254; base[rt] = ((size_t)(bg >> 1) * SEQ + 16 * c) * LDP + coloff + (bg & 1) * 64; }
    f32x4 acc[2][2];
#pragma unroll
    for (int rt = 0; rt < 2; ++rt)
#pragma unroll
        for (int ct = 0; ct < 2; ++ct) acc[rt][ct] = (f32x4){0.f, 0.f, 0.f, 0.f};
    __syncthreads();
#pragma unroll 1
    for (int s8 = 0; s8 < 64; s8 += 8) {
        bf16x8 a[8][2], bb[8][2];
#pragma unroll
        for (int u = 0; u < 8; ++u) { const int s = s8 + u, ltok = s >> 1, dd = 32 * (s & 1) + 8 * q;
#pragma unroll
            for (int rt = 0; rt < 2; ++rt) a[u][rt] = *(const bf16x8*)(proj + base[rt] + (size_t)ltok * LDP + dd);
#pragma unroll
            for (int ct = 0; ct < 2; ++ct) bb[u][ct] = *(const bf16x8*)(W1T + ((size_t)(s * 16 + 2 * w + ct) * 64 + F.lane) * 8); }
        __builtin_amdgcn_sched_barrier(0);
#pragma unroll
        for (int u = 0; u < 8; ++u)
#pragma unroll
            for (int rt = 0; rt < 2; ++rt)
#pragma unroll
                for (int ct = 0; ct < 2; ++ct) acc[rt][ct] = __builtin_amdgcn_mfma_f32_16x16x32_bf16(bb[u][ct], a[u][rt], acc[rt][ct], 0, 0, 0);
    }
#pragma unroll
    for (int rt = 0; rt < 2; ++rt)
#pragma unroll
        for (int ct = 0; ct < 2; ++ct) { const int col = 32 * w + 16 * ct + 4 * q; const f32x4 bv = *(const f32x4*)(b1f + col); const f32x4 v = acc[rt][ct] + bv;
            v2u o; o.x = cvt_pk_bf16(fgelu_safe(v[0]), fgelu_safe(v[1])); o.y = cvt_pk_bf16(fgelu_safe(v[2]), fgelu_safe(v[3]));
            *(LAS v2u*)(HID + (16 * rt + n) * 264 + col) = o; }
    __syncthreads();
    { const int rt = w & 1, ct = w >> 1; f32x4 o = (f32x4){0.f, 0.f, 0.f, 0.f};
      const bf16_t* w2f = (const bf16_t*)(ws + WS_W2T) + (size_t)kv * 16384;
#pragma unroll
      for (int s = 0; s < 8; ++s) { const bf16x8 a = *(const LAS bf16x8*)(HID + (16 * rt + n) * 264 + 32 * s + 8 * q); const bf16x8 bw = *(const bf16x8*)(w2f + ((size_t)(s * 4 + ct) * 64 + F.lane) * 8);
          o = __builtin_amdgcn_mfma_f32_16x16x32_bf16(bw, a, o, 0, 0, 0); }
      const int R = 32 * mb + 16 * rt + n, bg = R >> 8, c = R & 255, d0 = 16 * ct + 4 * q;
      if (c == 255) o = (f32x4){0.f, 0.f, 0.f, 0.f};
      if (kv == 0) { v2u ov; ov.x = cvt_pk_bf16(o[0], o[1]); ov.y = cvt_pk_bf16(o[2], o[3]); *(v2u*)((bf16_t*)(ws + WS_KCMP) + ((size_t)bg * 256 + c) * 64 + d0) = ov; }
      else { bf16_t* vt = (bf16_t*)(ws + WS_VCMPT) + (size_t)bg * 64 * 256 + c;
#pragma unroll
          for (int r = 0; r < 4; ++r) vt[(size_t)(d0 + r) * 256] = f2bf(o[r]); } }
    __syncthreads();
}

__device__ __forceinline__ void kv_prep_unit(Frame& F, int unit) {
    unsigned char* ws = F.ws; const bf16_t* proj = (const bf16_t*)(ws + WS_PROJ); const float* cs = (const float*)(ws + WS_CS); const float* sn = (const float*)(ws + WS_SN);
    const int b = unit >> 6, tile = unit & 63; const size_t tok0 = (size_t)b * SEQ + 64 * tile;
    LAS unsigned* KMX = (LAS unsigned*)(F.lds + LDSCTL_OFF + 1024);
    __syncthreads(); if (F.tid < 4) KMX[F.tid] = 0u; __syncthreads();
#pragma unroll
    for (int it = 0; it < 2; ++it) { const int id = F.tid + 512 * it; const int c = id & 3, g = (id >> 2) & 1, wh = (id >> 3) & 1, tk = id >> 4; const int pos = 64 * tile + tk;
        const bf16_t* src = proj + (tok0 + tk) * LDP + (wh ? C_KW : C_KS) + g * 64 + 8 * c; const v4u lo = *(const v4u*)src, hi = *(const v4u*)(src + 32);
        const f32x4 c0 = *(const f32x4*)(cs + pos * 32 + 8 * c), c1 = *(const f32x4*)(cs + pos * 32 + 8 * c + 4), s0 = *(const f32x4*)(sn + pos * 32 + 8 * c), s1 = *(const f32x4*)(sn + pos * 32 + 8 * c + 4);
        float a[8], bb[8], co[8], si[8];
        const unsigned lw[4] = {lo.x, lo.y, lo.z, lo.w}, hw[4] = {hi.x, hi.y, hi.z, hi.w};
#pragma unroll
        for (int k = 0; k < 4; ++k) { a[2 * k] = bf2f((bf16_t)(lw[k] & 0xffff)); a[2 * k + 1] = bf2f((bf16_t)(lw[k] >> 16)); bb[2 * k] = bf2f((bf16_t)(hw[k] & 0xffff)); bb[2 * k + 1] = bf2f((bf16_t)(hw[k] >> 16)); co[k] = c0[k]; co[4 + k] = c1[k]; si[k] = s0[k]; si[4 + k] = s1[k]; }
        unsigned olp[4], ohp[4];
#pragma unroll
        for (int k = 0; k < 4; ++k) { olp[k] = pk2(a[2 * k] * co[2 * k] - bb[2 * k] * si[2 * k], a[2 * k + 1] * co[2 * k + 1] - bb[2 * k + 1] * si[2 * k + 1]);
            ohp[k] = pk2(bb[2 * k] * co[2 * k] + a[2 * k] * si[2 * k], bb[2 * k + 1] * co[2 * k + 1] + a[2 * k + 1] * si[2 * k + 1]); }
        bf16_t* dst = (bf16_t*)(ws + (wh ? WS_KWR : WS_KSR)) + (((size_t)(b * 2 + g) * SEQ) + pos) * 64 + 8 * c; *(v4u*)dst = (v4u){olp[0], olp[1], olp[2], olp[3]}; *(v4u*)(dst + 32) = (v4u){ohp[0], ohp[1], ohp[2], ohp[3]};
        float nq = 0.f;
#pragma unroll
        for (int k = 0; k < 8; ++k) nq += a[k] * a[k] + bb[k] * bb[k];
        nq += __shfl_xor(nq, 1); nq += __shfl_xor(nq, 2); nq = fmaxf(nq, __shfl_xor(nq, 16)); nq = fmaxf(nq, __shfl_xor(nq, 32));
        if ((F.lane & 0x33) == 0) atomicMax((unsigned*)&KMX[2 * wh + g], __float_as_uint(nq)); }
    __syncthreads();
    if (F.tid < 4) atomicMax(F.ctl + CW_KMAX + (b * 2 + (F.tid & 1)) * 2 + (F.tid >> 1), KMX[F.tid]);
    LAS bf16_t* TL = (LAS bf16_t*)F.lds;
    v4u vin[4];
#pragma unroll
    for (int m = 0; m < 4; ++m) { const int wh = m >> 1, g = m & 1, tk = F.tid >> 3, c = F.tid & 7; vin[m] = *(const v4u*)(proj + (tok0 + tk) * LDP + (wh ? C_VW : C_VS) + g * 64 + 8 * c); }
#pragma unroll
    for (int m = 0; m < 4; ++m) { const int wh = m >> 1, g = m & 1;
        __syncthreads();
        { const int tk = F.tid >> 3, c = F.tid & 7; *(LAS v4u*)(TL + tk * 72 + 8 * c) = vin[m]; }
        __syncthreads();
        { const int d = F.tid >> 3, sc = F.tid & 7; unsigned short e[8];
#pragma unroll
          for (int i = 0; i < 8; ++i) e[i] = TL[(8 * sc + i) * 72 + d];
          v4u o; o.x = e[0] | ((unsigned)e[1] << 16); o.y = e[2] | ((unsigned)e[3] << 16); o.z = e[4] | ((unsigned)e[5] << 16); o.w = e[6] | ((unsigned)e[7] << 16);
          *(v4u*)((bf16_t*)(ws + (wh ? WS_VWT : WS_VST)) + ((size_t)(b * 2 + g) * 64 + d) * SEQ + 64 * tile + 8 * sc) = o; } }
    __syncthreads();
}

constexpr int ATT_NS = 5;
constexpr int ATT_VB = ATT_NS * 8192, ATT_PSL = 2 * ATT_NS * 8192, ATT_OUTA = ATT_PSL, ATT_SELM = LDSCTL_OFF + 512, ATT_UNI = ATT_SELM + 512, ATT_TL = ATT_UNI + 16, ATT_NT = ATT_TL + 80;
constexpr float ATT_QS = 0.125f * 1.4426950408889634f;
#ifndef PROBE_TILE
#define PROBE_TILE 0
#endif
#if PROBE_TILE == 1
#define PROBE_TILE_QK asm volatile("" :: "v"(s[0]), "v"(s[1])); att_qk(lds + kslot * 8192, qf, s, i, hh, ini[0], ini[1]);
#else
#define PROBE_TILE_QK
#endif
#if PROBE_TILE == 2
#define PROBE_TILE_EXP { float dsum_ = 0.f; _Pragma("unroll") for (int kt = 0; kt < 2; ++kt) _Pragma("unroll") for (int r = 0; r < 16; ++r) { float d_; asm volatile("v_exp_f32 %0, %1" : "=v"(d_) : "v"(s[kt][r])); asm volatile("v_add_f32 %0, %1, %0" : "+v"(dsum_) : "v"(d_)); } asm volatile("" :: "v"(dsum_)); }
#else
#define PROBE_TILE_EXP
#endif
#if PROBE_TILE == 3
#define PROBE_TILE_PV { const bf16x8 zb_ = __builtin_bit_cast(bf16x8, (v4u){0u, 0u, 0u, 0u}); _Pragma("unroll") for (int ks = 0; ks < 4; ++ks) _Pragma("unroll") for (int dt = 0; dt < 2; ++dt) o[dt] = __builtin_amdgcn_mfma_f32_32x32x16_bf16(vf[ks][dt], zb_, o[dt], 0, 0, 0); }
#elif PROBE_TILE == 4
#define PROBE_TILE_PV { _Pragma("unroll") for (int ks = 0; ks < 16; ++ks) { v4u d_; asm volatile("ds_read_b128 %0, %1" : "=v"(d_) : "v"((unsigned)(kslot * 8192 + att_swz(2 * ks + (i & 1), hh + 2 * (i >> 4))))); asm volatile("" :: "v"(d_)); } asm volatile("s_waitcnt lgkmcnt(0)"); }
#else
#define PROBE_TILE_PV
#endif
#ifndef ATT_MERGE
#define ATT_MERGE 1
#endif
#ifndef ATT_PIPE
#define ATT_PIPE 1
#endif
#ifndef ATT_PINGPONG
#define ATT_PINGPONG 1
#endif
#ifndef PP_PRIO
#define PP_PRIO 0
#endif
#if PP_PRIO == 1
#define PP_PRIO_UP __builtin_amdgcn_s_setprio(1)
#define PP_PRIO_DN __builtin_amdgcn_s_setprio(0)
#else
#define PP_PRIO_UP
#define PP_PRIO_DN
#endif
#ifndef PP_OACC
#define PP_OACC 0
#endif
#if PP_OACC
#define PP_PVMMA(acc_, a_, b_) asm("s_nop 1\n\tv_mfma_f32_32x32x16_bf16 %0, %1, %2, %0" : "+a"(acc_) : "v"(a_), "v"(b_))
#else
#define PP_PVMMA(acc_, a_, b_) acc_ = __builtin_amdgcn_mfma_f32_32x32x16_bf16(a_, __builtin_bit_cast(bf16x8, b_), acc_, 0, 0, 0)
#endif
#ifndef MG_SCHED_MODE
#define MG_SCHED_MODE 1
#endif
#if MG_SCHED_MODE == 1
#define MG_SCHED { _Pragma("unroll") for (int g_ = 0; g_ < 17; ++g_) { __builtin_amdgcn_sched_group_barrier(0x008, 1, 0); __builtin_amdgcn_sched_group_barrier(0x100, 1, 0); __builtin_amdgcn_sched_group_barrier(0x400, 2, 0); __builtin_amdgcn_sched_group_barrier(0x002, 3, 0); } }
#else
#define MG_SCHED
#endif
#ifndef PP_SCHED_MODE
#define PP_SCHED_MODE 0
#endif
#if PP_SCHED_MODE == 1
#define PP_SCHED { _Pragma("unroll") for (int g_ = 0; g_ < 17; ++g_) { __builtin_amdgcn_sched_group_barrier(0x008, 1, 0); __builtin_amdgcn_sched_group_barrier(0x100, 1, 0); __builtin_amdgcn_sched_group_barrier(0x400, 2, 0); __builtin_amdgcn_sched_group_barrier(0x002, 3, 0); } }
#else
#define PP_SCHED
#endif
#ifndef PROBE_PIPE
#define PROBE_PIPE 0
#endif
#if PROBE_PIPE == 1
#define PROBE_PIPE_X { float dsum_ = 0.f; _Pragma("unroll") for (int kt = 0; kt < 2; ++kt) _Pragma("unroll") for (int r = 0; r < 16; ++r) { float d_; asm volatile("v_exp_f32 %0, %1" : "=v"(d_) : "v"(s[kt][r])); dsum_ += d_; } asm volatile("" :: "v"(dsum_)); }
#elif PROBE_PIPE == 2
#define PROBE_PIPE_X { const bf16x8 zb_ = __builtin_bit_cast(bf16x8, (v4u){0u, 0u, 0u, 0u}); _Pragma("unroll") for (int q = 0; q < 4; ++q) o[q & 1] = __builtin_amdgcn_mfma_f32_32x32x16_bf16(fr[q], zb_, o[q & 1], 0, 0, 0); _Pragma("unroll") for (int q = 0; q < 4; ++q) o[q & 1] = __builtin_amdgcn_mfma_f32_32x32x16_bf16(fr[q + 4], zb_, o[q & 1], 0, 0, 0); }
#elif PROBE_PIPE == 3
#define PROBE_PIPE_X PP_DMA(t_ + 4); asm volatile("s_waitcnt vmcnt(4)" ::: "memory");
#elif PROBE_PIPE == 4
#define PROBE_PIPE_X { _Pragma("unroll") for (int q = 0; q < 8; ++q) { v4u d_; asm volatile("ds_read_b128 %0, %1" : "=v"(d_) : "v"((unsigned)((tcc_ % ATT_NS) * 8192 + att_swz(32 * (q & 1) + i, 2 * (q >> 1) + hh)))); asm volatile("" :: "v"(d_)); } }
#else
#define PROBE_PIPE_X
#endif
#ifndef ATT_STATIC_PRIO
#define ATT_STATIC_PRIO 0
#endif
#if ATT_STATIC_PRIO
#define ATT_PRIO_UP
#define ATT_PRIO_DN
#else
#define ATT_PRIO_UP __builtin_amdgcn_s_setprio(1)
#define ATT_PRIO_DN __builtin_amdgcn_s_setprio(0)
#endif
#ifndef ATT_MASKOFF
#define ATT_MASKOFF 200.0f
#endif
__device__ __forceinline__ int att_swz(int row, int c) { return row * 128 + ((c ^ ((row >> 1) & 7)) << 4); }
struct TileSrc { const bf16_t* K; int kpitch; const bf16_t* V; int vpitch; };
__device__ __forceinline__ void att_load(const TileSrc& s, int tid, v4u& kr, v4u& vr) { const int row = tid >> 3, c = tid & 7; kr = *(const v4u*)(s.K + (size_t)row * s.kpitch + 8 * c); vr = *(const v4u*)(s.V + (size_t)row * s.vpitch + 8 * c); }
__device__ __forceinline__ void att_store(LAS unsigned char* lds, int buf, int tid, const v4u& kr, const v4u& vr) {
    const int row = tid >> 3, c = tid & 7;
    *(LAS v4u*)(lds + buf * 8192 + att_swz(row, c)) = kr;
    const int s16 = c >> 1, half = c & 1;
    *(LAS v2u*)(lds + ATT_VB + buf * 8192 + att_swz(row, 2 * s16) + half * 8) = (v2u){vr.x, vr.y};
    *(LAS v2u*)(lds + ATT_VB + buf * 8192 + att_swz(row, 2 * s16 + 1) + half * 8) = (v2u){vr.z, vr.w};
}
__device__ __forceinline__ void att_qk(const LAS unsigned char* kb, const bf16x8 (&qf)[4], f32x16 (&s)[2], int i, int hh, const f32x16& ini0, const f32x16& ini1) {
    bf16x8 kf[2][4];
#pragma unroll
    for (int kt = 0; kt < 2; ++kt)
#pragma unroll
        for (int st = 0; st < 4; ++st) kf[kt][st] = *(const LAS bf16x8*)(kb + att_swz(32 * kt + i, 2 * st + hh));
    ATT_PRIO_UP;
#pragma unroll
    for (int st = 0; st < 4; ++st)
#pragma unroll
        for (int kt = 0; kt < 2; ++kt) s[kt] = __builtin_amdgcn_mfma_f32_32x32x16_bf16(kf[kt][st], qf[st], st == 0 ? (kt ? ini1 : ini0) : s[kt], 0, 0, 0);
    ATT_PRIO_DN;
}
__device__ __forceinline__ void att_vload(const LAS unsigned char* vb, bf16x8 (&vf)[4][2], int i, int hh) {
#pragma unroll
    for (int ks = 0; ks < 4; ++ks)
#pragma unroll
        for (int dt = 0; dt < 2; ++dt) vf[ks][dt] = *(const LAS bf16x8*)(vb + att_swz(32 * dt + i, 2 * ks + hh));
}
__device__ __forceinline__ void att_pv(const bf16x8 (&vf)[4][2], const f32x16 (&p)[2], f32x16 (&o)[2]) {
    ATT_PRIO_UP;
#pragma unroll
    for (int kt = 0; kt < 2; ++kt)
#pragma unroll
        for (int s = 0; s < 2; ++s) { const v4u pb = (v4u){cvt_pk_bf16(p[kt][8 * s], p[kt][8 * s + 1]), cvt_pk_bf16(p[kt][8 * s + 2], p[kt][8 * s + 3]), cvt_pk_bf16(p[kt][8 * s + 4], p[kt][8 * s + 5]), cvt_pk_bf16(p[kt][8 * s + 6], p[kt][8 * s + 7])};
            const bf16x8 bf = __builtin_bit_cast(bf16x8, pb);
#pragma unroll
            for (int dt = 0; dt < 2; ++dt) o[dt] = __builtin_amdgcn_mfma_f32_32x32x16_bf16(vf[2 * kt + s][dt], bf, o[dt], 0, 0, 0); }
    ATT_PRIO_DN;
}
template <bool PK = false>
__device__ __forceinline__ void att_ini(f32x16 (&ini)[2], bool uniform, float base, int lo, int hi, int hh, float masked = -1e30f) {
    if (uniform) {
#pragma unroll
        for (int r = 0; r < 16; ++r) ini[0][r] = base;
        ini[1] = ini[0];
    } else {
        const bool any_ = hi >= lo; const unsigned span = any_ ? (unsigned)(hi - lo) : 0u; const int bs = any_ ? lo - (PK ? 8 : 4) * hh : -(1 << 30);
#pragma unroll
        for (int kt = 0; kt < 2; ++kt)
#pragma unroll
            for (int r = 0; r < 16; ++r) ini[kt][r] = ((unsigned)((PK ? 32 * kt + 16 * (r >> 3) + (r & 7) : 32 * kt + (r & 3) + 8 * (r >> 2)) - bs) <= span) ? base : masked;
    }
}
#define ATT_KEY(kt, r, hh) (32 * (kt) + ((r) & 3) + 8 * ((r) >> 2) + 4 * (hh))

__device__ __forceinline__ void att_unit(Frame& F_, int unit) {
    Frame F = F_; asm volatile("" : "+v"(F.lane), "+v"(F.tid));
    unsigned char* ws = F.ws; const bf16_t* proj = (const bf16_t*)(ws + WS_PROJ); bf16_t* mix = (bf16_t*)(ws + WS_MIX);
    const int qb = unit & 63, bg = unit >> 6, b = bg >> 1, g = bg & 1;
    const int w = F.wave, i = F.lane & 31, hh = F.lane >> 5, head = i >> 3, tloc = i & 7, tt = 8 * w + tloc; const int pos = 64 * qb + tt; const size_t tok = (size_t)b * SEQ + pos;
    LAS unsigned char* lds = F.lds; LAS float* PSL = (LAS float*)(lds + ATT_PSL); LAS unsigned* SELM = (LAS unsigned*)(lds + ATT_SELM); LAS unsigned* UNI = (LAS unsigned*)(lds + ATT_UNI);
    LAS unsigned char* TL = lds + ATT_TL; LAS int* NTL = (LAS int*)(lds + ATT_NT);
    const bf16_t* kcmp = (const bf16_t*)(ws + WS_KCMP) + (size_t)bg * 256 * 64; const bf16_t* vcmpt = (const bf16_t*)(ws + WS_VCMPT) + (size_t)bg * 64 * 256;
    const bf16_t* ksr = (const bf16_t*)(ws + WS_KSR) + (size_t)bg * SEQ * 64; const bf16_t* vst = (const bf16_t*)(ws + WS_VST) + (size_t)bg * 64 * SEQ;
    const bf16_t* kwr = (const bf16_t*)(ws + WS_KWR) + (size_t)bg * SEQ * 64; const bf16_t* vwt = (const bf16_t*)(ws + WS_VWT) + (size_t)bg * 64 * SEQ;
    __syncthreads();
    v4u kr, vr; { TileSrc ts0{kcmp, 64, vcmpt, 256}; att_load(ts0, F.tid, kr, vr); }
    for (int k = F.tid; k < 64 * 64; k += NTHR) PSL[k] = 0.f;
    if (F.tid < 2) UNI[F.tid] = 0u;
    bf16x8 qf[4];
    const bf16_t* qp = proj + tok * LDP + C_NQ + (4 * g + head) * 64 + 8 * hh;
    { float qraw[4][8];
#pragma unroll
      for (int st = 0; st < 4; ++st) { const v4u v = *(const v4u*)(qp + 16 * st); const unsigned vw[4] = {v.x, v.y, v.z, v.w};
#pragma unroll
          for (int k = 0; k < 4; ++k) { qraw[st][2 * k] = bf2f((bf16_t)(vw[k] & 0xffff)); qraw[st][2 * k + 1] = bf2f((bf16_t)(vw[k] >> 16)); } }
#pragma unroll
      for (int st = 0; st < 4; ++st) { const v4u o = (v4u){cvt_pk_bf16(qraw[st][0] * ATT_QS, qraw[st][1] * ATT_QS), cvt_pk_bf16(qraw[st][2] * ATT_QS, qraw[st][3] * ATT_QS), cvt_pk_bf16(qraw[st][4] * ATT_QS, qraw[st][5] * ATT_QS), cvt_pk_bf16(qraw[st][6] * ATT_QS, qraw[st][7] * ATT_QS)};
          qf[st] = __builtin_bit_cast(bf16x8, o); } }
    LAS float* OUTA = (LAS float*)(lds + ATT_OUTA) + (size_t)w * 32 * 64 + F.lane;
    const float* gl = nullptr; (void)gl;
    const float gate0 = fsigmoid(bf2f(proj[tok * LDP + C_NG + (4 * g + head) * 3 + 0])), gate1 = fsigmoid(bf2f(proj[tok * LDP + C_NG + (4 * g + head) * 3 + 1])), gate2 = fsigmoid(bf2f(proj[tok * LDP + C_NG + (4 * g + head) * 3 + 2]));
    f32x16 s[2]; f32x16 ocmp[2];
#ifndef PROBE_ATT
#define PROBE_ATT 0
#endif
    for (int rep1_ = 0; rep1_ < (PROBE_ATT == 1 ? 2 : 1); ++rep1_) {
    if (qb == 63) R7STAMP(40);
    const int ncu = (4 * qb + 3) < 255 ? (4 * qb + 3) : 255, ntile = (ncu + 63) >> 6;
    const int ncv = pos >= 31 ? ((pos - 31) >> 4) + 1 : 0;
    const int ncv_min = qb >= 1 ? 4 * qb - 1 : 0;
    float m = -1e30f, l = 0.f;
    {
        att_store(lds, 0, F.tid, kr, vr);
        __syncthreads();
        for (int T_ = 0; T_ < ntile; ++T_) {
            const bool more = T_ + 1 < ntile;
            if (more) { TileSrc ts{kcmp + (size_t)(T_ + 1) * 64 * 64, 64, vcmpt + (T_ + 1) * 64, 256}; att_load(ts, F.tid, kr, vr); }
            { f32x16 ini[2]; att_ini(ini, 64 * T_ + 64 <= ncv_min, 0.f, 0, ncv - 1 - 64 * T_, hh, -ATT_MASKOFF); att_qk(lds + T_ * 8192, qf, s, i, hh, ini[0], ini[1]); }
            float tm = -1e30f;
#pragma unroll
            for (int kt = 0; kt < 2; ++kt)
#pragma unroll
                for (int r = 0; r < 16; ++r) tm = fmaxf(tm, s[kt][r]);
            tm = fmaxf(tm, __shfl_xor(tm, 32));
            const float mn = fmaxf(m, tm); l *= fexp2(m - mn);
#pragma unroll
            for (int kt = 0; kt < 2; ++kt)
#pragma unroll
                for (int r = 0; r < 16; ++r) l += __builtin_amdgcn_exp2f(s[kt][r] - mn);
            m = mn;
            if (more) att_store(lds, T_ + 1, F.tid, kr, vr);
            __syncthreads();
        }
        l += __shfl_xor(l, 32);
    }
    if (qb == 63) R7STAMP(41);
    {
        const float rl = (ncv > 0 && l > 0.f) ? 1.0f / l : 0.f;
        f32x16 o[2];
#pragma unroll
        for (int k = 0; k < 16; ++k) { o[0][k] = 0.f; o[1][k] = 0.f; }
        float carry = 0.f;
        for (int T_ = 0; T_ < ntile; ++T_) {
            bf16x8 vf[4][2];
            { f32x16 ini[2]; att_ini(ini, 64 * T_ + 64 <= ncv_min, -m, 0, ncv - 1 - 64 * T_, hh, -m - ATT_MASKOFF); att_qk(lds + T_ * 8192, qf, s, i, hh, ini[0], ini[1]); }
            att_vload(lds + ATT_VB + T_ * 8192, vf, i, hh);
#pragma unroll
            for (int kt = 0; kt < 2; ++kt)
#pragma unroll
                for (int r = 0; r < 16; ++r) s[kt][r] = __builtin_amdgcn_exp2f(s[kt][r]) * rl;
            att_pv(vf, s, o);
            float ps[8];
#pragma unroll
            for (int kt = 0; kt < 2; ++kt)
#pragma unroll
                for (int gi = 0; gi < 4; ++gi) ps[4 * kt + gi] = (s[kt][4 * gi] + s[kt][4 * gi + 1]) + (s[kt][4 * gi + 2] + 0.5f * s[kt][4 * gi + 3]);
            float nc = 0.f;
#pragma unroll
            for (int sl = 0; sl < 8; ++sl) { const float x = 0.5f * s[sl >> 2][4 * (sl & 3) + 3]; const float y = __shfl_xor(x, 32);
                if (hh == 1) ps[sl] += y; else { if (sl < 7) ps[sl + 1] += y; else nc = y; } }
            if (hh == 0) { ps[0] += carry; carry = nc; }
#pragma unroll
            for (int sl = 0; sl < 8; ++sl) { float v = ps[sl]; v += __shfl_xor(v, 8); v += __shfl_xor(v, 16); ps[sl] = v; }
            if (head == 0) {
#pragma unroll
                for (int sl = 0; sl < 8; ++sl) PSL[tt * 64 + 16 * T_ + 2 * sl + hh] = ps[sl]; }
        }
        __syncthreads();
#pragma unroll
        for (int dt = 0; dt < 2; ++dt)
#pragma unroll
            for (int k = 0; k < 16; ++k) ocmp[dt][k] = gate0 * o[dt][k];
    }
    if (qb == 63) R7STAMP(42);
    __syncthreads();
    {
        const int j = F.lane; const bool fj = (j == 0) || (j == qb) || (j == qb - 1);
#pragma unroll 1
        for (int tg = 0; tg < 8; tg += 8) {
            unsigned key[8], thr[8];
#pragma unroll
            for (int u = 0; u < 8; ++u) { key[u] = fj ? 0xFFFFFFFFu : (j <= qb ? __float_as_uint(PSL[(8 * w + tg + u) * 64 + j]) + 1u : 0u); thr[u] = 0u; }
#pragma unroll 1
            for (int bit = 31; bit >= 0; --bit) {
#pragma unroll
                for (int u = 0; u < 8; ++u) { const unsigned cand = thr[u] | (1u << bit); if (__popcll(__ballot(key[u] >= cand)) >= NSEL) thr[u] = cand; } }
#pragma unroll
            for (int u = 0; u < 8; ++u) { const int t = 8 * w + tg + u;
                const unsigned long long gt = __ballot(key[u] > thr[u]), eq = __ballot(key[u] == thr[u]); const int need = NSEL - __popcll(gt);
                const int below = __popcll(eq & ((1ull << j) - 1ull));
                const bool sel = (key[u] > 0u) && ((key[u] > thr[u]) || (key[u] == thr[u] && below < need));
                const unsigned long long msk = __ballot(sel);
                if (F.lane == 0) { const unsigned lo = (unsigned)msk, hi = (unsigned)(msk >> 32); SELM[2 * t] = lo; SELM[2 * t + 1] = hi; atomicOr((unsigned*)&UNI[0], lo); atomicOr((unsigned*)&UNI[1], hi); } }
        }
    }
    __syncthreads();
    }
    const unsigned sel0 = SELM[2 * tt], sel1 = SELM[2 * tt + 1];
#pragma unroll
    for (int dt = 0; dt < 2; ++dt)
#pragma unroll
        for (int k = 0; k < 16; ++k) OUTA[(dt * 16 + k) * 64] = ocmp[dt][k];
    if (qb == 63) R7STAMP(43);
    float qn2 = 0.f;
    { const float* csp = (const float*)(ws + WS_CS) + pos * 32 + 8 * hh; const float* snp = (const float*)(ws + WS_SN) + pos * 32 + 8 * hh;
      float qraw[4][8];
#pragma unroll
      for (int st = 0; st < 4; ++st) { const v4u v = *(const v4u*)(qp + 16 * st); const unsigned vw[4] = {v.x, v.y, v.z, v.w};
#pragma unroll
          for (int k = 0; k < 4; ++k) { qraw[st][2 * k] = bf2f((bf16_t)(vw[k] & 0xffff)); qraw[st][2 * k + 1] = bf2f((bf16_t)(vw[k] >> 16)); } }
#pragma unroll
      for (int st = 0; st < 2; ++st) { float co[8], si[8]; *(f32x4*)&co[0] = *(const f32x4*)(csp + 16 * st); *(f32x4*)&co[4] = *(const f32x4*)(csp + 16 * st + 4); *(f32x4*)&si[0] = *(const f32x4*)(snp + 16 * st); *(f32x4*)&si[4] = *(const f32x4*)(snp + 16 * st + 4);
          float rl_[8], rh_[8];
#pragma unroll
          for (int k = 0; k < 8; ++k) { rl_[k] = (qraw[st][k] * co[k] - qraw[st + 2][k] * si[k]) * ATT_QS; rh_[k] = (qraw[st + 2][k] * co[k] + qraw[st][k] * si[k]) * ATT_QS; }
#pragma unroll
          for (int k = 0; k < 8; ++k) qn2 += qraw[st][k] * qraw[st][k] + qraw[st + 2][k] * qraw[st + 2][k];
          qf[st] = __builtin_bit_cast(bf16x8, (v4u){cvt_pk_bf16(rl_[0], rl_[1]), cvt_pk_bf16(rl_[2], rl_[3]), cvt_pk_bf16(rl_[4], rl_[5]), cvt_pk_bf16(rl_[6], rl_[7])});
          qf[st + 2] = __builtin_bit_cast(bf16x8, (v4u){cvt_pk_bf16(rh_[0], rh_[1]), cvt_pk_bf16(rh_[2], rh_[3]), cvt_pk_bf16(rh_[4], rh_[5]), cvt_pk_bf16(rh_[6], rh_[7])}); } }
    qn2 += __shfl_xor(qn2, 32);
    if (qb == 63) R7STAMP(44);
    { int ln1_ = F.lane, td1_ = F.tid; asm volatile("" : "+v"(ln1_), "+v"(td1_));
    const int i = ln1_ & 31, hh = ln1_ >> 5, tt = 8 * w + (i & 7);
    LAS float* OUTA = (LAS float*)(lds + ATT_OUTA) + (size_t)w * 32 * 64 + ln1_;
#if ATT_STATIC_PRIO
    if (F.wave < 4) __builtin_amdgcn_s_setprio(2);
#endif
#if ATT_MERGE
    {
        if (F.wave == 0) { const int j = F.lane; const unsigned u0 = UNI[0], u1 = UNI[1]; const bool on = (j <= qb) && (j < 32 ? ((u0 >> j) & 1u) : ((u1 >> (j - 32)) & 1u));
            const unsigned long long bm = __ballot(on);
            if (on) TL[__popcll(bm & ((1ull << j) - 1ull))] = (unsigned char)j;
            if (j == 0) NTL[0] = __popcll(bm); }
        __syncthreads();
        const int nls = NTL[0], jw0 = qb > 8 ? qb - 8 : 0, nlw = qb - jw0 + 1, nl = nls + nlw;
        const float nref0 = -fminf(sqrtf(qn2 * __uint_as_float(__hip_atomic_load(F.ctl + CW_KMAX + (b * 2 + g) * 2 + 0, RLX_AGENT))) * ATT_QS + 1.0f, 300.f);
        const float nref1 = -fminf(sqrtf(qn2 * __uint_as_float(__hip_atomic_load(F.ctl + CW_KMAX + (b * 2 + g) * 2 + 1, RLX_AGENT))) * ATT_QS + 1.0f, 300.f);
        const unsigned nb0 = cvt_pk_bf16(nref0, 0.f) & 0xffffu, nb1 = cvt_pk_bf16(nref1, 0.f) & 0xffffu;
        const bf16x8 aones = __builtin_bit_cast(bf16x8, (v4u){hh ? 0u : 0x3f803f80u, 0u, 0u, 0u});
        const unsigned bon0 = hh ? 0u : nb0, boff0 = hh ? 0u : (nb0 | 0xc3480000u), bon1 = hh ? 0u : nb1, boff1 = hh ? 0u : (nb1 | 0xc3480000u);
        const int tlv = TL[ln1_];
        unsigned offK, offV;
        { const int row = 8 * w + (ln1_ >> 3), c = (ln1_ & 7) ^ ((row >> 1) & 7), key = (row & ~12) | ((row & 4) << 1) | ((row & 8) >> 1);
          offK = (unsigned)(key * 128 + c * 16); offV = (unsigned)(row * (SEQ * 2) + c * 16); }
        float ll = 0.f, ll0 = 0.f; f32x16 o[2];
#pragma unroll
        for (int k = 0; k < 16; ++k) { o[0][k] = 0.f; o[1][k] = 0.f; }
#define PP_BAR do { asm volatile("s_waitcnt lgkmcnt(0)" ::: "memory"); __builtin_amdgcn_s_barrier(); asm volatile("" ::: "memory"); } while (0)
#define MG_J(T_) ((T_) < nls ? __builtin_amdgcn_readlane(tlv, (T_)) : jw0 + (T_) - nls)
#define MG_DMA(T_) do { const int tc_ = (T_) < nl - 1 ? (T_) : nl - 1; const int j_ = MG_J(tc_); const int sl_ = tc_ % ATT_NS; const bool bw_ = tc_ >= nls; \
            __builtin_amdgcn_global_load_lds((const unsigned*)((const char*)(bw_ ? kwr : ksr) + (size_t)j_ * 8192 + offK), (LAS unsigned*)(lds + sl_ * 8192 + w * 1024), 16, 0, 0); \
            __builtin_amdgcn_global_load_lds((const unsigned*)((const char*)(bw_ ? vwt : vst) + (size_t)j_ * 128 + offV), (LAS unsigned*)(lds + ATT_VB + sl_ * 8192 + w * 1024), 16, 0, 0); } while (0)
#define MG_FIN(gate_, lsum_) do { const float lt_ = (lsum_) + __shfl_xor((lsum_), 32); const float sc_ = lt_ > 0.f ? (gate_) / lt_ : 0.f; \
            _Pragma("unroll") for (int dt = 0; dt < 2; ++dt) _Pragma("unroll") for (int k = 0; k < 16; ++k) { OUTA[(dt * 16 + k) * 64] += sc_ * o[dt][k]; o[dt][k] = 0.f; } } while (0)
#define MG_ITER(T_, SC, SN) do { const int t_ = (T_); const int tnc_ = t_ + 1 < nl ? t_ + 1 : nl - 1; const int tcc_ = t_ < 0 ? 0 : (t_ < nl ? t_ : nl - 1); \
            const int j = MG_J(tnc_); const bool bwN_ = tnc_ >= nls; bool lane_on; int lo_k, hi_k; \
            if (!bwN_) { lane_on = j < 32 ? ((sel0 >> j) & 1u) : ((sel1 >> (j - 32)) & 1u); lo_k = 0; hi_k = (j == qb) ? tt : 63; } \
            else { lane_on = true; lo_k = (j == qb - 8) ? tt + 1 : 0; hi_k = (j == qb) ? tt : 63; if (lo_k > hi_k) lane_on = false; } \
            bool fullN_ = (j != qb) && (!bwN_ || j != qb - 8); if (t_ + 1 >= nl) { lane_on = false; fullN_ = true; } \
            if (t_ == nls) { ll0 = ll; ll = 0.f; } \
            if (t_ == nls + 1) MG_FIN(gate1, ll0); \
            if (!fullC) { const unsigned span_ = (unsigned)(hiC - loC); const int bs_ = loC - 8 * hh; \
                _Pragma("unroll") for (int kt = 0; kt < 2; ++kt) _Pragma("unroll") for (int r = 0; r < 16; ++r) SC[kt][r] += ((unsigned)((32 * kt + 16 * (r >> 3) + (r & 7)) - bs_) <= span_) ? 0.f : -ATT_MASKOFF; } \
            const LAS unsigned char* kb = lds + (tnc_ % ATT_NS) * 8192; const LAS unsigned char* vb = lds + ATT_VB + (tcc_ % ATT_NS) * 8192; \
            _Pragma("unroll") for (int q = 0; q < 8; ++q) { PP_PVMMA(o[q & 1], fr[q], pA[q >> 1]); \
                fr[q] = *(const LAS bf16x8*)(kb + att_swz(32 * (q & 1) + i, 2 * (q >> 1) + hh)); if (q == 3) MG_DMA(t_ + 4); } \
            { const bf16x8 bq_ = __builtin_bit_cast(bf16x8, (v4u){lane_on ? (bwN_ ? bon1 : bon0) : (bwN_ ? boff1 : boff0), 0u, 0u, 0u}); const f32x16 z_ = {0.f, 0.f, 0.f, 0.f, 0.f, 0.f, 0.f, 0.f, 0.f, 0.f, 0.f, 0.f, 0.f, 0.f, 0.f, 0.f}; \
              SN[0] = __builtin_amdgcn_mfma_f32_32x32x16_bf16(aones, bq_, z_, 0, 0, 0); SN[1] = __builtin_amdgcn_mfma_f32_32x32x16_bf16(aones, bq_, z_, 0, 0, 0); } \
            _Pragma("unroll") for (int q = 0; q < 8; ++q) { SN[q & 1] = __builtin_amdgcn_mfma_f32_32x32x16_bf16(fr[q], qf[q >> 1], SN[q & 1], 0, 0, 0); \
                fr[q] = *(const LAS bf16x8*)(vb + att_swz(32 * (q & 1) + i, 2 * (q >> 1) + hh)); } \
            _Pragma("unroll") for (int kt = 0; kt < 2; ++kt) _Pragma("unroll") for (int r = 0; r < 16; ++r) { const float pv_ = __builtin_amdgcn_exp2f(SC[kt][r]); SC[kt][r] = pv_; ll += pv_; } \
            _Pragma("unroll") for (int kt = 0; kt < 2; ++kt) _Pragma("unroll") for (int s_ = 0; s_ < 2; ++s_) pA[2 * kt + s_] = (v4u){cvt_pk_bf16(SC[kt][8 * s_], SC[kt][8 * s_ + 1]), cvt_pk_bf16(SC[kt][8 * s_ + 2], SC[kt][8 * s_ + 3]), cvt_pk_bf16(SC[kt][8 * s_ + 4], SC[kt][8 * s_ + 5]), cvt_pk_bf16(SC[kt][8 * s_ + 6], SC[kt][8 * s_ + 7])}; \
            MG_SCHED \
            fullC = fullN_; loC = lo_k; hiC = hi_k; \
            asm volatile("s_waitcnt vmcnt(4)" ::: "memory"); PP_BAR; } while (0)
        f32x16 sB[2]; v4u pA[4]; bf16x8 fr[8]; bool fullC = true; int loC = 0, hiC = 63;
#pragma unroll
        for (int r = 0; r < 16; ++r) { sB[0][r] = -ATT_MASKOFF; sB[1][r] = -ATT_MASKOFF; }
#pragma unroll
        for (int q = 0; q < 4; ++q) { pA[q] = (v4u){0u, 0u, 0u, 0u}; fr[q] = __builtin_bit_cast(bf16x8, (v4u){0u, 0u, 0u, 0u}); fr[q + 4] = fr[q]; }
        MG_DMA(0); MG_DMA(1); MG_DMA(2);
        asm volatile("s_waitcnt vmcnt(4)" ::: "memory"); PP_BAR;
#pragma unroll 1
        for (int t = -1; t < nl; t += 2) { MG_ITER(t, sB, s); MG_ITER(t + 1, s, sB); }
        if (nl & 1) {
            if (nlw == 1) MG_FIN(gate1, ll0);
#pragma unroll
            for (int q = 0; q < 8; ++q) PP_PVMMA(o[q & 1], fr[q], pA[q >> 1]); }
        asm volatile("s_waitcnt vmcnt(0)" ::: "memory"); PP_BAR;
        MG_FIN(gate2, ll);
#undef PP_BAR
#undef MG_J
#undef MG_DMA
#undef MG_FIN
#undef MG_ITER
    }
#else
    for (int rep2_ = 0; rep2_ < (PROBE_ATT == 2 ? 2 : 1); ++rep2_)
#pragma unroll 1
    for (int br = 0; br < 2; ++br) {
        if (F.wave == 0) {
            const int j = F.lane; bool on;
            if (br == 0) { const unsigned u0 = UNI[0], u1 = UNI[1]; on = (j <= qb) && (j < 32 ? ((u0 >> j) & 1u) : ((u1 >> (j - 32)) & 1u)); }
            else on = (j <= qb) && (j >= qb - 8);
            const unsigned long long bm = __ballot(on);
            if (on) TL[__popcll(bm & ((1ull << j) - 1ull))] = (unsigned char)j;
            if (j == 0) NTL[0] = __popcll(bm); }
        __syncthreads();
        const int nl = NTL[0]; const bf16_t* Kg = br ? kwr : ksr; const bf16_t* Vg = br ? vwt : vst;
        const float nref = -fminf(sqrtf(qn2 * __uint_as_float(__hip_atomic_load(F.ctl + CW_KMAX + (b * 2 + g) * 2 + br, RLX_AGENT))) * ATT_QS + 1.0f, 300.f);
        float ll = 0.f; f32x16 o[2];
#pragma unroll
        for (int k = 0; k < 16; ++k) { o[0][k] = 0.f; o[1][k] = 0.f; }
#if ATT_PIPE
        { const unsigned nb = cvt_pk_bf16(nref, 0.f) & 0xffffu; const float nrf = __uint_as_float(nb << 16);
          const bf16x8 aones = __builtin_bit_cast(bf16x8, (v4u){hh ? 0u : 0x3f803f80u, 0u, 0u, 0u});
          const unsigned bias_on = hh ? 0u : nb, bias_off = hh ? 0u : (nb | 0xc3480000u);
          const int tlv = TL[ln1_];
          unsigned offK, offV;
          { const int row = 8 * w + (ln1_ >> 3), c = (ln1_ & 7) ^ ((row >> 1) & 7), key = (row & ~12) | ((row & 4) << 1) | ((row & 8) >> 1);
            offK = (unsigned)(key * 128 + c * 16); offV = (unsigned)(row * (SEQ * 2) + c * 16); }
#define PP_BAR do { asm volatile("s_waitcnt lgkmcnt(0)" ::: "memory"); __builtin_amdgcn_s_barrier(); asm volatile("" ::: "memory"); } while (0)
#define PP_DMA(T_) do { const int tc_ = (T_) < nl - 1 ? (T_) : nl - 1; const int j_ = __builtin_amdgcn_readlane(tlv, tc_); const int sl_ = tc_ % ATT_NS; \
            __builtin_amdgcn_global_load_lds((const unsigned*)((const char*)Kg + (size_t)j_ * 8192 + offK), (LAS unsigned*)(lds + sl_ * 8192 + w * 1024), 16, 0, 0); \
            __builtin_amdgcn_global_load_lds((const unsigned*)((const char*)Vg + (size_t)j_ * 128 + offV), (LAS unsigned*)(lds + ATT_VB + sl_ * 8192 + w * 1024), 16, 0, 0); } while (0)
#define PP_ITER(T_, SC, SN) do { const int t_ = (T_); const int tnc_ = t_ + 1 < nl ? t_ + 1 : nl - 1; const int tcc_ = t_ < 0 ? 0 : (t_ < nl ? t_ : nl - 1); \
            const int j = __builtin_amdgcn_readlane(tlv, tnc_); bool lane_on; int lo_k, hi_k; \
            if (br == 0) { lane_on = j < 32 ? ((sel0 >> j) & 1u) : ((sel1 >> (j - 32)) & 1u); lo_k = 0; hi_k = (j == qb) ? tt : 63; } \
            else { lane_on = true; lo_k = (j == qb - 8) ? tt + 1 : 0; hi_k = (j == qb) ? tt : 63; if (lo_k > hi_k) lane_on = false; } \
            bool fullN_ = (j != qb) && (br == 0 || j != qb - 8); if (t_ + 1 >= nl) { lane_on = false; fullN_ = true; } \
            if (!fullC) { const unsigned span_ = (unsigned)(hiC - loC); const int bs_ = loC - 8 * hh; \
                _Pragma("unroll") for (int kt = 0; kt < 2; ++kt) _Pragma("unroll") for (int r = 0; r < 16; ++r) SC[kt][r] += ((unsigned)((32 * kt + 16 * (r >> 3) + (r & 7)) - bs_) <= span_) ? 0.f : -ATT_MASKOFF; } \
            const LAS unsigned char* kb = lds + (tnc_ % ATT_NS) * 8192; const LAS unsigned char* vb = lds + ATT_VB + (tcc_ % ATT_NS) * 8192; \
            _Pragma("unroll") for (int q = 0; q < 8; ++q) { PP_PVMMA(o[q & 1], fr[q], pA[q >> 1]); \
                fr[q] = *(const LAS bf16x8*)(kb + att_swz(32 * (q & 1) + i, 2 * (q >> 1) + hh)); if (q == 3) PP_DMA(t_ + 4); } \
            { const bf16x8 bq_ = __builtin_bit_cast(bf16x8, (v4u){lane_on ? bias_on : bias_off, 0u, 0u, 0u}); const f32x16 z_ = {0.f, 0.f, 0.f, 0.f, 0.f, 0.f, 0.f, 0.f, 0.f, 0.f, 0.f, 0.f, 0.f, 0.f, 0.f, 0.f}; \
              SN[0] = __builtin_amdgcn_mfma_f32_32x32x16_bf16(aones, bq_, z_, 0, 0, 0); SN[1] = __builtin_amdgcn_mfma_f32_32x32x16_bf16(aones, bq_, z_, 0, 0, 0); } \
            _Pragma("unroll") for (int q = 0; q < 8; ++q) { SN[q & 1] = __builtin_amdgcn_mfma_f32_32x32x16_bf16(fr[q], qf[q >> 1], SN[q & 1], 0, 0, 0); \
                fr[q] = *(const LAS bf16x8*)(vb + att_swz(32 * (q & 1) + i, 2 * (q >> 1) + hh)); } \
            _Pragma("unroll") for (int kt = 0; kt < 2; ++kt) _Pragma("unroll") for (int r = 0; r < 16; ++r) { const float pv_ = __builtin_amdgcn_exp2f(SC[kt][r]); SC[kt][r] = pv_; ll += pv_; } \
            _Pragma("unroll") for (int kt = 0; kt < 2; ++kt) _Pragma("unroll") for (int s_ = 0; s_ < 2; ++s_) pA[2 * kt + s_] = (v4u){cvt_pk_bf16(SC[kt][8 * s_], SC[kt][8 * s_ + 1]), cvt_pk_bf16(SC[kt][8 * s_ + 2], SC[kt][8 * s_ + 3]), cvt_pk_bf16(SC[kt][8 * s_ + 4], SC[kt][8 * s_ + 5]), cvt_pk_bf16(SC[kt][8 * s_ + 6], SC[kt][8 * s_ + 7])}; \
            PP_SCHED \
            PROBE_PIPE_X \
            fullC = fullN_; loC = lo_k; hiC = hi_k; \
            asm volatile("s_waitcnt vmcnt(4)" ::: "memory"); PP_BAR; } while (0)
          f32x16 sB[2]; v4u pA[4]; bf16x8 fr[8]; bool fullC = true; int loC = 0, hiC = 63;
#pragma unroll
          for (int r = 0; r < 16; ++r) { sB[0][r] = -ATT_MASKOFF; sB[1][r] = -ATT_MASKOFF; }
#pragma unroll
          for (int q = 0; q < 4; ++q) { pA[q] = (v4u){0u, 0u, 0u, 0u}; fr[q] = __builtin_bit_cast(bf16x8, (v4u){0u, 0u, 0u, 0u}); fr[q + 4] = fr[q]; }
          if (nl > 0) {
          PP_DMA(0); PP_DMA(1); PP_DMA(2);
          asm volatile("s_waitcnt vmcnt(4)" ::: "memory"); PP_BAR;
#pragma unroll 1
          for (int t = -1; t <= nl; t += 2) { PP_ITER(t, sB, s); PP_ITER(t + 1, s, sB); }
          asm volatile("s_waitcnt vmcnt(0)" ::: "memory"); PP_BAR;
          }
#undef PP_BAR
#undef PP_DMA
#undef PP_ITER
        }
#elif ATT_PINGPONG
#ifndef PP_PARITY
#define PP_PARITY 0
#endif
        { const int grp = PP_PARITY ? (w & 1) : (w >> 2), gix = PP_PARITY ? (w >> 1) : (w & 3);
          v4u pb[4]; bool actS = false, actP = false;
#define PP_BAR do { asm volatile("s_waitcnt lgkmcnt(0)" ::: "memory"); __builtin_amdgcn_s_barrier(); asm volatile("" ::: "memory"); } while (0)
          unsigned offK, offV;
          { const int row = 8 * w + (ln1_ >> 3), c = (ln1_ & 7) ^ ((row >> 1) & 7), key = (row & ~12) | ((row & 4) << 1) | ((row & 8) >> 1);
            offK = (unsigned)(key * 128 + c * 16); offV = (unsigned)(row * (SEQ * 2) + c * 16); }
#define PP_DMA(T_) do { const int j_ = TL[T_]; const int sl_ = (T_) % ATT_NS; \
            __builtin_amdgcn_global_load_lds((const unsigned*)((const char*)Kg + (size_t)j_ * 8192 + offK), (LAS unsigned*)(lds + sl_ * 8192 + w * 1024), 16, 0, 0); \
            __builtin_amdgcn_global_load_lds((const unsigned*)((const char*)Vg + (size_t)j_ * 128 + offV), (LAS unsigned*)(lds + ATT_VB + sl_ * 8192 + w * 1024), 16, 0, 0); } while (0)
#define PP_WAIT(cnt_) do { const int c_ = (cnt_); if (c_ >= 2) asm volatile("s_waitcnt vmcnt(4)" ::: "memory"); else if (c_ == 1) asm volatile("s_waitcnt vmcnt(2)" ::: "memory"); else asm volatile("s_waitcnt vmcnt(0)" ::: "memory"); } while (0)
#define PP_LAND(t_) do { if ((t_) + 1 < nl) { const int last_ = (t_) + ATT_NS - 2 < nl - 1 ? (t_) + ATT_NS - 2 : nl - 1; PP_WAIT(last_ - ((t_) + 1)); } } while (0)
#define PP_INI(T_) do { const int j = TL[T_]; bool lane_on; int lo_k, hi_k; \
            if (br == 0) { lane_on = j < 32 ? ((sel0 >> j) & 1u) : ((sel1 >> (j - 32)) & 1u); lo_k = 0; hi_k = (j == qb) ? tt : 63; } \
            else { lane_on = true; lo_k = (j == qb - 8) ? tt + 1 : 0; hi_k = (j == qb) ? tt : 63; if (lo_k > hi_k) lane_on = false; } \
            const bool full = (j != qb) && (br == 0 || j != qb - 8); \
            actS = __any(lane_on); \
            if (actS) att_ini<true>(s, full, lane_on ? nref : nref - ATT_MASKOFF, lo_k, lane_on ? hi_k : -1, hh, nref - ATT_MASKOFF); } while (0)
          { const int np_ = nl < ATT_NS - 2 ? nl : ATT_NS - 2;
#pragma unroll 1
            for (int T_ = 0; T_ < np_; ++T_) PP_DMA(T_);
            PP_WAIT(np_ - 1); }
          if (nl > 0) PP_INI(0);
          PP_BAR;
#ifndef PROBE_SEG
#define PROBE_SEG -1
#endif
#if PROBE_SEG >= 0
          const bool meas_ = blockIdx.x == 0 && qb == 63 && F.tid == (PROBE_SEG >= 4 ? 256 : 0); unsigned long long tprev_ = __builtin_amdgcn_s_memrealtime(), tacc_ = 0;
#define SEGSTAMP(k_) do { if (meas_) { const unsigned long long t_ = __builtin_amdgcn_s_memrealtime(); if ((k_) == (PROBE_SEG & 3)) tacc_ += t_ - tprev_; tprev_ = t_; } } while (0)
#else
#define SEGSTAMP(k_)
#endif
          if (grp) PP_BAR;
          bf16x8 fa[4], fb[4];
#pragma unroll 1
          for (int t = 0; t <= nl; ++t) {
              {
                  const bool doqk = (t < nl) && actS; const LAS unsigned char* kb = lds + (t % ATT_NS) * 8192;
                  PP_PRIO_UP;
                  if (actP) {
#pragma unroll
                      for (int q = 0; q < 4; ++q) o[q & 1] = __builtin_amdgcn_mfma_f32_32x32x16_bf16(fa[q], __builtin_bit_cast(bf16x8, pb[q >> 1]), o[q & 1], 0, 0, 0); }
                  __builtin_amdgcn_sched_barrier(0);
                  if (doqk) {
#pragma unroll
                      for (int q = 0; q < 4; ++q) fa[q] = *(const LAS bf16x8*)(kb + att_swz(32 * (q & 1) + i, 2 * (q >> 1) + hh)); }
                  if (t + ATT_NS - 2 < nl) PP_DMA(t + ATT_NS - 2);
                  __builtin_amdgcn_sched_barrier(0);
                  if (actP) {
#pragma unroll
                      for (int q = 0; q < 4; ++q) o[q & 1] = __builtin_amdgcn_mfma_f32_32x32x16_bf16(fb[q], __builtin_bit_cast(bf16x8, pb[2 + (q >> 1)]), o[q & 1], 0, 0, 0); }
                  __builtin_amdgcn_sched_barrier(0);
                  if (doqk) {
#pragma unroll
                      for (int q = 0; q < 4; ++q) fb[q] = *(const LAS bf16x8*)(kb + att_swz(32 * (q & 1) + i, 2 * (2 + (q >> 1)) + hh)); }
                  __builtin_amdgcn_sched_barrier(0);
                  if (doqk) {
#pragma unroll
                      for (int q = 0; q < 4; ++q) s[q & 1] = __builtin_amdgcn_mfma_f32_32x32x16_bf16(fa[q], qf[q >> 1], s[q & 1], 0, 0, 0);
#pragma unroll
                      for (int q = 0; q < 4; ++q) s[q & 1] = __builtin_amdgcn_mfma_f32_32x32x16_bf16(fb[q], qf[2 + (q >> 1)], s[q & 1], 0, 0, 0); }
                  PP_PRIO_DN;
                  asm volatile("" :: "v"(o[0]), "v"(o[1]), "v"(s[0]), "v"(s[1])); SEGSTAMP(0);
                  if (grp) PP_LAND(t);
              }
              PP_BAR; SEGSTAMP(3);
              if (t < nl) {
                  if (actS) { const LAS unsigned char* vb = lds + ATT_VB + (t % ATT_NS) * 8192;
#pragma unroll
                      for (int q = 0; q < 4; ++q) { fa[q] = *(const LAS bf16x8*)(vb + att_swz(32 * (q & 1) + i, 2 * (q >> 1) + hh)); fb[q] = *(const LAS bf16x8*)(vb + att_swz(32 * (q & 1) + i, 2 * (2 + (q >> 1)) + hh)); }
#pragma unroll
                      for (int kt = 0; kt < 2; ++kt)
#pragma unroll
                          for (int r = 0; r < 16; ++r) { const float pv_ = __builtin_amdgcn_exp2f(s[kt][r]); s[kt][r] = pv_; ll += pv_; }
#pragma unroll
                      for (int kt = 0; kt < 2; ++kt)
#pragma unroll
                          for (int s_ = 0; s_ < 2; ++s_) pb[2 * kt + s_] = (v4u){cvt_pk_bf16(s[kt][8 * s_], s[kt][8 * s_ + 1]), cvt_pk_bf16(s[kt][8 * s_ + 2], s[kt][8 * s_ + 3]), cvt_pk_bf16(s[kt][8 * s_ + 4], s[kt][8 * s_ + 5]), cvt_pk_bf16(s[kt][8 * s_ + 6], s[kt][8 * s_ + 7])};
                  }
                  asm volatile("" :: "v"(pb[0]), "v"(pb[1]), "v"(pb[2]), "v"(pb[3]), "v"(ll)); SEGSTAMP(1);
                  actP = actS;
                  if (t + 1 < nl) PP_INI(t + 1); else actS = false;
                  if (!grp) PP_LAND(t);
              }
              SEGSTAMP(2);
              PP_BAR; SEGSTAMP(3);
          }
          if (!grp) PP_BAR;
#if PROBE_SEG >= 0
          if (meas_) { volatile LAS unsigned long long* TS_ = (volatile LAS unsigned long long*)(F.lds + LDSCTL_OFF + 8192); TS_[60] = 0; TS_[61] = (br ? TS_[61] : 0ull) + tacc_; }
#endif
#undef PP_DMA
#undef PP_WAIT
#undef PP_LAND
#undef PP_INI
        }
#else
#define ATT_BODY \
            bool lane_on; int lo_k, hi_k;     \
            if (br == 0) { lane_on = j < 32 ? ((sel0 >> j) & 1u) : ((sel1 >> (j - 32)) & 1u); lo_k = 0; hi_k = (j == qb) ? tt : 63; } \
            else { lane_on = true; lo_k = (j == qb - 8) ? tt + 1 : 0; hi_k = (j == qb) ? tt : 63; if (lo_k > hi_k) lane_on = false; } \
            const bool full = (j != qb) && (br == 0 || j != qb - 8);               \
            if (__any(lane_on)) { \
                bf16x8 vf[4][2]; \
                { f32x16 ini[2]; att_ini(ini, full, lane_on ? nref : nref - ATT_MASKOFF, lo_k, lane_on ? hi_k : -1, hh, nref - ATT_MASKOFF); att_qk(lds + kslot * 8192, qf, s, i, hh, ini[0], ini[1]); PROBE_TILE_QK } \
                att_vload(lds + ATT_VB + kslot * 8192, vf, i, hh); \
_Pragma("unroll") \
                for (int kt = 0; kt < 2; ++kt) \
_Pragma("unroll") \
                    for (int r = 0; r < 16; ++r) { const float pv_ = __builtin_amdgcn_exp2f(s[kt][r]); s[kt][r] = pv_; ll += pv_; } \
                PROBE_TILE_EXP att_pv(vf, s, o); PROBE_TILE_PV \
            }
        v4u kr2, vr2;
        const int np = (nl + 1) >> 1;
#define ATT_LOADPAIR(p_) do { { const int ja = TL[2 * (p_)]; TileSrc ts{Kg + (size_t)ja * 64 * 64, 64, Vg + (size_t)ja * 64, SEQ}; att_load(ts, F.tid, kr, vr); } \
            if (2 * (p_) + 1 < nl) { const int jb = TL[2 * (p_) + 1]; TileSrc ts{Kg + (size_t)jb * 64 * 64, 64, Vg + (size_t)jb * 64, SEQ}; att_load(ts, F.tid, kr2, vr2); } } while (0)
#define ATT_STOREPAIR(p_, c_) do { att_store(lds, 2 * (c_), F.tid, kr, vr); if (2 * (p_) + 1 < nl) att_store(lds, 2 * (c_) + 1, F.tid, kr2, vr2); } while (0)
        ATT_LOADPAIR(0); ATT_STOREPAIR(0, 0);
        if (np > 1) ATT_LOADPAIR(1);
        __syncthreads();
        int cur = 0;
        for (int p = 0; p < np; ++p) {
            if (p + 1 < np) ATT_STOREPAIR(p + 1, cur ^ 1);
            if (p + 2 < np) ATT_LOADPAIR(p + 2);
#pragma unroll 1
            for (int t2 = 0; t2 < 2; ++t2) { const int it = 2 * p + t2; if (it < nl) { const int j = TL[it]; const int kslot = 2 * cur + t2;
                ATT_BODY
            } }
            __syncthreads(); cur ^= 1;
        }
#undef ATT_LOADPAIR
#undef ATT_STOREPAIR
#undef ATT_BODY
#endif
        ll += __shfl_xor(ll, 32);
        const float sc_ = (rep2_ || !(ll > 0.f)) ? 0.f : (br ? gate2 : gate1) / ll;
#pragma unroll
        for (int dt = 0; dt < 2; ++dt)
#pragma unroll
            for (int k = 0; k < 16; ++k) OUTA[(dt * 16 + k) * 64] += sc_ * o[dt][k];
    }
#endif
    }
#if ATT_STATIC_PRIO
    __builtin_amdgcn_s_setprio(0);
#endif
    if (qb == 63) R7STAMP(45);
    { int ln2_ = F.lane; asm volatile("" : "+v"(ln2_));
      const int i = ln2_ & 31, hh = ln2_ >> 5, head = i >> 3, tt = 8 * w + (i & 7); const size_t tok = (size_t)b * SEQ + 64 * qb + tt;
      LAS float* OUTA = (LAS float*)(lds + ATT_OUTA) + (size_t)w * 32 * 64 + ln2_;
      bf16_t* op = mix + tok * D + 512 + (4 * g + head) * 64 + 4 * hh;
#pragma unroll
      for (int dt = 0; dt < 2; ++dt)
#pragma unroll
          for (int gi = 0; gi < 4; ++gi) { const float a0 = OUTA[(dt * 16 + 4 * gi) * 64], a1 = OUTA[(dt * 16 + 4 * gi + 1) * 64], a2 = OUTA[(dt * 16 + 4 * gi + 2) * 64], a3 = OUTA[(dt * 16 + 4 * gi + 3) * 64];
              v2u ov; ov.x = cvt_pk_bf16(a0, a1); ov.y = cvt_pk_bf16(a2, a3); *(v2u*)(op + 32 * dt + 8 * gi) = ov; } }
    __syncthreads();
}

__global__ void __launch_bounds__(NTHR, 2) mk_fwd(Args args) {
    extern __shared__ __attribute__((aligned(16))) unsigned char lds_raw[];
    Frame F;
    F.lds = (LAS unsigned char*)lds_raw; F.MISC = (volatile LAS unsigned*)(F.lds + MISC_OFF);
    F.tid = threadIdx.x; F.lane = F.tid & 63; F.wave = __builtin_amdgcn_readfirstlane(F.tid >> 6);
    F.G = gridDim.x; { const int bx = blockIdx.x; F.vcu = (F.G % 8 == 0) ? (bx % 8) * (F.G / 8) + bx / 8 : bx; }
    F.ws = args.ws; F.ctl = (unsigned*)(args.ws + WS_CTL); F.out = args.out;
#pragma unroll
    for (int i = 0; i < 25; ++i) F.in[i] = args.in[i];
    for (int u = F.tid; u < (LDS_BYTES - LDSCTL_OFF) / 4; u += NTHR) ((LAS unsigned*)(F.lds + LDSCTL_OFF))[u] = 0u;
    __syncthreads();
    const int lo = args.ph_lo, hi = args.ph_hi;
    XcdBarrier bar = xcd_barrier_post(F.ctl + CW_BAR + lo * XCD_BAR_WORDS, F.MISC + 8);
#define IN_PH(k) (lo <= (k) && (k) < hi)
#ifndef PROBE_TIME
#define PROBE_TIME -1
#endif
    volatile LAS unsigned long long* TS = (volatile LAS unsigned long long*)(F.lds + LDSCTL_OFF + 8192);
    if (PROBE_TIME >= 0 && blockIdx.x == 0 && F.tid == 0) TS[0] = __builtin_amdgcn_s_memrealtime();
#define SEAM(k) do { if (IN_PH(k) && IN_PH((k) + 1)) xcd_barrier(bar); if (PROBE_TIME >= 0 && blockIdx.x == 0 && F.tid == 0) TS[(k) + 1] = __builtin_amdgcn_s_memrealtime(); } while (0)
#define RUNP(k, BODY) do { if (IN_PH(k)) { BODY; if (PROBE_REP == (k)) { xcd_barrier(bar); BODY; } } } while (0)
#define BODY0 p0_prologue(F)
#define BODY1 p1a_norm(F)
#define BODY2 { p2_b1f(F); gm::DenseSched S{(const char*)(F.ws + WS_XN), (const char*)(F.ws + WS_WINT), T / 256, LDP / 256, F.G, (int)blockIdx.x, 2048u, 1024u}; \
        gm::EpiBf16 E{(bf16_t*)(F.ws + WS_PROJ), LDP}; gm::gemm_phase<gm::EpiBf16, gm::DenseSched>(F.lds, S, E, 1024, 128u); \
        { const int nf_ = p2_fillers(F.G), f0_ = F.G - nf_; if (nf_ > 0 && (int)blockIdx.x >= f0_) { __syncthreads(); xpose_fp8(F, 2, (int)blockIdx.x - f0_, nf_); } } }
#define BODY3 { if (F.G == 256) { if (F.vcu < 128) { cmp_unit(F, F.vcu); if (PROBE_P3 == 1) cmp_unit(F, F.vcu); } else { const int u0 = 2 * (F.vcu - 128); hg_passA(F, u0); hg_passA(F, u0 + 1); if (PROBE_P3 == 2) { hg_passA(F, u0); hg_passA(F, u0 + 1); } kv_prep_unit(F, u0); kv_prep_unit(F, u0 + 1); if (PROBE_P3 == 3) { kv_prep_unit(F, u0); kv_prep_unit(F, u0 + 1); } } } \
        else { for (int u = F.vcu; u < 128; u += F.G) cmp_unit(F, u); for (int u = F.vcu; u < 256; u += F.G) hg_passA(F, u); for (int u = F.vcu; u < 256; u += F.G) kv_prep_unit(F, u); } \
        for (int u = F.vcu; u < 256; u += F.G) hg_scan(F, u); }
#define BODY4 { for (int u = F.vcu; u < 256; u += F.G) hg_passC(F, u); }
#define BODY5 { for (int c = F.vcu; c < 256; c += F.G) { const int bg = c >> 5, k = c & 31; att_unit(F, bg * 64 + 63 - k); att_unit(F, bg * 64 + k); } }
#define BODY6 { gm::DenseSched S{(const char*)(F.ws + WS_MIX), (const char*)(F.ws + WS_WOUTT), T / 256, 4, F.G, (int)blockIdx.x, 2048u, 1024u}; \
        gm::EpiRes E{F.in[IN_X], (const float*)(F.ws + WS_MOD), 2, (bf16_t*)(F.ws + WS_X2), (float*)(F.ws + WS_SSQ)}; gm::gemm_phase<gm::EpiRes, gm::DenseSched>(F.lds, S, E, 1024, 128u); }
#define BODY7 p5_router(F)
#define BODY8 { const MoeTabs Tb = moe_tabs_build(F); \
        GateUpSched S{Tb, (const char*)(F.ws + WS_H2), (const char*)(F.ws + WS_WGUT), (const char*)(F.ws + WS_WSGUT), (const int*)(F.ws + WS_ROWL), F.G, (int)blockIdx.x}; \
        EpiSwiglu E{F.ws + WS_ACT, F.ws + WS_ACTS}; gm::gemm_phase<EpiSwiglu, GateUpSched, true, true, true>(F.lds, S, E, 512, 128u); }
#define BODY9 { const MoeTabs Tb = moe_tabs_build(F); DownSched S{Tb, (const char*)(F.ws + WS_ACT), (const char*)(F.ws + WS_ACTS), (const char*)(F.ws + WS_WDNT), (const char*)(F.ws + WS_WSDNT), F.G, (int)blockIdx.x}; \
        EpiDown E{(unsigned char*)(F.ws + WS_Y), (unsigned char*)(F.ws + WS_YS)}; gm::gemm_phase<EpiDown, DownSched, true, true>(F.lds, S, E, 128, 128u); }
#define BODY10 p8_final(F)
    RUNP(0, BODY0); if (!(IN_PH(0) && IN_PH(1))) { SEAM(0); } else if (PROBE_TIME >= 0 && blockIdx.x == 0 && F.tid == 0) TS[1] = __builtin_amdgcn_s_memrealtime();
    RUNP(1, BODY1); SEAM(1);
    RUNP(2, BODY2); SEAM(2);
    RUNP(3, BODY3); SEAM(3);
    RUNP(4, BODY4); if (!(IN_PH(4) && IN_PH(5))) { SEAM(4); } else if (PROBE_TIME >= 0 && blockIdx.x == 0 && F.tid == 0) TS[5] = __builtin_amdgcn_s_memrealtime();
    RUNP(5, BODY5); SEAM(5);
    RUNP(6, BODY6); SEAM(6);
    RUNP(7, BODY7); SEAM(7);
    RUNP(8, BODY8); SEAM(8);
    RUNP(9, BODY9); SEAM(9);
    RUNP(10, BODY10);
    if (PROBE_TIME >= 0 && blockIdx.x == 0) { __syncthreads(); if (F.tid == 0) { const unsigned long long te = __builtin_amdgcn_s_memrealtime(); TS[11] = te;
        const unsigned long long dt = TS[PROBE_TIME + 1] - TS[PROBE_TIME]; while (__builtin_amdgcn_s_memrealtime() - te < (PROBE_TIME >= 40 ? 4ull : PROBE_TIME >= 20 ? 16ull : 4ull) * dt) __builtin_amdgcn_s_sleep(8); } }
#undef IN_PH
#undef SEAM
#undef RUNP
}
#ifndef ONE_LAUNCH
#define ONE_LAUNCH 1
#endif
#ifndef OPT_S1
#define OPT_S1 1
#endif
#ifndef OPT_S2B
#define OPT_S2B 1
#endif
#ifndef OPT_S2A
#define OPT_S2A 1
#endif
#ifndef OPT_S5
#define OPT_S5 1
#endif
#ifndef OPT_S3
#define OPT_S3 1
#endif
#ifndef OPT_S4
#define OPT_S4 1
#endif
static void launch_mk(const nv::In& I, void* const* d_in, float* out, unsigned char* ws, int lo, int hi, int grid, hipStream_t stream) {
    Args a{}; for (int i = 0; i < 25; ++i) a.in[i] = (const float*)d_in[i];
    a.out = out; a.ws = ws; a.ph_lo = lo; a.ph_hi = hi; a.rep = 0; a.pad = 0;
    hipLaunchKernelGGL(mk_fwd, dim3(grid), dim3(NTHR), LDS_BYTES, stream, a);
}
extern "C" void kernel_launch(void* const* d_in, const int* in_sizes, int n_in, void* d_out, int out_size, void* d_ws, size_t ws_size, hipStream_t stream) {
    static int grid = 0;
    if (grid == 0) {
        if (ws_size < WS_END || n_in != 25) { fprintf(stderr, "kernel_launch: ws %zu < %zu or n_in %d != 25\n", ws_size, (size_t)WS_END, n_in); grid = -1; return; }
        int dev = 0, cus = 0;
        if (hipGetDevice(&dev) != hipSuccess || hipDeviceGetAttribute(&cus, hipDeviceAttributeMultiprocessorCount, dev) != hipSuccess) { grid = -1; return; }
        if (hipFuncSetAttribute((const void*)mk_fwd, hipFuncAttributeMaxDynamicSharedMemorySize, LDS_BYTES) != hipSuccess) { fprintf(stderr, "kernel_launch: hipFuncSetAttribute failed\n"); grid = -1; return; }
        int per_cu = 0; (void)hipOccupancyMaxActiveBlocksPerMultiprocessor(&per_cu, (const void*)mk_fwd, NTHR, LDS_BYTES); (void)hipGetLastError();
        if (per_cu < 1) fprintf(stderr, "kernel_launch: occupancy query says %d blocks/CU\n", per_cu);
        grid = cus;
    }
    if (grid < 0) return;
    unsigned char* ws = (unsigned char*)d_ws; float* out = (float*)d_out;
    nv::In I; I.set(d_in);
    (void)hipMemsetAsync(ws + WS_CTL, 0, CTL_ZERO_BYTES, stream);
#if ONE_LAUNCH
    launch_mk(I, d_in, out, ws, 0, 11, grid, stream);
#else
#if OPT_S1
    launch_mk(I, d_in, out, ws, 0, 3, grid, stream);
#else
    nv::s1_naive(I, ws, stream);
#endif
#if OPT_S2A
    launch_mk(I, d_in, out, ws, 3, OPT_S2B ? 6 : 5, grid, stream);
#endif
    if (!OPT_S2A || !OPT_S2B) nv::s2_naive(I, ws, stream, !OPT_S2A, !OPT_S2B);
#if OPT_S3
    launch_mk(I, d_in, out, ws, 6, OPT_S4 ? 8 : 7, grid, stream);
#else
    nv::s3_naive(I, ws, stream);
#endif
#if OPT_S4
    if (!OPT_S3) launch_mk(I, d_in, out, ws, 7, 8, grid, stream);
#else
    nv::s4_naive(I, ws, stream);
#endif
#if OPT_S5
    launch_mk(I, d_in, out, ws, 8, 11, grid, stream);
#else
    nv::s5_naive(I, ws, out, stream);
#endif
#endif
}
#endif
```
